# Optimizing an MI355X kernel written in HIP

```python
import jax, jax.numpy as jnp
from jax import lax
import numpy as np

D_MODEL = 1024
BATCH = 2
SEQ = 8192
DEPTH = 2

HEAD_DIM = 64
ROT_DIM = HEAD_DIM // 4
ROPE_THETA = 500000.0
NORM_EPS = 1e-6
NEG = -1e30
Q_BLOCK = 128

A_HEADS = 8
MOBA_BLOCK = 256
MOBA_TOPK = 3
B_HEADS = 8
IDX_HEADS = 4
IDX_DIM = 64
DSA_TOPK = 256
C_HEADS = 16
DILATED_PAIRS = ((128, 1), (512, 4), (2048, 16))
PEER_HEADS = 8
N_KEYS = 128
N_EXPERTS = N_KEYS * N_KEYS
PEER_TOPK = 16
PEER_QDIM = 256
PEER_TOKEN_BLOCK = 128
PLE_DIM = 256

N_EVEN = (DEPTH + 1) // 2
N_ODD = DEPTH // 2
A_WIDTH = A_HEADS * HEAD_DIM
B_WIDTH = B_HEADS * HEAD_DIM
AB_WIDTH = A_WIDTH + B_WIDTH
AB_IN = 3 * AB_WIDTH + IDX_HEADS * IDX_DIM + IDX_DIM + IDX_HEADS
C_WIDTH = C_HEADS * HEAD_DIM
C_IN = 3 * C_WIDTH

kernel_name = "hybrid_moba_dsa_dilated_peer_trunk"


def rmsnorm(x, g):
    xf = x.astype(jnp.float32)
    y = xf * lax.rsqrt(jnp.mean(xf * xf, axis=-1, keepdims=True) + NORM_EPS)
    return (y * g.astype(jnp.float32)).astype(x.dtype)


def rope_tables(positions):
    half = ROT_DIM // 2
    inv = ROPE_THETA ** (-jnp.arange(half, dtype=jnp.float32) / half)
    ang = positions.astype(jnp.float32)[..., None] * inv
    return jnp.cos(ang)[:, :, None, :], jnp.sin(ang)[:, :, None, :]


def partial_rope(x, cos, sin):
    half = ROT_DIM // 2
    xf = x.astype(jnp.float32)
    x1 = xf[..., :half]
    x2 = xf[..., half:ROT_DIM]
    out = jnp.concatenate([x1 * cos - x2 * sin, x2 * cos + x1 * sin, xf[..., ROT_DIM:]], axis=-1)
    return out.astype(x.dtype)


def qk_prep(q, k, gq, gk, cos, sin):
    return partial_rope(rmsnorm(q, gq), cos, sin), partial_rope(rmsnorm(k, gk), cos, sin)


def moba_attention(q, k, v):
    B, S, H, dh = q.shape
    scale = dh ** -0.5
    Sp = -(-S // MOBA_BLOCK) * MOBA_BLOCK
    pad = ((0, 0), (0, Sp - S), (0, 0), (0, 0))
    qp, kp, vp = [jnp.pad(a, pad).transpose(0, 2, 1, 3) for a in (q, k, v)]
    nb = Sp // MOBA_BLOCK
    qb = qp.reshape(B, H, nb, MOBA_BLOCK, dh)
    kb = kp.reshape(B, H, nb, MOBA_BLOCK, dh)
    vb = vp.reshape(B, H, nb, MOBA_BLOCK, dh)
    s_own = jnp.einsum('bhnqd,bhnkd->bhnqk', qb, kb).astype(jnp.float32) * scale
    causal = jnp.tril(jnp.ones((MOBA_BLOCK, MOBA_BLOCK), dtype=bool))
    s_own = jnp.where(causal, s_own, NEG)
    m_own = jnp.max(s_own, axis=-1)
    p_own = jnp.exp(s_own - m_own[..., None])
    l_own = jnp.sum(p_own, axis=-1)
    o_own = jnp.einsum('bhnqk,bhnkd->bhnqd', p_own, vb.astype(jnp.float32)) / l_own[..., None]
    o_own = o_own.reshape(B, H, Sp, dh)
    lse_own = (m_own + jnp.log(l_own)).reshape(B, H, Sp)
    n_sel = min(MOBA_TOPK, nb - 1)
    if n_sel == 0:
        out = o_own
    else:
        kmean = jnp.mean(kb.astype(jnp.float32), axis=3)
        gate = jnp.einsum('bhsd,bhnd->bhsn', qp.astype(jnp.float32), kmean)
        qblk = jnp.arange(Sp) // MOBA_BLOCK
        past = jnp.arange(nb)[None, :] < qblk[:, None]
        gate = jnp.where(past, gate, NEG)
        _, gidx = lax.top_k(gate, n_sel)
        gvalid = gidx < qblk[:, None]
        nq = Sp // Q_BLOCK
        to_chunks = lambda a: jnp.moveaxis(a.reshape(B, H, nq, Q_BLOCK, *a.shape[3:]), 2, 0)
        bi = jnp.arange(B)[:, None, None, None]
        hi = jnp.arange(H)[None, :, None, None]

        def sel_step(args):
            qc, ic, vc = args
            kg = kb[bi, hi, ic]
            vg = vb[bi, hi, ic]
            s = jnp.einsum('bhqd,bhqnkd->bhqnk', qc, kg).astype(jnp.float32) * scale
            s = jnp.where(vc[..., None], s, NEG).reshape(B, H, Q_BLOCK, n_sel * MOBA_BLOCK)
            m = jnp.max(s, axis=-1)
            pr = jnp.exp(s - m[..., None])
            l = jnp.sum(pr, axis=-1)
            o = jnp.einsum('bhqj,bhqjd->bhqd', pr,
                           vg.reshape(B, H, Q_BLOCK, n_sel * MOBA_BLOCK, dh).astype(jnp.float32)) / l[..., None]
            return o, m + jnp.log(l)

        o_sel, lse_sel = lax.map(sel_step, (to_chunks(qp), to_chunks(gidx), to_chunks(gvalid)))
        o_sel = jnp.moveaxis(o_sel, 0, 2).reshape(B, H, Sp, dh)
        lse_sel = jnp.moveaxis(lse_sel, 0, 2).reshape(B, H, Sp)
        mx = jnp.maximum(lse_own, lse_sel)
        w1 = jnp.exp(lse_own - mx)
        w2 = jnp.exp(lse_sel - mx)
        out = (o_own * w1[..., None] + o_sel * w2[..., None]) / (w1 + w2)[..., None]
    return out.transpose(0, 2, 1, 3)[:, :S].astype(q.dtype)


def dsa_attention(q, k, v, q_idx, k_idx, w_idx):
    B, S, H, dh = q.shape
    n_sel = min(DSA_TOPK, S // 4)
    nq = S // Q_BLOCK
    scale = dh ** -0.5
    kpos = jnp.arange(S)
    bi = jnp.arange(B)[:, None, None]
    to_chunks = lambda a: jnp.moveaxis(a.reshape(B, nq, Q_BLOCK, *a.shape[2:]), 1, 0)

    def step(args):
        qc, qic, wc, t0 = args
        tpos = t0 + jnp.arange(Q_BLOCK)
        logits = jnp.einsum('bqhd,bsd->bqhs', qic, k_idx).astype(jnp.float32)
        score = jnp.einsum('bqh,bqhs->bqs', wc.astype(jnp.float32), jax.nn.relu(logits))
        adm = kpos[None, :] <= tpos[:, None]
        score = jnp.where(adm, score, NEG)
        _, sidx = lax.top_k(score, n_sel)
        valid = sidx <= tpos[None, :, None]
        kg = k[bi, sidx]
        vg = v[bi, sidx]
        s = jnp.einsum('bqhd,bqnhd->bqhn', qc, kg).astype(jnp.float32) * scale
        s = jnp.where(valid[:, :, None, :], s, NEG)
        pr = jax.nn.softmax(s, axis=-1)
        return jnp.einsum('bqhn,bqnhd->bqhd', pr, vg.astype(jnp.float32)).astype(q.dtype)

    t0s = jnp.arange(nq, dtype=jnp.int32) * Q_BLOCK
    o = lax.map(step, (to_chunks(q), to_chunks(q_idx), to_chunks(w_idx), t0s))
    return jnp.moveaxis(o, 0, 1).reshape(B, S, H, dh)


def dilated_branch(q, k, v, window, dil):
    B, S, H, dh = q.shape
    band = window // dil
    scale = dh ** -0.5
    span = dil * band
    Sp = -(-S // span) * span
    M = Sp // dil
    nb = M // band

    def split(a):
        a = jnp.pad(a, ((0, 0), (0, Sp - S), (0, 0), (0, 0)))
        a = a.reshape(B, M, dil, H, dh).transpose(0, 2, 3, 1, 4)
        return a.reshape(B, dil, H, nb, band, dh)

    def with_prev(a):
        prev = jnp.pad(a, ((0, 0), (0, 0), (0, 0), (1, 0), (0, 0), (0, 0)))[:, :, :, :-1]
        return jnp.concatenate([prev, a], axis=4)

    qb = split(q)
    kk = with_prev(split(k))
    vv = with_prev(split(v))
    s = jnp.einsum('brhnqd,brhnkd->brhnqk', qb, kk).astype(jnp.float32) * scale
    i = jnp.arange(band)[:, None]
    j = jnp.arange(2 * band)[None, :]
    dist = i + band - j
    in_band = (dist >= 0) & (dist <= band)
    mask = in_band[None] & ((jnp.arange(nb)[:, None, None] > 0) | (j[None] >= band))
    s = jnp.where(mask, s, NEG)
    m = jnp.max(s, axis=-1)
    pr = jnp.exp(s - m[..., None])
    l = jnp.sum(pr, axis=-1)
    o = jnp.einsum('brhnqk,brhnkd->brhnqd', pr, vv.astype(jnp.float32)) / l[..., None]
    lse = m + jnp.log(l)
    o = o.reshape(B, dil, H, M, dh).transpose(0, 3, 1, 2, 4).reshape(B, Sp, H, dh)[:, :S]
    lse = lse.reshape(B, dil, H, M).transpose(0, 3, 1, 2).reshape(B, Sp, H)[:, :S]
    return o, lse


def dilated_attention(q, k, v):
    outs, lses = [], []
    for window, dil in DILATED_PAIRS:
        o, lse = dilated_branch(q, k, v, window, dil)
        outs.append(o)
        lses.append(lse)
    wts = jax.nn.softmax(jnp.stack(lses, axis=0), axis=0)
    return jnp.einsum('gbsh,gbshd->bshd', wts, jnp.stack(outs, axis=0)).astype(q.dtype)


def ab_mixer(xn, cos, sin, w_in, w_out, a_q_norm, a_k_norm, b_q_norm, b_k_norm):
    B, S, _ = xn.shape
    sizes = [A_WIDTH, A_WIDTH, A_WIDTH, B_WIDTH, B_WIDTH, B_WIDTH, IDX_HEADS * IDX_DIM, IDX_DIM, IDX_HEADS]
    cuts = np.cumsum(sizes)[:-1].tolist()
    qa, ka, va, qb, kb, vb, qi, ki, wi = jnp.split(xn @ w_in, cuts, axis=-1)
    heads = lambda a, n: a.reshape(B, S, n, -1)
    qa, ka = qk_prep(heads(qa, A_HEADS), heads(ka, A_HEADS), a_q_norm, a_k_norm, cos, sin)
    oa = moba_attention(qa, ka, heads(va, A_HEADS))
    qb, kb = qk_prep(heads(qb, B_HEADS), heads(kb, B_HEADS), b_q_norm, b_k_norm, cos, sin)
    qi = partial_rope(heads(qi, IDX_HEADS), cos, sin)
    ki = partial_rope(ki[:, :, None, :], cos, sin)[:, :, 0]
    ob = dsa_attention(qb, kb, heads(vb, B_HEADS), qi, ki, wi)
    o = jnp.concatenate([oa.reshape(B, S, A_WIDTH), ob.reshape(B, S, B_WIDTH)], axis=-1)
    return o @ w_out


def c_mixer(xn, cos, sin, w_in, w_out, q_norm, k_norm):
    B, S, _ = xn.shape
    q, k, v = jnp.split(xn @ w_in, 3, axis=-1)
    heads = lambda a: a.reshape(B, S, C_HEADS, HEAD_DIM)
    q, k = qk_prep(heads(q), heads(k), q_norm, k_norm, cos, sin)
    o = dilated_attention(q, k, heads(v))
    return o.reshape(B, S, C_WIDTH) @ w_out


def peer_ffn(xn, w_query, sub_keys, expert_u, expert_v):
    B, S, D = xn.shape
    T = B * S
    xt = xn.reshape(T // PEER_TOKEN_BLOCK, PEER_TOKEN_BLOCK, D)

    def step(xc):
        tc = xc.shape[0]
        qry = (xc @ w_query).reshape(tc, PEER_HEADS, 2, PEER_QDIM // 2)
        s = jnp.einsum('thcd,hckd->thck', qry, sub_keys).astype(jnp.float32)
        sv, si = lax.top_k(s, PEER_TOPK)
        cand = (sv[:, :, 0, :, None] + sv[:, :, 1, None, :]).reshape(tc, PEER_HEADS, PEER_TOPK * PEER_TOPK)
        cidx = (si[:, :, 0, :, None] * N_KEYS + si[:, :, 1, None, :]).reshape(tc, PEER_HEADS, PEER_TOPK * PEER_TOPK)
        cv, ci = lax.top_k(cand, PEER_TOPK)
        eidx = jnp.take_along_axis(cidx, ci, axis=-1)
        g = jax.nn.softmax(cv, axis=-1)
        u = expert_u[eidx]
        a = jax.nn.gelu(jnp.einsum('td,thkd->thk', xc, u).astype(jnp.float32))
        ve = expert_v[eidx]
        return jnp.einsum('thk,thkd->td', (g * a).astype(ve.dtype), ve).astype(xc.dtype)

    return lax.map(step, xt).reshape(B, S, D)


def setup_inputs(seed: int = 0) -> dict:
    key = jax.random.key(seed)
    ks = jax.random.split(key, 24)
    f32 = jnp.float32
    nrm = lambda k, shape, sc: jax.random.normal(k, shape, f32) * sc
    gain = lambda k, shape: 1.0 + 0.05 * jax.random.normal(k, shape, f32)
    return {
        "x": nrm(ks[0], (BATCH, SEQ, D_MODEL), 1.0),
        "p": nrm(ks[1], (DEPTH, BATCH, SEQ, PLE_DIM), 1.0),
        "positions": jnp.broadcast_to(jnp.arange(SEQ, dtype=jnp.int32), (BATCH, SEQ)),
        "attn_norm": gain(ks[2], (DEPTH, D_MODEL)),
        "ffn_norm": gain(ks[3], (DEPTH, D_MODEL)),
        "ple_norm": gain(ks[4], (DEPTH, D_MODEL)),
        "ab_w_in": nrm(ks[5], (N_EVEN, D_MODEL, AB_IN), D_MODEL ** -0.5),
        "ab_w_out": nrm(ks[6], (N_EVEN, AB_WIDTH, D_MODEL), AB_WIDTH ** -0.5),
        "a_q_norm": gain(ks[7], (N_EVEN, HEAD_DIM)),
        "a_k_norm": gain(ks[8], (N_EVEN, HEAD_DIM)),
        "b_q_norm": gain(ks[9], (N_EVEN, HEAD_DIM)),
        "b_k_norm": gain(ks[10], (N_EVEN, HEAD_DIM)),
        "c_w_in": nrm(ks[11], (N_ODD, D_MODEL, C_IN), D_MODEL ** -0.5),
        "c_w_out": nrm(ks[12], (N_ODD, C_WIDTH, D_MODEL), C_WIDTH ** -0.5),
        "c_q_norm": gain(ks[13], (N_ODD, HEAD_DIM)),
        "c_k_norm": gain(ks[14], (N_ODD, HEAD_DIM)),
        "peer_w_query": nrm(ks[15], (DEPTH, D_MODEL, PEER_HEADS * PEER_QDIM), D_MODEL ** -0.5),
        "peer_sub_keys": nrm(ks[16], (DEPTH, PEER_HEADS, 2, N_KEYS, PEER_QDIM // 2), (PEER_QDIM // 2) ** -0.5),
        "peer_u": nrm(ks[17], (DEPTH, N_EXPERTS, D_MODEL), D_MODEL ** -0.5),
        "peer_v": nrm(ks[18], (DEPTH, N_EXPERTS, D_MODEL), PEER_HEADS ** -0.5),
        "ple_w_gate": nrm(ks[19], (DEPTH, D_MODEL, D_MODEL), D_MODEL ** -0.5),
        "ple_w_up": nrm(ks[20], (DEPTH, PLE_DIM, D_MODEL), PLE_DIM ** -0.5),
    }


def reference(x, p, positions, attn_norm, ffn_norm, ple_norm, ab_w_in, ab_w_out,
              a_q_norm, a_k_norm, b_q_norm, b_k_norm, c_w_in, c_w_out, c_q_norm, c_k_norm,
              peer_w_query, peer_sub_keys, peer_u, peer_v, ple_w_gate, ple_w_up):
    cos, sin = rope_tables(positions)
    h = x
    for i in range(DEPTH):
        xn = rmsnorm(h, attn_norm[i])
        if i % 2 == 0:
            j = i // 2
            h = h + ab_mixer(xn, cos, sin, ab_w_in[j], ab_w_out[j],
                             a_q_norm[j], a_k_norm[j], b_q_norm[j], b_k_norm[j])
        else:
            j = i // 2
            h = h + c_mixer(xn, cos, sin, c_w_in[j], c_w_out[j], c_q_norm[j], c_k_norm[j])
        h = h + peer_ffn(rmsnorm(h, ffn_norm[i]), peer_w_query[i], peer_sub_keys[i], peer_u[i], peer_v[i])
        gate = jax.nn.sigmoid(rmsnorm(h, ple_norm[i]) @ ple_w_gate[i])
        h = h + (p[i] @ ple_w_up[i]) * gate
    return h
```

```cpp
#include <hip/hip_runtime.h>
#include <cstdio>
#include <cstdint>

constexpr int BATCH = 2, SEQ = 8192, T = BATCH * SEQ, DM = 1024;
constexpr int AB_N = 3396, AB_LD = 3584;
constexpr int CQA = 0, CKA = 512, CVA = 1024, CQB = 1536, CKB = 2048, CVB = 2560, CQI = 3072, CKI = 3328, CWI = 3392;
constexpr int C_LD = 3072;
constexpr int NEXP = 16384;
constexpr float NORM_EPS = 1e-6f;
constexpr float C2 = 0.125f * 1.4426950408889634f;
constexpr int NT = 512;

constexpr size_t MiB = 1u << 20;
constexpr size_t WS_CTL = 0;
constexpr size_t WS_KMEAN = 32 * MiB;
constexpr size_t WS_SEL = 33 * MiB;
constexpr size_t WS_LSE = 34 * MiB;
constexpr size_t WS_EIDX = 37 * MiB;
constexpr size_t WS_GW = 45 * MiB;
constexpr size_t WS_P = 53 * MiB;
constexpr size_t WS_XN = 69 * MiB;
constexpr size_t WS_QKV = 101 * MiB;
constexpr size_t WS_MASK = 213 * MiB;
constexpr size_t WS_SCORES = 229 * MiB;
constexpr size_t WS_QRY = 101 * MiB;
constexpr size_t WS_UP = 165 * MiB;
constexpr size_t WS_QKV1 = 357 * MiB;
constexpr size_t WS_OG = 101 * MiB;
constexpr size_t WS_END = 512 * MiB;

typedef unsigned short bf16;
typedef float f32x4 __attribute__((ext_vector_type(4)));

__device__ __forceinline__ unsigned f2bf(float f) { unsigned u = __builtin_bit_cast(unsigned, f); return (u + 0x7fffu + ((u >> 16) & 1u)) >> 16; }
__device__ __forceinline__ float bf2f(bf16 h) { return __builtin_bit_cast(float, (unsigned)h << 16); }
__device__ __forceinline__ float wave_sum(float v) {
#pragma unroll
    for (int o = 1; o < 64; o <<= 1) v += __shfl_xor(v, o);
    return v;
}
__device__ __forceinline__ float wave_max(float v) {
#pragma unroll
    for (int o = 1; o < 64; o <<= 1) v = fmaxf(v, __shfl_xor(v, o));
    return v;
}
__device__ __forceinline__ unsigned okey(float f) { unsigned u = __builtin_bit_cast(unsigned, f); return (u & 0x80000000u) ? ~u : (u | 0x80000000u); }

struct Params {
    const float* in[22];
    float* out;
    unsigned char* ws;
    int layer;
    int pad;
};

__device__ void ph_rmsnorm(const float* src, const float* gain, bf16* dst) {
    const int lane = threadIdx.x & 63, wave = threadIdx.x >> 6;
    const int gw = blockIdx.x * (NT / 64) + wave, ngw = gridDim.x * (NT / 64);
    for (int r = gw; r < T; r += ngw) {
        const f32x4* xr = (const f32x4*)(src + (size_t)r * DM) + lane;
        f32x4 v[4]; float s = 0.f;
#pragma unroll
        for (int j = 0; j < 4; ++j) { v[j] = xr[64 * j]; s += v[j].x * v[j].x + v[j].y * v[j].y + v[j].z * v[j].z + v[j].w * v[j].w; }
        const float rstd = 1.0f / sqrtf(wave_sum(s) * (1.0f / DM) + NORM_EPS);
#pragma unroll
        for (int j = 0; j < 4; ++j) {
            const f32x4 g = ((const f32x4*)gain)[lane + 64 * j];
            unsigned long long o = (unsigned long long)(f2bf(v[j].x * rstd * g.x) | (f2bf(v[j].y * rstd * g.y) << 16)) |
                                   ((unsigned long long)(f2bf(v[j].z * rstd * g.z) | (f2bf(v[j].w * rstd * g.w) << 16)) << 32);
            ((unsigned long long*)(dst + (size_t)r * DM))[lane + 64 * j] = o;
        }
    }
}

template <class AT> __device__ __forceinline__ float ldA(const AT* p);
template <> __device__ __forceinline__ float ldA<bf16>(const bf16* p) { return bf2f(*p); }
template <> __device__ __forceinline__ float ldA<float>(const float* p) { return *p; }

template <class AT, class Epi>
__device__ void ph_gemm_naive(const AT* A, int lda, const float* B, int N, int K, const Epi& E, unsigned char* smem) {
    float* As = (float*)smem;
    float* Bs = As + 16 * 132;
    const int tid = threadIdx.x, ty = tid >> 5, tx = tid & 31;
    const int ntn = (N + 127) / 128, ntm = T / 128, ntile = ntn * ntm;
    for (int tile = blockIdx.x; tile < ntile; tile += gridDim.x) {
        const int tm = tile / ntn, tn = tile % ntn, m0 = tm * 128, n0 = tn * 128;
        float acc[8][4];
#pragma unroll
        for (int i = 0; i < 8; ++i)
#pragma unroll
            for (int j = 0; j < 4; ++j) acc[i][j] = 0.f;
        for (int k0 = 0; k0 < K; k0 += 16) {
            __syncthreads();
#pragma unroll
            for (int i = 0; i < 4; ++i) { const int e = tid + i * NT, r = e >> 4, kk = e & 15; As[kk * 132 + r] = ldA<AT>(A + (size_t)(m0 + r) * lda + k0 + kk); }
#pragma unroll
            for (int i = 0; i < 4; ++i) { const int e = tid + i * NT, kk = e >> 7, c = e & 127; Bs[kk * 128 + c] = (n0 + c < N) ? B[(size_t)(k0 + kk) * N + n0 + c] : 0.f; }
            __syncthreads();
#pragma unroll
            for (int kk = 0; kk < 16; ++kk) {
                float a[8], b[4];
#pragma unroll
                for (int i = 0; i < 8; ++i) a[i] = As[kk * 132 + ty * 8 + i];
#pragma unroll
                for (int j = 0; j < 4; ++j) b[j] = Bs[kk * 128 + tx * 4 + j];
#pragma unroll
                for (int i = 0; i < 8; ++i)
#pragma unroll
                    for (int j = 0; j < 4; ++j) acc[i][j] += a[i] * b[j];
            }
        }
#pragma unroll
        for (int i = 0; i < 8; ++i) {
            const int col = n0 + tx * 4;
            if (col < N) E.store4(m0 + ty * 8 + i, col, (f32x4){acc[i][0], acc[i][1], acc[i][2], acc[i][3]});
        }
    }
}
struct EpBf16 { bf16* O; int ldc;
    __device__ __forceinline__ void store4(int r, int c, f32x4 v) const {
        unsigned long long o = (unsigned long long)(f2bf(v.x) | (f2bf(v.y) << 16)) | ((unsigned long long)(f2bf(v.z) | (f2bf(v.w) << 16)) << 32);
        *(unsigned long long*)(O + (size_t)r * ldc + c) = o; } };
struct EpResAdd { const float* base; float* out;
    __device__ __forceinline__ void store4(int r, int c, f32x4 v) const {
        const f32x4 b = *(const f32x4*)(base + (size_t)r * DM + c); *(f32x4*)(out + (size_t)r * DM + c) = b + v; } };
struct EpGate { float* h; const bf16* up;
    __device__ __forceinline__ void store4(int r, int c, f32x4 v) const {
        f32x4 hv = *(const f32x4*)(h + (size_t)r * DM + c); const bf16* u = up + (size_t)r * DM + c;
        hv.x += bf2f(u[0]) / (1.f + __expf(-v.x)); hv.y += bf2f(u[1]) / (1.f + __expf(-v.y));
        hv.z += bf2f(u[2]) / (1.f + __expf(-v.z)); hv.w += bf2f(u[3]) / (1.f + __expf(-v.w));
        *(f32x4*)(h + (size_t)r * DM + c) = hv; } };

__device__ __forceinline__ void rope_cs(int pos, int i, float& c, float& s) {
    const float inv = exp2f(-(float)i * 0.125f * 18.931568569324174f);
    const float ang = (float)pos * inv;
    const float k = rintf(ang * 0.15915494309189535f);
    float r = fmaf(-k, 6.28125f, ang); r = fmaf(-k, 1.9353071795864769e-3f, r);
    c = cosf(r); s = sinf(r);
}
__device__ __forceinline__ void prep_head(bf16* p, const float* gain, int pos, float scale, bool donorm, int lane) {
    float v = bf2f(p[lane]);
    if (donorm) { const float ss = wave_sum(v * v); v = v * (1.0f / sqrtf(ss * (1.0f / 64.f) + NORM_EPS)) * gain[lane]; }
    const float partner = __shfl_xor(v, 8);
    float c = 1.f, s = 0.f;
    if (lane < 16) rope_cs(pos, lane & 7, c, s);
    float o = v;
    if (lane < 8) o = v * c - partner * s; else if (lane < 16) o = v * c + partner * s;
    p[lane] = (bf16)f2bf(o * scale);
}
__device__ void ph_prep0(bf16* qkv, const int* positions, const float* aq, const float* ak, const float* bq, const float* bk) {
    const int lane = threadIdx.x & 63, wave = threadIdx.x >> 6;
    const int gw = blockIdx.x * (NT / 64) + wave, ngw = gridDim.x * (NT / 64);
    for (int r = gw; r < T; r += ngw) {
        const int pos = positions[r]; bf16* row = qkv + (size_t)r * AB_LD;
        for (int h = 0; h < 8; ++h) {
            prep_head(row + CQA + h * 64, aq, pos, C2, true, lane);
            prep_head(row + CKA + h * 64, ak, pos, 1.f, true, lane);
            prep_head(row + CQB + h * 64, bq, pos, C2, true, lane);
            prep_head(row + CKB + h * 64, bk, pos, 1.f, true, lane);
        }
        for (int h = 0; h < 4; ++h) prep_head(row + CQI + h * 64, nullptr, pos, 1.f, false, lane);
        prep_head(row + CKI, nullptr, pos, 1.f, false, lane);
    }
}
__device__ void ph_prep1(bf16* qkv, const int* positions, const float* cq, const float* ck) {
    const int lane = threadIdx.x & 63, wave = threadIdx.x >> 6;
    const int gw = blockIdx.x * (NT / 64) + wave, ngw = gridDim.x * (NT / 64);
    for (int r = gw; r < T; r += ngw) {
        const int pos = positions[r]; bf16* row = qkv + (size_t)r * C_LD;
        for (int h = 0; h < 16; ++h) {
            prep_head(row + h * 64, cq, pos, C2, true, lane);
            prep_head(row + 1024 + h * 64, ck, pos, 1.f, true, lane);
        }
    }
}
__device__ void ph_kmean(const bf16* qkv, float* kmean) {
    const int lane = threadIdx.x & 63, wave = threadIdx.x >> 6;
    const int gw = blockIdx.x * (NT / 64) + wave, ngw = gridDim.x * (NT / 64);
    for (int it = gw; it < BATCH * 8 * 32; it += ngw) {
        const int b = it / 256, h = (it / 32) % 8, n = it % 32;
        float s = 0.f;
        for (int r = 0; r < 256; ++r) s += bf2f(qkv[(size_t)(b * SEQ + n * 256 + r) * AB_LD + CKA + h * 64 + lane]);
        kmean[(size_t)it * 64 + lane] = s * (1.0f / 256.f);
    }
}
__device__ void ph_moba_select(const bf16* qkv, const float* kmean, unsigned* sel) {
    for (int it = blockIdx.x * NT + threadIdx.x; it < T * 8; it += gridDim.x * NT) {
        const int t = it >> 3, h = it & 7, b = t / SEQ, qblk = (t % SEQ) / 256;
        float q[64];
#pragma unroll
        for (int d = 0; d < 64; ++d) q[d] = bf2f(qkv[(size_t)t * AB_LD + CQA + h * 64 + d]);
        float v0 = -3e38f, v1 = -3e38f, v2 = -3e38f; int i0 = 255, i1 = 255, i2 = 255;
        for (int n = 0; n < qblk; ++n) {
            const float* km = kmean + (size_t)((b * 8 + h) * 32 + n) * 64; float g = 0.f;
#pragma unroll
            for (int d = 0; d < 64; ++d) g += q[d] * km[d];
            if (g > v0) { v2 = v1; i2 = i1; v1 = v0; i1 = i0; v0 = g; i0 = n; }
            else if (g > v1) { v2 = v1; i2 = i1; v1 = g; i1 = n; }
            else if (g > v2) { v2 = g; i2 = n; }
        }
        sel[it] = (unsigned)i0 | ((unsigned)i1 << 8) | ((unsigned)i2 << 16) | (255u << 24);
    }
}
__device__ void ph_moba_attend(const bf16* qkv, const unsigned* sel, bf16* O, unsigned char* smem) {
    const int lane = threadIdx.x & 63, wave = threadIdx.x >> 6;
    float* pl = (float*)smem + wave * 1024;
    const int gw = blockIdx.x * (NT / 64) + wave, ngw = gridDim.x * (NT / 64);
    for (int it = gw; it < T * 8; it += ngw) {
        const int t = it >> 3, h = it & 7, b = t / SEQ, tt = t % SEQ, qblk = tt / 256;
        const unsigned sw = sel[it];
        int blk[4] = {qblk, (int)(sw & 255), (int)((sw >> 8) & 255), (int)((sw >> 16) & 255)};
        const bf16* qp = qkv + (size_t)t * AB_LD + CQA + h * 64;
        float q[64];
#pragma unroll
        for (int d = 0; d < 64; ++d) q[d] = bf2f(qp[d]);
        float sc[16]; float mx = -3e38f;
#pragma unroll
        for (int s = 0; s < 4; ++s) {
#pragma unroll
            for (int i = 0; i < 4; ++i) {
                const int j = lane + 64 * i, pos = blk[s] * 256 + j;
                const bool ok = (blk[s] != 255) && (s > 0 || pos <= tt);
                float a = -3e38f;
                if (ok) { const bf16* kp = qkv + (size_t)(b * SEQ + pos) * AB_LD + CKA + h * 64; a = 0.f;
#pragma unroll
                    for (int d = 0; d < 64; ++d) a += q[d] * bf2f(kp[d]); }
                sc[s * 4 + i] = a; mx = fmaxf(mx, a);
            }
        }
        mx = wave_max(mx); float l = 0.f;
#pragma unroll
        for (int e = 0; e < 16; ++e) { const float p = (sc[e] > -1e38f) ? exp2f(sc[e] - mx) : 0.f; l += p; pl[(e >> 2) * 256 + lane + 64 * (e & 3)] = p; }
        l = wave_sum(l);
        __builtin_amdgcn_s_waitcnt(0);
        float o = 0.f;
#pragma unroll
        for (int s = 0; s < 4; ++s) {
            if (blk[s] == 255) continue;
            const int nk = (s == 0) ? (tt - qblk * 256 + 1) : 256;
            const bf16* vp = qkv + (size_t)(b * SEQ + blk[s] * 256) * AB_LD + CVA + h * 64 + lane;
            for (int j = 0; j < nk; ++j) o += pl[s * 256 + j] * bf2f(vp[(size_t)j * AB_LD]);
        }
        O[(size_t)t * DM + h * 64 + lane] = (bf16)f2bf(o / l);
    }
}
__device__ void ph_dsa_select(const bf16* qkv, unsigned long long* mask, unsigned char* smem) {
    unsigned* keys = (unsigned*)smem;
    unsigned* cnt = keys + 8192;
    const int tid = threadIdx.x, lane = tid & 63;
    for (int t = blockIdx.x; t < T; t += gridDim.x) {
        const int b = t / SEQ, tt = t % SEQ, n = tt + 1;
        __syncthreads();
        const bf16* row = qkv + (size_t)t * AB_LD;
        float* qf = (float*)(cnt + 4);
        if (tid < 256) qf[tid] = bf2f(row[CQI + tid]);
        if (tid < 4) qf[256 + tid] = bf2f(row[CWI + tid]);
        __syncthreads();
        for (int kv = tid; kv < 8192; kv += NT) {
            unsigned key = 0u;
            if (kv < n) {
                const bf16* kp = qkv + (size_t)(b * SEQ + kv) * AB_LD + CKI;
                float a0 = 0.f, a1 = 0.f, a2 = 0.f, a3 = 0.f;
                for (int d = 0; d < 64; ++d) { const float kd = bf2f(kp[d]); a0 += qf[d] * kd; a1 += qf[64 + d] * kd; a2 += qf[128 + d] * kd; a3 += qf[192 + d] * kd; }
                const float s = ((qf[256] * fmaxf(a0, 0.f) + qf[257] * fmaxf(a1, 0.f)) + qf[258] * fmaxf(a2, 0.f)) + qf[259] * fmaxf(a3, 0.f);
                key = okey(s);
            }
            keys[kv] = key;
        }
        __syncthreads();
        unsigned thr = 0u, need = 0u;
        if (n > 256) {
            unsigned lo = 0u, hi = 0xFFFFFFFFu;
            while (lo < hi) {
                const unsigned mid = lo + ((hi - lo) >> 1) + ((hi - lo) & 1u);
                if (tid == 0) cnt[0] = 0u;
                __syncthreads();
                unsigned c = 0;
                for (int kv = tid; kv < 8192; kv += NT) c += (keys[kv] >= mid) ? 1u : 0u;
                c = (unsigned)wave_sum((float)c);
                if (lane == 0) atomicAdd(&cnt[0], c);
                __syncthreads();
                const unsigned tot = cnt[0];
                __syncthreads();
                if (tot >= 256u) lo = mid; else hi = mid - 1u;
            }
            thr = lo;
            if (tid == 0) cnt[1] = 0u;
            __syncthreads();
            unsigned c = 0;
            for (int kv = tid; kv < 8192; kv += NT) c += (keys[kv] > thr) ? 1u : 0u;
            c = (unsigned)wave_sum((float)c);
            if (lane == 0) atomicAdd(&cnt[1], c);
            __syncthreads();
            need = 256u - cnt[1];
        }
        if (tid < 64) {
            const int ntile = 4 * (tt / 256 + 1);
            unsigned taken = 0u;
            for (int j = 0; j < ntile; ++j) {
                const int kv = j * 64 + lane; const unsigned key = keys[kv];
                bool s;
                if (n <= 256) s = kv < n;
                else {
                    const bool gt = key > thr, eq = (key == thr) && (kv < n);
                    const unsigned long long em = __ballot(eq);
                    const unsigned rank = taken + (unsigned)__popcll(em & ((1ull << lane) - 1ull));
                    s = gt || (eq && rank < need);
                    taken += (unsigned)__popcll(em);
                }
                const unsigned long long m = __ballot(s);
                if (lane == 0) mask[((size_t)(b * 128 + j)) * SEQ + tt] = m;
            }
        }
    }
}
__device__ void ph_dsa_attend(const bf16* qkv, const unsigned long long* mask, bf16* O, unsigned char* smem) {
    int* list = (int*)smem;
    int* cnt = list + 256;
    float* pr = (float*)(cnt + 4);
    float* linv = pr + 8 * 256;
    const int tid = threadIdx.x, lane = tid & 63, wave = tid >> 6;
    for (int t = blockIdx.x; t < T; t += gridDim.x) {
        const int b = t / SEQ, tt = t % SEQ;
        __syncthreads();
        const int ntile = 4 * (tt / 256 + 1);
        if (wave == 0) {
            int base = 0;
            for (int j = 0; j < ntile; ++j) {
                const unsigned long long m = mask[((size_t)(b * 128 + j)) * SEQ + tt];
                const int p = base + (int)__popcll(m & ((1ull << lane) - 1ull));
                if (((m >> lane) & 1ull) && p < 256) list[p] = j * 64 + lane;
                base += (int)__popcll(m);
            }
            if (lane == 0) cnt[0] = base;
        }
        __syncthreads();
        const int ns = min(cnt[0], 256);
        const bf16* row = qkv + (size_t)t * AB_LD;
        for (int e = tid; e < 8 * 256; e += NT) {
            const int h = e >> 8, j = e & 255; float a = -3e38f;
            if (j < ns) { const bf16* kp = qkv + (size_t)(b * SEQ + list[j]) * AB_LD + CKB + h * 64; a = 0.f;
                for (int d = 0; d < 64; ++d) a += bf2f(row[CQB + h * 64 + d]) * bf2f(kp[d]); }
            pr[e] = a;
        }
        __syncthreads();
        {
            const int h = wave; float v[4]; float mx = -3e38f;
#pragma unroll
            for (int i = 0; i < 4; ++i) { v[i] = pr[h * 256 + lane + 64 * i]; mx = fmaxf(mx, v[i]); }
            mx = wave_max(mx); float l = 0.f;
#pragma unroll
            for (int i = 0; i < 4; ++i) { const float p = (v[i] > -1e38f) ? exp2f(v[i] - mx) : 0.f; l += p; pr[h * 256 + lane + 64 * i] = p; }
            l = wave_sum(l); if (lane == 0) linv[h] = 1.0f / l;
        }
        __syncthreads();
        {   const int h = tid >> 6, d = tid & 63; float o = 0.f;
            for (int j = 0; j < ns; ++j) o += pr[h * 256 + j] * bf2f(qkv[(size_t)(b * SEQ + list[j]) * AB_LD + CVB + h * 64 + d]);
            O[(size_t)t * DM + 512 + h * 64 + d] = (bf16)f2bf(o * linv[h]); }
    }
}
__device__ void ph_dilated(const bf16* qkv, bf16* OG, float* LSE) {
    const int lane = threadIdx.x & 63, wave = threadIdx.x >> 6;
    const int gw = blockIdx.x * (NT / 64) + wave, ngw = gridDim.x * (NT / 64);
    for (int it = gw; it < T * 16; it += ngw) {
        const int t = it >> 4, h = it & 15, b = t / SEQ, tt = t % SEQ;
        const bf16* qp = qkv + (size_t)t * C_LD + h * 64;
        float q[64];
#pragma unroll
        for (int d = 0; d < 64; ++d) q[d] = bf2f(qp[d]);
        for (int g = 0; g < 3; ++g) {
            const int dil = (g == 0) ? 1 : (g == 1 ? 4 : 16);
            float sc[3]; float mx = -3e38f;
#pragma unroll
            for (int i = 0; i < 3; ++i) {
                const int j = lane + 64 * i, pos = tt - j * dil; float a = -3e38f;
                if (j <= 128 && pos >= 0) { const bf16* kp = qkv + (size_t)(b * SEQ + pos) * C_LD + 1024 + h * 64; a = 0.f;
#pragma unroll
                    for (int d = 0; d < 64; ++d) a += q[d] * bf2f(kp[d]); }
                sc[i] = a; mx = fmaxf(mx, a);
            }
            mx = wave_max(mx); float l = 0.f; float p[3];
#pragma unroll
            for (int i = 0; i < 3; ++i) { p[i] = (sc[i] > -1e38f) ? exp2f(sc[i] - mx) : 0.f; l += p[i]; }
            l = wave_sum(l);
            float o = 0.f;
            for (int j = 0; j <= 128; ++j) {
                const int pos = tt - j * dil; if (pos < 0) break;
                const float pj = (j < 64) ? __shfl(p[0], j) : ((j < 128) ? __shfl(p[1], j - 64) : __shfl(p[2], 0));
                o += pj * bf2f(qkv[(size_t)(b * SEQ + pos) * C_LD + 2048 + h * 64 + lane]);
            }
            OG[((size_t)g * T + t) * DM + h * 64 + lane] = (bf16)f2bf(o / l);
            if (lane == 0) LSE[((size_t)g * T + t) * 16 + h] = mx + log2f(l);
        }
    }
}
__device__ void ph_dil_merge(const bf16* OG, const float* LSE, bf16* O) {
    for (size_t e = (size_t)blockIdx.x * NT + threadIdx.x; e < (size_t)T * DM; e += (size_t)gridDim.x * NT) {
        const int t = (int)(e >> 10), c = (int)(e & 1023), h = c >> 6;
        const float l0 = LSE[((size_t)0 * T + t) * 16 + h], l1 = LSE[((size_t)1 * T + t) * 16 + h], l2 = LSE[((size_t)2 * T + t) * 16 + h];
        const float m = fmaxf(l0, fmaxf(l1, l2)); const float w0 = exp2f(l0 - m), w1 = exp2f(l1 - m), w2 = exp2f(l2 - m);
        const float o = (w0 * bf2f(OG[e]) + w1 * bf2f(OG[(size_t)T * DM + e]) + w2 * bf2f(OG[(size_t)2 * T * DM + e])) / (w0 + w1 + w2);
        O[e] = (bf16)f2bf(o);
    }
}
__device__ void ph_peer_route(const bf16* qry, const float* subk, int* eidx, float* gw, unsigned char* smem) {
    float* s = (float*)smem;
    float* sv = s + 2048;
    int* si = (int*)(sv + 256);
    float* qf = (float*)(si + 256);
    const int tid = threadIdx.x, lane = tid & 63, wave = tid >> 6;
    for (int t = blockIdx.x; t < T; t += gridDim.x) {
        __syncthreads();
        for (int e = tid; e < 2048; e += NT) qf[e] = bf2f(qry[(size_t)t * 2048 + e]);
        __syncthreads();
        for (int e = tid; e < 2048; e += NT) {
            const int hc = e >> 7, k = e & 127; const float* kp = subk + ((size_t)hc * 128 + k) * 128; float a = 0.f;
            for (int d = 0; d < 128; ++d) a += qf[hc * 128 + d] * kp[d];
            s[e] = a;
        }
        __syncthreads();
        for (int hc = wave; hc < 16; hc += NT / 64) {
            float v0 = s[hc * 128 + lane], v1 = s[hc * 128 + 64 + lane];
            for (int r = 0; r < 16; ++r) {
                float bv = v0; int bi = lane;
                if (v1 > bv) { bv = v1; bi = lane + 64; }
#pragma unroll
                for (int o = 1; o < 64; o <<= 1) { const float ov = __shfl_xor(bv, o); const int oi = __shfl_xor(bi, o); if (ov > bv || (ov == bv && oi < bi)) { bv = ov; bi = oi; } }
                if (lane == 0) { sv[hc * 16 + r] = bv; si[hc * 16 + r] = bi; }
                if (bi == lane) v0 = -3e38f; if (bi == lane + 64) v1 = -3e38f;
            }
        }
        __syncthreads();
        {   const int h = wave;
            float c[4]; int ci[4];
#pragma unroll
            for (int i = 0; i < 4; ++i) { const int f = lane + 64 * i; c[i] = sv[(h * 2) * 16 + (f >> 4)] + sv[(h * 2 + 1) * 16 + (f & 15)]; ci[i] = f; }
            float cv[16]; int cf[16];
#pragma unroll
            for (int r = 0; r < 16; ++r) {
                float bv = c[0]; int bi = ci[0];
#pragma unroll
                for (int i = 1; i < 4; ++i) if (c[i] > bv) { bv = c[i]; bi = ci[i]; }
#pragma unroll
                for (int o = 1; o < 64; o <<= 1) { const float ov = __shfl_xor(bv, o); const int oi = __shfl_xor(bi, o); if (ov > bv || (ov == bv && oi < bi)) { bv = ov; bi = oi; } }
                cv[r] = bv; cf[r] = bi;
#pragma unroll
                for (int i = 0; i < 4; ++i) if (ci[i] == bi) c[i] = -3e38f;
            }
            float l = 0.f;
#pragma unroll
            for (int r = 0; r < 16; ++r) l += __expf(cv[r] - cv[0]);
            if (lane < 16) {
                float myv = 0.f; int myf = 0;
#pragma unroll
                for (int r = 0; r < 16; ++r) if (r == lane) { myv = cv[r]; myf = cf[r]; }
                eidx[(size_t)t * 128 + h * 16 + lane] = si[(h * 2) * 16 + (myf >> 4)] * 128 + si[(h * 2 + 1) * 16 + (myf & 15)];
                gw[(size_t)t * 128 + h * 16 + lane] = __expf(myv - cv[0]) / l;
            }
        }
    }
}
__device__ __forceinline__ float gelu_tanh(float x) { const float u = 0.7978845608028654f * (x + 0.044715f * x * x * x); return 0.5f * x * (1.f + tanhf(u)); }
__device__ void ph_peer_gather(const bf16* xn, const int* eidx, const float* gw, const float* U, const float* V, float* h, unsigned char* smem) {
    float* xf = (float*)smem;
    float* w = xf + 1024;
    int* ei = (int*)(w + 128);
    const int tid = threadIdx.x, lane = tid & 63, wave = tid >> 6;
    for (int t = blockIdx.x; t < T; t += gridDim.x) {
        __syncthreads();
        for (int e = tid; e < 1024; e += NT) xf[e] = bf2f(xn[(size_t)t * DM + e]);
        if (tid < 128) ei[tid] = eidx[(size_t)t * 128 + tid];
        __syncthreads();
        for (int e = wave; e < 128; e += NT / 64) {
            const float* up = U + (size_t)ei[e] * DM; float a = 0.f;
            for (int d = lane; d < 1024; d += 64) a += xf[d] * up[d];
            a = wave_sum(a);
            if (lane == 0) w[e] = gw[(size_t)t * 128 + e] * gelu_tanh(a);
        }
        __syncthreads();
        for (int d = tid; d < 1024; d += NT) {
            float o = 0.f;
            for (int e = 0; e < 128; ++e) o += w[e] * V[(size_t)ei[e] * DM + d];
            h[(size_t)t * DM + d] += o;
        }
    }
}

constexpr int N_PHASES = 32;
__device__ __forceinline__ void run_phase(const Params& P, int ph, unsigned char* smem) {
    unsigned char* ws = P.ws;
    const float* x = P.in[0]; const float* p_in = P.in[1]; const int* positions = (const int*)P.in[2];
    float* hbuf = P.out;
    bf16* XN = (bf16*)(ws + WS_XN); bf16* QKV = (bf16*)(ws + WS_QKV); bf16* QKV1 = (bf16*)(ws + WS_QKV1);
    float* KMEAN = (float*)(ws + WS_KMEAN); unsigned* SEL = (unsigned*)(ws + WS_SEL); float* LSE = (float*)(ws + WS_LSE);
    int* EIDX = (int*)(ws + WS_EIDX); float* GW = (float*)(ws + WS_GW);
    unsigned long long* MASK = (unsigned long long*)(ws + WS_MASK);
    bf16* QRY = (bf16*)(ws + WS_QRY); bf16* UP = (bf16*)(ws + WS_UP); bf16* OG = (bf16*)(ws + WS_OG);
    switch (ph) {
    case 0: ph_rmsnorm(x, P.in[3], XN); break;
    case 1: ph_gemm_naive<bf16, EpBf16>(XN, DM, P.in[6], AB_N, DM, EpBf16{QKV, AB_LD}, smem); break;
    case 2: ph_prep0(QKV, positions, P.in[8], P.in[9], P.in[10], P.in[11]); break;
    case 3: ph_kmean(QKV, KMEAN); break;
    case 4: ph_moba_select(QKV, KMEAN, SEL); break;
    case 5: ph_moba_attend(QKV, SEL, XN, smem); break;
    case 6: ph_dsa_select(QKV, MASK, smem); break;
    case 7: ph_dsa_attend(QKV, MASK, XN, smem); break;
    case 8: ph_gemm_naive<bf16, EpResAdd>(XN, DM, P.in[7], DM, DM, EpResAdd{x, hbuf}, smem); break;
    case 9: ph_rmsnorm(hbuf, P.in[4], XN); break;
    case 10: ph_gemm_naive<bf16, EpBf16>(XN, DM, P.in[16], 2048, DM, EpBf16{QRY, 2048}, smem); break;
    case 11: ph_peer_route(QRY, P.in[17], EIDX, GW, smem); break;
    case 12: ph_peer_gather(XN, EIDX, GW, P.in[18], P.in[19], hbuf, smem); break;
    case 13: ph_rmsnorm(hbuf, P.in[5], XN); break;
    case 14: ph_gemm_naive<float, EpBf16>(p_in, 256, P.in[21], DM, 256, EpBf16{UP, DM}, smem); break;
    case 15: ph_gemm_naive<bf16, EpGate>(XN, DM, P.in[20], DM, DM, EpGate{hbuf, UP}, smem); break;
    case 16: ph_rmsnorm(hbuf, P.in[3] + DM, XN); break;
    case 17: ph_gemm_naive<bf16, EpBf16>(XN, DM, P.in[12], C_LD, DM, EpBf16{QKV1, C_LD}, smem); break;
    case 18: ph_prep1(QKV1, positions, P.in[14], P.in[15]); break;
    case 19: ph_dilated(QKV1, OG, LSE); break;
    case 20: ph_dil_merge(OG, LSE, XN); break;
    case 21: ph_gemm_naive<bf16, EpResAdd>(XN, DM, P.in[13], DM, DM, EpResAdd{hbuf, hbuf}, smem); break;
    case 22: ph_rmsnorm(hbuf, P.in[4] + DM, XN); break;
    case 23: ph_gemm_naive<bf16, EpBf16>(XN, DM, P.in[16] + (size_t)DM * 2048, 2048, DM, EpBf16{QRY, 2048}, smem); break;
    case 24: ph_peer_route(QRY, P.in[17] + (size_t)16 * 128 * 128, EIDX, GW, smem); break;
    case 25: ph_peer_gather(XN, EIDX, GW, P.in[18] + (size_t)NEXP * DM, P.in[19] + (size_t)NEXP * DM, hbuf, smem); break;
    case 26: ph_rmsnorm(hbuf, P.in[5] + DM, XN); break;
    case 27: ph_gemm_naive<float, EpBf16>(p_in + (size_t)T * 256, 256, P.in[21] + (size_t)256 * DM, DM, 256, EpBf16{UP, DM}, smem); break;
    case 28: ph_gemm_naive<bf16, EpGate>(XN, DM, P.in[20] + (size_t)DM * DM, DM, DM, EpGate{hbuf, UP}, smem); break;
    default: break;
    }
}

__global__ void __launch_bounds__(NT) k_phase(Params P, int ph) {
    extern __shared__ __attribute__((aligned(16))) unsigned char smem[];
    run_phase(P, ph, smem);
}

extern "C" void kernel_launch(void* const* d_in, const int* in_sizes, int n_in, void* d_out, int out_size, void* d_ws, size_t ws_size, hipStream_t stream) {
    static int ok = 0;
    if (ok == 0) {
        if (n_in != 22 || out_size != T * DM || ws_size < WS_END) { fprintf(stderr, "kernel_launch: unexpected shapes: n_in %d out %d ws %zu\n", n_in, out_size, ws_size); ok = -1; return; }
        if (hipFuncSetAttribute((const void*)k_phase, hipFuncAttributeMaxDynamicSharedMemorySize, 65536) != hipSuccess) { fprintf(stderr, "hipFuncSetAttribute failed\n"); ok = -1; return; }
        ok = 1;
    }
    if (ok < 0) return;
    Params P{};
    for (int i = 0; i < 22; ++i) P.in[i] = (const float*)d_in[i];
    P.out = (float*)d_out; P.ws = (unsigned char*)d_ws;
    for (int ph = 0; ph < 29; ++ph) hipLaunchKernelGGL(k_phase, dim3(2048), dim3(NT), 65536, stream, P, ph);
}
```

```cpp
#include <hip/hip_runtime.h>
#include <hip/hip_cooperative_groups.h>
#include <cstdio>
#include <cstdint>

constexpr int BATCH = 2, SEQ = 8192, T = BATCH * SEQ, DM = 1024;
constexpr int AB_N = 3396, AB_LD = 3584;
constexpr int CQA = 0, CKA = 512, CVA = 1024, CQB = 1536, CKB = 2048, CVB = 2560, CQI = 3072, CKI = 3328, CWI = 3392;
constexpr int C_LD = 3072;
constexpr int NEXP = 16384;
constexpr float NORM_EPS = 1e-6f;
constexpr float C2 = 0.125f * 1.4426950408889634f;
constexpr int NT = 512;

constexpr size_t MiB = 1u << 20;
constexpr size_t WS_CTL = 0;
constexpr size_t WS_KMEAN = 32 * MiB;
constexpr size_t WS_SEL = 33 * MiB;
constexpr size_t WS_LSE = 34 * MiB;
constexpr size_t WS_EIDX = 37 * MiB;
constexpr size_t WS_GW = 45 * MiB;
constexpr size_t WS_P = 53 * MiB;
constexpr size_t WS_XN = 69 * MiB;
constexpr size_t WS_QKV = 101 * MiB;
constexpr size_t WS_MASK = 213 * MiB;
constexpr size_t WS_SCORES = 229 * MiB;
constexpr size_t WS_QRY = 101 * MiB;
constexpr size_t WS_UP = 165 * MiB;
constexpr size_t WS_QKV1 = 357 * MiB;
constexpr size_t WS_OG = 101 * MiB;
constexpr size_t WS_END = 512 * MiB;

typedef unsigned short bf16;
typedef float f32x4 __attribute__((ext_vector_type(4)));

__device__ __forceinline__ unsigned f2bf(float f) { unsigned u = __builtin_bit_cast(unsigned, f); return (u + 0x7fffu + ((u >> 16) & 1u)) >> 16; }
__device__ __forceinline__ float bf2f(bf16 h) { return __builtin_bit_cast(float, (unsigned)h << 16); }
__device__ __forceinline__ float wave_sum(float v) {
#pragma unroll
    for (int o = 1; o < 64; o <<= 1) v += __shfl_xor(v, o);
    return v;
}
__device__ __forceinline__ float wave_max(float v) {
#pragma unroll
    for (int o = 1; o < 64; o <<= 1) v = fmaxf(v, __shfl_xor(v, o));
    return v;
}
__device__ __forceinline__ unsigned okey(float f) { unsigned u = __builtin_bit_cast(unsigned, f); return (u & 0x80000000u) ? ~u : (u | 0x80000000u); }

struct Params {
    const float* in[22];
    float* out;
    unsigned char* ws;
    int layer;
    int pad;
};

__device__ void ph_rmsnorm(const float* src, const float* gain, bf16* dst) {
    const int lane = threadIdx.x & 63, wave = threadIdx.x >> 6;
    const int gw = blockIdx.x * (NT / 64) + wave, ngw = gridDim.x * (NT / 64);
    for (int r = gw; r < T; r += ngw) {
        const f32x4* xr = (const f32x4*)(src + (size_t)r * DM) + lane;
        f32x4 v[4]; float s = 0.f;
#pragma unroll
        for (int j = 0; j < 4; ++j) { v[j] = xr[64 * j]; s += v[j].x * v[j].x + v[j].y * v[j].y + v[j].z * v[j].z + v[j].w * v[j].w; }
        const float rstd = 1.0f / sqrtf(wave_sum(s) * (1.0f / DM) + NORM_EPS);
#pragma unroll
        for (int j = 0; j < 4; ++j) {
            const f32x4 g = ((const f32x4*)gain)[lane + 64 * j];
            unsigned long long o = (unsigned long long)(f2bf(v[j].x * rstd * g.x) | (f2bf(v[j].y * rstd * g.y) << 16)) |
                                   ((unsigned long long)(f2bf(v[j].z * rstd * g.z) | (f2bf(v[j].w * rstd * g.w) << 16)) << 32);
            ((unsigned long long*)(dst + (size_t)r * DM))[lane + 64 * j] = o;
        }
    }
}

template <class AT> __device__ __forceinline__ float ldA(const AT* p);
template <> __device__ __forceinline__ float ldA<bf16>(const bf16* p) { return bf2f(*p); }
template <> __device__ __forceinline__ float ldA<float>(const float* p) { return *p; }

template <class AT, class Epi>
__device__ void ph_gemm_naive(const AT* A, int lda, const float* B, int N, int K, const Epi& E, unsigned char* smem) {
    float* As = (float*)smem;
    float* Bs = As + 16 * 132;
    const int tid = threadIdx.x, ty = tid >> 5, tx = tid & 31;
    const int ntn = (N + 127) / 128, ntm = T / 128, ntile = ntn * ntm;
    for (int tile = blockIdx.x; tile < ntile; tile += gridDim.x) {
        const int tm = tile / ntn, tn = tile % ntn, m0 = tm * 128, n0 = tn * 128;
        float acc[8][4];
#pragma unroll
        for (int i = 0; i < 8; ++i)
#pragma unroll
            for (int j = 0; j < 4; ++j) acc[i][j] = 0.f;
        for (int k0 = 0; k0 < K; k0 += 16) {
            __syncthreads();
#pragma unroll
            for (int i = 0; i < 4; ++i) { const int e = tid + i * NT, r = e >> 4, kk = e & 15; As[kk * 132 + r] = ldA<AT>(A + (size_t)(m0 + r) * lda + k0 + kk); }
#pragma unroll
            for (int i = 0; i < 4; ++i) { const int e = tid + i * NT, kk = e >> 7, c = e & 127; Bs[kk * 128 + c] = (n0 + c < N) ? B[(size_t)(k0 + kk) * N + n0 + c] : 0.f; }
            __syncthreads();
#pragma unroll 2
            for (int kk = 0; kk < 16; ++kk) {
                float a[8], b[4];
#pragma unroll
                for (int i = 0; i < 8; ++i) a[i] = As[kk * 132 + ty * 8 + i];
#pragma unroll
                for (int j = 0; j < 4; ++j) b[j] = Bs[kk * 128 + tx * 4 + j];
#pragma unroll
                for (int i = 0; i < 8; ++i)
#pragma unroll
                    for (int j = 0; j < 4; ++j) acc[i][j] += a[i] * b[j];
            }
        }
#pragma unroll
        for (int i = 0; i < 8; ++i) {
            const int col = n0 + tx * 4;
            if (col < N) E.store4(m0 + ty * 8 + i, col, (f32x4){acc[i][0], acc[i][1], acc[i][2], acc[i][3]});
        }
    }
}
struct EpBf16 { bf16* O; int ldc;
    __device__ __forceinline__ void store4(int r, int c, f32x4 v) const {
        unsigned long long o = (unsigned long long)(f2bf(v.x) | (f2bf(v.y) << 16)) | ((unsigned long long)(f2bf(v.z) | (f2bf(v.w) << 16)) << 32);
        *(unsigned long long*)(O + (size_t)r * ldc + c) = o; } };
struct EpResAdd { const float* base; float* out;
    __device__ __forceinline__ void store4(int r, int c, f32x4 v) const {
        const f32x4 b = *(const f32x4*)(base + (size_t)r * DM + c); *(f32x4*)(out + (size_t)r * DM + c) = b + v; } };
struct EpGate { float* h; const bf16* up;
    __device__ __forceinline__ void store4(int r, int c, f32x4 v) const {
        f32x4 hv = *(const f32x4*)(h + (size_t)r * DM + c); const bf16* u = up + (size_t)r * DM + c;
        hv.x += bf2f(u[0]) / (1.f + __expf(-v.x)); hv.y += bf2f(u[1]) / (1.f + __expf(-v.y));
        hv.z += bf2f(u[2]) / (1.f + __expf(-v.z)); hv.w += bf2f(u[3]) / (1.f + __expf(-v.w));
        *(f32x4*)(h + (size_t)r * DM + c) = hv; } };

__device__ __forceinline__ void rope_cs(int pos, int i, float& c, float& s) {
    const float inv = exp2f(-(float)i * 0.125f * 18.931568569324174f);
    const float ang = (float)pos * inv;
    const float k = rintf(ang * 0.15915494309189535f);
    float r = fmaf(-k, 6.28125f, ang); r = fmaf(-k, 1.9353071795864769e-3f, r);
    c = cosf(r); s = sinf(r);
}
__device__ __forceinline__ void prep_head(bf16* p, const float* gain, int pos, float scale, bool donorm, int lane) {
    float v = bf2f(p[lane]);
    if (donorm) { const float ss = wave_sum(v * v); v = v * (1.0f / sqrtf(ss * (1.0f / 64.f) + NORM_EPS)) * gain[lane]; }
    const float partner = __shfl_xor(v, 8);
    float c = 1.f, s = 0.f;
    if (lane < 16) rope_cs(pos, lane & 7, c, s);
    float o = v;
    if (lane < 8) o = v * c - partner * s; else if (lane < 16) o = v * c + partner * s;
    p[lane] = (bf16)f2bf(o * scale);
}
__device__ void ph_prep0(bf16* qkv, const int* positions, const float* aq, const float* ak, const float* bq, const float* bk) {
    const int lane = threadIdx.x & 63, wave = threadIdx.x >> 6;
    const int gw = blockIdx.x * (NT / 64) + wave, ngw = gridDim.x * (NT / 64);
    for (int r = gw; r < T; r += ngw) {
        const int pos = positions[r]; bf16* row = qkv + (size_t)r * AB_LD;
        for (int h = 0; h < 8; ++h) {
            prep_head(row + CQA + h * 64, aq, pos, C2, true, lane);
            prep_head(row + CKA + h * 64, ak, pos, 1.f, true, lane);
            prep_head(row + CQB + h * 64, bq, pos, C2, true, lane);
            prep_head(row + CKB + h * 64, bk, pos, 1.f, true, lane);
        }
        for (int h = 0; h < 4; ++h) prep_head(row + CQI + h * 64, nullptr, pos, 1.f, false, lane);
        prep_head(row + CKI, nullptr, pos, 1.f, false, lane);
    }
}
__device__ void ph_prep1(bf16* qkv, const int* positions, const float* cq, const float* ck) {
    const int lane = threadIdx.x & 63, wave = threadIdx.x >> 6;
    const int gw = blockIdx.x * (NT / 64) + wave, ngw = gridDim.x * (NT / 64);
    for (int r = gw; r < T; r += ngw) {
        const int pos = positions[r]; bf16* row = qkv + (size_t)r * C_LD;
        for (int h = 0; h < 16; ++h) {
            prep_head(row + h * 64, cq, pos, C2, true, lane);
            prep_head(row + 1024 + h * 64, ck, pos, 1.f, true, lane);
        }
    }
}
__device__ void ph_kmean(const bf16* qkv, float* kmean) {
    const int lane = threadIdx.x & 63, wave = threadIdx.x >> 6;
    const int gw = blockIdx.x * (NT / 64) + wave, ngw = gridDim.x * (NT / 64);
    for (int it = gw; it < BATCH * 8 * 32; it += ngw) {
        const int b = it / 256, h = (it / 32) % 8, n = it % 32;
        float s = 0.f;
        for (int r = 0; r < 256; ++r) s += bf2f(qkv[(size_t)(b * SEQ + n * 256 + r) * AB_LD + CKA + h * 64 + lane]);
        kmean[(size_t)it * 64 + lane] = s * (1.0f / 256.f);
    }
}
__device__ void ph_moba_select(const bf16* qkv, const float* kmean, unsigned* sel) {
    for (int it = blockIdx.x * NT + threadIdx.x; it < T * 8; it += gridDim.x * NT) {
        const int t = it >> 3, h = it & 7, b = t / SEQ, qblk = (t % SEQ) / 256;
        float q[64];
#pragma unroll
        for (int d = 0; d < 64; ++d) q[d] = bf2f(qkv[(size_t)t * AB_LD + CQA + h * 64 + d]);
        float v0 = -3e38f, v1 = -3e38f, v2 = -3e38f; int i0 = 255, i1 = 255, i2 = 255;
        for (int n = 0; n < qblk; ++n) {
            const float* km = kmean + (size_t)((b * 8 + h) * 32 + n) * 64; float g = 0.f;
#pragma unroll
            for (int d = 0; d < 64; ++d) g += q[d] * km[d];
            if (g > v0) { v2 = v1; i2 = i1; v1 = v0; i1 = i0; v0 = g; i0 = n; }
            else if (g > v1) { v2 = v1; i2 = i1; v1 = g; i1 = n; }
            else if (g > v2) { v2 = g; i2 = n; }
        }
        sel[it] = (unsigned)i0 | ((unsigned)i1 << 8) | ((unsigned)i2 << 16) | (255u << 24);
    }
}
__device__ void ph_moba_attend(const bf16* qkv, const unsigned* sel, bf16* O, unsigned char* smem) {
    const int lane = threadIdx.x & 63, wave = threadIdx.x >> 6;
    float* pl = (float*)smem + wave * 1024;
    const int gw = blockIdx.x * (NT / 64) + wave, ngw = gridDim.x * (NT / 64);
    for (int it = gw; it < T * 8; it += ngw) {
        const int t = it >> 3, h = it & 7, b = t / SEQ, tt = t % SEQ, qblk = tt / 256;
        const unsigned sw = sel[it];
        int blk[4] = {qblk, (int)(sw & 255), (int)((sw >> 8) & 255), (int)((sw >> 16) & 255)};
        const bf16* qp = qkv + (size_t)t * AB_LD + CQA + h * 64;
        float q[64];
#pragma unroll
        for (int d = 0; d < 64; ++d) q[d] = bf2f(qp[d]);
        float sc[16]; float mx = -3e38f;
#pragma unroll
        for (int s = 0; s < 4; ++s) {
#pragma unroll
            for (int i = 0; i < 4; ++i) {
                const int j = lane + 64 * i, pos = blk[s] * 256 + j;
                const bool ok = (blk[s] != 255) && (s > 0 || pos <= tt);
                float a = -3e38f;
                if (ok) { const bf16* kp = qkv + (size_t)(b * SEQ + pos) * AB_LD + CKA + h * 64; a = 0.f;
#pragma unroll
                    for (int d = 0; d < 64; ++d) a += q[d] * bf2f(kp[d]); }
                sc[s * 4 + i] = a; mx = fmaxf(mx, a);
            }
        }
        mx = wave_max(mx); float l = 0.f;
#pragma unroll
        for (int e = 0; e < 16; ++e) { const float p = (sc[e] > -1e38f) ? exp2f(sc[e] - mx) : 0.f; l += p; pl[(e >> 2) * 256 + lane + 64 * (e & 3)] = p; }
        l = wave_sum(l);
        __builtin_amdgcn_s_waitcnt(0);
        float o = 0.f;
#pragma unroll
        for (int s = 0; s < 4; ++s) {
            if (blk[s] == 255) continue;
            const int nk = (s == 0) ? (tt - qblk * 256 + 1) : 256;
            const bf16* vp = qkv + (size_t)(b * SEQ + blk[s] * 256) * AB_LD + CVA + h * 64 + lane;
            for (int j = 0; j < nk; ++j) o += pl[s * 256 + j] * bf2f(vp[(size_t)j * AB_LD]);
        }
        O[(size_t)t * DM + h * 64 + lane] = (bf16)f2bf(o / l);
    }
}
__device__ void ph_dsa_select(const bf16* qkv, unsigned long long* mask, unsigned char* smem) {
    unsigned* keys = (unsigned*)smem;
    unsigned* cnt = keys + 8192;
    const int tid = threadIdx.x, lane = tid & 63;
    for (int t = blockIdx.x; t < T; t += gridDim.x) {
        const int b = t / SEQ, tt = t % SEQ, n = tt + 1;
        __syncthreads();
        const bf16* row = qkv + (size_t)t * AB_LD;
        float* qf = (float*)(cnt + 4);
        if (tid < 256) qf[tid] = bf2f(row[CQI + tid]);
        if (tid < 4) qf[256 + tid] = bf2f(row[CWI + tid]);
        __syncthreads();
        for (int kv = tid; kv < 8192; kv += NT) {
            unsigned key = 0u;
            if (kv < n) {
                const bf16* kp = qkv + (size_t)(b * SEQ + kv) * AB_LD + CKI;
                float a0 = 0.f, a1 = 0.f, a2 = 0.f, a3 = 0.f;
                for (int d = 0; d < 64; ++d) { const float kd = bf2f(kp[d]); a0 += qf[d] * kd; a1 += qf[64 + d] * kd; a2 += qf[128 + d] * kd; a3 += qf[192 + d] * kd; }
                const float s = ((qf[256] * fmaxf(a0, 0.f) + qf[257] * fmaxf(a1, 0.f)) + qf[258] * fmaxf(a2, 0.f)) + qf[259] * fmaxf(a3, 0.f);
                key = okey(s);
            }
            keys[kv] = key;
        }
        __syncthreads();
        unsigned thr = 0u, need = 0u;
        if (n > 256) {
            unsigned lo = 0u, hi = 0xFFFFFFFFu;
            while (lo < hi) {
                const unsigned mid = lo + ((hi - lo) >> 1) + ((hi - lo) & 1u);
                if (tid == 0) cnt[0] = 0u;
                __syncthreads();
                unsigned c = 0;
                for (int kv = tid; kv < 8192; kv += NT) c += (keys[kv] >= mid) ? 1u : 0u;
                c = (unsigned)wave_sum((float)c);
                if (lane == 0) atomicAdd(&cnt[0], c);
                __syncthreads();
                const unsigned tot = cnt[0];
                __syncthreads();
                if (tot >= 256u) lo = mid; else hi = mid - 1u;
            }
            thr = lo;
            if (tid == 0) cnt[1] = 0u;
            __syncthreads();
            unsigned c = 0;
            for (int kv = tid; kv < 8192; kv += NT) c += (keys[kv] > thr) ? 1u : 0u;
            c = (unsigned)wave_sum((float)c);
            if (lane == 0) atomicAdd(&cnt[1], c);
            __syncthreads();
            need = 256u - cnt[1];
        }
        if (tid < 64) {
            const int ntile = 4 * (tt / 256 + 1);
            unsigned taken = 0u;
            for (int j = 0; j < ntile; ++j) {
                const int kv = j * 64 + lane; const unsigned key = keys[kv];
                bool s;
                if (n <= 256) s = kv < n;
                else {
                    const bool gt = key > thr, eq = (key == thr) && (kv < n);
                    const unsigned long long em = __ballot(eq);
                    const unsigned rank = taken + (unsigned)__popcll(em & ((1ull << lane) - 1ull));
                    s = gt || (eq && rank < need);
                    taken += (unsigned)__popcll(em);
                }
                const unsigned long long m = __ballot(s);
                if (lane == 0) mask[((size_t)(b * 128 + j)) * SEQ + tt] = m;
            }
        }
    }
}
__device__ void ph_dsa_attend(const bf16* qkv, const unsigned long long* mask, bf16* O, unsigned char* smem) {
    int* list = (int*)smem;
    int* cnt = list + 256;
    float* pr = (float*)(cnt + 4);
    float* linv = pr + 8 * 256;
    const int tid = threadIdx.x, lane = tid & 63, wave = tid >> 6;
    for (int t = blockIdx.x; t < T; t += gridDim.x) {
        const int b = t / SEQ, tt = t % SEQ;
        __syncthreads();
        const int ntile = 4 * (tt / 256 + 1);
        if (wave == 0) {
            int base = 0;
            for (int j = 0; j < ntile; ++j) {
                const unsigned long long m = mask[((size_t)(b * 128 + j)) * SEQ + tt];
                const int p = base + (int)__popcll(m & ((1ull << lane) - 1ull));
                if (((m >> lane) & 1ull) && p < 256) list[p] = j * 64 + lane;
                base += (int)__popcll(m);
            }
            if (lane == 0) cnt[0] = base;
        }
        __syncthreads();
        const int ns = min(cnt[0], 256);
        const bf16* row = qkv + (size_t)t * AB_LD;
        for (int e = tid; e < 8 * 256; e += NT) {
            const int h = e >> 8, j = e & 255; float a = -3e38f;
            if (j < ns) { const bf16* kp = qkv + (size_t)(b * SEQ + list[j]) * AB_LD + CKB + h * 64; a = 0.f;
                for (int d = 0; d < 64; ++d) a += bf2f(row[CQB + h * 64 + d]) * bf2f(kp[d]); }
            pr[e] = a;
        }
        __syncthreads();
        {
            const int h = wave; float v[4]; float mx = -3e38f;
#pragma unroll
            for (int i = 0; i < 4; ++i) { v[i] = pr[h * 256 + lane + 64 * i]; mx = fmaxf(mx, v[i]); }
            mx = wave_max(mx); float l = 0.f;
#pragma unroll
            for (int i = 0; i < 4; ++i) { const float p = (v[i] > -1e38f) ? exp2f(v[i] - mx) : 0.f; l += p; pr[h * 256 + lane + 64 * i] = p; }
            l = wave_sum(l); if (lane == 0) linv[h] = 1.0f / l;
        }
        __syncthreads();
        {   const int h = tid >> 6, d = tid & 63; float o = 0.f;
            for (int j = 0; j < ns; ++j) o += pr[h * 256 + j] * bf2f(qkv[(size_t)(b * SEQ + list[j]) * AB_LD + CVB + h * 64 + d]);
            O[(size_t)t * DM + 512 + h * 64 + d] = (bf16)f2bf(o * linv[h]); }
    }
}
__device__ void ph_dilated(const bf16* qkv, bf16* OG, float* LSE) {
    const int lane = threadIdx.x & 63, wave = threadIdx.x >> 6;
    const int gw = blockIdx.x * (NT / 64) + wave, ngw = gridDim.x * (NT / 64);
    for (int it = gw; it < T * 16; it += ngw) {
        const int t = it >> 4, h = it & 15, b = t / SEQ, tt = t % SEQ;
        const bf16* qp = qkv + (size_t)t * C_LD + h * 64;
        float q[64];
#pragma unroll
        for (int d = 0; d < 64; ++d) q[d] = bf2f(qp[d]);
        for (int g = 0; g < 3; ++g) {
            const int dil = (g == 0) ? 1 : (g == 1 ? 4 : 16);
            float sc[3]; float mx = -3e38f;
#pragma unroll
            for (int i = 0; i < 3; ++i) {
                const int j = lane + 64 * i, pos = tt - j * dil; float a = -3e38f;
                if (j <= 128 && pos >= 0) { const bf16* kp = qkv + (size_t)(b * SEQ + pos) * C_LD + 1024 + h * 64; a = 0.f;
#pragma unroll
                    for (int d = 0; d < 64; ++d) a += q[d] * bf2f(kp[d]); }
                sc[i] = a; mx = fmaxf(mx, a);
            }
            mx = wave_max(mx); float l = 0.f; float p[3];
#pragma unroll
            for (int i = 0; i < 3; ++i) { p[i] = (sc[i] > -1e38f) ? exp2f(sc[i] - mx) : 0.f; l += p[i]; }
            l = wave_sum(l);
            float o = 0.f;
            for (int j = 0; j <= 128; ++j) {
                const int pos = tt - j * dil; if (pos < 0) break;
                const float pj = (j < 64) ? __shfl(p[0], j) : ((j < 128) ? __shfl(p[1], j - 64) : __shfl(p[2], 0));
                o += pj * bf2f(qkv[(size_t)(b * SEQ + pos) * C_LD + 2048 + h * 64 + lane]);
            }
            OG[((size_t)g * T + t) * DM + h * 64 + lane] = (bf16)f2bf(o / l);
            if (lane == 0) LSE[((size_t)g * T + t) * 16 + h] = mx + log2f(l);
        }
    }
}
__device__ void ph_dil_merge(const bf16* OG, const float* LSE, bf16* O) {
    for (size_t e = (size_t)blockIdx.x * NT + threadIdx.x; e < (size_t)T * DM; e += (size_t)gridDim.x * NT) {
        const int t = (int)(e >> 10), c = (int)(e & 1023), h = c >> 6;
        const float l0 = LSE[((size_t)0 * T + t) * 16 + h], l1 = LSE[((size_t)1 * T + t) * 16 + h], l2 = LSE[((size_t)2 * T + t) * 16 + h];
        const float m = fmaxf(l0, fmaxf(l1, l2)); const float w0 = exp2f(l0 - m), w1 = exp2f(l1 - m), w2 = exp2f(l2 - m);
        const float o = (w0 * bf2f(OG[e]) + w1 * bf2f(OG[(size_t)T * DM + e]) + w2 * bf2f(OG[(size_t)2 * T * DM + e])) / (w0 + w1 + w2);
        O[e] = (bf16)f2bf(o);
    }
}
__device__ void ph_peer_route(const bf16* qry, const float* subk, int* eidx, float* gw, unsigned char* smem) {
    float* s = (float*)smem;
    float* sv = s + 2048;
    int* si = (int*)(sv + 256);
    float* qf = (float*)(si + 256);
    const int tid = threadIdx.x, lane = tid & 63, wave = tid >> 6;
    for (int t = blockIdx.x; t < T; t += gridDim.x) {
        __syncthreads();
        for (int e = tid; e < 2048; e += NT) qf[e] = bf2f(qry[(size_t)t * 2048 + e]);
        __syncthreads();
        for (int e = tid; e < 2048; e += NT) {
            const int hc = e >> 7, k = e & 127; const float* kp = subk + ((size_t)hc * 128 + k) * 128; float a = 0.f;
            for (int d = 0; d < 128; ++d) a += qf[hc * 128 + d] * kp[d];
            s[e] = a;
        }
        __syncthreads();
        for (int hc = wave; hc < 16; hc += NT / 64) {
            float v0 = s[hc * 128 + lane], v1 = s[hc * 128 + 64 + lane];
            for (int r = 0; r < 16; ++r) {
                float bv = v0; int bi = lane;
                if (v1 > bv) { bv = v1; bi = lane + 64; }
#pragma unroll
                for (int o = 1; o < 64; o <<= 1) { const float ov = __shfl_xor(bv, o); const int oi = __shfl_xor(bi, o); if (ov > bv || (ov == bv && oi < bi)) { bv = ov; bi = oi; } }
                if (lane == 0) { sv[hc * 16 + r] = bv; si[hc * 16 + r] = bi; }
                if (bi == lane) v0 = -3e38f; if (bi == lane + 64) v1 = -3e38f;
            }
        }
        __syncthreads();
        {   const int h = wave;
            float c[4]; int ci[4];
#pragma unroll
            for (int i = 0; i < 4; ++i) { const int f = lane + 64 * i; c[i] = sv[(h * 2) * 16 + (f >> 4)] + sv[(h * 2 + 1) * 16 + (f & 15)]; ci[i] = f; }
            float cv[16]; int cf[16];
#pragma unroll
            for (int r = 0; r < 16; ++r) {
                float bv = c[0]; int bi = ci[0];
#pragma unroll
                for (int i = 1; i < 4; ++i) if (c[i] > bv) { bv = c[i]; bi = ci[i]; }
#pragma unroll
                for (int o = 1; o < 64; o <<= 1) { const float ov = __shfl_xor(bv, o); const int oi = __shfl_xor(bi, o); if (ov > bv || (ov == bv && oi < bi)) { bv = ov; bi = oi; } }
                cv[r] = bv; cf[r] = bi;
#pragma unroll
                for (int i = 0; i < 4; ++i) if (ci[i] == bi) c[i] = -3e38f;
            }
            float l = 0.f;
#pragma unroll
            for (int r = 0; r < 16; ++r) l += __expf(cv[r] - cv[0]);
            if (lane < 16) {
                float myv = 0.f; int myf = 0;
#pragma unroll
                for (int r = 0; r < 16; ++r) if (r == lane) { myv = cv[r]; myf = cf[r]; }
                eidx[(size_t)t * 128 + h * 16 + lane] = si[(h * 2) * 16 + (myf >> 4)] * 128 + si[(h * 2 + 1) * 16 + (myf & 15)];
                gw[(size_t)t * 128 + h * 16 + lane] = __expf(myv - cv[0]) / l;
            }
        }
    }
}
__device__ __forceinline__ float gelu_tanh(float x) { const float u = 0.7978845608028654f * (x + 0.044715f * x * x * x); return 0.5f * x * (1.f + tanhf(u)); }
__device__ void ph_peer_gather(const bf16* xn, const int* eidx, const float* gw, const float* U, const float* V, float* h, unsigned char* smem) {
    float* xf = (float*)smem;
    float* w = xf + 1024;
    int* ei = (int*)(w + 128);
    const int tid = threadIdx.x, lane = tid & 63, wave = tid >> 6;
    for (int t = blockIdx.x; t < T; t += gridDim.x) {
        __syncthreads();
        for (int e = tid; e < 1024; e += NT) xf[e] = bf2f(xn[(size_t)t * DM + e]);
        if (tid < 128) ei[tid] = eidx[(size_t)t * 128 + tid];
        __syncthreads();
        for (int e = wave; e < 128; e += NT / 64) {
            const float* up = U + (size_t)ei[e] * DM; float a = 0.f;
            for (int d = lane; d < 1024; d += 64) a += xf[d] * up[d];
            a = wave_sum(a);
            if (lane == 0) w[e] = gw[(size_t)t * 128 + e] * gelu_tanh(a);
        }
        __syncthreads();
        for (int d = tid; d < 1024; d += NT) {
            float o = 0.f;
            for (int e = 0; e < 128; ++e) o += w[e] * V[(size_t)ei[e] * DM + d];
            h[(size_t)t * DM + d] += o;
        }
    }
}

constexpr int N_PHASES = 32;
__device__ __forceinline__ void run_phase(const Params& P, int ph, unsigned char* smem) {
    unsigned char* ws = P.ws;
    const float* x = P.in[0]; const float* p_in = P.in[1]; const int* positions = (const int*)P.in[2];
    float* hbuf = P.out;
    bf16* XN = (bf16*)(ws + WS_XN); bf16* QKV = (bf16*)(ws + WS_QKV); bf16* QKV1 = (bf16*)(ws + WS_QKV1);
    float* KMEAN = (float*)(ws + WS_KMEAN); unsigned* SEL = (unsigned*)(ws + WS_SEL); float* LSE = (float*)(ws + WS_LSE);
    int* EIDX = (int*)(ws + WS_EIDX); float* GW = (float*)(ws + WS_GW);
    unsigned long long* MASK = (unsigned long long*)(ws + WS_MASK);
    bf16* QRY = (bf16*)(ws + WS_QRY); bf16* UP = (bf16*)(ws + WS_UP); bf16* OG = (bf16*)(ws + WS_OG);
    switch (ph) {
    case 0: ph_rmsnorm(x, P.in[3], XN); break;
    case 1: ph_gemm_naive<bf16, EpBf16>(XN, DM, P.in[6], AB_N, DM, EpBf16{QKV, AB_LD}, smem); break;
    case 2: ph_prep0(QKV, positions, P.in[8], P.in[9], P.in[10], P.in[11]); break;
    case 3: ph_kmean(QKV, KMEAN); break;
    case 4: ph_moba_select(QKV, KMEAN, SEL); break;
    case 5: ph_moba_attend(QKV, SEL, XN, smem); break;
    case 6: ph_dsa_select(QKV, MASK, smem); break;
    case 7: ph_dsa_attend(QKV, MASK, XN, smem); break;
    case 8: ph_gemm_naive<bf16, EpResAdd>(XN, DM, P.in[7], DM, DM, EpResAdd{x, hbuf}, smem); break;
    case 9: ph_rmsnorm(hbuf, P.in[4], XN); break;
    case 10: ph_gemm_naive<bf16, EpBf16>(XN, DM, P.in[16], 2048, DM, EpBf16{QRY, 2048}, smem); break;
    case 11: ph_peer_route(QRY, P.in[17], EIDX, GW, smem); break;
    case 12: ph_peer_gather(XN, EIDX, GW, P.in[18], P.in[19], hbuf, smem); break;
    case 13: ph_rmsnorm(hbuf, P.in[5], XN); break;
    case 14: ph_gemm_naive<float, EpBf16>(p_in, 256, P.in[21], DM, 256, EpBf16{UP, DM}, smem); break;
    case 15: ph_gemm_naive<bf16, EpGate>(XN, DM, P.in[20], DM, DM, EpGate{hbuf, UP}, smem); break;
    case 16: ph_rmsnorm(hbuf, P.in[3] + DM, XN); break;
    case 17: ph_gemm_naive<bf16, EpBf16>(XN, DM, P.in[12], C_LD, DM, EpBf16{QKV1, C_LD}, smem); break;
    case 18: ph_prep1(QKV1, positions, P.in[14], P.in[15]); break;
    case 19: ph_dilated(QKV1, OG, LSE); break;
    case 20: ph_dil_merge(OG, LSE, XN); break;
    case 21: ph_gemm_naive<bf16, EpResAdd>(XN, DM, P.in[13], DM, DM, EpResAdd{hbuf, hbuf}, smem); break;
    case 22: ph_rmsnorm(hbuf, P.in[4] + DM, XN); break;
    case 23: ph_gemm_naive<bf16, EpBf16>(XN, DM, P.in[16] + (size_t)DM * 2048, 2048, DM, EpBf16{QRY, 2048}, smem); break;
    case 24: ph_peer_route(QRY, P.in[17] + (size_t)16 * 128 * 128, EIDX, GW, smem); break;
    case 25: ph_peer_gather(XN, EIDX, GW, P.in[18] + (size_t)NEXP * DM, P.in[19] + (size_t)NEXP * DM, hbuf, smem); break;
    case 26: ph_rmsnorm(hbuf, P.in[5] + DM, XN); break;
    case 27: ph_gemm_naive<float, EpBf16>(p_in + (size_t)T * 256, 256, P.in[21] + (size_t)256 * DM, DM, 256, EpBf16{UP, DM}, smem); break;
    case 28: ph_gemm_naive<bf16, EpGate>(XN, DM, P.in[20] + (size_t)DM * DM, DM, DM, EpGate{hbuf, UP}, smem); break;
    default: break;
    }
}

namespace cg = cooperative_groups;
constexpr int LDS_BYTES = 147456;
__global__ void __launch_bounds__(NT, 2) k_mega(Params P) {
    extern __shared__ __attribute__((aligned(16))) unsigned char smem[];
    cg::grid_group grid = cg::this_grid();
    run_phase(P, 0, smem);  grid.sync();
    run_phase(P, 1, smem);  grid.sync();
    run_phase(P, 2, smem);  grid.sync();
    run_phase(P, 3, smem);  grid.sync();
    run_phase(P, 4, smem);  grid.sync();
    run_phase(P, 5, smem);  grid.sync();
    run_phase(P, 6, smem);  grid.sync();
    run_phase(P, 7, smem);  grid.sync();
    run_phase(P, 8, smem);  grid.sync();
    run_phase(P, 9, smem);  grid.sync();
    run_phase(P, 10, smem);  grid.sync();
    run_phase(P, 11, smem);  grid.sync();
    run_phase(P, 12, smem);  grid.sync();
    run_phase(P, 13, smem);  grid.sync();
    run_phase(P, 14, smem);  grid.sync();
    run_phase(P, 15, smem);  grid.sync();
    run_phase(P, 16, smem);  grid.sync();
    run_phase(P, 17, smem);  grid.sync();
    run_phase(P, 18, smem);  grid.sync();
    run_phase(P, 19, smem);  grid.sync();
    run_phase(P, 20, smem);  grid.sync();
    run_phase(P, 21, smem);  grid.sync();
    run_phase(P, 22, smem);  grid.sync();
    run_phase(P, 23, smem);  grid.sync();
    run_phase(P, 24, smem);  grid.sync();
    run_phase(P, 25, smem);  grid.sync();
    run_phase(P, 26, smem);  grid.sync();
    run_phase(P, 27, smem);  grid.sync();
    run_phase(P, 28, smem);
}

extern "C" void kernel_launch(void* const* d_in, const int* in_sizes, int n_in, void* d_out, int out_size, void* d_ws, size_t ws_size, hipStream_t stream) {
    static int grid_blocks = 0;
    if (grid_blocks == 0) {
        if (n_in != 22 || out_size != T * DM || ws_size < WS_END) { fprintf(stderr, "kernel_launch: unexpected shapes: n_in %d out %d ws %zu\n", n_in, out_size, ws_size); grid_blocks = -1; return; }
        if (hipFuncSetAttribute((const void*)k_mega, hipFuncAttributeMaxDynamicSharedMemorySize, LDS_BYTES) != hipSuccess) { fprintf(stderr, "hipFuncSetAttribute failed\n"); grid_blocks = -1; return; }
        int dev = 0, cus = 0, per_cu = 0;
        hipGetDevice(&dev);
        hipDeviceGetAttribute(&cus, hipDeviceAttributeMultiprocessorCount, dev);
        hipOccupancyMaxActiveBlocksPerMultiprocessor(&per_cu, (const void*)k_mega, NT, LDS_BYTES);
        if (per_cu < 1 || cus < 1) { fprintf(stderr, "kernel_launch: occupancy query says %d blocks/CU on %d CUs\n", per_cu, cus); grid_blocks = -1; return; }
        grid_blocks = cus;
    }
    if (grid_blocks < 0) return;
    Params P{};
    for (int i = 0; i < 22; ++i) P.in[i] = (const float*)d_in[i];
    P.out = (float*)d_out; P.ws = (unsigned char*)d_ws;
    void* args[] = {&P};
    hipError_t e = hipLaunchCooperativeKernel((const void*)k_mega, dim3(grid_blocks), dim3(NT), args, LDS_BYTES, stream);
    if (e != hipSuccess) fprintf(stderr, "cooperative launch failed: %s (grid %d)\n", hipGetErrorString(e), grid_blocks);
}
```

```cpp
#include <hip/hip_runtime.h>
#include <hip/hip_cooperative_groups.h>
#include <cstdio>
#include <cstdint>

constexpr int BATCH = 2, SEQ = 8192, T = BATCH * SEQ, DM = 1024;
constexpr int AB_N = 3396, AB_LD = 3584;
constexpr int CQA = 0, CKA = 512, CVA = 1024, CQB = 1536, CKB = 2048, CVB = 2560, CQI = 3072, CKI = 3328, CWI = 3392;
constexpr int C_LD = 3072;
constexpr int NEXP = 16384;
constexpr float NORM_EPS = 1e-6f;
constexpr float C2 = 0.125f * 1.4426950408889634f;
constexpr int NT = 512;

constexpr size_t MiB = 1u << 20;
constexpr size_t WS_CTL = 0;
constexpr size_t WS_WAB_IN = 1 * MiB, WS_WAB_OUT = 8 * MiB, WS_WC_IN = 10 * MiB, WS_WC_OUT = 16 * MiB;
constexpr size_t WS_WQ = 18 * MiB, WS_WG = 26 * MiB, WS_WUP = 30 * MiB, WS_SUBK = 31 * MiB;
constexpr size_t WS_KMEAN = 32 * MiB;
constexpr size_t WS_SEL = 33 * MiB;
constexpr size_t WS_LSE = 34 * MiB;
constexpr size_t WS_EIDX = 37 * MiB;
constexpr size_t WS_GW = 45 * MiB;
constexpr size_t WS_P = 53 * MiB;
constexpr size_t WS_XN = 69 * MiB;
constexpr size_t WS_QKV = 101 * MiB;
constexpr size_t WS_MASK = 213 * MiB;
constexpr size_t WS_SCORES = 229 * MiB;
constexpr size_t WS_QRY = 101 * MiB;
constexpr size_t WS_UP = 165 * MiB;
constexpr size_t WS_QKV1 = 357 * MiB;
constexpr size_t WS_OG = 101 * MiB;
constexpr size_t WS_END = 512 * MiB;

typedef unsigned short bf16;
typedef float f32x4 __attribute__((ext_vector_type(4)));

__device__ __forceinline__ unsigned f2bf(float f) { unsigned u = __builtin_bit_cast(unsigned, f); return (u + 0x7fffu + ((u >> 16) & 1u)) >> 16; }
__device__ __forceinline__ float bf2f(bf16 h) { return __builtin_bit_cast(float, (unsigned)h << 16); }
__device__ __forceinline__ float wave_sum(float v) {
#pragma unroll
    for (int o = 1; o < 64; o <<= 1) v += __shfl_xor(v, o);
    return v;
}
__device__ __forceinline__ float wave_max(float v) {
#pragma unroll
    for (int o = 1; o < 64; o <<= 1) v = fmaxf(v, __shfl_xor(v, o));
    return v;
}
__device__ __forceinline__ unsigned okey(float f) { unsigned u = __builtin_bit_cast(unsigned, f); return (u & 0x80000000u) ? ~u : (u | 0x80000000u); }

__device__ __forceinline__ int tidx() { int t = __builtin_amdgcn_workitem_id_x(); asm volatile("" : "+v"(t)); return t; }
__device__ __forceinline__ int bidx() { int b = __builtin_amdgcn_workgroup_id_x(); asm volatile("" : "+s"(b)); return b; }
struct Params {
    const float* in[22];
    float* out;
    unsigned char* ws;
    int layer;
    int pad;
};

typedef const __attribute__((address_space(4))) unsigned long long* karg_t;
__device__ __forceinline__ unsigned long long karg(int idx) { karg_t ka = (karg_t)__builtin_amdgcn_kernarg_segment_ptr(); asm volatile("" : "+s"(ka)); return ka[idx]; }
#define IN(i) ((const float*)karg(i))
#define OUTP ((float*)karg(22))
#define WSP ((unsigned char*)karg(23))

__device__ __forceinline__ void ph_rmsnorm(const float* src, const float* gain, bf16* dst) {
    const int lane = tidx() & 63, wave = tidx() >> 6;
    const int gw = bidx() * (NT / 64) + wave, ngw = gridDim.x * (NT / 64);
    for (int r = gw; r < T; r += ngw) {
        const f32x4* xr = (const f32x4*)(src + (size_t)r * DM) + lane;
        f32x4 v[4]; float s = 0.f;
#pragma unroll
        for (int j = 0; j < 4; ++j) { v[j] = xr[64 * j]; s += v[j].x * v[j].x + v[j].y * v[j].y + v[j].z * v[j].z + v[j].w * v[j].w; }
        const float rstd = 1.0f / sqrtf(wave_sum(s) * (1.0f / DM) + NORM_EPS);
#pragma unroll
        for (int j = 0; j < 4; ++j) {
            const f32x4 g = ((const f32x4*)gain)[lane + 64 * j];
            unsigned long long o = (unsigned long long)(f2bf(v[j].x * rstd * g.x) | (f2bf(v[j].y * rstd * g.y) << 16)) |
                                   ((unsigned long long)(f2bf(v[j].z * rstd * g.z) | (f2bf(v[j].w * rstd * g.w) << 16)) << 32);
            ((unsigned long long*)(dst + (size_t)r * DM))[lane + 64 * j] = o;
        }
    }
}

template <class AT> __device__ __forceinline__ float ldA(const AT* p);
template <> __device__ __forceinline__ float ldA<bf16>(const bf16* p) { return bf2f(*p); }
template <> __device__ __forceinline__ float ldA<float>(const float* p) { return *p; }

template <class AT, class Epi> __forceinline__
__device__ __forceinline__ void ph_gemm_naive(const AT* A, int lda, const float* B, int N, int K, const Epi& E, unsigned char* smem) {
    float* As = (float*)smem;
    float* Bs = As + 16 * 132;
    const int tid = tidx(), ty = tid >> 5, tx = tid & 31;
    const int ntn = (N + 127) / 128, ntm = T / 128, ntile = ntn * ntm;
    for (int tile = bidx(); tile < ntile; tile += gridDim.x) {
        const int tm = tile / ntn, tn = tile % ntn, m0 = tm * 128, n0 = tn * 128;
        float acc[8][4];
#pragma unroll
        for (int i = 0; i < 8; ++i)
#pragma unroll
            for (int j = 0; j < 4; ++j) acc[i][j] = 0.f;
        for (int k0 = 0; k0 < K; k0 += 16) {
            __syncthreads();
#pragma unroll
            for (int i = 0; i < 4; ++i) { const int e = tid + i * NT, r = e >> 4, kk = e & 15; As[kk * 132 + r] = ldA<AT>(A + (size_t)(m0 + r) * lda + k0 + kk); }
#pragma unroll
            for (int i = 0; i < 4; ++i) { const int e = tid + i * NT, kk = e >> 7, c = e & 127; Bs[kk * 128 + c] = (n0 + c < N) ? B[(size_t)(k0 + kk) * N + n0 + c] : 0.f; }
            __syncthreads();
#pragma unroll 2
            for (int kk = 0; kk < 16; ++kk) {
                float a[8], b[4];
#pragma unroll
                for (int i = 0; i < 8; ++i) a[i] = As[kk * 132 + ty * 8 + i];
#pragma unroll
                for (int j = 0; j < 4; ++j) b[j] = Bs[kk * 128 + tx * 4 + j];
#pragma unroll
                for (int i = 0; i < 8; ++i)
#pragma unroll
                    for (int j = 0; j < 4; ++j) acc[i][j] += a[i] * b[j];
            }
        }
#pragma unroll
        for (int i = 0; i < 8; ++i) {
            const int col = n0 + tx * 4;
            if (col < N) E.store4(m0 + ty * 8 + i, col, (f32x4){acc[i][0], acc[i][1], acc[i][2], acc[i][3]});
        }
    }
}
struct EpBf16 { bf16* O; int ldc;
    __device__ __forceinline__ void store4(int r, int c, f32x4 v) const {
        unsigned long long o = (unsigned long long)(f2bf(v.x) | (f2bf(v.y) << 16)) | ((unsigned long long)(f2bf(v.z) | (f2bf(v.w) << 16)) << 32);
        *(unsigned long long*)(O + (size_t)r * ldc + c) = o; } };
struct EpResAdd { const float* base; float* out;
    __device__ __forceinline__ void store4(int r, int c, f32x4 v) const {
        const f32x4 b = *(const f32x4*)(base + (size_t)r * DM + c); *(f32x4*)(out + (size_t)r * DM + c) = b + v; } };
struct EpGate { float* h; const bf16* up;
    __device__ __forceinline__ void store4(int r, int c, f32x4 v) const {
        f32x4 hv = *(const f32x4*)(h + (size_t)r * DM + c); const bf16* u = up + (size_t)r * DM + c;
        hv.x += bf2f(u[0]) / (1.f + __expf(-v.x)); hv.y += bf2f(u[1]) / (1.f + __expf(-v.y));
        hv.z += bf2f(u[2]) / (1.f + __expf(-v.z)); hv.w += bf2f(u[3]) / (1.f + __expf(-v.w));
        *(f32x4*)(h + (size_t)r * DM + c) = hv; } };

__device__ __forceinline__ void rope_cs(int pos, int i, float& c, float& s) {
    const float inv = exp2f(-(float)i * 0.125f * 18.931568569324174f);
    const float ang = (float)pos * inv;
    const float k = rintf(ang * 0.15915494309189535f);
    float r = fmaf(-k, 6.28125f, ang); r = fmaf(-k, 1.9353071795864769e-3f, r);
    c = cosf(r); s = sinf(r);
}
__device__ __forceinline__ void prep_head(bf16* p, const float* gain, int pos, float scale, bool donorm, int lane) {
    float v = bf2f(p[lane]);
    if (donorm) { const float ss = wave_sum(v * v); v = v * (1.0f / sqrtf(ss * (1.0f / 64.f) + NORM_EPS)) * gain[lane]; }
    const float partner = __shfl_xor(v, 8);
    float c = 1.f, s = 0.f;
    if (lane < 16) rope_cs(pos, lane & 7, c, s);
    float o = v;
    if (lane < 8) o = v * c - partner * s; else if (lane < 16) o = v * c + partner * s;
    p[lane] = (bf16)f2bf(o * scale);
}
__device__ __forceinline__ void ph_prep0(bf16* qkv, const int* positions, const float* aq, const float* ak, const float* bq, const float* bk) {
    const int lane = tidx() & 63, wave = tidx() >> 6;
    const int gw = bidx() * (NT / 64) + wave, ngw = gridDim.x * (NT / 64);
    for (int r = gw; r < T; r += ngw) {
        const int pos = positions[r]; bf16* row = qkv + (size_t)r * AB_LD;
        for (int h = 0; h < 8; ++h) {
            prep_head(row + CQA + h * 64, aq, pos, C2, true, lane);
            prep_head(row + CKA + h * 64, ak, pos, 1.f, true, lane);
            prep_head(row + CQB + h * 64, bq, pos, C2, true, lane);
            prep_head(row + CKB + h * 64, bk, pos, 1.f, true, lane);
        }
        for (int h = 0; h < 4; ++h) prep_head(row + CQI + h * 64, nullptr, pos, 1.f, false, lane);
        prep_head(row + CKI, nullptr, pos, 1.f, false, lane);
    }
}
__device__ __forceinline__ void ph_prep1(bf16* qkv, const int* positions, const float* cq, const float* ck) {
    const int lane = tidx() & 63, wave = tidx() >> 6;
    const int gw = bidx() * (NT / 64) + wave, ngw = gridDim.x * (NT / 64);
    for (int r = gw; r < T; r += ngw) {
        const int pos = positions[r]; bf16* row = qkv + (size_t)r * C_LD;
        for (int h = 0; h < 16; ++h) {
            prep_head(row + h * 64, cq, pos, C2, true, lane);
            prep_head(row + 1024 + h * 64, ck, pos, 1.f, true, lane);
        }
    }
}
__device__ __forceinline__ void ph_kmean(const bf16* qkv, float* kmean) {
    const int lane = tidx() & 63, wave = tidx() >> 6;
    const int gw = bidx() * (NT / 64) + wave, ngw = gridDim.x * (NT / 64);
    for (int it = gw; it < BATCH * 8 * 32; it += ngw) {
        const int b = it / 256, h = (it / 32) % 8, n = it % 32;
        float s = 0.f;
        for (int r = 0; r < 256; ++r) s += bf2f(qkv[(size_t)(b * SEQ + n * 256 + r) * AB_LD + CKA + h * 64 + lane]);
        kmean[(size_t)it * 64 + lane] = s * (1.0f / 256.f);
    }
}
__device__ __forceinline__ void ph_moba_select(const bf16* qkv, const float* kmean, unsigned* sel) {
    for (int it = bidx() * NT + tidx(); it < T * 8; it += gridDim.x * NT) {
        const int t = it >> 3, h = it & 7, b = t / SEQ, qblk = (t % SEQ) / 256;
        float q[64];
#pragma unroll
        for (int d = 0; d < 64; ++d) q[d] = bf2f(qkv[(size_t)t * AB_LD + CQA + h * 64 + d]);
        float v0 = -3e38f, v1 = -3e38f, v2 = -3e38f; int i0 = 255, i1 = 255, i2 = 255;
        for (int n = 0; n < qblk; ++n) {
            const float* km = kmean + (size_t)((b * 8 + h) * 32 + n) * 64; float g = 0.f;
#pragma unroll
            for (int d = 0; d < 64; ++d) g += q[d] * km[d];
            if (g > v0) { v2 = v1; i2 = i1; v1 = v0; i1 = i0; v0 = g; i0 = n; }
            else if (g > v1) { v2 = v1; i2 = i1; v1 = g; i1 = n; }
            else if (g > v2) { v2 = g; i2 = n; }
        }
        sel[it] = (unsigned)i0 | ((unsigned)i1 << 8) | ((unsigned)i2 << 16) | (255u << 24);
    }
}
__device__ __forceinline__ void ph_moba_attend(const bf16* qkv, const unsigned* sel, bf16* O, unsigned char* smem) {
    const int lane = tidx() & 63, wave = tidx() >> 6;
    float* pl = (float*)smem + wave * 1024;
    const int gw = bidx() * (NT / 64) + wave, ngw = gridDim.x * (NT / 64);
    for (int it = gw; it < T * 8; it += ngw) {
        const int t = it >> 3, h = it & 7, b = t / SEQ, tt = t % SEQ, qblk = tt / 256;
        const unsigned sw = sel[it];
        int blk[4] = {qblk, (int)(sw & 255), (int)((sw >> 8) & 255), (int)((sw >> 16) & 255)};
        const bf16* qp = qkv + (size_t)t * AB_LD + CQA + h * 64;
        float q[64];
#pragma unroll
        for (int d = 0; d < 64; ++d) q[d] = bf2f(qp[d]);
        float sc[16]; float mx = -3e38f;
#pragma unroll
        for (int s = 0; s < 4; ++s) {
#pragma unroll
            for (int i = 0; i < 4; ++i) {
                const int j = lane + 64 * i, pos = blk[s] * 256 + j;
                const bool ok = (blk[s] != 255) && (s > 0 || pos <= tt);
                float a = -3e38f;
                if (ok) { const bf16* kp = qkv + (size_t)(b * SEQ + pos) * AB_LD + CKA + h * 64; a = 0.f;
#pragma unroll
                    for (int d = 0; d < 64; ++d) a += q[d] * bf2f(kp[d]); }
                sc[s * 4 + i] = a; mx = fmaxf(mx, a);
            }
        }
        mx = wave_max(mx); float l = 0.f;
#pragma unroll
        for (int e = 0; e < 16; ++e) { const float p = (sc[e] > -1e38f) ? exp2f(sc[e] - mx) : 0.f; l += p; pl[(e >> 2) * 256 + lane + 64 * (e & 3)] = p; }
        l = wave_sum(l);
        __builtin_amdgcn_s_waitcnt(0);
        float o = 0.f;
#pragma unroll
        for (int s = 0; s < 4; ++s) {
            if (blk[s] == 255) continue;
            const int nk = (s == 0) ? (tt - qblk * 256 + 1) : 256;
            const bf16* vp = qkv + (size_t)(b * SEQ + blk[s] * 256) * AB_LD + CVA + h * 64 + lane;
            for (int j = 0; j < nk; ++j) o += pl[s * 256 + j] * bf2f(vp[(size_t)j * AB_LD]);
        }
        O[(size_t)t * DM + h * 64 + lane] = (bf16)f2bf(o / l);
    }
}
__device__ __forceinline__ void ph_dsa_select(const bf16* qkv, unsigned long long* mask, unsigned char* smem) {
    unsigned* keys = (unsigned*)smem;
    unsigned* cnt = keys + 8192;
    const int tid = tidx(), lane = tid & 63;
    for (int t = bidx(); t < T; t += gridDim.x) {
        const int b = t / SEQ, tt = t % SEQ, n = tt + 1;
        __syncthreads();
        const bf16* row = qkv + (size_t)t * AB_LD;
        float* qf = (float*)(cnt + 4);
        if (tid < 256) qf[tid] = bf2f(row[CQI + tid]);
        if (tid < 4) qf[256 + tid] = bf2f(row[CWI + tid]);
        __syncthreads();
        for (int kv = tid; kv < 8192; kv += NT) {
            unsigned key = 0u;
            if (kv < n) {
                const bf16* kp = qkv + (size_t)(b * SEQ + kv) * AB_LD + CKI;
                float a0 = 0.f, a1 = 0.f, a2 = 0.f, a3 = 0.f;
                for (int d = 0; d < 64; ++d) { const float kd = bf2f(kp[d]); a0 += qf[d] * kd; a1 += qf[64 + d] * kd; a2 += qf[128 + d] * kd; a3 += qf[192 + d] * kd; }
                const float s = ((qf[256] * fmaxf(a0, 0.f) + qf[257] * fmaxf(a1, 0.f)) + qf[258] * fmaxf(a2, 0.f)) + qf[259] * fmaxf(a3, 0.f);
                key = okey(s);
            }
            keys[kv] = key;
        }
        __syncthreads();
        unsigned thr = 0u, need = 0u;
        if (n > 256) {
            unsigned lo = 0u, hi = 0xFFFFFFFFu;
            while (lo < hi) {
                const unsigned mid = lo + ((hi - lo) >> 1) + ((hi - lo) & 1u);
                if (tid == 0) cnt[0] = 0u;
                __syncthreads();
                unsigned c = 0;
                for (int kv = tid; kv < 8192; kv += NT) c += (keys[kv] >= mid) ? 1u : 0u;
                c = (unsigned)wave_sum((float)c);
                if (lane == 0) atomicAdd(&cnt[0], c);
                __syncthreads();
                const unsigned tot = cnt[0];
                __syncthreads();
                if (tot >= 256u) lo = mid; else hi = mid - 1u;
            }
            thr = lo;
            if (tid == 0) cnt[1] = 0u;
            __syncthreads();
            unsigned c = 0;
            for (int kv = tid; kv < 8192; kv += NT) c += (keys[kv] > thr) ? 1u : 0u;
            c = (unsigned)wave_sum((float)c);
            if (lane == 0) atomicAdd(&cnt[1], c);
            __syncthreads();
            need = 256u - cnt[1];
        }
        if (tid < 64) {
            const int ntile = 4 * (tt / 256 + 1);
            unsigned taken = 0u;
            for (int j = 0; j < ntile; ++j) {
                const int kv = j * 64 + lane; const unsigned key = keys[kv];
                bool s;
                if (n <= 256) s = kv < n;
                else {
                    const bool gt = key > thr, eq = (key == thr) && (kv < n);
                    const unsigned long long em = __ballot(eq);
                    const unsigned rank = taken + (unsigned)__popcll(em & ((1ull << lane) - 1ull));
                    s = gt || (eq && rank < need);
                    taken += (unsigned)__popcll(em);
                }
                const unsigned long long m = __ballot(s);
                if (lane == 0) mask[((size_t)(b * 128 + j)) * SEQ + tt] = m;
            }
        }
    }
}
__device__ __forceinline__ void ph_dsa_attend(const bf16* qkv, const unsigned long long* mask, bf16* O, unsigned char* smem) {
    int* list = (int*)smem;
    int* cnt = list + 256;
    float* pr = (float*)(cnt + 4);
    float* linv = pr + 8 * 256;
    const int tid = tidx(), lane = tid & 63, wave = tid >> 6;
    for (int t = bidx(); t < T; t += gridDim.x) {
        const int b = t / SEQ, tt = t % SEQ;
        __syncthreads();
        const int ntile = 4 * (tt / 256 + 1);
        if (wave == 0) {
            int base = 0;
            for (int j = 0; j < ntile; ++j) {
                const unsigned long long m = mask[((size_t)(b * 128 + j)) * SEQ + tt];
                const int p = base + (int)__popcll(m & ((1ull << lane) - 1ull));
                if (((m >> lane) & 1ull) && p < 256) list[p] = j * 64 + lane;
                base += (int)__popcll(m);
            }
            if (lane == 0) cnt[0] = base;
        }
        __syncthreads();
        const int ns = min(cnt[0], 256);
        const bf16* row = qkv + (size_t)t * AB_LD;
        for (int e = tid; e < 8 * 256; e += NT) {
            const int h = e >> 8, j = e & 255; float a = -3e38f;
            if (j < ns) { const bf16* kp = qkv + (size_t)(b * SEQ + list[j]) * AB_LD + CKB + h * 64; a = 0.f;
                for (int d = 0; d < 64; ++d) a += bf2f(row[CQB + h * 64 + d]) * bf2f(kp[d]); }
            pr[e] = a;
        }
        __syncthreads();
        {
            const int h = wave; float v[4]; float mx = -3e38f;
#pragma unroll
            for (int i = 0; i < 4; ++i) { v[i] = pr[h * 256 + lane + 64 * i]; mx = fmaxf(mx, v[i]); }
            mx = wave_max(mx); float l = 0.f;
#pragma unroll
            for (int i = 0; i < 4; ++i) { const float p = (v[i] > -1e38f) ? exp2f(v[i] - mx) : 0.f; l += p; pr[h * 256 + lane + 64 * i] = p; }
            l = wave_sum(l); if (lane == 0) linv[h] = 1.0f / l;
        }
        __syncthreads();
        {   const int h = tid >> 6, d = tid & 63; float o = 0.f;
            for (int j = 0; j < ns; ++j) o += pr[h * 256 + j] * bf2f(qkv[(size_t)(b * SEQ + list[j]) * AB_LD + CVB + h * 64 + d]);
            O[(size_t)t * DM + 512 + h * 64 + d] = (bf16)f2bf(o * linv[h]); }
    }
}
__device__ __forceinline__ void ph_dilated(const bf16* qkv, bf16* OG, float* LSE) {
    const int lane = tidx() & 63, wave = tidx() >> 6;
    const int gw = bidx() * (NT / 64) + wave, ngw = gridDim.x * (NT / 64);
    for (int it = gw; it < T * 16; it += ngw) {
        const int t = it >> 4, h = it & 15, b = t / SEQ, tt = t % SEQ;
        const bf16* qp = qkv + (size_t)t * C_LD + h * 64;
        float q[64];
#pragma unroll
        for (int d = 0; d < 64; ++d) q[d] = bf2f(qp[d]);
        for (int g = 0; g < 3; ++g) {
            const int dil = (g == 0) ? 1 : (g == 1 ? 4 : 16);
            float sc[3]; float mx = -3e38f;
#pragma unroll
            for (int i = 0; i < 3; ++i) {
                const int j = lane + 64 * i, pos = tt - j * dil; float a = -3e38f;
                if (j <= 128 && pos >= 0) { const bf16* kp = qkv + (size_t)(b * SEQ + pos) * C_LD + 1024 + h * 64; a = 0.f;
#pragma unroll
                    for (int d = 0; d < 64; ++d) a += q[d] * bf2f(kp[d]); }
                sc[i] = a; mx = fmaxf(mx, a);
            }
            mx = wave_max(mx); float l = 0.f; float p[3];
#pragma unroll
            for (int i = 0; i < 3; ++i) { p[i] = (sc[i] > -1e38f) ? exp2f(sc[i] - mx) : 0.f; l += p[i]; }
            l = wave_sum(l);
            float o = 0.f;
            for (int j = 0; j <= 128; ++j) {
                const int pos = tt - j * dil; if (pos < 0) break;
                const float pj = (j < 64) ? __shfl(p[0], j) : ((j < 128) ? __shfl(p[1], j - 64) : __shfl(p[2], 0));
                o += pj * bf2f(qkv[(size_t)(b * SEQ + pos) * C_LD + 2048 + h * 64 + lane]);
            }
            OG[((size_t)g * T + t) * DM + h * 64 + lane] = (bf16)f2bf(o / l);
            if (lane == 0) LSE[((size_t)g * T + t) * 16 + h] = mx + log2f(l);
        }
    }
}
__device__ __forceinline__ void ph_dil_merge(const bf16* OG, const float* LSE, bf16* O) {
    for (size_t e = (size_t)bidx() * NT + tidx(); e < (size_t)T * DM; e += (size_t)gridDim.x * NT) {
        const int t = (int)(e >> 10), c = (int)(e & 1023), h = c >> 6;
        const float l0 = LSE[((size_t)0 * T + t) * 16 + h], l1 = LSE[((size_t)1 * T + t) * 16 + h], l2 = LSE[((size_t)2 * T + t) * 16 + h];
        const float m = fmaxf(l0, fmaxf(l1, l2)); const float w0 = exp2f(l0 - m), w1 = exp2f(l1 - m), w2 = exp2f(l2 - m);
        const float o = (w0 * bf2f(OG[e]) + w1 * bf2f(OG[(size_t)T * DM + e]) + w2 * bf2f(OG[(size_t)2 * T * DM + e])) / (w0 + w1 + w2);
        O[e] = (bf16)f2bf(o);
    }
}
__device__ __forceinline__ void ph_peer_route(const bf16* qry, const float* subk, int* eidx, float* gw, unsigned char* smem) {
    float* s = (float*)smem;
    float* sv = s + 2048;
    int* si = (int*)(sv + 256);
    float* qf = (float*)(si + 256);
    const int tid = tidx(), lane = tid & 63, wave = tid >> 6;
    for (int t = bidx(); t < T; t += gridDim.x) {
        __syncthreads();
        for (int e = tid; e < 2048; e += NT) qf[e] = bf2f(qry[(size_t)t * 2048 + e]);
        __syncthreads();
        for (int e = tid; e < 2048; e += NT) {
            const int hc = e >> 7, k = e & 127; const float* kp = subk + ((size_t)hc * 128 + k) * 128; float a = 0.f;
            for (int d = 0; d < 128; ++d) a += qf[hc * 128 + d] * kp[d];
            s[e] = a;
        }
        __syncthreads();
        for (int hc = wave; hc < 16; hc += NT / 64) {
            float v0 = s[hc * 128 + lane], v1 = s[hc * 128 + 64 + lane];
            for (int r = 0; r < 16; ++r) {
                float bv = v0; int bi = lane;
                if (v1 > bv) { bv = v1; bi = lane + 64; }
#pragma unroll
                for (int o = 1; o < 64; o <<= 1) { const float ov = __shfl_xor(bv, o); const int oi = __shfl_xor(bi, o); if (ov > bv || (ov == bv && oi < bi)) { bv = ov; bi = oi; } }
                if (lane == 0) { sv[hc * 16 + r] = bv; si[hc * 16 + r] = bi; }
                if (bi == lane) v0 = -3e38f; if (bi == lane + 64) v1 = -3e38f;
            }
        }
        __syncthreads();
        {   const int h = wave;
            float c[4]; int ci[4];
#pragma unroll
            for (int i = 0; i < 4; ++i) { const int f = lane + 64 * i; c[i] = sv[(h * 2) * 16 + (f >> 4)] + sv[(h * 2 + 1) * 16 + (f & 15)]; ci[i] = f; }
            float cv[16]; int cf[16];
#pragma unroll
            for (int r = 0; r < 16; ++r) {
                float bv = c[0]; int bi = ci[0];
#pragma unroll
                for (int i = 1; i < 4; ++i) if (c[i] > bv) { bv = c[i]; bi = ci[i]; }
#pragma unroll
                for (int o = 1; o < 64; o <<= 1) { const float ov = __shfl_xor(bv, o); const int oi = __shfl_xor(bi, o); if (ov > bv || (ov == bv && oi < bi)) { bv = ov; bi = oi; } }
                cv[r] = bv; cf[r] = bi;
#pragma unroll
                for (int i = 0; i < 4; ++i) if (ci[i] == bi) c[i] = -3e38f;
            }
            float l = 0.f;
#pragma unroll
            for (int r = 0; r < 16; ++r) l += __expf(cv[r] - cv[0]);
            if (lane < 16) {
                float myv = 0.f; int myf = 0;
#pragma unroll
                for (int r = 0; r < 16; ++r) if (r == lane) { myv = cv[r]; myf = cf[r]; }
                eidx[(size_t)t * 128 + h * 16 + lane] = si[(h * 2) * 16 + (myf >> 4)] * 128 + si[(h * 2 + 1) * 16 + (myf & 15)];
                gw[(size_t)t * 128 + h * 16 + lane] = __expf(myv - cv[0]) / l;
            }
        }
    }
}
__device__ __forceinline__ float gelu_tanh(float x) { const float u = 0.7978845608028654f * (x + 0.044715f * x * x * x); return 0.5f * x * (1.f + tanhf(u)); }
__device__ __forceinline__ void ph_peer_gather(const bf16* xn, const int* eidx, const float* gw, const float* U, const float* V, float* h, unsigned char* smem) {
    float* xf = (float*)smem;
    float* w = xf + 1024;
    int* ei = (int*)(w + 128);
    const int tid = tidx(), lane = tid & 63, wave = tid >> 6;
    for (int t = bidx(); t < T; t += gridDim.x) {
        __syncthreads();
        for (int e = tid; e < 1024; e += NT) xf[e] = bf2f(xn[(size_t)t * DM + e]);
        if (tid < 128) ei[tid] = eidx[(size_t)t * 128 + tid];
        __syncthreads();
        for (int e = wave; e < 128; e += NT / 64) {
            const float* up = U + (size_t)ei[e] * DM; float a = 0.f;
            for (int d = lane; d < 1024; d += 64) a += xf[d] * up[d];
            a = wave_sum(a);
            if (lane == 0) w[e] = gw[(size_t)t * 128 + e] * gelu_tanh(a);
        }
        __syncthreads();
        for (int d = tid; d < 1024; d += NT) {
            float o = 0.f;
            for (int e = 0; e < 128; ++e) o += w[e] * V[(size_t)ei[e] * DM + d];
            h[(size_t)t * DM + d] += o;
        }
    }
}

namespace pg8 {
#define PG8_LAS __attribute__((address_space(3)))
typedef unsigned short bf16_t;
typedef short bf16x8 __attribute__((ext_vector_type(8)));
typedef float f32x4 __attribute__((ext_vector_type(4)));
typedef unsigned u32x4 __attribute__((ext_vector_type(4)));
constexpr int BM = 256, BK = 64, HALF = 128, HTB = HALF * BK * 2  , STAGE_BYTES = 8 * HTB, NXCD = 8, WGM = 8;

__host__ __device__ __forceinline__ int lds_byte(int r, int c) { const int st = (r >> 4) * 2 + (c >> 5), rr = r & 15, cc = c & 31, ob = rr * 64 + cc * 2; return st * 1024 + (ob ^ (((ob >> 9) & 1) << 5)); }
__host__ __device__ __forceinline__ void stage_rc(int b, int& R, int& C) { const int st = b / 1024, sb = b % 1024, swz = sb ^ (((sb >> 9) & 1) << 5); R = (st >> 1) * 16 + swz / 64; C = (st & 1) * 32 + (swz % 64) / 2; }
__host__ __device__ __forceinline__ int perm32(int rho) { const int n = rho >> 4, i = rho & 15; return 8 * (i >> 2) + 4 * n + (i & 3); }

struct Unit { int pm, pn; };
struct Gemm { const bf16_t* A; const bf16_t* Bt; int M, N, K; };

struct StaticOrder {
    int nM, nN, nwg, G, c;
    __host__ __device__ void init(int M, int N, int G_, int c_) { nM = M / BM; nN = N / BM; nwg = nM * nN; G = G_; c = c_; }
    __host__ __device__ bool next(int i, Unit& u) const {
        const long L = (long)i * G + c; if (L >= nwg) return false;
        int wgid = (int)L; { const int q = nwg / NXCD, r = nwg % NXCD, xcd = wgid % NXCD, off = wgid / NXCD; wgid = (xcd < r ? xcd * (q + 1) : r * (q + 1) + (xcd - r) * q) + off; }
        const int nig = WGM * nN, gid = wgid / nig, fm = gid * WGM, gsz = (nM - fm) < WGM ? (nM - fm) : WGM;
        u.pm = fm + ((wgid % nig) % gsz); u.pn = (wgid % nig) / gsz; return true;
    }
    __device__ __forceinline__ void a_ready(const Unit&) const {}
    __device__ __forceinline__ void done(const Unit&) const {}
};


__device__ __forceinline__ unsigned pk_bf16(float lo, float hi) { typedef float f2 __attribute__((ext_vector_type(2))); typedef __bf16 b2 __attribute__((ext_vector_type(2))); f2 v = {lo, hi}; b2 b = __builtin_convertvector(v, b2); return __builtin_bit_cast(unsigned, b); }
struct EBf16 {
    static constexpr bool PERM = true, AFTER_DRAIN = false; bf16_t* O; int ldc;
    __device__ __forceinline__ void operator()(const f32x4 (&acc)[2][2][4][2], const Unit& u, int wr, int wc, int fr, int fq) const {
        const int row0 = u.pm * BM + wr * 64 + fr, col0 = u.pn * BM + wc * 32 + 8 * fq;
#pragma unroll
        for (int ai = 0; ai < 2; ++ai)
#pragma unroll
            for (int m = 0; m < 4; ++m) { bf16_t* rowp = O + (size_t)(row0 + ai * HALF + m * 16) * ldc + col0;
#pragma unroll
                for (int bj = 0; bj < 2; ++bj) { const f32x4 v0 = acc[ai][bj][m][0], v1 = acc[ai][bj][m][1];
                    u32x4 w; w.x = pk_bf16(v0[0], v0[1]); w.y = pk_bf16(v0[2], v0[3]); w.z = pk_bf16(v1[0], v1[1]); w.w = pk_bf16(v1[2], v1[3]);
                    *(u32x4*)(rowp + bj * HALF) = w; } }
    }
};
struct EResAdd {
    static constexpr bool PERM = false, AFTER_DRAIN = false; const float* base; float* out;
    __device__ __forceinline__ void operator()(const f32x4 (&acc)[2][2][4][2], const Unit& u, int wr, int wc, int fr, int fq) const {
        const int col0 = u.pn * BM + wc * 32 + 4 * fq;
#pragma unroll
        for (int ai = 0; ai < 2; ++ai)
#pragma unroll
            for (int m = 0; m < 4; ++m) { const size_t off = (size_t)(u.pm * BM + ai * HALF + wr * 64 + m * 16 + fr) * 1024 + col0;
#pragma unroll
                for (int bj = 0; bj < 2; ++bj)
#pragma unroll
                    for (int n = 0; n < 2; ++n) { const f32x4 b = *(const f32x4*)(base + off + bj * HALF + n * 16); *(f32x4*)(out + off + bj * HALF + n * 16) = b + acc[ai][bj][m][n]; } }
    }
};
struct EGate {
    static constexpr bool PERM = false, AFTER_DRAIN = false; float* h; const bf16_t* up;
    __device__ __forceinline__ void operator()(const f32x4 (&acc)[2][2][4][2], const Unit& u, int wr, int wc, int fr, int fq) const {
        const int col0 = u.pn * BM + wc * 32 + 4 * fq;
#pragma unroll
        for (int ai = 0; ai < 2; ++ai)
#pragma unroll
            for (int m = 0; m < 4; ++m) { const size_t off = (size_t)(u.pm * BM + ai * HALF + wr * 64 + m * 16 + fr) * 1024 + col0;
#pragma unroll
                for (int bj = 0; bj < 2; ++bj)
#pragma unroll
                    for (int n = 0; n < 2; ++n) { const size_t o = off + bj * HALF + n * 16; f32x4 hv = *(const f32x4*)(h + o);
                        const unsigned long long uu = *(const unsigned long long*)(up + o); const f32x4 a = acc[ai][bj][m][n];
                        hv[0] += __builtin_bit_cast(float, (unsigned)(uu << 16)) / (1.f + __expf(-a[0]));
                        hv[1] += __builtin_bit_cast(float, (unsigned)(uu & 0xffff0000ull)) / (1.f + __expf(-a[1]));
                        hv[2] += __builtin_bit_cast(float, (unsigned)((uu >> 16) & 0xffff0000ull)) / (1.f + __expf(-a[2]));
                        hv[3] += __builtin_bit_cast(float, (unsigned)((uu >> 32) & 0xffff0000ull)) / (1.f + __expf(-a[3]));
                        *(f32x4*)(h + o) = hv; } }
    }
};
template <class Epi, class Sched, bool ALIGN_EPI = false, bool SP2 = false>
__device__ __forceinline__ void gemm_phase(PG8_LAS unsigned char* lds, const Gemm g, const Sched& S, const Epi& E) {
    const int tid = tidx(), wid = __builtin_amdgcn_readfirstlane(tid >> 6), lane = tid & 63, wr = wid >> 2, wc = wid & 3, fr = lane & 15, fq = lane >> 4;
    const int K = g.K, nt = K / BK;
    unsigned voffA[2], voffB[2];
#pragma unroll
    for (int i = 0; i < 2; ++i) { int R, C; stage_rc(tid * 16 + i * 8192, R, C); const int Rb = Epi::PERM ? ((R & ~31) + perm32(R & 31)) : R;
        voffA[i] = (unsigned)(R * K + C) * 2u; voffB[i] = (unsigned)(Rb * K + C) * 2u; }
    const size_t kstep = (size_t)(BK * 2);
    const size_t hstep = (size_t)HALF * K * 2;
    const size_t tstep = 2 * hstep;
    const unsigned ldsw = (unsigned)wid * 1024u;
    const int aoff = lds_byte(wr * 64 + fr, fq * 8), boff = lds_byte(wc * 32 + fr, fq * 8);
#define PG8_SA(b, h) (((b) * 2 + (h)) * HTB)
#define PG8_SB(b, h) ((4 + (b) * 2 + (h)) * HTB)
#define PG8_STAGE(bufoff, gbase, voff) do { _Pragma("unroll") for (int _i = 0; _i < 2; ++_i) \
        __builtin_amdgcn_global_load_lds((const unsigned*)((const char*)(gbase) + (voff)[_i]), (PG8_LAS unsigned*)(lds + (bufoff) + ldsw + _i * 8192), 16, 0, 0); } while (0)
#define PG8_LDA(dst, b, h) do { _Pragma("unroll") for (int m = 0; m < 4; ++m) _Pragma("unroll") for (int k = 0; k < 2; ++k) dst[m][k] = *(const PG8_LAS bf16x8*)(lds + PG8_SA(b, h) + aoff + m * 2048 + k * 1024); } while (0)
#define PG8_LDB(dst, b, h) do { _Pragma("unroll") for (int n = 0; n < 2; ++n) _Pragma("unroll") for (int k = 0; k < 2; ++k) dst[n][k] = *(const PG8_LAS bf16x8*)(lds + PG8_SB(b, h) + boff + n * 2048 + k * 1024); } while (0)
#define PG8_MMA(ai, bj, At, Bt) do { __builtin_amdgcn_s_setprio(1); _Pragma("unroll") for (int m = 0; m < 4; ++m) _Pragma("unroll") for (int n = 0; n < 2; ++n) _Pragma("unroll") for (int k = 0; k < 2; ++k) \
        acc[ai][bj][m][n] = __builtin_amdgcn_mfma_f32_16x16x32_bf16(Bt[n][k], At[m][k], acc[ai][bj][m][n], 0, 0, 0); __builtin_amdgcn_s_setprio(0); } while (0)
#define PG8_WAIT_V(n) asm volatile("s_waitcnt vmcnt(" #n ")" ::: "memory")
#define PG8_WAIT_L(n) asm volatile("s_waitcnt lgkmcnt(" #n ")" ::: "memory")
#define PG8_BAR __builtin_amdgcn_s_barrier()
#define PG8_SCHED __builtin_amdgcn_sched_barrier(0)
    Unit cur, nxt; int ui = 0;
    if (!S.next(0, cur)) return;
    f32x4 acc[2][2][4][2];
#pragma unroll
    for (int a = 0; a < 2; ++a)
#pragma unroll
        for (int b = 0; b < 2; ++b)
#pragma unroll
            for (int m = 0; m < 4; ++m)
#pragma unroll
                for (int n = 0; n < 2; ++n) acc[a][b][m][n] = (f32x4){0.f, 0.f, 0.f, 0.f};
    bf16x8 At[4][2], B0[2][2], B1[2][2];
    const char* cA = (const char*)g.A + (size_t)cur.pm * tstep; const char* cB = (const char*)g.Bt + (size_t)cur.pn * tstep;
    S.a_ready(cur);
    if constexpr (SP2) {
        PG8_STAGE(PG8_SB(0, 0), cB, voffB); PG8_STAGE(PG8_SB(0, 1), cB + hstep, voffB); PG8_STAGE(PG8_SA(0, 0), cA, voffA); PG8_STAGE(PG8_SA(0, 1), cA + hstep, voffA);
        if (wr == 1) PG8_BAR;
        PG8_WAIT_V(2); PG8_BAR;
        PG8_STAGE(PG8_SB(1, 0), cB + kstep, voffB); PG8_STAGE(PG8_SA(1, 0), cA + kstep, voffA); PG8_STAGE(PG8_SB(1, 1), cB + hstep + kstep, voffB);
        PG8_WAIT_V(6); PG8_BAR;
    } else {
        PG8_STAGE(PG8_SB(0, 0), cB, voffB); PG8_STAGE(PG8_SA(0, 0), cA, voffA); PG8_STAGE(PG8_SB(0, 1), cB + hstep, voffB); PG8_STAGE(PG8_SA(0, 1), cA + hstep, voffA);
        if (wr == 1) PG8_BAR;
        PG8_WAIT_V(4); PG8_BAR;
        PG8_STAGE(PG8_SB(1, 0), cB + kstep, voffB); PG8_STAGE(PG8_SA(1, 0), cA + kstep, voffA); PG8_STAGE(PG8_SB(1, 1), cB + hstep + kstep, voffB);
        PG8_WAIT_V(6); PG8_BAR;
    }
    for (;;) {
        const bool has_next = S.next(ui + 1, nxt);
        const char* nA = has_next ? (const char*)g.A + (size_t)nxt.pm * tstep : cA; const char* nB = has_next ? (const char*)g.Bt + (size_t)nxt.pn * tstep : cB;
        for (int t = 0; t < nt; t += 2) {
            const bool last = (t == nt - 2);
            const char* a1 = cA + (size_t)(t + 1) * kstep;
            const char* a2 = last ? nA : cA + (size_t)(t + 2) * kstep; const char* b2 = last ? nB : cB + (size_t)(t + 2) * kstep;
            const char* a3 = a2 + kstep; const char* b3 = b2 + kstep;
            if (last && has_next) S.a_ready(nxt);
            if constexpr (SP2) {
            PG8_LDB(B0, 0, 0); PG8_LDB(B1, 0, 1); PG8_SCHED; PG8_LDA(At, 0, 0); PG8_STAGE(PG8_SA(1, 1), a1 + hstep, voffA);
            PG8_WAIT_V(8); PG8_WAIT_L(0); PG8_BAR; PG8_MMA(0, 0, At, B0); PG8_MMA(0, 1, At, B1); PG8_BAR; PG8_SCHED;
            PG8_LDA(At, 0, 1); PG8_STAGE(PG8_SB(0, 0), b2, voffB); PG8_STAGE(PG8_SB(0, 1), b2 + hstep, voffB); PG8_STAGE(PG8_SA(0, 0), a2, voffA);
            PG8_WAIT_V(8); PG8_WAIT_L(0); PG8_BAR; PG8_MMA(1, 0, At, B0); PG8_MMA(1, 1, At, B1); PG8_BAR; PG8_SCHED;
            PG8_LDB(B0, 1, 0); PG8_LDB(B1, 1, 1); PG8_SCHED; PG8_LDA(At, 1, 0); PG8_STAGE(PG8_SA(0, 1), a2 + hstep, voffA);
            PG8_WAIT_V(8); PG8_WAIT_L(0); PG8_BAR; PG8_MMA(0, 0, At, B0); PG8_MMA(0, 1, At, B1); PG8_BAR; PG8_SCHED;
            PG8_LDA(At, 1, 1); PG8_STAGE(PG8_SB(1, 0), b3, voffB); PG8_STAGE(PG8_SB(1, 1), b3 + hstep, voffB); PG8_STAGE(PG8_SA(1, 0), a3, voffA);
            PG8_WAIT_V(8); PG8_WAIT_L(0); PG8_BAR; PG8_MMA(1, 0, At, B0); PG8_MMA(1, 1, At, B1); PG8_BAR; PG8_SCHED;
            } else {
            PG8_LDB(B0, 0, 0); PG8_SCHED; PG8_LDA(At, 0, 0); PG8_STAGE(PG8_SA(1, 1), a1 + hstep, voffA);
            PG8_WAIT_L(8); PG8_BAR; PG8_WAIT_L(0); PG8_MMA(0, 0, At, B0); PG8_BAR; PG8_SCHED;
            PG8_LDB(B1, 0, 1); PG8_STAGE(PG8_SB(0, 0), b2, voffB);
            PG8_BAR; PG8_WAIT_L(0); PG8_MMA(0, 1, At, B1); PG8_BAR;
            PG8_LDA(At, 0, 1); PG8_STAGE(PG8_SA(0, 0), a2, voffA);
            PG8_BAR; PG8_WAIT_L(0); PG8_MMA(1, 0, At, B0); PG8_BAR; PG8_SCHED;
            PG8_STAGE(PG8_SB(0, 1), b2 + hstep, voffB);
            PG8_WAIT_V(6); PG8_BAR; PG8_MMA(1, 1, At, B1); PG8_BAR;
            PG8_LDB(B0, 1, 0); PG8_SCHED; PG8_LDA(At, 1, 0); PG8_STAGE(PG8_SA(0, 1), a2 + hstep, voffA);
            PG8_WAIT_L(8); PG8_BAR; PG8_WAIT_L(0); PG8_MMA(0, 0, At, B0); PG8_BAR; PG8_SCHED;
            PG8_LDB(B1, 1, 1); PG8_STAGE(PG8_SB(1, 0), b3, voffB);
            PG8_BAR; PG8_WAIT_L(0); PG8_MMA(0, 1, At, B1); PG8_BAR;
            PG8_LDA(At, 1, 1); PG8_STAGE(PG8_SA(1, 0), a3, voffA);
            PG8_BAR; PG8_WAIT_L(0); PG8_MMA(1, 0, At, B0); PG8_BAR; PG8_SCHED;
            PG8_STAGE(PG8_SB(1, 1), b3 + hstep, voffB);
            PG8_WAIT_V(6); PG8_BAR; PG8_MMA(1, 1, At, B1); PG8_BAR;
            }
        }
        if constexpr (ALIGN_EPI) { if (wr == 0) PG8_BAR; }
        if constexpr (!Epi::AFTER_DRAIN) { E(acc, cur, wr, wc, fr, fq); S.done(cur); }
        if (!has_next) break;
#pragma unroll
        for (int a = 0; a < 2; ++a)
#pragma unroll
            for (int b = 0; b < 2; ++b)
#pragma unroll
                for (int m = 0; m < 4; ++m)
#pragma unroll
                    for (int n = 0; n < 2; ++n) acc[a][b][m][n] = (f32x4){0.f, 0.f, 0.f, 0.f};
        cur = nxt; cA = nA; cB = nB; ++ui;
        if constexpr (ALIGN_EPI) { if (wr == 1) PG8_BAR; }
    }
    PG8_WAIT_V(0);
    if constexpr (!ALIGN_EPI) { if (wr == 0) PG8_BAR; }
    PG8_BAR;
    if constexpr (Epi::AFTER_DRAIN) { E.fused(acc, cur, wr, wc, fr, fq, lds, wid, lane); S.done(cur); }
#undef PG8_SA
#undef PG8_SB
#undef PG8_STAGE
#undef PG8_LDA
#undef PG8_LDB
#undef PG8_MMA
#undef PG8_WAIT_V
#undef PG8_WAIT_L
#undef PG8_BAR
#undef PG8_SCHED
}
}

#define LAS __attribute__((address_space(3)))
typedef unsigned v4u __attribute__((ext_vector_type(4)));
__device__ __forceinline__ unsigned pk2(float lo, float hi) { return f2bf(lo) | (f2bf(hi) << 16); }
__device__ __forceinline__ void transpose_item(const float* W, int K, int N, bf16* WT, float* scr, int item, int nblk, int lane) {
    const int kb = item / nblk, nb = item % nblk, k0 = 64 * kb, n0 = 32 * nb;
    const int nn = n0 + (lane & 31);
#pragma unroll 8
    for (int i = 0; i < 32; ++i) { const int kk = 2 * i + (lane >> 5); scr[kk * 33 + (lane & 31)] = (nn < N) ? W[(size_t)(k0 + kk) * N + nn] : 0.f; }
    __builtin_amdgcn_s_waitcnt(0xc07f); asm volatile("" ::: "memory");
    const int c = lane & 7;
#pragma unroll
    for (int j = 0; j < 4; ++j) { const int n = (lane >> 3) + 8 * j; const float* sp = scr + (8 * c) * 33 + n;
        v4u o; o.x = pk2(sp[0 * 33], sp[1 * 33]); o.y = pk2(sp[2 * 33], sp[3 * 33]); o.z = pk2(sp[4 * 33], sp[5 * 33]); o.w = pk2(sp[6 * 33], sp[7 * 33]);
        *(v4u*)(WT + (size_t)(n0 + n) * K + k0 + 8 * c) = o; }
    __builtin_amdgcn_s_waitcnt(0xc07f); asm volatile("" ::: "memory");
}
__device__ __forceinline__ void cvt_bf16(const float* src, bf16* dst, size_t n) {
    for (size_t e = ((size_t)bidx() * NT + tidx()) * 8; e < n; e += (size_t)gridDim.x * NT * 8) {
        const f32x4 a = *(const f32x4*)(src + e), b = *(const f32x4*)(src + e + 4);
        v4u o; o.x = pk2(a.x, a.y); o.y = pk2(a.z, a.w); o.z = pk2(b.x, b.y); o.w = pk2(b.z, b.w);
        *(v4u*)(dst + e) = o; }
}
__device__ __forceinline__ void transpose_matrix(const float* W, int K, int N, int Npad, bf16* WT, float* scr, int gw, int ngw, int lane) {
    const int nblk = Npad / 32, nit = (K / 64) * nblk;
    for (int it = gw; it < nit; it += ngw) transpose_item(W, K, N, WT, scr, it, nblk, lane);
}
__device__ __forceinline__ void ph_prologue(unsigned char* smem) {
    const int lane = tidx() & 63, wave = tidx() >> 6;
    float* scr = (float*)smem + wave * (64 * 33);
    const int gw = bidx() * (NT / 64) + wave, ngw = gridDim.x * (NT / 64);
    unsigned char* ws = WSP;
    transpose_matrix(IN(6), 1024, AB_N, AB_LD, (bf16*)(ws + WS_WAB_IN), scr, gw, ngw, lane);
    transpose_matrix(IN(7), 1024, 1024, 1024, (bf16*)(ws + WS_WAB_OUT), scr, gw, ngw, lane);
    transpose_matrix(IN(12), 1024, 3072, 3072, (bf16*)(ws + WS_WC_IN), scr, gw, ngw, lane);
    transpose_matrix(IN(13), 1024, 1024, 1024, (bf16*)(ws + WS_WC_OUT), scr, gw, ngw, lane);
#pragma unroll 1
    for (int L = 0; L < 2; ++L) {
        transpose_matrix(IN(16) + (size_t)L * DM * 2048, 1024, 2048, 2048, (bf16*)(ws + WS_WQ + (size_t)L * 4 * MiB), scr, gw, ngw, lane);
        transpose_matrix(IN(20) + (size_t)L * DM * DM, 1024, 1024, 1024, (bf16*)(ws + WS_WG + (size_t)L * 2 * MiB), scr, gw, ngw, lane);
        transpose_matrix(IN(21) + (size_t)L * 256 * DM, 256, 1024, 1024, (bf16*)(ws + WS_WUP + (size_t)L * (MiB / 2)), scr, gw, ngw, lane);
    }
    cvt_bf16(IN(1), (bf16*)(ws + WS_P), (size_t)2 * T * 256);
    cvt_bf16(IN(17), (bf16*)(ws + WS_SUBK), (size_t)2 * 16 * 128 * 128);
}

namespace cg = cooperative_groups;
constexpr int LDS_BYTES = 147456;
#define GEMM_PHASE(EPI, Aptr, Bptr, Nn, Kk, ...) do { pg8::Gemm g_{(const pg8::bf16_t*)(Aptr), (const pg8::bf16_t*)(Bptr), T, (Nn), (Kk)}; pg8::StaticOrder S_; S_.init(T, (Nn), (int)gridDim.x, (int)bidx()); \
    pg8::EPI E_{__VA_ARGS__}; pg8::gemm_phase<pg8::EPI, pg8::StaticOrder, true, true>((PG8_LAS unsigned char*)smem, g_, S_, E_); } while (0)
__global__ void __launch_bounds__(NT, 2) k_mega(Params P) {
    extern __shared__ __attribute__((aligned(16))) unsigned char smem[];
    cg::grid_group grid = cg::this_grid();
#define BAR() grid.sync()
    ph_prologue(smem);
    ph_rmsnorm(IN(0), IN(3), (bf16*)(WSP + WS_XN)); BAR();
    { unsigned char* ws = WSP; GEMM_PHASE(EBf16, ws + WS_XN, ws + WS_WAB_IN, AB_LD, DM, (bf16*)(ws + WS_QKV), AB_LD); } BAR();
    ph_prep0((bf16*)(WSP + WS_QKV), (const int*)IN(2), IN(8), IN(9), IN(10), IN(11)); BAR();
    { unsigned char* ws = WSP; ph_kmean((bf16*)(ws + WS_QKV), (float*)(ws + WS_KMEAN)); } BAR();
    { unsigned char* ws = WSP; ph_moba_select((bf16*)(ws + WS_QKV), (float*)(ws + WS_KMEAN), (unsigned*)(ws + WS_SEL)); } BAR();
    { unsigned char* ws = WSP; ph_moba_attend((bf16*)(ws + WS_QKV), (unsigned*)(ws + WS_SEL), (bf16*)(ws + WS_XN), smem); }
    { unsigned char* ws = WSP; ph_dsa_select((bf16*)(ws + WS_QKV), (unsigned long long*)(ws + WS_MASK), smem); } BAR();
    { unsigned char* ws = WSP; ph_dsa_attend((bf16*)(ws + WS_QKV), (unsigned long long*)(ws + WS_MASK), (bf16*)(ws + WS_XN), smem); } BAR();
    { unsigned char* ws = WSP; GEMM_PHASE(EResAdd, ws + WS_XN, ws + WS_WAB_OUT, DM, DM, IN(0), OUTP); } BAR();
#pragma unroll 1
    for (int L = 0; L < 2; ++L) {
        if (L == 1) {
            ph_rmsnorm(OUTP, IN(3) + DM, (bf16*)(WSP + WS_XN)); BAR();
            { unsigned char* ws = WSP; GEMM_PHASE(EBf16, ws + WS_XN, ws + WS_WC_IN, C_LD, DM, (bf16*)(ws + WS_QKV1), C_LD); } BAR();
            ph_prep1((bf16*)(WSP + WS_QKV1), (const int*)IN(2), IN(14), IN(15)); BAR();
            { unsigned char* ws = WSP; ph_dilated((bf16*)(ws + WS_QKV1), (bf16*)(ws + WS_OG), (float*)(ws + WS_LSE)); } BAR();
            { unsigned char* ws = WSP; ph_dil_merge((bf16*)(ws + WS_OG), (float*)(ws + WS_LSE), (bf16*)(ws + WS_XN)); } BAR();
            { unsigned char* ws = WSP; float* hb = OUTP; GEMM_PHASE(EResAdd, ws + WS_XN, ws + WS_WC_OUT, DM, DM, hb, hb); } BAR();
        }
        ph_rmsnorm(OUTP, IN(4) + L * DM, (bf16*)(WSP + WS_XN)); BAR();
        { unsigned char* ws = WSP; GEMM_PHASE(EBf16, ws + WS_XN, ws + WS_WQ + (size_t)L * 4 * MiB, 2048, DM, (bf16*)(ws + WS_QRY), 2048); } BAR();
        { unsigned char* ws = WSP; ph_peer_route((bf16*)(ws + WS_QRY), IN(17) + (size_t)L * 16 * 128 * 128, (int*)(ws + WS_EIDX), (float*)(ws + WS_GW), smem); } BAR();
        { unsigned char* ws = WSP; ph_peer_gather((bf16*)(ws + WS_XN), (int*)(ws + WS_EIDX), (float*)(ws + WS_GW), IN(18) + (size_t)L * NEXP * DM, IN(19) + (size_t)L * NEXP * DM, OUTP, smem); } BAR();
        ph_rmsnorm(OUTP, IN(5) + L * DM, (bf16*)(WSP + WS_XN));
        { unsigned char* ws = WSP; GEMM_PHASE(EBf16, ws + WS_P + (size_t)L * T * 256 * 2, ws + WS_WUP + (size_t)L * (MiB / 2), DM, 256, (bf16*)(ws + WS_UP), DM); } BAR();
        { unsigned char* ws = WSP; GEMM_PHASE(EGate, ws + WS_XN, ws + WS_WG + (size_t)L * 2 * MiB, DM, DM, OUTP, (bf16*)(ws + WS_UP)); } BAR();
    }
}

extern "C" void kernel_launch(void* const* d_in, const int* in_sizes, int n_in, void* d_out, int out_size, void* d_ws, size_t ws_size, hipStream_t stream) {
    static int grid_blocks = 0;
    if (grid_blocks == 0) {
        if (n_in != 22 || out_size != T * DM || ws_size < WS_END) { fprintf(stderr, "kernel_launch: unexpected shapes: n_in %d out %d ws %zu\n", n_in, out_size, ws_size); grid_blocks = -1; return; }
        if (hipFuncSetAttribute((const void*)k_mega, hipFuncAttributeMaxDynamicSharedMemorySize, LDS_BYTES) != hipSuccess) { fprintf(stderr, "hipFuncSetAttribute failed\n"); grid_blocks = -1; return; }
        int dev = 0, cus = 0, per_cu = 0;
        hipGetDevice(&dev);
        hipDeviceGetAttribute(&cus, hipDeviceAttributeMultiprocessorCount, dev);
        hipOccupancyMaxActiveBlocksPerMultiprocessor(&per_cu, (const void*)k_mega, NT, LDS_BYTES);
        if (per_cu < 1 || cus < 1) { fprintf(stderr, "kernel_launch: occupancy query says %d blocks/CU on %d CUs\n", per_cu, cus); grid_blocks = -1; return; }
        grid_blocks = cus;
    }
    if (grid_blocks < 0) return;
    Params P{};
    for (int i = 0; i < 22; ++i) P.in[i] = (const float*)d_in[i];
    P.out = (float*)d_out; P.ws = (unsigned char*)d_ws;
    void* args[] = {&P};
    hipError_t e = hipLaunchCooperativeKernel((const void*)k_mega, dim3(grid_blocks), dim3(NT), args, LDS_BYTES, stream);
    if (e != hipSuccess) fprintf(stderr, "cooperative launch failed: %s (grid %d)\n", hipGetErrorString(e), grid_blocks);
}
```

```cpp
#include <hip/hip_runtime.h>
#include <hip/hip_cooperative_groups.h>
#include <cstdio>
#include <cstdint>

constexpr int BATCH = 2, SEQ = 8192, T = BATCH * SEQ, DM = 1024;
constexpr int AB_N = 3396, AB_LD = 3584;
constexpr int CQA = 0, CKA = 512, CVA = 1024, CQB = 1536, CKB = 2048, CVB = 2560, CQI = 3072, CKI = 3328, CWI = 3392;
constexpr int C_LD = 3072;
constexpr int NEXP = 16384;
constexpr float NORM_EPS = 1e-6f;
constexpr float C2 = 0.125f * 1.4426950408889634f;
constexpr int NT = 512;

constexpr size_t MiB = 1u << 20;
constexpr size_t WS_CTL = 0;
constexpr size_t WS_WAB_IN = 1 * MiB, WS_WAB_OUT = 8 * MiB, WS_WC_IN = 10 * MiB, WS_WC_OUT = 16 * MiB;
constexpr size_t WS_WQ = 18 * MiB, WS_WG = 26 * MiB, WS_WUP = 30 * MiB, WS_SUBK = 31 * MiB;
constexpr size_t WS_KMEAN = 32 * MiB;
constexpr size_t WS_SEL = 33 * MiB;
constexpr size_t WS_LSE = 34 * MiB;
constexpr size_t WS_EIDX = 37 * MiB;
constexpr size_t WS_GW = 45 * MiB;
constexpr size_t WS_P = 53 * MiB;
constexpr size_t WS_XN = 69 * MiB;
constexpr size_t WS_QKV = 101 * MiB;
constexpr size_t WS_MASK = 213 * MiB;
constexpr size_t WS_SCORES = 229 * MiB;
constexpr size_t WS_EXP = 229 * MiB;
constexpr size_t WS_QRY = 101 * MiB;
constexpr size_t WS_UP = 165 * MiB;
constexpr size_t WS_QKV1 = 357 * MiB;
constexpr size_t WS_OG = 101 * MiB;
constexpr size_t WS_END = 512 * MiB;

typedef unsigned short bf16;
typedef float f32x4 __attribute__((ext_vector_type(4)));

__device__ __forceinline__ unsigned f2bf(float f) { unsigned u = __builtin_bit_cast(unsigned, f); return (u + 0x7fffu + ((u >> 16) & 1u)) >> 16; }
__device__ __forceinline__ float bf2f(bf16 h) { return __builtin_bit_cast(float, (unsigned)h << 16); }
__device__ __forceinline__ float wave_sum(float v) {
#pragma unroll
    for (int o = 1; o < 64; o <<= 1) v += __shfl_xor(v, o);
    return v;
}
__device__ __forceinline__ float wave_max(float v) {
#pragma unroll
    for (int o = 1; o < 64; o <<= 1) v = fmaxf(v, __shfl_xor(v, o));
    return v;
}
__device__ __forceinline__ unsigned okey(float f) { unsigned u = __builtin_bit_cast(unsigned, f); return (u & 0x80000000u) ? ~u : (u | 0x80000000u); }

__device__ __forceinline__ int tidx() { int t = __builtin_amdgcn_workitem_id_x(); asm volatile("" : "+v"(t)); return t; }
__device__ __forceinline__ int bidx() { int b = __builtin_amdgcn_workgroup_id_x(); asm volatile("" : "+s"(b)); return b; }
struct Params {
    const float* in[22];
    float* out;
    unsigned char* ws;
    int layer;
    int pad;
};

typedef const __attribute__((address_space(4))) unsigned long long* karg_t;
__device__ __forceinline__ unsigned long long karg(int idx) { karg_t ka = (karg_t)__builtin_amdgcn_kernarg_segment_ptr(); asm volatile("" : "+s"(ka)); return ka[idx]; }
#define IN(i) ((const float*)karg(i))
#define OUTP ((float*)karg(22))
#define WSP ((unsigned char*)karg(23))

__device__ __forceinline__ void ph_rmsnorm(const float* src, const float* gain, bf16* dst) {
    const int lane = tidx() & 63, wave = tidx() >> 6;
    const int gw = bidx() * (NT / 64) + wave, ngw = gridDim.x * (NT / 64);
    for (int r = gw; r < T; r += ngw) {
        const f32x4* xr = (const f32x4*)(src + (size_t)r * DM) + lane;
        f32x4 v[4]; float s = 0.f;
#pragma unroll
        for (int j = 0; j < 4; ++j) { v[j] = xr[64 * j]; s += v[j].x * v[j].x + v[j].y * v[j].y + v[j].z * v[j].z + v[j].w * v[j].w; }
        const float rstd = 1.0f / sqrtf(wave_sum(s) * (1.0f / DM) + NORM_EPS);
#pragma unroll
        for (int j = 0; j < 4; ++j) {
            const f32x4 g = ((const f32x4*)gain)[lane + 64 * j];
            unsigned long long o = (unsigned long long)(f2bf(v[j].x * rstd * g.x) | (f2bf(v[j].y * rstd * g.y) << 16)) |
                                   ((unsigned long long)(f2bf(v[j].z * rstd * g.z) | (f2bf(v[j].w * rstd * g.w) << 16)) << 32);
            ((unsigned long long*)(dst + (size_t)r * DM))[lane + 64 * j] = o;
        }
    }
}

template <class AT> __device__ __forceinline__ float ldA(const AT* p);
template <> __device__ __forceinline__ float ldA<bf16>(const bf16* p) { return bf2f(*p); }
template <> __device__ __forceinline__ float ldA<float>(const float* p) { return *p; }

template <class AT, class Epi> __forceinline__
__device__ __forceinline__ void ph_gemm_naive(const AT* A, int lda, const float* B, int N, int K, const Epi& E, unsigned char* smem) {
    float* As = (float*)smem;
    float* Bs = As + 16 * 132;
    const int tid = tidx(), ty = tid >> 5, tx = tid & 31;
    const int ntn = (N + 127) / 128, ntm = T / 128, ntile = ntn * ntm;
    for (int tile = bidx(); tile < ntile; tile += gridDim.x) {
        const int tm = tile / ntn, tn = tile % ntn, m0 = tm * 128, n0 = tn * 128;
        float acc[8][4];
#pragma unroll
        for (int i = 0; i < 8; ++i)
#pragma unroll
            for (int j = 0; j < 4; ++j) acc[i][j] = 0.f;
        for (int k0 = 0; k0 < K; k0 += 16) {
            __syncthreads();
#pragma unroll
            for (int i = 0; i < 4; ++i) { const int e = tid + i * NT, r = e >> 4, kk = e & 15; As[kk * 132 + r] = ldA<AT>(A + (size_t)(m0 + r) * lda + k0 + kk); }
#pragma unroll
            for (int i = 0; i < 4; ++i) { const int e = tid + i * NT, kk = e >> 7, c = e & 127; Bs[kk * 128 + c] = (n0 + c < N) ? B[(size_t)(k0 + kk) * N + n0 + c] : 0.f; }
            __syncthreads();
#pragma unroll 2
            for (int kk = 0; kk < 16; ++kk) {
                float a[8], b[4];
#pragma unroll
                for (int i = 0; i < 8; ++i) a[i] = As[kk * 132 + ty * 8 + i];
#pragma unroll
                for (int j = 0; j < 4; ++j) b[j] = Bs[kk * 128 + tx * 4 + j];
#pragma unroll
                for (int i = 0; i < 8; ++i)
#pragma unroll
                    for (int j = 0; j < 4; ++j) acc[i][j] += a[i] * b[j];
            }
        }
#pragma unroll
        for (int i = 0; i < 8; ++i) {
            const int col = n0 + tx * 4;
            if (col < N) E.store4(m0 + ty * 8 + i, col, (f32x4){acc[i][0], acc[i][1], acc[i][2], acc[i][3]});
        }
    }
}
struct EpBf16 { bf16* O; int ldc;
    __device__ __forceinline__ void store4(int r, int c, f32x4 v) const {
        unsigned long long o = (unsigned long long)(f2bf(v.x) | (f2bf(v.y) << 16)) | ((unsigned long long)(f2bf(v.z) | (f2bf(v.w) << 16)) << 32);
        *(unsigned long long*)(O + (size_t)r * ldc + c) = o; } };
struct EpResAdd { const float* base; float* out;
    __device__ __forceinline__ void store4(int r, int c, f32x4 v) const {
        const f32x4 b = *(const f32x4*)(base + (size_t)r * DM + c); *(f32x4*)(out + (size_t)r * DM + c) = b + v; } };
struct EpGate { float* h; const bf16* up;
    __device__ __forceinline__ void store4(int r, int c, f32x4 v) const {
        f32x4 hv = *(const f32x4*)(h + (size_t)r * DM + c); const bf16* u = up + (size_t)r * DM + c;
        hv.x += bf2f(u[0]) / (1.f + __expf(-v.x)); hv.y += bf2f(u[1]) / (1.f + __expf(-v.y));
        hv.z += bf2f(u[2]) / (1.f + __expf(-v.z)); hv.w += bf2f(u[3]) / (1.f + __expf(-v.w));
        *(f32x4*)(h + (size_t)r * DM + c) = hv; } };

__device__ __forceinline__ void rope_cs(int pos, int i, float& c, float& s) {
    const float inv = exp2f(-(float)i * 0.125f * 18.931568569324174f);
    const float ang = (float)pos * inv;
    const float k = rintf(ang * 0.15915494309189535f);
    float r = fmaf(-k, 6.28125f, ang); r = fmaf(-k, 1.9353071795864769e-3f, r);
    c = cosf(r); s = sinf(r);
}
__device__ __forceinline__ void prep_head(bf16* p, const float* gain, int pos, float scale, bool donorm, int lane) {
    float v = bf2f(p[lane]);
    if (donorm) { const float ss = wave_sum(v * v); v = v * (1.0f / sqrtf(ss * (1.0f / 64.f) + NORM_EPS)) * gain[lane]; }
    const float partner = __shfl_xor(v, 8);
    float c = 1.f, s = 0.f;
    if (lane < 16) rope_cs(pos, lane & 7, c, s);
    float o = v;
    if (lane < 8) o = v * c - partner * s; else if (lane < 16) o = v * c + partner * s;
    p[lane] = (bf16)f2bf(o * scale);
}
__device__ __forceinline__ void ph_prep0(bf16* qkv, const int* positions, const float* aq, const float* ak, const float* bq, const float* bk) {
    const int lane = tidx() & 63, wave = tidx() >> 6;
    const int gw = bidx() * (NT / 64) + wave, ngw = gridDim.x * (NT / 64);
    for (int r = gw; r < T; r += ngw) {
        const int pos = positions[r]; bf16* row = qkv + (size_t)r * AB_LD;
        for (int h = 0; h < 8; ++h) {
            prep_head(row + CQA + h * 64, aq, pos, C2, true, lane);
            prep_head(row + CKA + h * 64, ak, pos, 1.f, true, lane);
            prep_head(row + CQB + h * 64, bq, pos, C2, true, lane);
            prep_head(row + CKB + h * 64, bk, pos, 1.f, true, lane);
        }
        for (int h = 0; h < 4; ++h) prep_head(row + CQI + h * 64, nullptr, pos, 1.f, false, lane);
        prep_head(row + CKI, nullptr, pos, 1.f, false, lane);
    }
}
__device__ __forceinline__ void ph_prep1(bf16* qkv, const int* positions, const float* cq, const float* ck) {
    const int lane = tidx() & 63, wave = tidx() >> 6;
    const int gw = bidx() * (NT / 64) + wave, ngw = gridDim.x * (NT / 64);
    for (int r = gw; r < T; r += ngw) {
        const int pos = positions[r]; bf16* row = qkv + (size_t)r * C_LD;
        for (int h = 0; h < 16; ++h) {
            prep_head(row + h * 64, cq, pos, C2, true, lane);
            prep_head(row + 1024 + h * 64, ck, pos, 1.f, true, lane);
        }
    }
}
__device__ __forceinline__ void ph_kmean(const bf16* qkv, float* kmean) {
    const int lane = tidx() & 63, wave = tidx() >> 6;
    const int gw = bidx() * (NT / 64) + wave, ngw = gridDim.x * (NT / 64);
    for (int it = gw; it < BATCH * 8 * 32; it += ngw) {
        const int b = it / 256, h = (it / 32) % 8, n = it % 32;
        float s = 0.f;
        for (int r = 0; r < 256; ++r) s += bf2f(qkv[(size_t)(b * SEQ + n * 256 + r) * AB_LD + CKA + h * 64 + lane]);
        kmean[(size_t)it * 64 + lane] = s * (1.0f / 256.f);
    }
}
__device__ __forceinline__ void ph_moba_select(const bf16* qkv, const float* kmean, unsigned* sel) {
    for (int it = bidx() * NT + tidx(); it < T * 8; it += gridDim.x * NT) {
        const int t = it >> 3, h = it & 7, b = t / SEQ, qblk = (t % SEQ) / 256;
        float q[64];
#pragma unroll
        for (int d = 0; d < 64; ++d) q[d] = bf2f(qkv[(size_t)t * AB_LD + CQA + h * 64 + d]);
        float v0 = -3e38f, v1 = -3e38f, v2 = -3e38f; int i0 = 255, i1 = 255, i2 = 255;
        for (int n = 0; n < qblk; ++n) {
            const float* km = kmean + (size_t)((b * 8 + h) * 32 + n) * 64; float g = 0.f;
#pragma unroll
            for (int d = 0; d < 64; ++d) g += q[d] * km[d];
            if (g > v0) { v2 = v1; i2 = i1; v1 = v0; i1 = i0; v0 = g; i0 = n; }
            else if (g > v1) { v2 = v1; i2 = i1; v1 = g; i1 = n; }
            else if (g > v2) { v2 = g; i2 = n; }
        }
        sel[it] = (unsigned)i0 | ((unsigned)i1 << 8) | ((unsigned)i2 << 16) | (255u << 24);
    }
}
__device__ __forceinline__ void ph_moba_attend(const bf16* qkv, const unsigned* sel, bf16* O, unsigned char* smem) {
    const int lane = tidx() & 63, wave = tidx() >> 6;
    float* pl = (float*)smem + wave * 1024;
    const int gw = bidx() * (NT / 64) + wave, ngw = gridDim.x * (NT / 64);
    for (int it = gw; it < T * 8; it += ngw) {
        const int t = it >> 3, h = it & 7, b = t / SEQ, tt = t % SEQ, qblk = tt / 256;
        const unsigned sw = sel[it];
        int blk[4] = {qblk, (int)(sw & 255), (int)((sw >> 8) & 255), (int)((sw >> 16) & 255)};
        const bf16* qp = qkv + (size_t)t * AB_LD + CQA + h * 64;
        float q[64];
#pragma unroll
        for (int d = 0; d < 64; ++d) q[d] = bf2f(qp[d]);
        float sc[16]; float mx = -3e38f;
#pragma unroll
        for (int s = 0; s < 4; ++s) {
#pragma unroll
            for (int i = 0; i < 4; ++i) {
                const int j = lane + 64 * i, pos = blk[s] * 256 + j;
                const bool ok = (blk[s] != 255) && (s > 0 || pos <= tt);
                float a = -3e38f;
                if (ok) { const bf16* kp = qkv + (size_t)(b * SEQ + pos) * AB_LD + CKA + h * 64; a = 0.f;
#pragma unroll
                    for (int d = 0; d < 64; ++d) a += q[d] * bf2f(kp[d]); }
                sc[s * 4 + i] = a; mx = fmaxf(mx, a);
            }
        }
        mx = wave_max(mx); float l = 0.f;
#pragma unroll
        for (int e = 0; e < 16; ++e) { const float p = (sc[e] > -1e38f) ? exp2f(sc[e] - mx) : 0.f; l += p; pl[(e >> 2) * 256 + lane + 64 * (e & 3)] = p; }
        l = wave_sum(l);
        __builtin_amdgcn_s_waitcnt(0);
        float o = 0.f;
#pragma unroll
        for (int s = 0; s < 4; ++s) {
            if (blk[s] == 255) continue;
            const int nk = (s == 0) ? (tt - qblk * 256 + 1) : 256;
            const bf16* vp = qkv + (size_t)(b * SEQ + blk[s] * 256) * AB_LD + CVA + h * 64 + lane;
            for (int j = 0; j < nk; ++j) o += pl[s * 256 + j] * bf2f(vp[(size_t)j * AB_LD]);
        }
        O[(size_t)t * DM + h * 64 + lane] = (bf16)f2bf(o / l);
    }
}
__device__ __forceinline__ void ph_dsa_select(const bf16* qkv, unsigned long long* mask, unsigned char* smem) {
    unsigned* keys = (unsigned*)smem;
    unsigned* cnt = keys + 8192;
    const int tid = tidx(), lane = tid & 63;
    for (int t = bidx(); t < T; t += gridDim.x) {
        const int b = t / SEQ, tt = t % SEQ, n = tt + 1;
        __syncthreads();
        const bf16* row = qkv + (size_t)t * AB_LD;
        float* qf = (float*)(cnt + 4);
        if (tid < 256) qf[tid] = bf2f(row[CQI + tid]);
        if (tid < 4) qf[256 + tid] = bf2f(row[CWI + tid]);
        __syncthreads();
        for (int kv = tid; kv < 8192; kv += NT) {
            unsigned key = 0u;
            if (kv < n) {
                const bf16* kp = qkv + (size_t)(b * SEQ + kv) * AB_LD + CKI;
                float a0 = 0.f, a1 = 0.f, a2 = 0.f, a3 = 0.f;
                for (int d = 0; d < 64; ++d) { const float kd = bf2f(kp[d]); a0 += qf[d] * kd; a1 += qf[64 + d] * kd; a2 += qf[128 + d] * kd; a3 += qf[192 + d] * kd; }
                const float s = ((qf[256] * fmaxf(a0, 0.f) + qf[257] * fmaxf(a1, 0.f)) + qf[258] * fmaxf(a2, 0.f)) + qf[259] * fmaxf(a3, 0.f);
                key = okey(s);
            }
            keys[kv] = key;
        }
        __syncthreads();
        unsigned thr = 0u, need = 0u;
        if (n > 256) {
            unsigned lo = 0u, hi = 0xFFFFFFFFu;
            while (lo < hi) {
                const unsigned mid = lo + ((hi - lo) >> 1) + ((hi - lo) & 1u);
                if (tid == 0) cnt[0] = 0u;
                __syncthreads();
                unsigned c = 0;
                for (int kv = tid; kv < 8192; kv += NT) c += (keys[kv] >= mid) ? 1u : 0u;
                c = (unsigned)wave_sum((float)c);
                if (lane == 0) atomicAdd(&cnt[0], c);
                __syncthreads();
                const unsigned tot = cnt[0];
                __syncthreads();
                if (tot >= 256u) lo = mid; else hi = mid - 1u;
            }
            thr = lo;
            if (tid == 0) cnt[1] = 0u;
            __syncthreads();
            unsigned c = 0;
            for (int kv = tid; kv < 8192; kv += NT) c += (keys[kv] > thr) ? 1u : 0u;
            c = (unsigned)wave_sum((float)c);
            if (lane == 0) atomicAdd(&cnt[1], c);
            __syncthreads();
            need = 256u - cnt[1];
        }
        if (tid < 64) {
            const int ntile = 4 * (tt / 256 + 1);
            unsigned taken = 0u;
            for (int j = 0; j < ntile; ++j) {
                const int kv = j * 64 + lane; const unsigned key = keys[kv];
                bool s;
                if (n <= 256) s = kv < n;
                else {
                    const bool gt = key > thr, eq = (key == thr) && (kv < n);
                    const unsigned long long em = __ballot(eq);
                    const unsigned rank = taken + (unsigned)__popcll(em & ((1ull << lane) - 1ull));
                    s = gt || (eq && rank < need);
                    taken += (unsigned)__popcll(em);
                }
                const unsigned long long m = __ballot(s);
                if (lane == 0) mask[((size_t)(b * 128 + j)) * SEQ + tt] = m;
            }
        }
    }
}
__device__ __forceinline__ void ph_dsa_attend(const bf16* qkv, const unsigned long long* mask, bf16* O, unsigned char* smem) {
    int* list = (int*)smem;
    int* cnt = list + 256;
    float* pr = (float*)(cnt + 4);
    float* linv = pr + 8 * 256;
    const int tid = tidx(), lane = tid & 63, wave = tid >> 6;
    for (int t = bidx(); t < T; t += gridDim.x) {
        const int b = t / SEQ, tt = t % SEQ;
        __syncthreads();
        const int ntile = 4 * (tt / 256 + 1);
        if (wave == 0) {
            int base = 0;
            for (int j = 0; j < ntile; ++j) {
                const unsigned long long m = mask[((size_t)(b * 128 + j)) * SEQ + tt];
                const int p = base + (int)__popcll(m & ((1ull << lane) - 1ull));
                if (((m >> lane) & 1ull) && p < 256) list[p] = j * 64 + lane;
                base += (int)__popcll(m);
            }
            if (lane == 0) cnt[0] = base;
        }
        __syncthreads();
        const int ns = min(cnt[0], 256);
        const bf16* row = qkv + (size_t)t * AB_LD;
        for (int e = tid; e < 8 * 256; e += NT) {
            const int h = e >> 8, j = e & 255; float a = -3e38f;
            if (j < ns) { const bf16* kp = qkv + (size_t)(b * SEQ + list[j]) * AB_LD + CKB + h * 64; a = 0.f;
                for (int d = 0; d < 64; ++d) a += bf2f(row[CQB + h * 64 + d]) * bf2f(kp[d]); }
            pr[e] = a;
        }
        __syncthreads();
        {
            const int h = wave; float v[4]; float mx = -3e38f;
#pragma unroll
            for (int i = 0; i < 4; ++i) { v[i] = pr[h * 256 + lane + 64 * i]; mx = fmaxf(mx, v[i]); }
            mx = wave_max(mx); float l = 0.f;
#pragma unroll
            for (int i = 0; i < 4; ++i) { const float p = (v[i] > -1e38f) ? exp2f(v[i] - mx) : 0.f; l += p; pr[h * 256 + lane + 64 * i] = p; }
            l = wave_sum(l); if (lane == 0) linv[h] = 1.0f / l;
        }
        __syncthreads();
        {   const int h = tid >> 6, d = tid & 63; float o = 0.f;
            for (int j = 0; j < ns; ++j) o += pr[h * 256 + j] * bf2f(qkv[(size_t)(b * SEQ + list[j]) * AB_LD + CVB + h * 64 + d]);
            O[(size_t)t * DM + 512 + h * 64 + d] = (bf16)f2bf(o * linv[h]); }
    }
}
__device__ __forceinline__ void ph_dilated(const bf16* qkv, bf16* OG, float* LSE) {
    const int lane = tidx() & 63, wave = tidx() >> 6;
    const int gw = bidx() * (NT / 64) + wave, ngw = gridDim.x * (NT / 64);
    for (int it = gw; it < T * 16; it += ngw) {
        const int t = it >> 4, h = it & 15, b = t / SEQ, tt = t % SEQ;
        const bf16* qp = qkv + (size_t)t * C_LD + h * 64;
        float q[64];
#pragma unroll
        for (int d = 0; d < 64; ++d) q[d] = bf2f(qp[d]);
        for (int g = 0; g < 3; ++g) {
            const int dil = (g == 0) ? 1 : (g == 1 ? 4 : 16);
            float sc[3]; float mx = -3e38f;
#pragma unroll
            for (int i = 0; i < 3; ++i) {
                const int j = lane + 64 * i, pos = tt - j * dil; float a = -3e38f;
                if (j <= 128 && pos >= 0) { const bf16* kp = qkv + (size_t)(b * SEQ + pos) * C_LD + 1024 + h * 64; a = 0.f;
#pragma unroll
                    for (int d = 0; d < 64; ++d) a += q[d] * bf2f(kp[d]); }
                sc[i] = a; mx = fmaxf(mx, a);
            }
            mx = wave_max(mx); float l = 0.f; float p[3];
#pragma unroll
            for (int i = 0; i < 3; ++i) { p[i] = (sc[i] > -1e38f) ? exp2f(sc[i] - mx) : 0.f; l += p[i]; }
            l = wave_sum(l);
            float o = 0.f;
            for (int j = 0; j <= 128; ++j) {
                const int pos = tt - j * dil; if (pos < 0) break;
                const float pj = (j < 64) ? __shfl(p[0], j) : ((j < 128) ? __shfl(p[1], j - 64) : __shfl(p[2], 0));
                o += pj * bf2f(qkv[(size_t)(b * SEQ + pos) * C_LD + 2048 + h * 64 + lane]);
            }
            OG[((size_t)g * T + t) * DM + h * 64 + lane] = (bf16)f2bf(o / l);
            if (lane == 0) LSE[((size_t)g * T + t) * 16 + h] = mx + log2f(l);
        }
    }
}
__device__ __forceinline__ void ph_dil_merge(const bf16* OG, const float* LSE, bf16* O) {
    for (size_t e = (size_t)bidx() * NT + tidx(); e < (size_t)T * DM; e += (size_t)gridDim.x * NT) {
        const int t = (int)(e >> 10), c = (int)(e & 1023), h = c >> 6;
        const float l0 = LSE[((size_t)0 * T + t) * 16 + h], l1 = LSE[((size_t)1 * T + t) * 16 + h], l2 = LSE[((size_t)2 * T + t) * 16 + h];
        const float m = fmaxf(l0, fmaxf(l1, l2)); const float w0 = exp2f(l0 - m), w1 = exp2f(l1 - m), w2 = exp2f(l2 - m);
        const float o = (w0 * bf2f(OG[e]) + w1 * bf2f(OG[(size_t)T * DM + e]) + w2 * bf2f(OG[(size_t)2 * T * DM + e])) / (w0 + w1 + w2);
        O[e] = (bf16)f2bf(o);
    }
}
__device__ __forceinline__ void ph_peer_route(const bf16* qry, const float* subk, int* eidx, float* gw, unsigned char* smem) {
    float* s = (float*)smem;
    float* sv = s + 2048;
    int* si = (int*)(sv + 256);
    float* qf = (float*)(si + 256);
    const int tid = tidx(), lane = tid & 63, wave = tid >> 6;
    for (int t = bidx(); t < T; t += gridDim.x) {
        __syncthreads();
        for (int e = tid; e < 2048; e += NT) qf[e] = bf2f(qry[(size_t)t * 2048 + e]);
        __syncthreads();
        for (int e = tid; e < 2048; e += NT) {
            const int hc = e >> 7, k = e & 127; const float* kp = subk + ((size_t)hc * 128 + k) * 128; float a = 0.f;
            for (int d = 0; d < 128; ++d) a += qf[hc * 128 + d] * kp[d];
            s[e] = a;
        }
        __syncthreads();
        for (int hc = wave; hc < 16; hc += NT / 64) {
            float v0 = s[hc * 128 + lane], v1 = s[hc * 128 + 64 + lane];
            for (int r = 0; r < 16; ++r) {
                float bv = v0; int bi = lane;
                if (v1 > bv) { bv = v1; bi = lane + 64; }
#pragma unroll
                for (int o = 1; o < 64; o <<= 1) { const float ov = __shfl_xor(bv, o); const int oi = __shfl_xor(bi, o); if (ov > bv || (ov == bv && oi < bi)) { bv = ov; bi = oi; } }
                if (lane == 0) { sv[hc * 16 + r] = bv; si[hc * 16 + r] = bi; }
                if (bi == lane) v0 = -3e38f; if (bi == lane + 64) v1 = -3e38f;
            }
        }
        __syncthreads();
        {   const int h = wave;
            float c[4]; int ci[4];
#pragma unroll
            for (int i = 0; i < 4; ++i) { const int f = lane + 64 * i; c[i] = sv[(h * 2) * 16 + (f >> 4)] + sv[(h * 2 + 1) * 16 + (f & 15)]; ci[i] = f; }
            float cv[16]; int cf[16];
#pragma unroll
            for (int r = 0; r < 16; ++r) {
                float bv = c[0]; int bi = ci[0];
#pragma unroll
                for (int i = 1; i < 4; ++i) if (c[i] > bv) { bv = c[i]; bi = ci[i]; }
#pragma unroll
                for (int o = 1; o < 64; o <<= 1) { const float ov = __shfl_xor(bv, o); const int oi = __shfl_xor(bi, o); if (ov > bv || (ov == bv && oi < bi)) { bv = ov; bi = oi; } }
                cv[r] = bv; cf[r] = bi;
#pragma unroll
                for (int i = 0; i < 4; ++i) if (ci[i] == bi) c[i] = -3e38f;
            }
            float l = 0.f;
#pragma unroll
            for (int r = 0; r < 16; ++r) l += __expf(cv[r] - cv[0]);
            if (lane < 16) {
                float myv = 0.f; int myf = 0;
#pragma unroll
                for (int r = 0; r < 16; ++r) if (r == lane) { myv = cv[r]; myf = cf[r]; }
                eidx[(size_t)t * 128 + h * 16 + lane] = si[(h * 2) * 16 + (myf >> 4)] * 128 + si[(h * 2 + 1) * 16 + (myf & 15)];
                gw[(size_t)t * 128 + h * 16 + lane] = __expf(myv - cv[0]) / l;
            }
        }
    }
}
__device__ __forceinline__ float gelu_tanh(float x) { const float u = 0.7978845608028654f * (x + 0.044715f * x * x * x); return 0.5f * x * (1.f + tanhf(u)); }
__device__ __forceinline__ void ph_peer_gather(const bf16* xn, const int* eidx, const float* gw, const float* U, const float* V, float* h, unsigned char* smem) {
    float* xf = (float*)smem;
    float* w = xf + 1024;
    int* ei = (int*)(w + 128);
    const int tid = tidx(), lane = tid & 63, wave = tid >> 6;
    for (int t = bidx(); t < T; t += gridDim.x) {
        __syncthreads();
        for (int e = tid; e < 1024; e += NT) xf[e] = bf2f(xn[(size_t)t * DM + e]);
        if (tid < 128) ei[tid] = eidx[(size_t)t * 128 + tid];
        __syncthreads();
        for (int e = wave; e < 128; e += NT / 64) {
            const float* up = U + (size_t)ei[e] * DM; float a = 0.f;
            for (int d = lane; d < 1024; d += 64) a += xf[d] * up[d];
            a = wave_sum(a);
            if (lane == 0) w[e] = gw[(size_t)t * 128 + e] * gelu_tanh(a);
        }
        __syncthreads();
        for (int d = tid; d < 1024; d += NT) {
            float o = 0.f;
            for (int e = 0; e < 128; ++e) o += w[e] * V[(size_t)ei[e] * DM + d];
            h[(size_t)t * DM + d] += o;
        }
    }
}

namespace pg8 {
#define PG8_LAS __attribute__((address_space(3)))
typedef unsigned short bf16_t;
typedef short bf16x8 __attribute__((ext_vector_type(8)));
typedef float f32x4 __attribute__((ext_vector_type(4)));
typedef unsigned u32x4 __attribute__((ext_vector_type(4)));
constexpr int BM = 256, BK = 64, HALF = 128, HTB = HALF * BK * 2  , STAGE_BYTES = 8 * HTB, NXCD = 8, WGM = 8;

__host__ __device__ __forceinline__ int lds_byte(int r, int c) { const int st = (r >> 4) * 2 + (c >> 5), rr = r & 15, cc = c & 31, ob = rr * 64 + cc * 2; return st * 1024 + (ob ^ (((ob >> 9) & 1) << 5)); }
__host__ __device__ __forceinline__ void stage_rc(int b, int& R, int& C) { const int st = b / 1024, sb = b % 1024, swz = sb ^ (((sb >> 9) & 1) << 5); R = (st >> 1) * 16 + swz / 64; C = (st & 1) * 32 + (swz % 64) / 2; }
__host__ __device__ __forceinline__ int perm32(int rho) { const int n = rho >> 4, i = rho & 15; return 8 * (i >> 2) + 4 * n + (i & 3); }

struct Unit { int pm, pn; };
struct Gemm { const bf16_t* A; const bf16_t* Bt; int M, N, K; };

struct StaticOrder {
    int nM, nN, nwg, G, c;
    __host__ __device__ void init(int M, int N, int G_, int c_) { nM = M / BM; nN = N / BM; nwg = nM * nN; G = G_; c = c_; }
    __host__ __device__ bool next(int i, Unit& u) const {
        const long L = (long)i * G + c; if (L >= nwg) return false;
        int wgid = (int)L; { const int q = nwg / NXCD, r = nwg % NXCD, xcd = wgid % NXCD, off = wgid / NXCD; wgid = (xcd < r ? xcd * (q + 1) : r * (q + 1) + (xcd - r) * q) + off; }
        const int nig = WGM * nN, gid = wgid / nig, fm = gid * WGM, gsz = (nM - fm) < WGM ? (nM - fm) : WGM;
        u.pm = fm + ((wgid % nig) % gsz); u.pn = (wgid % nig) / gsz; return true;
    }
    __device__ __forceinline__ void a_ready(const Unit&) const {}
    __device__ __forceinline__ void done(const Unit&) const {}
};


__device__ __forceinline__ unsigned pk_bf16(float lo, float hi) { typedef float f2 __attribute__((ext_vector_type(2))); typedef __bf16 b2 __attribute__((ext_vector_type(2))); f2 v = {lo, hi}; b2 b = __builtin_convertvector(v, b2); return __builtin_bit_cast(unsigned, b); }
struct EBf16 {
    static constexpr bool PERM = true, AFTER_DRAIN = false; bf16_t* O; int ldc;
    __device__ __forceinline__ void operator()(const f32x4 (&acc)[2][2][4][2], const Unit& u, int wr, int wc, int fr, int fq) const {
        const int row0 = u.pm * BM + wr * 64 + fr, col0 = u.pn * BM + wc * 32 + 8 * fq;
#pragma unroll
        for (int ai = 0; ai < 2; ++ai)
#pragma unroll
            for (int m = 0; m < 4; ++m) { bf16_t* rowp = O + (size_t)(row0 + ai * HALF + m * 16) * ldc + col0;
#pragma unroll
                for (int bj = 0; bj < 2; ++bj) { const f32x4 v0 = acc[ai][bj][m][0], v1 = acc[ai][bj][m][1];
                    u32x4 w; w.x = pk_bf16(v0[0], v0[1]); w.y = pk_bf16(v0[2], v0[3]); w.z = pk_bf16(v1[0], v1[1]); w.w = pk_bf16(v1[2], v1[3]);
                    *(u32x4*)(rowp + bj * HALF) = w; } }
    }
};
struct EResAdd {
    static constexpr bool PERM = false, AFTER_DRAIN = false; const float* base; float* out;
    __device__ __forceinline__ void operator()(const f32x4 (&acc)[2][2][4][2], const Unit& u, int wr, int wc, int fr, int fq) const {
        const int col0 = u.pn * BM + wc * 32 + 4 * fq;
#pragma unroll
        for (int ai = 0; ai < 2; ++ai)
#pragma unroll
            for (int m = 0; m < 4; ++m) { const size_t off = (size_t)(u.pm * BM + ai * HALF + wr * 64 + m * 16 + fr) * 1024 + col0;
#pragma unroll
                for (int bj = 0; bj < 2; ++bj)
#pragma unroll
                    for (int n = 0; n < 2; ++n) { const f32x4 b = *(const f32x4*)(base + off + bj * HALF + n * 16); *(f32x4*)(out + off + bj * HALF + n * 16) = b + acc[ai][bj][m][n]; } }
    }
};
struct EGate {
    static constexpr bool PERM = false, AFTER_DRAIN = false; float* h; const bf16_t* up;
    __device__ __forceinline__ void operator()(const f32x4 (&acc)[2][2][4][2], const Unit& u, int wr, int wc, int fr, int fq) const {
        const int col0 = u.pn * BM + wc * 32 + 4 * fq;
#pragma unroll
        for (int ai = 0; ai < 2; ++ai)
#pragma unroll
            for (int m = 0; m < 4; ++m) { const size_t off = (size_t)(u.pm * BM + ai * HALF + wr * 64 + m * 16 + fr) * 1024 + col0;
#pragma unroll
                for (int bj = 0; bj < 2; ++bj)
#pragma unroll
                    for (int n = 0; n < 2; ++n) { const size_t o = off + bj * HALF + n * 16; f32x4 hv = *(const f32x4*)(h + o);
                        const unsigned long long uu = *(const unsigned long long*)(up + o); const f32x4 a = acc[ai][bj][m][n];
                        hv[0] += __builtin_bit_cast(float, (unsigned)(uu << 16)) / (1.f + __expf(-a[0]));
                        hv[1] += __builtin_bit_cast(float, (unsigned)(uu & 0xffff0000ull)) / (1.f + __expf(-a[1]));
                        hv[2] += __builtin_bit_cast(float, (unsigned)((uu >> 16) & 0xffff0000ull)) / (1.f + __expf(-a[2]));
                        hv[3] += __builtin_bit_cast(float, (unsigned)((uu >> 32) & 0xffff0000ull)) / (1.f + __expf(-a[3]));
                        *(f32x4*)(h + o) = hv; } }
    }
};
template <class Epi, class Sched, bool ALIGN_EPI = false, bool SP2 = false>
__device__ __forceinline__ void gemm_phase(PG8_LAS unsigned char* lds, const Gemm g, const Sched& S, const Epi& E) {
    const int tid = tidx(), wid = __builtin_amdgcn_readfirstlane(tid >> 6), lane = tid & 63, wr = wid >> 2, wc = wid & 3, fr = lane & 15, fq = lane >> 4;
    const int K = g.K, nt = K / BK;
    unsigned voffA[2], voffB[2];
#pragma unroll
    for (int i = 0; i < 2; ++i) { int R, C; stage_rc(tid * 16 + i * 8192, R, C); const int Rb = Epi::PERM ? ((R & ~31) + perm32(R & 31)) : R;
        voffA[i] = (unsigned)(R * K + C) * 2u; voffB[i] = (unsigned)(Rb * K + C) * 2u; }
    const size_t kstep = (size_t)(BK * 2);
    const size_t hstep = (size_t)HALF * K * 2;
    const size_t tstep = 2 * hstep;
    const unsigned ldsw = (unsigned)wid * 1024u;
    const int aoff = lds_byte(wr * 64 + fr, fq * 8), boff = lds_byte(wc * 32 + fr, fq * 8);
#define PG8_SA(b, h) (((b) * 2 + (h)) * HTB)
#define PG8_SB(b, h) ((4 + (b) * 2 + (h)) * HTB)
#define PG8_STAGE(bufoff, gbase, voff) do { _Pragma("unroll") for (int _i = 0; _i < 2; ++_i) \
        __builtin_amdgcn_global_load_lds((const unsigned*)((const char*)(gbase) + (voff)[_i]), (PG8_LAS unsigned*)(lds + (bufoff) + ldsw + _i * 8192), 16, 0, 0); } while (0)
#define PG8_LDA(dst, b, h) do { _Pragma("unroll") for (int m = 0; m < 4; ++m) _Pragma("unroll") for (int k = 0; k < 2; ++k) dst[m][k] = *(const PG8_LAS bf16x8*)(lds + PG8_SA(b, h) + aoff + m * 2048 + k * 1024); } while (0)
#define PG8_LDB(dst, b, h) do { _Pragma("unroll") for (int n = 0; n < 2; ++n) _Pragma("unroll") for (int k = 0; k < 2; ++k) dst[n][k] = *(const PG8_LAS bf16x8*)(lds + PG8_SB(b, h) + boff + n * 2048 + k * 1024); } while (0)
#define PG8_MMA(ai, bj, At, Bt) do { __builtin_amdgcn_s_setprio(1); _Pragma("unroll") for (int m = 0; m < 4; ++m) _Pragma("unroll") for (int n = 0; n < 2; ++n) _Pragma("unroll") for (int k = 0; k < 2; ++k) \
        acc[ai][bj][m][n] = __builtin_amdgcn_mfma_f32_16x16x32_bf16(Bt[n][k], At[m][k], acc[ai][bj][m][n], 0, 0, 0); __builtin_amdgcn_s_setprio(0); } while (0)
#define PG8_WAIT_V(n) asm volatile("s_waitcnt vmcnt(" #n ")" ::: "memory")
#define PG8_WAIT_L(n) asm volatile("s_waitcnt lgkmcnt(" #n ")" ::: "memory")
#define PG8_BAR __builtin_amdgcn_s_barrier()
#define PG8_SCHED __builtin_amdgcn_sched_barrier(0)
    Unit cur, nxt; int ui = 0;
    if (!S.next(0, cur)) return;
    f32x4 acc[2][2][4][2];
#pragma unroll
    for (int a = 0; a < 2; ++a)
#pragma unroll
        for (int b = 0; b < 2; ++b)
#pragma unroll
            for (int m = 0; m < 4; ++m)
#pragma unroll
                for (int n = 0; n < 2; ++n) acc[a][b][m][n] = (f32x4){0.f, 0.f, 0.f, 0.f};
    bf16x8 At[4][2], B0[2][2], B1[2][2];
    const char* cA = (const char*)g.A + (size_t)cur.pm * tstep; const char* cB = (const char*)g.Bt + (size_t)cur.pn * tstep;
    S.a_ready(cur);
    if constexpr (SP2) {
        PG8_STAGE(PG8_SB(0, 0), cB, voffB); PG8_STAGE(PG8_SB(0, 1), cB + hstep, voffB); PG8_STAGE(PG8_SA(0, 0), cA, voffA); PG8_STAGE(PG8_SA(0, 1), cA + hstep, voffA);
        if (wr == 1) PG8_BAR;
        PG8_WAIT_V(2); PG8_BAR;
        PG8_STAGE(PG8_SB(1, 0), cB + kstep, voffB); PG8_STAGE(PG8_SA(1, 0), cA + kstep, voffA); PG8_STAGE(PG8_SB(1, 1), cB + hstep + kstep, voffB);
        PG8_WAIT_V(6); PG8_BAR;
    } else {
        PG8_STAGE(PG8_SB(0, 0), cB, voffB); PG8_STAGE(PG8_SA(0, 0), cA, voffA); PG8_STAGE(PG8_SB(0, 1), cB + hstep, voffB); PG8_STAGE(PG8_SA(0, 1), cA + hstep, voffA);
        if (wr == 1) PG8_BAR;
        PG8_WAIT_V(4); PG8_BAR;
        PG8_STAGE(PG8_SB(1, 0), cB + kstep, voffB); PG8_STAGE(PG8_SA(1, 0), cA + kstep, voffA); PG8_STAGE(PG8_SB(1, 1), cB + hstep + kstep, voffB);
        PG8_WAIT_V(6); PG8_BAR;
    }
    for (;;) {
        const bool has_next = S.next(ui + 1, nxt);
        const char* nA = has_next ? (const char*)g.A + (size_t)nxt.pm * tstep : cA; const char* nB = has_next ? (const char*)g.Bt + (size_t)nxt.pn * tstep : cB;
        for (int t = 0; t < nt; t += 2) {
            const bool last = (t == nt - 2);
            const char* a1 = cA + (size_t)(t + 1) * kstep;
            const char* a2 = last ? nA : cA + (size_t)(t + 2) * kstep; const char* b2 = last ? nB : cB + (size_t)(t + 2) * kstep;
            const char* a3 = a2 + kstep; const char* b3 = b2 + kstep;
            if (last && has_next) S.a_ready(nxt);
            if constexpr (SP2) {
            PG8_LDB(B0, 0, 0); PG8_LDB(B1, 0, 1); PG8_SCHED; PG8_LDA(At, 0, 0); PG8_STAGE(PG8_SA(1, 1), a1 + hstep, voffA);
            PG8_WAIT_V(8); PG8_WAIT_L(0); PG8_BAR; PG8_MMA(0, 0, At, B0); PG8_MMA(0, 1, At, B1); PG8_BAR; PG8_SCHED;
            PG8_LDA(At, 0, 1); PG8_STAGE(PG8_SB(0, 0), b2, voffB); PG8_STAGE(PG8_SB(0, 1), b2 + hstep, voffB); PG8_STAGE(PG8_SA(0, 0), a2, voffA);
            PG8_WAIT_V(8); PG8_WAIT_L(0); PG8_BAR; PG8_MMA(1, 0, At, B0); PG8_MMA(1, 1, At, B1); PG8_BAR; PG8_SCHED;
            PG8_LDB(B0, 1, 0); PG8_LDB(B1, 1, 1); PG8_SCHED; PG8_LDA(At, 1, 0); PG8_STAGE(PG8_SA(0, 1), a2 + hstep, voffA);
            PG8_WAIT_V(8); PG8_WAIT_L(0); PG8_BAR; PG8_MMA(0, 0, At, B0); PG8_MMA(0, 1, At, B1); PG8_BAR; PG8_SCHED;
            PG8_LDA(At, 1, 1); PG8_STAGE(PG8_SB(1, 0), b3, voffB); PG8_STAGE(PG8_SB(1, 1), b3 + hstep, voffB); PG8_STAGE(PG8_SA(1, 0), a3, voffA);
            PG8_WAIT_V(8); PG8_WAIT_L(0); PG8_BAR; PG8_MMA(1, 0, At, B0); PG8_MMA(1, 1, At, B1); PG8_BAR; PG8_SCHED;
            } else {
            PG8_LDB(B0, 0, 0); PG8_SCHED; PG8_LDA(At, 0, 0); PG8_STAGE(PG8_SA(1, 1), a1 + hstep, voffA);
            PG8_WAIT_L(8); PG8_BAR; PG8_WAIT_L(0); PG8_MMA(0, 0, At, B0); PG8_BAR; PG8_SCHED;
            PG8_LDB(B1, 0, 1); PG8_STAGE(PG8_SB(0, 0), b2, voffB);
            PG8_BAR; PG8_WAIT_L(0); PG8_MMA(0, 1, At, B1); PG8_BAR;
            PG8_LDA(At, 0, 1); PG8_STAGE(PG8_SA(0, 0), a2, voffA);
            PG8_BAR; PG8_WAIT_L(0); PG8_MMA(1, 0, At, B0); PG8_BAR; PG8_SCHED;
            PG8_STAGE(PG8_SB(0, 1), b2 + hstep, voffB);
            PG8_WAIT_V(6); PG8_BAR; PG8_MMA(1, 1, At, B1); PG8_BAR;
            PG8_LDB(B0, 1, 0); PG8_SCHED; PG8_LDA(At, 1, 0); PG8_STAGE(PG8_SA(0, 1), a2 + hstep, voffA);
            PG8_WAIT_L(8); PG8_BAR; PG8_WAIT_L(0); PG8_MMA(0, 0, At, B0); PG8_BAR; PG8_SCHED;
            PG8_LDB(B1, 1, 1); PG8_STAGE(PG8_SB(1, 0), b3, voffB);
            PG8_BAR; PG8_WAIT_L(0); PG8_MMA(0, 1, At, B1); PG8_BAR;
            PG8_LDA(At, 1, 1); PG8_STAGE(PG8_SA(1, 0), a3, voffA);
            PG8_BAR; PG8_WAIT_L(0); PG8_MMA(1, 0, At, B0); PG8_BAR; PG8_SCHED;
            PG8_STAGE(PG8_SB(1, 1), b3 + hstep, voffB);
            PG8_WAIT_V(6); PG8_BAR; PG8_MMA(1, 1, At, B1); PG8_BAR;
            }
        }
        if constexpr (ALIGN_EPI) { if (wr == 0) PG8_BAR; }
        if constexpr (!Epi::AFTER_DRAIN) { E(acc, cur, wr, wc, fr, fq); S.done(cur); }
        if (!has_next) break;
#pragma unroll
        for (int a = 0; a < 2; ++a)
#pragma unroll
            for (int b = 0; b < 2; ++b)
#pragma unroll
                for (int m = 0; m < 4; ++m)
#pragma unroll
                    for (int n = 0; n < 2; ++n) acc[a][b][m][n] = (f32x4){0.f, 0.f, 0.f, 0.f};
        cur = nxt; cA = nA; cB = nB; ++ui;
        if constexpr (ALIGN_EPI) { if (wr == 1) PG8_BAR; }
    }
    PG8_WAIT_V(0);
    if constexpr (!ALIGN_EPI) { if (wr == 0) PG8_BAR; }
    PG8_BAR;
    if constexpr (Epi::AFTER_DRAIN) { E.fused(acc, cur, wr, wc, fr, fq, lds, wid, lane); S.done(cur); }
#undef PG8_SA
#undef PG8_SB
#undef PG8_STAGE
#undef PG8_LDA
#undef PG8_LDB
#undef PG8_MMA
#undef PG8_WAIT_V
#undef PG8_WAIT_L
#undef PG8_BAR
#undef PG8_SCHED
}
}

#define LAS __attribute__((address_space(3)))
typedef unsigned v4u __attribute__((ext_vector_type(4)));
__device__ __forceinline__ unsigned pk2(float lo, float hi) { return f2bf(lo) | (f2bf(hi) << 16); }
__device__ __forceinline__ void transpose_item(const float* W, int K, int N, bf16* WT, float* scr, int item, int nblk, int lane) {
    const int kb = item / nblk, nb = item % nblk, k0 = 64 * kb, n0 = 32 * nb;
    const int nn = n0 + (lane & 31);
#pragma unroll 8
    for (int i = 0; i < 32; ++i) { const int kk = 2 * i + (lane >> 5); scr[kk * 33 + (lane & 31)] = (nn < N) ? W[(size_t)(k0 + kk) * N + nn] : 0.f; }
    __builtin_amdgcn_s_waitcnt(0xc07f); asm volatile("" ::: "memory");
    const int c = lane & 7;
#pragma unroll
    for (int j = 0; j < 4; ++j) { const int n = (lane >> 3) + 8 * j; const float* sp = scr + (8 * c) * 33 + n;
        v4u o; o.x = pk2(sp[0 * 33], sp[1 * 33]); o.y = pk2(sp[2 * 33], sp[3 * 33]); o.z = pk2(sp[4 * 33], sp[5 * 33]); o.w = pk2(sp[6 * 33], sp[7 * 33]);
        *(v4u*)(WT + (size_t)(n0 + n) * K + k0 + 8 * c) = o; }
    __builtin_amdgcn_s_waitcnt(0xc07f); asm volatile("" ::: "memory");
}
__device__ __forceinline__ void cvt_bf16(const float* src, bf16* dst, size_t n) {
    for (size_t e = ((size_t)bidx() * NT + tidx()) * 8; e < n; e += (size_t)gridDim.x * NT * 8) {
        const f32x4 a = *(const f32x4*)(src + e), b = *(const f32x4*)(src + e + 4);
        v4u o; o.x = pk2(a.x, a.y); o.y = pk2(a.z, a.w); o.z = pk2(b.x, b.y); o.w = pk2(b.z, b.w);
        *(v4u*)(dst + e) = o; }
}
__device__ __forceinline__ void transpose_matrix(const float* W, int K, int N, int Npad, bf16* WT, float* scr, int gw, int ngw, int lane) {
    const int nblk = Npad / 32, nit = (K / 64) * nblk;
    for (int it = gw; it < nit; it += ngw) transpose_item(W, K, N, WT, scr, it, nblk, lane);
}
__device__ __forceinline__ void ph_prologue(unsigned char* smem) {
    const int lane = tidx() & 63, wave = tidx() >> 6;
    float* scr = (float*)smem + wave * (64 * 33);
    const int gw = bidx() * (NT / 64) + wave, ngw = gridDim.x * (NT / 64);
    unsigned char* ws = WSP;
    transpose_matrix(IN(6), 1024, AB_N, AB_LD, (bf16*)(ws + WS_WAB_IN), scr, gw, ngw, lane);
    transpose_matrix(IN(7), 1024, 1024, 1024, (bf16*)(ws + WS_WAB_OUT), scr, gw, ngw, lane);
    transpose_matrix(IN(12), 1024, 3072, 3072, (bf16*)(ws + WS_WC_IN), scr, gw, ngw, lane);
    transpose_matrix(IN(13), 1024, 1024, 1024, (bf16*)(ws + WS_WC_OUT), scr, gw, ngw, lane);
#pragma unroll 1
    for (int L = 0; L < 2; ++L) {
        transpose_matrix(IN(16) + (size_t)L * DM * 2048, 1024, 2048, 2048, (bf16*)(ws + WS_WQ + (size_t)L * 4 * MiB), scr, gw, ngw, lane);
        transpose_matrix(IN(20) + (size_t)L * DM * DM, 1024, 1024, 1024, (bf16*)(ws + WS_WG + (size_t)L * 2 * MiB), scr, gw, ngw, lane);
        transpose_matrix(IN(21) + (size_t)L * 256 * DM, 256, 1024, 1024, (bf16*)(ws + WS_WUP + (size_t)L * (MiB / 2)), scr, gw, ngw, lane);
    }
    cvt_bf16(IN(1), (bf16*)(ws + WS_P), (size_t)2 * T * 256);
    cvt_bf16(IN(17), (bf16*)(ws + WS_SUBK), (size_t)2 * 16 * 128 * 128);
#pragma unroll 1
    for (int L = 0; L < 2; ++L) {
        cvt_bf16(IN(18) + (size_t)L * NEXP * DM, (bf16*)(ws + WS_EXP + (size_t)(2 * L) * 32 * MiB), (size_t)NEXP * DM);
        cvt_bf16(IN(19) + (size_t)L * NEXP * DM, (bf16*)(ws + WS_EXP + (size_t)(2 * L + 1) * 32 * MiB), (size_t)NEXP * DM);
    }
}


typedef __bf16 bf2_t __attribute__((ext_vector_type(2)));
typedef unsigned u32x4g __attribute__((ext_vector_type(4)));
__device__ __forceinline__ float dot2u(unsigned a, unsigned b, float c) { return __builtin_amdgcn_fdot2_f32_bf16(__builtin_bit_cast(bf2_t, a), __builtin_bit_cast(bf2_t, b), c, false); }
__device__ __forceinline__ float dot8(u32x4g a, u32x4g b, float c) {
    c = dot2u(a[0], b[0], c); c = dot2u(a[1], b[1], c); c = dot2u(a[2], b[2], c); c = dot2u(a[3], b[3], c);
    return c;
}
__device__ __forceinline__ float bflo(unsigned d) { return __builtin_bit_cast(float, d << 16); }
__device__ __forceinline__ float bfhi(unsigned d) { return __builtin_bit_cast(float, d & 0xffff0000u); }
#define GATHER_U8(EREG, B) do { float s_[8]; \
    _Pragma("unroll") for (int k = 0; k < 8; ++k) { const int idx = __builtin_amdgcn_readlane(EREG, ((B) * 8 + k) & 63); \
        const u32x4g* up = (const u32x4g*)(U + (size_t)idx * DM); const u32x4g u0 = up[lane], u1 = up[64 + lane]; s_[k] = dot8(x1, u1, dot8(x0, u0, 0.f)); } \
    float r_[4]; const bool b5 = lane & 32, b4 = lane & 16, b3 = lane & 8; \
    _Pragma("unroll") for (int i = 0; i < 4; ++i) { const float snd = b5 ? s_[i] : s_[4 + i], kp = b5 ? s_[4 + i] : s_[i]; r_[i] = kp + __shfl_xor(snd, 32); } \
    float q_[2]; \
    _Pragma("unroll") for (int i = 0; i < 2; ++i) { const float snd = b4 ? r_[i] : r_[2 + i], kp = b4 ? r_[2 + i] : r_[i]; q_[i] = kp + __shfl_xor(snd, 16); } \
    float p_; { const float snd = b3 ? q_[0] : q_[1], kp = b3 ? q_[1] : q_[0]; p_ = kp + __shfl_xor(snd, 8); } \
    p_ += __shfl_xor(p_, 4); p_ += __shfl_xor(p_, 2); p_ += __shfl_xor(p_, 1); \
    if ((lane & 7) == 0) al[(B) * 8 + (lane >> 3)] = p_; } while (0)
#define GATHER_V8(EREG, WREG, B) do { \
    _Pragma("unroll") for (int k = 0; k < 8; ++k) { const int idx = __builtin_amdgcn_readlane(EREG, ((B) * 8 + k) & 63); \
        const float w = __builtin_bit_cast(float, __builtin_amdgcn_readlane(__builtin_bit_cast(int, WREG), ((B) * 8 + k) & 63)); \
        const u32x4g* vp = (const u32x4g*)(V + (size_t)idx * DM); const u32x4g v0 = vp[lane], v1 = vp[64 + lane]; \
        acc[0] += w * bflo(v0.x); acc[1] += w * bfhi(v0.x); acc[2] += w * bflo(v0.y); acc[3] += w * bfhi(v0.y); \
        acc[4] += w * bflo(v0.z); acc[5] += w * bfhi(v0.z); acc[6] += w * bflo(v0.w); acc[7] += w * bfhi(v0.w); \
        acc[8] += w * bflo(v1.x); acc[9] += w * bfhi(v1.x); acc[10] += w * bflo(v1.y); acc[11] += w * bfhi(v1.y); \
        acc[12] += w * bflo(v1.z); acc[13] += w * bfhi(v1.z); acc[14] += w * bflo(v1.w); acc[15] += w * bfhi(v1.w); } } while (0)
__device__ __forceinline__ void ph_peer_gather_opt(const int* eidx, const float* gw, const bf16* U, const bf16* V, float* h, const float* gain_next, bf16* XN, unsigned char* smem) {
    const int tid = tidx(), lane = tid & 63, wave = tid >> 6;
    float* al = (float*)smem + wave * 128;
    const int gwv = bidx() * (NT / 64) + wave, ngw = gridDim.x * (NT / 64);
    for (int t = gwv; t < T; t += ngw) {
        const u32x4g x0 = *(const u32x4g*)(XN + (size_t)t * DM + 8 * lane), x1 = *(const u32x4g*)(XN + (size_t)t * DM + 512 + 8 * lane);
        const int e0 = eidx[(size_t)t * 128 + lane], e1 = eidx[(size_t)t * 128 + 64 + lane];
        const float g0 = gw[(size_t)t * 128 + lane], g1 = gw[(size_t)t * 128 + 64 + lane];
#pragma unroll 1
        for (int b = 0; b < 8; ++b) GATHER_U8(e0, b);
#pragma unroll 1
        for (int b = 8; b < 16; ++b) GATHER_U8(e1, b);
        __builtin_amdgcn_s_waitcnt(0xc07f); asm volatile("" ::: "memory");
        const float w0 = g0 * gelu_tanh(al[lane]), w1 = g1 * gelu_tanh(al[64 + lane]);
        float acc[16];
#pragma unroll
        for (int i = 0; i < 16; ++i) acc[i] = 0.f;
#pragma unroll 1
        for (int b = 0; b < 8; ++b) GATHER_V8(e0, w0, b);
#pragma unroll 1
        for (int b = 8; b < 16; ++b) GATHER_V8(e1, w1, b);
        float* hp = h + (size_t)t * DM + 8 * lane;
        f32x4 h0 = *(f32x4*)(hp), h1 = *(f32x4*)(hp + 4), h2 = *(f32x4*)(hp + 512), h3 = *(f32x4*)(hp + 516);
        h0 += (f32x4){acc[0], acc[1], acc[2], acc[3]}; h1 += (f32x4){acc[4], acc[5], acc[6], acc[7]};
        h2 += (f32x4){acc[8], acc[9], acc[10], acc[11]}; h3 += (f32x4){acc[12], acc[13], acc[14], acc[15]};
        *(f32x4*)(hp) = h0; *(f32x4*)(hp + 4) = h1; *(f32x4*)(hp + 512) = h2; *(f32x4*)(hp + 516) = h3;
        float ss = 0.f;
#pragma unroll
        for (int i = 0; i < 4; ++i) ss += h0[i] * h0[i] + h1[i] * h1[i] + h2[i] * h2[i] + h3[i] * h3[i];
        const float rstd = 1.0f / sqrtf(wave_sum(ss) * (1.0f / DM) + NORM_EPS);
        const f32x4 ga = *(const f32x4*)(gain_next + 8 * lane), gb = *(const f32x4*)(gain_next + 8 * lane + 4), gc = *(const f32x4*)(gain_next + 512 + 8 * lane), gd = *(const f32x4*)(gain_next + 516 + 8 * lane);
        u32x4g o0, o1;
        o0.x = pk2(h0[0] * rstd * ga[0], h0[1] * rstd * ga[1]); o0.y = pk2(h0[2] * rstd * ga[2], h0[3] * rstd * ga[3]);
        o0.z = pk2(h1[0] * rstd * gb[0], h1[1] * rstd * gb[1]); o0.w = pk2(h1[2] * rstd * gb[2], h1[3] * rstd * gb[3]);
        o1.x = pk2(h2[0] * rstd * gc[0], h2[1] * rstd * gc[1]); o1.y = pk2(h2[2] * rstd * gc[2], h2[3] * rstd * gc[3]);
        o1.z = pk2(h3[0] * rstd * gd[0], h3[1] * rstd * gd[1]); o1.w = pk2(h3[2] * rstd * gd[2], h3[3] * rstd * gd[3]);
        *(u32x4g*)(XN + (size_t)t * DM + 8 * lane) = o0; *(u32x4g*)(XN + (size_t)t * DM + 512 + 8 * lane) = o1;
    }
}

namespace cg = cooperative_groups;
constexpr int LDS_BYTES = 147456;
#define GEMM_PHASE(EPI, Aptr, Bptr, Nn, Kk, ...) do { pg8::Gemm g_{(const pg8::bf16_t*)(Aptr), (const pg8::bf16_t*)(Bptr), T, (Nn), (Kk)}; pg8::StaticOrder S_; S_.init(T, (Nn), (int)gridDim.x, (int)bidx()); \
    pg8::EPI E_{__VA_ARGS__}; pg8::gemm_phase<pg8::EPI, pg8::StaticOrder, true, true>((PG8_LAS unsigned char*)smem, g_, S_, E_); } while (0)
__global__ void __launch_bounds__(NT, 2) k_mega(Params P) {
    extern __shared__ __attribute__((aligned(16))) unsigned char smem[];
    cg::grid_group grid = cg::this_grid();
#define BAR() grid.sync()
    ph_prologue(smem);
    ph_rmsnorm(IN(0), IN(3), (bf16*)(WSP + WS_XN)); BAR();
    { unsigned char* ws = WSP; GEMM_PHASE(EBf16, ws + WS_XN, ws + WS_WAB_IN, AB_LD, DM, (bf16*)(ws + WS_QKV), AB_LD); } BAR();
    ph_prep0((bf16*)(WSP + WS_QKV), (const int*)IN(2), IN(8), IN(9), IN(10), IN(11)); BAR();
    { unsigned char* ws = WSP; ph_kmean((bf16*)(ws + WS_QKV), (float*)(ws + WS_KMEAN)); } BAR();
    { unsigned char* ws = WSP; ph_moba_select((bf16*)(ws + WS_QKV), (float*)(ws + WS_KMEAN), (unsigned*)(ws + WS_SEL)); } BAR();
    { unsigned char* ws = WSP; ph_moba_attend((bf16*)(ws + WS_QKV), (unsigned*)(ws + WS_SEL), (bf16*)(ws + WS_XN), smem); }
    { unsigned char* ws = WSP; ph_dsa_select((bf16*)(ws + WS_QKV), (unsigned long long*)(ws + WS_MASK), smem); } BAR();
    { unsigned char* ws = WSP; ph_dsa_attend((bf16*)(ws + WS_QKV), (unsigned long long*)(ws + WS_MASK), (bf16*)(ws + WS_XN), smem); } BAR();
    { unsigned char* ws = WSP; GEMM_PHASE(EResAdd, ws + WS_XN, ws + WS_WAB_OUT, DM, DM, IN(0), OUTP); } BAR();
#pragma unroll 1
    for (int L = 0; L < 2; ++L) {
        if (L == 1) {
            ph_rmsnorm(OUTP, IN(3) + DM, (bf16*)(WSP + WS_XN)); BAR();
            { unsigned char* ws = WSP; GEMM_PHASE(EBf16, ws + WS_XN, ws + WS_WC_IN, C_LD, DM, (bf16*)(ws + WS_QKV1), C_LD); } BAR();
            ph_prep1((bf16*)(WSP + WS_QKV1), (const int*)IN(2), IN(14), IN(15)); BAR();
            { unsigned char* ws = WSP; ph_dilated((bf16*)(ws + WS_QKV1), (bf16*)(ws + WS_OG), (float*)(ws + WS_LSE)); } BAR();
            { unsigned char* ws = WSP; ph_dil_merge((bf16*)(ws + WS_OG), (float*)(ws + WS_LSE), (bf16*)(ws + WS_XN)); } BAR();
            { unsigned char* ws = WSP; float* hb = OUTP; GEMM_PHASE(EResAdd, ws + WS_XN, ws + WS_WC_OUT, DM, DM, hb, hb); } BAR();
        }
        ph_rmsnorm(OUTP, IN(4) + L * DM, (bf16*)(WSP + WS_XN)); BAR();
        { unsigned char* ws = WSP; GEMM_PHASE(EBf16, ws + WS_XN, ws + WS_WQ + (size_t)L * 4 * MiB, 2048, DM, (bf16*)(ws + WS_QRY), 2048); } BAR();
        { unsigned char* ws = WSP; ph_peer_route((bf16*)(ws + WS_QRY), IN(17) + (size_t)L * 16 * 128 * 128, (int*)(ws + WS_EIDX), (float*)(ws + WS_GW), smem); } BAR();
        { unsigned char* ws = WSP; ph_peer_gather_opt((int*)(ws + WS_EIDX), (float*)(ws + WS_GW), (bf16*)(ws + WS_EXP + (size_t)(2 * L) * 32 * MiB), (bf16*)(ws + WS_EXP + (size_t)(2 * L + 1) * 32 * MiB), OUTP, IN(5) + L * DM, (bf16*)(ws + WS_XN), smem); }
        __syncthreads();
        { unsigned char* ws = WSP; GEMM_PHASE(EBf16, ws + WS_P + (size_t)L * T * 256 * 2, ws + WS_WUP + (size_t)L * (MiB / 2), DM, 256, (bf16*)(ws + WS_UP), DM); } BAR();
        { unsigned char* ws = WSP; GEMM_PHASE(EGate, ws + WS_XN, ws + WS_WG + (size_t)L * 2 * MiB, DM, DM, OUTP, (bf16*)(ws + WS_UP)); } BAR();
    }
}

extern "C" void kernel_launch(void* const* d_in, const int* in_sizes, int n_in, void* d_out, int out_size, void* d_ws, size_t ws_size, hipStream_t stream) {
    static int grid_blocks = 0;
    if (grid_blocks == 0) {
        if (n_in != 22 || out_size != T * DM || ws_size < WS_END) { fprintf(stderr, "kernel_launch: unexpected shapes: n_in %d out %d ws %zu\n", n_in, out_size, ws_size); grid_blocks = -1; return; }
        if (hipFuncSetAttribute((const void*)k_mega, hipFuncAttributeMaxDynamicSharedMemorySize, LDS_BYTES) != hipSuccess) { fprintf(stderr, "hipFuncSetAttribute failed\n"); grid_blocks = -1; return; }
        int dev = 0, cus = 0, per_cu = 0;
        hipGetDevice(&dev);
        hipDeviceGetAttribute(&cus, hipDeviceAttributeMultiprocessorCount, dev);
        hipOccupancyMaxActiveBlocksPerMultiprocessor(&per_cu, (const void*)k_mega, NT, LDS_BYTES);
        if (per_cu < 1 || cus < 1) { fprintf(stderr, "kernel_launch: occupancy query says %d blocks/CU on %d CUs\n", per_cu, cus); grid_blocks = -1; return; }
        grid_blocks = cus;
    }
    if (grid_blocks < 0) return;
    Params P{};
    for (int i = 0; i < 22; ++i) P.in[i] = (const float*)d_in[i];
    P.out = (float*)d_out; P.ws = (unsigned char*)d_ws;
    void* args[] = {&P};
    hipError_t e = hipLaunchCooperativeKernel((const void*)k_mega, dim3(grid_blocks), dim3(NT), args, LDS_BYTES, stream);
    if (e != hipSuccess) fprintf(stderr, "cooperative launch failed: %s (grid %d)\n", hipGetErrorString(e), grid_blocks);
}
```

```cpp
#include <hip/hip_runtime.h>
#include <hip/hip_cooperative_groups.h>
#include <cstdio>
#include <cstdint>

constexpr int BATCH = 2, SEQ = 8192, T = BATCH * SEQ, DM = 1024;
constexpr int AB_N = 3396, AB_LD = 3584;
constexpr int CQA = 0, CKA = 512, CVA = 1024, CQB = 1536, CKB = 2048, CVB = 2560, CQI = 3072, CKI = 3328, CWI = 3392;
constexpr int C_LD = 3072;
constexpr int NEXP = 16384;
constexpr float NORM_EPS = 1e-6f;
constexpr float C2 = 0.125f * 1.4426950408889634f;
constexpr int NT = 512;

constexpr size_t MiB = 1u << 20;
constexpr size_t WS_CTL = 0;
constexpr size_t WS_WAB_IN = 1 * MiB, WS_WAB_OUT = 8 * MiB, WS_WC_IN = 10 * MiB, WS_WC_OUT = 16 * MiB;
constexpr size_t WS_WQ = 18 * MiB, WS_WG = 26 * MiB, WS_WUP = 30 * MiB, WS_SUBK = 31 * MiB;
constexpr size_t WS_KMEAN = 32 * MiB;
constexpr size_t WS_SEL = 33 * MiB;
constexpr size_t WS_LSE = 34 * MiB;
constexpr size_t WS_EIDX = 37 * MiB;
constexpr size_t WS_GW = 45 * MiB;
constexpr size_t WS_P = 53 * MiB;
constexpr size_t WS_XN = 69 * MiB;
constexpr size_t WS_QKV = 101 * MiB;
constexpr size_t WS_MASK = 213 * MiB;
constexpr size_t WS_SCORES = 229 * MiB;
constexpr size_t WS_EXP = 229 * MiB;
constexpr size_t WS_QRY = 101 * MiB;
constexpr size_t WS_UP = 165 * MiB;
constexpr size_t WS_QKV1 = 357 * MiB;
constexpr size_t WS_OG = 101 * MiB;
constexpr size_t WS_END = 512 * MiB;

typedef unsigned short bf16;
typedef float f32x4 __attribute__((ext_vector_type(4)));

__device__ __forceinline__ unsigned f2bf(float f) { unsigned u = __builtin_bit_cast(unsigned, f); return (u + 0x7fffu + ((u >> 16) & 1u)) >> 16; }
__device__ __forceinline__ float bf2f(bf16 h) { return __builtin_bit_cast(float, (unsigned)h << 16); }
__device__ __forceinline__ float wave_sum(float v) {
#pragma unroll
    for (int o = 1; o < 64; o <<= 1) v += __shfl_xor(v, o);
    return v;
}
__device__ __forceinline__ float wave_max(float v) {
#pragma unroll
    for (int o = 1; o < 64; o <<= 1) v = fmaxf(v, __shfl_xor(v, o));
    return v;
}
__device__ __forceinline__ unsigned okey(float f) { unsigned u = __builtin_bit_cast(unsigned, f); return (u & 0x80000000u) ? ~u : (u | 0x80000000u); }

__device__ __forceinline__ int tidx() { int t = __builtin_amdgcn_workitem_id_x(); asm volatile("" : "+v"(t)); return t; }
__device__ __forceinline__ int bidx() { int b = __builtin_amdgcn_workgroup_id_x(); asm volatile("" : "+s"(b)); return b; }
struct Params {
    const float* in[22];
    float* out;
    unsigned char* ws;
    int layer;
    int pad;
};

typedef const __attribute__((address_space(4))) unsigned long long* karg_t;
__device__ __forceinline__ unsigned long long karg(int idx) { karg_t ka = (karg_t)__builtin_amdgcn_kernarg_segment_ptr(); asm volatile("" : "+s"(ka)); return ka[idx]; }
#define IN(i) ((const float*)karg(i))
#define OUTP ((float*)karg(22))
#define WSP ((unsigned char*)karg(23))

__device__ __forceinline__ void ph_rmsnorm(const float* src, const float* gain, bf16* dst) {
    const int lane = tidx() & 63, wave = tidx() >> 6;
    const int gw = bidx() * (NT / 64) + wave, ngw = gridDim.x * (NT / 64);
    for (int r = gw; r < T; r += ngw) {
        const f32x4* xr = (const f32x4*)(src + (size_t)r * DM) + lane;
        f32x4 v[4]; float s = 0.f;
#pragma unroll
        for (int j = 0; j < 4; ++j) { v[j] = xr[64 * j]; s += v[j].x * v[j].x + v[j].y * v[j].y + v[j].z * v[j].z + v[j].w * v[j].w; }
        const float rstd = 1.0f / sqrtf(wave_sum(s) * (1.0f / DM) + NORM_EPS);
#pragma unroll
        for (int j = 0; j < 4; ++j) {
            const f32x4 g = ((const f32x4*)gain)[lane + 64 * j];
            unsigned long long o = (unsigned long long)(f2bf(v[j].x * rstd * g.x) | (f2bf(v[j].y * rstd * g.y) << 16)) |
                                   ((unsigned long long)(f2bf(v[j].z * rstd * g.z) | (f2bf(v[j].w * rstd * g.w) << 16)) << 32);
            ((unsigned long long*)(dst + (size_t)r * DM))[lane + 64 * j] = o;
        }
    }
}

template <class AT> __device__ __forceinline__ float ldA(const AT* p);
template <> __device__ __forceinline__ float ldA<bf16>(const bf16* p) { return bf2f(*p); }
template <> __device__ __forceinline__ float ldA<float>(const float* p) { return *p; }

template <class AT, class Epi> __forceinline__
__device__ __forceinline__ void ph_gemm_naive(const AT* A, int lda, const float* B, int N, int K, const Epi& E, unsigned char* smem) {
    float* As = (float*)smem;
    float* Bs = As + 16 * 132;
    const int tid = tidx(), ty = tid >> 5, tx = tid & 31;
    const int ntn = (N + 127) / 128, ntm = T / 128, ntile = ntn * ntm;
    for (int tile = bidx(); tile < ntile; tile += gridDim.x) {
        const int tm = tile / ntn, tn = tile % ntn, m0 = tm * 128, n0 = tn * 128;
        float acc[8][4];
#pragma unroll
        for (int i = 0; i < 8; ++i)
#pragma unroll
            for (int j = 0; j < 4; ++j) acc[i][j] = 0.f;
        for (int k0 = 0; k0 < K; k0 += 16) {
            __syncthreads();
#pragma unroll
            for (int i = 0; i < 4; ++i) { const int e = tid + i * NT, r = e >> 4, kk = e & 15; As[kk * 132 + r] = ldA<AT>(A + (size_t)(m0 + r) * lda + k0 + kk); }
#pragma unroll
            for (int i = 0; i < 4; ++i) { const int e = tid + i * NT, kk = e >> 7, c = e & 127; Bs[kk * 128 + c] = (n0 + c < N) ? B[(size_t)(k0 + kk) * N + n0 + c] : 0.f; }
            __syncthreads();
#pragma unroll 2
            for (int kk = 0; kk < 16; ++kk) {
                float a[8], b[4];
#pragma unroll
                for (int i = 0; i < 8; ++i) a[i] = As[kk * 132 + ty * 8 + i];
#pragma unroll
                for (int j = 0; j < 4; ++j) b[j] = Bs[kk * 128 + tx * 4 + j];
#pragma unroll
                for (int i = 0; i < 8; ++i)
#pragma unroll
                    for (int j = 0; j < 4; ++j) acc[i][j] += a[i] * b[j];
            }
        }
#pragma unroll
        for (int i = 0; i < 8; ++i) {
            const int col = n0 + tx * 4;
            if (col < N) E.store4(m0 + ty * 8 + i, col, (f32x4){acc[i][0], acc[i][1], acc[i][2], acc[i][3]});
        }
    }
}
struct EpBf16 { bf16* O; int ldc;
    __device__ __forceinline__ void store4(int r, int c, f32x4 v) const {
        unsigned long long o = (unsigned long long)(f2bf(v.x) | (f2bf(v.y) << 16)) | ((unsigned long long)(f2bf(v.z) | (f2bf(v.w) << 16)) << 32);
        *(unsigned long long*)(O + (size_t)r * ldc + c) = o; } };
struct EpResAdd { const float* base; float* out;
    __device__ __forceinline__ void store4(int r, int c, f32x4 v) const {
        const f32x4 b = *(const f32x4*)(base + (size_t)r * DM + c); *(f32x4*)(out + (size_t)r * DM + c) = b + v; } };
struct EpGate { float* h; const bf16* up;
    __device__ __forceinline__ void store4(int r, int c, f32x4 v) const {
        f32x4 hv = *(const f32x4*)(h + (size_t)r * DM + c); const bf16* u = up + (size_t)r * DM + c;
        hv.x += bf2f(u[0]) / (1.f + __expf(-v.x)); hv.y += bf2f(u[1]) / (1.f + __expf(-v.y));
        hv.z += bf2f(u[2]) / (1.f + __expf(-v.z)); hv.w += bf2f(u[3]) / (1.f + __expf(-v.w));
        *(f32x4*)(h + (size_t)r * DM + c) = hv; } };

__device__ __forceinline__ void rope_cs(int pos, int i, float& c, float& s) {
    const float inv = exp2f(-(float)i * 0.125f * 18.931568569324174f);
    const float ang = (float)pos * inv;
    const float k = rintf(ang * 0.15915494309189535f);
    float r = fmaf(-k, 6.28125f, ang); r = fmaf(-k, 1.9353071795864769e-3f, r);
    c = cosf(r); s = sinf(r);
}
__device__ __forceinline__ void prep_head(bf16* p, const float* gain, int pos, float scale, bool donorm, int lane) {
    float v = bf2f(p[lane]);
    if (donorm) { const float ss = wave_sum(v * v); v = v * (1.0f / sqrtf(ss * (1.0f / 64.f) + NORM_EPS)) * gain[lane]; }
    const float partner = __shfl_xor(v, 8);
    float c = 1.f, s = 0.f;
    if (lane < 16) rope_cs(pos, lane & 7, c, s);
    float o = v;
    if (lane < 8) o = v * c - partner * s; else if (lane < 16) o = v * c + partner * s;
    p[lane] = (bf16)f2bf(o * scale);
}
__device__ __forceinline__ void ph_prep0(bf16* qkv, const int* positions, const float* aq, const float* ak, const float* bq, const float* bk) {
    const int lane = tidx() & 63, wave = tidx() >> 6;
    const int gw = bidx() * (NT / 64) + wave, ngw = gridDim.x * (NT / 64);
    for (int r = gw; r < T; r += ngw) {
        const int pos = positions[r]; bf16* row = qkv + (size_t)r * AB_LD;
        for (int h = 0; h < 8; ++h) {
            prep_head(row + CQA + h * 64, aq, pos, C2, true, lane);
            prep_head(row + CKA + h * 64, ak, pos, 1.f, true, lane);
            prep_head(row + CQB + h * 64, bq, pos, C2, true, lane);
            prep_head(row + CKB + h * 64, bk, pos, 1.f, true, lane);
        }
        for (int h = 0; h < 4; ++h) prep_head(row + CQI + h * 64, nullptr, pos, 1.f, false, lane);
        prep_head(row + CKI, nullptr, pos, 1.f, false, lane);
    }
}
__device__ __forceinline__ void ph_prep1(bf16* qkv, const int* positions, const float* cq, const float* ck) {
    const int lane = tidx() & 63, wave = tidx() >> 6;
    const int gw = bidx() * (NT / 64) + wave, ngw = gridDim.x * (NT / 64);
    for (int r = gw; r < T; r += ngw) {
        const int pos = positions[r]; bf16* row = qkv + (size_t)r * C_LD;
        for (int h = 0; h < 16; ++h) {
            prep_head(row + h * 64, cq, pos, C2, true, lane);
            prep_head(row + 1024 + h * 64, ck, pos, 1.f, true, lane);
        }
    }
}
__device__ __forceinline__ void ph_kmean(const bf16* qkv, float* kmean) {
    const int lane = tidx() & 63, wave = tidx() >> 6;
    const int gw = bidx() * (NT / 64) + wave, ngw = gridDim.x * (NT / 64);
    for (int it = gw; it < BATCH * 8 * 32; it += ngw) {
        const int b = it / 256, h = (it / 32) % 8, n = it % 32;
        float s = 0.f;
        for (int r = 0; r < 256; ++r) s += bf2f(qkv[(size_t)(b * SEQ + n * 256 + r) * AB_LD + CKA + h * 64 + lane]);
        kmean[(size_t)it * 64 + lane] = s * (1.0f / 256.f);
    }
}
__device__ __forceinline__ void ph_moba_select(const bf16* qkv, const float* kmean, unsigned* sel) {
    for (int it = bidx() * NT + tidx(); it < T * 8; it += gridDim.x * NT) {
        const int t = it >> 3, h = it & 7, b = t / SEQ, qblk = (t % SEQ) / 256;
        float q[64];
#pragma unroll
        for (int d = 0; d < 64; ++d) q[d] = bf2f(qkv[(size_t)t * AB_LD + CQA + h * 64 + d]);
        float v0 = -3e38f, v1 = -3e38f, v2 = -3e38f; int i0 = 255, i1 = 255, i2 = 255;
        for (int n = 0; n < qblk; ++n) {
            const float* km = kmean + (size_t)((b * 8 + h) * 32 + n) * 64; float g = 0.f;
#pragma unroll
            for (int d = 0; d < 64; ++d) g += q[d] * km[d];
            if (g > v0) { v2 = v1; i2 = i1; v1 = v0; i1 = i0; v0 = g; i0 = n; }
            else if (g > v1) { v2 = v1; i2 = i1; v1 = g; i1 = n; }
            else if (g > v2) { v2 = g; i2 = n; }
        }
        sel[it] = (unsigned)i0 | ((unsigned)i1 << 8) | ((unsigned)i2 << 16) | (255u << 24);
    }
}
__device__ __forceinline__ void ph_moba_attend(const bf16* qkv, const unsigned* sel, bf16* O, unsigned char* smem) {
    const int lane = tidx() & 63, wave = tidx() >> 6;
    float* pl = (float*)smem + wave * 1024;
    const int gw = bidx() * (NT / 64) + wave, ngw = gridDim.x * (NT / 64);
    for (int it = gw; it < T * 8; it += ngw) {
        const int t = it >> 3, h = it & 7, b = t / SEQ, tt = t % SEQ, qblk = tt / 256;
        const unsigned sw = sel[it];
        int blk[4] = {qblk, (int)(sw & 255), (int)((sw >> 8) & 255), (int)((sw >> 16) & 255)};
        const bf16* qp = qkv + (size_t)t * AB_LD + CQA + h * 64;
        float q[64];
#pragma unroll
        for (int d = 0; d < 64; ++d) q[d] = bf2f(qp[d]);
        float sc[16]; float mx = -3e38f;
#pragma unroll
        for (int s = 0; s < 4; ++s) {
#pragma unroll
            for (int i = 0; i < 4; ++i) {
                const int j = lane + 64 * i, pos = blk[s] * 256 + j;
                const bool ok = (blk[s] != 255) && (s > 0 || pos <= tt);
                float a = -3e38f;
                if (ok) { const bf16* kp = qkv + (size_t)(b * SEQ + pos) * AB_LD + CKA + h * 64; a = 0.f;
#pragma unroll
                    for (int d = 0; d < 64; ++d) a += q[d] * bf2f(kp[d]); }
                sc[s * 4 + i] = a; mx = fmaxf(mx, a);
            }
        }
        mx = wave_max(mx); float l = 0.f;
#pragma unroll
        for (int e = 0; e < 16; ++e) { const float p = (sc[e] > -1e38f) ? exp2f(sc[e] - mx) : 0.f; l += p; pl[(e >> 2) * 256 + lane + 64 * (e & 3)] = p; }
        l = wave_sum(l);
        __builtin_amdgcn_s_waitcnt(0);
        float o = 0.f;
#pragma unroll
        for (int s = 0; s < 4; ++s) {
            if (blk[s] == 255) continue;
            const int nk = (s == 0) ? (tt - qblk * 256 + 1) : 256;
            const bf16* vp = qkv + (size_t)(b * SEQ + blk[s] * 256) * AB_LD + CVA + h * 64 + lane;
            for (int j = 0; j < nk; ++j) o += pl[s * 256 + j] * bf2f(vp[(size_t)j * AB_LD]);
        }
        O[(size_t)t * DM + h * 64 + lane] = (bf16)f2bf(o / l);
    }
}
__device__ __forceinline__ void ph_dsa_select(const bf16* qkv, unsigned long long* mask, unsigned char* smem) {
    unsigned* keys = (unsigned*)smem;
    unsigned* cnt = keys + 8192;
    const int tid = tidx(), lane = tid & 63;
    for (int t = bidx(); t < T; t += gridDim.x) {
        const int b = t / SEQ, tt = t % SEQ, n = tt + 1;
        __syncthreads();
        const bf16* row = qkv + (size_t)t * AB_LD;
        float* qf = (float*)(cnt + 4);
        if (tid < 256) qf[tid] = bf2f(row[CQI + tid]);
        if (tid < 4) qf[256 + tid] = bf2f(row[CWI + tid]);
        __syncthreads();
        for (int kv = tid; kv < 8192; kv += NT) {
            unsigned key = 0u;
            if (kv < n) {
                const bf16* kp = qkv + (size_t)(b * SEQ + kv) * AB_LD + CKI;
                float a0 = 0.f, a1 = 0.f, a2 = 0.f, a3 = 0.f;
                for (int d = 0; d < 64; ++d) { const float kd = bf2f(kp[d]); a0 += qf[d] * kd; a1 += qf[64 + d] * kd; a2 += qf[128 + d] * kd; a3 += qf[192 + d] * kd; }
                const float s = ((qf[256] * fmaxf(a0, 0.f) + qf[257] * fmaxf(a1, 0.f)) + qf[258] * fmaxf(a2, 0.f)) + qf[259] * fmaxf(a3, 0.f);
                key = okey(s);
            }
            keys[kv] = key;
        }
        __syncthreads();
        unsigned thr = 0u, need = 0u;
        if (n > 256) {
            unsigned lo = 0u, hi = 0xFFFFFFFFu;
            while (lo < hi) {
                const unsigned mid = lo + ((hi - lo) >> 1) + ((hi - lo) & 1u);
                if (tid == 0) cnt[0] = 0u;
                __syncthreads();
                unsigned c = 0;
                for (int kv = tid; kv < 8192; kv += NT) c += (keys[kv] >= mid) ? 1u : 0u;
                c = (unsigned)wave_sum((float)c);
                if (lane == 0) atomicAdd(&cnt[0], c);
                __syncthreads();
                const unsigned tot = cnt[0];
                __syncthreads();
                if (tot >= 256u) lo = mid; else hi = mid - 1u;
            }
            thr = lo;
            if (tid == 0) cnt[1] = 0u;
            __syncthreads();
            unsigned c = 0;
            for (int kv = tid; kv < 8192; kv += NT) c += (keys[kv] > thr) ? 1u : 0u;
            c = (unsigned)wave_sum((float)c);
            if (lane == 0) atomicAdd(&cnt[1], c);
            __syncthreads();
            need = 256u - cnt[1];
        }
        if (tid < 64) {
            const int ntile = 4 * (tt / 256 + 1);
            unsigned taken = 0u;
            for (int j = 0; j < ntile; ++j) {
                const int kv = j * 64 + lane; const unsigned key = keys[kv];
                bool s;
                if (n <= 256) s = kv < n;
                else {
                    const bool gt = key > thr, eq = (key == thr) && (kv < n);
                    const unsigned long long em = __ballot(eq);
                    const unsigned rank = taken + (unsigned)__popcll(em & ((1ull << lane) - 1ull));
                    s = gt || (eq && rank < need);
                    taken += (unsigned)__popcll(em);
                }
                const unsigned long long m = __ballot(s);
                if (lane == 0) mask[((size_t)(b * 128 + j)) * SEQ + tt] = m;
            }
        }
    }
}
__device__ __forceinline__ void ph_dsa_attend(const bf16* qkv, const unsigned long long* mask, bf16* O, unsigned char* smem) {
    int* list = (int*)smem;
    int* cnt = list + 256;
    float* pr = (float*)(cnt + 4);
    float* linv = pr + 8 * 256;
    const int tid = tidx(), lane = tid & 63, wave = tid >> 6;
    for (int t = bidx(); t < T; t += gridDim.x) {
        const int b = t / SEQ, tt = t % SEQ;
        __syncthreads();
        const int ntile = 4 * (tt / 256 + 1);
        if (wave == 0) {
            int base = 0;
            for (int j = 0; j < ntile; ++j) {
                const unsigned long long m = mask[((size_t)(b * 128 + j)) * SEQ + tt];
                const int p = base + (int)__popcll(m & ((1ull << lane) - 1ull));
                if (((m >> lane) & 1ull) && p < 256) list[p] = j * 64 + lane;
                base += (int)__popcll(m);
            }
            if (lane == 0) cnt[0] = base;
        }
        __syncthreads();
        const int ns = min(cnt[0], 256);
        const bf16* row = qkv + (size_t)t * AB_LD;
        for (int e = tid; e < 8 * 256; e += NT) {
            const int h = e >> 8, j = e & 255; float a = -3e38f;
            if (j < ns) { const bf16* kp = qkv + (size_t)(b * SEQ + list[j]) * AB_LD + CKB + h * 64; a = 0.f;
                for (int d = 0; d < 64; ++d) a += bf2f(row[CQB + h * 64 + d]) * bf2f(kp[d]); }
            pr[e] = a;
        }
        __syncthreads();
        {
            const int h = wave; float v[4]; float mx = -3e38f;
#pragma unroll
            for (int i = 0; i < 4; ++i) { v[i] = pr[h * 256 + lane + 64 * i]; mx = fmaxf(mx, v[i]); }
            mx = wave_max(mx); float l = 0.f;
#pragma unroll
            for (int i = 0; i < 4; ++i) { const float p = (v[i] > -1e38f) ? exp2f(v[i] - mx) : 0.f; l += p; pr[h * 256 + lane + 64 * i] = p; }
            l = wave_sum(l); if (lane == 0) linv[h] = 1.0f / l;
        }
        __syncthreads();
        {   const int h = tid >> 6, d = tid & 63; float o = 0.f;
            for (int j = 0; j < ns; ++j) o += pr[h * 256 + j] * bf2f(qkv[(size_t)(b * SEQ + list[j]) * AB_LD + CVB + h * 64 + d]);
            O[(size_t)t * DM + 512 + h * 64 + d] = (bf16)f2bf(o * linv[h]); }
    }
}
__device__ __forceinline__ void ph_dilated(const bf16* qkv, bf16* OG, float* LSE) {
    const int lane = tidx() & 63, wave = tidx() >> 6;
    const int gw = bidx() * (NT / 64) + wave, ngw = gridDim.x * (NT / 64);
    for (int it = gw; it < T * 16; it += ngw) {
        const int t = it >> 4, h = it & 15, b = t / SEQ, tt = t % SEQ;
        const bf16* qp = qkv + (size_t)t * C_LD + h * 64;
        float q[64];
#pragma unroll
        for (int d = 0; d < 64; ++d) q[d] = bf2f(qp[d]);
        for (int g = 0; g < 3; ++g) {
            const int dil = (g == 0) ? 1 : (g == 1 ? 4 : 16);
            float sc[3]; float mx = -3e38f;
#pragma unroll
            for (int i = 0; i < 3; ++i) {
                const int j = lane + 64 * i, pos = tt - j * dil; float a = -3e38f;
                if (j <= 128 && pos >= 0) { const bf16* kp = qkv + (size_t)(b * SEQ + pos) * C_LD + 1024 + h * 64; a = 0.f;
#pragma unroll
                    for (int d = 0; d < 64; ++d) a += q[d] * bf2f(kp[d]); }
                sc[i] = a; mx = fmaxf(mx, a);
            }
            mx = wave_max(mx); float l = 0.f; float p[3];
#pragma unroll
            for (int i = 0; i < 3; ++i) { p[i] = (sc[i] > -1e38f) ? exp2f(sc[i] - mx) : 0.f; l += p[i]; }
            l = wave_sum(l);
            float o = 0.f;
            for (int j = 0; j <= 128; ++j) {
                const int pos = tt - j * dil; if (pos < 0) break;
                const float pj = (j < 64) ? __shfl(p[0], j) : ((j < 128) ? __shfl(p[1], j - 64) : __shfl(p[2], 0));
                o += pj * bf2f(qkv[(size_t)(b * SEQ + pos) * C_LD + 2048 + h * 64 + lane]);
            }
            OG[((size_t)g * T + t) * DM + h * 64 + lane] = (bf16)f2bf(o / l);
            if (lane == 0) LSE[((size_t)g * T + t) * 16 + h] = mx + log2f(l);
        }
    }
}
__device__ __forceinline__ void ph_dil_merge(const bf16* OG, const float* LSE, bf16* O) {
    for (size_t e = (size_t)bidx() * NT + tidx(); e < (size_t)T * DM; e += (size_t)gridDim.x * NT) {
        const int t = (int)(e >> 10), c = (int)(e & 1023), h = c >> 6;
        const float l0 = LSE[((size_t)0 * T + t) * 16 + h], l1 = LSE[((size_t)1 * T + t) * 16 + h], l2 = LSE[((size_t)2 * T + t) * 16 + h];
        const float m = fmaxf(l0, fmaxf(l1, l2)); const float w0 = exp2f(l0 - m), w1 = exp2f(l1 - m), w2 = exp2f(l2 - m);
        const float o = (w0 * bf2f(OG[e]) + w1 * bf2f(OG[(size_t)T * DM + e]) + w2 * bf2f(OG[(size_t)2 * T * DM + e])) / (w0 + w1 + w2);
        O[e] = (bf16)f2bf(o);
    }
}
__device__ __forceinline__ void ph_peer_route(const bf16* qry, const float* subk, int* eidx, float* gw, unsigned char* smem) {
    float* s = (float*)smem;
    float* sv = s + 2048;
    int* si = (int*)(sv + 256);
    float* qf = (float*)(si + 256);
    const int tid = tidx(), lane = tid & 63, wave = tid >> 6;
    for (int t = bidx(); t < T; t += gridDim.x) {
        __syncthreads();
        for (int e = tid; e < 2048; e += NT) qf[e] = bf2f(qry[(size_t)t * 2048 + e]);
        __syncthreads();
        for (int e = tid; e < 2048; e += NT) {
            const int hc = e >> 7, k = e & 127; const float* kp = subk + ((size_t)hc * 128 + k) * 128; float a = 0.f;
            for (int d = 0; d < 128; ++d) a += qf[hc * 128 + d] * kp[d];
            s[e] = a;
        }
        __syncthreads();
        for (int hc = wave; hc < 16; hc += NT / 64) {
            float v0 = s[hc * 128 + lane], v1 = s[hc * 128 + 64 + lane];
            for (int r = 0; r < 16; ++r) {
                float bv = v0; int bi = lane;
                if (v1 > bv) { bv = v1; bi = lane + 64; }
#pragma unroll
                for (int o = 1; o < 64; o <<= 1) { const float ov = __shfl_xor(bv, o); const int oi = __shfl_xor(bi, o); if (ov > bv || (ov == bv && oi < bi)) { bv = ov; bi = oi; } }
                if (lane == 0) { sv[hc * 16 + r] = bv; si[hc * 16 + r] = bi; }
                if (bi == lane) v0 = -3e38f; if (bi == lane + 64) v1 = -3e38f;
            }
        }
        __syncthreads();
        {   const int h = wave;
            float c[4]; int ci[4];
#pragma unroll
            for (int i = 0; i < 4; ++i) { const int f = lane + 64 * i; c[i] = sv[(h * 2) * 16 + (f >> 4)] + sv[(h * 2 + 1) * 16 + (f & 15)]; ci[i] = f; }
            float cv[16]; int cf[16];
#pragma unroll
            for (int r = 0; r < 16; ++r) {
                float bv = c[0]; int bi = ci[0];
#pragma unroll
                for (int i = 1; i < 4; ++i) if (c[i] > bv) { bv = c[i]; bi = ci[i]; }
#pragma unroll
                for (int o = 1; o < 64; o <<= 1) { const float ov = __shfl_xor(bv, o); const int oi = __shfl_xor(bi, o); if (ov > bv || (ov == bv && oi < bi)) { bv = ov; bi = oi; } }
                cv[r] = bv; cf[r] = bi;
#pragma unroll
                for (int i = 0; i < 4; ++i) if (ci[i] == bi) c[i] = -3e38f;
            }
            float l = 0.f;
#pragma unroll
            for (int r = 0; r < 16; ++r) l += __expf(cv[r] - cv[0]);
            if (lane < 16) {
                float myv = 0.f; int myf = 0;
#pragma unroll
                for (int r = 0; r < 16; ++r) if (r == lane) { myv = cv[r]; myf = cf[r]; }
                eidx[(size_t)t * 128 + h * 16 + lane] = si[(h * 2) * 16 + (myf >> 4)] * 128 + si[(h * 2 + 1) * 16 + (myf & 15)];
                gw[(size_t)t * 128 + h * 16 + lane] = __expf(myv - cv[0]) / l;
            }
        }
    }
}
__device__ __forceinline__ float gelu_tanh(float x) { const float u = 0.7978845608028654f * (x + 0.044715f * x * x * x); return 0.5f * x * (1.f + tanhf(u)); }
__device__ __forceinline__ void ph_peer_gather(const bf16* xn, const int* eidx, const float* gw, const float* U, const float* V, float* h, unsigned char* smem) {
    float* xf = (float*)smem;
    float* w = xf + 1024;
    int* ei = (int*)(w + 128);
    const int tid = tidx(), lane = tid & 63, wave = tid >> 6;
    for (int t = bidx(); t < T; t += gridDim.x) {
        __syncthreads();
        for (int e = tid; e < 1024; e += NT) xf[e] = bf2f(xn[(size_t)t * DM + e]);
        if (tid < 128) ei[tid] = eidx[(size_t)t * 128 + tid];
        __syncthreads();
        for (int e = wave; e < 128; e += NT / 64) {
            const float* up = U + (size_t)ei[e] * DM; float a = 0.f;
            for (int d = lane; d < 1024; d += 64) a += xf[d] * up[d];
            a = wave_sum(a);
            if (lane == 0) w[e] = gw[(size_t)t * 128 + e] * gelu_tanh(a);
        }
        __syncthreads();
        for (int d = tid; d < 1024; d += NT) {
            float o = 0.f;
            for (int e = 0; e < 128; ++e) o += w[e] * V[(size_t)ei[e] * DM + d];
            h[(size_t)t * DM + d] += o;
        }
    }
}

namespace pg8 {
#define PG8_LAS __attribute__((address_space(3)))
typedef unsigned short bf16_t;
typedef short bf16x8 __attribute__((ext_vector_type(8)));
typedef float f32x4 __attribute__((ext_vector_type(4)));
typedef unsigned u32x4 __attribute__((ext_vector_type(4)));
constexpr int BM = 256, BK = 64, HALF = 128, HTB = HALF * BK * 2  , STAGE_BYTES = 8 * HTB, NXCD = 8, WGM = 8;

__host__ __device__ __forceinline__ int lds_byte(int r, int c) { const int st = (r >> 4) * 2 + (c >> 5), rr = r & 15, cc = c & 31, ob = rr * 64 + cc * 2; return st * 1024 + (ob ^ (((ob >> 9) & 1) << 5)); }
__host__ __device__ __forceinline__ void stage_rc(int b, int& R, int& C) { const int st = b / 1024, sb = b % 1024, swz = sb ^ (((sb >> 9) & 1) << 5); R = (st >> 1) * 16 + swz / 64; C = (st & 1) * 32 + (swz % 64) / 2; }
__host__ __device__ __forceinline__ int perm32(int rho) { const int n = rho >> 4, i = rho & 15; return 8 * (i >> 2) + 4 * n + (i & 3); }

struct Unit { int pm, pn; };
struct Gemm { const bf16_t* A; const bf16_t* Bt; int M, N, K; };

struct StaticOrder {
    int nM, nN, nwg, G, c;
    __host__ __device__ void init(int M, int N, int G_, int c_) { nM = M / BM; nN = N / BM; nwg = nM * nN; G = G_; c = c_; }
    __host__ __device__ bool next(int i, Unit& u) const {
        const long L = (long)i * G + c; if (L >= nwg) return false;
        int wgid = (int)L; { const int q = nwg / NXCD, r = nwg % NXCD, xcd = wgid % NXCD, off = wgid / NXCD; wgid = (xcd < r ? xcd * (q + 1) : r * (q + 1) + (xcd - r) * q) + off; }
        const int nig = WGM * nN, gid = wgid / nig, fm = gid * WGM, gsz = (nM - fm) < WGM ? (nM - fm) : WGM;
        u.pm = fm + ((wgid % nig) % gsz); u.pn = (wgid % nig) / gsz; return true;
    }
    __device__ __forceinline__ void a_ready(const Unit&) const {}
    __device__ __forceinline__ void done(const Unit&) const {}
};


__device__ __forceinline__ unsigned pk_bf16(float lo, float hi) { typedef float f2 __attribute__((ext_vector_type(2))); typedef __bf16 b2 __attribute__((ext_vector_type(2))); f2 v = {lo, hi}; b2 b = __builtin_convertvector(v, b2); return __builtin_bit_cast(unsigned, b); }
struct EBf16 {
    static constexpr bool PERM = true, AFTER_DRAIN = false; bf16_t* O; int ldc;
    __device__ __forceinline__ void operator()(const f32x4 (&acc)[2][2][4][2], const Unit& u, int wr, int wc, int fr, int fq) const {
        const int row0 = u.pm * BM + wr * 64 + fr, col0 = u.pn * BM + wc * 32 + 8 * fq;
#pragma unroll
        for (int ai = 0; ai < 2; ++ai)
#pragma unroll
            for (int m = 0; m < 4; ++m) { bf16_t* rowp = O + (size_t)(row0 + ai * HALF + m * 16) * ldc + col0;
#pragma unroll
                for (int bj = 0; bj < 2; ++bj) { const f32x4 v0 = acc[ai][bj][m][0], v1 = acc[ai][bj][m][1];
                    u32x4 w; w.x = pk_bf16(v0[0], v0[1]); w.y = pk_bf16(v0[2], v0[3]); w.z = pk_bf16(v1[0], v1[1]); w.w = pk_bf16(v1[2], v1[3]);
                    *(u32x4*)(rowp + bj * HALF) = w; } }
    }
};
struct EResAdd {
    static constexpr bool PERM = false, AFTER_DRAIN = false; const float* base; float* out;
    __device__ __forceinline__ void operator()(const f32x4 (&acc)[2][2][4][2], const Unit& u, int wr, int wc, int fr, int fq) const {
        const int col0 = u.pn * BM + wc * 32 + 4 * fq;
#pragma unroll
        for (int ai = 0; ai < 2; ++ai)
#pragma unroll
            for (int m = 0; m < 4; ++m) { const size_t off = (size_t)(u.pm * BM + ai * HALF + wr * 64 + m * 16 + fr) * 1024 + col0;
#pragma unroll
                for (int bj = 0; bj < 2; ++bj)
#pragma unroll
                    for (int n = 0; n < 2; ++n) { const f32x4 b = *(const f32x4*)(base + off + bj * HALF + n * 16); *(f32x4*)(out + off + bj * HALF + n * 16) = b + acc[ai][bj][m][n]; } }
    }
};
struct EGate {
    static constexpr bool PERM = false, AFTER_DRAIN = false; float* h; const bf16_t* up;
    __device__ __forceinline__ void operator()(const f32x4 (&acc)[2][2][4][2], const Unit& u, int wr, int wc, int fr, int fq) const {
        const int col0 = u.pn * BM + wc * 32 + 4 * fq;
#pragma unroll
        for (int ai = 0; ai < 2; ++ai)
#pragma unroll
            for (int m = 0; m < 4; ++m) { const size_t off = (size_t)(u.pm * BM + ai * HALF + wr * 64 + m * 16 + fr) * 1024 + col0;
#pragma unroll
                for (int bj = 0; bj < 2; ++bj)
#pragma unroll
                    for (int n = 0; n < 2; ++n) { const size_t o = off + bj * HALF + n * 16; f32x4 hv = *(const f32x4*)(h + o);
                        const unsigned long long uu = *(const unsigned long long*)(up + o); const f32x4 a = acc[ai][bj][m][n];
                        hv[0] += __builtin_bit_cast(float, (unsigned)(uu << 16)) / (1.f + __expf(-a[0]));
                        hv[1] += __builtin_bit_cast(float, (unsigned)(uu & 0xffff0000ull)) / (1.f + __expf(-a[1]));
                        hv[2] += __builtin_bit_cast(float, (unsigned)((uu >> 16) & 0xffff0000ull)) / (1.f + __expf(-a[2]));
                        hv[3] += __builtin_bit_cast(float, (unsigned)((uu >> 32) & 0xffff0000ull)) / (1.f + __expf(-a[3]));
                        *(f32x4*)(h + o) = hv; } }
    }
};
template <class Epi, class Sched, bool ALIGN_EPI = false, bool SP2 = false>
__device__ __forceinline__ void gemm_phase(PG8_LAS unsigned char* lds, const Gemm g, const Sched& S, const Epi& E) {
    const int tid = tidx(), wid = __builtin_amdgcn_readfirstlane(tid >> 6), lane = tid & 63, wr = wid >> 2, wc = wid & 3, fr = lane & 15, fq = lane >> 4;
    const int K = g.K, nt = K / BK;
    unsigned voffA[2], voffB[2];
#pragma unroll
    for (int i = 0; i < 2; ++i) { int R, C; stage_rc(tid * 16 + i * 8192, R, C); const int Rb = Epi::PERM ? ((R & ~31) + perm32(R & 31)) : R;
        voffA[i] = (unsigned)(R * K + C) * 2u; voffB[i] = (unsigned)(Rb * K + C) * 2u; }
    const size_t kstep = (size_t)(BK * 2);
    const size_t hstep = (size_t)HALF * K * 2;
    const size_t tstep = 2 * hstep;
    const unsigned ldsw = (unsigned)wid * 1024u;
    const int aoff = lds_byte(wr * 64 + fr, fq * 8), boff = lds_byte(wc * 32 + fr, fq * 8);
#define PG8_SA(b, h) (((b) * 2 + (h)) * HTB)
#define PG8_SB(b, h) ((4 + (b) * 2 + (h)) * HTB)
#define PG8_STAGE(bufoff, gbase, voff) do { _Pragma("unroll") for (int _i = 0; _i < 2; ++_i) \
        __builtin_amdgcn_global_load_lds((const unsigned*)((const char*)(gbase) + (voff)[_i]), (PG8_LAS unsigned*)(lds + (bufoff) + ldsw + _i * 8192), 16, 0, 0); } while (0)
#define PG8_LDA(dst, b, h) do { _Pragma("unroll") for (int m = 0; m < 4; ++m) _Pragma("unroll") for (int k = 0; k < 2; ++k) dst[m][k] = *(const PG8_LAS bf16x8*)(lds + PG8_SA(b, h) + aoff + m * 2048 + k * 1024); } while (0)
#define PG8_LDB(dst, b, h) do { _Pragma("unroll") for (int n = 0; n < 2; ++n) _Pragma("unroll") for (int k = 0; k < 2; ++k) dst[n][k] = *(const PG8_LAS bf16x8*)(lds + PG8_SB(b, h) + boff + n * 2048 + k * 1024); } while (0)
#define PG8_MMA(ai, bj, At, Bt) do { __builtin_amdgcn_s_setprio(1); _Pragma("unroll") for (int m = 0; m < 4; ++m) _Pragma("unroll") for (int n = 0; n < 2; ++n) _Pragma("unroll") for (int k = 0; k < 2; ++k) \
        acc[ai][bj][m][n] = __builtin_amdgcn_mfma_f32_16x16x32_bf16(Bt[n][k], At[m][k], acc[ai][bj][m][n], 0, 0, 0); __builtin_amdgcn_s_setprio(0); } while (0)
#define PG8_WAIT_V(n) asm volatile("s_waitcnt vmcnt(" #n ")" ::: "memory")
#define PG8_WAIT_L(n) asm volatile("s_waitcnt lgkmcnt(" #n ")" ::: "memory")
#define PG8_BAR __builtin_amdgcn_s_barrier()
#define PG8_SCHED __builtin_amdgcn_sched_barrier(0)
    Unit cur, nxt; int ui = 0;
    if (!S.next(0, cur)) return;
    f32x4 acc[2][2][4][2];
#pragma unroll
    for (int a = 0; a < 2; ++a)
#pragma unroll
        for (int b = 0; b < 2; ++b)
#pragma unroll
            for (int m = 0; m < 4; ++m)
#pragma unroll
                for (int n = 0; n < 2; ++n) acc[a][b][m][n] = (f32x4){0.f, 0.f, 0.f, 0.f};
    bf16x8 At[4][2], B0[2][2], B1[2][2];
    const char* cA = (const char*)g.A + (size_t)cur.pm * tstep; const char* cB = (const char*)g.Bt + (size_t)cur.pn * tstep;
    S.a_ready(cur);
    if constexpr (SP2) {
        PG8_STAGE(PG8_SB(0, 0), cB, voffB); PG8_STAGE(PG8_SB(0, 1), cB + hstep, voffB); PG8_STAGE(PG8_SA(0, 0), cA, voffA); PG8_STAGE(PG8_SA(0, 1), cA + hstep, voffA);
        if (wr == 1) PG8_BAR;
        PG8_WAIT_V(2); PG8_BAR;
        PG8_STAGE(PG8_SB(1, 0), cB + kstep, voffB); PG8_STAGE(PG8_SA(1, 0), cA + kstep, voffA); PG8_STAGE(PG8_SB(1, 1), cB + hstep + kstep, voffB);
        PG8_WAIT_V(6); PG8_BAR;
    } else {
        PG8_STAGE(PG8_SB(0, 0), cB, voffB); PG8_STAGE(PG8_SA(0, 0), cA, voffA); PG8_STAGE(PG8_SB(0, 1), cB + hstep, voffB); PG8_STAGE(PG8_SA(0, 1), cA + hstep, voffA);
        if (wr == 1) PG8_BAR;
        PG8_WAIT_V(4); PG8_BAR;
        PG8_STAGE(PG8_SB(1, 0), cB + kstep, voffB); PG8_STAGE(PG8_SA(1, 0), cA + kstep, voffA); PG8_STAGE(PG8_SB(1, 1), cB + hstep + kstep, voffB);
        PG8_WAIT_V(6); PG8_BAR;
    }
    for (;;) {
        const bool has_next = S.next(ui + 1, nxt);
        const char* nA = has_next ? (const char*)g.A + (size_t)nxt.pm * tstep : cA; const char* nB = has_next ? (const char*)g.Bt + (size_t)nxt.pn * tstep : cB;
        for (int t = 0; t < nt; t += 2) {
            const bool last = (t == nt - 2);
            const char* a1 = cA + (size_t)(t + 1) * kstep;
            const char* a2 = last ? nA : cA + (size_t)(t + 2) * kstep; const char* b2 = last ? nB : cB + (size_t)(t + 2) * kstep;
            const char* a3 = a2 + kstep; const char* b3 = b2 + kstep;
            if (last && has_next) S.a_ready(nxt);
            if constexpr (SP2) {
            PG8_LDB(B0, 0, 0); PG8_LDB(B1, 0, 1); PG8_SCHED; PG8_LDA(At, 0, 0); PG8_STAGE(PG8_SA(1, 1), a1 + hstep, voffA);
            PG8_WAIT_V(8); PG8_WAIT_L(0); PG8_BAR; PG8_MMA(0, 0, At, B0); PG8_MMA(0, 1, At, B1); PG8_BAR; PG8_SCHED;
            PG8_LDA(At, 0, 1); PG8_STAGE(PG8_SB(0, 0), b2, voffB); PG8_STAGE(PG8_SB(0, 1), b2 + hstep, voffB); PG8_STAGE(PG8_SA(0, 0), a2, voffA);
            PG8_WAIT_V(8); PG8_WAIT_L(0); PG8_BAR; PG8_MMA(1, 0, At, B0); PG8_MMA(1, 1, At, B1); PG8_BAR; PG8_SCHED;
            PG8_LDB(B0, 1, 0); PG8_LDB(B1, 1, 1); PG8_SCHED; PG8_LDA(At, 1, 0); PG8_STAGE(PG8_SA(0, 1), a2 + hstep, voffA);
            PG8_WAIT_V(8); PG8_WAIT_L(0); PG8_BAR; PG8_MMA(0, 0, At, B0); PG8_MMA(0, 1, At, B1); PG8_BAR; PG8_SCHED;
            PG8_LDA(At, 1, 1); PG8_STAGE(PG8_SB(1, 0), b3, voffB); PG8_STAGE(PG8_SB(1, 1), b3 + hstep, voffB); PG8_STAGE(PG8_SA(1, 0), a3, voffA);
            PG8_WAIT_V(8); PG8_WAIT_L(0); PG8_BAR; PG8_MMA(1, 0, At, B0); PG8_MMA(1, 1, At, B1); PG8_BAR; PG8_SCHED;
            } else {
            PG8_LDB(B0, 0, 0); PG8_SCHED; PG8_LDA(At, 0, 0); PG8_STAGE(PG8_SA(1, 1), a1 + hstep, voffA);
            PG8_WAIT_L(8); PG8_BAR; PG8_WAIT_L(0); PG8_MMA(0, 0, At, B0); PG8_BAR; PG8_SCHED;
            PG8_LDB(B1, 0, 1); PG8_STAGE(PG8_SB(0, 0), b2, voffB);
            PG8_BAR; PG8_WAIT_L(0); PG8_MMA(0, 1, At, B1); PG8_BAR;
            PG8_LDA(At, 0, 1); PG8_STAGE(PG8_SA(0, 0), a2, voffA);
            PG8_BAR; PG8_WAIT_L(0); PG8_MMA(1, 0, At, B0); PG8_BAR; PG8_SCHED;
            PG8_STAGE(PG8_SB(0, 1), b2 + hstep, voffB);
            PG8_WAIT_V(6); PG8_BAR; PG8_MMA(1, 1, At, B1); PG8_BAR;
            PG8_LDB(B0, 1, 0); PG8_SCHED; PG8_LDA(At, 1, 0); PG8_STAGE(PG8_SA(0, 1), a2 + hstep, voffA);
            PG8_WAIT_L(8); PG8_BAR; PG8_WAIT_L(0); PG8_MMA(0, 0, At, B0); PG8_BAR; PG8_SCHED;
            PG8_LDB(B1, 1, 1); PG8_STAGE(PG8_SB(1, 0), b3, voffB);
            PG8_BAR; PG8_WAIT_L(0); PG8_MMA(0, 1, At, B1); PG8_BAR;
            PG8_LDA(At, 1, 1); PG8_STAGE(PG8_SA(1, 0), a3, voffA);
            PG8_BAR; PG8_WAIT_L(0); PG8_MMA(1, 0, At, B0); PG8_BAR; PG8_SCHED;
            PG8_STAGE(PG8_SB(1, 1), b3 + hstep, voffB);
            PG8_WAIT_V(6); PG8_BAR; PG8_MMA(1, 1, At, B1); PG8_BAR;
            }
        }
        if constexpr (ALIGN_EPI) { if (wr == 0) PG8_BAR; }
        if constexpr (!Epi::AFTER_DRAIN) { E(acc, cur, wr, wc, fr, fq); S.done(cur); }
        if (!has_next) break;
#pragma unroll
        for (int a = 0; a < 2; ++a)
#pragma unroll
            for (int b = 0; b < 2; ++b)
#pragma unroll
                for (int m = 0; m < 4; ++m)
#pragma unroll
                    for (int n = 0; n < 2; ++n) acc[a][b][m][n] = (f32x4){0.f, 0.f, 0.f, 0.f};
        cur = nxt; cA = nA; cB = nB; ++ui;
        if constexpr (ALIGN_EPI) { if (wr == 1) PG8_BAR; }
    }
    PG8_WAIT_V(0);
    if constexpr (!ALIGN_EPI) { if (wr == 0) PG8_BAR; }
    PG8_BAR;
    if constexpr (Epi::AFTER_DRAIN) { E.fused(acc, cur, wr, wc, fr, fq, lds, wid, lane); S.done(cur); }
#undef PG8_SA
#undef PG8_SB
#undef PG8_STAGE
#undef PG8_LDA
#undef PG8_LDB
#undef PG8_MMA
#undef PG8_WAIT_V
#undef PG8_WAIT_L
#undef PG8_BAR
#undef PG8_SCHED
}
}

#define LAS __attribute__((address_space(3)))
typedef unsigned v4u __attribute__((ext_vector_type(4)));
__device__ __forceinline__ unsigned pk2(float lo, float hi) { return f2bf(lo) | (f2bf(hi) << 16); }
__device__ __forceinline__ void transpose_item(const float* W, int K, int N, bf16* WT, float* scr, int item, int nblk, int lane) {
    const int kb = item / nblk, nb = item % nblk, k0 = 64 * kb, n0 = 32 * nb;
    const int nn = n0 + (lane & 31);
#pragma unroll 8
    for (int i = 0; i < 32; ++i) { const int kk = 2 * i + (lane >> 5); scr[kk * 33 + (lane & 31)] = (nn < N) ? W[(size_t)(k0 + kk) * N + nn] : 0.f; }
    __builtin_amdgcn_s_waitcnt(0xc07f); asm volatile("" ::: "memory");
    const int c = lane & 7;
#pragma unroll
    for (int j = 0; j < 4; ++j) { const int n = (lane >> 3) + 8 * j; const float* sp = scr + (8 * c) * 33 + n;
        v4u o; o.x = pk2(sp[0 * 33], sp[1 * 33]); o.y = pk2(sp[2 * 33], sp[3 * 33]); o.z = pk2(sp[4 * 33], sp[5 * 33]); o.w = pk2(sp[6 * 33], sp[7 * 33]);
        *(v4u*)(WT + (size_t)(n0 + n) * K + k0 + 8 * c) = o; }
    __builtin_amdgcn_s_waitcnt(0xc07f); asm volatile("" ::: "memory");
}
__device__ __forceinline__ void cvt_bf16(const float* src, bf16* dst, size_t n) {
    for (size_t e = ((size_t)bidx() * NT + tidx()) * 8; e < n; e += (size_t)gridDim.x * NT * 8) {
        const f32x4 a = *(const f32x4*)(src + e), b = *(const f32x4*)(src + e + 4);
        v4u o; o.x = pk2(a.x, a.y); o.y = pk2(a.z, a.w); o.z = pk2(b.x, b.y); o.w = pk2(b.z, b.w);
        *(v4u*)(dst + e) = o; }
}
__device__ __forceinline__ void transpose_matrix(const float* W, int K, int N, int Npad, bf16* WT, float* scr, int gw, int ngw, int lane) {
    const int nblk = Npad / 32, nit = (K / 64) * nblk;
    for (int it = gw; it < nit; it += ngw) transpose_item(W, K, N, WT, scr, it, nblk, lane);
}
__device__ __forceinline__ void ph_prologue(unsigned char* smem) {
    const int lane = tidx() & 63, wave = tidx() >> 6;
    float* scr = (float*)smem + wave * (64 * 33);
    const int gw = bidx() * (NT / 64) + wave, ngw = gridDim.x * (NT / 64);
    unsigned char* ws = WSP;
    transpose_matrix(IN(6), 1024, AB_N, AB_LD, (bf16*)(ws + WS_WAB_IN), scr, gw, ngw, lane);
    transpose_matrix(IN(7), 1024, 1024, 1024, (bf16*)(ws + WS_WAB_OUT), scr, gw, ngw, lane);
    transpose_matrix(IN(12), 1024, 3072, 3072, (bf16*)(ws + WS_WC_IN), scr, gw, ngw, lane);
    transpose_matrix(IN(13), 1024, 1024, 1024, (bf16*)(ws + WS_WC_OUT), scr, gw, ngw, lane);
#pragma unroll 1
    for (int L = 0; L < 2; ++L) {
        transpose_matrix(IN(16) + (size_t)L * DM * 2048, 1024, 2048, 2048, (bf16*)(ws + WS_WQ + (size_t)L * 4 * MiB), scr, gw, ngw, lane);
        transpose_matrix(IN(20) + (size_t)L * DM * DM, 1024, 1024, 1024, (bf16*)(ws + WS_WG + (size_t)L * 2 * MiB), scr, gw, ngw, lane);
        transpose_matrix(IN(21) + (size_t)L * 256 * DM, 256, 1024, 1024, (bf16*)(ws + WS_WUP + (size_t)L * (MiB / 2)), scr, gw, ngw, lane);
    }
    cvt_bf16(IN(1), (bf16*)(ws + WS_P), (size_t)2 * T * 256);
    cvt_bf16(IN(17), (bf16*)(ws + WS_SUBK), (size_t)2 * 16 * 128 * 128);
#pragma unroll 1
    for (int L = 0; L < 2; ++L) {
        cvt_bf16(IN(18) + (size_t)L * NEXP * DM, (bf16*)(ws + WS_EXP + (size_t)(2 * L) * 32 * MiB), (size_t)NEXP * DM);
        cvt_bf16(IN(19) + (size_t)L * NEXP * DM, (bf16*)(ws + WS_EXP + (size_t)(2 * L + 1) * 32 * MiB), (size_t)NEXP * DM);
    }
}


typedef __bf16 bf2_t __attribute__((ext_vector_type(2)));
typedef unsigned u32x4g __attribute__((ext_vector_type(4)));
__device__ __forceinline__ float dot2u(unsigned a, unsigned b, float c) { return __builtin_amdgcn_fdot2_f32_bf16(__builtin_bit_cast(bf2_t, a), __builtin_bit_cast(bf2_t, b), c, false); }
__device__ __forceinline__ float dot8(u32x4g a, u32x4g b, float c) {
    c = dot2u(a[0], b[0], c); c = dot2u(a[1], b[1], c); c = dot2u(a[2], b[2], c); c = dot2u(a[3], b[3], c);
    return c;
}
__device__ __forceinline__ float bflo(unsigned d) { return __builtin_bit_cast(float, d << 16); }
__device__ __forceinline__ float bfhi(unsigned d) { return __builtin_bit_cast(float, d & 0xffff0000u); }
#define GATHER_U8(EREG, B) do { float s_[8]; \
    _Pragma("unroll") for (int k = 0; k < 8; ++k) { const int idx = __builtin_amdgcn_readlane(EREG, ((B) * 8 + k) & 63); \
        const u32x4g* up = (const u32x4g*)(U + (size_t)idx * DM); const u32x4g u0 = up[lane], u1 = up[64 + lane]; s_[k] = dot8(x1, u1, dot8(x0, u0, 0.f)); } \
    float r_[4]; const bool b5 = lane & 32, b4 = lane & 16, b3 = lane & 8; \
    _Pragma("unroll") for (int i = 0; i < 4; ++i) { const float snd = b5 ? s_[i] : s_[4 + i], kp = b5 ? s_[4 + i] : s_[i]; r_[i] = kp + __shfl_xor(snd, 32); } \
    float q_[2]; \
    _Pragma("unroll") for (int i = 0; i < 2; ++i) { const float snd = b4 ? r_[i] : r_[2 + i], kp = b4 ? r_[2 + i] : r_[i]; q_[i] = kp + __shfl_xor(snd, 16); } \
    float p_; { const float snd = b3 ? q_[0] : q_[1], kp = b3 ? q_[1] : q_[0]; p_ = kp + __shfl_xor(snd, 8); } \
    p_ += __shfl_xor(p_, 4); p_ += __shfl_xor(p_, 2); p_ += __shfl_xor(p_, 1); \
    if ((lane & 7) == 0) al[(B) * 8 + (lane >> 3)] = p_; } while (0)
#define GATHER_V8(EREG, WREG, B) do { \
    _Pragma("unroll") for (int k = 0; k < 8; ++k) { const int idx = __builtin_amdgcn_readlane(EREG, ((B) * 8 + k) & 63); \
        const float w = __builtin_bit_cast(float, __builtin_amdgcn_readlane(__builtin_bit_cast(int, WREG), ((B) * 8 + k) & 63)); \
        const u32x4g* vp = (const u32x4g*)(V + (size_t)idx * DM); const u32x4g v0 = vp[lane], v1 = vp[64 + lane]; \
        acc[0] += w * bflo(v0.x); acc[1] += w * bfhi(v0.x); acc[2] += w * bflo(v0.y); acc[3] += w * bfhi(v0.y); \
        acc[4] += w * bflo(v0.z); acc[5] += w * bfhi(v0.z); acc[6] += w * bflo(v0.w); acc[7] += w * bfhi(v0.w); \
        acc[8] += w * bflo(v1.x); acc[9] += w * bfhi(v1.x); acc[10] += w * bflo(v1.y); acc[11] += w * bfhi(v1.y); \
        acc[12] += w * bflo(v1.z); acc[13] += w * bfhi(v1.z); acc[14] += w * bflo(v1.w); acc[15] += w * bfhi(v1.w); } } while (0)
__device__ __forceinline__ void ph_peer_gather_opt(const int* eidx, const float* gw, const bf16* U, const bf16* V, float* h, const float* gain_next, bf16* XN, unsigned char* smem) {
    const int tid = tidx(), lane = tid & 63, wave = tid >> 6;
    float* al = (float*)smem + wave * 128;
    const int gwv = bidx() * (NT / 64) + wave, ngw = gridDim.x * (NT / 64);
    for (int t = gwv; t < T; t += ngw) {
        const u32x4g x0 = *(const u32x4g*)(XN + (size_t)t * DM + 8 * lane), x1 = *(const u32x4g*)(XN + (size_t)t * DM + 512 + 8 * lane);
        const int e0 = eidx[(size_t)t * 128 + lane], e1 = eidx[(size_t)t * 128 + 64 + lane];
        const float g0 = gw[(size_t)t * 128 + lane], g1 = gw[(size_t)t * 128 + 64 + lane];
#pragma unroll 1
        for (int b = 0; b < 8; ++b) GATHER_U8(e0, b);
#pragma unroll 1
        for (int b = 8; b < 16; ++b) GATHER_U8(e1, b);
        __builtin_amdgcn_s_waitcnt(0xc07f); asm volatile("" ::: "memory");
        const float w0 = g0 * gelu_tanh(al[lane]), w1 = g1 * gelu_tanh(al[64 + lane]);
        float acc[16];
#pragma unroll
        for (int i = 0; i < 16; ++i) acc[i] = 0.f;
#pragma unroll 1
        for (int b = 0; b < 8; ++b) GATHER_V8(e0, w0, b);
#pragma unroll 1
        for (int b = 8; b < 16; ++b) GATHER_V8(e1, w1, b);
        float* hp = h + (size_t)t * DM + 8 * lane;
        f32x4 h0 = *(f32x4*)(hp), h1 = *(f32x4*)(hp + 4), h2 = *(f32x4*)(hp + 512), h3 = *(f32x4*)(hp + 516);
        h0 += (f32x4){acc[0], acc[1], acc[2], acc[3]}; h1 += (f32x4){acc[4], acc[5], acc[6], acc[7]};
        h2 += (f32x4){acc[8], acc[9], acc[10], acc[11]}; h3 += (f32x4){acc[12], acc[13], acc[14], acc[15]};
        *(f32x4*)(hp) = h0; *(f32x4*)(hp + 4) = h1; *(f32x4*)(hp + 512) = h2; *(f32x4*)(hp + 516) = h3;
        float ss = 0.f;
#pragma unroll
        for (int i = 0; i < 4; ++i) ss += h0[i] * h0[i] + h1[i] * h1[i] + h2[i] * h2[i] + h3[i] * h3[i];
        const float rstd = 1.0f / sqrtf(wave_sum(ss) * (1.0f / DM) + NORM_EPS);
        const f32x4 ga = *(const f32x4*)(gain_next + 8 * lane), gb = *(const f32x4*)(gain_next + 8 * lane + 4), gc = *(const f32x4*)(gain_next + 512 + 8 * lane), gd = *(const f32x4*)(gain_next + 516 + 8 * lane);
        u32x4g o0, o1;
        o0.x = pk2(h0[0] * rstd * ga[0], h0[1] * rstd * ga[1]); o0.y = pk2(h0[2] * rstd * ga[2], h0[3] * rstd * ga[3]);
        o0.z = pk2(h1[0] * rstd * gb[0], h1[1] * rstd * gb[1]); o0.w = pk2(h1[2] * rstd * gb[2], h1[3] * rstd * gb[3]);
        o1.x = pk2(h2[0] * rstd * gc[0], h2[1] * rstd * gc[1]); o1.y = pk2(h2[2] * rstd * gc[2], h2[3] * rstd * gc[3]);
        o1.z = pk2(h3[0] * rstd * gd[0], h3[1] * rstd * gd[1]); o1.w = pk2(h3[2] * rstd * gd[2], h3[3] * rstd * gd[3]);
        *(u32x4g*)(XN + (size_t)t * DM + 8 * lane) = o0; *(u32x4g*)(XN + (size_t)t * DM + 512 + 8 * lane) = o1;
    }
}


typedef short bf16x8r __attribute__((ext_vector_type(8)));
typedef float f32x16r __attribute__((ext_vector_type(16)));
__device__ __forceinline__ float unokey(unsigned k) { const unsigned u = (k & 0x80000000u) ? (k & 0x7fffffffu) : ~k; return __builtin_bit_cast(float, u); }
#define CE_D(a, b) do { const unsigned mx_ = max(a, b), mn_ = min(a, b); a = mx_; b = mn_; } while (0)
#define SORT16_DESC(v, base) do { \
    _Pragma("unroll") for (int k_ = 2; k_ <= 16; k_ <<= 1) \
    _Pragma("unroll") for (int j_ = k_ >> 1; j_ > 0; j_ >>= 1) \
    _Pragma("unroll") for (int i_ = 0; i_ < 16; ++i_) { const int l_ = i_ ^ j_; if (l_ > i_) { if ((i_ & k_) == 0) CE_D(v[(base) + i_], v[(base) + l_]); else CE_D(v[(base) + l_], v[(base) + i_]); } } } while (0)
#define BMERGE16_DESC(v, base) do { \
    _Pragma("unroll") for (int j_ = 8; j_ > 0; j_ >>= 1) \
    _Pragma("unroll") for (int i_ = 0; i_ < 16; ++i_) { const int l_ = i_ ^ j_; if (l_ > i_) CE_D(v[(base) + i_], v[(base) + l_]); } } while (0)
#define TOPMERGE16(v, a, b) do { _Pragma("unroll") for (int i_ = 0; i_ < 16; ++i_) v[(a) + i_] = max(v[(a) + i_], v[(b) + 15 - i_]); BMERGE16_DESC(v, a); } while (0)
#define PARTNER_TOP16(v) do { unsigned o_[16]; _Pragma("unroll") for (int i_ = 0; i_ < 16; ++i_) o_[i_] = (unsigned)__shfl_xor((int)v[15 - i_], 32); \
    _Pragma("unroll") for (int i_ = 0; i_ < 16; ++i_) v[i_] = max(v[i_], o_[i_]); BMERGE16_DESC(v, 0); } while (0)
constexpr int SK_ROW = 272;
__device__ __forceinline__ void ph_peer_route_opt(const bf16* qry, const bf16* subk, int* eidx, float* gw, unsigned char* smem) {
    const int tid = tidx(), lane = tid & 63, wave = tid >> 6, r32 = lane & 31, hi = lane >> 5;
    for (int unit = bidx(); unit < 512; unit += gridDim.x) {
        const int h = unit & 7, tb = unit >> 3;
        __syncthreads();
        for (int i = tid; i < 4096; i += NT) { const int row = i >> 4, ch = i & 15;
            *(u32x4g*)(smem + row * SK_ROW + ch * 16) = *(const u32x4g*)(subk + ((size_t)(h * 2) * 128 + row) * 128 + ch * 8); }
        __syncthreads();
        const int trow = tb * 256 + wave * 32 + r32;
        unsigned top[2][16];
#pragma unroll
        for (int c = 0; c < 2; ++c) {
            f32x16r acc[4];
#pragma unroll
            for (int kb = 0; kb < 4; ++kb) acc[kb] = (f32x16r){0.f, 0.f, 0.f, 0.f, 0.f, 0.f, 0.f, 0.f, 0.f, 0.f, 0.f, 0.f, 0.f, 0.f, 0.f, 0.f};
#pragma unroll
            for (int ks = 0; ks < 8; ++ks) {
                const bf16x8r bq = *(const bf16x8r*)(qry + (size_t)trow * 2048 + h * 256 + c * 128 + ks * 16 + 8 * hi);
#pragma unroll
                for (int kb = 0; kb < 4; ++kb) {
                    const bf16x8r ak = *(const bf16x8r*)(smem + (c * 128 + kb * 32 + r32) * SK_ROW + (ks * 16 + 8 * hi) * 2);
                    acc[kb] = __builtin_amdgcn_mfma_f32_32x32x16_bf16(ak, bq, acc[kb], 0, 0, 0);
                }
            }
            unsigned k[64];
#pragma unroll
            for (int kb = 0; kb < 4; ++kb)
#pragma unroll
                for (int r = 0; r < 16; ++r) { const float sc = acc[kb][r]; const int idx = kb * 32 + (r & 3) + 8 * (r >> 2) + 4 * hi;
                    k[kb * 16 + r] = (okey(sc) & 0xffffff80u) | (unsigned)(127 - idx); }
            SORT16_DESC(k, 0); SORT16_DESC(k, 16); SORT16_DESC(k, 32); SORT16_DESC(k, 48);
            TOPMERGE16(k, 0, 16); TOPMERGE16(k, 32, 48); TOPMERGE16(k, 0, 32);
            PARTNER_TOP16(k);
#pragma unroll
            for (int i = 0; i < 16; ++i) top[c][i] = k[i];
        }
        float va[16], vb[16];
#pragma unroll
        for (int i = 0; i < 16; ++i) { va[i] = unokey((top[0][i] & 0xffffff80u) | 0x40u); vb[i] = unokey((top[1][i] & 0xffffff80u) | 0x40u); }
        unsigned ck[32];
        ck[0] = (okey(hi ? (va[2] + vb[1]) : (va[0] + vb[0])) & 0xffffff00u) | (hi ? 222u : 255u);
        ck[1] = (okey(hi ? (va[2] + vb[2]) : (va[0] + vb[1])) & 0xffffff00u) | (hi ? 221u : 254u);
        ck[2] = (okey(hi ? (va[2] + vb[3]) : (va[0] + vb[2])) & 0xffffff00u) | (hi ? 220u : 253u);
        ck[3] = (okey(hi ? (va[2] + vb[4]) : (va[0] + vb[3])) & 0xffffff00u) | (hi ? 219u : 252u);
        ck[4] = (okey(hi ? (va[3] + vb[0]) : (va[0] + vb[4])) & 0xffffff00u) | (hi ? 207u : 251u);
        ck[5] = (okey(hi ? (va[3] + vb[1]) : (va[0] + vb[5])) & 0xffffff00u) | (hi ? 206u : 250u);
        ck[6] = (okey(hi ? (va[3] + vb[2]) : (va[0] + vb[6])) & 0xffffff00u) | (hi ? 205u : 249u);
        ck[7] = (okey(hi ? (va[3] + vb[3]) : (va[0] + vb[7])) & 0xffffff00u) | (hi ? 204u : 248u);
        ck[8] = (okey(hi ? (va[4] + vb[0]) : (va[0] + vb[8])) & 0xffffff00u) | (hi ? 191u : 247u);
        ck[9] = (okey(hi ? (va[4] + vb[1]) : (va[0] + vb[9])) & 0xffffff00u) | (hi ? 190u : 246u);
        ck[10] = (okey(hi ? (va[4] + vb[2]) : (va[0] + vb[10])) & 0xffffff00u) | (hi ? 189u : 245u);
        ck[11] = (okey(hi ? (va[5] + vb[0]) : (va[0] + vb[11])) & 0xffffff00u) | (hi ? 175u : 244u);
        ck[12] = (okey(hi ? (va[5] + vb[1]) : (va[0] + vb[12])) & 0xffffff00u) | (hi ? 174u : 243u);
        ck[13] = (okey(hi ? (va[6] + vb[0]) : (va[0] + vb[13])) & 0xffffff00u) | (hi ? 159u : 242u);
        ck[14] = (okey(hi ? (va[6] + vb[1]) : (va[0] + vb[14])) & 0xffffff00u) | (hi ? 158u : 241u);
        ck[15] = (okey(hi ? (va[7] + vb[0]) : (va[0] + vb[15])) & 0xffffff00u) | (hi ? 143u : 240u);
        ck[16] = (okey(hi ? (va[7] + vb[1]) : (va[1] + vb[0])) & 0xffffff00u) | (hi ? 142u : 239u);
        ck[17] = (okey(hi ? (va[8] + vb[0]) : (va[1] + vb[1])) & 0xffffff00u) | (hi ? 127u : 238u);
        ck[18] = (okey(hi ? (va[9] + vb[0]) : (va[1] + vb[2])) & 0xffffff00u) | (hi ? 111u : 237u);
        ck[19] = (okey(hi ? (va[10] + vb[0]) : (va[1] + vb[3])) & 0xffffff00u) | (hi ? 95u : 236u);
        ck[20] = (okey(hi ? (va[11] + vb[0]) : (va[1] + vb[4])) & 0xffffff00u) | (hi ? 79u : 235u);
        ck[21] = (okey(hi ? (va[12] + vb[0]) : (va[1] + vb[5])) & 0xffffff00u) | (hi ? 63u : 234u);
        ck[22] = (okey(hi ? (va[13] + vb[0]) : (va[1] + vb[6])) & 0xffffff00u) | (hi ? 47u : 233u);
        ck[23] = (okey(hi ? (va[14] + vb[0]) : (va[1] + vb[7])) & 0xffffff00u) | (hi ? 31u : 232u);
        ck[24] = (okey(hi ? (va[15] + vb[0]) : (va[2] + vb[0])) & 0xffffff00u) | (hi ? 15u : 223u);
#pragma unroll
        for (int s = 25; s < 32; ++s) ck[s] = 0u;
        SORT16_DESC(ck, 0); SORT16_DESC(ck, 16); TOPMERGE16(ck, 0, 16);
        PARTNER_TOP16(ck);
        const float m = unokey((ck[0] & 0xffffff00u) | 0x80u);
        float l = 0.f;
#pragma unroll
        for (int r = 0; r < 16; ++r) l += __expf(unokey((ck[r] & 0xffffff00u) | 0x80u) - m);
        const float linv = 1.0f / l;
        unsigned p0[4], p1[4];
#pragma unroll
        for (int w = 0; w < 4; ++w) { p0[w] = 0u; p1[w] = 0u;
#pragma unroll
            for (int b = 0; b < 4; ++b) { p0[w] |= (127u - (top[0][4 * w + b] & 127u)) << (8 * b); p1[w] |= (127u - (top[1][4 * w + b] & 127u)) << (8 * b); } }
        int eo[8]; float go[8]; const unsigned hmask = 0u - (unsigned)hi;
#pragma unroll
        for (int rr = 0; rr < 8; ++rr) {
            const unsigned key = ck[rr] ^ ((ck[rr] ^ ck[8 + rr]) & hmask);
            const unsigned flat = 255u - (key & 255u), i = flat >> 4, j = flat & 15u;
            const unsigned wi = (i >> 2) == 0 ? p0[0] : ((i >> 2) == 1 ? p0[1] : ((i >> 2) == 2 ? p0[2] : p0[3]));
            const unsigned wj = (j >> 2) == 0 ? p1[0] : ((j >> 2) == 1 ? p1[1] : ((j >> 2) == 2 ? p1[2] : p1[3]));
            const unsigned i0 = (wi >> ((i & 3u) * 8u)) & 255u, i1 = (wj >> ((j & 3u) * 8u)) & 255u;
            eo[rr] = (int)(i0 * 128u + i1);
            go[rr] = __expf(unokey((key & 0xffffff00u) | 0x80u) - m) * linv;
        }
        int* ep = eidx + (size_t)trow * 128 + h * 16 + 8 * hi; float* gp = gw + (size_t)trow * 128 + h * 16 + 8 * hi;
        typedef int i32x4 __attribute__((ext_vector_type(4)));
        *(i32x4*)ep = (i32x4){eo[0], eo[1], eo[2], eo[3]}; *(i32x4*)(ep + 4) = (i32x4){eo[4], eo[5], eo[6], eo[7]};
        *(f32x4*)gp = (f32x4){go[0], go[1], go[2], go[3]}; *(f32x4*)(gp + 4) = (f32x4){go[4], go[5], go[6], go[7]};
    }
}

namespace cg = cooperative_groups;
constexpr int LDS_BYTES = 147456;
#define GEMM_PHASE(EPI, Aptr, Bptr, Nn, Kk, ...) do { pg8::Gemm g_{(const pg8::bf16_t*)(Aptr), (const pg8::bf16_t*)(Bptr), T, (Nn), (Kk)}; pg8::StaticOrder S_; S_.init(T, (Nn), (int)gridDim.x, (int)bidx()); \
    pg8::EPI E_{__VA_ARGS__}; pg8::gemm_phase<pg8::EPI, pg8::StaticOrder, true, true>((PG8_LAS unsigned char*)smem, g_, S_, E_); } while (0)
__global__ void __launch_bounds__(NT, 2) k_mega(Params P) {
    extern __shared__ __attribute__((aligned(16))) unsigned char smem[];
    cg::grid_group grid = cg::this_grid();
#define BAR() grid.sync()
    ph_prologue(smem);
    ph_rmsnorm(IN(0), IN(3), (bf16*)(WSP + WS_XN)); BAR();
    { unsigned char* ws = WSP; GEMM_PHASE(EBf16, ws + WS_XN, ws + WS_WAB_IN, AB_LD, DM, (bf16*)(ws + WS_QKV), AB_LD); } BAR();
    ph_prep0((bf16*)(WSP + WS_QKV), (const int*)IN(2), IN(8), IN(9), IN(10), IN(11)); BAR();
    { unsigned char* ws = WSP; ph_kmean((bf16*)(ws + WS_QKV), (float*)(ws + WS_KMEAN)); } BAR();
    { unsigned char* ws = WSP; ph_moba_select((bf16*)(ws + WS_QKV), (float*)(ws + WS_KMEAN), (unsigned*)(ws + WS_SEL)); } BAR();
    { unsigned char* ws = WSP; ph_moba_attend((bf16*)(ws + WS_QKV), (unsigned*)(ws + WS_SEL), (bf16*)(ws + WS_XN), smem); }
    { unsigned char* ws = WSP; ph_dsa_select((bf16*)(ws + WS_QKV), (unsigned long long*)(ws + WS_MASK), smem); } BAR();
    { unsigned char* ws = WSP; ph_dsa_attend((bf16*)(ws + WS_QKV), (unsigned long long*)(ws + WS_MASK), (bf16*)(ws + WS_XN), smem); } BAR();
    { unsigned char* ws = WSP; GEMM_PHASE(EResAdd, ws + WS_XN, ws + WS_WAB_OUT, DM, DM, IN(0), OUTP); } BAR();
#pragma unroll 1
    for (int L = 0; L < 2; ++L) {
        if (L == 1) {
            ph_rmsnorm(OUTP, IN(3) + DM, (bf16*)(WSP + WS_XN)); BAR();
            { unsigned char* ws = WSP; GEMM_PHASE(EBf16, ws + WS_XN, ws + WS_WC_IN, C_LD, DM, (bf16*)(ws + WS_QKV1), C_LD); } BAR();
            ph_prep1((bf16*)(WSP + WS_QKV1), (const int*)IN(2), IN(14), IN(15)); BAR();
            { unsigned char* ws = WSP; ph_dilated((bf16*)(ws + WS_QKV1), (bf16*)(ws + WS_OG), (float*)(ws + WS_LSE)); } BAR();
            { unsigned char* ws = WSP; ph_dil_merge((bf16*)(ws + WS_OG), (float*)(ws + WS_LSE), (bf16*)(ws + WS_XN)); } BAR();
            { unsigned char* ws = WSP; float* hb = OUTP; GEMM_PHASE(EResAdd, ws + WS_XN, ws + WS_WC_OUT, DM, DM, hb, hb); } BAR();
        }
        ph_rmsnorm(OUTP, IN(4) + L * DM, (bf16*)(WSP + WS_XN)); BAR();
        { unsigned char* ws = WSP; GEMM_PHASE(EBf16, ws + WS_XN, ws + WS_WQ + (size_t)L * 4 * MiB, 2048, DM, (bf16*)(ws + WS_QRY), 2048); } BAR();
        { unsigned char* ws = WSP; ph_peer_route_opt((bf16*)(ws + WS_QRY), (bf16*)(ws + WS_SUBK) + (size_t)L * 16 * 128 * 128, (int*)(ws + WS_EIDX), (float*)(ws + WS_GW), smem); } BAR();
        { unsigned char* ws = WSP; ph_peer_gather_opt((int*)(ws + WS_EIDX), (float*)(ws + WS_GW), (bf16*)(ws + WS_EXP + (size_t)(2 * L) * 32 * MiB), (bf16*)(ws + WS_EXP + (size_t)(2 * L + 1) * 32 * MiB), OUTP, IN(5) + L * DM, (bf16*)(ws + WS_XN), smem); }
        __syncthreads();
        { unsigned char* ws = WSP; GEMM_PHASE(EBf16, ws + WS_P + (size_t)L * T * 256 * 2, ws + WS_WUP + (size_t)L * (MiB / 2), DM, 256, (bf16*)(ws + WS_UP), DM); } BAR();
        { unsigned char* ws = WSP; GEMM_PHASE(EGate, ws + WS_XN, ws + WS_WG + (size_t)L * 2 * MiB, DM, DM, OUTP, (bf16*)(ws + WS_UP)); } BAR();
    }
}

extern "C" void kernel_launch(void* const* d_in, const int* in_sizes, int n_in, void* d_out, int out_size, void* d_ws, size_t ws_size, hipStream_t stream) {
    static int grid_blocks = 0;
    if (grid_blocks == 0) {
        if (n_in != 22 || out_size != T * DM || ws_size < WS_END) { fprintf(stderr, "kernel_launch: unexpected shapes: n_in %d out %d ws %zu\n", n_in, out_size, ws_size); grid_blocks = -1; return; }
        if (hipFuncSetAttribute((const void*)k_mega, hipFuncAttributeMaxDynamicSharedMemorySize, LDS_BYTES) != hipSuccess) { fprintf(stderr, "hipFuncSetAttribute failed\n"); grid_blocks = -1; return; }
        int dev = 0, cus = 0, per_cu = 0;
        hipGetDevice(&dev);
        hipDeviceGetAttribute(&cus, hipDeviceAttributeMultiprocessorCount, dev);
        hipOccupancyMaxActiveBlocksPerMultiprocessor(&per_cu, (const void*)k_mega, NT, LDS_BYTES);
        if (per_cu < 1 || cus < 1) { fprintf(stderr, "kernel_launch: occupancy query says %d blocks/CU on %d CUs\n", per_cu, cus); grid_blocks = -1; return; }
        grid_blocks = cus;
    }
    if (grid_blocks < 0) return;
    Params P{};
    for (int i = 0; i < 22; ++i) P.in[i] = (const float*)d_in[i];
    P.out = (float*)d_out; P.ws = (unsigned char*)d_ws;
    void* args[] = {&P};
    hipError_t e = hipLaunchCooperativeKernel((const void*)k_mega, dim3(grid_blocks), dim3(NT), args, LDS_BYTES, stream);
    if (e != hipSuccess) fprintf(stderr, "cooperative launch failed: %s (grid %d)\n", hipGetErrorString(e), grid_blocks);
}
```

```cpp
#include <hip/hip_runtime.h>
#include <hip/hip_cooperative_groups.h>
#include <cstdio>
#include <cstdint>

constexpr int BATCH = 2, SEQ = 8192, T = BATCH * SEQ, DM = 1024;
constexpr int AB_N = 3396, AB_LD = 3584;
constexpr int CQA = 0, CKA = 512, CVA = 1024, CQB = 1536, CKB = 2048, CVB = 2560, CQI = 3072, CKI = 3328, CWI = 3392;
constexpr int C_LD = 3072;
constexpr int NEXP = 16384;
constexpr float NORM_EPS = 1e-6f;
constexpr float C2 = 0.125f * 1.4426950408889634f;
constexpr int NT = 512;

constexpr size_t MiB = 1u << 20;
constexpr size_t WS_CTL = 0;
constexpr size_t WS_WAB_IN = 1 * MiB, WS_WAB_OUT = 8 * MiB, WS_WC_IN = 10 * MiB, WS_WC_OUT = 16 * MiB;
constexpr size_t WS_WQ = 18 * MiB, WS_WG = 26 * MiB, WS_WUP = 30 * MiB, WS_SUBK = 31 * MiB;
constexpr size_t WS_KMEAN = 32 * MiB;
constexpr size_t WS_SEL = 33 * MiB;
constexpr size_t WS_LSE = 34 * MiB;
constexpr size_t WS_EIDX = 37 * MiB;
constexpr size_t WS_GW = 45 * MiB;
constexpr size_t WS_P = 53 * MiB;
constexpr size_t WS_XN = 69 * MiB;
constexpr size_t WS_QKV = 101 * MiB;
constexpr size_t WS_MASK = 213 * MiB;
constexpr size_t WS_SCORES = 229 * MiB;
constexpr size_t WS_EXP = 229 * MiB;
constexpr size_t WS_QRY = 101 * MiB;
constexpr size_t WS_UP = 165 * MiB;
constexpr size_t WS_QKV1 = 357 * MiB;
constexpr size_t WS_OG = 101 * MiB;
constexpr size_t WS_END = 512 * MiB;

typedef unsigned short bf16;
typedef float f32x4 __attribute__((ext_vector_type(4)));

__device__ __forceinline__ unsigned f2bf(float f) { unsigned u = __builtin_bit_cast(unsigned, f); return (u + 0x7fffu + ((u >> 16) & 1u)) >> 16; }
__device__ __forceinline__ float bf2f(bf16 h) { return __builtin_bit_cast(float, (unsigned)h << 16); }
__device__ __forceinline__ float wave_sum(float v) {
#pragma unroll
    for (int o = 1; o < 64; o <<= 1) v += __shfl_xor(v, o);
    return v;
}
__device__ __forceinline__ float wave_max(float v) {
#pragma unroll
    for (int o = 1; o < 64; o <<= 1) v = fmaxf(v, __shfl_xor(v, o));
    return v;
}
__device__ __forceinline__ unsigned okey(float f) { unsigned u = __builtin_bit_cast(unsigned, f); return (u & 0x80000000u) ? ~u : (u | 0x80000000u); }

__device__ __forceinline__ int tidx() { int t = __builtin_amdgcn_workitem_id_x(); asm volatile("" : "+v"(t)); return t; }
__device__ __forceinline__ int bidx() { int b = __builtin_amdgcn_workgroup_id_x(); asm volatile("" : "+s"(b)); return b; }
struct Params {
    const float* in[22];
    float* out;
    unsigned char* ws;
    int layer;
    int pad;
};

typedef const __attribute__((address_space(4))) unsigned long long* karg_t;
__device__ __forceinline__ unsigned long long karg(int idx) { karg_t ka = (karg_t)__builtin_amdgcn_kernarg_segment_ptr(); asm volatile("" : "+s"(ka)); return ka[idx]; }
#define GASP __attribute__((address_space(1)))
#define IN(i) ((const float*)(const GASP float*)karg(i))
#define OUTP ((float*)(GASP float*)karg(22))
#define WSP ((unsigned char*)(GASP unsigned char*)karg(23))

__device__ __forceinline__ void ph_rmsnorm(const float* src, const float* gain, bf16* dst) {
    const int lane = tidx() & 63, wave = tidx() >> 6;
    const int gw = bidx() * (NT / 64) + wave, ngw = gridDim.x * (NT / 64);
    for (int r = gw; r < T; r += ngw) {
        const f32x4* xr = (const f32x4*)(src + (size_t)r * DM) + lane;
        f32x4 v[4]; float s = 0.f;
#pragma unroll
        for (int j = 0; j < 4; ++j) { v[j] = xr[64 * j]; s += v[j].x * v[j].x + v[j].y * v[j].y + v[j].z * v[j].z + v[j].w * v[j].w; }
        const float rstd = 1.0f / sqrtf(wave_sum(s) * (1.0f / DM) + NORM_EPS);
#pragma unroll
        for (int j = 0; j < 4; ++j) {
            const f32x4 g = ((const f32x4*)gain)[lane + 64 * j];
            unsigned long long o = (unsigned long long)(f2bf(v[j].x * rstd * g.x) | (f2bf(v[j].y * rstd * g.y) << 16)) |
                                   ((unsigned long long)(f2bf(v[j].z * rstd * g.z) | (f2bf(v[j].w * rstd * g.w) << 16)) << 32);
            ((unsigned long long*)(dst + (size_t)r * DM))[lane + 64 * j] = o;
        }
    }
}

template <class AT> __device__ __forceinline__ float ldA(const AT* p);
template <> __device__ __forceinline__ float ldA<bf16>(const bf16* p) { return bf2f(*p); }
template <> __device__ __forceinline__ float ldA<float>(const float* p) { return *p; }

template <class AT, class Epi> __forceinline__
__device__ __forceinline__ void ph_gemm_naive(const AT* A, int lda, const float* B, int N, int K, const Epi& E, unsigned char* smem) {
    float* As = (float*)smem;
    float* Bs = As + 16 * 132;
    const int tid = tidx(), ty = tid >> 5, tx = tid & 31;
    const int ntn = (N + 127) / 128, ntm = T / 128, ntile = ntn * ntm;
    for (int tile = bidx(); tile < ntile; tile += gridDim.x) {
        const int tm = tile / ntn, tn = tile % ntn, m0 = tm * 128, n0 = tn * 128;
        float acc[8][4];
#pragma unroll
        for (int i = 0; i < 8; ++i)
#pragma unroll
            for (int j = 0; j < 4; ++j) acc[i][j] = 0.f;
        for (int k0 = 0; k0 < K; k0 += 16) {
            __syncthreads();
#pragma unroll
            for (int i = 0; i < 4; ++i) { const int e = tid + i * NT, r = e >> 4, kk = e & 15; As[kk * 132 + r] = ldA<AT>(A + (size_t)(m0 + r) * lda + k0 + kk); }
#pragma unroll
            for (int i = 0; i < 4; ++i) { const int e = tid + i * NT, kk = e >> 7, c = e & 127; Bs[kk * 128 + c] = (n0 + c < N) ? B[(size_t)(k0 + kk) * N + n0 + c] : 0.f; }
            __syncthreads();
#pragma unroll 2
            for (int kk = 0; kk < 16; ++kk) {
                float a[8], b[4];
#pragma unroll
                for (int i = 0; i < 8; ++i) a[i] = As[kk * 132 + ty * 8 + i];
#pragma unroll
                for (int j = 0; j < 4; ++j) b[j] = Bs[kk * 128 + tx * 4 + j];
#pragma unroll
                for (int i = 0; i < 8; ++i)
#pragma unroll
                    for (int j = 0; j < 4; ++j) acc[i][j] += a[i] * b[j];
            }
        }
#pragma unroll
        for (int i = 0; i < 8; ++i) {
            const int col = n0 + tx * 4;
            if (col < N) E.store4(m0 + ty * 8 + i, col, (f32x4){acc[i][0], acc[i][1], acc[i][2], acc[i][3]});
        }
    }
}
struct EpBf16 { bf16* O; int ldc;
    __device__ __forceinline__ void store4(int r, int c, f32x4 v) const {
        unsigned long long o = (unsigned long long)(f2bf(v.x) | (f2bf(v.y) << 16)) | ((unsigned long long)(f2bf(v.z) | (f2bf(v.w) << 16)) << 32);
        *(unsigned long long*)(O + (size_t)r * ldc + c) = o; } };
struct EpResAdd { const float* base; float* out;
    __device__ __forceinline__ void store4(int r, int c, f32x4 v) const {
        const f32x4 b = *(const f32x4*)(base + (size_t)r * DM + c); *(f32x4*)(out + (size_t)r * DM + c) = b + v; } };
struct EpGate { float* h; const bf16* up;
    __device__ __forceinline__ void store4(int r, int c, f32x4 v) const {
        f32x4 hv = *(const f32x4*)(h + (size_t)r * DM + c); const bf16* u = up + (size_t)r * DM + c;
        hv.x += bf2f(u[0]) / (1.f + __expf(-v.x)); hv.y += bf2f(u[1]) / (1.f + __expf(-v.y));
        hv.z += bf2f(u[2]) / (1.f + __expf(-v.z)); hv.w += bf2f(u[3]) / (1.f + __expf(-v.w));
        *(f32x4*)(h + (size_t)r * DM + c) = hv; } };

__device__ __forceinline__ void rope_cs(int pos, int i, float& c, float& s) {
    const float inv = exp2f(-(float)i * 0.125f * 18.931568569324174f);
    const float ang = (float)pos * inv;
    const float k = rintf(ang * 0.15915494309189535f);
    float r = fmaf(-k, 6.28125f, ang); r = fmaf(-k, 1.9353071795864769e-3f, r);
    c = cosf(r); s = sinf(r);
}
__device__ __forceinline__ void prep_head(bf16* p, const float* gain, int pos, float scale, bool donorm, int lane) {
    float v = bf2f(p[lane]);
    if (donorm) { const float ss = wave_sum(v * v); v = v * (1.0f / sqrtf(ss * (1.0f / 64.f) + NORM_EPS)) * gain[lane]; }
    const float partner = __shfl_xor(v, 8);
    float c = 1.f, s = 0.f;
    if (lane < 16) rope_cs(pos, lane & 7, c, s);
    float o = v;
    if (lane < 8) o = v * c - partner * s; else if (lane < 16) o = v * c + partner * s;
    p[lane] = (bf16)f2bf(o * scale);
}
__device__ __forceinline__ void ph_prep0(bf16* qkv, const int* positions, const float* aq, const float* ak, const float* bq, const float* bk) {
    const int lane = tidx() & 63, wave = tidx() >> 6;
    const int gw = bidx() * (NT / 64) + wave, ngw = gridDim.x * (NT / 64);
    for (int r = gw; r < T; r += ngw) {
        const int pos = positions[r]; bf16* row = qkv + (size_t)r * AB_LD;
        for (int h = 0; h < 8; ++h) {
            prep_head(row + CQA + h * 64, aq, pos, C2, true, lane);
            prep_head(row + CKA + h * 64, ak, pos, 1.f, true, lane);
            prep_head(row + CQB + h * 64, bq, pos, C2, true, lane);
            prep_head(row + CKB + h * 64, bk, pos, 1.f, true, lane);
        }
        for (int h = 0; h < 4; ++h) prep_head(row + CQI + h * 64, nullptr, pos, 1.f, false, lane);
        prep_head(row + CKI, nullptr, pos, 1.f, false, lane);
    }
}
__device__ __forceinline__ void ph_prep1(bf16* qkv, const int* positions, const float* cq, const float* ck) {
    const int lane = tidx() & 63, wave = tidx() >> 6;
    const int gw = bidx() * (NT / 64) + wave, ngw = gridDim.x * (NT / 64);
    for (int r = gw; r < T; r += ngw) {
        const int pos = positions[r]; bf16* row = qkv + (size_t)r * C_LD;
        for (int h = 0; h < 16; ++h) {
            prep_head(row + h * 64, cq, pos, C2, true, lane);
            prep_head(row + 1024 + h * 64, ck, pos, 1.f, true, lane);
        }
    }
}
__device__ __forceinline__ void ph_kmean(const bf16* qkv, float* kmean) {
    const int lane = tidx() & 63, wave = tidx() >> 6;
    const int gw = bidx() * (NT / 64) + wave, ngw = gridDim.x * (NT / 64);
    for (int it = gw; it < BATCH * 8 * 32; it += ngw) {
        const int b = it / 256, h = (it / 32) % 8, n = it % 32;
        float s = 0.f;
        for (int r = 0; r < 256; ++r) s += bf2f(qkv[(size_t)(b * SEQ + n * 256 + r) * AB_LD + CKA + h * 64 + lane]);
        kmean[(size_t)it * 64 + lane] = s * (1.0f / 256.f);
    }
}
__device__ __forceinline__ void ph_moba_select(const bf16* qkv, const float* kmean, unsigned* sel) {
    for (int it = bidx() * NT + tidx(); it < T * 8; it += gridDim.x * NT) {
        const int t = it >> 3, h = it & 7, b = t / SEQ, qblk = (t % SEQ) / 256;
        float q[64];
#pragma unroll
        for (int d = 0; d < 64; ++d) q[d] = bf2f(qkv[(size_t)t * AB_LD + CQA + h * 64 + d]);
        float v0 = -3e38f, v1 = -3e38f, v2 = -3e38f; int i0 = 255, i1 = 255, i2 = 255;
        for (int n = 0; n < qblk; ++n) {
            const float* km = kmean + (size_t)((b * 8 + h) * 32 + n) * 64; float g = 0.f;
#pragma unroll
            for (int d = 0; d < 64; ++d) g += q[d] * km[d];
            if (g > v0) { v2 = v1; i2 = i1; v1 = v0; i1 = i0; v0 = g; i0 = n; }
            else if (g > v1) { v2 = v1; i2 = i1; v1 = g; i1 = n; }
            else if (g > v2) { v2 = g; i2 = n; }
        }
        sel[it] = (unsigned)i0 | ((unsigned)i1 << 8) | ((unsigned)i2 << 16) | (255u << 24);
    }
}
__device__ __forceinline__ void ph_moba_attend(const bf16* qkv, const unsigned* sel, bf16* O, unsigned char* smem) {
    const int lane = tidx() & 63, wave = tidx() >> 6;
    float* pl = (float*)smem + wave * 1024;
    const int gw = bidx() * (NT / 64) + wave, ngw = gridDim.x * (NT / 64);
    for (int it = gw; it < T * 8; it += ngw) {
        const int t = it >> 3, h = it & 7, b = t / SEQ, tt = t % SEQ, qblk = tt / 256;
        const unsigned sw = sel[it];
        int blk[4] = {qblk, (int)(sw & 255), (int)((sw >> 8) & 255), (int)((sw >> 16) & 255)};
        const bf16* qp = qkv + (size_t)t * AB_LD + CQA + h * 64;
        float q[64];
#pragma unroll
        for (int d = 0; d < 64; ++d) q[d] = bf2f(qp[d]);
        float sc[16]; float mx = -3e38f;
#pragma unroll
        for (int s = 0; s < 4; ++s) {
#pragma unroll
            for (int i = 0; i < 4; ++i) {
                const int j = lane + 64 * i, pos = blk[s] * 256 + j;
                const bool ok = (blk[s] != 255) && (s > 0 || pos <= tt);
                float a = -3e38f;
                if (ok) { const bf16* kp = qkv + (size_t)(b * SEQ + pos) * AB_LD + CKA + h * 64; a = 0.f;
#pragma unroll
                    for (int d = 0; d < 64; ++d) a += q[d] * bf2f(kp[d]); }
                sc[s * 4 + i] = a; mx = fmaxf(mx, a);
            }
        }
        mx = wave_max(mx); float l = 0.f;
#pragma unroll
        for (int e = 0; e < 16; ++e) { const float p = (sc[e] > -1e38f) ? exp2f(sc[e] - mx) : 0.f; l += p; pl[(e >> 2) * 256 + lane + 64 * (e & 3)] = p; }
        l = wave_sum(l);
        __builtin_amdgcn_s_waitcnt(0);
        float o = 0.f;
#pragma unroll
        for (int s = 0; s < 4; ++s) {
            if (blk[s] == 255) continue;
            const int nk = (s == 0) ? (tt - qblk * 256 + 1) : 256;
            const bf16* vp = qkv + (size_t)(b * SEQ + blk[s] * 256) * AB_LD + CVA + h * 64 + lane;
            for (int j = 0; j < nk; ++j) o += pl[s * 256 + j] * bf2f(vp[(size_t)j * AB_LD]);
        }
        O[(size_t)t * DM + h * 64 + lane] = (bf16)f2bf(o / l);
    }
}
__device__ __forceinline__ void ph_dsa_select(const bf16* qkv, unsigned long long* mask, unsigned char* smem) {
    unsigned* keys = (unsigned*)smem;
    unsigned* cnt = keys + 8192;
    const int tid = tidx(), lane = tid & 63;
    for (int t = bidx(); t < T; t += gridDim.x) {
        const int b = t / SEQ, tt = t % SEQ, n = tt + 1;
        __syncthreads();
        const bf16* row = qkv + (size_t)t * AB_LD;
        float* qf = (float*)(cnt + 4);
        if (tid < 256) qf[tid] = bf2f(row[CQI + tid]);
        if (tid < 4) qf[256 + tid] = bf2f(row[CWI + tid]);
        __syncthreads();
        for (int kv = tid; kv < 8192; kv += NT) {
            unsigned key = 0u;
            if (kv < n) {
                const bf16* kp = qkv + (size_t)(b * SEQ + kv) * AB_LD + CKI;
                float a0 = 0.f, a1 = 0.f, a2 = 0.f, a3 = 0.f;
                for (int d = 0; d < 64; ++d) { const float kd = bf2f(kp[d]); a0 += qf[d] * kd; a1 += qf[64 + d] * kd; a2 += qf[128 + d] * kd; a3 += qf[192 + d] * kd; }
                const float s = ((qf[256] * fmaxf(a0, 0.f) + qf[257] * fmaxf(a1, 0.f)) + qf[258] * fmaxf(a2, 0.f)) + qf[259] * fmaxf(a3, 0.f);
                key = okey(s);
            }
            keys[kv] = key;
        }
        __syncthreads();
        unsigned thr = 0u, need = 0u;
        if (n > 256) {
            unsigned lo = 0u, hi = 0xFFFFFFFFu;
            while (lo < hi) {
                const unsigned mid = lo + ((hi - lo) >> 1) + ((hi - lo) & 1u);
                if (tid == 0) cnt[0] = 0u;
                __syncthreads();
                unsigned c = 0;
                for (int kv = tid; kv < 8192; kv += NT) c += (keys[kv] >= mid) ? 1u : 0u;
                c = (unsigned)wave_sum((float)c);
                if (lane == 0) atomicAdd(&cnt[0], c);
                __syncthreads();
                const unsigned tot = cnt[0];
                __syncthreads();
                if (tot >= 256u) lo = mid; else hi = mid - 1u;
            }
            thr = lo;
            if (tid == 0) cnt[1] = 0u;
            __syncthreads();
            unsigned c = 0;
            for (int kv = tid; kv < 8192; kv += NT) c += (keys[kv] > thr) ? 1u : 0u;
            c = (unsigned)wave_sum((float)c);
            if (lane == 0) atomicAdd(&cnt[1], c);
            __syncthreads();
            need = 256u - cnt[1];
        }
        if (tid < 64) {
            const int ntile = 4 * (tt / 256 + 1);
            unsigned taken = 0u;
            for (int j = 0; j < ntile; ++j) {
                const int kv = j * 64 + lane; const unsigned key = keys[kv];
                bool s;
                if (n <= 256) s = kv < n;
                else {
                    const bool gt = key > thr, eq = (key == thr) && (kv < n);
                    const unsigned long long em = __ballot(eq);
                    const unsigned rank = taken + (unsigned)__popcll(em & ((1ull << lane) - 1ull));
                    s = gt || (eq && rank < need);
                    taken += (unsigned)__popcll(em);
                }
                const unsigned long long m = __ballot(s);
                if (lane == 0) mask[((size_t)(b * 128 + j)) * SEQ + tt] = m;
            }
        }
    }
}
__device__ __forceinline__ void ph_dsa_attend(const bf16* qkv, const unsigned long long* mask, bf16* O, unsigned char* smem) {
    int* list = (int*)smem;
    int* cnt = list + 256;
    float* pr = (float*)(cnt + 4);
    float* linv = pr + 8 * 256;
    const int tid = tidx(), lane = tid & 63, wave = tid >> 6;
    for (int t = bidx(); t < T; t += gridDim.x) {
        const int b = t / SEQ, tt = t % SEQ;
        __syncthreads();
        const int ntile = 4 * (tt / 256 + 1);
        if (wave == 0) {
            int base = 0;
            for (int j = 0; j < ntile; ++j) {
                const unsigned long long m = mask[((size_t)(b * 128 + j)) * SEQ + tt];
                const int p = base + (int)__popcll(m & ((1ull << lane) - 1ull));
                if (((m >> lane) & 1ull) && p < 256) list[p] = j * 64 + lane;
                base += (int)__popcll(m);
            }
            if (lane == 0) cnt[0] = base;
        }
        __syncthreads();
        const int ns = min(cnt[0], 256);
        const bf16* row = qkv + (size_t)t * AB_LD;
        for (int e = tid; e < 8 * 256; e += NT) {
            const int h = e >> 8, j = e & 255; float a = -3e38f;
            if (j < ns) { const bf16* kp = qkv + (size_t)(b * SEQ + list[j]) * AB_LD + CKB + h * 64; a = 0.f;
                for (int d = 0; d < 64; ++d) a += bf2f(row[CQB + h * 64 + d]) * bf2f(kp[d]); }
            pr[e] = a;
        }
        __syncthreads();
        {
            const int h = wave; float v[4]; float mx = -3e38f;
#pragma unroll
            for (int i = 0; i < 4; ++i) { v[i] = pr[h * 256 + lane + 64 * i]; mx = fmaxf(mx, v[i]); }
            mx = wave_max(mx); float l = 0.f;
#pragma unroll
            for (int i = 0; i < 4; ++i) { const float p = (v[i] > -1e38f) ? exp2f(v[i] - mx) : 0.f; l += p; pr[h * 256 + lane + 64 * i] = p; }
            l = wave_sum(l); if (lane == 0) linv[h] = 1.0f / l;
        }
        __syncthreads();
        {   const int h = tid >> 6, d = tid & 63; float o = 0.f;
            for (int j = 0; j < ns; ++j) o += pr[h * 256 + j] * bf2f(qkv[(size_t)(b * SEQ + list[j]) * AB_LD + CVB + h * 64 + d]);
            O[(size_t)t * DM + 512 + h * 64 + d] = (bf16)f2bf(o * linv[h]); }
    }
}
__device__ __forceinline__ void ph_dilated(const bf16* qkv, bf16* OG, float* LSE) {
    const int lane = tidx() & 63, wave = tidx() >> 6;
    const int gw = bidx() * (NT / 64) + wave, ngw = gridDim.x * (NT / 64);
    for (int it = gw; it < T * 16; it += ngw) {
        const int t = it >> 4, h = it & 15, b = t / SEQ, tt = t % SEQ;
        const bf16* qp = qkv + (size_t)t * C_LD + h * 64;
        float q[64];
#pragma unroll
        for (int d = 0; d < 64; ++d) q[d] = bf2f(qp[d]);
        for (int g = 0; g < 3; ++g) {
            const int dil = (g == 0) ? 1 : (g == 1 ? 4 : 16);
            float sc[3]; float mx = -3e38f;
#pragma unroll
            for (int i = 0; i < 3; ++i) {
                const int j = lane + 64 * i, pos = tt - j * dil; float a = -3e38f;
                if (j <= 128 && pos >= 0) { const bf16* kp = qkv + (size_t)(b * SEQ + pos) * C_LD + 1024 + h * 64; a = 0.f;
#pragma unroll
                    for (int d = 0; d < 64; ++d) a += q[d] * bf2f(kp[d]); }
                sc[i] = a; mx = fmaxf(mx, a);
            }
            mx = wave_max(mx); float l = 0.f; float p[3];
#pragma unroll
            for (int i = 0; i < 3; ++i) { p[i] = (sc[i] > -1e38f) ? exp2f(sc[i] - mx) : 0.f; l += p[i]; }
            l = wave_sum(l);
            float o = 0.f;
            for (int j = 0; j <= 128; ++j) {
                const int pos = tt - j * dil; if (pos < 0) break;
                const float pj = (j < 64) ? __shfl(p[0], j) : ((j < 128) ? __shfl(p[1], j - 64) : __shfl(p[2], 0));
                o += pj * bf2f(qkv[(size_t)(b * SEQ + pos) * C_LD + 2048 + h * 64 + lane]);
            }
            OG[((size_t)g * T + t) * DM + h * 64 + lane] = (bf16)f2bf(o / l);
            if (lane == 0) LSE[((size_t)g * T + t) * 16 + h] = mx + log2f(l);
        }
    }
}
__device__ __forceinline__ void ph_dil_merge(const bf16* OG, const float* LSE, bf16* O) {
    for (size_t e = (size_t)bidx() * NT + tidx(); e < (size_t)T * DM; e += (size_t)gridDim.x * NT) {
        const int t = (int)(e >> 10), c = (int)(e & 1023), h = c >> 6;
        const float l0 = LSE[((size_t)0 * T + t) * 16 + h], l1 = LSE[((size_t)1 * T + t) * 16 + h], l2 = LSE[((size_t)2 * T + t) * 16 + h];
        const float m = fmaxf(l0, fmaxf(l1, l2)); const float w0 = exp2f(l0 - m), w1 = exp2f(l1 - m), w2 = exp2f(l2 - m);
        const float o = (w0 * bf2f(OG[e]) + w1 * bf2f(OG[(size_t)T * DM + e]) + w2 * bf2f(OG[(size_t)2 * T * DM + e])) / (w0 + w1 + w2);
        O[e] = (bf16)f2bf(o);
    }
}
__device__ __forceinline__ void ph_peer_route(const bf16* qry, const float* subk, int* eidx, float* gw, unsigned char* smem) {
    float* s = (float*)smem;
    float* sv = s + 2048;
    int* si = (int*)(sv + 256);
    float* qf = (float*)(si + 256);
    const int tid = tidx(), lane = tid & 63, wave = tid >> 6;
    for (int t = bidx(); t < T; t += gridDim.x) {
        __syncthreads();
        for (int e = tid; e < 2048; e += NT) qf[e] = bf2f(qry[(size_t)t * 2048 + e]);
        __syncthreads();
        for (int e = tid; e < 2048; e += NT) {
            const int hc = e >> 7, k = e & 127; const float* kp = subk + ((size_t)hc * 128 + k) * 128; float a = 0.f;
            for (int d = 0; d < 128; ++d) a += qf[hc * 128 + d] * kp[d];
            s[e] = a;
        }
        __syncthreads();
        for (int hc = wave; hc < 16; hc += NT / 64) {
            float v0 = s[hc * 128 + lane], v1 = s[hc * 128 + 64 + lane];
            for (int r = 0; r < 16; ++r) {
                float bv = v0; int bi = lane;
                if (v1 > bv) { bv = v1; bi = lane + 64; }
#pragma unroll
                for (int o = 1; o < 64; o <<= 1) { const float ov = __shfl_xor(bv, o); const int oi = __shfl_xor(bi, o); if (ov > bv || (ov == bv && oi < bi)) { bv = ov; bi = oi; } }
                if (lane == 0) { sv[hc * 16 + r] = bv; si[hc * 16 + r] = bi; }
                if (bi == lane) v0 = -3e38f; if (bi == lane + 64) v1 = -3e38f;
            }
        }
        __syncthreads();
        {   const int h = wave;
            float c[4]; int ci[4];
#pragma unroll
            for (int i = 0; i < 4; ++i) { const int f = lane + 64 * i; c[i] = sv[(h * 2) * 16 + (f >> 4)] + sv[(h * 2 + 1) * 16 + (f & 15)]; ci[i] = f; }
            float cv[16]; int cf[16];
#pragma unroll
            for (int r = 0; r < 16; ++r) {
                float bv = c[0]; int bi = ci[0];
#pragma unroll
                for (int i = 1; i < 4; ++i) if (c[i] > bv) { bv = c[i]; bi = ci[i]; }
#pragma unroll
                for (int o = 1; o < 64; o <<= 1) { const float ov = __shfl_xor(bv, o); const int oi = __shfl_xor(bi, o); if (ov > bv || (ov == bv && oi < bi)) { bv = ov; bi = oi; } }
                cv[r] = bv; cf[r] = bi;
#pragma unroll
                for (int i = 0; i < 4; ++i) if (ci[i] == bi) c[i] = -3e38f;
            }
            float l = 0.f;
#pragma unroll
            for (int r = 0; r < 16; ++r) l += __expf(cv[r] - cv[0]);
            if (lane < 16) {
                float myv = 0.f; int myf = 0;
#pragma unroll
                for (int r = 0; r < 16; ++r) if (r == lane) { myv = cv[r]; myf = cf[r]; }
                eidx[(size_t)t * 128 + h * 16 + lane] = si[(h * 2) * 16 + (myf >> 4)] * 128 + si[(h * 2 + 1) * 16 + (myf & 15)];
                gw[(size_t)t * 128 + h * 16 + lane] = __expf(myv - cv[0]) / l;
            }
        }
    }
}
__device__ __forceinline__ float gelu_tanh(float x) { const float u = 0.7978845608028654f * (x + 0.044715f * x * x * x); return 0.5f * x * (1.f + tanhf(u)); }
__device__ __forceinline__ void ph_peer_gather(const bf16* xn, const int* eidx, const float* gw, const float* U, const float* V, float* h, unsigned char* smem) {
    float* xf = (float*)smem;
    float* w = xf + 1024;
    int* ei = (int*)(w + 128);
    const int tid = tidx(), lane = tid & 63, wave = tid >> 6;
    for (int t = bidx(); t < T; t += gridDim.x) {
        __syncthreads();
        for (int e = tid; e < 1024; e += NT) xf[e] = bf2f(xn[(size_t)t * DM + e]);
        if (tid < 128) ei[tid] = eidx[(size_t)t * 128 + tid];
        __syncthreads();
        for (int e = wave; e < 128; e += NT / 64) {
            const float* up = U + (size_t)ei[e] * DM; float a = 0.f;
            for (int d = lane; d < 1024; d += 64) a += xf[d] * up[d];
            a = wave_sum(a);
            if (lane == 0) w[e] = gw[(size_t)t * 128 + e] * gelu_tanh(a);
        }
        __syncthreads();
        for (int d = tid; d < 1024; d += NT) {
            float o = 0.f;
            for (int e = 0; e < 128; ++e) o += w[e] * V[(size_t)ei[e] * DM + d];
            h[(size_t)t * DM + d] += o;
        }
    }
}

namespace pg8 {
#define PG8_LAS __attribute__((address_space(3)))
typedef unsigned short bf16_t;
typedef short bf16x8 __attribute__((ext_vector_type(8)));
typedef float f32x4 __attribute__((ext_vector_type(4)));
typedef unsigned u32x4 __attribute__((ext_vector_type(4)));
constexpr int BM = 256, BK = 64, HALF = 128, HTB = HALF * BK * 2  , STAGE_BYTES = 8 * HTB, NXCD = 8, WGM = 8;

__host__ __device__ __forceinline__ int lds_byte(int r, int c) { const int st = (r >> 4) * 2 + (c >> 5), rr = r & 15, cc = c & 31, ob = rr * 64 + cc * 2; return st * 1024 + (ob ^ (((ob >> 9) & 1) << 5)); }
__host__ __device__ __forceinline__ void stage_rc(int b, int& R, int& C) { const int st = b / 1024, sb = b % 1024, swz = sb ^ (((sb >> 9) & 1) << 5); R = (st >> 1) * 16 + swz / 64; C = (st & 1) * 32 + (swz % 64) / 2; }
__host__ __device__ __forceinline__ int perm32(int rho) { const int n = rho >> 4, i = rho & 15; return 8 * (i >> 2) + 4 * n + (i & 3); }

struct Unit { int pm, pn; };
struct Gemm { const bf16_t* A; const bf16_t* Bt; int M, N, K; };

struct StaticOrder {
    int nM, nN, nwg, G, c;
    __host__ __device__ void init(int M, int N, int G_, int c_) { nM = M / BM; nN = N / BM; nwg = nM * nN; G = G_; c = c_; }
    __host__ __device__ bool next(int i, Unit& u) const {
        const long L = (long)i * G + c; if (L >= nwg) return false;
        int wgid = (int)L; { const int q = nwg / NXCD, r = nwg % NXCD, xcd = wgid % NXCD, off = wgid / NXCD; wgid = (xcd < r ? xcd * (q + 1) : r * (q + 1) + (xcd - r) * q) + off; }
        const int nig = WGM * nN, gid = wgid / nig, fm = gid * WGM, gsz = (nM - fm) < WGM ? (nM - fm) : WGM;
        u.pm = fm + ((wgid % nig) % gsz); u.pn = (wgid % nig) / gsz; return true;
    }
    __device__ __forceinline__ void a_ready(const Unit&) const {}
    __device__ __forceinline__ void done(const Unit&) const {}
};


__device__ __forceinline__ unsigned pk_bf16(float lo, float hi) { typedef float f2 __attribute__((ext_vector_type(2))); typedef __bf16 b2 __attribute__((ext_vector_type(2))); f2 v = {lo, hi}; b2 b = __builtin_convertvector(v, b2); return __builtin_bit_cast(unsigned, b); }
struct EBf16 {
    static constexpr bool PERM = true, AFTER_DRAIN = false; bf16_t* O; int ldc;
    __device__ __forceinline__ void operator()(const f32x4 (&acc)[2][2][4][2], const Unit& u, int wr, int wc, int fr, int fq) const {
        const int row0 = u.pm * BM + wr * 64 + fr, col0 = u.pn * BM + wc * 32 + 8 * fq;
#pragma unroll
        for (int ai = 0; ai < 2; ++ai)
#pragma unroll
            for (int m = 0; m < 4; ++m) { bf16_t* rowp = O + (size_t)(row0 + ai * HALF + m * 16) * ldc + col0;
#pragma unroll
                for (int bj = 0; bj < 2; ++bj) { const f32x4 v0 = acc[ai][bj][m][0], v1 = acc[ai][bj][m][1];
                    u32x4 w; w.x = pk_bf16(v0[0], v0[1]); w.y = pk_bf16(v0[2], v0[3]); w.z = pk_bf16(v1[0], v1[1]); w.w = pk_bf16(v1[2], v1[3]);
                    *(u32x4*)(rowp + bj * HALF) = w; } }
    }
};
struct EResAdd {
    static constexpr bool PERM = false, AFTER_DRAIN = false; const float* base; float* out;
    __device__ __forceinline__ void operator()(const f32x4 (&acc)[2][2][4][2], const Unit& u, int wr, int wc, int fr, int fq) const {
        const int col0 = u.pn * BM + wc * 32 + 4 * fq;
#pragma unroll
        for (int ai = 0; ai < 2; ++ai)
#pragma unroll
            for (int m = 0; m < 4; ++m) { const size_t off = (size_t)(u.pm * BM + ai * HALF + wr * 64 + m * 16 + fr) * 1024 + col0;
#pragma unroll
                for (int bj = 0; bj < 2; ++bj)
#pragma unroll
                    for (int n = 0; n < 2; ++n) { const f32x4 b = *(const f32x4*)(base + off + bj * HALF + n * 16); *(f32x4*)(out + off + bj * HALF + n * 16) = b + acc[ai][bj][m][n]; } }
    }
};
struct EGate {
    static constexpr bool PERM = false, AFTER_DRAIN = false; float* h; const bf16_t* up;
    __device__ __forceinline__ void operator()(const f32x4 (&acc)[2][2][4][2], const Unit& u, int wr, int wc, int fr, int fq) const {
        const int col0 = u.pn * BM + wc * 32 + 4 * fq;
#pragma unroll
        for (int ai = 0; ai < 2; ++ai)
#pragma unroll
            for (int m = 0; m < 4; ++m) { const size_t off = (size_t)(u.pm * BM + ai * HALF + wr * 64 + m * 16 + fr) * 1024 + col0;
#pragma unroll
                for (int bj = 0; bj < 2; ++bj)
#pragma unroll
                    for (int n = 0; n < 2; ++n) { const size_t o = off + bj * HALF + n * 16; f32x4 hv = *(const f32x4*)(h + o);
                        const unsigned long long uu = *(const unsigned long long*)(up + o); const f32x4 a = acc[ai][bj][m][n];
                        hv[0] += __builtin_bit_cast(float, (unsigned)(uu << 16)) / (1.f + __expf(-a[0]));
                        hv[1] += __builtin_bit_cast(float, (unsigned)(uu & 0xffff0000ull)) / (1.f + __expf(-a[1]));
                        hv[2] += __builtin_bit_cast(float, (unsigned)((uu >> 16) & 0xffff0000ull)) / (1.f + __expf(-a[2]));
                        hv[3] += __builtin_bit_cast(float, (unsigned)((uu >> 32) & 0xffff0000ull)) / (1.f + __expf(-a[3]));
                        *(f32x4*)(h + o) = hv; } }
    }
};
template <class Epi, class Sched, bool ALIGN_EPI = false, bool SP2 = false>
__device__ __forceinline__ void gemm_phase(PG8_LAS unsigned char* lds, const Gemm g, const Sched& S, const Epi& E) {
    const int tid = tidx(), wid = __builtin_amdgcn_readfirstlane(tid >> 6), lane = tid & 63, wr = wid >> 2, wc = wid & 3, fr = lane & 15, fq = lane >> 4;
    const int K = g.K, nt = K / BK;
    unsigned voffA[2], voffB[2];
#pragma unroll
    for (int i = 0; i < 2; ++i) { int R, C; stage_rc(tid * 16 + i * 8192, R, C); const int Rb = Epi::PERM ? ((R & ~31) + perm32(R & 31)) : R;
        voffA[i] = (unsigned)(R * K + C) * 2u; voffB[i] = (unsigned)(Rb * K + C) * 2u; }
    const size_t kstep = (size_t)(BK * 2);
    const size_t hstep = (size_t)HALF * K * 2;
    const size_t tstep = 2 * hstep;
    const unsigned ldsw = (unsigned)wid * 1024u;
    const int aoff = lds_byte(wr * 64 + fr, fq * 8), boff = lds_byte(wc * 32 + fr, fq * 8);
#define PG8_SA(b, h) (((b) * 2 + (h)) * HTB)
#define PG8_SB(b, h) ((4 + (b) * 2 + (h)) * HTB)
#define PG8_STAGE(bufoff, gbase, voff) do { _Pragma("unroll") for (int _i = 0; _i < 2; ++_i) \
        __builtin_amdgcn_global_load_lds((const unsigned*)((const char*)(gbase) + (voff)[_i]), (PG8_LAS unsigned*)(lds + (bufoff) + ldsw + _i * 8192), 16, 0, 0); } while (0)
#define PG8_LDA(dst, b, h) do { _Pragma("unroll") for (int m = 0; m < 4; ++m) _Pragma("unroll") for (int k = 0; k < 2; ++k) dst[m][k] = *(const PG8_LAS bf16x8*)(lds + PG8_SA(b, h) + aoff + m * 2048 + k * 1024); } while (0)
#define PG8_LDB(dst, b, h) do { _Pragma("unroll") for (int n = 0; n < 2; ++n) _Pragma("unroll") for (int k = 0; k < 2; ++k) dst[n][k] = *(const PG8_LAS bf16x8*)(lds + PG8_SB(b, h) + boff + n * 2048 + k * 1024); } while (0)
#define PG8_MMA(ai, bj, At, Bt) do { __builtin_amdgcn_s_setprio(1); _Pragma("unroll") for (int m = 0; m < 4; ++m) _Pragma("unroll") for (int n = 0; n < 2; ++n) _Pragma("unroll") for (int k = 0; k < 2; ++k) \
        acc[ai][bj][m][n] = __builtin_amdgcn_mfma_f32_16x16x32_bf16(Bt[n][k], At[m][k], acc[ai][bj][m][n], 0, 0, 0); __builtin_amdgcn_s_setprio(0); } while (0)
#define PG8_WAIT_V(n) asm volatile("s_waitcnt vmcnt(" #n ")" ::: "memory")
#define PG8_WAIT_L(n) asm volatile("s_waitcnt lgkmcnt(" #n ")" ::: "memory")
#define PG8_BAR __builtin_amdgcn_s_barrier()
#define PG8_SCHED __builtin_amdgcn_sched_barrier(0)
    Unit cur, nxt; int ui = 0;
    if (!S.next(0, cur)) return;
    f32x4 acc[2][2][4][2];
#pragma unroll
    for (int a = 0; a < 2; ++a)
#pragma unroll
        for (int b = 0; b < 2; ++b)
#pragma unroll
            for (int m = 0; m < 4; ++m)
#pragma unroll
                for (int n = 0; n < 2; ++n) acc[a][b][m][n] = (f32x4){0.f, 0.f, 0.f, 0.f};
    bf16x8 At[4][2], B0[2][2], B1[2][2];
    const char* cA = (const char*)g.A + (size_t)cur.pm * tstep; const char* cB = (const char*)g.Bt + (size_t)cur.pn * tstep;
    S.a_ready(cur);
    if constexpr (SP2) {
        PG8_STAGE(PG8_SB(0, 0), cB, voffB); PG8_STAGE(PG8_SB(0, 1), cB + hstep, voffB); PG8_STAGE(PG8_SA(0, 0), cA, voffA); PG8_STAGE(PG8_SA(0, 1), cA + hstep, voffA);
        if (wr == 1) PG8_BAR;
        PG8_WAIT_V(2); PG8_BAR;
        PG8_STAGE(PG8_SB(1, 0), cB + kstep, voffB); PG8_STAGE(PG8_SA(1, 0), cA + kstep, voffA); PG8_STAGE(PG8_SB(1, 1), cB + hstep + kstep, voffB);
        PG8_WAIT_V(6); PG8_BAR;
    } else {
        PG8_STAGE(PG8_SB(0, 0), cB, voffB); PG8_STAGE(PG8_SA(0, 0), cA, voffA); PG8_STAGE(PG8_SB(0, 1), cB + hstep, voffB); PG8_STAGE(PG8_SA(0, 1), cA + hstep, voffA);
        if (wr == 1) PG8_BAR;
        PG8_WAIT_V(4); PG8_BAR;
        PG8_STAGE(PG8_SB(1, 0), cB + kstep, voffB); PG8_STAGE(PG8_SA(1, 0), cA + kstep, voffA); PG8_STAGE(PG8_SB(1, 1), cB + hstep + kstep, voffB);
        PG8_WAIT_V(6); PG8_BAR;
    }
    for (;;) {
        const bool has_next = S.next(ui + 1, nxt);
        const char* nA = has_next ? (const char*)g.A + (size_t)nxt.pm * tstep : cA; const char* nB = has_next ? (const char*)g.Bt + (size_t)nxt.pn * tstep : cB;
        for (int t = 0; t < nt; t += 2) {
            const bool last = (t == nt - 2);
            const char* a1 = cA + (size_t)(t + 1) * kstep;
            const char* a2 = last ? nA : cA + (size_t)(t + 2) * kstep; const char* b2 = last ? nB : cB + (size_t)(t + 2) * kstep;
            const char* a3 = a2 + kstep; const char* b3 = b2 + kstep;
            if (last && has_next) S.a_ready(nxt);
            if constexpr (SP2) {
            PG8_LDB(B0, 0, 0); PG8_LDB(B1, 0, 1); PG8_SCHED; PG8_LDA(At, 0, 0); PG8_STAGE(PG8_SA(1, 1), a1 + hstep, voffA);
            PG8_WAIT_V(8); PG8_WAIT_L(0); PG8_BAR; PG8_MMA(0, 0, At, B0); PG8_MMA(0, 1, At, B1); PG8_BAR; PG8_SCHED;
            PG8_LDA(At, 0, 1); PG8_STAGE(PG8_SB(0, 0), b2, voffB); PG8_STAGE(PG8_SB(0, 1), b2 + hstep, voffB); PG8_STAGE(PG8_SA(0, 0), a2, voffA);
            PG8_WAIT_V(8); PG8_WAIT_L(0); PG8_BAR; PG8_MMA(1, 0, At, B0); PG8_MMA(1, 1, At, B1); PG8_BAR; PG8_SCHED;
            PG8_LDB(B0, 1, 0); PG8_LDB(B1, 1, 1); PG8_SCHED; PG8_LDA(At, 1, 0); PG8_STAGE(PG8_SA(0, 1), a2 + hstep, voffA);
            PG8_WAIT_V(8); PG8_WAIT_L(0); PG8_BAR; PG8_MMA(0, 0, At, B0); PG8_MMA(0, 1, At, B1); PG8_BAR; PG8_SCHED;
            PG8_LDA(At, 1, 1); PG8_STAGE(PG8_SB(1, 0), b3, voffB); PG8_STAGE(PG8_SB(1, 1), b3 + hstep, voffB); PG8_STAGE(PG8_SA(1, 0), a3, voffA);
            PG8_WAIT_V(8); PG8_WAIT_L(0); PG8_BAR; PG8_MMA(1, 0, At, B0); PG8_MMA(1, 1, At, B1); PG8_BAR; PG8_SCHED;
            } else {
            PG8_LDB(B0, 0, 0); PG8_SCHED; PG8_LDA(At, 0, 0); PG8_STAGE(PG8_SA(1, 1), a1 + hstep, voffA);
            PG8_WAIT_L(8); PG8_BAR; PG8_WAIT_L(0); PG8_MMA(0, 0, At, B0); PG8_BAR; PG8_SCHED;
            PG8_LDB(B1, 0, 1); PG8_STAGE(PG8_SB(0, 0), b2, voffB);
            PG8_BAR; PG8_WAIT_L(0); PG8_MMA(0, 1, At, B1); PG8_BAR;
            PG8_LDA(At, 0, 1); PG8_STAGE(PG8_SA(0, 0), a2, voffA);
            PG8_BAR; PG8_WAIT_L(0); PG8_MMA(1, 0, At, B0); PG8_BAR; PG8_SCHED;
            PG8_STAGE(PG8_SB(0, 1), b2 + hstep, voffB);
            PG8_WAIT_V(6); PG8_BAR; PG8_MMA(1, 1, At, B1); PG8_BAR;
            PG8_LDB(B0, 1, 0); PG8_SCHED; PG8_LDA(At, 1, 0); PG8_STAGE(PG8_SA(0, 1), a2 + hstep, voffA);
            PG8_WAIT_L(8); PG8_BAR; PG8_WAIT_L(0); PG8_MMA(0, 0, At, B0); PG8_BAR; PG8_SCHED;
            PG8_LDB(B1, 1, 1); PG8_STAGE(PG8_SB(1, 0), b3, voffB);
            PG8_BAR; PG8_WAIT_L(0); PG8_MMA(0, 1, At, B1); PG8_BAR;
            PG8_LDA(At, 1, 1); PG8_STAGE(PG8_SA(1, 0), a3, voffA);
            PG8_BAR; PG8_WAIT_L(0); PG8_MMA(1, 0, At, B0); PG8_BAR; PG8_SCHED;
            PG8_STAGE(PG8_SB(1, 1), b3 + hstep, voffB);
            PG8_WAIT_V(6); PG8_BAR; PG8_MMA(1, 1, At, B1); PG8_BAR;
            }
        }
        if constexpr (ALIGN_EPI) { if (wr == 0) PG8_BAR; }
        if constexpr (!Epi::AFTER_DRAIN) { E(acc, cur, wr, wc, fr, fq); S.done(cur); }
        if (!has_next) break;
#pragma unroll
        for (int a = 0; a < 2; ++a)
#pragma unroll
            for (int b = 0; b < 2; ++b)
#pragma unroll
                for (int m = 0; m < 4; ++m)
#pragma unroll
                    for (int n = 0; n < 2; ++n) acc[a][b][m][n] = (f32x4){0.f, 0.f, 0.f, 0.f};
        cur = nxt; cA = nA; cB = nB; ++ui;
        if constexpr (ALIGN_EPI) { if (wr == 1) PG8_BAR; }
    }
    PG8_WAIT_V(0);
    if constexpr (!ALIGN_EPI) { if (wr == 0) PG8_BAR; }
    PG8_BAR;
    if constexpr (Epi::AFTER_DRAIN) { E.fused(acc, cur, wr, wc, fr, fq, lds, wid, lane); S.done(cur); }
#undef PG8_SA
#undef PG8_SB
#undef PG8_STAGE
#undef PG8_LDA
#undef PG8_LDB
#undef PG8_MMA
#undef PG8_WAIT_V
#undef PG8_WAIT_L
#undef PG8_BAR
#undef PG8_SCHED
}
}

#define LAS __attribute__((address_space(3)))
typedef unsigned v4u __attribute__((ext_vector_type(4)));
__device__ __forceinline__ unsigned pk2(float lo, float hi) { return f2bf(lo) | (f2bf(hi) << 16); }
__device__ __forceinline__ void transpose_item(const float* W, int K, int N, bf16* WT, float* scr, int item, int nblk, int lane) {
    const int kb = item / nblk, nb = item % nblk, k0 = 64 * kb, n0 = 32 * nb;
    const int nn = n0 + (lane & 31);
#pragma unroll 8
    for (int i = 0; i < 32; ++i) { const int kk = 2 * i + (lane >> 5); scr[kk * 33 + (lane & 31)] = (nn < N) ? W[(size_t)(k0 + kk) * N + nn] : 0.f; }
    __builtin_amdgcn_s_waitcnt(0xc07f); asm volatile("" ::: "memory");
    const int c = lane & 7;
#pragma unroll
    for (int j = 0; j < 4; ++j) { const int n = (lane >> 3) + 8 * j; const float* sp = scr + (8 * c) * 33 + n;
        v4u o; o.x = pk2(sp[0 * 33], sp[1 * 33]); o.y = pk2(sp[2 * 33], sp[3 * 33]); o.z = pk2(sp[4 * 33], sp[5 * 33]); o.w = pk2(sp[6 * 33], sp[7 * 33]);
        *(v4u*)(WT + (size_t)(n0 + n) * K + k0 + 8 * c) = o; }
    __builtin_amdgcn_s_waitcnt(0xc07f); asm volatile("" ::: "memory");
}
__device__ __forceinline__ void cvt_bf16(const float* src, bf16* dst, size_t n) {
    for (size_t e = ((size_t)bidx() * NT + tidx()) * 8; e < n; e += (size_t)gridDim.x * NT * 8) {
        const f32x4 a = *(const f32x4*)(src + e), b = *(const f32x4*)(src + e + 4);
        v4u o; o.x = pk2(a.x, a.y); o.y = pk2(a.z, a.w); o.z = pk2(b.x, b.y); o.w = pk2(b.z, b.w);
        *(v4u*)(dst + e) = o; }
}
__device__ __forceinline__ void transpose_matrix(const float* W, int K, int N, int Npad, bf16* WT, float* scr, int gw, int ngw, int lane) {
    const int nblk = Npad / 32, nit = (K / 64) * nblk;
    for (int it = gw; it < nit; it += ngw) transpose_item(W, K, N, WT, scr, it, nblk, lane);
}
__device__ __forceinline__ void ph_prologue(unsigned char* smem) {
    const int lane = tidx() & 63, wave = tidx() >> 6;
    float* scr = (float*)smem + wave * (64 * 33);
    const int gw = bidx() * (NT / 64) + wave, ngw = gridDim.x * (NT / 64);
    unsigned char* ws = WSP;
    transpose_matrix(IN(6), 1024, AB_N, AB_LD, (bf16*)(ws + WS_WAB_IN), scr, gw, ngw, lane);
    transpose_matrix(IN(7), 1024, 1024, 1024, (bf16*)(ws + WS_WAB_OUT), scr, gw, ngw, lane);
    transpose_matrix(IN(12), 1024, 3072, 3072, (bf16*)(ws + WS_WC_IN), scr, gw, ngw, lane);
    transpose_matrix(IN(13), 1024, 1024, 1024, (bf16*)(ws + WS_WC_OUT), scr, gw, ngw, lane);
#pragma unroll 1
    for (int L = 0; L < 2; ++L) {
        transpose_matrix(IN(16) + (size_t)L * DM * 2048, 1024, 2048, 2048, (bf16*)(ws + WS_WQ + (size_t)L * 4 * MiB), scr, gw, ngw, lane);
        transpose_matrix(IN(20) + (size_t)L * DM * DM, 1024, 1024, 1024, (bf16*)(ws + WS_WG + (size_t)L * 2 * MiB), scr, gw, ngw, lane);
        transpose_matrix(IN(21) + (size_t)L * 256 * DM, 256, 1024, 1024, (bf16*)(ws + WS_WUP + (size_t)L * (MiB / 2)), scr, gw, ngw, lane);
    }
    cvt_bf16(IN(1), (bf16*)(ws + WS_P), (size_t)2 * T * 256);
    cvt_bf16(IN(17), (bf16*)(ws + WS_SUBK), (size_t)2 * 16 * 128 * 128);
#pragma unroll 1
    for (int L = 0; L < 2; ++L) {
        cvt_bf16(IN(18) + (size_t)L * NEXP * DM, (bf16*)(ws + WS_EXP + (size_t)(2 * L) * 32 * MiB), (size_t)NEXP * DM);
        cvt_bf16(IN(19) + (size_t)L * NEXP * DM, (bf16*)(ws + WS_EXP + (size_t)(2 * L + 1) * 32 * MiB), (size_t)NEXP * DM);
    }
}


typedef __bf16 bf2_t __attribute__((ext_vector_type(2)));
typedef unsigned u32x4g __attribute__((ext_vector_type(4)));
__device__ __forceinline__ float dot2u(unsigned a, unsigned b, float c) { return __builtin_amdgcn_fdot2_f32_bf16(__builtin_bit_cast(bf2_t, a), __builtin_bit_cast(bf2_t, b), c, false); }
__device__ __forceinline__ float dot8(u32x4g a, u32x4g b, float c) {
    c = dot2u(a[0], b[0], c); c = dot2u(a[1], b[1], c); c = dot2u(a[2], b[2], c); c = dot2u(a[3], b[3], c);
    return c;
}
__device__ __forceinline__ float bflo(unsigned d) { return __builtin_bit_cast(float, d << 16); }
__device__ __forceinline__ float bfhi(unsigned d) { return __builtin_bit_cast(float, d & 0xffff0000u); }
#define GATHER_U8(EREG, B) do { float s_[8]; \
    _Pragma("unroll") for (int k = 0; k < 8; ++k) { const int idx = __builtin_amdgcn_readlane(EREG, ((B) * 8 + k) & 63); \
        const u32x4g* up = (const u32x4g*)(U + (size_t)idx * DM); const u32x4g u0 = up[lane], u1 = up[64 + lane]; s_[k] = dot8(x1, u1, dot8(x0, u0, 0.f)); } \
    float r_[4]; const bool b5 = lane & 32, b4 = lane & 16, b3 = lane & 8; \
    _Pragma("unroll") for (int i = 0; i < 4; ++i) { const float snd = b5 ? s_[i] : s_[4 + i], kp = b5 ? s_[4 + i] : s_[i]; r_[i] = kp + __shfl_xor(snd, 32); } \
    float q_[2]; \
    _Pragma("unroll") for (int i = 0; i < 2; ++i) { const float snd = b4 ? r_[i] : r_[2 + i], kp = b4 ? r_[2 + i] : r_[i]; q_[i] = kp + __shfl_xor(snd, 16); } \
    float p_; { const float snd = b3 ? q_[0] : q_[1], kp = b3 ? q_[1] : q_[0]; p_ = kp + __shfl_xor(snd, 8); } \
    p_ += __shfl_xor(p_, 4); p_ += __shfl_xor(p_, 2); p_ += __shfl_xor(p_, 1); \
    if ((lane & 7) == 0) al[(B) * 8 + (lane >> 3)] = p_; } while (0)
#define GATHER_V8(EREG, WREG, B) do { \
    _Pragma("unroll") for (int k = 0; k < 8; ++k) { const int idx = __builtin_amdgcn_readlane(EREG, ((B) * 8 + k) & 63); \
        const float w = __builtin_bit_cast(float, __builtin_amdgcn_readlane(__builtin_bit_cast(int, WREG), ((B) * 8 + k) & 63)); \
        const u32x4g* vp = (const u32x4g*)(V + (size_t)idx * DM); const u32x4g v0 = vp[lane], v1 = vp[64 + lane]; \
        acc[0] += w * bflo(v0.x); acc[1] += w * bfhi(v0.x); acc[2] += w * bflo(v0.y); acc[3] += w * bfhi(v0.y); \
        acc[4] += w * bflo(v0.z); acc[5] += w * bfhi(v0.z); acc[6] += w * bflo(v0.w); acc[7] += w * bfhi(v0.w); \
        acc[8] += w * bflo(v1.x); acc[9] += w * bfhi(v1.x); acc[10] += w * bflo(v1.y); acc[11] += w * bfhi(v1.y); \
        acc[12] += w * bflo(v1.z); acc[13] += w * bfhi(v1.z); acc[14] += w * bflo(v1.w); acc[15] += w * bfhi(v1.w); } } while (0)
__device__ __forceinline__ void ph_peer_gather_opt(const int* eidx, const float* gw, const bf16* U, const bf16* V, float* h, const float* gain_next, bf16* XN, unsigned char* smem) {
    const int tid = tidx(), lane = tid & 63, wave = tid >> 6;
    float* al = (float*)smem + wave * 128;
    const int gwv = bidx() * (NT / 64) + wave, ngw = gridDim.x * (NT / 64);
    for (int t = gwv; t < T; t += ngw) {
        const u32x4g x0 = *(const u32x4g*)(XN + (size_t)t * DM + 8 * lane), x1 = *(const u32x4g*)(XN + (size_t)t * DM + 512 + 8 * lane);
        const int e0 = eidx[(size_t)t * 128 + lane], e1 = eidx[(size_t)t * 128 + 64 + lane];
        const float g0 = gw[(size_t)t * 128 + lane], g1 = gw[(size_t)t * 128 + 64 + lane];
#pragma unroll 1
        for (int b = 0; b < 8; ++b) GATHER_U8(e0, b);
#pragma unroll 1
        for (int b = 8; b < 16; ++b) GATHER_U8(e1, b);
        __builtin_amdgcn_s_waitcnt(0xc07f); asm volatile("" ::: "memory");
        const float w0 = g0 * gelu_tanh(al[lane]), w1 = g1 * gelu_tanh(al[64 + lane]);
        float acc[16];
#pragma unroll
        for (int i = 0; i < 16; ++i) acc[i] = 0.f;
#pragma unroll 1
        for (int b = 0; b < 8; ++b) GATHER_V8(e0, w0, b);
#pragma unroll 1
        for (int b = 8; b < 16; ++b) GATHER_V8(e1, w1, b);
        float* hp = h + (size_t)t * DM + 8 * lane;
        f32x4 h0 = *(f32x4*)(hp), h1 = *(f32x4*)(hp + 4), h2 = *(f32x4*)(hp + 512), h3 = *(f32x4*)(hp + 516);
        h0 += (f32x4){acc[0], acc[1], acc[2], acc[3]}; h1 += (f32x4){acc[4], acc[5], acc[6], acc[7]};
        h2 += (f32x4){acc[8], acc[9], acc[10], acc[11]}; h3 += (f32x4){acc[12], acc[13], acc[14], acc[15]};
        *(f32x4*)(hp) = h0; *(f32x4*)(hp + 4) = h1; *(f32x4*)(hp + 512) = h2; *(f32x4*)(hp + 516) = h3;
        float ss = 0.f;
#pragma unroll
        for (int i = 0; i < 4; ++i) ss += h0[i] * h0[i] + h1[i] * h1[i] + h2[i] * h2[i] + h3[i] * h3[i];
        const float rstd = 1.0f / sqrtf(wave_sum(ss) * (1.0f / DM) + NORM_EPS);
        const f32x4 ga = *(const f32x4*)(gain_next + 8 * lane), gb = *(const f32x4*)(gain_next + 8 * lane + 4), gc = *(const f32x4*)(gain_next + 512 + 8 * lane), gd = *(const f32x4*)(gain_next + 516 + 8 * lane);
        u32x4g o0, o1;
        o0.x = pk2(h0[0] * rstd * ga[0], h0[1] * rstd * ga[1]); o0.y = pk2(h0[2] * rstd * ga[2], h0[3] * rstd * ga[3]);
        o0.z = pk2(h1[0] * rstd * gb[0], h1[1] * rstd * gb[1]); o0.w = pk2(h1[2] * rstd * gb[2], h1[3] * rstd * gb[3]);
        o1.x = pk2(h2[0] * rstd * gc[0], h2[1] * rstd * gc[1]); o1.y = pk2(h2[2] * rstd * gc[2], h2[3] * rstd * gc[3]);
        o1.z = pk2(h3[0] * rstd * gd[0], h3[1] * rstd * gd[1]); o1.w = pk2(h3[2] * rstd * gd[2], h3[3] * rstd * gd[3]);
        *(u32x4g*)(XN + (size_t)t * DM + 8 * lane) = o0; *(u32x4g*)(XN + (size_t)t * DM + 512 + 8 * lane) = o1;
    }
}


typedef short bf16x8r __attribute__((ext_vector_type(8)));
typedef float f32x16r __attribute__((ext_vector_type(16)));
__device__ __forceinline__ float unokey(unsigned k) { const unsigned u = (k & 0x80000000u) ? (k & 0x7fffffffu) : ~k; return __builtin_bit_cast(float, u); }
#define CE_D(a, b) do { const unsigned mx_ = max(a, b), mn_ = min(a, b); a = mx_; b = mn_; } while (0)
#define SORT16_DESC(v, base) do { \
    _Pragma("unroll") for (int k_ = 2; k_ <= 16; k_ <<= 1) \
    _Pragma("unroll") for (int j_ = k_ >> 1; j_ > 0; j_ >>= 1) \
    _Pragma("unroll") for (int i_ = 0; i_ < 16; ++i_) { const int l_ = i_ ^ j_; if (l_ > i_) { if ((i_ & k_) == 0) CE_D(v[(base) + i_], v[(base) + l_]); else CE_D(v[(base) + l_], v[(base) + i_]); } } } while (0)
#define BMERGE16_DESC(v, base) do { \
    _Pragma("unroll") for (int j_ = 8; j_ > 0; j_ >>= 1) \
    _Pragma("unroll") for (int i_ = 0; i_ < 16; ++i_) { const int l_ = i_ ^ j_; if (l_ > i_) CE_D(v[(base) + i_], v[(base) + l_]); } } while (0)
#define TOPMERGE16(v, a, b) do { _Pragma("unroll") for (int i_ = 0; i_ < 16; ++i_) v[(a) + i_] = max(v[(a) + i_], v[(b) + 15 - i_]); BMERGE16_DESC(v, a); } while (0)
#define PARTNER_TOP16(v) do { unsigned o_[16]; _Pragma("unroll") for (int i_ = 0; i_ < 16; ++i_) o_[i_] = (unsigned)__shfl_xor((int)v[15 - i_], 32); \
    _Pragma("unroll") for (int i_ = 0; i_ < 16; ++i_) v[i_] = max(v[i_], o_[i_]); BMERGE16_DESC(v, 0); } while (0)
constexpr int SK_ROW = 272;
__device__ __forceinline__ void ph_peer_route_opt(const bf16* qry, const bf16* subk, int* eidx, float* gw, unsigned char* smem) {
    const int tid = tidx(), lane = tid & 63, wave = tid >> 6, r32 = lane & 31, hi = lane >> 5;
    for (int unit = bidx(); unit < 512; unit += gridDim.x) {
        const int h = unit & 7, tb = unit >> 3;
        __syncthreads();
        for (int i = tid; i < 4096; i += NT) { const int row = i >> 4, ch = i & 15;
            *(u32x4g*)(smem + row * SK_ROW + ch * 16) = *(const u32x4g*)(subk + ((size_t)(h * 2) * 128 + row) * 128 + ch * 8); }
        __syncthreads();
        const int trow = tb * 256 + wave * 32 + r32;
        unsigned top[2][16];
#pragma unroll
        for (int c = 0; c < 2; ++c) {
            f32x16r acc[4];
#pragma unroll
            for (int kb = 0; kb < 4; ++kb) acc[kb] = (f32x16r){0.f, 0.f, 0.f, 0.f, 0.f, 0.f, 0.f, 0.f, 0.f, 0.f, 0.f, 0.f, 0.f, 0.f, 0.f, 0.f};
#pragma unroll
            for (int ks = 0; ks < 8; ++ks) {
                const bf16x8r bq = *(const bf16x8r*)(qry + (size_t)trow * 2048 + h * 256 + c * 128 + ks * 16 + 8 * hi);
#pragma unroll
                for (int kb = 0; kb < 4; ++kb) {
                    const bf16x8r ak = *(const bf16x8r*)(smem + (c * 128 + kb * 32 + r32) * SK_ROW + (ks * 16 + 8 * hi) * 2);
                    acc[kb] = __builtin_amdgcn_mfma_f32_32x32x16_bf16(ak, bq, acc[kb], 0, 0, 0);
                }
            }
            unsigned k[64];
#pragma unroll
            for (int kb = 0; kb < 4; ++kb)
#pragma unroll
                for (int r = 0; r < 16; ++r) { const float sc = acc[kb][r]; const int idx = kb * 32 + (r & 3) + 8 * (r >> 2) + 4 * hi;
                    k[kb * 16 + r] = (okey(sc) & 0xffffff80u) | (unsigned)(127 - idx); }
            SORT16_DESC(k, 0); SORT16_DESC(k, 16); SORT16_DESC(k, 32); SORT16_DESC(k, 48);
            TOPMERGE16(k, 0, 16); TOPMERGE16(k, 32, 48); TOPMERGE16(k, 0, 32);
            PARTNER_TOP16(k);
#pragma unroll
            for (int i = 0; i < 16; ++i) top[c][i] = k[i];
        }
        float va[16], vb[16];
#pragma unroll
        for (int i = 0; i < 16; ++i) { va[i] = unokey((top[0][i] & 0xffffff80u) | 0x40u); vb[i] = unokey((top[1][i] & 0xffffff80u) | 0x40u); }
        unsigned ck[32];
        ck[0] = (okey(hi ? (va[2] + vb[1]) : (va[0] + vb[0])) & 0xffffff00u) | (hi ? 222u : 255u);
        ck[1] = (okey(hi ? (va[2] + vb[2]) : (va[0] + vb[1])) & 0xffffff00u) | (hi ? 221u : 254u);
        ck[2] = (okey(hi ? (va[2] + vb[3]) : (va[0] + vb[2])) & 0xffffff00u) | (hi ? 220u : 253u);
        ck[3] = (okey(hi ? (va[2] + vb[4]) : (va[0] + vb[3])) & 0xffffff00u) | (hi ? 219u : 252u);
        ck[4] = (okey(hi ? (va[3] + vb[0]) : (va[0] + vb[4])) & 0xffffff00u) | (hi ? 207u : 251u);
        ck[5] = (okey(hi ? (va[3] + vb[1]) : (va[0] + vb[5])) & 0xffffff00u) | (hi ? 206u : 250u);
        ck[6] = (okey(hi ? (va[3] + vb[2]) : (va[0] + vb[6])) & 0xffffff00u) | (hi ? 205u : 249u);
        ck[7] = (okey(hi ? (va[3] + vb[3]) : (va[0] + vb[7])) & 0xffffff00u) | (hi ? 204u : 248u);
        ck[8] = (okey(hi ? (va[4] + vb[0]) : (va[0] + vb[8])) & 0xffffff00u) | (hi ? 191u : 247u);
        ck[9] = (okey(hi ? (va[4] + vb[1]) : (va[0] + vb[9])) & 0xffffff00u) | (hi ? 190u : 246u);
        ck[10] = (okey(hi ? (va[4] + vb[2]) : (va[0] + vb[10])) & 0xffffff00u) | (hi ? 189u : 245u);
        ck[11] = (okey(hi ? (va[5] + vb[0]) : (va[0] + vb[11])) & 0xffffff00u) | (hi ? 175u : 244u);
        ck[12] = (okey(hi ? (va[5] + vb[1]) : (va[0] + vb[12])) & 0xffffff00u) | (hi ? 174u : 243u);
        ck[13] = (okey(hi ? (va[6] + vb[0]) : (va[0] + vb[13])) & 0xffffff00u) | (hi ? 159u : 242u);
        ck[14] = (okey(hi ? (va[6] + vb[1]) : (va[0] + vb[14])) & 0xffffff00u) | (hi ? 158u : 241u);
        ck[15] = (okey(hi ? (va[7] + vb[0]) : (va[0] + vb[15])) & 0xffffff00u) | (hi ? 143u : 240u);
        ck[16] = (okey(hi ? (va[7] + vb[1]) : (va[1] + vb[0])) & 0xffffff00u) | (hi ? 142u : 239u);
        ck[17] = (okey(hi ? (va[8] + vb[0]) : (va[1] + vb[1])) & 0xffffff00u) | (hi ? 127u : 238u);
        ck[18] = (okey(hi ? (va[9] + vb[0]) : (va[1] + vb[2])) & 0xffffff00u) | (hi ? 111u : 237u);
        ck[19] = (okey(hi ? (va[10] + vb[0]) : (va[1] + vb[3])) & 0xffffff00u) | (hi ? 95u : 236u);
        ck[20] = (okey(hi ? (va[11] + vb[0]) : (va[1] + vb[4])) & 0xffffff00u) | (hi ? 79u : 235u);
        ck[21] = (okey(hi ? (va[12] + vb[0]) : (va[1] + vb[5])) & 0xffffff00u) | (hi ? 63u : 234u);
        ck[22] = (okey(hi ? (va[13] + vb[0]) : (va[1] + vb[6])) & 0xffffff00u) | (hi ? 47u : 233u);
        ck[23] = (okey(hi ? (va[14] + vb[0]) : (va[1] + vb[7])) & 0xffffff00u) | (hi ? 31u : 232u);
        ck[24] = (okey(hi ? (va[15] + vb[0]) : (va[2] + vb[0])) & 0xffffff00u) | (hi ? 15u : 223u);
#pragma unroll
        for (int s = 25; s < 32; ++s) ck[s] = 0u;
        SORT16_DESC(ck, 0); SORT16_DESC(ck, 16); TOPMERGE16(ck, 0, 16);
        PARTNER_TOP16(ck);
        const float m = unokey((ck[0] & 0xffffff00u) | 0x80u);
        float l = 0.f;
#pragma unroll
        for (int r = 0; r < 16; ++r) l += __expf(unokey((ck[r] & 0xffffff00u) | 0x80u) - m);
        const float linv = 1.0f / l;
        unsigned p0[4], p1[4];
#pragma unroll
        for (int w = 0; w < 4; ++w) { p0[w] = 0u; p1[w] = 0u;
#pragma unroll
            for (int b = 0; b < 4; ++b) { p0[w] |= (127u - (top[0][4 * w + b] & 127u)) << (8 * b); p1[w] |= (127u - (top[1][4 * w + b] & 127u)) << (8 * b); } }
        int eo[8]; float go[8]; const unsigned hmask = 0u - (unsigned)hi;
#pragma unroll
        for (int rr = 0; rr < 8; ++rr) {
            const unsigned key = ck[rr] ^ ((ck[rr] ^ ck[8 + rr]) & hmask);
            const unsigned flat = 255u - (key & 255u), i = flat >> 4, j = flat & 15u;
            const unsigned wi = (i >> 2) == 0 ? p0[0] : ((i >> 2) == 1 ? p0[1] : ((i >> 2) == 2 ? p0[2] : p0[3]));
            const unsigned wj = (j >> 2) == 0 ? p1[0] : ((j >> 2) == 1 ? p1[1] : ((j >> 2) == 2 ? p1[2] : p1[3]));
            const unsigned i0 = (wi >> ((i & 3u) * 8u)) & 255u, i1 = (wj >> ((j & 3u) * 8u)) & 255u;
            eo[rr] = (int)(i0 * 128u + i1);
            go[rr] = __expf(unokey((key & 0xffffff00u) | 0x80u) - m) * linv;
        }
        int* ep = eidx + (size_t)trow * 128 + h * 16 + 8 * hi; float* gp = gw + (size_t)trow * 128 + h * 16 + 8 * hi;
        typedef int i32x4 __attribute__((ext_vector_type(4)));
        *(i32x4*)ep = (i32x4){eo[0], eo[1], eo[2], eo[3]}; *(i32x4*)(ep + 4) = (i32x4){eo[4], eo[5], eo[6], eo[7]};
        *(f32x4*)gp = (f32x4){go[0], go[1], go[2], go[3]}; *(f32x4*)(gp + 4) = (f32x4){go[4], go[5], go[6], go[7]};
    }
}

#ifndef ATTN_STORE16
#define ATTN_STORE16(p,v) (*(u32x4*)(p)=(v))
#endif
namespace attn_g {
typedef unsigned short bf16;
using bf16x8=__attribute__((ext_vector_type(8)))short;
using s16x4=__attribute__((ext_vector_type(4)))short;
using f32x16=__attribute__((ext_vector_type(16)))float;
using u32x4=__attribute__((ext_vector_type(4)))unsigned;
constexpr int D=64;
constexpr int NW=8,QBLK=32,QB=QBLK*NW,KVBLK=64;
__device__ __forceinline__ int crow(int r,int hi){return (r&3)+8*(r>>2)+4*hi;}
#define SBAR() __builtin_amdgcn_sched_barrier(0)
__device__ __forceinline__ void cmask(f32x16&p0,f32x16&p1,int jb,int qrel,int hi){
  const float NEG=-__builtin_inff(); int kb=64*jb+4*hi;
  #pragma unroll
  for(int r=0;r<16;++r){int kv=kb+(r&3)+8*(r>>2); if(kv>qrel)p0[r]=NEG; if(kv+32>qrel)p1[r]=NEG;}
}

constexpr int NSLOT=3, SLOTB=8192;
constexpr int LDS_K=0, LDS_V=NSLOT*SLOTB, LDS_WS=2*NSLOT*SLOTB, LDS_OST=LDS_WS+NW*64*4, LDS_MSK=LDS_OST+NW*4096, LDS_BYTES=LDS_MSK+NW*2*256;
constexpr float C2=0.125f*1.4426950408889634f;
__device__ __forceinline__ void glds16(const void*gsrc,unsigned lds_dst){unsigned keep;
  asm volatile("s_mov_b32 %0, m0\n\ts_mov_b32 m0, %2\n\ts_nop 0\n\tglobal_load_lds_dwordx4 %1, off\n\ts_mov_b32 m0, %0":"=&s"(keep):"v"(gsrc),"s"(lds_dst):"memory");}
__device__ __forceinline__ void glds4(const void*gsrc,unsigned lds_dst){unsigned keep;
  asm volatile("s_mov_b32 %0, m0\n\ts_mov_b32 m0, %2\n\ts_nop 0\n\tglobal_load_lds_dword %1, off\n\ts_mov_b32 m0, %0":"=&s"(keep):"v"(gsrc),"s"(lds_dst):"memory");}
__device__ __forceinline__ float max3f(float a,float b,float c){float r;asm("v_max3_f32 %0, %1, %2, %3":"=v"(r):"v"(a),"v"(b),"v"(c));return r;}
__device__ __forceinline__ float max2f(float a,float b){float r;asm("v_max_f32_e32 %0, %1, %2":"=v"(r):"v"(a),"v"(b));return r;}
__device__ __forceinline__ float fadd_s(float a,float b){float r;asm("v_add_f32_e32 %0, %1, %2":"=v"(r):"v"(a),"v"(b));return r;}
__device__ __forceinline__ float fsub_s(float a,float b){float r;asm("v_sub_f32_e32 %0, %1, %2":"=v"(r):"v"(a),"v"(b));return r;}
typedef float f32x2_t __attribute__((ext_vector_type(2))); typedef __bf16 bf16x2_t __attribute__((ext_vector_type(2)));
__device__ __forceinline__ unsigned cvtpk_s(float lo,float hi){f32x2_t v={lo,hi};bf16x2_t b=__builtin_convertvector(v,bf16x2_t);return __builtin_bit_cast(unsigned,b);}
#define WAIT_BAR(N) asm volatile("s_waitcnt vmcnt(" #N ") lgkmcnt(0)\n\ts_barrier":::"memory")

__device__ __forceinline__ void qkt(f32x16&p0,f32x16&p1,const char*Kslot,const bf16x8*qr,const f32x16&negm,int r32,int hi){
  const char*kb=Kslot+hi*1024+r32*16;
  #pragma unroll
  for(int d0=0;d0<4;++d0){
    const bf16x8 b0=*reinterpret_cast<const bf16x8*>(kb+d0*2048);
    const bf16x8 b1=*reinterpret_cast<const bf16x8*>(kb+d0*2048+512);
    if(d0==0){p0=__builtin_amdgcn_mfma_f32_32x32x16_bf16(b0,qr[0],negm,0,0,0);p1=__builtin_amdgcn_mfma_f32_32x32x16_bf16(b1,qr[0],negm,0,0,0);}
    else{p0=__builtin_amdgcn_mfma_f32_32x32x16_bf16(b0,qr[d0],p0,0,0,0);p1=__builtin_amdgcn_mfma_f32_32x32x16_bf16(b1,qr[d0],p1,0,0,0);}}
}
typedef __attribute__((address_space(3))) const char* lds_cptr;
typedef short v4i16_t __attribute__((ext_vector_type(4)));
__device__ __forceinline__ void kload8(bf16x8*kf,lds_cptr kp){
  kf[0]=*(const __attribute__((address_space(3))) bf16x8*)(kp);      kf[1]=*(const __attribute__((address_space(3))) bf16x8*)(kp+512);
  kf[2]=*(const __attribute__((address_space(3))) bf16x8*)(kp+2048); kf[3]=*(const __attribute__((address_space(3))) bf16x8*)(kp+2560);
  kf[4]=*(const __attribute__((address_space(3))) bf16x8*)(kp+4096); kf[5]=*(const __attribute__((address_space(3))) bf16x8*)(kp+4608);
  kf[6]=*(const __attribute__((address_space(3))) bf16x8*)(kp+6144); kf[7]=*(const __attribute__((address_space(3))) bf16x8*)(kp+6656);
}
__device__ __forceinline__ void kload2(bf16x8*kf,lds_cptr kp,int j){ kf[2*j]=*(const __attribute__((address_space(3))) bf16x8*)(kp+j*2048); kf[2*j+1]=*(const __attribute__((address_space(3))) bf16x8*)(kp+j*2048+512); }
__device__ __forceinline__ s16x4 vtr(lds_cptr p){ return __builtin_bit_cast(s16x4,__builtin_amdgcn_ds_read_tr16_b64_v4i16((__attribute__((address_space(3))) v4i16_t*)p)); }
__device__ __forceinline__ float rowmax(const f32x16&p0,const f32x16&p1){
  float a=max3f(p0[0],p0[1],p1[0]),b=max3f(p0[2],p0[3],p1[1]);a=max3f(a,p1[2],p1[3]);
  #pragma unroll
  for(int r=4;r<16;r+=4){a=max3f(a,p0[r],p0[r+1]);b=max3f(b,p0[r+2],p0[r+3]);a=max3f(a,p1[r],p1[r+1]);b=max3f(b,p1[r+2],p1[r+3]);}
  const float m=max2f(a,b);
  auto rr=__builtin_amdgcn_permlane32_swap(__float_as_uint(m),__float_as_uint(m),false,false);
  return max2f(__uint_as_float(rr[0]),__uint_as_float(rr[1]));
}
__device__ __forceinline__ void pv(f32x16*o,int vb,bf16x8 pa0,bf16x8 pa1,bf16x8 pa2,bf16x8 pa3){
  #pragma unroll
  for(int d0=0;d0<2;++d0){s16x4 lo[4],hi[4];
    #pragma unroll
    for(int ks=0;ks<4;++ks){
      asm volatile("ds_read_b64_tr_b16 %0,%1 offset:%c2":"=&v"(lo[ks]):"v"(vb),"i"(d0*4096+ks*1024):"memory");
      asm volatile("ds_read_b64_tr_b16 %0,%1 offset:%c2":"=&v"(hi[ks]):"v"(vb),"i"(d0*4096+ks*1024+512):"memory");}
    asm volatile("s_waitcnt lgkmcnt(0)":::"memory");SBAR();
    #define PK(k) (bf16x8){lo[k][0],lo[k][1],lo[k][2],lo[k][3],hi[k][0],hi[k][1],hi[k][2],hi[k][3]}
    o[d0]=__builtin_amdgcn_mfma_f32_32x32x16_bf16(pa0,PK(0),o[d0],0,0,0);
    o[d0]=__builtin_amdgcn_mfma_f32_32x32x16_bf16(pa1,PK(1),o[d0],0,0,0);
    o[d0]=__builtin_amdgcn_mfma_f32_32x32x16_bf16(pa2,PK(2),o[d0],0,0,0);
    o[d0]=__builtin_amdgcn_mfma_f32_32x32x16_bf16(pa3,PK(3),o[d0],0,0,0);
    #undef PK
  }
}

#ifndef ATTN_STORE16
#define ATTN_STORE16(p,v) (*(u32x4*)(p)=(v))
#endif
template<int MODE,int THRL> __device__ __forceinline__ void attn_unit(const bf16*Qu,long qs,const bf16*__restrict__ Kh,const bf16*__restrict__ Vh,long kvs,bf16*Ou,long os,float*lse,long lses,const int NT,
    const unsigned*selp,const char*Msrc,const int e0,char*shm){
  const int tid=tidx(),lane=tid&63,r32=lane&31,hi=lane>>5; const int wid=__builtin_amdgcn_readfirstlane(tid>>6);
  const bf16*Qw=Qu+(long)(wid*QBLK)*qs;
  const unsigned lds0=(unsigned)(uintptr_t)shm;
  float*wsf=(float*)(shm+LDS_WS)+wid*64;
  const bf16*ksrc=Kh+(long)lane*kvs+wid*8;
  const bf16*vsrc=Vh+(long)(16*(wid&3)+(lane>>2))*kvs+(wid>>2)*32+(lane&3)*8;
  const unsigned kdst=lds0+LDS_K+wid*1024, vdst=lds0+LDS_V+wid*1024;
  #define KT(t) ((MODE==0)?(((t)<4)?(NT-4+(t)):((t)-4)):(t))
  #define DMA_K(t,slot) glds16(ksrc+(long)KT(t)*KVBLK*kvs,(unsigned)__builtin_amdgcn_readfirstlane(kdst+(slot)))
  #define DMA_V(t,slot) glds16(vsrc+(long)KT(t)*KVBLK*kvs,(unsigned)__builtin_amdgcn_readfirstlane(vdst+(slot)))
  const char*msrc=Msrc+(long)(wid*QBLK)*8+lane*4; const unsigned mdst=lds0+LDS_MSK+wid*512;
  #define DMA_M(t) do{ if(MODE==1) glds4(msrc+(long)(t)*(8192*8),(unsigned)__builtin_amdgcn_readfirstlane(mdst+((t)&1)*256)); }while(0)
  const int vb0=(int)(lds0+LDS_V)+((lane>>4)&1)*32+(lane&3)*8+(4*hi+((lane&15)>>2))*64;
  const char*Kbase=shm+LDS_K; bf16x8 kf[8];
  const lds_cptr shm3=(lds_cptr)shm; const lds_cptr kp0=shm3+LDS_K+hi*1024+r32*16; const lds_cptr vp0=shm3+LDS_V+((lane>>4)&1)*32+(lane&3)*8+(4*hi+((lane&15)>>2))*64;
  DMA_M(0);DMA_M(1);
  DMA_K(0,0);DMA_V(0,0);DMA_K(1,SLOTB);
  bf16x8 qr[4];
  #pragma unroll
  for(int d0=0;d0<4;++d0)qr[d0]=*reinterpret_cast<const bf16x8*>(&Qw[(long)r32*qs+d0*16+hi*8]);
  unsigned selw=0u; if(MODE==0) selw=selp[(long)(wid*QBLK+r32)*8];
  float mhat=0.f,l_reg=0.f;f32x16 o[2];f32x16 negm; { float zz_=0.f; asm volatile("":"+v"(zz_));
    _Pragma("unroll") for(int r=0;r<16;++r){o[0][r]=zz_;o[1][r]=zz_;negm[r]=zz_;} } asm volatile("":"+v"(negm));
  const int qrel=wid*QBLK+r32;
  #define CMASK(P0,P1,t) do{ const float NEG_=-__builtin_inff(); \
    if(MODE==0){ if((t)<4){cmask(P0,P1,(t),qrel,hi);} else { const unsigned n_=(unsigned)(((t)-4)>>2); const bool ok_=(n_==(selw&255u))|(n_==((selw>>8)&255u))|(n_==((selw>>16)&255u)); \
        _Pragma("unroll") for(int r=0;r<16;++r){P0[r]=ok_?P0[r]:NEG_;P1[r]=ok_?P1[r]:NEG_;} } } \
    else if(MODE==1){ const unsigned long long mw_=*(const __attribute__((address_space(3))) unsigned long long*)(shm3+LDS_MSK+wid*512+((t)&1)*256+r32*8); \
        const unsigned lo_=((unsigned)mw_)>>(4*hi), hh_=((unsigned)(mw_>>32))>>(4*hi); \
        _Pragma("unroll") for(int r=0;r<16;++r){ const unsigned bit_=1u<<((r&3)+8*(r>>2)); P0[r]=(lo_&bit_)?P0[r]:NEG_; P1[r]=(hh_&bit_)?P1[r]:NEG_; } } \
    else { const int e_=e0-64*(t)+qrel-4*hi; \
        _Pragma("unroll") for(int r=0;r<16;++r){ const int c_=(r&3)+8*(r>>2); P0[r]=((unsigned)(e_-c_)<=128u)?P0[r]:NEG_; P1[r]=((unsigned)(e_-c_-32)<=128u)?P1[r]:NEG_; } } }while(0)
  bool resc=false;
  #define START(P0,P1) do{ const float rm=rowmax(P0,P1); resc=false; \
    { const float dl=(rm<-1e30f)?0.f:rm; mhat=fadd_s(mhat,dl); \
      _Pragma("unroll") for(int r=0;r<16;++r){P0[r]=fsub_s(P0[r],dl);P1[r]=fsub_s(P1[r],dl);} \
      _Pragma("unroll") for(int r=0;r<16;++r)negm[r]=-mhat; asm volatile("":"+v"(negm)); } \
    _Pragma("unroll") for(int r=0;r<16;++r)P0[r]=__builtin_amdgcn_exp2f(P0[r]); }while(0)
  #define RESC() do{ if(resc){ asm volatile("s_waitcnt lgkmcnt(0)":::"memory"); \
      _Pragma("unroll") for(int d_=0;d_<2;++d_) _Pragma("unroll") for(int r=0;r<16;++r)o[d_][r]*=wsf[crow(r,hi)]; } }while(0)
  f32x16 pA0,pA1,pB0,pB1;
  int sl_prev=0,sl_cur=0,sl_next=SLOTB;
  #define ROT() do{sl_prev=sl_cur;sl_cur=sl_next;sl_next=(sl_next==(NSLOT-1)*SLOTB)?0:sl_next+SLOTB;}while(0)
  DMA_K(2,2*SLOTB);
  WAIT_BAR(3);
  qkt(pA0,pA1,Kbase,qr,negm,r32,hi);asm volatile("s_nop 15\n\ts_nop 7":"+v"(pA0),"+v"(pA1));CMASK(pA0,pA1,0);
  START(pA0,pA1);
  _Pragma("unroll") for(int r=0;r<16;++r)pA1[r]=__builtin_amdgcn_exp2f(pA1[r]);
  WAIT_BAR(0);
  DMA_K(3,0);DMA_V(1,SLOTB);
  ROT();
  kload8(kf,kp0+sl_cur);
  WAIT_BAR(2);
  s16x4 vlo[8],vhi[8]; u32x4 pw0,pw1,pw2,pw3;
  #define PKW(P,B) cvtpk_s(P[B],P[B+1])
  #define PAF(k) __builtin_bit_cast(bf16x8,pw##k)
  #define VFR(i) (bf16x8){vlo[i][0],vlo[i][1],vlo[i][2],vlo[i][3],vhi[i][0],vhi[i][1],vhi[i][2],vhi[i][3]}
  #define PIN(x) asm volatile("":"+v"(x))
  #define MX3(a,b,c) __builtin_fmaxf(__builtin_fmaxf((a),(b)),(c))
  #define GAPA(MF,A0,A1,A2,A3,W0,W1,PW) do{ MF; sacc+=A0; sacc+=A1; sacc+=A2; sacc+=A3; PIN(sacc); W0; W1; PIN(PW); SBAR(); }while(0)
  #define EX(v) __builtin_amdgcn_exp2f(v)
  #define GAPB(MF,X,B) do{ MF; X[B]=EX(X[B]); X[B+1]=EX(X[B+1]); X[B+2]=EX(X[B+2]); X[B+3]=EX(X[B+3]); PIN(X); SBAR(); }while(0)
  #define VRD(i) do{ vlo[i]=vtr(vp_+(((i)>>2)*4096+((i)&3)*1024)); vhi[i]=vtr(vp_+(((i)>>2)*4096+((i)&3)*1024+512)); }while(0)
  #define KRD(G,j) do{ if(G){ kload2(kf,kp0+sl_next,j); SBAR(); } }while(0)
  #define STEP(C0,C1,P0,P1,t,GK,GV,GL) do{ SBAR(); if((t)+1<NT){DMA_M((t)+1);} \
    const lds_cptr vp_=vp0+sl_prev; \
    VRD(0); SBAR(); float sacc=(P0[0]+P0[1]); \
    GAPA(C0=__builtin_amdgcn_mfma_f32_32x32x16_bf16(kf[0],qr[0],negm,0,0,0), P0[2],P0[3],P0[4],P0[5],     pw0[0]=PKW(P0,0), pw0[1]=PKW(P0,2), pw0); \
    VRD(4); SBAR(); GAPA(C1=__builtin_amdgcn_mfma_f32_32x32x16_bf16(kf[1],qr[0],negm,0,0,0), P0[6],P0[7],P0[8],P0[9],     pw0[2]=PKW(P0,4), pw0[3]=PKW(P0,6), pw0); \
    VRD(1); SBAR(); GAPA(C0=__builtin_amdgcn_mfma_f32_32x32x16_bf16(kf[2],qr[1],C0,0,0,0),   P0[10],P0[11],P0[12],P0[13], pw1[0]=PKW(P0,8), pw1[1]=PKW(P0,10), pw1); \
    VRD(5); SBAR(); GAPA(C1=__builtin_amdgcn_mfma_f32_32x32x16_bf16(kf[3],qr[1],C1,0,0,0),   P0[14],P0[15],P1[0],P1[1],   pw1[2]=PKW(P0,12),pw1[3]=PKW(P0,14), pw1); \
    VRD(2); SBAR(); GAPA(C0=__builtin_amdgcn_mfma_f32_32x32x16_bf16(kf[4],qr[2],C0,0,0,0),   P1[2],P1[3],P1[4],P1[5],     pw2[0]=PKW(P1,0), pw2[1]=PKW(P1,2), pw2); \
    VRD(6); SBAR(); GAPA(C1=__builtin_amdgcn_mfma_f32_32x32x16_bf16(kf[5],qr[2],C1,0,0,0),   P1[6],P1[7],P1[8],P1[9],     pw2[2]=PKW(P1,4), pw2[3]=PKW(P1,6), pw2); \
    VRD(3); SBAR(); GAPA(C0=__builtin_amdgcn_mfma_f32_32x32x16_bf16(kf[6],qr[3],C0,0,0,0),   P1[10],P1[11],P1[12],P1[13], pw3[0]=PKW(P1,8), pw3[1]=PKW(P1,10), pw3); \
    VRD(7); SBAR(); GAPA(C1=__builtin_amdgcn_mfma_f32_32x32x16_bf16(kf[7],qr[3],C1,0,0,0),   P1[14],P1[15],0.f,0.f,       pw3[2]=PKW(P1,12),pw3[3]=PKW(P1,14), pw3); \
    l_reg+=sacc; \
    if(GK){DMA_K((t)+3,sl_cur);} if(GV){DMA_V((t)+1,sl_next);} \
    CMASK(C0,C1,t); \
    { float a=MX3(C0[0],C0[1],C1[0]),b=MX3(C0[2],C0[3],C1[1]); a=MX3(a,C1[2],C1[3]); \
      _Pragma("unroll") for(int r=4;r<16;r+=4){a=MX3(a,C0[r],C0[r+1]);b=MX3(b,C0[r+2],C0[r+3]);a=MX3(a,C1[r],C1[r+1]);b=MX3(b,C1[r+2],C1[r+3]);} \
      float rm=__builtin_fmaxf(a,b); { auto rr=__builtin_amdgcn_permlane32_swap(__float_as_uint(rm),__float_as_uint(rm),false,false); rm=__builtin_fmaxf(__uint_as_float(rr[0]),__uint_as_float(rr[1])); } \
      resc=false; \
      if(__builtin_expect(__any(rm>(float)THRL),0)){ const float dl=__builtin_fmaxf(rm,0.f); mhat+=dl; \
        _Pragma("unroll") for(int r=0;r<16;++r){C0[r]-=dl;C1[r]-=dl;} \
        _Pragma("unroll") for(int r=0;r<16;++r)negm[r]=-mhat; asm volatile("":"+v"(negm)); \
        const float f=__builtin_amdgcn_exp2f(-dl); l_reg*=f; if(hi==0)wsf[r32]=f; resc=true; } } \
    SBAR(); \
    GAPB(o[0]=__builtin_amdgcn_mfma_f32_32x32x16_bf16(PAF(0),VFR(0),o[0],0,0,0), C0,0); \
    GAPB(o[1]=__builtin_amdgcn_mfma_f32_32x32x16_bf16(PAF(0),VFR(4),o[1],0,0,0), C0,4); \
    KRD(GL,0); GAPB(o[0]=__builtin_amdgcn_mfma_f32_32x32x16_bf16(PAF(1),VFR(1),o[0],0,0,0), C0,8); \
    KRD(GL,1); GAPB(o[1]=__builtin_amdgcn_mfma_f32_32x32x16_bf16(PAF(1),VFR(5),o[1],0,0,0), C0,12); \
    KRD(GL,2); GAPB(o[0]=__builtin_amdgcn_mfma_f32_32x32x16_bf16(PAF(2),VFR(2),o[0],0,0,0), C1,0); \
    KRD(GL,3); GAPB(o[1]=__builtin_amdgcn_mfma_f32_32x32x16_bf16(PAF(2),VFR(6),o[1],0,0,0), C1,4); \
    GAPB(o[0]=__builtin_amdgcn_mfma_f32_32x32x16_bf16(PAF(3),VFR(3),o[0],0,0,0), C1,8); \
    GAPB(o[1]=__builtin_amdgcn_mfma_f32_32x32x16_bf16(PAF(3),VFR(7),o[1],0,0,0), C1,12); \
    }while(0)
  int t=1;
  for(;t+5<NT;t+=2){
    STEP(pB0,pB1,pA0,pA1,t,true,true,true);     WAIT_BAR(2); RESC(); ROT();
    STEP(pA0,pA1,pB0,pB1,t+1,true,true,true);   WAIT_BAR(2); RESC(); ROT();
  }
  #define ENDW(tt) do{ if((tt)+3<NT){WAIT_BAR(2);} else if((tt)+2<NT){WAIT_BAR(1);} else {WAIT_BAR(0);} }while(0)
  for(;t+1<NT;t+=2){
    STEP(pB0,pB1,pA0,pA1,t,(t+3<NT),(t+1<NT),(t+1<NT));       ENDW(t);   RESC(); ROT();
    STEP(pA0,pA1,pB0,pB1,t+1,(t+4<NT),(t+2<NT),(t+2<NT));     ENDW(t+1); RESC(); ROT();
  }
  STEP(pB0,pB1,pA0,pA1,NT-1,false,false,false); RESC();
  { float sacc=pB0[0]+pB0[1]; _Pragma("unroll") for(int r=2;r<16;++r)sacc+=pB0[r]; _Pragma("unroll") for(int r=0;r<16;++r)sacc+=pB1[r]; l_reg+=sacc;
    pw0=(u32x4){PKW(pB0,0),PKW(pB0,2),PKW(pB0,4),PKW(pB0,6)};pw1=(u32x4){PKW(pB0,8),PKW(pB0,10),PKW(pB0,12),PKW(pB0,14)};pw2=(u32x4){PKW(pB1,0),PKW(pB1,2),PKW(pB1,4),PKW(pB1,6)};pw3=(u32x4){PKW(pB1,8),PKW(pB1,10),PKW(pB1,12),PKW(pB1,14)};
    SBAR(); pv(o,vb0+sl_cur,PAF(0),PAF(1),PAF(2),PAF(3)); }
  #undef PKW
  #undef PAF
  #undef VFR
  #undef PIN
  #undef MX3
  #undef GAPA
  #undef GAPB
  #undef EX
  #undef VRD
  #undef KRD
  #undef STEP
  #undef ENDW
  {auto rr=__builtin_amdgcn_permlane32_swap(__float_as_uint(l_reg),__float_as_uint(l_reg),false,false);l_reg=__uint_as_float(rr[0])+__uint_as_float(rr[1]);}
  if(hi==0)wsf[32+r32]=l_reg;asm volatile("s_waitcnt lgkmcnt(0)":::"memory");
  float rli[16];
  #pragma unroll
  for(int r=0;r<16;++r)rli[r]=__builtin_amdgcn_rcpf(wsf[32+crow(r,hi)]);
  if(lse!=nullptr && hi==0) lse[(long)(wid*QBLK+r32)*lses]=mhat+__log2f(l_reg);
  bf16*Ow=Ou+(long)(wid*QBLK)*os;
  { bf16*stg=(bf16*)(shm+LDS_OST)+wid*2048;
    #pragma unroll
    for(int r=0;r<16;++r){const int orow=crow(r,hi);
      #pragma unroll
      for(int d0=0;d0<2;++d0)stg[orow*64+d0*32+r32]=(bf16)f2bf(o[d0][r]*rli[r]);}
    asm volatile("s_waitcnt lgkmcnt(0)":::"memory");
    #pragma unroll
    for(int i=0;i<4;++i){const int row=i*8+(lane>>3),ch=lane&7; const u32x4 v=*(const u32x4*)(stg+row*64+ch*8); ATTN_STORE16(Ow+(long)row*os+ch*8,v);} }
  asm volatile("s_waitcnt lgkmcnt(0)\n\ts_barrier":::"memory");
  #undef DMA_K
  #undef DMA_V
  #undef DMA_M
  #undef KT
  #undef CMASK
  #undef START
  #undef RESC
  #undef ROT
}
constexpr int ATTN_LDS_BYTES=LDS_BYTES;
#undef SBAR
#undef WAIT_BAR
}

__device__ __forceinline__ int vcu_of(int G, int bx) { return (G % 8 == 0) ? (bx % 8) * (G / 8) + bx / 8 : bx; }
__device__ __forceinline__ void ph_attn_moba(const bf16* QKV, const unsigned* SEL, bf16* O, unsigned char* smem) {
    const int G = (int)gridDim.x, vcu = vcu_of(G, bidx());
#pragma unroll 1
    for (int idx = 2 * vcu; idx < 512; idx += ((idx & 1) ? 2 * G - 1 : 1)) {
        const int bh = idx >> 5, j = idx & 31, qb = (j & 1) ? 31 - (j >> 1) : (j >> 1), b = bh >> 3, h = bh & 7;
        const long row0 = (long)b * SEQ + 256 * qb, kv0 = (long)b * SEQ * AB_LD;
        attn_g::attn_unit<0, 8>(QKV + row0 * AB_LD + CQA + h * 64, AB_LD, QKV + kv0 + CKA + h * 64, QKV + kv0 + CVA + h * 64, AB_LD, O + row0 * DM + h * 64, DM, nullptr, 0, 4 * qb + 4,
                                SEL + row0 * 8 + h, nullptr, 0, (char*)smem);
    }
}

namespace cg = cooperative_groups;
constexpr int LDS_BYTES = 147456;
#define GEMM_PHASE(EPI, Aptr, Bptr, Nn, Kk, ...) do { pg8::Gemm g_{(const pg8::bf16_t*)(Aptr), (const pg8::bf16_t*)(Bptr), T, (Nn), (Kk)}; pg8::StaticOrder S_; S_.init(T, (Nn), (int)gridDim.x, (int)bidx()); \
    pg8::EPI E_{__VA_ARGS__}; pg8::gemm_phase<pg8::EPI, pg8::StaticOrder, true, true>((PG8_LAS unsigned char*)smem, g_, S_, E_); } while (0)
__global__ void __launch_bounds__(NT, 2) k_mega(Params P) {
    extern __shared__ __attribute__((aligned(16))) unsigned char smem[];
    cg::grid_group grid = cg::this_grid();
#define BAR() grid.sync()
    ph_prologue(smem);
    ph_rmsnorm(IN(0), IN(3), (bf16*)(WSP + WS_XN)); BAR();
    { unsigned char* ws = WSP; GEMM_PHASE(EBf16, ws + WS_XN, ws + WS_WAB_IN, AB_LD, DM, (bf16*)(ws + WS_QKV), AB_LD); } BAR();
    ph_prep0((bf16*)(WSP + WS_QKV), (const int*)IN(2), IN(8), IN(9), IN(10), IN(11)); BAR();
    { unsigned char* ws = WSP; ph_kmean((bf16*)(ws + WS_QKV), (float*)(ws + WS_KMEAN)); } BAR();
    { unsigned char* ws = WSP; ph_moba_select((bf16*)(ws + WS_QKV), (float*)(ws + WS_KMEAN), (unsigned*)(ws + WS_SEL)); } BAR();
    { unsigned char* ws = WSP; ph_attn_moba((bf16*)(ws + WS_QKV), (unsigned*)(ws + WS_SEL), (bf16*)(ws + WS_XN), smem); }
    { unsigned char* ws = WSP; ph_dsa_select((bf16*)(ws + WS_QKV), (unsigned long long*)(ws + WS_MASK), smem); } BAR();
    { unsigned char* ws = WSP; ph_dsa_attend((bf16*)(ws + WS_QKV), (unsigned long long*)(ws + WS_MASK), (bf16*)(ws + WS_XN), smem); } BAR();
    { unsigned char* ws = WSP; GEMM_PHASE(EResAdd, ws + WS_XN, ws + WS_WAB_OUT, DM, DM, IN(0), OUTP); } BAR();
#pragma unroll 1
    for (int L = 0; L < 2; ++L) {
        if (L == 1) {
            ph_rmsnorm(OUTP, IN(3) + DM, (bf16*)(WSP + WS_XN)); BAR();
            { unsigned char* ws = WSP; GEMM_PHASE(EBf16, ws + WS_XN, ws + WS_WC_IN, C_LD, DM, (bf16*)(ws + WS_QKV1), C_LD); } BAR();
            ph_prep1((bf16*)(WSP + WS_QKV1), (const int*)IN(2), IN(14), IN(15)); BAR();
            { unsigned char* ws = WSP; ph_dilated((bf16*)(ws + WS_QKV1), (bf16*)(ws + WS_OG), (float*)(ws + WS_LSE)); } BAR();
            { unsigned char* ws = WSP; ph_dil_merge((bf16*)(ws + WS_OG), (float*)(ws + WS_LSE), (bf16*)(ws + WS_XN)); } BAR();
            { unsigned char* ws = WSP; float* hb = OUTP; GEMM_PHASE(EResAdd, ws + WS_XN, ws + WS_WC_OUT, DM, DM, hb, hb); } BAR();
        }
        ph_rmsnorm(OUTP, IN(4) + L * DM, (bf16*)(WSP + WS_XN)); BAR();
        { unsigned char* ws = WSP; GEMM_PHASE(EBf16, ws + WS_XN, ws + WS_WQ + (size_t)L * 4 * MiB, 2048, DM, (bf16*)(ws + WS_QRY), 2048); } BAR();
        { unsigned char* ws = WSP; ph_peer_route_opt((bf16*)(ws + WS_QRY), (bf16*)(ws + WS_SUBK) + (size_t)L * 16 * 128 * 128, (int*)(ws + WS_EIDX), (float*)(ws + WS_GW), smem); } BAR();
        { unsigned char* ws = WSP; ph_peer_gather_opt((int*)(ws + WS_EIDX), (float*)(ws + WS_GW), (bf16*)(ws + WS_EXP + (size_t)(2 * L) * 32 * MiB), (bf16*)(ws + WS_EXP + (size_t)(2 * L + 1) * 32 * MiB), OUTP, IN(5) + L * DM, (bf16*)(ws + WS_XN), smem); }
        __syncthreads();
        { unsigned char* ws = WSP; GEMM_PHASE(EBf16, ws + WS_P + (size_t)L * T * 256 * 2, ws + WS_WUP + (size_t)L * (MiB / 2), DM, 256, (bf16*)(ws + WS_UP), DM); } BAR();
        { unsigned char* ws = WSP; GEMM_PHASE(EGate, ws + WS_XN, ws + WS_WG + (size_t)L * 2 * MiB, DM, DM, OUTP, (bf16*)(ws + WS_UP)); } BAR();
    }
}

extern "C" void kernel_launch(void* const* d_in, const int* in_sizes, int n_in, void* d_out, int out_size, void* d_ws, size_t ws_size, hipStream_t stream) {
    static int grid_blocks = 0;
    if (grid_blocks == 0) {
        if (n_in != 22 || out_size != T * DM || ws_size < WS_END) { fprintf(stderr, "kernel_launch: unexpected shapes: n_in %d out %d ws %zu\n", n_in, out_size, ws_size); grid_blocks = -1; return; }
        if (hipFuncSetAttribute((const void*)k_mega, hipFuncAttributeMaxDynamicSharedMemorySize, LDS_BYTES) != hipSuccess) { fprintf(stderr, "hipFuncSetAttribute failed\n"); grid_blocks = -1; return; }
        int dev = 0, cus = 0, per_cu = 0;
        hipGetDevice(&dev);
        hipDeviceGetAttribute(&cus, hipDeviceAttributeMultiprocessorCount, dev);
        hipOccupancyMaxActiveBlocksPerMultiprocessor(&per_cu, (const void*)k_mega, NT, LDS_BYTES);
        if (per_cu < 1 || cus < 1) { fprintf(stderr, "kernel_launch: occupancy query says %d blocks/CU on %d CUs\n", per_cu, cus); grid_blocks = -1; return; }
        grid_blocks = cus;
    }
    if (grid_blocks < 0) return;
    Params P{};
    for (int i = 0; i < 22; ++i) P.in[i] = (const float*)d_in[i];
    P.out = (float*)d_out; P.ws = (unsigned char*)d_ws;
    void* args[] = {&P};
    hipError_t e = hipLaunchCooperativeKernel((const void*)k_mega, dim3(grid_blocks), dim3(NT), args, LDS_BYTES, stream);
    if (e != hipSuccess) fprintf(stderr, "cooperative launch failed: %s (grid %d)\n", hipGetErrorString(e), grid_blocks);
}
```

```cpp
#include <hip/hip_runtime.h>
#include <hip/hip_cooperative_groups.h>
#include <cstdio>
#include <cstdint>

constexpr int BATCH = 2, SEQ = 8192, T = BATCH * SEQ, DM = 1024;
constexpr int AB_N = 3396, AB_LD = 3584;
constexpr int CQA = 0, CKA = 512, CVA = 1024, CQB = 1536, CKB = 2048, CVB = 2560, CQI = 3072, CKI = 3328, CWI = 3392;
constexpr int C_LD = 3072;
constexpr int NEXP = 16384;
constexpr float NORM_EPS = 1e-6f;
constexpr float C2 = 0.125f * 1.4426950408889634f;
constexpr int NT = 512;

constexpr size_t MiB = 1u << 20;
constexpr size_t WS_CTL = 0;
constexpr size_t WS_WAB_IN = 1 * MiB, WS_WAB_OUT = 8 * MiB, WS_WC_IN = 10 * MiB, WS_WC_OUT = 16 * MiB;
constexpr size_t WS_WQ = 18 * MiB, WS_WG = 26 * MiB, WS_WUP = 30 * MiB, WS_SUBK = 31 * MiB;
constexpr size_t WS_KMEAN = 32 * MiB;
constexpr size_t WS_SEL = 33 * MiB;
constexpr size_t WS_LSE = 34 * MiB;
constexpr size_t WS_EIDX = 37 * MiB;
constexpr size_t WS_GW = 45 * MiB;
constexpr size_t WS_P = 53 * MiB;
constexpr size_t WS_XN = 69 * MiB;
constexpr size_t WS_QKV = 101 * MiB;
constexpr size_t WS_MASK = 213 * MiB;
constexpr size_t WS_SCORES = 229 * MiB;
constexpr size_t WS_EXP = 229 * MiB;
constexpr size_t WS_QRY = 101 * MiB;
constexpr size_t WS_UP = 165 * MiB;
constexpr size_t WS_QKV1 = 357 * MiB;
constexpr size_t WS_OG = 101 * MiB;
constexpr size_t WS_END = 512 * MiB;

typedef unsigned short bf16;
typedef float f32x4 __attribute__((ext_vector_type(4)));

__device__ __forceinline__ unsigned f2bf(float f) { unsigned u = __builtin_bit_cast(unsigned, f); return (u + 0x7fffu + ((u >> 16) & 1u)) >> 16; }
__device__ __forceinline__ float bf2f(bf16 h) { return __builtin_bit_cast(float, (unsigned)h << 16); }
__device__ __forceinline__ float wave_sum(float v) {
#pragma unroll
    for (int o = 1; o < 64; o <<= 1) v += __shfl_xor(v, o);
    return v;
}
__device__ __forceinline__ float wave_max(float v) {
#pragma unroll
    for (int o = 1; o < 64; o <<= 1) v = fmaxf(v, __shfl_xor(v, o));
    return v;
}
__device__ __forceinline__ unsigned okey(float f) { unsigned u = __builtin_bit_cast(unsigned, f); return (u & 0x80000000u) ? ~u : (u | 0x80000000u); }

__device__ __forceinline__ int tidx() { int t = __builtin_amdgcn_workitem_id_x(); asm volatile("" : "+v"(t)); return t; }
__device__ __forceinline__ int bidx() { int b = __builtin_amdgcn_workgroup_id_x(); asm volatile("" : "+s"(b)); return b; }
struct Params {
    const float* in[22];
    float* out;
    unsigned char* ws;
    int layer;
    int pad;
};

typedef const __attribute__((address_space(4))) unsigned long long* karg_t;
__device__ __forceinline__ unsigned long long karg(int idx) { karg_t ka = (karg_t)__builtin_amdgcn_kernarg_segment_ptr(); asm volatile("" : "+s"(ka)); return ka[idx]; }
#define GASP __attribute__((address_space(1)))
#define IN(i) ((const float*)(const GASP float*)karg(i))
#define OUTP ((float*)(GASP float*)karg(22))
#define WSP ((unsigned char*)(GASP unsigned char*)karg(23))

__device__ __forceinline__ void ph_rmsnorm(const float* src, const float* gain, bf16* dst) {
    const int lane = tidx() & 63, wave = tidx() >> 6;
    const int gw = bidx() * (NT / 64) + wave, ngw = gridDim.x * (NT / 64);
    for (int r = gw; r < T; r += ngw) {
        const f32x4* xr = (const f32x4*)(src + (size_t)r * DM) + lane;
        f32x4 v[4]; float s = 0.f;
#pragma unroll
        for (int j = 0; j < 4; ++j) { v[j] = xr[64 * j]; s += v[j].x * v[j].x + v[j].y * v[j].y + v[j].z * v[j].z + v[j].w * v[j].w; }
        const float rstd = 1.0f / sqrtf(wave_sum(s) * (1.0f / DM) + NORM_EPS);
#pragma unroll
        for (int j = 0; j < 4; ++j) {
            const f32x4 g = ((const f32x4*)gain)[lane + 64 * j];
            unsigned long long o = (unsigned long long)(f2bf(v[j].x * rstd * g.x) | (f2bf(v[j].y * rstd * g.y) << 16)) |
                                   ((unsigned long long)(f2bf(v[j].z * rstd * g.z) | (f2bf(v[j].w * rstd * g.w) << 16)) << 32);
            ((unsigned long long*)(dst + (size_t)r * DM))[lane + 64 * j] = o;
        }
    }
}

template <class AT> __device__ __forceinline__ float ldA(const AT* p);
template <> __device__ __forceinline__ float ldA<bf16>(const bf16* p) { return bf2f(*p); }
template <> __device__ __forceinline__ float ldA<float>(const float* p) { return *p; }

template <class AT, class Epi> __forceinline__
__device__ __forceinline__ void ph_gemm_naive(const AT* A, int lda, const float* B, int N, int K, const Epi& E, unsigned char* smem) {
    float* As = (float*)smem;
    float* Bs = As + 16 * 132;
    const int tid = tidx(), ty = tid >> 5, tx = tid & 31;
    const int ntn = (N + 127) / 128, ntm = T / 128, ntile = ntn * ntm;
    for (int tile = bidx(); tile < ntile; tile += gridDim.x) {
        const int tm = tile / ntn, tn = tile % ntn, m0 = tm * 128, n0 = tn * 128;
        float acc[8][4];
#pragma unroll
        for (int i = 0; i < 8; ++i)
#pragma unroll
            for (int j = 0; j < 4; ++j) acc[i][j] = 0.f;
        for (int k0 = 0; k0 < K; k0 += 16) {
            __syncthreads();
#pragma unroll
            for (int i = 0; i < 4; ++i) { const int e = tid + i * NT, r = e >> 4, kk = e & 15; As[kk * 132 + r] = ldA<AT>(A + (size_t)(m0 + r) * lda + k0 + kk); }
#pragma unroll
            for (int i = 0; i < 4; ++i) { const int e = tid + i * NT, kk = e >> 7, c = e & 127; Bs[kk * 128 + c] = (n0 + c < N) ? B[(size_t)(k0 + kk) * N + n0 + c] : 0.f; }
            __syncthreads();
#pragma unroll 2
            for (int kk = 0; kk < 16; ++kk) {
                float a[8], b[4];
#pragma unroll
                for (int i = 0; i < 8; ++i) a[i] = As[kk * 132 + ty * 8 + i];
#pragma unroll
                for (int j = 0; j < 4; ++j) b[j] = Bs[kk * 128 + tx * 4 + j];
#pragma unroll
                for (int i = 0; i < 8; ++i)
#pragma unroll
                    for (int j = 0; j < 4; ++j) acc[i][j] += a[i] * b[j];
            }
        }
#pragma unroll
        for (int i = 0; i < 8; ++i) {
            const int col = n0 + tx * 4;
            if (col < N) E.store4(m0 + ty * 8 + i, col, (f32x4){acc[i][0], acc[i][1], acc[i][2], acc[i][3]});
        }
    }
}
struct EpBf16 { bf16* O; int ldc;
    __device__ __forceinline__ void store4(int r, int c, f32x4 v) const {
        unsigned long long o = (unsigned long long)(f2bf(v.x) | (f2bf(v.y) << 16)) | ((unsigned long long)(f2bf(v.z) | (f2bf(v.w) << 16)) << 32);
        *(unsigned long long*)(O + (size_t)r * ldc + c) = o; } };
struct EpResAdd { const float* base; float* out;
    __device__ __forceinline__ void store4(int r, int c, f32x4 v) const {
        const f32x4 b = *(const f32x4*)(base + (size_t)r * DM + c); *(f32x4*)(out + (size_t)r * DM + c) = b + v; } };
struct EpGate { float* h; const bf16* up;
    __device__ __forceinline__ void store4(int r, int c, f32x4 v) const {
        f32x4 hv = *(const f32x4*)(h + (size_t)r * DM + c); const bf16* u = up + (size_t)r * DM + c;
        hv.x += bf2f(u[0]) / (1.f + __expf(-v.x)); hv.y += bf2f(u[1]) / (1.f + __expf(-v.y));
        hv.z += bf2f(u[2]) / (1.f + __expf(-v.z)); hv.w += bf2f(u[3]) / (1.f + __expf(-v.w));
        *(f32x4*)(h + (size_t)r * DM + c) = hv; } };

__device__ __forceinline__ void rope_cs(int pos, int i, float& c, float& s) {
    const float inv = exp2f(-(float)i * 0.125f * 18.931568569324174f);
    const float ang = (float)pos * inv;
    const float k = rintf(ang * 0.15915494309189535f);
    float r = fmaf(-k, 6.28125f, ang); r = fmaf(-k, 1.9353071795864769e-3f, r);
    c = cosf(r); s = sinf(r);
}
__device__ __forceinline__ void prep_head(bf16* p, const float* gain, int pos, float scale, bool donorm, int lane) {
    float v = bf2f(p[lane]);
    if (donorm) { const float ss = wave_sum(v * v); v = v * (1.0f / sqrtf(ss * (1.0f / 64.f) + NORM_EPS)) * gain[lane]; }
    const float partner = __shfl_xor(v, 8);
    float c = 1.f, s = 0.f;
    if (lane < 16) rope_cs(pos, lane & 7, c, s);
    float o = v;
    if (lane < 8) o = v * c - partner * s; else if (lane < 16) o = v * c + partner * s;
    p[lane] = (bf16)f2bf(o * scale);
}
__device__ __forceinline__ void ph_prep0(bf16* qkv, const int* positions, const float* aq, const float* ak, const float* bq, const float* bk) {
    const int lane = tidx() & 63, wave = tidx() >> 6;
    const int gw = bidx() * (NT / 64) + wave, ngw = gridDim.x * (NT / 64);
    for (int r = gw; r < T; r += ngw) {
        const int pos = positions[r]; bf16* row = qkv + (size_t)r * AB_LD;
        for (int h = 0; h < 8; ++h) {
            prep_head(row + CQA + h * 64, aq, pos, C2, true, lane);
            prep_head(row + CKA + h * 64, ak, pos, 1.f, true, lane);
            prep_head(row + CQB + h * 64, bq, pos, C2, true, lane);
            prep_head(row + CKB + h * 64, bk, pos, 1.f, true, lane);
        }
        for (int h = 0; h < 4; ++h) prep_head(row + CQI + h * 64, nullptr, pos, 1.f, false, lane);
        prep_head(row + CKI, nullptr, pos, 1.f, false, lane);
    }
}
__device__ __forceinline__ void ph_prep1(bf16* qkv, const int* positions, const float* cq, const float* ck) {
    const int lane = tidx() & 63, wave = tidx() >> 6;
    const int gw = bidx() * (NT / 64) + wave, ngw = gridDim.x * (NT / 64);
    for (int r = gw; r < T; r += ngw) {
        const int pos = positions[r]; bf16* row = qkv + (size_t)r * C_LD;
        for (int h = 0; h < 16; ++h) {
            prep_head(row + h * 64, cq, pos, C2, true, lane);
            prep_head(row + 1024 + h * 64, ck, pos, 1.f, true, lane);
        }
    }
}
__device__ __forceinline__ void ph_kmean(const bf16* qkv, float* kmean) {
    const int lane = tidx() & 63, wave = tidx() >> 6;
    const int gw = bidx() * (NT / 64) + wave, ngw = gridDim.x * (NT / 64);
    for (int it = gw; it < BATCH * 8 * 32; it += ngw) {
        const int b = it / 256, h = (it / 32) % 8, n = it % 32;
        float s = 0.f;
        for (int r = 0; r < 256; ++r) s += bf2f(qkv[(size_t)(b * SEQ + n * 256 + r) * AB_LD + CKA + h * 64 + lane]);
        kmean[(size_t)it * 64 + lane] = s * (1.0f / 256.f);
    }
}
__device__ __forceinline__ void ph_moba_select(const bf16* qkv, const float* kmean, unsigned* sel) {
    for (int it = bidx() * NT + tidx(); it < T * 8; it += gridDim.x * NT) {
        const int t = it >> 3, h = it & 7, b = t / SEQ, qblk = (t % SEQ) / 256;
        float q[64];
#pragma unroll
        for (int d = 0; d < 64; ++d) q[d] = bf2f(qkv[(size_t)t * AB_LD + CQA + h * 64 + d]);
        float v0 = -3e38f, v1 = -3e38f, v2 = -3e38f; int i0 = 255, i1 = 255, i2 = 255;
        for (int n = 0; n < qblk; ++n) {
            const float* km = kmean + (size_t)((b * 8 + h) * 32 + n) * 64; float g = 0.f;
#pragma unroll
            for (int d = 0; d < 64; ++d) g += q[d] * km[d];
            if (g > v0) { v2 = v1; i2 = i1; v1 = v0; i1 = i0; v0 = g; i0 = n; }
            else if (g > v1) { v2 = v1; i2 = i1; v1 = g; i1 = n; }
            else if (g > v2) { v2 = g; i2 = n; }
        }
        sel[it] = (unsigned)i0 | ((unsigned)i1 << 8) | ((unsigned)i2 << 16) | (255u << 24);
    }
}
__device__ __forceinline__ void ph_moba_attend(const bf16* qkv, const unsigned* sel, bf16* O, unsigned char* smem) {
    const int lane = tidx() & 63, wave = tidx() >> 6;
    float* pl = (float*)smem + wave * 1024;
    const int gw = bidx() * (NT / 64) + wave, ngw = gridDim.x * (NT / 64);
    for (int it = gw; it < T * 8; it += ngw) {
        const int t = it >> 3, h = it & 7, b = t / SEQ, tt = t % SEQ, qblk = tt / 256;
        const unsigned sw = sel[it];
        int blk[4] = {qblk, (int)(sw & 255), (int)((sw >> 8) & 255), (int)((sw >> 16) & 255)};
        const bf16* qp = qkv + (size_t)t * AB_LD + CQA + h * 64;
        float q[64];
#pragma unroll
        for (int d = 0; d < 64; ++d) q[d] = bf2f(qp[d]);
        float sc[16]; float mx = -3e38f;
#pragma unroll
        for (int s = 0; s < 4; ++s) {
#pragma unroll
            for (int i = 0; i < 4; ++i) {
                const int j = lane + 64 * i, pos = blk[s] * 256 + j;
                const bool ok = (blk[s] != 255) && (s > 0 || pos <= tt);
                float a = -3e38f;
                if (ok) { const bf16* kp = qkv + (size_t)(b * SEQ + pos) * AB_LD + CKA + h * 64; a = 0.f;
#pragma unroll
                    for (int d = 0; d < 64; ++d) a += q[d] * bf2f(kp[d]); }
                sc[s * 4 + i] = a; mx = fmaxf(mx, a);
            }
        }
        mx = wave_max(mx); float l = 0.f;
#pragma unroll
        for (int e = 0; e < 16; ++e) { const float p = (sc[e] > -1e38f) ? exp2f(sc[e] - mx) : 0.f; l += p; pl[(e >> 2) * 256 + lane + 64 * (e & 3)] = p; }
        l = wave_sum(l);
        __builtin_amdgcn_s_waitcnt(0);
        float o = 0.f;
#pragma unroll
        for (int s = 0; s < 4; ++s) {
            if (blk[s] == 255) continue;
            const int nk = (s == 0) ? (tt - qblk * 256 + 1) : 256;
            const bf16* vp = qkv + (size_t)(b * SEQ + blk[s] * 256) * AB_LD + CVA + h * 64 + lane;
            for (int j = 0; j < nk; ++j) o += pl[s * 256 + j] * bf2f(vp[(size_t)j * AB_LD]);
        }
        O[(size_t)t * DM + h * 64 + lane] = (bf16)f2bf(o / l);
    }
}
__device__ __forceinline__ void ph_dsa_select(const bf16* qkv, unsigned long long* mask, unsigned char* smem) {
    unsigned* keys = (unsigned*)smem;
    unsigned* cnt = keys + 8192;
    const int tid = tidx(), lane = tid & 63;
    for (int t = bidx(); t < T; t += gridDim.x) {
        const int b = t / SEQ, tt = t % SEQ, n = tt + 1;
        __syncthreads();
        const bf16* row = qkv + (size_t)t * AB_LD;
        float* qf = (float*)(cnt + 4);
        if (tid < 256) qf[tid] = bf2f(row[CQI + tid]);
        if (tid < 4) qf[256 + tid] = bf2f(row[CWI + tid]);
        __syncthreads();
        for (int kv = tid; kv < 8192; kv += NT) {
            unsigned key = 0u;
            if (kv < n) {
                const bf16* kp = qkv + (size_t)(b * SEQ + kv) * AB_LD + CKI;
                float a0 = 0.f, a1 = 0.f, a2 = 0.f, a3 = 0.f;
                for (int d = 0; d < 64; ++d) { const float kd = bf2f(kp[d]); a0 += qf[d] * kd; a1 += qf[64 + d] * kd; a2 += qf[128 + d] * kd; a3 += qf[192 + d] * kd; }
                const float s = ((qf[256] * fmaxf(a0, 0.f) + qf[257] * fmaxf(a1, 0.f)) + qf[258] * fmaxf(a2, 0.f)) + qf[259] * fmaxf(a3, 0.f);
                key = okey(s);
            }
            keys[kv] = key;
        }
        __syncthreads();
        unsigned thr = 0u, need = 0u;
        if (n > 256) {
            unsigned lo = 0u, hi = 0xFFFFFFFFu;
            while (lo < hi) {
                const unsigned mid = lo + ((hi - lo) >> 1) + ((hi - lo) & 1u);
                if (tid == 0) cnt[0] = 0u;
                __syncthreads();
                unsigned c = 0;
                for (int kv = tid; kv < 8192; kv += NT) c += (keys[kv] >= mid) ? 1u : 0u;
                c = (unsigned)wave_sum((float)c);
                if (lane == 0) atomicAdd(&cnt[0], c);
                __syncthreads();
                const unsigned tot = cnt[0];
                __syncthreads();
                if (tot >= 256u) lo = mid; else hi = mid - 1u;
            }
            thr = lo;
            if (tid == 0) cnt[1] = 0u;
            __syncthreads();
            unsigned c = 0;
            for (int kv = tid; kv < 8192; kv += NT) c += (keys[kv] > thr) ? 1u : 0u;
            c = (unsigned)wave_sum((float)c);
            if (lane == 0) atomicAdd(&cnt[1], c);
            __syncthreads();
            need = 256u - cnt[1];
        }
        if (tid < 64) {
            const int ntile = 4 * (tt / 256 + 1);
            unsigned taken = 0u;
            for (int j = 0; j < ntile; ++j) {
                const int kv = j * 64 + lane; const unsigned key = keys[kv];
                bool s;
                if (n <= 256) s = kv < n;
                else {
                    const bool gt = key > thr, eq = (key == thr) && (kv < n);
                    const unsigned long long em = __ballot(eq);
                    const unsigned rank = taken + (unsigned)__popcll(em & ((1ull << lane) - 1ull));
                    s = gt || (eq && rank < need);
                    taken += (unsigned)__popcll(em);
                }
                const unsigned long long m = __ballot(s);
                if (lane == 0) mask[((size_t)(b * 128 + j)) * SEQ + tt] = m;
            }
        }
    }
}
__device__ __forceinline__ void ph_dsa_attend(const bf16* qkv, const unsigned long long* mask, bf16* O, unsigned char* smem) {
    int* list = (int*)smem;
    int* cnt = list + 256;
    float* pr = (float*)(cnt + 4);
    float* linv = pr + 8 * 256;
    const int tid = tidx(), lane = tid & 63, wave = tid >> 6;
    for (int t = bidx(); t < T; t += gridDim.x) {
        const int b = t / SEQ, tt = t % SEQ;
        __syncthreads();
        const int ntile = 4 * (tt / 256 + 1);
        if (wave == 0) {
            int base = 0;
            for (int j = 0; j < ntile; ++j) {
                const unsigned long long m = mask[((size_t)(b * 128 + j)) * SEQ + tt];
                const int p = base + (int)__popcll(m & ((1ull << lane) - 1ull));
                if (((m >> lane) & 1ull) && p < 256) list[p] = j * 64 + lane;
                base += (int)__popcll(m);
            }
            if (lane == 0) cnt[0] = base;
        }
        __syncthreads();
        const int ns = min(cnt[0], 256);
        const bf16* row = qkv + (size_t)t * AB_LD;
        for (int e = tid; e < 8 * 256; e += NT) {
            const int h = e >> 8, j = e & 255; float a = -3e38f;
            if (j < ns) { const bf16* kp = qkv + (size_t)(b * SEQ + list[j]) * AB_LD + CKB + h * 64; a = 0.f;
                for (int d = 0; d < 64; ++d) a += bf2f(row[CQB + h * 64 + d]) * bf2f(kp[d]); }
            pr[e] = a;
        }
        __syncthreads();
        {
            const int h = wave; float v[4]; float mx = -3e38f;
#pragma unroll
            for (int i = 0; i < 4; ++i) { v[i] = pr[h * 256 + lane + 64 * i]; mx = fmaxf(mx, v[i]); }
            mx = wave_max(mx); float l = 0.f;
#pragma unroll
            for (int i = 0; i < 4; ++i) { const float p = (v[i] > -1e38f) ? exp2f(v[i] - mx) : 0.f; l += p; pr[h * 256 + lane + 64 * i] = p; }
            l = wave_sum(l); if (lane == 0) linv[h] = 1.0f / l;
        }
        __syncthreads();
        {   const int h = tid >> 6, d = tid & 63; float o = 0.f;
            for (int j = 0; j < ns; ++j) o += pr[h * 256 + j] * bf2f(qkv[(size_t)(b * SEQ + list[j]) * AB_LD + CVB + h * 64 + d]);
            O[(size_t)t * DM + 512 + h * 64 + d] = (bf16)f2bf(o * linv[h]); }
    }
}
__device__ __forceinline__ void ph_dilated(const bf16* qkv, bf16* OG, float* LSE) {
    const int lane = tidx() & 63, wave = tidx() >> 6;
    const int gw = bidx() * (NT / 64) + wave, ngw = gridDim.x * (NT / 64);
    for (int it = gw; it < T * 16; it += ngw) {
        const int t = it >> 4, h = it & 15, b = t / SEQ, tt = t % SEQ;
        const bf16* qp = qkv + (size_t)t * C_LD + h * 64;
        float q[64];
#pragma unroll
        for (int d = 0; d < 64; ++d) q[d] = bf2f(qp[d]);
        for (int g = 0; g < 3; ++g) {
            const int dil = (g == 0) ? 1 : (g == 1 ? 4 : 16);
            float sc[3]; float mx = -3e38f;
#pragma unroll
            for (int i = 0; i < 3; ++i) {
                const int j = lane + 64 * i, pos = tt - j * dil; float a = -3e38f;
                if (j <= 128 && pos >= 0) { const bf16* kp = qkv + (size_t)(b * SEQ + pos) * C_LD + 1024 + h * 64; a = 0.f;
#pragma unroll
                    for (int d = 0; d < 64; ++d) a += q[d] * bf2f(kp[d]); }
                sc[i] = a; mx = fmaxf(mx, a);
            }
            mx = wave_max(mx); float l = 0.f; float p[3];
#pragma unroll
            for (int i = 0; i < 3; ++i) { p[i] = (sc[i] > -1e38f) ? exp2f(sc[i] - mx) : 0.f; l += p[i]; }
            l = wave_sum(l);
            float o = 0.f;
            for (int j = 0; j <= 128; ++j) {
                const int pos = tt - j * dil; if (pos < 0) break;
                const float pj = (j < 64) ? __shfl(p[0], j) : ((j < 128) ? __shfl(p[1], j - 64) : __shfl(p[2], 0));
                o += pj * bf2f(qkv[(size_t)(b * SEQ + pos) * C_LD + 2048 + h * 64 + lane]);
            }
            OG[((size_t)g * T + t) * DM + h * 64 + lane] = (bf16)f2bf(o / l);
            if (lane == 0) LSE[((size_t)g * T + t) * 16 + h] = mx + log2f(l);
        }
    }
}
__device__ __forceinline__ void ph_dil_merge(const bf16* OG, const float* LSE, bf16* O) {
    for (size_t e = (size_t)bidx() * NT + tidx(); e < (size_t)T * DM; e += (size_t)gridDim.x * NT) {
        const int t = (int)(e >> 10), c = (int)(e & 1023), h = c >> 6;
        const float l0 = LSE[((size_t)0 * T + t) * 16 + h], l1 = LSE[((size_t)1 * T + t) * 16 + h], l2 = LSE[((size_t)2 * T + t) * 16 + h];
        const float m = fmaxf(l0, fmaxf(l1, l2)); const float w0 = exp2f(l0 - m), w1 = exp2f(l1 - m), w2 = exp2f(l2 - m);
        const float o = (w0 * bf2f(OG[e]) + w1 * bf2f(OG[(size_t)T * DM + e]) + w2 * bf2f(OG[(size_t)2 * T * DM + e])) / (w0 + w1 + w2);
        O[e] = (bf16)f2bf(o);
    }
}
__device__ __forceinline__ void ph_peer_route(const bf16* qry, const float* subk, int* eidx, float* gw, unsigned char* smem) {
    float* s = (float*)smem;
    float* sv = s + 2048;
    int* si = (int*)(sv + 256);
    float* qf = (float*)(si + 256);
    const int tid = tidx(), lane = tid & 63, wave = tid >> 6;
    for (int t = bidx(); t < T; t += gridDim.x) {
        __syncthreads();
        for (int e = tid; e < 2048; e += NT) qf[e] = bf2f(qry[(size_t)t * 2048 + e]);
        __syncthreads();
        for (int e = tid; e < 2048; e += NT) {
            const int hc = e >> 7, k = e & 127; const float* kp = subk + ((size_t)hc * 128 + k) * 128; float a = 0.f;
            for (int d = 0; d < 128; ++d) a += qf[hc * 128 + d] * kp[d];
            s[e] = a;
        }
        __syncthreads();
        for (int hc = wave; hc < 16; hc += NT / 64) {
            float v0 = s[hc * 128 + lane], v1 = s[hc * 128 + 64 + lane];
            for (int r = 0; r < 16; ++r) {
                float bv = v0; int bi = lane;
                if (v1 > bv) { bv = v1; bi = lane + 64; }
#pragma unroll
                for (int o = 1; o < 64; o <<= 1) { const float ov = __shfl_xor(bv, o); const int oi = __shfl_xor(bi, o); if (ov > bv || (ov == bv && oi < bi)) { bv = ov; bi = oi; } }
                if (lane == 0) { sv[hc * 16 + r] = bv; si[hc * 16 + r] = bi; }
                if (bi == lane) v0 = -3e38f; if (bi == lane + 64) v1 = -3e38f;
            }
        }
        __syncthreads();
        {   const int h = wave;
            float c[4]; int ci[4];
#pragma unroll
            for (int i = 0; i < 4; ++i) { const int f = lane + 64 * i; c[i] = sv[(h * 2) * 16 + (f >> 4)] + sv[(h * 2 + 1) * 16 + (f & 15)]; ci[i] = f; }
            float cv[16]; int cf[16];
#pragma unroll
            for (int r = 0; r < 16; ++r) {
                float bv = c[0]; int bi = ci[0];
#pragma unroll
                for (int i = 1; i < 4; ++i) if (c[i] > bv) { bv = c[i]; bi = ci[i]; }
#pragma unroll
                for (int o = 1; o < 64; o <<= 1) { const float ov = __shfl_xor(bv, o); const int oi = __shfl_xor(bi, o); if (ov > bv || (ov == bv && oi < bi)) { bv = ov; bi = oi; } }
                cv[r] = bv; cf[r] = bi;
#pragma unroll
                for (int i = 0; i < 4; ++i) if (ci[i] == bi) c[i] = -3e38f;
            }
            float l = 0.f;
#pragma unroll
            for (int r = 0; r < 16; ++r) l += __expf(cv[r] - cv[0]);
            if (lane < 16) {
                float myv = 0.f; int myf = 0;
#pragma unroll
                for (int r = 0; r < 16; ++r) if (r == lane) { myv = cv[r]; myf = cf[r]; }
                eidx[(size_t)t * 128 + h * 16 + lane] = si[(h * 2) * 16 + (myf >> 4)] * 128 + si[(h * 2 + 1) * 16 + (myf & 15)];
                gw[(size_t)t * 128 + h * 16 + lane] = __expf(myv - cv[0]) / l;
            }
        }
    }
}
__device__ __forceinline__ float gelu_tanh(float x) { const float u = 0.7978845608028654f * (x + 0.044715f * x * x * x); return 0.5f * x * (1.f + tanhf(u)); }
__device__ __forceinline__ void ph_peer_gather(const bf16* xn, const int* eidx, const float* gw, const float* U, const float* V, float* h, unsigned char* smem) {
    float* xf = (float*)smem;
    float* w = xf + 1024;
    int* ei = (int*)(w + 128);
    const int tid = tidx(), lane = tid & 63, wave = tid >> 6;
    for (int t = bidx(); t < T; t += gridDim.x) {
        __syncthreads();
        for (int e = tid; e < 1024; e += NT) xf[e] = bf2f(xn[(size_t)t * DM + e]);
        if (tid < 128) ei[tid] = eidx[(size_t)t * 128 + tid];
        __syncthreads();
        for (int e = wave; e < 128; e += NT / 64) {
            const float* up = U + (size_t)ei[e] * DM; float a = 0.f;
            for (int d = lane; d < 1024; d += 64) a += xf[d] * up[d];
            a = wave_sum(a);
            if (lane == 0) w[e] = gw[(size_t)t * 128 + e] * gelu_tanh(a);
        }
        __syncthreads();
        for (int d = tid; d < 1024; d += NT) {
            float o = 0.f;
            for (int e = 0; e < 128; ++e) o += w[e] * V[(size_t)ei[e] * DM + d];
            h[(size_t)t * DM + d] += o;
        }
    }
}

namespace pg8 {
#define PG8_LAS __attribute__((address_space(3)))
typedef unsigned short bf16_t;
typedef short bf16x8 __attribute__((ext_vector_type(8)));
typedef float f32x4 __attribute__((ext_vector_type(4)));
typedef unsigned u32x4 __attribute__((ext_vector_type(4)));
constexpr int BM = 256, BK = 64, HALF = 128, HTB = HALF * BK * 2  , STAGE_BYTES = 8 * HTB, NXCD = 8, WGM = 8;

__host__ __device__ __forceinline__ int lds_byte(int r, int c) { const int st = (r >> 4) * 2 + (c >> 5), rr = r & 15, cc = c & 31, ob = rr * 64 + cc * 2; return st * 1024 + (ob ^ (((ob >> 9) & 1) << 5)); }
__host__ __device__ __forceinline__ void stage_rc(int b, int& R, int& C) { const int st = b / 1024, sb = b % 1024, swz = sb ^ (((sb >> 9) & 1) << 5); R = (st >> 1) * 16 + swz / 64; C = (st & 1) * 32 + (swz % 64) / 2; }
__host__ __device__ __forceinline__ int perm32(int rho) { const int n = rho >> 4, i = rho & 15; return 8 * (i >> 2) + 4 * n + (i & 3); }

struct Unit { int pm, pn; };
struct Gemm { const bf16_t* A; const bf16_t* Bt; int M, N, K; };

struct StaticOrder {
    int nM, nN, nwg, G, c;
    __host__ __device__ void init(int M, int N, int G_, int c_) { nM = M / BM; nN = N / BM; nwg = nM * nN; G = G_; c = c_; }
    __host__ __device__ bool next(int i, Unit& u) const {
        const long L = (long)i * G + c; if (L >= nwg) return false;
        int wgid = (int)L; { const int q = nwg / NXCD, r = nwg % NXCD, xcd = wgid % NXCD, off = wgid / NXCD; wgid = (xcd < r ? xcd * (q + 1) : r * (q + 1) + (xcd - r) * q) + off; }
        const int nig = WGM * nN, gid = wgid / nig, fm = gid * WGM, gsz = (nM - fm) < WGM ? (nM - fm) : WGM;
        u.pm = fm + ((wgid % nig) % gsz); u.pn = (wgid % nig) / gsz; return true;
    }
    __device__ __forceinline__ void a_ready(const Unit&) const {}
    __device__ __forceinline__ void done(const Unit&) const {}
};


__device__ __forceinline__ unsigned pk_bf16(float lo, float hi) { typedef float f2 __attribute__((ext_vector_type(2))); typedef __bf16 b2 __attribute__((ext_vector_type(2))); f2 v = {lo, hi}; b2 b = __builtin_convertvector(v, b2); return __builtin_bit_cast(unsigned, b); }
struct EBf16 {
    static constexpr bool PERM = true, AFTER_DRAIN = false; bf16_t* O; int ldc;
    __device__ __forceinline__ void operator()(const f32x4 (&acc)[2][2][4][2], const Unit& u, int wr, int wc, int fr, int fq) const {
        const int row0 = u.pm * BM + wr * 64 + fr, col0 = u.pn * BM + wc * 32 + 8 * fq;
#pragma unroll
        for (int ai = 0; ai < 2; ++ai)
#pragma unroll
            for (int m = 0; m < 4; ++m) { bf16_t* rowp = O + (size_t)(row0 + ai * HALF + m * 16) * ldc + col0;
#pragma unroll
                for (int bj = 0; bj < 2; ++bj) { const f32x4 v0 = acc[ai][bj][m][0], v1 = acc[ai][bj][m][1];
                    u32x4 w; w.x = pk_bf16(v0[0], v0[1]); w.y = pk_bf16(v0[2], v0[3]); w.z = pk_bf16(v1[0], v1[1]); w.w = pk_bf16(v1[2], v1[3]);
                    *(u32x4*)(rowp + bj * HALF) = w; } }
    }
};
struct EResAdd {
    static constexpr bool PERM = false, AFTER_DRAIN = false; const float* base; float* out;
    __device__ __forceinline__ void operator()(const f32x4 (&acc)[2][2][4][2], const Unit& u, int wr, int wc, int fr, int fq) const {
        const int col0 = u.pn * BM + wc * 32 + 4 * fq;
#pragma unroll
        for (int ai = 0; ai < 2; ++ai)
#pragma unroll
            for (int m = 0; m < 4; ++m) { const size_t off = (size_t)(u.pm * BM + ai * HALF + wr * 64 + m * 16 + fr) * 1024 + col0;
#pragma unroll
                for (int bj = 0; bj < 2; ++bj)
#pragma unroll
                    for (int n = 0; n < 2; ++n) { const f32x4 b = *(const f32x4*)(base + off + bj * HALF + n * 16); *(f32x4*)(out + off + bj * HALF + n * 16) = b + acc[ai][bj][m][n]; } }
    }
};
struct EGate {
    static constexpr bool PERM = false, AFTER_DRAIN = false; float* h; const bf16_t* up;
    __device__ __forceinline__ void operator()(const f32x4 (&acc)[2][2][4][2], const Unit& u, int wr, int wc, int fr, int fq) const {
        const int col0 = u.pn * BM + wc * 32 + 4 * fq;
#pragma unroll
        for (int ai = 0; ai < 2; ++ai)
#pragma unroll
            for (int m = 0; m < 4; ++m) { const size_t off = (size_t)(u.pm * BM + ai * HALF + wr * 64 + m * 16 + fr) * 1024 + col0;
#pragma unroll
                for (int bj = 0; bj < 2; ++bj)
#pragma unroll
                    for (int n = 0; n < 2; ++n) { const size_t o = off + bj * HALF + n * 16; f32x4 hv = *(const f32x4*)(h + o);
                        const unsigned long long uu = *(const unsigned long long*)(up + o); const f32x4 a = acc[ai][bj][m][n];
                        hv[0] += __builtin_bit_cast(float, (unsigned)(uu << 16)) / (1.f + __expf(-a[0]));
                        hv[1] += __builtin_bit_cast(float, (unsigned)(uu & 0xffff0000ull)) / (1.f + __expf(-a[1]));
                        hv[2] += __builtin_bit_cast(float, (unsigned)((uu >> 16) & 0xffff0000ull)) / (1.f + __expf(-a[2]));
                        hv[3] += __builtin_bit_cast(float, (unsigned)((uu >> 32) & 0xffff0000ull)) / (1.f + __expf(-a[3]));
                        *(f32x4*)(h + o) = hv; } }
    }
};
template <class Epi, class Sched, bool ALIGN_EPI = false, bool SP2 = false>
__device__ __forceinline__ void gemm_phase(PG8_LAS unsigned char* lds, const Gemm g, const Sched& S, const Epi& E) {
    const int tid = tidx(), wid = __builtin_amdgcn_readfirstlane(tid >> 6), lane = tid & 63, wr = wid >> 2, wc = wid & 3, fr = lane & 15, fq = lane >> 4;
    const int K = g.K, nt = K / BK;
    unsigned voffA[2], voffB[2];
#pragma unroll
    for (int i = 0; i < 2; ++i) { int R, C; stage_rc(tid * 16 + i * 8192, R, C); const int Rb = Epi::PERM ? ((R & ~31) + perm32(R & 31)) : R;
        voffA[i] = (unsigned)(R * K + C) * 2u; voffB[i] = (unsigned)(Rb * K + C) * 2u; }
    const size_t kstep = (size_t)(BK * 2);
    const size_t hstep = (size_t)HALF * K * 2;
    const size_t tstep = 2 * hstep;
    const unsigned ldsw = (unsigned)wid * 1024u;
    const int aoff = lds_byte(wr * 64 + fr, fq * 8), boff = lds_byte(wc * 32 + fr, fq * 8);
#define PG8_SA(b, h) (((b) * 2 + (h)) * HTB)
#define PG8_SB(b, h) ((4 + (b) * 2 + (h)) * HTB)
#define PG8_STAGE(bufoff, gbase, voff) do { _Pragma("unroll") for (int _i = 0; _i < 2; ++_i) \
        __builtin_amdgcn_global_load_lds((const unsigned*)((const char*)(gbase) + (voff)[_i]), (PG8_LAS unsigned*)(lds + (bufoff) + ldsw + _i * 8192), 16, 0, 0); } while (0)
#define PG8_LDA(dst, b, h) do { _Pragma("unroll") for (int m = 0; m < 4; ++m) _Pragma("unroll") for (int k = 0; k < 2; ++k) dst[m][k] = *(const PG8_LAS bf16x8*)(lds + PG8_SA(b, h) + aoff + m * 2048 + k * 1024); } while (0)
#define PG8_LDB(dst, b, h) do { _Pragma("unroll") for (int n = 0; n < 2; ++n) _Pragma("unroll") for (int k = 0; k < 2; ++k) dst[n][k] = *(const PG8_LAS bf16x8*)(lds + PG8_SB(b, h) + boff + n * 2048 + k * 1024); } while (0)
#define PG8_MMA(ai, bj, At, Bt) do { __builtin_amdgcn_s_setprio(1); _Pragma("unroll") for (int m = 0; m < 4; ++m) _Pragma("unroll") for (int n = 0; n < 2; ++n) _Pragma("unroll") for (int k = 0; k < 2; ++k) \
        acc[ai][bj][m][n] = __builtin_amdgcn_mfma_f32_16x16x32_bf16(Bt[n][k], At[m][k], acc[ai][bj][m][n], 0, 0, 0); __builtin_amdgcn_s_setprio(0); } while (0)
#define PG8_WAIT_V(n) asm volatile("s_waitcnt vmcnt(" #n ")" ::: "memory")
#define PG8_WAIT_L(n) asm volatile("s_waitcnt lgkmcnt(" #n ")" ::: "memory")
#define PG8_BAR __builtin_amdgcn_s_barrier()
#define PG8_SCHED __builtin_amdgcn_sched_barrier(0)
    Unit cur, nxt; int ui = 0;
    if (!S.next(0, cur)) return;
    f32x4 acc[2][2][4][2];
#pragma unroll
    for (int a = 0; a < 2; ++a)
#pragma unroll
        for (int b = 0; b < 2; ++b)
#pragma unroll
            for (int m = 0; m < 4; ++m)
#pragma unroll
                for (int n = 0; n < 2; ++n) acc[a][b][m][n] = (f32x4){0.f, 0.f, 0.f, 0.f};
    bf16x8 At[4][2], B0[2][2], B1[2][2];
    const char* cA = (const char*)g.A + (size_t)cur.pm * tstep; const char* cB = (const char*)g.Bt + (size_t)cur.pn * tstep;
    S.a_ready(cur);
    if constexpr (SP2) {
        PG8_STAGE(PG8_SB(0, 0), cB, voffB); PG8_STAGE(PG8_SB(0, 1), cB + hstep, voffB); PG8_STAGE(PG8_SA(0, 0), cA, voffA); PG8_STAGE(PG8_SA(0, 1), cA + hstep, voffA);
        if (wr == 1) PG8_BAR;
        PG8_WAIT_V(2); PG8_BAR;
        PG8_STAGE(PG8_SB(1, 0), cB + kstep, voffB); PG8_STAGE(PG8_SA(1, 0), cA + kstep, voffA); PG8_STAGE(PG8_SB(1, 1), cB + hstep + kstep, voffB);
        PG8_WAIT_V(6); PG8_BAR;
    } else {
        PG8_STAGE(PG8_SB(0, 0), cB, voffB); PG8_STAGE(PG8_SA(0, 0), cA, voffA); PG8_STAGE(PG8_SB(0, 1), cB + hstep, voffB); PG8_STAGE(PG8_SA(0, 1), cA + hstep, voffA);
        if (wr == 1) PG8_BAR;
        PG8_WAIT_V(4); PG8_BAR;
        PG8_STAGE(PG8_SB(1, 0), cB + kstep, voffB); PG8_STAGE(PG8_SA(1, 0), cA + kstep, voffA); PG8_STAGE(PG8_SB(1, 1), cB + hstep + kstep, voffB);
        PG8_WAIT_V(6); PG8_BAR;
    }
    for (;;) {
        const bool has_next = S.next(ui + 1, nxt);
        const char* nA = has_next ? (const char*)g.A + (size_t)nxt.pm * tstep : cA; const char* nB = has_next ? (const char*)g.Bt + (size_t)nxt.pn * tstep : cB;
        for (int t = 0; t < nt; t += 2) {
            const bool last = (t == nt - 2);
            const char* a1 = cA + (size_t)(t + 1) * kstep;
            const char* a2 = last ? nA : cA + (size_t)(t + 2) * kstep; const char* b2 = last ? nB : cB + (size_t)(t + 2) * kstep;
            const char* a3 = a2 + kstep; const char* b3 = b2 + kstep;
            if (last && has_next) S.a_ready(nxt);
            if constexpr (SP2) {
            PG8_LDB(B0, 0, 0); PG8_LDB(B1, 0, 1); PG8_SCHED; PG8_LDA(At, 0, 0); PG8_STAGE(PG8_SA(1, 1), a1 + hstep, voffA);
            PG8_WAIT_V(8); PG8_WAIT_L(0); PG8_BAR; PG8_MMA(0, 0, At, B0); PG8_MMA(0, 1, At, B1); PG8_BAR; PG8_SCHED;
            PG8_LDA(At, 0, 1); PG8_STAGE(PG8_SB(0, 0), b2, voffB); PG8_STAGE(PG8_SB(0, 1), b2 + hstep, voffB); PG8_STAGE(PG8_SA(0, 0), a2, voffA);
            PG8_WAIT_V(8); PG8_WAIT_L(0); PG8_BAR; PG8_MMA(1, 0, At, B0); PG8_MMA(1, 1, At, B1); PG8_BAR; PG8_SCHED;
            PG8_LDB(B0, 1, 0); PG8_LDB(B1, 1, 1); PG8_SCHED; PG8_LDA(At, 1, 0); PG8_STAGE(PG8_SA(0, 1), a2 + hstep, voffA);
            PG8_WAIT_V(8); PG8_WAIT_L(0); PG8_BAR; PG8_MMA(0, 0, At, B0); PG8_MMA(0, 1, At, B1); PG8_BAR; PG8_SCHED;
            PG8_LDA(At, 1, 1); PG8_STAGE(PG8_SB(1, 0), b3, voffB); PG8_STAGE(PG8_SB(1, 1), b3 + hstep, voffB); PG8_STAGE(PG8_SA(1, 0), a3, voffA);
            PG8_WAIT_V(8); PG8_WAIT_L(0); PG8_BAR; PG8_MMA(1, 0, At, B0); PG8_MMA(1, 1, At, B1); PG8_BAR; PG8_SCHED;
            } else {
            PG8_LDB(B0, 0, 0); PG8_SCHED; PG8_LDA(At, 0, 0); PG8_STAGE(PG8_SA(1, 1), a1 + hstep, voffA);
            PG8_WAIT_L(8); PG8_BAR; PG8_WAIT_L(0); PG8_MMA(0, 0, At, B0); PG8_BAR; PG8_SCHED;
            PG8_LDB(B1, 0, 1); PG8_STAGE(PG8_SB(0, 0), b2, voffB);
            PG8_BAR; PG8_WAIT_L(0); PG8_MMA(0, 1, At, B1); PG8_BAR;
            PG8_LDA(At, 0, 1); PG8_STAGE(PG8_SA(0, 0), a2, voffA);
            PG8_BAR; PG8_WAIT_L(0); PG8_MMA(1, 0, At, B0); PG8_BAR; PG8_SCHED;
            PG8_STAGE(PG8_SB(0, 1), b2 + hstep, voffB);
            PG8_WAIT_V(6); PG8_BAR; PG8_MMA(1, 1, At, B1); PG8_BAR;
            PG8_LDB(B0, 1, 0); PG8_SCHED; PG8_LDA(At, 1, 0); PG8_STAGE(PG8_SA(0, 1), a2 + hstep, voffA);
            PG8_WAIT_L(8); PG8_BAR; PG8_WAIT_L(0); PG8_MMA(0, 0, At, B0); PG8_BAR; PG8_SCHED;
            PG8_LDB(B1, 1, 1); PG8_STAGE(PG8_SB(1, 0), b3, voffB);
            PG8_BAR; PG8_WAIT_L(0); PG8_MMA(0, 1, At, B1); PG8_BAR;
            PG8_LDA(At, 1, 1); PG8_STAGE(PG8_SA(1, 0), a3, voffA);
            PG8_BAR; PG8_WAIT_L(0); PG8_MMA(1, 0, At, B0); PG8_BAR; PG8_SCHED;
            PG8_STAGE(PG8_SB(1, 1), b3 + hstep, voffB);
            PG8_WAIT_V(6); PG8_BAR; PG8_MMA(1, 1, At, B1); PG8_BAR;
            }
        }
        if constexpr (ALIGN_EPI) { if (wr == 0) PG8_BAR; }
        if constexpr (!Epi::AFTER_DRAIN) { E(acc, cur, wr, wc, fr, fq); S.done(cur); }
        if (!has_next) break;
#pragma unroll
        for (int a = 0; a < 2; ++a)
#pragma unroll
            for (int b = 0; b < 2; ++b)
#pragma unroll
                for (int m = 0; m < 4; ++m)
#pragma unroll
                    for (int n = 0; n < 2; ++n) acc[a][b][m][n] = (f32x4){0.f, 0.f, 0.f, 0.f};
        cur = nxt; cA = nA; cB = nB; ++ui;
        if constexpr (ALIGN_EPI) { if (wr == 1) PG8_BAR; }
    }
    PG8_WAIT_V(0);
    if constexpr (!ALIGN_EPI) { if (wr == 0) PG8_BAR; }
    PG8_BAR;
    if constexpr (Epi::AFTER_DRAIN) { E.fused(acc, cur, wr, wc, fr, fq, lds, wid, lane); S.done(cur); }
#undef PG8_SA
#undef PG8_SB
#undef PG8_STAGE
#undef PG8_LDA
#undef PG8_LDB
#undef PG8_MMA
#undef PG8_WAIT_V
#undef PG8_WAIT_L
#undef PG8_BAR
#undef PG8_SCHED
}
}

#define LAS __attribute__((address_space(3)))
typedef unsigned v4u __attribute__((ext_vector_type(4)));
__device__ __forceinline__ unsigned pk2(float lo, float hi) { return f2bf(lo) | (f2bf(hi) << 16); }
__device__ __forceinline__ void transpose_item(const float* W, int K, int N, bf16* WT, float* scr, int item, int nblk, int lane) {
    const int kb = item / nblk, nb = item % nblk, k0 = 64 * kb, n0 = 32 * nb;
    const int nn = n0 + (lane & 31);
#pragma unroll 8
    for (int i = 0; i < 32; ++i) { const int kk = 2 * i + (lane >> 5); scr[kk * 33 + (lane & 31)] = (nn < N) ? W[(size_t)(k0 + kk) * N + nn] : 0.f; }
    __builtin_amdgcn_s_waitcnt(0xc07f); asm volatile("" ::: "memory");
    const int c = lane & 7;
#pragma unroll
    for (int j = 0; j < 4; ++j) { const int n = (lane >> 3) + 8 * j; const float* sp = scr + (8 * c) * 33 + n;
        v4u o; o.x = pk2(sp[0 * 33], sp[1 * 33]); o.y = pk2(sp[2 * 33], sp[3 * 33]); o.z = pk2(sp[4 * 33], sp[5 * 33]); o.w = pk2(sp[6 * 33], sp[7 * 33]);
        *(v4u*)(WT + (size_t)(n0 + n) * K + k0 + 8 * c) = o; }
    __builtin_amdgcn_s_waitcnt(0xc07f); asm volatile("" ::: "memory");
}
__device__ __forceinline__ void cvt_bf16(const float* src, bf16* dst, size_t n) {
    for (size_t e = ((size_t)bidx() * NT + tidx()) * 8; e < n; e += (size_t)gridDim.x * NT * 8) {
        const f32x4 a = *(const f32x4*)(src + e), b = *(const f32x4*)(src + e + 4);
        v4u o; o.x = pk2(a.x, a.y); o.y = pk2(a.z, a.w); o.z = pk2(b.x, b.y); o.w = pk2(b.z, b.w);
        *(v4u*)(dst + e) = o; }
}
__device__ __forceinline__ void transpose_matrix(const float* W, int K, int N, int Npad, bf16* WT, float* scr, int gw, int ngw, int lane) {
    const int nblk = Npad / 32, nit = (K / 64) * nblk;
    for (int it = gw; it < nit; it += ngw) transpose_item(W, K, N, WT, scr, it, nblk, lane);
}
__device__ __forceinline__ void ph_prologue(unsigned char* smem) {
    const int lane = tidx() & 63, wave = tidx() >> 6;
    float* scr = (float*)smem + wave * (64 * 33);
    const int gw = bidx() * (NT / 64) + wave, ngw = gridDim.x * (NT / 64);
    unsigned char* ws = WSP;
    transpose_matrix(IN(6), 1024, AB_N, AB_LD, (bf16*)(ws + WS_WAB_IN), scr, gw, ngw, lane);
    transpose_matrix(IN(7), 1024, 1024, 1024, (bf16*)(ws + WS_WAB_OUT), scr, gw, ngw, lane);
    transpose_matrix(IN(12), 1024, 3072, 3072, (bf16*)(ws + WS_WC_IN), scr, gw, ngw, lane);
    transpose_matrix(IN(13), 1024, 1024, 1024, (bf16*)(ws + WS_WC_OUT), scr, gw, ngw, lane);
#pragma unroll 1
    for (int L = 0; L < 2; ++L) {
        transpose_matrix(IN(16) + (size_t)L * DM * 2048, 1024, 2048, 2048, (bf16*)(ws + WS_WQ + (size_t)L * 4 * MiB), scr, gw, ngw, lane);
        transpose_matrix(IN(20) + (size_t)L * DM * DM, 1024, 1024, 1024, (bf16*)(ws + WS_WG + (size_t)L * 2 * MiB), scr, gw, ngw, lane);
        transpose_matrix(IN(21) + (size_t)L * 256 * DM, 256, 1024, 1024, (bf16*)(ws + WS_WUP + (size_t)L * (MiB / 2)), scr, gw, ngw, lane);
    }
    cvt_bf16(IN(1), (bf16*)(ws + WS_P), (size_t)2 * T * 256);
    cvt_bf16(IN(17), (bf16*)(ws + WS_SUBK), (size_t)2 * 16 * 128 * 128);
#pragma unroll 1
    for (int L = 0; L < 2; ++L) {
        cvt_bf16(IN(18) + (size_t)L * NEXP * DM, (bf16*)(ws + WS_EXP + (size_t)(2 * L) * 32 * MiB), (size_t)NEXP * DM);
        cvt_bf16(IN(19) + (size_t)L * NEXP * DM, (bf16*)(ws + WS_EXP + (size_t)(2 * L + 1) * 32 * MiB), (size_t)NEXP * DM);
    }
}


typedef __bf16 bf2_t __attribute__((ext_vector_type(2)));
typedef unsigned u32x4g __attribute__((ext_vector_type(4)));
__device__ __forceinline__ float dot2u(unsigned a, unsigned b, float c) { return __builtin_amdgcn_fdot2_f32_bf16(__builtin_bit_cast(bf2_t, a), __builtin_bit_cast(bf2_t, b), c, false); }
__device__ __forceinline__ float dot8(u32x4g a, u32x4g b, float c) {
    c = dot2u(a[0], b[0], c); c = dot2u(a[1], b[1], c); c = dot2u(a[2], b[2], c); c = dot2u(a[3], b[3], c);
    return c;
}
__device__ __forceinline__ float bflo(unsigned d) { return __builtin_bit_cast(float, d << 16); }
__device__ __forceinline__ float bfhi(unsigned d) { return __builtin_bit_cast(float, d & 0xffff0000u); }
#define GATHER_U8(EREG, B) do { float s_[8]; \
    _Pragma("unroll") for (int k = 0; k < 8; ++k) { const int idx = __builtin_amdgcn_readlane(EREG, ((B) * 8 + k) & 63); \
        const u32x4g* up = (const u32x4g*)(U + (size_t)idx * DM); const u32x4g u0 = up[lane], u1 = up[64 + lane]; s_[k] = dot8(x1, u1, dot8(x0, u0, 0.f)); } \
    float r_[4]; const bool b5 = lane & 32, b4 = lane & 16, b3 = lane & 8; \
    _Pragma("unroll") for (int i = 0; i < 4; ++i) { const float snd = b5 ? s_[i] : s_[4 + i], kp = b5 ? s_[4 + i] : s_[i]; r_[i] = kp + __shfl_xor(snd, 32); } \
    float q_[2]; \
    _Pragma("unroll") for (int i = 0; i < 2; ++i) { const float snd = b4 ? r_[i] : r_[2 + i], kp = b4 ? r_[2 + i] : r_[i]; q_[i] = kp + __shfl_xor(snd, 16); } \
    float p_; { const float snd = b3 ? q_[0] : q_[1], kp = b3 ? q_[1] : q_[0]; p_ = kp + __shfl_xor(snd, 8); } \
    p_ += __shfl_xor(p_, 4); p_ += __shfl_xor(p_, 2); p_ += __shfl_xor(p_, 1); \
    if ((lane & 7) == 0) al[(B) * 8 + (lane >> 3)] = p_; } while (0)
#define GATHER_V8(EREG, WREG, B) do { \
    _Pragma("unroll") for (int k = 0; k < 8; ++k) { const int idx = __builtin_amdgcn_readlane(EREG, ((B) * 8 + k) & 63); \
        const float w = __builtin_bit_cast(float, __builtin_amdgcn_readlane(__builtin_bit_cast(int, WREG), ((B) * 8 + k) & 63)); \
        const u32x4g* vp = (const u32x4g*)(V + (size_t)idx * DM); const u32x4g v0 = vp[lane], v1 = vp[64 + lane]; \
        acc[0] += w * bflo(v0.x); acc[1] += w * bfhi(v0.x); acc[2] += w * bflo(v0.y); acc[3] += w * bfhi(v0.y); \
        acc[4] += w * bflo(v0.z); acc[5] += w * bfhi(v0.z); acc[6] += w * bflo(v0.w); acc[7] += w * bfhi(v0.w); \
        acc[8] += w * bflo(v1.x); acc[9] += w * bfhi(v1.x); acc[10] += w * bflo(v1.y); acc[11] += w * bfhi(v1.y); \
        acc[12] += w * bflo(v1.z); acc[13] += w * bfhi(v1.z); acc[14] += w * bflo(v1.w); acc[15] += w * bfhi(v1.w); } } while (0)
__device__ __forceinline__ void ph_peer_gather_opt(const int* eidx, const float* gw, const bf16* U, const bf16* V, float* h, const float* gain_next, bf16* XN, unsigned char* smem) {
    const int tid = tidx(), lane = tid & 63, wave = tid >> 6;
    float* al = (float*)smem + wave * 128;
    const int gwv = bidx() * (NT / 64) + wave, ngw = gridDim.x * (NT / 64);
    for (int t = gwv; t < T; t += ngw) {
        const u32x4g x0 = *(const u32x4g*)(XN + (size_t)t * DM + 8 * lane), x1 = *(const u32x4g*)(XN + (size_t)t * DM + 512 + 8 * lane);
        const int e0 = eidx[(size_t)t * 128 + lane], e1 = eidx[(size_t)t * 128 + 64 + lane];
        const float g0 = gw[(size_t)t * 128 + lane], g1 = gw[(size_t)t * 128 + 64 + lane];
#pragma unroll 1
        for (int b = 0; b < 8; ++b) GATHER_U8(e0, b);
#pragma unroll 1
        for (int b = 8; b < 16; ++b) GATHER_U8(e1, b);
        __builtin_amdgcn_s_waitcnt(0xc07f); asm volatile("" ::: "memory");
        const float w0 = g0 * gelu_tanh(al[lane]), w1 = g1 * gelu_tanh(al[64 + lane]);
        float acc[16];
#pragma unroll
        for (int i = 0; i < 16; ++i) acc[i] = 0.f;
#pragma unroll 1
        for (int b = 0; b < 8; ++b) GATHER_V8(e0, w0, b);
#pragma unroll 1
        for (int b = 8; b < 16; ++b) GATHER_V8(e1, w1, b);
        float* hp = h + (size_t)t * DM + 8 * lane;
        f32x4 h0 = *(f32x4*)(hp), h1 = *(f32x4*)(hp + 4), h2 = *(f32x4*)(hp + 512), h3 = *(f32x4*)(hp + 516);
        h0 += (f32x4){acc[0], acc[1], acc[2], acc[3]}; h1 += (f32x4){acc[4], acc[5], acc[6], acc[7]};
        h2 += (f32x4){acc[8], acc[9], acc[10], acc[11]}; h3 += (f32x4){acc[12], acc[13], acc[14], acc[15]};
        *(f32x4*)(hp) = h0; *(f32x4*)(hp + 4) = h1; *(f32x4*)(hp + 512) = h2; *(f32x4*)(hp + 516) = h3;
        float ss = 0.f;
#pragma unroll
        for (int i = 0; i < 4; ++i) ss += h0[i] * h0[i] + h1[i] * h1[i] + h2[i] * h2[i] + h3[i] * h3[i];
        const float rstd = 1.0f / sqrtf(wave_sum(ss) * (1.0f / DM) + NORM_EPS);
        const f32x4 ga = *(const f32x4*)(gain_next + 8 * lane), gb = *(const f32x4*)(gain_next + 8 * lane + 4), gc = *(const f32x4*)(gain_next + 512 + 8 * lane), gd = *(const f32x4*)(gain_next + 516 + 8 * lane);
        u32x4g o0, o1;
        o0.x = pk2(h0[0] * rstd * ga[0], h0[1] * rstd * ga[1]); o0.y = pk2(h0[2] * rstd * ga[2], h0[3] * rstd * ga[3]);
        o0.z = pk2(h1[0] * rstd * gb[0], h1[1] * rstd * gb[1]); o0.w = pk2(h1[2] * rstd * gb[2], h1[3] * rstd * gb[3]);
        o1.x = pk2(h2[0] * rstd * gc[0], h2[1] * rstd * gc[1]); o1.y = pk2(h2[2] * rstd * gc[2], h2[3] * rstd * gc[3]);
        o1.z = pk2(h3[0] * rstd * gd[0], h3[1] * rstd * gd[1]); o1.w = pk2(h3[2] * rstd * gd[2], h3[3] * rstd * gd[3]);
        *(u32x4g*)(XN + (size_t)t * DM + 8 * lane) = o0; *(u32x4g*)(XN + (size_t)t * DM + 512 + 8 * lane) = o1;
    }
}


typedef short bf16x8r __attribute__((ext_vector_type(8)));
typedef float f32x16r __attribute__((ext_vector_type(16)));
__device__ __forceinline__ float unokey(unsigned k) { const unsigned u = (k & 0x80000000u) ? (k & 0x7fffffffu) : ~k; return __builtin_bit_cast(float, u); }
#define CE_D(a, b) do { const unsigned mx_ = max(a, b), mn_ = min(a, b); a = mx_; b = mn_; } while (0)
#define SORT16_DESC(v, base) do { \
    _Pragma("unroll") for (int k_ = 2; k_ <= 16; k_ <<= 1) \
    _Pragma("unroll") for (int j_ = k_ >> 1; j_ > 0; j_ >>= 1) \
    _Pragma("unroll") for (int i_ = 0; i_ < 16; ++i_) { const int l_ = i_ ^ j_; if (l_ > i_) { if ((i_ & k_) == 0) CE_D(v[(base) + i_], v[(base) + l_]); else CE_D(v[(base) + l_], v[(base) + i_]); } } } while (0)
#define BMERGE16_DESC(v, base) do { \
    _Pragma("unroll") for (int j_ = 8; j_ > 0; j_ >>= 1) \
    _Pragma("unroll") for (int i_ = 0; i_ < 16; ++i_) { const int l_ = i_ ^ j_; if (l_ > i_) CE_D(v[(base) + i_], v[(base) + l_]); } } while (0)
#define TOPMERGE16(v, a, b) do { _Pragma("unroll") for (int i_ = 0; i_ < 16; ++i_) v[(a) + i_] = max(v[(a) + i_], v[(b) + 15 - i_]); BMERGE16_DESC(v, a); } while (0)
#define PARTNER_TOP16(v) do { unsigned o_[16]; _Pragma("unroll") for (int i_ = 0; i_ < 16; ++i_) o_[i_] = (unsigned)__shfl_xor((int)v[15 - i_], 32); \
    _Pragma("unroll") for (int i_ = 0; i_ < 16; ++i_) v[i_] = max(v[i_], o_[i_]); BMERGE16_DESC(v, 0); } while (0)
constexpr int SK_ROW = 272;
__device__ __forceinline__ void ph_peer_route_opt(const bf16* qry, const bf16* subk, int* eidx, float* gw, unsigned char* smem) {
    const int tid = tidx(), lane = tid & 63, wave = tid >> 6, r32 = lane & 31, hi = lane >> 5;
    for (int unit = bidx(); unit < 512; unit += gridDim.x) {
        const int h = unit & 7, tb = unit >> 3;
        __syncthreads();
        for (int i = tid; i < 4096; i += NT) { const int row = i >> 4, ch = i & 15;
            *(u32x4g*)(smem + row * SK_ROW + ch * 16) = *(const u32x4g*)(subk + ((size_t)(h * 2) * 128 + row) * 128 + ch * 8); }
        __syncthreads();
        const int trow = tb * 256 + wave * 32 + r32;
        unsigned top[2][16];
#pragma unroll
        for (int c = 0; c < 2; ++c) {
            f32x16r acc[4];
#pragma unroll
            for (int kb = 0; kb < 4; ++kb) acc[kb] = (f32x16r){0.f, 0.f, 0.f, 0.f, 0.f, 0.f, 0.f, 0.f, 0.f, 0.f, 0.f, 0.f, 0.f, 0.f, 0.f, 0.f};
#pragma unroll
            for (int ks = 0; ks < 8; ++ks) {
                const bf16x8r bq = *(const bf16x8r*)(qry + (size_t)trow * 2048 + h * 256 + c * 128 + ks * 16 + 8 * hi);
#pragma unroll
                for (int kb = 0; kb < 4; ++kb) {
                    const bf16x8r ak = *(const bf16x8r*)(smem + (c * 128 + kb * 32 + r32) * SK_ROW + (ks * 16 + 8 * hi) * 2);
                    acc[kb] = __builtin_amdgcn_mfma_f32_32x32x16_bf16(ak, bq, acc[kb], 0, 0, 0);
                }
            }
            unsigned k[64];
#pragma unroll
            for (int kb = 0; kb < 4; ++kb)
#pragma unroll
                for (int r = 0; r < 16; ++r) { const float sc = acc[kb][r]; const int idx = kb * 32 + (r & 3) + 8 * (r >> 2) + 4 * hi;
                    k[kb * 16 + r] = (okey(sc) & 0xffffff80u) | (unsigned)(127 - idx); }
            SORT16_DESC(k, 0); SORT16_DESC(k, 16); SORT16_DESC(k, 32); SORT16_DESC(k, 48);
            TOPMERGE16(k, 0, 16); TOPMERGE16(k, 32, 48); TOPMERGE16(k, 0, 32);
            PARTNER_TOP16(k);
#pragma unroll
            for (int i = 0; i < 16; ++i) top[c][i] = k[i];
        }
        float va[16], vb[16];
#pragma unroll
        for (int i = 0; i < 16; ++i) { va[i] = unokey((top[0][i] & 0xffffff80u) | 0x40u); vb[i] = unokey((top[1][i] & 0xffffff80u) | 0x40u); }
        unsigned ck[32];
        ck[0] = (okey(hi ? (va[2] + vb[1]) : (va[0] + vb[0])) & 0xffffff00u) | (hi ? 222u : 255u);
        ck[1] = (okey(hi ? (va[2] + vb[2]) : (va[0] + vb[1])) & 0xffffff00u) | (hi ? 221u : 254u);
        ck[2] = (okey(hi ? (va[2] + vb[3]) : (va[0] + vb[2])) & 0xffffff00u) | (hi ? 220u : 253u);
        ck[3] = (okey(hi ? (va[2] + vb[4]) : (va[0] + vb[3])) & 0xffffff00u) | (hi ? 219u : 252u);
        ck[4] = (okey(hi ? (va[3] + vb[0]) : (va[0] + vb[4])) & 0xffffff00u) | (hi ? 207u : 251u);
        ck[5] = (okey(hi ? (va[3] + vb[1]) : (va[0] + vb[5])) & 0xffffff00u) | (hi ? 206u : 250u);
        ck[6] = (okey(hi ? (va[3] + vb[2]) : (va[0] + vb[6])) & 0xffffff00u) | (hi ? 205u : 249u);
        ck[7] = (okey(hi ? (va[3] + vb[3]) : (va[0] + vb[7])) & 0xffffff00u) | (hi ? 204u : 248u);
        ck[8] = (okey(hi ? (va[4] + vb[0]) : (va[0] + vb[8])) & 0xffffff00u) | (hi ? 191u : 247u);
        ck[9] = (okey(hi ? (va[4] + vb[1]) : (va[0] + vb[9])) & 0xffffff00u) | (hi ? 190u : 246u);
        ck[10] = (okey(hi ? (va[4] + vb[2]) : (va[0] + vb[10])) & 0xffffff00u) | (hi ? 189u : 245u);
        ck[11] = (okey(hi ? (va[5] + vb[0]) : (va[0] + vb[11])) & 0xffffff00u) | (hi ? 175u : 244u);
        ck[12] = (okey(hi ? (va[5] + vb[1]) : (va[0] + vb[12])) & 0xffffff00u) | (hi ? 174u : 243u);
        ck[13] = (okey(hi ? (va[6] + vb[0]) : (va[0] + vb[13])) & 0xffffff00u) | (hi ? 159u : 242u);
        ck[14] = (okey(hi ? (va[6] + vb[1]) : (va[0] + vb[14])) & 0xffffff00u) | (hi ? 158u : 241u);
        ck[15] = (okey(hi ? (va[7] + vb[0]) : (va[0] + vb[15])) & 0xffffff00u) | (hi ? 143u : 240u);
        ck[16] = (okey(hi ? (va[7] + vb[1]) : (va[1] + vb[0])) & 0xffffff00u) | (hi ? 142u : 239u);
        ck[17] = (okey(hi ? (va[8] + vb[0]) : (va[1] + vb[1])) & 0xffffff00u) | (hi ? 127u : 238u);
        ck[18] = (okey(hi ? (va[9] + vb[0]) : (va[1] + vb[2])) & 0xffffff00u) | (hi ? 111u : 237u);
        ck[19] = (okey(hi ? (va[10] + vb[0]) : (va[1] + vb[3])) & 0xffffff00u) | (hi ? 95u : 236u);
        ck[20] = (okey(hi ? (va[11] + vb[0]) : (va[1] + vb[4])) & 0xffffff00u) | (hi ? 79u : 235u);
        ck[21] = (okey(hi ? (va[12] + vb[0]) : (va[1] + vb[5])) & 0xffffff00u) | (hi ? 63u : 234u);
        ck[22] = (okey(hi ? (va[13] + vb[0]) : (va[1] + vb[6])) & 0xffffff00u) | (hi ? 47u : 233u);
        ck[23] = (okey(hi ? (va[14] + vb[0]) : (va[1] + vb[7])) & 0xffffff00u) | (hi ? 31u : 232u);
        ck[24] = (okey(hi ? (va[15] + vb[0]) : (va[2] + vb[0])) & 0xffffff00u) | (hi ? 15u : 223u);
#pragma unroll
        for (int s = 25; s < 32; ++s) ck[s] = 0u;
        SORT16_DESC(ck, 0); SORT16_DESC(ck, 16); TOPMERGE16(ck, 0, 16);
        PARTNER_TOP16(ck);
        const float m = unokey((ck[0] & 0xffffff00u) | 0x80u);
        float l = 0.f;
#pragma unroll
        for (int r = 0; r < 16; ++r) l += __expf(unokey((ck[r] & 0xffffff00u) | 0x80u) - m);
        const float linv = 1.0f / l;
        unsigned p0[4], p1[4];
#pragma unroll
        for (int w = 0; w < 4; ++w) { p0[w] = 0u; p1[w] = 0u;
#pragma unroll
            for (int b = 0; b < 4; ++b) { p0[w] |= (127u - (top[0][4 * w + b] & 127u)) << (8 * b); p1[w] |= (127u - (top[1][4 * w + b] & 127u)) << (8 * b); } }
        int eo[8]; float go[8]; const unsigned hmask = 0u - (unsigned)hi;
#pragma unroll
        for (int rr = 0; rr < 8; ++rr) {
            const unsigned key = ck[rr] ^ ((ck[rr] ^ ck[8 + rr]) & hmask);
            const unsigned flat = 255u - (key & 255u), i = flat >> 4, j = flat & 15u;
            const unsigned wi = (i >> 2) == 0 ? p0[0] : ((i >> 2) == 1 ? p0[1] : ((i >> 2) == 2 ? p0[2] : p0[3]));
            const unsigned wj = (j >> 2) == 0 ? p1[0] : ((j >> 2) == 1 ? p1[1] : ((j >> 2) == 2 ? p1[2] : p1[3]));
            const unsigned i0 = (wi >> ((i & 3u) * 8u)) & 255u, i1 = (wj >> ((j & 3u) * 8u)) & 255u;
            eo[rr] = (int)(i0 * 128u + i1);
            go[rr] = __expf(unokey((key & 0xffffff00u) | 0x80u) - m) * linv;
        }
        int* ep = eidx + (size_t)trow * 128 + h * 16 + 8 * hi; float* gp = gw + (size_t)trow * 128 + h * 16 + 8 * hi;
        typedef int i32x4 __attribute__((ext_vector_type(4)));
        *(i32x4*)ep = (i32x4){eo[0], eo[1], eo[2], eo[3]}; *(i32x4*)(ep + 4) = (i32x4){eo[4], eo[5], eo[6], eo[7]};
        *(f32x4*)gp = (f32x4){go[0], go[1], go[2], go[3]}; *(f32x4*)(gp + 4) = (f32x4){go[4], go[5], go[6], go[7]};
    }
}

#ifndef ATTN_STORE16
#define ATTN_STORE16(p,v) (*(u32x4*)(p)=(v))
#endif
namespace attn_g {
typedef unsigned short bf16;
using bf16x8=__attribute__((ext_vector_type(8)))short;
using s16x4=__attribute__((ext_vector_type(4)))short;
using f32x16=__attribute__((ext_vector_type(16)))float;
using u32x4=__attribute__((ext_vector_type(4)))unsigned;
constexpr int D=64;
constexpr int NW=8,QBLK=32,QB=QBLK*NW,KVBLK=64;
__device__ __forceinline__ int crow(int r,int hi){return (r&3)+8*(r>>2)+4*hi;}
#define SBAR() __builtin_amdgcn_sched_barrier(0)
__device__ __forceinline__ void cmask(f32x16&p0,f32x16&p1,int jb,int qrel,int hi){
  const float NEG=-__builtin_inff(); int kb=64*jb+4*hi;
  #pragma unroll
  for(int r=0;r<16;++r){int kv=kb+(r&3)+8*(r>>2); if(kv>qrel)p0[r]=NEG; if(kv+32>qrel)p1[r]=NEG;}
}

constexpr int NSLOT=3, SLOTB=8192;
constexpr int LDS_K=0, LDS_V=NSLOT*SLOTB, LDS_WS=2*NSLOT*SLOTB, LDS_OST=LDS_WS+NW*64*4, LDS_MSK=LDS_OST+NW*4096, LDS_BYTES=LDS_MSK+NW*2*256;
constexpr float C2=0.125f*1.4426950408889634f;
__device__ __forceinline__ void glds16(const void*gsrc,unsigned lds_dst){unsigned keep;
  asm volatile("s_mov_b32 %0, m0\n\ts_mov_b32 m0, %2\n\ts_nop 0\n\tglobal_load_lds_dwordx4 %1, off\n\ts_mov_b32 m0, %0":"=&s"(keep):"v"(gsrc),"s"(lds_dst):"memory");}
__device__ __forceinline__ void glds16s(const void*sbase,unsigned voff,unsigned lds_dst){unsigned keep;
  asm volatile("s_nop 4\n\ts_mov_b32 %0, m0\n\ts_mov_b32 m0, %3\n\ts_nop 0\n\tglobal_load_lds_dwordx4 %1, %2\n\ts_mov_b32 m0, %0":"=&s"(keep):"v"(voff),"s"(sbase),"s"(lds_dst):"memory");}
__device__ __forceinline__ void glds4s(const void*sbase,unsigned voff,unsigned lds_dst){unsigned keep;
  asm volatile("s_nop 4\n\ts_mov_b32 %0, m0\n\ts_mov_b32 m0, %3\n\ts_nop 0\n\tglobal_load_lds_dword %1, %2\n\ts_mov_b32 m0, %0":"=&s"(keep):"v"(voff),"s"(sbase),"s"(lds_dst):"memory");}
__device__ __forceinline__ unsigned bandw(int e){
  const unsigned a=(e<0)?0u:((e>=31)?0xffffffffu:((2u<<e)-1u)); const int f=e-128; const unsigned b=(f<=0)?0u:((f>=32)?0xffffffffu:((1u<<f)-1u)); return a&~b; }
__device__ __forceinline__ float max3f(float a,float b,float c){float r;asm("v_max3_f32 %0, %1, %2, %3":"=v"(r):"v"(a),"v"(b),"v"(c));return r;}
__device__ __forceinline__ float max2f(float a,float b){float r;asm("v_max_f32_e32 %0, %1, %2":"=v"(r):"v"(a),"v"(b));return r;}
__device__ __forceinline__ float fadd_s(float a,float b){float r;asm("v_add_f32_e32 %0, %1, %2":"=v"(r):"v"(a),"v"(b));return r;}
__device__ __forceinline__ float fsub_s(float a,float b){float r;asm("v_sub_f32_e32 %0, %1, %2":"=v"(r):"v"(a),"v"(b));return r;}
typedef float f32x2_t __attribute__((ext_vector_type(2))); typedef __bf16 bf16x2_t __attribute__((ext_vector_type(2)));
__device__ __forceinline__ unsigned cvtpk_s(float lo,float hi){f32x2_t v={lo,hi};bf16x2_t b=__builtin_convertvector(v,bf16x2_t);return __builtin_bit_cast(unsigned,b);}
#define WAIT_BAR(N) asm volatile("s_waitcnt vmcnt(" #N ") lgkmcnt(0)\n\ts_barrier":::"memory")

template<bool NEGM> __device__ __forceinline__ void qkt(f32x16&p0,f32x16&p1,const char*Kslot,const bf16x8*qr,const f32x16&negm,int r32,int hi){ const f32x16 zc_={};
  const char*kb=Kslot+hi*1024+r32*16;
  #pragma unroll
  for(int d0=0;d0<4;++d0){
    const bf16x8 b0=*reinterpret_cast<const bf16x8*>(kb+d0*2048);
    const bf16x8 b1=*reinterpret_cast<const bf16x8*>(kb+d0*2048+512);
    if(d0==0){p0=__builtin_amdgcn_mfma_f32_32x32x16_bf16(b0,qr[0],NEGM?negm:zc_,0,0,0);p1=__builtin_amdgcn_mfma_f32_32x32x16_bf16(b1,qr[0],NEGM?negm:zc_,0,0,0);}
    else{p0=__builtin_amdgcn_mfma_f32_32x32x16_bf16(b0,qr[d0],p0,0,0,0);p1=__builtin_amdgcn_mfma_f32_32x32x16_bf16(b1,qr[d0],p1,0,0,0);}}
}
typedef __attribute__((address_space(3))) const char* lds_cptr;
typedef short v4i16_t __attribute__((ext_vector_type(4)));
__device__ __forceinline__ void kload8(bf16x8*kf,lds_cptr kp){
  kf[0]=*(const __attribute__((address_space(3))) bf16x8*)(kp);      kf[1]=*(const __attribute__((address_space(3))) bf16x8*)(kp+512);
  kf[2]=*(const __attribute__((address_space(3))) bf16x8*)(kp+2048); kf[3]=*(const __attribute__((address_space(3))) bf16x8*)(kp+2560);
  kf[4]=*(const __attribute__((address_space(3))) bf16x8*)(kp+4096); kf[5]=*(const __attribute__((address_space(3))) bf16x8*)(kp+4608);
  kf[6]=*(const __attribute__((address_space(3))) bf16x8*)(kp+6144); kf[7]=*(const __attribute__((address_space(3))) bf16x8*)(kp+6656);
}
__device__ __forceinline__ void kload2(bf16x8*kf,lds_cptr kp,int j){ kf[2*j]=*(const __attribute__((address_space(3))) bf16x8*)(kp+j*2048); kf[2*j+1]=*(const __attribute__((address_space(3))) bf16x8*)(kp+j*2048+512); }
__device__ __forceinline__ s16x4 vtr(lds_cptr p){ return __builtin_bit_cast(s16x4,__builtin_amdgcn_ds_read_tr16_b64_v4i16((__attribute__((address_space(3))) v4i16_t*)p)); }
__device__ __forceinline__ float rowmax(const f32x16&p0,const f32x16&p1){
  float a=max3f(p0[0],p0[1],p1[0]),b=max3f(p0[2],p0[3],p1[1]);a=max3f(a,p1[2],p1[3]);
  #pragma unroll
  for(int r=4;r<16;r+=4){a=max3f(a,p0[r],p0[r+1]);b=max3f(b,p0[r+2],p0[r+3]);a=max3f(a,p1[r],p1[r+1]);b=max3f(b,p1[r+2],p1[r+3]);}
  const float m=max2f(a,b);
  auto rr=__builtin_amdgcn_permlane32_swap(__float_as_uint(m),__float_as_uint(m),false,false);
  return max2f(__uint_as_float(rr[0]),__uint_as_float(rr[1]));
}
__device__ __forceinline__ void pv(f32x16*o,int vb,bf16x8 pa0,bf16x8 pa1,bf16x8 pa2,bf16x8 pa3){
  #pragma unroll
  for(int d0=0;d0<2;++d0){s16x4 lo[4],hi[4];
    #pragma unroll
    for(int ks=0;ks<4;++ks){
      asm volatile("ds_read_b64_tr_b16 %0,%1 offset:%c2":"=&v"(lo[ks]):"v"(vb),"i"(d0*4096+ks*1024):"memory");
      asm volatile("ds_read_b64_tr_b16 %0,%1 offset:%c2":"=&v"(hi[ks]):"v"(vb),"i"(d0*4096+ks*1024+512):"memory");}
    asm volatile("s_waitcnt lgkmcnt(0)":::"memory");SBAR();
    #define PK(k) (bf16x8){lo[k][0],lo[k][1],lo[k][2],lo[k][3],hi[k][0],hi[k][1],hi[k][2],hi[k][3]}
    o[d0]=__builtin_amdgcn_mfma_f32_32x32x16_bf16(pa0,PK(0),o[d0],0,0,0);
    o[d0]=__builtin_amdgcn_mfma_f32_32x32x16_bf16(pa1,PK(1),o[d0],0,0,0);
    o[d0]=__builtin_amdgcn_mfma_f32_32x32x16_bf16(pa2,PK(2),o[d0],0,0,0);
    o[d0]=__builtin_amdgcn_mfma_f32_32x32x16_bf16(pa3,PK(3),o[d0],0,0,0);
    #undef PK
  }
}

#ifndef ATTN_STORE16
#define ATTN_STORE16(p,v) (*(u32x4*)(p)=(v))
#endif
template<int MODE,int THRL> __device__ __forceinline__ void attn_unit(const bf16*Qu,long qs,const bf16*__restrict__ Kh,const bf16*__restrict__ Vh,long kvs,bf16*Ou,long os,float*lse,long lses,const int NT,
    const unsigned*selp,const char*Msrc,const int e0,char*shm){
  constexpr bool USE_NEGM=(MODE==0);
  const int tid=tidx(),lane=tid&63,r32=lane&31,hi=lane>>5; const int wid=__builtin_amdgcn_readfirstlane(tid>>6);
  const bf16*Qw=Qu+(long)(wid*QBLK)*qs;
  const unsigned lds0=(unsigned)(uintptr_t)shm;
  float*wsf=(float*)(shm+LDS_WS)+wid*64;
  const unsigned kvoff=(unsigned)(((int)lane*(int)kvs+wid*8)*2);
  const unsigned vvoff=(unsigned)(((16*(wid&3)+(lane>>2))*(int)kvs+(wid>>2)*32+(lane&3)*8)*2);
  const unsigned kdst=lds0+LDS_K+wid*1024, vdst=lds0+LDS_V+wid*1024;
  #define KT(t) ((MODE==0)?(((t)<4)?(NT-4+(t)):((t)-4)):(t))
  #define DMA_K(t,slot) glds16s((const char*)Kh+(long)KT(t)*(KVBLK*2)*kvs,kvoff,(unsigned)__builtin_amdgcn_readfirstlane(kdst+(slot)))
  #define DMA_V(t,slot) glds16s((const char*)Vh+(long)KT(t)*(KVBLK*2)*kvs,vvoff,(unsigned)__builtin_amdgcn_readfirstlane(vdst+(slot)))
  const unsigned mvoff=(unsigned)((wid*QBLK)*8+lane*4); const unsigned mdst=lds0+LDS_MSK+wid*512;
  #define DMA_M(t) do{ if(MODE==1) glds4s(Msrc+(long)(t)*(8192*8),mvoff,(unsigned)__builtin_amdgcn_readfirstlane(mdst+((t)&1)*256)); }while(0)
  const int vb0=(int)(lds0+LDS_V)+((lane>>4)&1)*32+(lane&3)*8+(4*hi+((lane&15)>>2))*64;
  const char*Kbase=shm+LDS_K; bf16x8 kf[8];
  const lds_cptr shm3=(lds_cptr)shm; const lds_cptr kp0=shm3+LDS_K+hi*1024+r32*16; const lds_cptr vp0=shm3+LDS_V+((lane>>4)&1)*32+(lane&3)*8+(4*hi+((lane&15)>>2))*64;
  DMA_M(0);DMA_M(1);
  DMA_K(0,0);DMA_V(0,0);DMA_K(1,SLOTB);
  bf16x8 qr[4];
  #pragma unroll
  for(int d0=0;d0<4;++d0)qr[d0]=*reinterpret_cast<const bf16x8*>(&Qw[(long)r32*qs+d0*16+hi*8]);
  unsigned selw=0u; if(MODE==0) selw=selp[(long)(wid*QBLK+r32)*8];
  float mhat=0.f,l_reg=0.f;f32x16 o[2];f32x16 negm; { float zz_=0.f; asm volatile("":"+v"(zz_));
    _Pragma("unroll") for(int r=0;r<16;++r){o[0][r]=zz_;o[1][r]=zz_;negm[r]=zz_;} } if(USE_NEGM) asm volatile("":"+v"(negm));
  const int qrel=wid*QBLK+r32;
  #define CMASK(P0,P1,t) do{ const float NEG_=-__builtin_inff(); \
    if(MODE==0){ if((t)<4){cmask(P0,P1,(t),qrel,hi);} else { const unsigned n_=(unsigned)(((t)-4)>>2); const bool ok_=(n_==(selw&255u))|(n_==((selw>>8)&255u))|(n_==((selw>>16)&255u)); \
        _Pragma("unroll") for(int r=0;r<16;++r){P0[r]=ok_?P0[r]:NEG_;P1[r]=ok_?P1[r]:NEG_;} } } \
    else if(MODE==1){ const unsigned long long mw_=*(const __attribute__((address_space(3))) unsigned long long*)(shm3+LDS_MSK+wid*512+((t)&1)*256+r32*8); \
        const unsigned lo_=((unsigned)mw_)>>(4*hi), hh_=((unsigned)(mw_>>32))>>(4*hi); \
        _Pragma("unroll") for(int r=0;r<16;++r){ const unsigned bit_=1u<<((r&3)+8*(r>>2)); P0[r]=(lo_&bit_)?(P0[r]-mhat):NEG_; P1[r]=(hh_&bit_)?(P1[r]-mhat):NEG_; } } \
    else { const int e_=e0-64*(t)+qrel-4*hi; const unsigned lo_=bandw(e_), hh_=bandw(e_-32);     \
        _Pragma("unroll") for(int r=0;r<16;++r){ const unsigned bit_=1u<<((r&3)+8*(r>>2)); P0[r]=(lo_&bit_)?(P0[r]-mhat):NEG_; P1[r]=(hh_&bit_)?(P1[r]-mhat):NEG_; } } }while(0)
  bool resc=false;
  #define START(P0,P1) do{ const float rm=rowmax(P0,P1); resc=false; \
    { const float dl=(rm<-1e30f)?0.f:rm; mhat=fadd_s(mhat,dl); \
      _Pragma("unroll") for(int r=0;r<16;++r){P0[r]=fsub_s(P0[r],dl);P1[r]=fsub_s(P1[r],dl);} \
      if(USE_NEGM){ _Pragma("unroll") for(int r=0;r<16;++r)negm[r]=-mhat; asm volatile("":"+v"(negm)); } } \
    _Pragma("unroll") for(int r=0;r<16;++r)P0[r]=__builtin_amdgcn_exp2f(P0[r]); }while(0)
  #define RESC() do{ if(resc){ asm volatile("s_waitcnt lgkmcnt(0)":::"memory"); \
      _Pragma("unroll") for(int d_=0;d_<2;++d_) _Pragma("unroll") for(int r=0;r<16;++r)o[d_][r]*=wsf[crow(r,hi)]; } }while(0)
  f32x16 pA0,pA1,pB0,pB1; const f32x16 zc16={};
  int sl_prev=0,sl_cur=0,sl_next=SLOTB;
  #define ROT() do{sl_prev=sl_cur;sl_cur=sl_next;sl_next=(sl_next==(NSLOT-1)*SLOTB)?0:sl_next+SLOTB;}while(0)
  DMA_K(2,2*SLOTB);
  WAIT_BAR(3);
  qkt<USE_NEGM>(pA0,pA1,Kbase,qr,negm,r32,hi);asm volatile("s_nop 15\n\ts_nop 7":"+v"(pA0),"+v"(pA1));CMASK(pA0,pA1,0);
  START(pA0,pA1);
  _Pragma("unroll") for(int r=0;r<16;++r)pA1[r]=__builtin_amdgcn_exp2f(pA1[r]);
  WAIT_BAR(0);
  DMA_K(3,0);DMA_V(1,SLOTB);
  ROT();
  kload8(kf,kp0+sl_cur);
  WAIT_BAR(2);
  s16x4 vlo[8],vhi[8]; u32x4 pw0,pw1,pw2,pw3;
  #define PKW(P,B) cvtpk_s(P[B],P[B+1])
  #define PAF(k) __builtin_bit_cast(bf16x8,pw##k)
  #define VFR(i) (bf16x8){vlo[i][0],vlo[i][1],vlo[i][2],vlo[i][3],vhi[i][0],vhi[i][1],vhi[i][2],vhi[i][3]}
  #define PIN(x) asm volatile("":"+v"(x))
  #define MX3(a,b,c) __builtin_fmaxf(__builtin_fmaxf((a),(b)),(c))
  #define GAPA(MF,A0,A1,A2,A3,W0,W1,PW) do{ MF; sacc+=A0; sacc+=A1; sacc+=A2; sacc+=A3; PIN(sacc); W0; W1; PIN(PW); SBAR(); }while(0)
  #define EX(v) __builtin_amdgcn_exp2f(v)
  #define GAPB(MF,X,B) do{ MF; X[B]=EX(X[B]); X[B+1]=EX(X[B+1]); X[B+2]=EX(X[B+2]); X[B+3]=EX(X[B+3]); PIN(X); SBAR(); }while(0)
  #define VRD(i) do{ vlo[i]=vtr(vp_+(((i)>>2)*4096+((i)&3)*1024)); vhi[i]=vtr(vp_+(((i)>>2)*4096+((i)&3)*1024+512)); }while(0)
  #define KRD(G,j) do{ if(G){ kload2(kf,kp0+sl_next,j); SBAR(); } }while(0)
  #define STEP(C0,C1,P0,P1,t,GK,GV,GL) do{ SBAR(); if((t)+1<NT){DMA_M((t)+1);} \
    const lds_cptr vp_=vp0+sl_prev; \
    VRD(0); SBAR(); float sacc=(P0[0]+P0[1]); \
    GAPA(C0=__builtin_amdgcn_mfma_f32_32x32x16_bf16(kf[0],qr[0],USE_NEGM?negm:zc16,0,0,0), P0[2],P0[3],P0[4],P0[5],     pw0[0]=PKW(P0,0), pw0[1]=PKW(P0,2), pw0); \
    VRD(4); SBAR(); GAPA(C1=__builtin_amdgcn_mfma_f32_32x32x16_bf16(kf[1],qr[0],USE_NEGM?negm:zc16,0,0,0), P0[6],P0[7],P0[8],P0[9],     pw0[2]=PKW(P0,4), pw0[3]=PKW(P0,6), pw0); \
    VRD(1); SBAR(); GAPA(C0=__builtin_amdgcn_mfma_f32_32x32x16_bf16(kf[2],qr[1],C0,0,0,0),   P0[10],P0[11],P0[12],P0[13], pw1[0]=PKW(P0,8), pw1[1]=PKW(P0,10), pw1); \
    VRD(5); SBAR(); GAPA(C1=__builtin_amdgcn_mfma_f32_32x32x16_bf16(kf[3],qr[1],C1,0,0,0),   P0[14],P0[15],P1[0],P1[1],   pw1[2]=PKW(P0,12),pw1[3]=PKW(P0,14), pw1); \
    VRD(2); SBAR(); GAPA(C0=__builtin_amdgcn_mfma_f32_32x32x16_bf16(kf[4],qr[2],C0,0,0,0),   P1[2],P1[3],P1[4],P1[5],     pw2[0]=PKW(P1,0), pw2[1]=PKW(P1,2), pw2); \
    VRD(6); SBAR(); GAPA(C1=__builtin_amdgcn_mfma_f32_32x32x16_bf16(kf[5],qr[2],C1,0,0,0),   P1[6],P1[7],P1[8],P1[9],     pw2[2]=PKW(P1,4), pw2[3]=PKW(P1,6), pw2); \
    VRD(3); SBAR(); GAPA(C0=__builtin_amdgcn_mfma_f32_32x32x16_bf16(kf[6],qr[3],C0,0,0,0),   P1[10],P1[11],P1[12],P1[13], pw3[0]=PKW(P1,8), pw3[1]=PKW(P1,10), pw3); \
    VRD(7); SBAR(); GAPA(C1=__builtin_amdgcn_mfma_f32_32x32x16_bf16(kf[7],qr[3],C1,0,0,0),   P1[14],P1[15],0.f,0.f,       pw3[2]=PKW(P1,12),pw3[3]=PKW(P1,14), pw3); \
    l_reg+=sacc; \
    if(GK){DMA_K((t)+3,sl_cur);} if(GV){DMA_V((t)+1,sl_next);} \
    CMASK(C0,C1,t); \
    { float a=MX3(C0[0],C0[1],C1[0]),b=MX3(C0[2],C0[3],C1[1]); a=MX3(a,C1[2],C1[3]); \
      _Pragma("unroll") for(int r=4;r<16;r+=4){a=MX3(a,C0[r],C0[r+1]);b=MX3(b,C0[r+2],C0[r+3]);a=MX3(a,C1[r],C1[r+1]);b=MX3(b,C1[r+2],C1[r+3]);} \
      float rm=__builtin_fmaxf(a,b); { auto rr=__builtin_amdgcn_permlane32_swap(__float_as_uint(rm),__float_as_uint(rm),false,false); rm=__builtin_fmaxf(__uint_as_float(rr[0]),__uint_as_float(rr[1])); } \
      resc=false; \
      if(__builtin_expect(__any(rm>(float)THRL),0)){ const float dl=__builtin_fmaxf(rm,0.f); mhat+=dl; \
        _Pragma("unroll") for(int r=0;r<16;++r){C0[r]-=dl;C1[r]-=dl;} \
        if(USE_NEGM){ _Pragma("unroll") for(int r=0;r<16;++r)negm[r]=-mhat; asm volatile("":"+v"(negm)); } \
        const float f=__builtin_amdgcn_exp2f(-dl); l_reg*=f; if(hi==0)wsf[r32]=f; resc=true; } } \
    SBAR(); \
    GAPB(o[0]=__builtin_amdgcn_mfma_f32_32x32x16_bf16(PAF(0),VFR(0),o[0],0,0,0), C0,0); \
    GAPB(o[1]=__builtin_amdgcn_mfma_f32_32x32x16_bf16(PAF(0),VFR(4),o[1],0,0,0), C0,4); \
    KRD(GL,0); GAPB(o[0]=__builtin_amdgcn_mfma_f32_32x32x16_bf16(PAF(1),VFR(1),o[0],0,0,0), C0,8); \
    KRD(GL,1); GAPB(o[1]=__builtin_amdgcn_mfma_f32_32x32x16_bf16(PAF(1),VFR(5),o[1],0,0,0), C0,12); \
    KRD(GL,2); GAPB(o[0]=__builtin_amdgcn_mfma_f32_32x32x16_bf16(PAF(2),VFR(2),o[0],0,0,0), C1,0); \
    KRD(GL,3); GAPB(o[1]=__builtin_amdgcn_mfma_f32_32x32x16_bf16(PAF(2),VFR(6),o[1],0,0,0), C1,4); \
    GAPB(o[0]=__builtin_amdgcn_mfma_f32_32x32x16_bf16(PAF(3),VFR(3),o[0],0,0,0), C1,8); \
    GAPB(o[1]=__builtin_amdgcn_mfma_f32_32x32x16_bf16(PAF(3),VFR(7),o[1],0,0,0), C1,12); \
    }while(0)
  int t=1;
  for(;t+5<NT;t+=2){
    STEP(pB0,pB1,pA0,pA1,t,true,true,true);     WAIT_BAR(2); RESC(); ROT();
    STEP(pA0,pA1,pB0,pB1,t+1,true,true,true);   WAIT_BAR(2); RESC(); ROT();
  }
  #define ENDW(tt) do{ if((tt)+3<NT){WAIT_BAR(2);} else if((tt)+2<NT){WAIT_BAR(1);} else {WAIT_BAR(0);} }while(0)
  for(;t+1<NT;t+=2){
    STEP(pB0,pB1,pA0,pA1,t,(t+3<NT),(t+1<NT),(t+1<NT));       ENDW(t);   RESC(); ROT();
    STEP(pA0,pA1,pB0,pB1,t+1,(t+4<NT),(t+2<NT),(t+2<NT));     ENDW(t+1); RESC(); ROT();
  }
  STEP(pB0,pB1,pA0,pA1,NT-1,false,false,false); RESC();
  { float sacc=pB0[0]+pB0[1]; _Pragma("unroll") for(int r=2;r<16;++r)sacc+=pB0[r]; _Pragma("unroll") for(int r=0;r<16;++r)sacc+=pB1[r]; l_reg+=sacc;
    pw0=(u32x4){PKW(pB0,0),PKW(pB0,2),PKW(pB0,4),PKW(pB0,6)};pw1=(u32x4){PKW(pB0,8),PKW(pB0,10),PKW(pB0,12),PKW(pB0,14)};pw2=(u32x4){PKW(pB1,0),PKW(pB1,2),PKW(pB1,4),PKW(pB1,6)};pw3=(u32x4){PKW(pB1,8),PKW(pB1,10),PKW(pB1,12),PKW(pB1,14)};
    SBAR(); pv(o,vb0+sl_cur,PAF(0),PAF(1),PAF(2),PAF(3)); }
  #undef PKW
  #undef PAF
  #undef VFR
  #undef PIN
  #undef MX3
  #undef GAPA
  #undef GAPB
  #undef EX
  #undef VRD
  #undef KRD
  #undef STEP
  #undef ENDW
  {auto rr=__builtin_amdgcn_permlane32_swap(__float_as_uint(l_reg),__float_as_uint(l_reg),false,false);l_reg=__uint_as_float(rr[0])+__uint_as_float(rr[1]);}
  if(hi==0)wsf[32+r32]=l_reg;asm volatile("s_waitcnt lgkmcnt(0)":::"memory");
  float rli[16];
  #pragma unroll
  for(int r=0;r<16;++r)rli[r]=__builtin_amdgcn_rcpf(wsf[32+crow(r,hi)]);
  long os2=os,lses2=lses; asm volatile("":"+s"(os2),"+s"(lses2));
  if(lse!=nullptr && hi==0) lse[(long)(wid*QBLK+r32)*lses2]=mhat+__log2f(l_reg);
  bf16*Ow=Ou+(long)(wid*QBLK)*os2;
  { bf16*stg=(bf16*)(shm+LDS_OST)+wid*2048;
    #pragma unroll
    for(int r=0;r<16;++r){const int orow=crow(r,hi);
      #pragma unroll
      for(int d0=0;d0<2;++d0)stg[orow*64+d0*32+r32]=(bf16)f2bf(o[d0][r]*rli[r]);}
    asm volatile("s_waitcnt lgkmcnt(0)":::"memory");
    #pragma unroll
    for(int i=0;i<4;++i){const int row=i*8+(lane>>3),ch=lane&7; const u32x4 v=*(const u32x4*)(stg+row*64+ch*8); ATTN_STORE16(Ow+(long)row*os2+ch*8,v);} }
  asm volatile("s_waitcnt lgkmcnt(0)\n\ts_barrier":::"memory");
  #undef DMA_K
  #undef DMA_V
  #undef DMA_M
  #undef KT
  #undef CMASK
  #undef START
  #undef RESC
  #undef ROT
}
constexpr int ATTN_LDS_BYTES=LDS_BYTES;
#undef SBAR
#undef WAIT_BAR
}

__device__ __forceinline__ int vcu_of(int G, int bx) { return (G % 8 == 0) ? (bx % 8) * (G / 8) + bx / 8 : bx; }
__device__ __forceinline__ void ph_attn_moba(const bf16* QKV, const unsigned* SEL, bf16* O, unsigned char* smem) {
    const int G = (int)gridDim.x, vcu = vcu_of(G, bidx());
#pragma unroll 1
    for (int idx = 2 * vcu; idx < 512; idx += ((idx & 1) ? 2 * G - 1 : 1)) {
        const int bh = idx >> 5, j = idx & 31, qb = (j & 1) ? 31 - (j >> 1) : (j >> 1), b = bh >> 3, h = bh & 7;
        const long row0 = (long)b * SEQ + 256 * qb, kv0 = (long)b * SEQ * AB_LD;
        attn_g::attn_unit<0, 8>(QKV + row0 * AB_LD + CQA + h * 64, AB_LD, QKV + kv0 + CKA + h * 64, QKV + kv0 + CVA + h * 64, AB_LD, O + row0 * DM + h * 64, DM, nullptr, 0, 4 * qb + 4,
                                SEL + row0 * 8 + h, nullptr, 0, (char*)smem);
    }
}


__device__ __forceinline__ void ph_attn_dsa(const bf16* QKV, const unsigned long long* MASK, bf16* O, unsigned char* smem) {
    const int G = (int)gridDim.x, vcu = vcu_of(G, bidx());
#pragma unroll 1
    for (int idx = 2 * vcu; idx < 512; idx += ((idx & 1) ? 2 * G - 1 : 1)) {
        const int bh = idx >> 5, j = idx & 31, qb = (j & 1) ? 31 - (j >> 1) : (j >> 1), b = bh >> 3, h = bh & 7;
        const long row0 = (long)b * SEQ + 256 * qb, kv0 = (long)b * SEQ * AB_LD;
        attn_g::attn_unit<1, 8>(QKV + row0 * AB_LD + CQB + h * 64, AB_LD, QKV + kv0 + CKB + h * 64, QKV + kv0 + CVB + h * 64, AB_LD, O + row0 * DM + 512 + h * 64, DM, nullptr, 0, 4 * qb + 4,
                                nullptr, (const char*)(MASK + (size_t)b * 128 * SEQ + 256 * qb), 0, (char*)smem);
    }
}
__device__ __forceinline__ void ph_attn_dilated(const bf16* QKV1, bf16* OG, float* LSE, unsigned char* smem) {
    const int G = (int)gridDim.x, vcu = vcu_of(G, bidx());
#pragma unroll 1
    for (int u = vcu; u < 3072; u += G) {
        const int g = u >> 10, bh = (u >> 5) & 31, j = u & 31, b = bh >> 4, h = bh & 15;
        const int lg = 2 * g, dil = 1 << lg, per = 32 >> lg;
        const int res = j / per, mb = j % per, m0 = 256 * mb, mk0 = (mb == 0) ? 0 : m0 - 128, nt = (m0 + 256 - mk0) / 64;
        const long qrow = (long)b * SEQ + res + (long)dil * m0, krow = (long)b * SEQ + res + (long)dil * mk0;
        attn_g::attn_unit<2, 8>(QKV1 + qrow * C_LD + h * 64, (long)dil * C_LD, QKV1 + krow * C_LD + 1024 + h * 64, QKV1 + krow * C_LD + 2048 + h * 64, (long)dil * C_LD,
                                OG + ((size_t)g * T + qrow) * DM + h * 64, (long)dil * DM, LSE + ((size_t)g * T + qrow) * 16 + h, (long)dil * 16, nt, nullptr, nullptr, m0 - mk0, (char*)smem);
    }
}

namespace cg = cooperative_groups;
constexpr int LDS_BYTES = 147456;
#define GEMM_PHASE(EPI, Aptr, Bptr, Nn, Kk, ...) do { pg8::Gemm g_{(const pg8::bf16_t*)(Aptr), (const pg8::bf16_t*)(Bptr), T, (Nn), (Kk)}; pg8::StaticOrder S_; S_.init(T, (Nn), (int)gridDim.x, (int)bidx()); \
    pg8::EPI E_{__VA_ARGS__}; pg8::gemm_phase<pg8::EPI, pg8::StaticOrder, true, true>((PG8_LAS unsigned char*)smem, g_, S_, E_); } while (0)
__global__ void __launch_bounds__(NT, 2) k_mega(Params P) {
    extern __shared__ __attribute__((aligned(16))) unsigned char smem[];
    cg::grid_group grid = cg::this_grid();
#define BAR() grid.sync()
    ph_prologue(smem);
    ph_rmsnorm(IN(0), IN(3), (bf16*)(WSP + WS_XN)); BAR();
    { unsigned char* ws = WSP; GEMM_PHASE(EBf16, ws + WS_XN, ws + WS_WAB_IN, AB_LD, DM, (bf16*)(ws + WS_QKV), AB_LD); } BAR();
    ph_prep0((bf16*)(WSP + WS_QKV), (const int*)IN(2), IN(8), IN(9), IN(10), IN(11)); BAR();
    { unsigned char* ws = WSP; ph_kmean((bf16*)(ws + WS_QKV), (float*)(ws + WS_KMEAN)); } BAR();
    { unsigned char* ws = WSP; ph_moba_select((bf16*)(ws + WS_QKV), (float*)(ws + WS_KMEAN), (unsigned*)(ws + WS_SEL)); } BAR();
    { unsigned char* ws = WSP; ph_attn_moba((bf16*)(ws + WS_QKV), (unsigned*)(ws + WS_SEL), (bf16*)(ws + WS_XN), smem); }
    { unsigned char* ws = WSP; ph_dsa_select((bf16*)(ws + WS_QKV), (unsigned long long*)(ws + WS_MASK), smem); } BAR();
    { unsigned char* ws = WSP; ph_attn_dsa((bf16*)(ws + WS_QKV), (unsigned long long*)(ws + WS_MASK), (bf16*)(ws + WS_XN), smem); } BAR();
    { unsigned char* ws = WSP; GEMM_PHASE(EResAdd, ws + WS_XN, ws + WS_WAB_OUT, DM, DM, IN(0), OUTP); } BAR();
#pragma unroll 1
    for (int L = 0; L < 2; ++L) {
        if (L == 1) {
            ph_rmsnorm(OUTP, IN(3) + DM, (bf16*)(WSP + WS_XN)); BAR();
            { unsigned char* ws = WSP; GEMM_PHASE(EBf16, ws + WS_XN, ws + WS_WC_IN, C_LD, DM, (bf16*)(ws + WS_QKV1), C_LD); } BAR();
            ph_prep1((bf16*)(WSP + WS_QKV1), (const int*)IN(2), IN(14), IN(15)); BAR();
            { unsigned char* ws = WSP; ph_attn_dilated((bf16*)(ws + WS_QKV1), (bf16*)(ws + WS_OG), (float*)(ws + WS_LSE), smem); } BAR();
            { unsigned char* ws = WSP; ph_dil_merge((bf16*)(ws + WS_OG), (float*)(ws + WS_LSE), (bf16*)(ws + WS_XN)); } BAR();
            { unsigned char* ws = WSP; float* hb = OUTP; GEMM_PHASE(EResAdd, ws + WS_XN, ws + WS_WC_OUT, DM, DM, hb, hb); } BAR();
        }
        ph_rmsnorm(OUTP, IN(4) + L * DM, (bf16*)(WSP + WS_XN)); BAR();
        { unsigned char* ws = WSP; GEMM_PHASE(EBf16, ws + WS_XN, ws + WS_WQ + (size_t)L * 4 * MiB, 2048, DM, (bf16*)(ws + WS_QRY), 2048); } BAR();
        { unsigned char* ws = WSP; ph_peer_route_opt((bf16*)(ws + WS_QRY), (bf16*)(ws + WS_SUBK) + (size_t)L * 16 * 128 * 128, (int*)(ws + WS_EIDX), (float*)(ws + WS_GW), smem); } BAR();
        { unsigned char* ws = WSP; ph_peer_gather_opt((int*)(ws + WS_EIDX), (float*)(ws + WS_GW), (bf16*)(ws + WS_EXP + (size_t)(2 * L) * 32 * MiB), (bf16*)(ws + WS_EXP + (size_t)(2 * L + 1) * 32 * MiB), OUTP, IN(5) + L * DM, (bf16*)(ws + WS_XN), smem); }
        __syncthreads();
        { unsigned char* ws = WSP; GEMM_PHASE(EBf16, ws + WS_P + (size_t)L * T * 256 * 2, ws + WS_WUP + (size_t)L * (MiB / 2), DM, 256, (bf16*)(ws + WS_UP), DM); } BAR();
        { unsigned char* ws = WSP; GEMM_PHASE(EGate, ws + WS_XN, ws + WS_WG + (size_t)L * 2 * MiB, DM, DM, OUTP, (bf16*)(ws + WS_UP)); } BAR();
    }
}

extern "C" void kernel_launch(void* const* d_in, const int* in_sizes, int n_in, void* d_out, int out_size, void* d_ws, size_t ws_size, hipStream_t stream) {
    static int grid_blocks = 0;
    if (grid_blocks == 0) {
        if (n_in != 22 || out_size != T * DM || ws_size < WS_END) { fprintf(stderr, "kernel_launch: unexpected shapes: n_in %d out %d ws %zu\n", n_in, out_size, ws_size); grid_blocks = -1; return; }
        if (hipFuncSetAttribute((const void*)k_mega, hipFuncAttributeMaxDynamicSharedMemorySize, LDS_BYTES) != hipSuccess) { fprintf(stderr, "hipFuncSetAttribute failed\n"); grid_blocks = -1; return; }
        int dev = 0, cus = 0, per_cu = 0;
        hipGetDevice(&dev);
        hipDeviceGetAttribute(&cus, hipDeviceAttributeMultiprocessorCount, dev);
        hipOccupancyMaxActiveBlocksPerMultiprocessor(&per_cu, (const void*)k_mega, NT, LDS_BYTES);
        if (per_cu < 1 || cus < 1) { fprintf(stderr, "kernel_launch: occupancy query says %d blocks/CU on %d CUs\n", per_cu, cus); grid_blocks = -1; return; }
        grid_blocks = cus;
    }
    if (grid_blocks < 0) return;
    Params P{};
    for (int i = 0; i < 22; ++i) P.in[i] = (const float*)d_in[i];
    P.out = (float*)d_out; P.ws = (unsigned char*)d_ws;
    void* args[] = {&P};
    hipError_t e = hipLaunchCooperativeKernel((const void*)k_mega, dim3(grid_blocks), dim3(NT), args, LDS_BYTES, stream);
    if (e != hipSuccess) fprintf(stderr, "cooperative launch failed: %s (grid %d)\n", hipGetErrorString(e), grid_blocks);
}
```

```cpp
#include <hip/hip_runtime.h>
#include <hip/hip_cooperative_groups.h>
#include <cstdio>
#include <cstdint>

constexpr int BATCH = 2, SEQ = 8192, T = BATCH * SEQ, DM = 1024;
constexpr int AB_N = 3396, AB_LD = 3584;
constexpr int CQA = 0, CKA = 512, CVA = 1024, CQB = 1536, CKB = 2048, CVB = 2560, CQI = 3072, CKI = 3328, CWI = 3392;
constexpr int C_LD = 3072;
constexpr int NEXP = 16384;
constexpr float NORM_EPS = 1e-6f;
constexpr float C2 = 0.125f * 1.4426950408889634f;
constexpr int NT = 512;

constexpr size_t MiB = 1u << 20;
constexpr size_t WS_CTL = 0;
constexpr size_t WS_WAB_IN = 1 * MiB, WS_WAB_OUT = 8 * MiB, WS_WC_IN = 10 * MiB, WS_WC_OUT = 16 * MiB;
constexpr size_t WS_WQ = 18 * MiB, WS_WG = 26 * MiB, WS_WUP = 30 * MiB, WS_SUBK = 31 * MiB;
constexpr size_t WS_KMEAN = 32 * MiB;
constexpr size_t WS_SEL = 33 * MiB;
constexpr size_t WS_LSE = 34 * MiB;
constexpr size_t WS_EIDX = 37 * MiB;
constexpr size_t WS_GW = 45 * MiB;
constexpr size_t WS_P = 53 * MiB;
constexpr size_t WS_XN = 69 * MiB;
constexpr size_t WS_QKV = 101 * MiB;
constexpr size_t WS_MASK = 213 * MiB;
constexpr size_t WS_SCORES = 229 * MiB;
constexpr size_t WS_EXP = 229 * MiB;
constexpr size_t WS_QRY = 101 * MiB;
constexpr size_t WS_UP = 165 * MiB;
constexpr size_t WS_QKV1 = 357 * MiB;
constexpr size_t WS_OG = 101 * MiB;
constexpr size_t WS_END = 512 * MiB;

typedef unsigned short bf16;
typedef float f32x4 __attribute__((ext_vector_type(4)));

__device__ __forceinline__ unsigned f2bf(float f) { unsigned u = __builtin_bit_cast(unsigned, f); return (u + 0x7fffu + ((u >> 16) & 1u)) >> 16; }
__device__ __forceinline__ float bf2f(bf16 h) { return __builtin_bit_cast(float, (unsigned)h << 16); }
__device__ __forceinline__ float wave_sum(float v) {
#pragma unroll
    for (int o = 1; o < 64; o <<= 1) v += __shfl_xor(v, o);
    return v;
}
__device__ __forceinline__ float wave_max(float v) {
#pragma unroll
    for (int o = 1; o < 64; o <<= 1) v = fmaxf(v, __shfl_xor(v, o));
    return v;
}
__device__ __forceinline__ unsigned okey(float f) { unsigned u = __builtin_bit_cast(unsigned, f); return (u & 0x80000000u) ? ~u : (u | 0x80000000u); }

__device__ __forceinline__ int tidx() { int t = __builtin_amdgcn_workitem_id_x(); asm volatile("" : "+v"(t)); return t; }
__device__ __forceinline__ int bidx() { int b = __builtin_amdgcn_workgroup_id_x(); asm volatile("" : "+s"(b)); return b; }
struct Params {
    const float* in[22];
    float* out;
    unsigned char* ws;
    int layer;
    int pad;
};

typedef const __attribute__((address_space(4))) unsigned long long* karg_t;
__device__ __forceinline__ unsigned long long karg(int idx) { karg_t ka = (karg_t)__builtin_amdgcn_kernarg_segment_ptr(); asm volatile("" : "+s"(ka)); return ka[idx]; }
#define GASP __attribute__((address_space(1)))
#define IN(i) ((const float*)(const GASP float*)karg(i))
#define OUTP ((float*)(GASP float*)karg(22))
#define WSP ((unsigned char*)(GASP unsigned char*)karg(23))

__device__ __forceinline__ void ph_rmsnorm(const float* src, const float* gain, bf16* dst) {
    const int lane = tidx() & 63, wave = tidx() >> 6;
    const int gw = bidx() * (NT / 64) + wave, ngw = gridDim.x * (NT / 64);
    for (int r = gw; r < T; r += ngw) {
        const f32x4* xr = (const f32x4*)(src + (size_t)r * DM) + lane;
        f32x4 v[4]; float s = 0.f;
#pragma unroll
        for (int j = 0; j < 4; ++j) { v[j] = xr[64 * j]; s += v[j].x * v[j].x + v[j].y * v[j].y + v[j].z * v[j].z + v[j].w * v[j].w; }
        const float rstd = 1.0f / sqrtf(wave_sum(s) * (1.0f / DM) + NORM_EPS);
#pragma unroll
        for (int j = 0; j < 4; ++j) {
            const f32x4 g = ((const f32x4*)gain)[lane + 64 * j];
            unsigned long long o = (unsigned long long)(f2bf(v[j].x * rstd * g.x) | (f2bf(v[j].y * rstd * g.y) << 16)) |
                                   ((unsigned long long)(f2bf(v[j].z * rstd * g.z) | (f2bf(v[j].w * rstd * g.w) << 16)) << 32);
            ((unsigned long long*)(dst + (size_t)r * DM))[lane + 64 * j] = o;
        }
    }
}

template <class AT> __device__ __forceinline__ float ldA(const AT* p);
template <> __device__ __forceinline__ float ldA<bf16>(const bf16* p) { return bf2f(*p); }
template <> __device__ __forceinline__ float ldA<float>(const float* p) { return *p; }

template <class AT, class Epi> __forceinline__
__device__ __forceinline__ void ph_gemm_naive(const AT* A, int lda, const float* B, int N, int K, const Epi& E, unsigned char* smem) {
    float* As = (float*)smem;
    float* Bs = As + 16 * 132;
    const int tid = tidx(), ty = tid >> 5, tx = tid & 31;
    const int ntn = (N + 127) / 128, ntm = T / 128, ntile = ntn * ntm;
    for (int tile = bidx(); tile < ntile; tile += gridDim.x) {
        const int tm = tile / ntn, tn = tile % ntn, m0 = tm * 128, n0 = tn * 128;
        float acc[8][4];
#pragma unroll
        for (int i = 0; i < 8; ++i)
#pragma unroll
            for (int j = 0; j < 4; ++j) acc[i][j] = 0.f;
        for (int k0 = 0; k0 < K; k0 += 16) {
            __syncthreads();
#pragma unroll
            for (int i = 0; i < 4; ++i) { const int e = tid + i * NT, r = e >> 4, kk = e & 15; As[kk * 132 + r] = ldA<AT>(A + (size_t)(m0 + r) * lda + k0 + kk); }
#pragma unroll
            for (int i = 0; i < 4; ++i) { const int e = tid + i * NT, kk = e >> 7, c = e & 127; Bs[kk * 128 + c] = (n0 + c < N) ? B[(size_t)(k0 + kk) * N + n0 + c] : 0.f; }
            __syncthreads();
#pragma unroll 2
            for (int kk = 0; kk < 16; ++kk) {
                float a[8], b[4];
#pragma unroll
                for (int i = 0; i < 8; ++i) a[i] = As[kk * 132 + ty * 8 + i];
#pragma unroll
                for (int j = 0; j < 4; ++j) b[j] = Bs[kk * 128 + tx * 4 + j];
#pragma unroll
                for (int i = 0; i < 8; ++i)
#pragma unroll
                    for (int j = 0; j < 4; ++j) acc[i][j] += a[i] * b[j];
            }
        }
#pragma unroll
        for (int i = 0; i < 8; ++i) {
            const int col = n0 + tx * 4;
            if (col < N) E.store4(m0 + ty * 8 + i, col, (f32x4){acc[i][0], acc[i][1], acc[i][2], acc[i][3]});
        }
    }
}
struct EpBf16 { bf16* O; int ldc;
    __device__ __forceinline__ void store4(int r, int c, f32x4 v) const {
        unsigned long long o = (unsigned long long)(f2bf(v.x) | (f2bf(v.y) << 16)) | ((unsigned long long)(f2bf(v.z) | (f2bf(v.w) << 16)) << 32);
        *(unsigned long long*)(O + (size_t)r * ldc + c) = o; } };
struct EpResAdd { const float* base; float* out;
    __device__ __forceinline__ void store4(int r, int c, f32x4 v) const {
        const f32x4 b = *(const f32x4*)(base + (size_t)r * DM + c); *(f32x4*)(out + (size_t)r * DM + c) = b + v; } };
struct EpGate { float* h; const bf16* up;
    __device__ __forceinline__ void store4(int r, int c, f32x4 v) const {
        f32x4 hv = *(const f32x4*)(h + (size_t)r * DM + c); const bf16* u = up + (size_t)r * DM + c;
        hv.x += bf2f(u[0]) / (1.f + __expf(-v.x)); hv.y += bf2f(u[1]) / (1.f + __expf(-v.y));
        hv.z += bf2f(u[2]) / (1.f + __expf(-v.z)); hv.w += bf2f(u[3]) / (1.f + __expf(-v.w));
        *(f32x4*)(h + (size_t)r * DM + c) = hv; } };

__device__ __forceinline__ void rope_cs(int pos, int i, float& c, float& s) {
    const float inv = exp2f(-(float)i * 0.125f * 18.931568569324174f);
    const float ang = (float)pos * inv;
    const float k = rintf(ang * 0.15915494309189535f);
    float r = fmaf(-k, 6.28125f, ang); r = fmaf(-k, 1.9353071795864769e-3f, r);
    c = cosf(r); s = sinf(r);
}
__device__ __forceinline__ void prep_head(bf16* p, const float* gain, int pos, float scale, bool donorm, int lane) {
    float v = bf2f(p[lane]);
    if (donorm) { const float ss = wave_sum(v * v); v = v * (1.0f / sqrtf(ss * (1.0f / 64.f) + NORM_EPS)) * gain[lane]; }
    const float partner = __shfl_xor(v, 8);
    float c = 1.f, s = 0.f;
    if (lane < 16) rope_cs(pos, lane & 7, c, s);
    float o = v;
    if (lane < 8) o = v * c - partner * s; else if (lane < 16) o = v * c + partner * s;
    p[lane] = (bf16)f2bf(o * scale);
}
__device__ __forceinline__ void ph_prep0(bf16* qkv, const int* positions, const float* aq, const float* ak, const float* bq, const float* bk) {
    const int lane = tidx() & 63, wave = tidx() >> 6;
    const int gw = bidx() * (NT / 64) + wave, ngw = gridDim.x * (NT / 64);
    for (int r = gw; r < T; r += ngw) {
        const int pos = positions[r]; bf16* row = qkv + (size_t)r * AB_LD;
        for (int h = 0; h < 8; ++h) {
            prep_head(row + CQA + h * 64, aq, pos, C2, true, lane);
            prep_head(row + CKA + h * 64, ak, pos, 1.f, true, lane);
            prep_head(row + CQB + h * 64, bq, pos, C2, true, lane);
            prep_head(row + CKB + h * 64, bk, pos, 1.f, true, lane);
        }
        for (int h = 0; h < 4; ++h) prep_head(row + CQI + h * 64, nullptr, pos, 1.f, false, lane);
        prep_head(row + CKI, nullptr, pos, 1.f, false, lane);
    }
}
__device__ __forceinline__ void ph_prep1(bf16* qkv, const int* positions, const float* cq, const float* ck) {
    const int lane = tidx() & 63, wave = tidx() >> 6;
    const int gw = bidx() * (NT / 64) + wave, ngw = gridDim.x * (NT / 64);
    for (int r = gw; r < T; r += ngw) {
        const int pos = positions[r]; bf16* row = qkv + (size_t)r * C_LD;
        for (int h = 0; h < 16; ++h) {
            prep_head(row + h * 64, cq, pos, C2, true, lane);
            prep_head(row + 1024 + h * 64, ck, pos, 1.f, true, lane);
        }
    }
}
__device__ __forceinline__ void ph_kmean(const bf16* qkv, float* kmean) {
    const int lane = tidx() & 63, wave = tidx() >> 6;
    const int gw = bidx() * (NT / 64) + wave, ngw = gridDim.x * (NT / 64);
    for (int it = gw; it < BATCH * 8 * 32; it += ngw) {
        const int b = it / 256, h = (it / 32) % 8, n = it % 32;
        float s = 0.f;
        for (int r = 0; r < 256; ++r) s += bf2f(qkv[(size_t)(b * SEQ + n * 256 + r) * AB_LD + CKA + h * 64 + lane]);
        kmean[(size_t)it * 64 + lane] = s * (1.0f / 256.f);
    }
}
__device__ __forceinline__ void ph_moba_select(const bf16* qkv, const float* kmean, unsigned* sel) {
    for (int it = bidx() * NT + tidx(); it < T * 8; it += gridDim.x * NT) {
        const int t = it >> 3, h = it & 7, b = t / SEQ, qblk = (t % SEQ) / 256;
        float q[64];
#pragma unroll
        for (int d = 0; d < 64; ++d) q[d] = bf2f(qkv[(size_t)t * AB_LD + CQA + h * 64 + d]);
        float v0 = -3e38f, v1 = -3e38f, v2 = -3e38f; int i0 = 255, i1 = 255, i2 = 255;
        for (int n = 0; n < qblk; ++n) {
            const float* km = kmean + (size_t)((b * 8 + h) * 32 + n) * 64; float g = 0.f;
#pragma unroll
            for (int d = 0; d < 64; ++d) g += q[d] * km[d];
            if (g > v0) { v2 = v1; i2 = i1; v1 = v0; i1 = i0; v0 = g; i0 = n; }
            else if (g > v1) { v2 = v1; i2 = i1; v1 = g; i1 = n; }
            else if (g > v2) { v2 = g; i2 = n; }
        }
        sel[it] = (unsigned)i0 | ((unsigned)i1 << 8) | ((unsigned)i2 << 16) | (255u << 24);
    }
}
__device__ __forceinline__ void ph_moba_attend(const bf16* qkv, const unsigned* sel, bf16* O, unsigned char* smem) {
    const int lane = tidx() & 63, wave = tidx() >> 6;
    float* pl = (float*)smem + wave * 1024;
    const int gw = bidx() * (NT / 64) + wave, ngw = gridDim.x * (NT / 64);
    for (int it = gw; it < T * 8; it += ngw) {
        const int t = it >> 3, h = it & 7, b = t / SEQ, tt = t % SEQ, qblk = tt / 256;
        const unsigned sw = sel[it];
        int blk[4] = {qblk, (int)(sw & 255), (int)((sw >> 8) & 255), (int)((sw >> 16) & 255)};
        const bf16* qp = qkv + (size_t)t * AB_LD + CQA + h * 64;
        float q[64];
#pragma unroll
        for (int d = 0; d < 64; ++d) q[d] = bf2f(qp[d]);
        float sc[16]; float mx = -3e38f;
#pragma unroll
        for (int s = 0; s < 4; ++s) {
#pragma unroll
            for (int i = 0; i < 4; ++i) {
                const int j = lane + 64 * i, pos = blk[s] * 256 + j;
                const bool ok = (blk[s] != 255) && (s > 0 || pos <= tt);
                float a = -3e38f;
                if (ok) { const bf16* kp = qkv + (size_t)(b * SEQ + pos) * AB_LD + CKA + h * 64; a = 0.f;
#pragma unroll
                    for (int d = 0; d < 64; ++d) a += q[d] * bf2f(kp[d]); }
                sc[s * 4 + i] = a; mx = fmaxf(mx, a);
            }
        }
        mx = wave_max(mx); float l = 0.f;
#pragma unroll
        for (int e = 0; e < 16; ++e) { const float p = (sc[e] > -1e38f) ? exp2f(sc[e] - mx) : 0.f; l += p; pl[(e >> 2) * 256 + lane + 64 * (e & 3)] = p; }
        l = wave_sum(l);
        __builtin_amdgcn_s_waitcnt(0);
        float o = 0.f;
#pragma unroll
        for (int s = 0; s < 4; ++s) {
            if (blk[s] == 255) continue;
            const int nk = (s == 0) ? (tt - qblk * 256 + 1) : 256;
            const bf16* vp = qkv + (size_t)(b * SEQ + blk[s] * 256) * AB_LD + CVA + h * 64 + lane;
            for (int j = 0; j < nk; ++j) o += pl[s * 256 + j] * bf2f(vp[(size_t)j * AB_LD]);
        }
        O[(size_t)t * DM + h * 64 + lane] = (bf16)f2bf(o / l);
    }
}
__device__ __forceinline__ void ph_dsa_select(const bf16* qkv, unsigned long long* mask, unsigned char* smem) {
    unsigned* keys = (unsigned*)smem;
    unsigned* cnt = keys + 8192;
    const int tid = tidx(), lane = tid & 63;
    for (int t = bidx(); t < T; t += gridDim.x) {
        const int b = t / SEQ, tt = t % SEQ, n = tt + 1;
        __syncthreads();
        const bf16* row = qkv + (size_t)t * AB_LD;
        float* qf = (float*)(cnt + 4);
        if (tid < 256) qf[tid] = bf2f(row[CQI + tid]);
        if (tid < 4) qf[256 + tid] = bf2f(row[CWI + tid]);
        __syncthreads();
        for (int kv = tid; kv < 8192; kv += NT) {
            unsigned key = 0u;
            if (kv < n) {
                const bf16* kp = qkv + (size_t)(b * SEQ + kv) * AB_LD + CKI;
                float a0 = 0.f, a1 = 0.f, a2 = 0.f, a3 = 0.f;
                for (int d = 0; d < 64; ++d) { const float kd = bf2f(kp[d]); a0 += qf[d] * kd; a1 += qf[64 + d] * kd; a2 += qf[128 + d] * kd; a3 += qf[192 + d] * kd; }
                const float s = ((qf[256] * fmaxf(a0, 0.f) + qf[257] * fmaxf(a1, 0.f)) + qf[258] * fmaxf(a2, 0.f)) + qf[259] * fmaxf(a3, 0.f);
                key = okey(s);
            }
            keys[kv] = key;
        }
        __syncthreads();
        unsigned thr = 0u, need = 0u;
        if (n > 256) {
            unsigned lo = 0u, hi = 0xFFFFFFFFu;
            while (lo < hi) {
                const unsigned mid = lo + ((hi - lo) >> 1) + ((hi - lo) & 1u);
                if (tid == 0) cnt[0] = 0u;
                __syncthreads();
                unsigned c = 0;
                for (int kv = tid; kv < 8192; kv += NT) c += (keys[kv] >= mid) ? 1u : 0u;
                c = (unsigned)wave_sum((float)c);
                if (lane == 0) atomicAdd(&cnt[0], c);
                __syncthreads();
                const unsigned tot = cnt[0];
                __syncthreads();
                if (tot >= 256u) lo = mid; else hi = mid - 1u;
            }
            thr = lo;
            if (tid == 0) cnt[1] = 0u;
            __syncthreads();
            unsigned c = 0;
            for (int kv = tid; kv < 8192; kv += NT) c += (keys[kv] > thr) ? 1u : 0u;
            c = (unsigned)wave_sum((float)c);
            if (lane == 0) atomicAdd(&cnt[1], c);
            __syncthreads();
            need = 256u - cnt[1];
        }
        if (tid < 64) {
            const int ntile = 4 * (tt / 256 + 1);
            unsigned taken = 0u;
            for (int j = 0; j < ntile; ++j) {
                const int kv = j * 64 + lane; const unsigned key = keys[kv];
                bool s;
                if (n <= 256) s = kv < n;
                else {
                    const bool gt = key > thr, eq = (key == thr) && (kv < n);
                    const unsigned long long em = __ballot(eq);
                    const unsigned rank = taken + (unsigned)__popcll(em & ((1ull << lane) - 1ull));
                    s = gt || (eq && rank < need);
                    taken += (unsigned)__popcll(em);
                }
                const unsigned long long m = __ballot(s);
                if (lane == 0) mask[((size_t)(b * 128 + j)) * SEQ + tt] = m;
            }
        }
    }
}
__device__ __forceinline__ void ph_dsa_attend(const bf16* qkv, const unsigned long long* mask, bf16* O, unsigned char* smem) {
    int* list = (int*)smem;
    int* cnt = list + 256;
    float* pr = (float*)(cnt + 4);
    float* linv = pr + 8 * 256;
    const int tid = tidx(), lane = tid & 63, wave = tid >> 6;
    for (int t = bidx(); t < T; t += gridDim.x) {
        const int b = t / SEQ, tt = t % SEQ;
        __syncthreads();
        const int ntile = 4 * (tt / 256 + 1);
        if (wave == 0) {
            int base = 0;
            for (int j = 0; j < ntile; ++j) {
                const unsigned long long m = mask[((size_t)(b * 128 + j)) * SEQ + tt];
                const int p = base + (int)__popcll(m & ((1ull << lane) - 1ull));
                if (((m >> lane) & 1ull) && p < 256) list[p] = j * 64 + lane;
                base += (int)__popcll(m);
            }
            if (lane == 0) cnt[0] = base;
        }
        __syncthreads();
        const int ns = min(cnt[0], 256);
        const bf16* row = qkv + (size_t)t * AB_LD;
        for (int e = tid; e < 8 * 256; e += NT) {
            const int h = e >> 8, j = e & 255; float a = -3e38f;
            if (j < ns) { const bf16* kp = qkv + (size_t)(b * SEQ + list[j]) * AB_LD + CKB + h * 64; a = 0.f;
                for (int d = 0; d < 64; ++d) a += bf2f(row[CQB + h * 64 + d]) * bf2f(kp[d]); }
            pr[e] = a;
        }
        __syncthreads();
        {
            const int h = wave; float v[4]; float mx = -3e38f;
#pragma unroll
            for (int i = 0; i < 4; ++i) { v[i] = pr[h * 256 + lane + 64 * i]; mx = fmaxf(mx, v[i]); }
            mx = wave_max(mx); float l = 0.f;
#pragma unroll
            for (int i = 0; i < 4; ++i) { const float p = (v[i] > -1e38f) ? exp2f(v[i] - mx) : 0.f; l += p; pr[h * 256 + lane + 64 * i] = p; }
            l = wave_sum(l); if (lane == 0) linv[h] = 1.0f / l;
        }
        __syncthreads();
        {   const int h = tid >> 6, d = tid & 63; float o = 0.f;
            for (int j = 0; j < ns; ++j) o += pr[h * 256 + j] * bf2f(qkv[(size_t)(b * SEQ + list[j]) * AB_LD + CVB + h * 64 + d]);
            O[(size_t)t * DM + 512 + h * 64 + d] = (bf16)f2bf(o * linv[h]); }
    }
}
__device__ __forceinline__ void ph_dilated(const bf16* qkv, bf16* OG, float* LSE) {
    const int lane = tidx() & 63, wave = tidx() >> 6;
    const int gw = bidx() * (NT / 64) + wave, ngw = gridDim.x * (NT / 64);
    for (int it = gw; it < T * 16; it += ngw) {
        const int t = it >> 4, h = it & 15, b = t / SEQ, tt = t % SEQ;
        const bf16* qp = qkv + (size_t)t * C_LD + h * 64;
        float q[64];
#pragma unroll
        for (int d = 0; d < 64; ++d) q[d] = bf2f(qp[d]);
        for (int g = 0; g < 3; ++g) {
            const int dil = (g == 0) ? 1 : (g == 1 ? 4 : 16);
            float sc[3]; float mx = -3e38f;
#pragma unroll
            for (int i = 0; i < 3; ++i) {
                const int j = lane + 64 * i, pos = tt - j * dil; float a = -3e38f;
                if (j <= 128 && pos >= 0) { const bf16* kp = qkv + (size_t)(b * SEQ + pos) * C_LD + 1024 + h * 64; a = 0.f;
#pragma unroll
                    for (int d = 0; d < 64; ++d) a += q[d] * bf2f(kp[d]); }
                sc[i] = a; mx = fmaxf(mx, a);
            }
            mx = wave_max(mx); float l = 0.f; float p[3];
#pragma unroll
            for (int i = 0; i < 3; ++i) { p[i] = (sc[i] > -1e38f) ? exp2f(sc[i] - mx) : 0.f; l += p[i]; }
            l = wave_sum(l);
            float o = 0.f;
            for (int j = 0; j <= 128; ++j) {
                const int pos = tt - j * dil; if (pos < 0) break;
                const float pj = (j < 64) ? __shfl(p[0], j) : ((j < 128) ? __shfl(p[1], j - 64) : __shfl(p[2], 0));
                o += pj * bf2f(qkv[(size_t)(b * SEQ + pos) * C_LD + 2048 + h * 64 + lane]);
            }
            OG[((size_t)g * T + t) * DM + h * 64 + lane] = (bf16)f2bf(o / l);
            if (lane == 0) LSE[((size_t)g * T + t) * 16 + h] = mx + log2f(l);
        }
    }
}
__device__ __forceinline__ void ph_dil_merge(const bf16* OG, const float* LSE, bf16* O) {
    for (size_t e = (size_t)bidx() * NT + tidx(); e < (size_t)T * DM; e += (size_t)gridDim.x * NT) {
        const int t = (int)(e >> 10), c = (int)(e & 1023), h = c >> 6;
        const float l0 = LSE[((size_t)0 * T + t) * 16 + h], l1 = LSE[((size_t)1 * T + t) * 16 + h], l2 = LSE[((size_t)2 * T + t) * 16 + h];
        const float m = fmaxf(l0, fmaxf(l1, l2)); const float w0 = exp2f(l0 - m), w1 = exp2f(l1 - m), w2 = exp2f(l2 - m);
        const float o = (w0 * bf2f(OG[e]) + w1 * bf2f(OG[(size_t)T * DM + e]) + w2 * bf2f(OG[(size_t)2 * T * DM + e])) / (w0 + w1 + w2);
        O[e] = (bf16)f2bf(o);
    }
}
__device__ __forceinline__ void ph_peer_route(const bf16* qry, const float* subk, int* eidx, float* gw, unsigned char* smem) {
    float* s = (float*)smem;
    float* sv = s + 2048;
    int* si = (int*)(sv + 256);
    float* qf = (float*)(si + 256);
    const int tid = tidx(), lane = tid & 63, wave = tid >> 6;
    for (int t = bidx(); t < T; t += gridDim.x) {
        __syncthreads();
        for (int e = tid; e < 2048; e += NT) qf[e] = bf2f(qry[(size_t)t * 2048 + e]);
        __syncthreads();
        for (int e = tid; e < 2048; e += NT) {
            const int hc = e >> 7, k = e & 127; const float* kp = subk + ((size_t)hc * 128 + k) * 128; float a = 0.f;
            for (int d = 0; d < 128; ++d) a += qf[hc * 128 + d] * kp[d];
            s[e] = a;
        }
        __syncthreads();
        for (int hc = wave; hc < 16; hc += NT / 64) {
            float v0 = s[hc * 128 + lane], v1 = s[hc * 128 + 64 + lane];
            for (int r = 0; r < 16; ++r) {
                float bv = v0; int bi = lane;
                if (v1 > bv) { bv = v1; bi = lane + 64; }
#pragma unroll
                for (int o = 1; o < 64; o <<= 1) { const float ov = __shfl_xor(bv, o); const int oi = __shfl_xor(bi, o); if (ov > bv || (ov == bv && oi < bi)) { bv = ov; bi = oi; } }
                if (lane == 0) { sv[hc * 16 + r] = bv; si[hc * 16 + r] = bi; }
                if (bi == lane) v0 = -3e38f; if (bi == lane + 64) v1 = -3e38f;
            }
        }
        __syncthreads();
        {   const int h = wave;
            float c[4]; int ci[4];
#pragma unroll
            for (int i = 0; i < 4; ++i) { const int f = lane + 64 * i; c[i] = sv[(h * 2) * 16 + (f >> 4)] + sv[(h * 2 + 1) * 16 + (f & 15)]; ci[i] = f; }
            float cv[16]; int cf[16];
#pragma unroll
            for (int r = 0; r < 16; ++r) {
                float bv = c[0]; int bi = ci[0];
#pragma unroll
                for (int i = 1; i < 4; ++i) if (c[i] > bv) { bv = c[i]; bi = ci[i]; }
#pragma unroll
                for (int o = 1; o < 64; o <<= 1) { const float ov = __shfl_xor(bv, o); const int oi = __shfl_xor(bi, o); if (ov > bv || (ov == bv && oi < bi)) { bv = ov; bi = oi; } }
                cv[r] = bv; cf[r] = bi;
#pragma unroll
                for (int i = 0; i < 4; ++i) if (ci[i] == bi) c[i] = -3e38f;
            }
            float l = 0.f;
#pragma unroll
            for (int r = 0; r < 16; ++r) l += __expf(cv[r] - cv[0]);
            if (lane < 16) {
                float myv = 0.f; int myf = 0;
#pragma unroll
                for (int r = 0; r < 16; ++r) if (r == lane) { myv = cv[r]; myf = cf[r]; }
                eidx[(size_t)t * 128 + h * 16 + lane] = si[(h * 2) * 16 + (myf >> 4)] * 128 + si[(h * 2 + 1) * 16 + (myf & 15)];
                gw[(size_t)t * 128 + h * 16 + lane] = __expf(myv - cv[0]) / l;
            }
        }
    }
}
__device__ __forceinline__ float gelu_tanh(float x) { const float u = 0.7978845608028654f * (x + 0.044715f * x * x * x); return 0.5f * x * (1.f + tanhf(u)); }
__device__ __forceinline__ void ph_peer_gather(const bf16* xn, const int* eidx, const float* gw, const float* U, const float* V, float* h, unsigned char* smem) {
    float* xf = (float*)smem;
    float* w = xf + 1024;
    int* ei = (int*)(w + 128);
    const int tid = tidx(), lane = tid & 63, wave = tid >> 6;
    for (int t = bidx(); t < T; t += gridDim.x) {
        __syncthreads();
        for (int e = tid; e < 1024; e += NT) xf[e] = bf2f(xn[(size_t)t * DM + e]);
        if (tid < 128) ei[tid] = eidx[(size_t)t * 128 + tid];
        __syncthreads();
        for (int e = wave; e < 128; e += NT / 64) {
            const float* up = U + (size_t)ei[e] * DM; float a = 0.f;
            for (int d = lane; d < 1024; d += 64) a += xf[d] * up[d];
            a = wave_sum(a);
            if (lane == 0) w[e] = gw[(size_t)t * 128 + e] * gelu_tanh(a);
        }
        __syncthreads();
        for (int d = tid; d < 1024; d += NT) {
            float o = 0.f;
            for (int e = 0; e < 128; ++e) o += w[e] * V[(size_t)ei[e] * DM + d];
            h[(size_t)t * DM + d] += o;
        }
    }
}

namespace pg8 {
#define PG8_LAS __attribute__((address_space(3)))
typedef unsigned short bf16_t;
typedef short bf16x8 __attribute__((ext_vector_type(8)));
typedef float f32x4 __attribute__((ext_vector_type(4)));
typedef unsigned u32x4 __attribute__((ext_vector_type(4)));
constexpr int BM = 256, BK = 64, HALF = 128, HTB = HALF * BK * 2  , STAGE_BYTES = 8 * HTB, NXCD = 8, WGM = 8;

__host__ __device__ __forceinline__ int lds_byte(int r, int c) { const int st = (r >> 4) * 2 + (c >> 5), rr = r & 15, cc = c & 31, ob = rr * 64 + cc * 2; return st * 1024 + (ob ^ (((ob >> 9) & 1) << 5)); }
__host__ __device__ __forceinline__ void stage_rc(int b, int& R, int& C) { const int st = b / 1024, sb = b % 1024, swz = sb ^ (((sb >> 9) & 1) << 5); R = (st >> 1) * 16 + swz / 64; C = (st & 1) * 32 + (swz % 64) / 2; }
__host__ __device__ __forceinline__ int perm32(int rho) { const int n = rho >> 4, i = rho & 15; return 8 * (i >> 2) + 4 * n + (i & 3); }

struct Unit { int pm, pn; };
struct Gemm { const bf16_t* A; const bf16_t* Bt; int M, N, K; };

struct StaticOrder {
    int nM, nN, nwg, G, c;
    __host__ __device__ void init(int M, int N, int G_, int c_) { nM = M / BM; nN = N / BM; nwg = nM * nN; G = G_; c = c_; }
    __host__ __device__ bool next(int i, Unit& u) const {
        const long L = (long)i * G + c; if (L >= nwg) return false;
        int wgid = (int)L; { const int q = nwg / NXCD, r = nwg % NXCD, xcd = wgid % NXCD, off = wgid / NXCD; wgid = (xcd < r ? xcd * (q + 1) : r * (q + 1) + (xcd - r) * q) + off; }
        const int nig = WGM * nN, gid = wgid / nig, fm = gid * WGM, gsz = (nM - fm) < WGM ? (nM - fm) : WGM;
        u.pm = fm + ((wgid % nig) % gsz); u.pn = (wgid % nig) / gsz; return true;
    }
    __device__ __forceinline__ void a_ready(const Unit&) const {}
    __device__ __forceinline__ void done(const Unit&) const {}
};


__device__ __forceinline__ unsigned pk_bf16(float lo, float hi) { typedef float f2 __attribute__((ext_vector_type(2))); typedef __bf16 b2 __attribute__((ext_vector_type(2))); f2 v = {lo, hi}; b2 b = __builtin_convertvector(v, b2); return __builtin_bit_cast(unsigned, b); }
struct EBf16 {
    static constexpr bool PERM = true, AFTER_DRAIN = false; bf16_t* O; int ldc;
    __device__ __forceinline__ void operator()(const f32x4 (&acc)[2][2][4][2], const Unit& u, int wr, int wc, int fr, int fq) const {
        const int row0 = u.pm * BM + wr * 64 + fr, col0 = u.pn * BM + wc * 32 + 8 * fq;
#pragma unroll
        for (int ai = 0; ai < 2; ++ai)
#pragma unroll
            for (int m = 0; m < 4; ++m) { bf16_t* rowp = O + (size_t)(row0 + ai * HALF + m * 16) * ldc + col0;
#pragma unroll
                for (int bj = 0; bj < 2; ++bj) { const f32x4 v0 = acc[ai][bj][m][0], v1 = acc[ai][bj][m][1];
                    u32x4 w; w.x = pk_bf16(v0[0], v0[1]); w.y = pk_bf16(v0[2], v0[3]); w.z = pk_bf16(v1[0], v1[1]); w.w = pk_bf16(v1[2], v1[3]);
                    *(u32x4*)(rowp + bj * HALF) = w; } }
    }
};
struct EResAdd {
    static constexpr bool PERM = false, AFTER_DRAIN = false; const float* base; float* out;
    __device__ __forceinline__ void operator()(const f32x4 (&acc)[2][2][4][2], const Unit& u, int wr, int wc, int fr, int fq) const {
        const int col0 = u.pn * BM + wc * 32 + 4 * fq;
#pragma unroll
        for (int ai = 0; ai < 2; ++ai)
#pragma unroll
            for (int m = 0; m < 4; ++m) { const size_t off = (size_t)(u.pm * BM + ai * HALF + wr * 64 + m * 16 + fr) * 1024 + col0;
#pragma unroll
                for (int bj = 0; bj < 2; ++bj)
#pragma unroll
                    for (int n = 0; n < 2; ++n) { const f32x4 b = *(const f32x4*)(base + off + bj * HALF + n * 16); *(f32x4*)(out + off + bj * HALF + n * 16) = b + acc[ai][bj][m][n]; } }
    }
};
struct EGate {
    static constexpr bool PERM = false, AFTER_DRAIN = false; float* h; const bf16_t* up;
    __device__ __forceinline__ void operator()(const f32x4 (&acc)[2][2][4][2], const Unit& u, int wr, int wc, int fr, int fq) const {
        const int col0 = u.pn * BM + wc * 32 + 4 * fq;
#pragma unroll
        for (int ai = 0; ai < 2; ++ai)
#pragma unroll
            for (int m = 0; m < 4; ++m) { const size_t off = (size_t)(u.pm * BM + ai * HALF + wr * 64 + m * 16 + fr) * 1024 + col0;
#pragma unroll
                for (int bj = 0; bj < 2; ++bj)
#pragma unroll
                    for (int n = 0; n < 2; ++n) { const size_t o = off + bj * HALF + n * 16; f32x4 hv = *(const f32x4*)(h + o);
                        const unsigned long long uu = *(const unsigned long long*)(up + o); const f32x4 a = acc[ai][bj][m][n];
                        hv[0] += __builtin_bit_cast(float, (unsigned)(uu << 16)) / (1.f + __expf(-a[0]));
                        hv[1] += __builtin_bit_cast(float, (unsigned)(uu & 0xffff0000ull)) / (1.f + __expf(-a[1]));
                        hv[2] += __builtin_bit_cast(float, (unsigned)((uu >> 16) & 0xffff0000ull)) / (1.f + __expf(-a[2]));
                        hv[3] += __builtin_bit_cast(float, (unsigned)((uu >> 32) & 0xffff0000ull)) / (1.f + __expf(-a[3]));
                        *(f32x4*)(h + o) = hv; } }
    }
};
template <class Epi, class Sched, bool ALIGN_EPI = false, bool SP2 = false>
__device__ __forceinline__ void gemm_phase(PG8_LAS unsigned char* lds, const Gemm g, const Sched& S, const Epi& E) {
    const int tid = tidx(), wid = __builtin_amdgcn_readfirstlane(tid >> 6), lane = tid & 63, wr = wid >> 2, wc = wid & 3, fr = lane & 15, fq = lane >> 4;
    const int K = g.K, nt = K / BK;
    unsigned voffA[2], voffB[2];
#pragma unroll
    for (int i = 0; i < 2; ++i) { int R, C; stage_rc(tid * 16 + i * 8192, R, C); const int Rb = Epi::PERM ? ((R & ~31) + perm32(R & 31)) : R;
        voffA[i] = (unsigned)(R * K + C) * 2u; voffB[i] = (unsigned)(Rb * K + C) * 2u; }
    const size_t kstep = (size_t)(BK * 2);
    const size_t hstep = (size_t)HALF * K * 2;
    const size_t tstep = 2 * hstep;
    const unsigned ldsw = (unsigned)wid * 1024u;
    const int aoff = lds_byte(wr * 64 + fr, fq * 8), boff = lds_byte(wc * 32 + fr, fq * 8);
#define PG8_SA(b, h) (((b) * 2 + (h)) * HTB)
#define PG8_SB(b, h) ((4 + (b) * 2 + (h)) * HTB)
#define PG8_STAGE(bufoff, gbase, voff) do { _Pragma("unroll") for (int _i = 0; _i < 2; ++_i) \
        __builtin_amdgcn_global_load_lds((const unsigned*)((const char*)(gbase) + (voff)[_i]), (PG8_LAS unsigned*)(lds + (bufoff) + ldsw + _i * 8192), 16, 0, 0); } while (0)
#define PG8_LDA(dst, b, h) do { _Pragma("unroll") for (int m = 0; m < 4; ++m) _Pragma("unroll") for (int k = 0; k < 2; ++k) dst[m][k] = *(const PG8_LAS bf16x8*)(lds + PG8_SA(b, h) + aoff + m * 2048 + k * 1024); } while (0)
#define PG8_LDB(dst, b, h) do { _Pragma("unroll") for (int n = 0; n < 2; ++n) _Pragma("unroll") for (int k = 0; k < 2; ++k) dst[n][k] = *(const PG8_LAS bf16x8*)(lds + PG8_SB(b, h) + boff + n * 2048 + k * 1024); } while (0)
#define PG8_MMA(ai, bj, At, Bt) do { __builtin_amdgcn_s_setprio(1); _Pragma("unroll") for (int m = 0; m < 4; ++m) _Pragma("unroll") for (int n = 0; n < 2; ++n) _Pragma("unroll") for (int k = 0; k < 2; ++k) \
        acc[ai][bj][m][n] = __builtin_amdgcn_mfma_f32_16x16x32_bf16(Bt[n][k], At[m][k], acc[ai][bj][m][n], 0, 0, 0); __builtin_amdgcn_s_setprio(0); } while (0)
#define PG8_WAIT_V(n) asm volatile("s_waitcnt vmcnt(" #n ")" ::: "memory")
#define PG8_WAIT_L(n) asm volatile("s_waitcnt lgkmcnt(" #n ")" ::: "memory")
#define PG8_BAR __builtin_amdgcn_s_barrier()
#define PG8_SCHED __builtin_amdgcn_sched_barrier(0)
    Unit cur, nxt; int ui = 0;
    if (!S.next(0, cur)) return;
    f32x4 acc[2][2][4][2];
#pragma unroll
    for (int a = 0; a < 2; ++a)
#pragma unroll
        for (int b = 0; b < 2; ++b)
#pragma unroll
            for (int m = 0; m < 4; ++m)
#pragma unroll
                for (int n = 0; n < 2; ++n) acc[a][b][m][n] = (f32x4){0.f, 0.f, 0.f, 0.f};
    bf16x8 At[4][2], B0[2][2], B1[2][2];
    const char* cA = (const char*)g.A + (size_t)cur.pm * tstep; const char* cB = (const char*)g.Bt + (size_t)cur.pn * tstep;
    S.a_ready(cur);
    if constexpr (SP2) {
        PG8_STAGE(PG8_SB(0, 0), cB, voffB); PG8_STAGE(PG8_SB(0, 1), cB + hstep, voffB); PG8_STAGE(PG8_SA(0, 0), cA, voffA); PG8_STAGE(PG8_SA(0, 1), cA + hstep, voffA);
        if (wr == 1) PG8_BAR;
        PG8_WAIT_V(2); PG8_BAR;
        PG8_STAGE(PG8_SB(1, 0), cB + kstep, voffB); PG8_STAGE(PG8_SA(1, 0), cA + kstep, voffA); PG8_STAGE(PG8_SB(1, 1), cB + hstep + kstep, voffB);
        PG8_WAIT_V(6); PG8_BAR;
    } else {
        PG8_STAGE(PG8_SB(0, 0), cB, voffB); PG8_STAGE(PG8_SA(0, 0), cA, voffA); PG8_STAGE(PG8_SB(0, 1), cB + hstep, voffB); PG8_STAGE(PG8_SA(0, 1), cA + hstep, voffA);
        if (wr == 1) PG8_BAR;
        PG8_WAIT_V(4); PG8_BAR;
        PG8_STAGE(PG8_SB(1, 0), cB + kstep, voffB); PG8_STAGE(PG8_SA(1, 0), cA + kstep, voffA); PG8_STAGE(PG8_SB(1, 1), cB + hstep + kstep, voffB);
        PG8_WAIT_V(6); PG8_BAR;
    }
    for (;;) {
        const bool has_next = S.next(ui + 1, nxt);
        const char* nA = has_next ? (const char*)g.A + (size_t)nxt.pm * tstep : cA; const char* nB = has_next ? (const char*)g.Bt + (size_t)nxt.pn * tstep : cB;
        for (int t = 0; t < nt; t += 2) {
            const bool last = (t == nt - 2);
            const char* a1 = cA + (size_t)(t + 1) * kstep;
            const char* a2 = last ? nA : cA + (size_t)(t + 2) * kstep; const char* b2 = last ? nB : cB + (size_t)(t + 2) * kstep;
            const char* a3 = a2 + kstep; const char* b3 = b2 + kstep;
            if (last && has_next) S.a_ready(nxt);
            if constexpr (SP2) {
            PG8_LDB(B0, 0, 0); PG8_LDB(B1, 0, 1); PG8_SCHED; PG8_LDA(At, 0, 0); PG8_STAGE(PG8_SA(1, 1), a1 + hstep, voffA);
            PG8_WAIT_V(8); PG8_WAIT_L(0); PG8_BAR; PG8_MMA(0, 0, At, B0); PG8_MMA(0, 1, At, B1); PG8_BAR; PG8_SCHED;
            PG8_LDA(At, 0, 1); PG8_STAGE(PG8_SB(0, 0), b2, voffB); PG8_STAGE(PG8_SB(0, 1), b2 + hstep, voffB); PG8_STAGE(PG8_SA(0, 0), a2, voffA);
            PG8_WAIT_V(8); PG8_WAIT_L(0); PG8_BAR; PG8_MMA(1, 0, At, B0); PG8_MMA(1, 1, At, B1); PG8_BAR; PG8_SCHED;
            PG8_LDB(B0, 1, 0); PG8_LDB(B1, 1, 1); PG8_SCHED; PG8_LDA(At, 1, 0); PG8_STAGE(PG8_SA(0, 1), a2 + hstep, voffA);
            PG8_WAIT_V(8); PG8_WAIT_L(0); PG8_BAR; PG8_MMA(0, 0, At, B0); PG8_MMA(0, 1, At, B1); PG8_BAR; PG8_SCHED;
            PG8_LDA(At, 1, 1); PG8_STAGE(PG8_SB(1, 0), b3, voffB); PG8_STAGE(PG8_SB(1, 1), b3 + hstep, voffB); PG8_STAGE(PG8_SA(1, 0), a3, voffA);
            PG8_WAIT_V(8); PG8_WAIT_L(0); PG8_BAR; PG8_MMA(1, 0, At, B0); PG8_MMA(1, 1, At, B1); PG8_BAR; PG8_SCHED;
            } else {
            PG8_LDB(B0, 0, 0); PG8_SCHED; PG8_LDA(At, 0, 0); PG8_STAGE(PG8_SA(1, 1), a1 + hstep, voffA);
            PG8_WAIT_L(8); PG8_BAR; PG8_WAIT_L(0); PG8_MMA(0, 0, At, B0); PG8_BAR; PG8_SCHED;
            PG8_LDB(B1, 0, 1); PG8_STAGE(PG8_SB(0, 0), b2, voffB);
            PG8_BAR; PG8_WAIT_L(0); PG8_MMA(0, 1, At, B1); PG8_BAR;
            PG8_LDA(At, 0, 1); PG8_STAGE(PG8_SA(0, 0), a2, voffA);
            PG8_BAR; PG8_WAIT_L(0); PG8_MMA(1, 0, At, B0); PG8_BAR; PG8_SCHED;
            PG8_STAGE(PG8_SB(0, 1), b2 + hstep, voffB);
            PG8_WAIT_V(6); PG8_BAR; PG8_MMA(1, 1, At, B1); PG8_BAR;
            PG8_LDB(B0, 1, 0); PG8_SCHED; PG8_LDA(At, 1, 0); PG8_STAGE(PG8_SA(0, 1), a2 + hstep, voffA);
            PG8_WAIT_L(8); PG8_BAR; PG8_WAIT_L(0); PG8_MMA(0, 0, At, B0); PG8_BAR; PG8_SCHED;
            PG8_LDB(B1, 1, 1); PG8_STAGE(PG8_SB(1, 0), b3, voffB);
            PG8_BAR; PG8_WAIT_L(0); PG8_MMA(0, 1, At, B1); PG8_BAR;
            PG8_LDA(At, 1, 1); PG8_STAGE(PG8_SA(1, 0), a3, voffA);
            PG8_BAR; PG8_WAIT_L(0); PG8_MMA(1, 0, At, B0); PG8_BAR; PG8_SCHED;
            PG8_STAGE(PG8_SB(1, 1), b3 + hstep, voffB);
            PG8_WAIT_V(6); PG8_BAR; PG8_MMA(1, 1, At, B1); PG8_BAR;
            }
        }
        if constexpr (ALIGN_EPI) { if (wr == 0) PG8_BAR; }
        if constexpr (!Epi::AFTER_DRAIN) { E(acc, cur, wr, wc, fr, fq); S.done(cur); }
        if (!has_next) break;
#pragma unroll
        for (int a = 0; a < 2; ++a)
#pragma unroll
            for (int b = 0; b < 2; ++b)
#pragma unroll
                for (int m = 0; m < 4; ++m)
#pragma unroll
                    for (int n = 0; n < 2; ++n) acc[a][b][m][n] = (f32x4){0.f, 0.f, 0.f, 0.f};
        cur = nxt; cA = nA; cB = nB; ++ui;
        if constexpr (ALIGN_EPI) { if (wr == 1) PG8_BAR; }
    }
    PG8_WAIT_V(0);
    if constexpr (!ALIGN_EPI) { if (wr == 0) PG8_BAR; }
    PG8_BAR;
    if constexpr (Epi::AFTER_DRAIN) { E.fused(acc, cur, wr, wc, fr, fq, lds, wid, lane); S.done(cur); }
#undef PG8_SA
#undef PG8_SB
#undef PG8_STAGE
#undef PG8_LDA
#undef PG8_LDB
#undef PG8_MMA
#undef PG8_WAIT_V
#undef PG8_WAIT_L
#undef PG8_BAR
#undef PG8_SCHED
}
}

#define LAS __attribute__((address_space(3)))
typedef unsigned v4u __attribute__((ext_vector_type(4)));
__device__ __forceinline__ unsigned pk2(float lo, float hi) { return f2bf(lo) | (f2bf(hi) << 16); }
__device__ __forceinline__ void transpose_item(const float* W, int K, int N, bf16* WT, float* scr, int item, int nblk, int lane) {
    const int kb = item / nblk, nb = item % nblk, k0 = 64 * kb, n0 = 32 * nb;
    const int nn = n0 + (lane & 31);
#pragma unroll 8
    for (int i = 0; i < 32; ++i) { const int kk = 2 * i + (lane >> 5); scr[kk * 33 + (lane & 31)] = (nn < N) ? W[(size_t)(k0 + kk) * N + nn] : 0.f; }
    __builtin_amdgcn_s_waitcnt(0xc07f); asm volatile("" ::: "memory");
    const int c = lane & 7;
#pragma unroll
    for (int j = 0; j < 4; ++j) { const int n = (lane >> 3) + 8 * j; const float* sp = scr + (8 * c) * 33 + n;
        v4u o; o.x = pk2(sp[0 * 33], sp[1 * 33]); o.y = pk2(sp[2 * 33], sp[3 * 33]); o.z = pk2(sp[4 * 33], sp[5 * 33]); o.w = pk2(sp[6 * 33], sp[7 * 33]);
        *(v4u*)(WT + (size_t)(n0 + n) * K + k0 + 8 * c) = o; }
    __builtin_amdgcn_s_waitcnt(0xc07f); asm volatile("" ::: "memory");
}
__device__ __forceinline__ void cvt_bf16(const float* src, bf16* dst, size_t n) {
    for (size_t e = ((size_t)bidx() * NT + tidx()) * 8; e < n; e += (size_t)gridDim.x * NT * 8) {
        const f32x4 a = *(const f32x4*)(src + e), b = *(const f32x4*)(src + e + 4);
        v4u o; o.x = pk2(a.x, a.y); o.y = pk2(a.z, a.w); o.z = pk2(b.x, b.y); o.w = pk2(b.z, b.w);
        *(v4u*)(dst + e) = o; }
}
__device__ __forceinline__ void transpose_matrix(const float* W, int K, int N, int Npad, bf16* WT, float* scr, int gw, int ngw, int lane) {
    const int nblk = Npad / 32, nit = (K / 64) * nblk;
    for (int it = gw; it < nit; it += ngw) transpose_item(W, K, N, WT, scr, it, nblk, lane);
}
__device__ __forceinline__ void ph_prologue(unsigned char* smem) {
    const int lane = tidx() & 63, wave = tidx() >> 6;
    float* scr = (float*)smem + wave * (64 * 33);
    const int gw = bidx() * (NT / 64) + wave, ngw = gridDim.x * (NT / 64);
    unsigned char* ws = WSP;
    transpose_matrix(IN(6), 1024, AB_N, AB_LD, (bf16*)(ws + WS_WAB_IN), scr, gw, ngw, lane);
    transpose_matrix(IN(7), 1024, 1024, 1024, (bf16*)(ws + WS_WAB_OUT), scr, gw, ngw, lane);
    transpose_matrix(IN(12), 1024, 3072, 3072, (bf16*)(ws + WS_WC_IN), scr, gw, ngw, lane);
    transpose_matrix(IN(13), 1024, 1024, 1024, (bf16*)(ws + WS_WC_OUT), scr, gw, ngw, lane);
#pragma unroll 1
    for (int L = 0; L < 2; ++L) {
        transpose_matrix(IN(16) + (size_t)L * DM * 2048, 1024, 2048, 2048, (bf16*)(ws + WS_WQ + (size_t)L * 4 * MiB), scr, gw, ngw, lane);
        transpose_matrix(IN(20) + (size_t)L * DM * DM, 1024, 1024, 1024, (bf16*)(ws + WS_WG + (size_t)L * 2 * MiB), scr, gw, ngw, lane);
        transpose_matrix(IN(21) + (size_t)L * 256 * DM, 256, 1024, 1024, (bf16*)(ws + WS_WUP + (size_t)L * (MiB / 2)), scr, gw, ngw, lane);
    }
    cvt_bf16(IN(1), (bf16*)(ws + WS_P), (size_t)2 * T * 256);
    cvt_bf16(IN(17), (bf16*)(ws + WS_SUBK), (size_t)2 * 16 * 128 * 128);
}


typedef __bf16 bf2_t __attribute__((ext_vector_type(2)));
typedef unsigned u32x4g __attribute__((ext_vector_type(4)));
__device__ __forceinline__ float dot2u(unsigned a, unsigned b, float c) { return __builtin_amdgcn_fdot2_f32_bf16(__builtin_bit_cast(bf2_t, a), __builtin_bit_cast(bf2_t, b), c, false); }
__device__ __forceinline__ float dot8(u32x4g a, u32x4g b, float c) {
    c = dot2u(a[0], b[0], c); c = dot2u(a[1], b[1], c); c = dot2u(a[2], b[2], c); c = dot2u(a[3], b[3], c);
    return c;
}
__device__ __forceinline__ float bflo(unsigned d) { return __builtin_bit_cast(float, d << 16); }
__device__ __forceinline__ float bfhi(unsigned d) { return __builtin_bit_cast(float, d & 0xffff0000u); }
#define GATHER_U8(EREG, B) do { float s_[8]; \
    _Pragma("unroll") for (int k = 0; k < 8; ++k) { const int idx = __builtin_amdgcn_readlane(EREG, ((B) * 8 + k) & 63); \
        const u32x4g* up = (const u32x4g*)(U + (size_t)idx * DM); const u32x4g u0 = up[lane], u1 = up[64 + lane]; s_[k] = dot8(x1, u1, dot8(x0, u0, 0.f)); } \
    float r_[4]; const bool b5 = lane & 32, b4 = lane & 16, b3 = lane & 8; \
    _Pragma("unroll") for (int i = 0; i < 4; ++i) { const float snd = b5 ? s_[i] : s_[4 + i], kp = b5 ? s_[4 + i] : s_[i]; r_[i] = kp + __shfl_xor(snd, 32); } \
    float q_[2]; \
    _Pragma("unroll") for (int i = 0; i < 2; ++i) { const float snd = b4 ? r_[i] : r_[2 + i], kp = b4 ? r_[2 + i] : r_[i]; q_[i] = kp + __shfl_xor(snd, 16); } \
    float p_; { const float snd = b3 ? q_[0] : q_[1], kp = b3 ? q_[1] : q_[0]; p_ = kp + __shfl_xor(snd, 8); } \
    p_ += __shfl_xor(p_, 4); p_ += __shfl_xor(p_, 2); p_ += __shfl_xor(p_, 1); \
    if ((lane & 7) == 0) al[(B) * 8 + (lane >> 3)] = p_; } while (0)
#define GATHER_V8(EREG, WREG, B) do { \
    _Pragma("unroll") for (int k = 0; k < 8; ++k) { const int idx = __builtin_amdgcn_readlane(EREG, ((B) * 8 + k) & 63); \
        const float w = __builtin_bit_cast(float, __builtin_amdgcn_readlane(__builtin_bit_cast(int, WREG), ((B) * 8 + k) & 63)); \
        const u32x4g* vp = (const u32x4g*)(V + (size_t)idx * DM); const u32x4g v0 = vp[lane], v1 = vp[64 + lane]; \
        acc[0] += w * bflo(v0.x); acc[1] += w * bfhi(v0.x); acc[2] += w * bflo(v0.y); acc[3] += w * bfhi(v0.y); \
        acc[4] += w * bflo(v0.z); acc[5] += w * bfhi(v0.z); acc[6] += w * bflo(v0.w); acc[7] += w * bfhi(v0.w); \
        acc[8] += w * bflo(v1.x); acc[9] += w * bfhi(v1.x); acc[10] += w * bflo(v1.y); acc[11] += w * bfhi(v1.y); \
        acc[12] += w * bflo(v1.z); acc[13] += w * bfhi(v1.z); acc[14] += w * bflo(v1.w); acc[15] += w * bfhi(v1.w); } } while (0)
__device__ __forceinline__ void ph_peer_gather_opt(const int* eidx, const float* gw, const bf16* U, const bf16* V, float* h, const float* gain_next, bf16* XN, unsigned char* smem) {
    const int tid = tidx(), lane = tid & 63, wave = tid >> 6;
    float* al = (float*)smem + wave * 128;
    const int gwv = bidx() * (NT / 64) + wave, ngw = gridDim.x * (NT / 64);
    for (int t = gwv; t < T; t += ngw) {
        const u32x4g x0 = *(const u32x4g*)(XN + (size_t)t * DM + 8 * lane), x1 = *(const u32x4g*)(XN + (size_t)t * DM + 512 + 8 * lane);
        const int e0 = eidx[(size_t)t * 128 + lane], e1 = eidx[(size_t)t * 128 + 64 + lane];
        const float g0 = gw[(size_t)t * 128 + lane], g1 = gw[(size_t)t * 128 + 64 + lane];
#pragma unroll 1
        for (int b = 0; b < 8; ++b) GATHER_U8(e0, b);
#pragma unroll 1
        for (int b = 8; b < 16; ++b) GATHER_U8(e1, b);
        __builtin_amdgcn_s_waitcnt(0xc07f); asm volatile("" ::: "memory");
        const float w0 = g0 * gelu_tanh(al[lane]), w1 = g1 * gelu_tanh(al[64 + lane]);
        float acc[16];
#pragma unroll
        for (int i = 0; i < 16; ++i) acc[i] = 0.f;
#pragma unroll 1
        for (int b = 0; b < 8; ++b) GATHER_V8(e0, w0, b);
#pragma unroll 1
        for (int b = 8; b < 16; ++b) GATHER_V8(e1, w1, b);
        float* hp = h + (size_t)t * DM + 8 * lane;
        f32x4 h0 = *(f32x4*)(hp), h1 = *(f32x4*)(hp + 4), h2 = *(f32x4*)(hp + 512), h3 = *(f32x4*)(hp + 516);
        h0 += (f32x4){acc[0], acc[1], acc[2], acc[3]}; h1 += (f32x4){acc[4], acc[5], acc[6], acc[7]};
        h2 += (f32x4){acc[8], acc[9], acc[10], acc[11]}; h3 += (f32x4){acc[12], acc[13], acc[14], acc[15]};
        *(f32x4*)(hp) = h0; *(f32x4*)(hp + 4) = h1; *(f32x4*)(hp + 512) = h2; *(f32x4*)(hp + 516) = h3;
        float ss = 0.f;
#pragma unroll
        for (int i = 0; i < 4; ++i) ss += h0[i] * h0[i] + h1[i] * h1[i] + h2[i] * h2[i] + h3[i] * h3[i];
        const float rstd = 1.0f / sqrtf(wave_sum(ss) * (1.0f / DM) + NORM_EPS);
        const f32x4 ga = *(const f32x4*)(gain_next + 8 * lane), gb = *(const f32x4*)(gain_next + 8 * lane + 4), gc = *(const f32x4*)(gain_next + 512 + 8 * lane), gd = *(const f32x4*)(gain_next + 516 + 8 * lane);
        u32x4g o0, o1;
        o0.x = pk2(h0[0] * rstd * ga[0], h0[1] * rstd * ga[1]); o0.y = pk2(h0[2] * rstd * ga[2], h0[3] * rstd * ga[3]);
        o0.z = pk2(h1[0] * rstd * gb[0], h1[1] * rstd * gb[1]); o0.w = pk2(h1[2] * rstd * gb[2], h1[3] * rstd * gb[3]);
        o1.x = pk2(h2[0] * rstd * gc[0], h2[1] * rstd * gc[1]); o1.y = pk2(h2[2] * rstd * gc[2], h2[3] * rstd * gc[3]);
        o1.z = pk2(h3[0] * rstd * gd[0], h3[1] * rstd * gd[1]); o1.w = pk2(h3[2] * rstd * gd[2], h3[3] * rstd * gd[3]);
        *(u32x4g*)(XN + (size_t)t * DM + 8 * lane) = o0; *(u32x4g*)(XN + (size_t)t * DM + 512 + 8 * lane) = o1;
    }
}


typedef short bf16x8r __attribute__((ext_vector_type(8)));
typedef float f32x16r __attribute__((ext_vector_type(16)));
__device__ __forceinline__ float unokey(unsigned k) { const unsigned u = (k & 0x80000000u) ? (k & 0x7fffffffu) : ~k; return __builtin_bit_cast(float, u); }
#define CE_D(a, b) do { const unsigned mx_ = max(a, b), mn_ = min(a, b); a = mx_; b = mn_; } while (0)
#define SORT16_DESC(v, base) do { \
    _Pragma("unroll") for (int k_ = 2; k_ <= 16; k_ <<= 1) \
    _Pragma("unroll") for (int j_ = k_ >> 1; j_ > 0; j_ >>= 1) \
    _Pragma("unroll") for (int i_ = 0; i_ < 16; ++i_) { const int l_ = i_ ^ j_; if (l_ > i_) { if ((i_ & k_) == 0) CE_D(v[(base) + i_], v[(base) + l_]); else CE_D(v[(base) + l_], v[(base) + i_]); } } } while (0)
#define BMERGE16_DESC(v, base) do { \
    _Pragma("unroll") for (int j_ = 8; j_ > 0; j_ >>= 1) \
    _Pragma("unroll") for (int i_ = 0; i_ < 16; ++i_) { const int l_ = i_ ^ j_; if (l_ > i_) CE_D(v[(base) + i_], v[(base) + l_]); } } while (0)
#define TOPMERGE16(v, a, b) do { _Pragma("unroll") for (int i_ = 0; i_ < 16; ++i_) v[(a) + i_] = max(v[(a) + i_], v[(b) + 15 - i_]); BMERGE16_DESC(v, a); } while (0)
#define PARTNER_TOP16(v) do { unsigned o_[16]; _Pragma("unroll") for (int i_ = 0; i_ < 16; ++i_) o_[i_] = (unsigned)__shfl_xor((int)v[15 - i_], 32); \
    _Pragma("unroll") for (int i_ = 0; i_ < 16; ++i_) v[i_] = max(v[i_], o_[i_]); BMERGE16_DESC(v, 0); } while (0)
constexpr int SK_ROW = 272;
__device__ __forceinline__ void ph_peer_route_opt(const bf16* qry, const bf16* subk, int* eidx, float* gw, unsigned char* smem) {
    const int tid = tidx(), lane = tid & 63, wave = tid >> 6, r32 = lane & 31, hi = lane >> 5;
    for (int unit = bidx(); unit < 512; unit += gridDim.x) {
        const int h = unit & 7, tb = unit >> 3;
        __syncthreads();
        for (int i = tid; i < 4096; i += NT) { const int row = i >> 4, ch = i & 15;
            *(u32x4g*)(smem + row * SK_ROW + ch * 16) = *(const u32x4g*)(subk + ((size_t)(h * 2) * 128 + row) * 128 + ch * 8); }
        __syncthreads();
        const int trow = tb * 256 + wave * 32 + r32;
        unsigned top[2][16];
#pragma unroll
        for (int c = 0; c < 2; ++c) {
            f32x16r acc[4];
#pragma unroll
            for (int kb = 0; kb < 4; ++kb) acc[kb] = (f32x16r){0.f, 0.f, 0.f, 0.f, 0.f, 0.f, 0.f, 0.f, 0.f, 0.f, 0.f, 0.f, 0.f, 0.f, 0.f, 0.f};
#pragma unroll
            for (int ks = 0; ks < 8; ++ks) {
                const bf16x8r bq = *(const bf16x8r*)(qry + (size_t)trow * 2048 + h * 256 + c * 128 + ks * 16 + 8 * hi);
#pragma unroll
                for (int kb = 0; kb < 4; ++kb) {
                    const bf16x8r ak = *(const bf16x8r*)(smem + (c * 128 + kb * 32 + r32) * SK_ROW + (ks * 16 + 8 * hi) * 2);
                    acc[kb] = __builtin_amdgcn_mfma_f32_32x32x16_bf16(ak, bq, acc[kb], 0, 0, 0);
                }
            }
            unsigned k[64];
#pragma unroll
            for (int kb = 0; kb < 4; ++kb)
#pragma unroll
                for (int r = 0; r < 16; ++r) { const float sc = acc[kb][r]; const int idx = kb * 32 + (r & 3) + 8 * (r >> 2) + 4 * hi;
                    k[kb * 16 + r] = (okey(sc) & 0xffffff80u) | (unsigned)(127 - idx); }
            SORT16_DESC(k, 0); SORT16_DESC(k, 16); SORT16_DESC(k, 32); SORT16_DESC(k, 48);
            TOPMERGE16(k, 0, 16); TOPMERGE16(k, 32, 48); TOPMERGE16(k, 0, 32);
            PARTNER_TOP16(k);
#pragma unroll
            for (int i = 0; i < 16; ++i) top[c][i] = k[i];
        }
        float va[16], vb[16];
#pragma unroll
        for (int i = 0; i < 16; ++i) { va[i] = unokey((top[0][i] & 0xffffff80u) | 0x40u); vb[i] = unokey((top[1][i] & 0xffffff80u) | 0x40u); }
        unsigned ck[32];
        ck[0] = (okey(hi ? (va[2] + vb[1]) : (va[0] + vb[0])) & 0xffffff00u) | (hi ? 222u : 255u);
        ck[1] = (okey(hi ? (va[2] + vb[2]) : (va[0] + vb[1])) & 0xffffff00u) | (hi ? 221u : 254u);
        ck[2] = (okey(hi ? (va[2] + vb[3]) : (va[0] + vb[2])) & 0xffffff00u) | (hi ? 220u : 253u);
        ck[3] = (okey(hi ? (va[2] + vb[4]) : (va[0] + vb[3])) & 0xffffff00u) | (hi ? 219u : 252u);
        ck[4] = (okey(hi ? (va[3] + vb[0]) : (va[0] + vb[4])) & 0xffffff00u) | (hi ? 207u : 251u);
        ck[5] = (okey(hi ? (va[3] + vb[1]) : (va[0] + vb[5])) & 0xffffff00u) | (hi ? 206u : 250u);
        ck[6] = (okey(hi ? (va[3] + vb[2]) : (va[0] + vb[6])) & 0xffffff00u) | (hi ? 205u : 249u);
        ck[7] = (okey(hi ? (va[3] + vb[3]) : (va[0] + vb[7])) & 0xffffff00u) | (hi ? 204u : 248u);
        ck[8] = (okey(hi ? (va[4] + vb[0]) : (va[0] + vb[8])) & 0xffffff00u) | (hi ? 191u : 247u);
        ck[9] = (okey(hi ? (va[4] + vb[1]) : (va[0] + vb[9])) & 0xffffff00u) | (hi ? 190u : 246u);
        ck[10] = (okey(hi ? (va[4] + vb[2]) : (va[0] + vb[10])) & 0xffffff00u) | (hi ? 189u : 245u);
        ck[11] = (okey(hi ? (va[5] + vb[0]) : (va[0] + vb[11])) & 0xffffff00u) | (hi ? 175u : 244u);
        ck[12] = (okey(hi ? (va[5] + vb[1]) : (va[0] + vb[12])) & 0xffffff00u) | (hi ? 174u : 243u);
        ck[13] = (okey(hi ? (va[6] + vb[0]) : (va[0] + vb[13])) & 0xffffff00u) | (hi ? 159u : 242u);
        ck[14] = (okey(hi ? (va[6] + vb[1]) : (va[0] + vb[14])) & 0xffffff00u) | (hi ? 158u : 241u);
        ck[15] = (okey(hi ? (va[7] + vb[0]) : (va[0] + vb[15])) & 0xffffff00u) | (hi ? 143u : 240u);
        ck[16] = (okey(hi ? (va[7] + vb[1]) : (va[1] + vb[0])) & 0xffffff00u) | (hi ? 142u : 239u);
        ck[17] = (okey(hi ? (va[8] + vb[0]) : (va[1] + vb[1])) & 0xffffff00u) | (hi ? 127u : 238u);
        ck[18] = (okey(hi ? (va[9] + vb[0]) : (va[1] + vb[2])) & 0xffffff00u) | (hi ? 111u : 237u);
        ck[19] = (okey(hi ? (va[10] + vb[0]) : (va[1] + vb[3])) & 0xffffff00u) | (hi ? 95u : 236u);
        ck[20] = (okey(hi ? (va[11] + vb[0]) : (va[1] + vb[4])) & 0xffffff00u) | (hi ? 79u : 235u);
        ck[21] = (okey(hi ? (va[12] + vb[0]) : (va[1] + vb[5])) & 0xffffff00u) | (hi ? 63u : 234u);
        ck[22] = (okey(hi ? (va[13] + vb[0]) : (va[1] + vb[6])) & 0xffffff00u) | (hi ? 47u : 233u);
        ck[23] = (okey(hi ? (va[14] + vb[0]) : (va[1] + vb[7])) & 0xffffff00u) | (hi ? 31u : 232u);
        ck[24] = (okey(hi ? (va[15] + vb[0]) : (va[2] + vb[0])) & 0xffffff00u) | (hi ? 15u : 223u);
#pragma unroll
        for (int s = 25; s < 32; ++s) ck[s] = 0u;
        SORT16_DESC(ck, 0); SORT16_DESC(ck, 16); TOPMERGE16(ck, 0, 16);
        PARTNER_TOP16(ck);
        const float m = unokey((ck[0] & 0xffffff00u) | 0x80u);
        float l = 0.f;
#pragma unroll
        for (int r = 0; r < 16; ++r) l += __expf(unokey((ck[r] & 0xffffff00u) | 0x80u) - m);
        const float linv = 1.0f / l;
        unsigned p0[4], p1[4];
#pragma unroll
        for (int w = 0; w < 4; ++w) { p0[w] = 0u; p1[w] = 0u;
#pragma unroll
            for (int b = 0; b < 4; ++b) { p0[w] |= (127u - (top[0][4 * w + b] & 127u)) << (8 * b); p1[w] |= (127u - (top[1][4 * w + b] & 127u)) << (8 * b); } }
        int eo[8]; float go[8]; const unsigned hmask = 0u - (unsigned)hi;
#pragma unroll
        for (int rr = 0; rr < 8; ++rr) {
            const unsigned key = ck[rr] ^ ((ck[rr] ^ ck[8 + rr]) & hmask);
            const unsigned flat = 255u - (key & 255u), i = flat >> 4, j = flat & 15u;
            const unsigned wi = (i >> 2) == 0 ? p0[0] : ((i >> 2) == 1 ? p0[1] : ((i >> 2) == 2 ? p0[2] : p0[3]));
            const unsigned wj = (j >> 2) == 0 ? p1[0] : ((j >> 2) == 1 ? p1[1] : ((j >> 2) == 2 ? p1[2] : p1[3]));
            const unsigned i0 = (wi >> ((i & 3u) * 8u)) & 255u, i1 = (wj >> ((j & 3u) * 8u)) & 255u;
            eo[rr] = (int)(i0 * 128u + i1);
            go[rr] = __expf(unokey((key & 0xffffff00u) | 0x80u) - m) * linv;
        }
        int* ep = eidx + (size_t)trow * 128 + h * 16 + 8 * hi; float* gp = gw + (size_t)trow * 128 + h * 16 + 8 * hi;
        typedef int i32x4 __attribute__((ext_vector_type(4)));
        *(i32x4*)ep = (i32x4){eo[0], eo[1], eo[2], eo[3]}; *(i32x4*)(ep + 4) = (i32x4){eo[4], eo[5], eo[6], eo[7]};
        *(f32x4*)gp = (f32x4){go[0], go[1], go[2], go[3]}; *(f32x4*)(gp + 4) = (f32x4){go[4], go[5], go[6], go[7]};
    }
}

#ifndef ATTN_STORE16
#define ATTN_STORE16(p,v) (*(u32x4*)(p)=(v))
#endif
namespace attn_g {
typedef unsigned short bf16;
using bf16x8=__attribute__((ext_vector_type(8)))short;
using s16x4=__attribute__((ext_vector_type(4)))short;
using f32x16=__attribute__((ext_vector_type(16)))float;
using u32x4=__attribute__((ext_vector_type(4)))unsigned;
constexpr int D=64;
constexpr int NW=8,QBLK=32,QB=QBLK*NW,KVBLK=64;
__device__ __forceinline__ int crow(int r,int hi){return (r&3)+8*(r>>2)+4*hi;}
#define SBAR() __builtin_amdgcn_sched_barrier(0)
__device__ __forceinline__ void cmask(f32x16&p0,f32x16&p1,int jb,int qrel,int hi){
  const float NEG=-__builtin_inff(); int kb=64*jb+4*hi;
  #pragma unroll
  for(int r=0;r<16;++r){int kv=kb+(r&3)+8*(r>>2); if(kv>qrel)p0[r]=NEG; if(kv+32>qrel)p1[r]=NEG;}
}

constexpr int NSLOT=3, SLOTB=8192;
constexpr int LDS_K=0, LDS_V=NSLOT*SLOTB, LDS_WS=2*NSLOT*SLOTB, LDS_OST=LDS_WS+NW*64*4, LDS_MSK=LDS_OST+NW*4096, LDS_BYTES=LDS_MSK+NW*2*256;
constexpr float C2=0.125f*1.4426950408889634f;
__device__ __forceinline__ void glds16(const void*gsrc,unsigned lds_dst){unsigned keep;
  asm volatile("s_mov_b32 %0, m0\n\ts_mov_b32 m0, %2\n\ts_nop 0\n\tglobal_load_lds_dwordx4 %1, off\n\ts_mov_b32 m0, %0":"=&s"(keep):"v"(gsrc),"s"(lds_dst):"memory");}
__device__ __forceinline__ void glds16s(const void*sbase,unsigned voff,unsigned lds_dst){unsigned keep;
  asm volatile("s_nop 4\n\ts_mov_b32 %0, m0\n\ts_mov_b32 m0, %3\n\ts_nop 0\n\tglobal_load_lds_dwordx4 %1, %2\n\ts_mov_b32 m0, %0":"=&s"(keep):"v"(voff),"s"(sbase),"s"(lds_dst):"memory");}
__device__ __forceinline__ void glds4s(const void*sbase,unsigned voff,unsigned lds_dst){unsigned keep;
  asm volatile("s_nop 4\n\ts_mov_b32 %0, m0\n\ts_mov_b32 m0, %3\n\ts_nop 0\n\tglobal_load_lds_dword %1, %2\n\ts_mov_b32 m0, %0":"=&s"(keep):"v"(voff),"s"(sbase),"s"(lds_dst):"memory");}
__device__ __forceinline__ unsigned bandw(int e){
  const unsigned a=(e<0)?0u:((e>=31)?0xffffffffu:((2u<<e)-1u)); const int f=e-128; const unsigned b=(f<=0)?0u:((f>=32)?0xffffffffu:((1u<<f)-1u)); return a&~b; }
__device__ __forceinline__ float max3f(float a,float b,float c){float r;asm("v_max3_f32 %0, %1, %2, %3":"=v"(r):"v"(a),"v"(b),"v"(c));return r;}
__device__ __forceinline__ float max2f(float a,float b){float r;asm("v_max_f32_e32 %0, %1, %2":"=v"(r):"v"(a),"v"(b));return r;}
__device__ __forceinline__ float fadd_s(float a,float b){float r;asm("v_add_f32_e32 %0, %1, %2":"=v"(r):"v"(a),"v"(b));return r;}
__device__ __forceinline__ float fsub_s(float a,float b){float r;asm("v_sub_f32_e32 %0, %1, %2":"=v"(r):"v"(a),"v"(b));return r;}
typedef float f32x2_t __attribute__((ext_vector_type(2))); typedef __bf16 bf16x2_t __attribute__((ext_vector_type(2)));
__device__ __forceinline__ unsigned cvtpk_s(float lo,float hi){f32x2_t v={lo,hi};bf16x2_t b=__builtin_convertvector(v,bf16x2_t);return __builtin_bit_cast(unsigned,b);}
#define WAIT_BAR(N) asm volatile("s_waitcnt vmcnt(" #N ") lgkmcnt(0)\n\ts_barrier":::"memory")

template<bool NEGM> __device__ __forceinline__ void qkt(f32x16&p0,f32x16&p1,const char*Kslot,const bf16x8*qr,const f32x16&negm,int r32,int hi){ const f32x16 zc_={};
  const char*kb=Kslot+hi*1024+r32*16;
  #pragma unroll
  for(int d0=0;d0<4;++d0){
    const bf16x8 b0=*reinterpret_cast<const bf16x8*>(kb+d0*2048);
    const bf16x8 b1=*reinterpret_cast<const bf16x8*>(kb+d0*2048+512);
    if(d0==0){p0=__builtin_amdgcn_mfma_f32_32x32x16_bf16(b0,qr[0],NEGM?negm:zc_,0,0,0);p1=__builtin_amdgcn_mfma_f32_32x32x16_bf16(b1,qr[0],NEGM?negm:zc_,0,0,0);}
    else{p0=__builtin_amdgcn_mfma_f32_32x32x16_bf16(b0,qr[d0],p0,0,0,0);p1=__builtin_amdgcn_mfma_f32_32x32x16_bf16(b1,qr[d0],p1,0,0,0);}}
}
typedef __attribute__((address_space(3))) const char* lds_cptr;
typedef short v4i16_t __attribute__((ext_vector_type(4)));
__device__ __forceinline__ void kload8(bf16x8*kf,lds_cptr kp){
  kf[0]=*(const __attribute__((address_space(3))) bf16x8*)(kp);      kf[1]=*(const __attribute__((address_space(3))) bf16x8*)(kp+512);
  kf[2]=*(const __attribute__((address_space(3))) bf16x8*)(kp+2048); kf[3]=*(const __attribute__((address_space(3))) bf16x8*)(kp+2560);
  kf[4]=*(const __attribute__((address_space(3))) bf16x8*)(kp+4096); kf[5]=*(const __attribute__((address_space(3))) bf16x8*)(kp+4608);
  kf[6]=*(const __attribute__((address_space(3))) bf16x8*)(kp+6144); kf[7]=*(const __attribute__((address_space(3))) bf16x8*)(kp+6656);
}
__device__ __forceinline__ void kload2(bf16x8*kf,lds_cptr kp,int j){ kf[2*j]=*(const __attribute__((address_space(3))) bf16x8*)(kp+j*2048); kf[2*j+1]=*(const __attribute__((address_space(3))) bf16x8*)(kp+j*2048+512); }
__device__ __forceinline__ s16x4 vtr(lds_cptr p){ return __builtin_bit_cast(s16x4,__builtin_amdgcn_ds_read_tr16_b64_v4i16((__attribute__((address_space(3))) v4i16_t*)p)); }
__device__ __forceinline__ float rowmax(const f32x16&p0,const f32x16&p1){
  float a=max3f(p0[0],p0[1],p1[0]),b=max3f(p0[2],p0[3],p1[1]);a=max3f(a,p1[2],p1[3]);
  #pragma unroll
  for(int r=4;r<16;r+=4){a=max3f(a,p0[r],p0[r+1]);b=max3f(b,p0[r+2],p0[r+3]);a=max3f(a,p1[r],p1[r+1]);b=max3f(b,p1[r+2],p1[r+3]);}
  const float m=max2f(a,b);
  auto rr=__builtin_amdgcn_permlane32_swap(__float_as_uint(m),__float_as_uint(m),false,false);
  return max2f(__uint_as_float(rr[0]),__uint_as_float(rr[1]));
}
__device__ __forceinline__ void pv(f32x16*o,int vb,bf16x8 pa0,bf16x8 pa1,bf16x8 pa2,bf16x8 pa3){
  #pragma unroll
  for(int d0=0;d0<2;++d0){s16x4 lo[4],hi[4];
    #pragma unroll
    for(int ks=0;ks<4;++ks){
      asm volatile("ds_read_b64_tr_b16 %0,%1 offset:%c2":"=&v"(lo[ks]):"v"(vb),"i"(d0*4096+ks*1024):"memory");
      asm volatile("ds_read_b64_tr_b16 %0,%1 offset:%c2":"=&v"(hi[ks]):"v"(vb),"i"(d0*4096+ks*1024+512):"memory");}
    asm volatile("s_waitcnt lgkmcnt(0)":::"memory");SBAR();
    #define PK(k) (bf16x8){lo[k][0],lo[k][1],lo[k][2],lo[k][3],hi[k][0],hi[k][1],hi[k][2],hi[k][3]}
    o[d0]=__builtin_amdgcn_mfma_f32_32x32x16_bf16(pa0,PK(0),o[d0],0,0,0);
    o[d0]=__builtin_amdgcn_mfma_f32_32x32x16_bf16(pa1,PK(1),o[d0],0,0,0);
    o[d0]=__builtin_amdgcn_mfma_f32_32x32x16_bf16(pa2,PK(2),o[d0],0,0,0);
    o[d0]=__builtin_amdgcn_mfma_f32_32x32x16_bf16(pa3,PK(3),o[d0],0,0,0);
    #undef PK
  }
}

#ifndef ATTN_STORE16
#define ATTN_STORE16(p,v) (*(u32x4*)(p)=(v))
#endif
template<int MODE,int THRL> __device__ __forceinline__ void attn_unit(const bf16*Qu,long qs,const bf16*__restrict__ Kh,const bf16*__restrict__ Vh,long kvs,bf16*Ou,long os,float*lse,long lses,const int NT,
    const unsigned*selp,const char*Msrc,const int e0,char*shm){
  constexpr bool USE_NEGM=(MODE==0);
  const int tid=tidx(),lane=tid&63,r32=lane&31,hi=lane>>5; const int wid=__builtin_amdgcn_readfirstlane(tid>>6);
  const bf16*Qw=Qu+(long)(wid*QBLK)*qs;
  const unsigned lds0=(unsigned)(uintptr_t)shm;
  float*wsf=(float*)(shm+LDS_WS)+wid*64;
  const unsigned kvoff=(unsigned)(((int)lane*(int)kvs+wid*8)*2);
  const unsigned vvoff=(unsigned)(((16*(wid&3)+(lane>>2))*(int)kvs+(wid>>2)*32+(lane&3)*8)*2);
  const unsigned kdst=lds0+LDS_K+wid*1024, vdst=lds0+LDS_V+wid*1024;
  #define KT(t) ((MODE==0)?(((t)<4)?(NT-4+(t)):((t)-4)):(t))
  #define DMA_K(t,slot) glds16s((const char*)Kh+(long)KT(t)*(KVBLK*2)*kvs,kvoff,(unsigned)__builtin_amdgcn_readfirstlane(kdst+(slot)))
  #define DMA_V(t,slot) glds16s((const char*)Vh+(long)KT(t)*(KVBLK*2)*kvs,vvoff,(unsigned)__builtin_amdgcn_readfirstlane(vdst+(slot)))
  const unsigned mvoff=(unsigned)((wid*QBLK)*8+lane*4); const unsigned mdst=lds0+LDS_MSK+wid*512;
  #define DMA_M(t) do{ if(MODE==1) glds4s(Msrc+(long)(t)*(8192*8),mvoff,(unsigned)__builtin_amdgcn_readfirstlane(mdst+((t)&1)*256)); }while(0)
  const int vb0=(int)(lds0+LDS_V)+((lane>>4)&1)*32+(lane&3)*8+(4*hi+((lane&15)>>2))*64;
  const char*Kbase=shm+LDS_K; bf16x8 kf[8];
  const lds_cptr shm3=(lds_cptr)shm; const lds_cptr kp0=shm3+LDS_K+hi*1024+r32*16; const lds_cptr vp0=shm3+LDS_V+((lane>>4)&1)*32+(lane&3)*8+(4*hi+((lane&15)>>2))*64;
  DMA_M(0);DMA_M(1);
  DMA_K(0,0);DMA_V(0,0);DMA_K(1,SLOTB);
  bf16x8 qr[4];
  #pragma unroll
  for(int d0=0;d0<4;++d0)qr[d0]=*reinterpret_cast<const bf16x8*>(&Qw[(long)r32*qs+d0*16+hi*8]);
  unsigned selw=0u; if(MODE==0) selw=selp[(long)(wid*QBLK+r32)*8];
  float mhat=0.f,l_reg=0.f;f32x16 o[2];f32x16 negm; { float zz_=0.f; asm volatile("":"+v"(zz_));
    _Pragma("unroll") for(int r=0;r<16;++r){o[0][r]=zz_;o[1][r]=zz_;negm[r]=zz_;} } if(USE_NEGM) asm volatile("":"+v"(negm));
  const int qrel=wid*QBLK+r32;
  #define CMASK(P0,P1,t) do{ const float NEG_=-__builtin_inff(); \
    if(MODE==0){ if((t)<4){cmask(P0,P1,(t),qrel,hi);} else { const unsigned n_=(unsigned)(((t)-4)>>2); const bool ok_=(n_==(selw&255u))|(n_==((selw>>8)&255u))|(n_==((selw>>16)&255u)); \
        _Pragma("unroll") for(int r=0;r<16;++r){P0[r]=ok_?P0[r]:NEG_;P1[r]=ok_?P1[r]:NEG_;} } } \
    else if(MODE==1){ const unsigned long long mw_=*(const __attribute__((address_space(3))) unsigned long long*)(shm3+LDS_MSK+wid*512+((t)&1)*256+r32*8); \
        const unsigned lo_=((unsigned)mw_)>>(4*hi), hh_=((unsigned)(mw_>>32))>>(4*hi); \
        _Pragma("unroll") for(int r=0;r<16;++r){ const unsigned bit_=1u<<((r&3)+8*(r>>2)); P0[r]=(lo_&bit_)?(P0[r]-mhat):NEG_; P1[r]=(hh_&bit_)?(P1[r]-mhat):NEG_; } } \
    else { const int e_=e0-64*(t)+qrel-4*hi; const unsigned lo_=bandw(e_), hh_=bandw(e_-32);     \
        _Pragma("unroll") for(int r=0;r<16;++r){ const unsigned bit_=1u<<((r&3)+8*(r>>2)); P0[r]=(lo_&bit_)?(P0[r]-mhat):NEG_; P1[r]=(hh_&bit_)?(P1[r]-mhat):NEG_; } } }while(0)
  bool resc=false;
  #define START(P0,P1) do{ const float rm=rowmax(P0,P1); resc=false; \
    { const float dl=(rm<-1e30f)?0.f:rm; mhat=fadd_s(mhat,dl); \
      _Pragma("unroll") for(int r=0;r<16;++r){P0[r]=fsub_s(P0[r],dl);P1[r]=fsub_s(P1[r],dl);} \
      if(USE_NEGM){ _Pragma("unroll") for(int r=0;r<16;++r)negm[r]=-mhat; asm volatile("":"+v"(negm)); } } \
    _Pragma("unroll") for(int r=0;r<16;++r)P0[r]=__builtin_amdgcn_exp2f(P0[r]); }while(0)
  #define RESC() do{ if(resc){ asm volatile("s_waitcnt lgkmcnt(0)":::"memory"); \
      _Pragma("unroll") for(int d_=0;d_<2;++d_) _Pragma("unroll") for(int r=0;r<16;++r)o[d_][r]*=wsf[crow(r,hi)]; } }while(0)
  f32x16 pA0,pA1,pB0,pB1; const f32x16 zc16={};
  int sl_prev=0,sl_cur=0,sl_next=SLOTB;
  #define ROT() do{sl_prev=sl_cur;sl_cur=sl_next;sl_next=(sl_next==(NSLOT-1)*SLOTB)?0:sl_next+SLOTB;}while(0)
  DMA_K(2,2*SLOTB);
  WAIT_BAR(3);
  qkt<USE_NEGM>(pA0,pA1,Kbase,qr,negm,r32,hi);asm volatile("s_nop 15\n\ts_nop 7":"+v"(pA0),"+v"(pA1));CMASK(pA0,pA1,0);
  START(pA0,pA1);
  _Pragma("unroll") for(int r=0;r<16;++r)pA1[r]=__builtin_amdgcn_exp2f(pA1[r]);
  WAIT_BAR(0);
  DMA_K(3,0);DMA_V(1,SLOTB);
  ROT();
  kload8(kf,kp0+sl_cur);
  WAIT_BAR(2);
  s16x4 vlo[8],vhi[8]; u32x4 pw0,pw1,pw2,pw3;
  #define PKW(P,B) cvtpk_s(P[B],P[B+1])
  #define PAF(k) __builtin_bit_cast(bf16x8,pw##k)
  #define VFR(i) (bf16x8){vlo[i][0],vlo[i][1],vlo[i][2],vlo[i][3],vhi[i][0],vhi[i][1],vhi[i][2],vhi[i][3]}
  #define PIN(x) asm volatile("":"+v"(x))
  #define MX3(a,b,c) __builtin_fmaxf(__builtin_fmaxf((a),(b)),(c))
  #define GAPA(MF,A0,A1,A2,A3,W0,W1,PW) do{ MF; sacc+=A0; sacc+=A1; sacc+=A2; sacc+=A3; PIN(sacc); W0; W1; PIN(PW); SBAR(); }while(0)
  #define EX(v) __builtin_amdgcn_exp2f(v)
  #define GAPB(MF,X,B) do{ MF; X[B]=EX(X[B]); X[B+1]=EX(X[B+1]); X[B+2]=EX(X[B+2]); X[B+3]=EX(X[B+3]); PIN(X); SBAR(); }while(0)
  #define VRD(i) do{ vlo[i]=vtr(vp_+(((i)>>2)*4096+((i)&3)*1024)); vhi[i]=vtr(vp_+(((i)>>2)*4096+((i)&3)*1024+512)); }while(0)
  #define KRD(G,j) do{ if(G){ kload2(kf,kp0+sl_next,j); SBAR(); } }while(0)
  #define STEP(C0,C1,P0,P1,t,GK,GV,GL) do{ SBAR(); if((t)+1<NT){DMA_M((t)+1);} \
    const lds_cptr vp_=vp0+sl_prev; \
    VRD(0); SBAR(); float sacc=(P0[0]+P0[1]); \
    GAPA(C0=__builtin_amdgcn_mfma_f32_32x32x16_bf16(kf[0],qr[0],USE_NEGM?negm:zc16,0,0,0), P0[2],P0[3],P0[4],P0[5],     pw0[0]=PKW(P0,0), pw0[1]=PKW(P0,2), pw0); \
    VRD(4); SBAR(); GAPA(C1=__builtin_amdgcn_mfma_f32_32x32x16_bf16(kf[1],qr[0],USE_NEGM?negm:zc16,0,0,0), P0[6],P0[7],P0[8],P0[9],     pw0[2]=PKW(P0,4), pw0[3]=PKW(P0,6), pw0); \
    VRD(1); SBAR(); GAPA(C0=__builtin_amdgcn_mfma_f32_32x32x16_bf16(kf[2],qr[1],C0,0,0,0),   P0[10],P0[11],P0[12],P0[13], pw1[0]=PKW(P0,8), pw1[1]=PKW(P0,10), pw1); \
    VRD(5); SBAR(); GAPA(C1=__builtin_amdgcn_mfma_f32_32x32x16_bf16(kf[3],qr[1],C1,0,0,0),   P0[14],P0[15],P1[0],P1[1],   pw1[2]=PKW(P0,12),pw1[3]=PKW(P0,14), pw1); \
    VRD(2); SBAR(); GAPA(C0=__builtin_amdgcn_mfma_f32_32x32x16_bf16(kf[4],qr[2],C0,0,0,0),   P1[2],P1[3],P1[4],P1[5],     pw2[0]=PKW(P1,0), pw2[1]=PKW(P1,2), pw2); \
    VRD(6); SBAR(); GAPA(C1=__builtin_amdgcn_mfma_f32_32x32x16_bf16(kf[5],qr[2],C1,0,0,0),   P1[6],P1[7],P1[8],P1[9],     pw2[2]=PKW(P1,4), pw2[3]=PKW(P1,6), pw2); \
    VRD(3); SBAR(); GAPA(C0=__builtin_amdgcn_mfma_f32_32x32x16_bf16(kf[6],qr[3],C0,0,0,0),   P1[10],P1[11],P1[12],P1[13], pw3[0]=PKW(P1,8), pw3[1]=PKW(P1,10), pw3); \
    VRD(7); SBAR(); GAPA(C1=__builtin_amdgcn_mfma_f32_32x32x16_bf16(kf[7],qr[3],C1,0,0,0),   P1[14],P1[15],0.f,0.f,       pw3[2]=PKW(P1,12),pw3[3]=PKW(P1,14), pw3); \
    l_reg+=sacc; \
    if(GK){DMA_K((t)+3,sl_cur);} if(GV){DMA_V((t)+1,sl_next);} \
    CMASK(C0,C1,t); \
    { float a=MX3(C0[0],C0[1],C1[0]),b=MX3(C0[2],C0[3],C1[1]); a=MX3(a,C1[2],C1[3]); \
      _Pragma("unroll") for(int r=4;r<16;r+=4){a=MX3(a,C0[r],C0[r+1]);b=MX3(b,C0[r+2],C0[r+3]);a=MX3(a,C1[r],C1[r+1]);b=MX3(b,C1[r+2],C1[r+3]);} \
      float rm=__builtin_fmaxf(a,b); { auto rr=__builtin_amdgcn_permlane32_swap(__float_as_uint(rm),__float_as_uint(rm),false,false); rm=__builtin_fmaxf(__uint_as_float(rr[0]),__uint_as_float(rr[1])); } \
      resc=false; \
      if(__builtin_expect(__any(rm>(float)THRL),0)){ const float dl=__builtin_fmaxf(rm,0.f); mhat+=dl; \
        _Pragma("unroll") for(int r=0;r<16;++r){C0[r]-=dl;C1[r]-=dl;} \
        if(USE_NEGM){ _Pragma("unroll") for(int r=0;r<16;++r)negm[r]=-mhat; asm volatile("":"+v"(negm)); } \
        const float f=__builtin_amdgcn_exp2f(-dl); l_reg*=f; if(hi==0)wsf[r32]=f; resc=true; } } \
    SBAR(); \
    GAPB(o[0]=__builtin_amdgcn_mfma_f32_32x32x16_bf16(PAF(0),VFR(0),o[0],0,0,0), C0,0); \
    GAPB(o[1]=__builtin_amdgcn_mfma_f32_32x32x16_bf16(PAF(0),VFR(4),o[1],0,0,0), C0,4); \
    KRD(GL,0); GAPB(o[0]=__builtin_amdgcn_mfma_f32_32x32x16_bf16(PAF(1),VFR(1),o[0],0,0,0), C0,8); \
    KRD(GL,1); GAPB(o[1]=__builtin_amdgcn_mfma_f32_32x32x16_bf16(PAF(1),VFR(5),o[1],0,0,0), C0,12); \
    KRD(GL,2); GAPB(o[0]=__builtin_amdgcn_mfma_f32_32x32x16_bf16(PAF(2),VFR(2),o[0],0,0,0), C1,0); \
    KRD(GL,3); GAPB(o[1]=__builtin_amdgcn_mfma_f32_32x32x16_bf16(PAF(2),VFR(6),o[1],0,0,0), C1,4); \
    GAPB(o[0]=__builtin_amdgcn_mfma_f32_32x32x16_bf16(PAF(3),VFR(3),o[0],0,0,0), C1,8); \
    GAPB(o[1]=__builtin_amdgcn_mfma_f32_32x32x16_bf16(PAF(3),VFR(7),o[1],0,0,0), C1,12); \
    }while(0)
  int t=1;
  for(;t+5<NT;t+=2){
    STEP(pB0,pB1,pA0,pA1,t,true,true,true);     WAIT_BAR(2); RESC(); ROT();
    STEP(pA0,pA1,pB0,pB1,t+1,true,true,true);   WAIT_BAR(2); RESC(); ROT();
  }
  #define ENDW(tt) do{ if((tt)+3<NT){WAIT_BAR(2);} else if((tt)+2<NT){WAIT_BAR(1);} else {WAIT_BAR(0);} }while(0)
  for(;t+1<NT;t+=2){
    STEP(pB0,pB1,pA0,pA1,t,(t+3<NT),(t+1<NT),(t+1<NT));       ENDW(t);   RESC(); ROT();
    STEP(pA0,pA1,pB0,pB1,t+1,(t+4<NT),(t+2<NT),(t+2<NT));     ENDW(t+1); RESC(); ROT();
  }
  STEP(pB0,pB1,pA0,pA1,NT-1,false,false,false); RESC();
  { float sacc=pB0[0]+pB0[1]; _Pragma("unroll") for(int r=2;r<16;++r)sacc+=pB0[r]; _Pragma("unroll") for(int r=0;r<16;++r)sacc+=pB1[r]; l_reg+=sacc;
    pw0=(u32x4){PKW(pB0,0),PKW(pB0,2),PKW(pB0,4),PKW(pB0,6)};pw1=(u32x4){PKW(pB0,8),PKW(pB0,10),PKW(pB0,12),PKW(pB0,14)};pw2=(u32x4){PKW(pB1,0),PKW(pB1,2),PKW(pB1,4),PKW(pB1,6)};pw3=(u32x4){PKW(pB1,8),PKW(pB1,10),PKW(pB1,12),PKW(pB1,14)};
    SBAR(); pv(o,vb0+sl_cur,PAF(0),PAF(1),PAF(2),PAF(3)); }
  #undef PKW
  #undef PAF
  #undef VFR
  #undef PIN
  #undef MX3
  #undef GAPA
  #undef GAPB
  #undef EX
  #undef VRD
  #undef KRD
  #undef STEP
  #undef ENDW
  {auto rr=__builtin_amdgcn_permlane32_swap(__float_as_uint(l_reg),__float_as_uint(l_reg),false,false);l_reg=__uint_as_float(rr[0])+__uint_as_float(rr[1]);}
  if(hi==0)wsf[32+r32]=l_reg;asm volatile("s_waitcnt lgkmcnt(0)":::"memory");
  float rli[16];
  #pragma unroll
  for(int r=0;r<16;++r)rli[r]=__builtin_amdgcn_rcpf(wsf[32+crow(r,hi)]);
  long os2=os,lses2=lses; asm volatile("":"+s"(os2),"+s"(lses2));
  if(lse!=nullptr && hi==0) lse[(long)(wid*QBLK+r32)*lses2]=mhat+__log2f(l_reg);
  bf16*Ow=Ou+(long)(wid*QBLK)*os2;
  { bf16*stg=(bf16*)(shm+LDS_OST)+wid*2048;
    #pragma unroll
    for(int r=0;r<16;++r){const int orow=crow(r,hi);
      #pragma unroll
      for(int d0=0;d0<2;++d0)stg[orow*64+d0*32+r32]=(bf16)f2bf(o[d0][r]*rli[r]);}
    asm volatile("s_waitcnt lgkmcnt(0)":::"memory");
    #pragma unroll
    for(int i=0;i<4;++i){const int row=i*8+(lane>>3),ch=lane&7; const u32x4 v=*(const u32x4*)(stg+row*64+ch*8); ATTN_STORE16(Ow+(long)row*os2+ch*8,v);} }
  asm volatile("s_waitcnt lgkmcnt(0)\n\ts_barrier":::"memory");
  #undef DMA_K
  #undef DMA_V
  #undef DMA_M
  #undef KT
  #undef CMASK
  #undef START
  #undef RESC
  #undef ROT
}
constexpr int ATTN_LDS_BYTES=LDS_BYTES;
#undef SBAR
#undef WAIT_BAR
}

__device__ __forceinline__ int vcu_of(int G, int bx) { return (G % 8 == 0) ? (bx % 8) * (G / 8) + bx / 8 : bx; }
__device__ __forceinline__ void ph_attn_moba(const bf16* QKV, const unsigned* SEL, bf16* O, unsigned char* smem) {
    const int G = (int)gridDim.x, vcu = vcu_of(G, bidx());
#pragma unroll 1
    for (int idx = 2 * vcu; idx < 512; idx += ((idx & 1) ? 2 * G - 1 : 1)) {
        const int bh = idx >> 5, j = idx & 31, qb = (j & 1) ? 31 - (j >> 1) : (j >> 1), b = bh >> 3, h = bh & 7;
        const long row0 = (long)b * SEQ + 256 * qb, kv0 = (long)b * SEQ * AB_LD;
        attn_g::attn_unit<0, 8>(QKV + row0 * AB_LD + CQA + h * 64, AB_LD, QKV + kv0 + CKA + h * 64, QKV + kv0 + CVA + h * 64, AB_LD, O + row0 * DM + h * 64, DM, nullptr, 0, 4 * qb + 4,
                                SEL + row0 * 8 + h, nullptr, 0, (char*)smem);
    }
}


__device__ __forceinline__ void ph_attn_dsa(const bf16* QKV, const unsigned long long* MASK, bf16* O, unsigned char* smem) {
    const int G = (int)gridDim.x, vcu = vcu_of(G, bidx());
#pragma unroll 1
    for (int idx = 2 * vcu; idx < 512; idx += ((idx & 1) ? 2 * G - 1 : 1)) {
        const int bh = idx >> 5, j = idx & 31, qb = (j & 1) ? 31 - (j >> 1) : (j >> 1), b = bh >> 3, h = bh & 7;
        const long row0 = (long)b * SEQ + 256 * qb, kv0 = (long)b * SEQ * AB_LD;
        attn_g::attn_unit<1, 8>(QKV + row0 * AB_LD + CQB + h * 64, AB_LD, QKV + kv0 + CKB + h * 64, QKV + kv0 + CVB + h * 64, AB_LD, O + row0 * DM + 512 + h * 64, DM, nullptr, 0, 4 * qb + 4,
                                nullptr, (const char*)(MASK + (size_t)b * 128 * SEQ + 256 * qb), 0, (char*)smem);
    }
}
__device__ __forceinline__ void ph_attn_dilated(const bf16* QKV1, bf16* OG, float* LSE, unsigned char* smem) {
    const int G = (int)gridDim.x, vcu = vcu_of(G, bidx());
#pragma unroll 1
    for (int u = vcu; u < 3072; u += G) {
        const int g = u >> 10, bh = (u >> 5) & 31, j = u & 31, b = bh >> 4, h = bh & 15;
        const int lg = 2 * g, dil = 1 << lg, per = 32 >> lg;
        const int res = j / per, mb = j % per, m0 = 256 * mb, mk0 = (mb == 0) ? 0 : m0 - 128, nt = (m0 + 256 - mk0) / 64;
        const long qrow = (long)b * SEQ + res + (long)dil * m0, krow = (long)b * SEQ + res + (long)dil * mk0;
        attn_g::attn_unit<2, 8>(QKV1 + qrow * C_LD + h * 64, (long)dil * C_LD, QKV1 + krow * C_LD + 1024 + h * 64, QKV1 + krow * C_LD + 2048 + h * 64, (long)dil * C_LD,
                                OG + ((size_t)g * T + qrow) * DM + h * 64, (long)dil * DM, LSE + ((size_t)g * T + qrow) * 16 + h, (long)dil * 16, nt, nullptr, nullptr, m0 - mk0, (char*)smem);
    }
}


__device__ __forceinline__ size_t score_base(int b, int qb) { return (size_t)65536 * (size_t)(528 * b + (qb * (qb + 1)) / 2); }
__device__ __forceinline__ void ph_dsa_score(const bf16* QKV, float* S, unsigned char* smem) {
    using attn_g::bf16x8; using attn_g::f32x16;
    typedef __attribute__((address_space(3))) const char* lcp;
    const int tid = tidx(), lane = tid & 63, r32 = lane & 31, hi = lane >> 5; const int wid = __builtin_amdgcn_readfirstlane(tid >> 6);
    const unsigned lds0 = (unsigned)(uintptr_t)smem;
    const unsigned kvoff = (unsigned)((lane * AB_LD + wid * 8) * 2);
#pragma unroll 1
    for (int item = bidx(); item < 544; item += (int)gridDim.x) {
        const int b = item / 272; int rr = item % 272, qb = 0;
#pragma unroll 1
        for (;;) { const int nc = (qb + 2) >> 1; if (rr < nc) break; rr -= nc; ++qb; }
        const int t0 = 8 * rr, t1 = min(t0 + 8, 4 * qb + 4);
        const bf16* qrow = QKV + ((size_t)b * SEQ + 256 * qb + wid * 32 + r32) * AB_LD;
        bf16x8 qr[4][4]; float w[4];
#pragma unroll
        for (int h = 0; h < 4; ++h) { w[h] = bf2f(qrow[CWI + h]);
#pragma unroll
            for (int d0 = 0; d0 < 4; ++d0) qr[h][d0] = *(const bf16x8*)(qrow + CQI + h * 64 + d0 * 16 + hi * 8); }
        const char* kbase = (const char*)(QKV + (size_t)b * SEQ * AB_LD + CKI);
        float* srow = S + score_base(b, qb) + (size_t)(wid * 32 + r32) * (256 * (qb + 1)) + 4 * hi;
#define SC_DMA(t) attn_g::glds16s(kbase + (size_t)(t) * (64 * AB_LD * 2), kvoff, (unsigned)__builtin_amdgcn_readfirstlane(lds0 + (((t) - t0) & 1) * 8192 + wid * 1024))
        SC_DMA(t0);
        asm volatile("s_waitcnt vmcnt(0) lgkmcnt(0)\n\ts_barrier" ::: "memory");
#pragma unroll 1
        for (int t = t0; t < t1; ++t) {
            if (t + 1 < t1) SC_DMA(t + 1);
            const lcp kb = (lcp)smem + ((t - t0) & 1) * 8192 + hi * 1024 + r32 * 16;
            bf16x8 kf[4][2];
#pragma unroll
            for (int d0 = 0; d0 < 4; ++d0) { kf[d0][0] = *(const __attribute__((address_space(3))) bf16x8*)(kb + d0 * 2048); kf[d0][1] = *(const __attribute__((address_space(3))) bf16x8*)(kb + d0 * 2048 + 512); }
            f32x16 sc0, sc1;
#pragma unroll
            for (int r = 0; r < 16; ++r) { sc0[r] = 0.f; sc1[r] = 0.f; }
#pragma unroll
            for (int h = 0; h < 4; ++h) {
                f32x16 p0 = {}, p1 = {};
#pragma unroll
                for (int d0 = 0; d0 < 4; ++d0) { p0 = __builtin_amdgcn_mfma_f32_32x32x16_bf16(kf[d0][0], qr[h][d0], p0, 0, 0, 0); p1 = __builtin_amdgcn_mfma_f32_32x32x16_bf16(kf[d0][1], qr[h][d0], p1, 0, 0, 0); }
#pragma unroll
                for (int r = 0; r < 16; ++r) { sc0[r] = fmaf(w[h], fmaxf(p0[r], 0.f), sc0[r]); sc1[r] = fmaf(w[h], fmaxf(p1[r], 0.f), sc1[r]); }
                __builtin_amdgcn_sched_barrier(0);
            }
#pragma unroll
            for (int g = 0; g < 4; ++g) {
                *(f32x4*)(srow + 64 * t + 8 * g) = (f32x4){sc0[4 * g], sc0[4 * g + 1], sc0[4 * g + 2], sc0[4 * g + 3]};
                *(f32x4*)(srow + 64 * t + 8 * g + 32) = (f32x4){sc1[4 * g], sc1[4 * g + 1], sc1[4 * g + 2], sc1[4 * g + 3]};
            }
            asm volatile("s_waitcnt vmcnt(8) lgkmcnt(0)\n\ts_barrier" ::: "memory");
        }
#undef SC_DMA
    }
}
__device__ __forceinline__ void ph_dsa_select_opt(const float* S, unsigned long long* mask) {
    const int tid = tidx(), lane = tid & 63, wave = tid >> 6;
    const int gwv = bidx() * (NT / 64) + wave, ngw = (int)gridDim.x * (NT / 64);
#pragma unroll 1
    for (int t = gwv; t < T; t += ngw) {
        const int b = t / SEQ, tt = t % SEQ, n = tt + 1, qb = tt >> 8;
        const float* row = S + score_base(b, qb) + (size_t)(tt & 255) * (256 * (qb + 1));
        unsigned v[128];
#pragma unroll
        for (int g = 0; g < 8; ++g) {
            if (g * 1024 < n) {
#pragma unroll
                for (int j = 16 * g; j < 16 * g + 16; ++j) { const int kv = 64 * j + lane; v[j] = (kv < n) ? okey(row[(kv < n) ? kv : 0]) : 0u; }
            } else {
#pragma unroll
                for (int j = 16 * g; j < 16 * g + 16; ++j) v[j] = 0u;
            }
        }
        unsigned thr = 0u, need = 0u;
        if (n > 256) {
            unsigned lo = 0u, hi = 0xffffffffu;
#pragma unroll 1
            while (lo < hi) {
                const unsigned mid = lo + ((hi - lo) >> 1) + ((hi - lo) & 1u);
                int c = 0;
#pragma unroll
                for (int g = 0; g < 8; ++g) if (g * 1024 < n) {
#pragma unroll
                    for (int j = 16 * g; j < 16 * g + 16; ++j) c += (v[j] >= mid) ? 1 : 0; }
#pragma unroll
                for (int o = 1; o < 64; o <<= 1) c += __shfl_xor(c, o);
                c = __builtin_amdgcn_readfirstlane(c);
                if (c >= 256) lo = mid; else hi = mid - 1u;
            }
            thr = lo;
            int c = 0;
#pragma unroll
            for (int j = 0; j < 128; ++j) c += (v[j] > thr) ? 1 : 0;
#pragma unroll
            for (int o = 1; o < 64; o <<= 1) c += __shfl_xor(c, o);
            need = 256u - (unsigned)__builtin_amdgcn_readfirstlane(c);
        }
        const int ntile = 4 * (qb + 1);
        unsigned taken = 0u;
        unsigned long long* mrow = mask + (size_t)b * 128 * SEQ + tt;
#pragma unroll
        for (int j = 0; j < 128; ++j) {
            if (j < ntile) {
                const int kv = 64 * j + lane; bool sel;
                if (n <= 256) sel = kv < n;
                else {
                    const bool gt = v[j] > thr, eq = (v[j] == thr) && (kv < n);
                    const unsigned long long em = __ballot(eq);
                    const unsigned rank = taken + (unsigned)__popcll(em & ((1ull << lane) - 1ull));
                    sel = gt || (eq && rank < need);
                    taken += (unsigned)__popcll(em);
                }
                const unsigned long long m = __ballot(sel);
                if (lane == 0) mrow[(size_t)j * SEQ] = m;
            }
        }
    }
}

namespace cg = cooperative_groups;
constexpr int LDS_BYTES = 147456;
#define GEMM_PHASE(EPI, Aptr, Bptr, Nn, Kk, ...) do { pg8::Gemm g_{(const pg8::bf16_t*)(Aptr), (const pg8::bf16_t*)(Bptr), T, (Nn), (Kk)}; pg8::StaticOrder S_; S_.init(T, (Nn), (int)gridDim.x, (int)bidx()); \
    pg8::EPI E_{__VA_ARGS__}; pg8::gemm_phase<pg8::EPI, pg8::StaticOrder, true, true>((PG8_LAS unsigned char*)smem, g_, S_, E_); } while (0)
__global__ void __launch_bounds__(NT, 2) k_mega(Params P) {
    extern __shared__ __attribute__((aligned(16))) unsigned char smem[];
    cg::grid_group grid = cg::this_grid();
#define BAR() grid.sync()
    ph_prologue(smem);
    ph_rmsnorm(IN(0), IN(3), (bf16*)(WSP + WS_XN)); BAR();
    { unsigned char* ws = WSP; GEMM_PHASE(EBf16, ws + WS_XN, ws + WS_WAB_IN, AB_LD, DM, (bf16*)(ws + WS_QKV), AB_LD); } BAR();
    ph_prep0((bf16*)(WSP + WS_QKV), (const int*)IN(2), IN(8), IN(9), IN(10), IN(11)); BAR();
    { unsigned char* ws = WSP; ph_kmean((bf16*)(ws + WS_QKV), (float*)(ws + WS_KMEAN)); } BAR();
    { unsigned char* ws = WSP; ph_moba_select((bf16*)(ws + WS_QKV), (float*)(ws + WS_KMEAN), (unsigned*)(ws + WS_SEL)); }
    { unsigned char* ws = WSP; ph_dsa_score((bf16*)(ws + WS_QKV), (float*)(ws + WS_SCORES), smem); } BAR();
    { unsigned char* ws = WSP; ph_attn_moba((bf16*)(ws + WS_QKV), (unsigned*)(ws + WS_SEL), (bf16*)(ws + WS_XN), smem); }
    __syncthreads();
    { unsigned char* ws = WSP; ph_dsa_select_opt((float*)(ws + WS_SCORES), (unsigned long long*)(ws + WS_MASK)); } BAR();
    { unsigned char* ws = WSP; ph_attn_dsa((bf16*)(ws + WS_QKV), (unsigned long long*)(ws + WS_MASK), (bf16*)(ws + WS_XN), smem); } BAR();
    { unsigned char* ws = WSP; GEMM_PHASE(EResAdd, ws + WS_XN, ws + WS_WAB_OUT, DM, DM, IN(0), OUTP); }
    {
        unsigned char* ws = WSP;
#pragma unroll 1
        for (int L = 0; L < 2; ++L) {
            cvt_bf16(IN(18) + (size_t)L * NEXP * DM, (bf16*)(ws + WS_EXP + (size_t)(2 * L) * 32 * MiB), (size_t)NEXP * DM);
            cvt_bf16(IN(19) + (size_t)L * NEXP * DM, (bf16*)(ws + WS_EXP + (size_t)(2 * L + 1) * 32 * MiB), (size_t)NEXP * DM);
        }
    } BAR();
#pragma unroll 1
    for (int L = 0; L < 2; ++L) {
        if (L == 1) {
            ph_rmsnorm(OUTP, IN(3) + DM, (bf16*)(WSP + WS_XN)); BAR();
            { unsigned char* ws = WSP; GEMM_PHASE(EBf16, ws + WS_XN, ws + WS_WC_IN, C_LD, DM, (bf16*)(ws + WS_QKV1), C_LD); } BAR();
            ph_prep1((bf16*)(WSP + WS_QKV1), (const int*)IN(2), IN(14), IN(15)); BAR();
            { unsigned char* ws = WSP; ph_attn_dilated((bf16*)(ws + WS_QKV1), (bf16*)(ws + WS_OG), (float*)(ws + WS_LSE), smem); } BAR();
            { unsigned char* ws = WSP; ph_dil_merge((bf16*)(ws + WS_OG), (float*)(ws + WS_LSE), (bf16*)(ws + WS_XN)); } BAR();
            { unsigned char* ws = WSP; float* hb = OUTP; GEMM_PHASE(EResAdd, ws + WS_XN, ws + WS_WC_OUT, DM, DM, hb, hb); } BAR();
        }
        ph_rmsnorm(OUTP, IN(4) + L * DM, (bf16*)(WSP + WS_XN)); BAR();
        { unsigned char* ws = WSP; GEMM_PHASE(EBf16, ws + WS_XN, ws + WS_WQ + (size_t)L * 4 * MiB, 2048, DM, (bf16*)(ws + WS_QRY), 2048); } BAR();
        { unsigned char* ws = WSP; ph_peer_route_opt((bf16*)(ws + WS_QRY), (bf16*)(ws + WS_SUBK) + (size_t)L * 16 * 128 * 128, (int*)(ws + WS_EIDX), (float*)(ws + WS_GW), smem); } BAR();
        { unsigned char* ws = WSP; ph_peer_gather_opt((int*)(ws + WS_EIDX), (float*)(ws + WS_GW), (bf16*)(ws + WS_EXP + (size_t)(2 * L) * 32 * MiB), (bf16*)(ws + WS_EXP + (size_t)(2 * L + 1) * 32 * MiB), OUTP, IN(5) + L * DM, (bf16*)(ws + WS_XN), smem); }
        __syncthreads();
        { unsigned char* ws = WSP; GEMM_PHASE(EBf16, ws + WS_P + (size_t)L * T * 256 * 2, ws + WS_WUP + (size_t)L * (MiB / 2), DM, 256, (bf16*)(ws + WS_UP), DM); } BAR();
        { unsigned char* ws = WSP; GEMM_PHASE(EGate, ws + WS_XN, ws + WS_WG + (size_t)L * 2 * MiB, DM, DM, OUTP, (bf16*)(ws + WS_UP)); } BAR();
    }
}

extern "C" void kernel_launch(void* const* d_in, const int* in_sizes, int n_in, void* d_out, int out_size, void* d_ws, size_t ws_size, hipStream_t stream) {
    static int grid_blocks = 0;
    if (grid_blocks == 0) {
        if (n_in != 22 || out_size != T * DM || ws_size < WS_END) { fprintf(stderr, "kernel_launch: unexpected shapes: n_in %d out %d ws %zu\n", n_in, out_size, ws_size); grid_blocks = -1; return; }
        if (hipFuncSetAttribute((const void*)k_mega, hipFuncAttributeMaxDynamicSharedMemorySize, LDS_BYTES) != hipSuccess) { fprintf(stderr, "hipFuncSetAttribute failed\n"); grid_blocks = -1; return; }
        int dev = 0, cus = 0, per_cu = 0;
        hipGetDevice(&dev);
        hipDeviceGetAttribute(&cus, hipDeviceAttributeMultiprocessorCount, dev);
        hipOccupancyMaxActiveBlocksPerMultiprocessor(&per_cu, (const void*)k_mega, NT, LDS_BYTES);
        if (per_cu < 1 || cus < 1) { fprintf(stderr, "kernel_launch: occupancy query says %d blocks/CU on %d CUs\n", per_cu, cus); grid_blocks = -1; return; }
        grid_blocks = cus;
    }
    if (grid_blocks < 0) return;
    Params P{};
    for (int i = 0; i < 22; ++i) P.in[i] = (const float*)d_in[i];
    P.out = (float*)d_out; P.ws = (unsigned char*)d_ws;
    void* args[] = {&P};
    hipError_t e = hipLaunchCooperativeKernel((const void*)k_mega, dim3(grid_blocks), dim3(NT), args, LDS_BYTES, stream);
    if (e != hipSuccess) fprintf(stderr, "cooperative launch failed: %s (grid %d)\n", hipGetErrorString(e), grid_blocks);
}
```

```cpp
#include <hip/hip_runtime.h>
#include <hip/hip_cooperative_groups.h>
#include <cstdio>
#include <cstdint>

constexpr int BATCH = 2, SEQ = 8192, T = BATCH * SEQ, DM = 1024;
constexpr int AB_N = 3396, AB_LD = 3584;
constexpr int CQA = 0, CKA = 512, CVA = 1024, CQB = 1536, CKB = 2048, CVB = 2560, CQI = 3072, CKI = 3328, CWI = 3392;
constexpr int C_LD = 3072;
constexpr int NEXP = 16384;
constexpr float NORM_EPS = 1e-6f;
constexpr float C2 = 0.125f * 1.4426950408889634f;
constexpr int NT = 512;

constexpr size_t MiB = 1u << 20;
constexpr size_t WS_CTL = 0;
constexpr size_t WS_WAB_IN = 1 * MiB, WS_WAB_OUT = 8 * MiB, WS_WC_IN = 10 * MiB, WS_WC_OUT = 16 * MiB;
constexpr size_t WS_WQ = 18 * MiB, WS_WG = 26 * MiB, WS_WUP = 30 * MiB, WS_SUBK = 31 * MiB;
constexpr size_t WS_KMEAN = 32 * MiB;
constexpr size_t WS_SEL = 33 * MiB;
constexpr size_t WS_LSE = 34 * MiB;
constexpr size_t WS_EIDX = 37 * MiB;
constexpr size_t WS_GW = 45 * MiB;
constexpr size_t WS_P = 53 * MiB;
constexpr size_t WS_XN = 69 * MiB;
constexpr size_t WS_QKV = 101 * MiB;
constexpr size_t WS_MASK = 213 * MiB;
constexpr size_t WS_SCORES = 229 * MiB;
constexpr size_t WS_EXP = 229 * MiB;
constexpr size_t WS_QRY = 101 * MiB;
constexpr size_t WS_UP = 165 * MiB;
constexpr size_t WS_QKV1 = 357 * MiB;
constexpr size_t WS_OG = 101 * MiB;
constexpr size_t WS_END = 512 * MiB;

typedef unsigned short bf16;
typedef float f32x4 __attribute__((ext_vector_type(4)));

__device__ __forceinline__ unsigned f2bf(float f) { unsigned u = __builtin_bit_cast(unsigned, f); return (u + 0x7fffu + ((u >> 16) & 1u)) >> 16; }
__device__ __forceinline__ float bf2f(bf16 h) { return __builtin_bit_cast(float, (unsigned)h << 16); }
__device__ __forceinline__ float wave_sum(float v) {
#pragma unroll
    for (int o = 1; o < 64; o <<= 1) v += __shfl_xor(v, o);
    return v;
}
__device__ __forceinline__ float wave_max(float v) {
#pragma unroll
    for (int o = 1; o < 64; o <<= 1) v = fmaxf(v, __shfl_xor(v, o));
    return v;
}
__device__ __forceinline__ unsigned okey(float f) { unsigned u = __builtin_bit_cast(unsigned, f); return (u & 0x80000000u) ? ~u : (u | 0x80000000u); }

__device__ __forceinline__ int tidx() { int t = __builtin_amdgcn_workitem_id_x(); asm volatile("" : "+v"(t)); return t; }
__device__ __forceinline__ int bidx() { int b = __builtin_amdgcn_workgroup_id_x(); asm volatile("" : "+s"(b)); return b; }
struct Params {
    const float* in[22];
    float* out;
    unsigned char* ws;
    int layer;
    int pad;
};

typedef const __attribute__((address_space(4))) unsigned long long* karg_t;
__device__ __forceinline__ unsigned long long karg(int idx) { karg_t ka = (karg_t)__builtin_amdgcn_kernarg_segment_ptr(); asm volatile("" : "+s"(ka)); return ka[idx]; }
#define GASP __attribute__((address_space(1)))
#define IN(i) ((const float*)(const GASP float*)karg(i))
#define OUTP ((float*)(GASP float*)karg(22))
#define WSP ((unsigned char*)(GASP unsigned char*)karg(23))

__device__ __forceinline__ void ph_rmsnorm(const float* src, const float* gain, bf16* dst) {
    const int lane = tidx() & 63, wave = tidx() >> 6;
    const int gw = bidx() * (NT / 64) + wave, ngw = gridDim.x * (NT / 64);
    for (int r = gw; r < T; r += ngw) {
        const f32x4* xr = (const f32x4*)(src + (size_t)r * DM) + lane;
        f32x4 v[4]; float s = 0.f;
#pragma unroll
        for (int j = 0; j < 4; ++j) { v[j] = xr[64 * j]; s += v[j].x * v[j].x + v[j].y * v[j].y + v[j].z * v[j].z + v[j].w * v[j].w; }
        const float rstd = 1.0f / sqrtf(wave_sum(s) * (1.0f / DM) + NORM_EPS);
#pragma unroll
        for (int j = 0; j < 4; ++j) {
            const f32x4 g = ((const f32x4*)gain)[lane + 64 * j];
            unsigned long long o = (unsigned long long)(f2bf(v[j].x * rstd * g.x) | (f2bf(v[j].y * rstd * g.y) << 16)) |
                                   ((unsigned long long)(f2bf(v[j].z * rstd * g.z) | (f2bf(v[j].w * rstd * g.w) << 16)) << 32);
            ((unsigned long long*)(dst + (size_t)r * DM))[lane + 64 * j] = o;
        }
    }
}

template <class AT> __device__ __forceinline__ float ldA(const AT* p);
template <> __device__ __forceinline__ float ldA<bf16>(const bf16* p) { return bf2f(*p); }
template <> __device__ __forceinline__ float ldA<float>(const float* p) { return *p; }

template <class AT, class Epi> __forceinline__
__device__ __forceinline__ void ph_gemm_naive(const AT* A, int lda, const float* B, int N, int K, const Epi& E, unsigned char* smem) {
    float* As = (float*)smem;
    float* Bs = As + 16 * 132;
    const int tid = tidx(), ty = tid >> 5, tx = tid & 31;
    const int ntn = (N + 127) / 128, ntm = T / 128, ntile = ntn * ntm;
    for (int tile = bidx(); tile < ntile; tile += gridDim.x) {
        const int tm = tile / ntn, tn = tile % ntn, m0 = tm * 128, n0 = tn * 128;
        float acc[8][4];
#pragma unroll
        for (int i = 0; i < 8; ++i)
#pragma unroll
            for (int j = 0; j < 4; ++j) acc[i][j] = 0.f;
        for (int k0 = 0; k0 < K; k0 += 16) {
            __syncthreads();
#pragma unroll
            for (int i = 0; i < 4; ++i) { const int e = tid + i * NT, r = e >> 4, kk = e & 15; As[kk * 132 + r] = ldA<AT>(A + (size_t)(m0 + r) * lda + k0 + kk); }
#pragma unroll
            for (int i = 0; i < 4; ++i) { const int e = tid + i * NT, kk = e >> 7, c = e & 127; Bs[kk * 128 + c] = (n0 + c < N) ? B[(size_t)(k0 + kk) * N + n0 + c] : 0.f; }
            __syncthreads();
#pragma unroll 2
            for (int kk = 0; kk < 16; ++kk) {
                float a[8], b[4];
#pragma unroll
                for (int i = 0; i < 8; ++i) a[i] = As[kk * 132 + ty * 8 + i];
#pragma unroll
                for (int j = 0; j < 4; ++j) b[j] = Bs[kk * 128 + tx * 4 + j];
#pragma unroll
                for (int i = 0; i < 8; ++i)
#pragma unroll
                    for (int j = 0; j < 4; ++j) acc[i][j] += a[i] * b[j];
            }
        }
#pragma unroll
        for (int i = 0; i < 8; ++i) {
            const int col = n0 + tx * 4;
            if (col < N) E.store4(m0 + ty * 8 + i, col, (f32x4){acc[i][0], acc[i][1], acc[i][2], acc[i][3]});
        }
    }
}
struct EpBf16 { bf16* O; int ldc;
    __device__ __forceinline__ void store4(int r, int c, f32x4 v) const {
        unsigned long long o = (unsigned long long)(f2bf(v.x) | (f2bf(v.y) << 16)) | ((unsigned long long)(f2bf(v.z) | (f2bf(v.w) << 16)) << 32);
        *(unsigned long long*)(O + (size_t)r * ldc + c) = o; } };
struct EpResAdd { const float* base; float* out;
    __device__ __forceinline__ void store4(int r, int c, f32x4 v) const {
        const f32x4 b = *(const f32x4*)(base + (size_t)r * DM + c); *(f32x4*)(out + (size_t)r * DM + c) = b + v; } };
struct EpGate { float* h; const bf16* up;
    __device__ __forceinline__ void store4(int r, int c, f32x4 v) const {
        f32x4 hv = *(const f32x4*)(h + (size_t)r * DM + c); const bf16* u = up + (size_t)r * DM + c;
        hv.x += bf2f(u[0]) / (1.f + __expf(-v.x)); hv.y += bf2f(u[1]) / (1.f + __expf(-v.y));
        hv.z += bf2f(u[2]) / (1.f + __expf(-v.z)); hv.w += bf2f(u[3]) / (1.f + __expf(-v.w));
        *(f32x4*)(h + (size_t)r * DM + c) = hv; } };

__device__ __forceinline__ void rope_cs(int pos, int i, float& c, float& s) {
    const float inv = exp2f(-(float)i * 0.125f * 18.931568569324174f);
    const float ang = (float)pos * inv;
    const float k = rintf(ang * 0.15915494309189535f);
    float r = fmaf(-k, 6.28125f, ang); r = fmaf(-k, 1.9353071795864769e-3f, r);
    c = cosf(r); s = sinf(r);
}
__device__ __forceinline__ void prep_head(bf16* p, const float* gain, int pos, float scale, bool donorm, int lane) {
    float v = bf2f(p[lane]);
    if (donorm) { const float ss = wave_sum(v * v); v = v * (1.0f / sqrtf(ss * (1.0f / 64.f) + NORM_EPS)) * gain[lane]; }
    const float partner = __shfl_xor(v, 8);
    float c = 1.f, s = 0.f;
    if (lane < 16) rope_cs(pos, lane & 7, c, s);
    float o = v;
    if (lane < 8) o = v * c - partner * s; else if (lane < 16) o = v * c + partner * s;
    p[lane] = (bf16)f2bf(o * scale);
}
__device__ __forceinline__ void ph_prep0(bf16* qkv, const int* positions, const float* aq, const float* ak, const float* bq, const float* bk) {
    const int lane = tidx() & 63, wave = tidx() >> 6;
    const int gw = bidx() * (NT / 64) + wave, ngw = gridDim.x * (NT / 64);
    for (int r = gw; r < T; r += ngw) {
        const int pos = positions[r]; bf16* row = qkv + (size_t)r * AB_LD;
        for (int h = 0; h < 8; ++h) {
            prep_head(row + CQA + h * 64, aq, pos, C2, true, lane);
            prep_head(row + CKA + h * 64, ak, pos, 1.f, true, lane);
            prep_head(row + CQB + h * 64, bq, pos, C2, true, lane);
            prep_head(row + CKB + h * 64, bk, pos, 1.f, true, lane);
        }
        for (int h = 0; h < 4; ++h) prep_head(row + CQI + h * 64, nullptr, pos, 1.f, false, lane);
        prep_head(row + CKI, nullptr, pos, 1.f, false, lane);
    }
}
__device__ __forceinline__ void ph_prep1(bf16* qkv, const int* positions, const float* cq, const float* ck) {
    const int lane = tidx() & 63, wave = tidx() >> 6;
    const int gw = bidx() * (NT / 64) + wave, ngw = gridDim.x * (NT / 64);
    for (int r = gw; r < T; r += ngw) {
        const int pos = positions[r]; bf16* row = qkv + (size_t)r * C_LD;
        for (int h = 0; h < 16; ++h) {
            prep_head(row + h * 64, cq, pos, C2, true, lane);
            prep_head(row + 1024 + h * 64, ck, pos, 1.f, true, lane);
        }
    }
}
__device__ __forceinline__ void ph_kmean(const bf16* qkv, float* kmean) {
    const int lane = tidx() & 63, wave = tidx() >> 6;
    const int gw = bidx() * (NT / 64) + wave, ngw = gridDim.x * (NT / 64);
    for (int it = gw; it < BATCH * 8 * 32; it += ngw) {
        const int b = it / 256, h = (it / 32) % 8, n = it % 32;
        float s = 0.f;
        for (int r = 0; r < 256; ++r) s += bf2f(qkv[(size_t)(b * SEQ + n * 256 + r) * AB_LD + CKA + h * 64 + lane]);
        kmean[(size_t)it * 64 + lane] = s * (1.0f / 256.f);
    }
}
__device__ __forceinline__ void ph_moba_select(const bf16* qkv, const float* kmean, unsigned* sel) {
    for (int it = bidx() * NT + tidx(); it < T * 8; it += gridDim.x * NT) {
        const int t = it >> 3, h = it & 7, b = t / SEQ, qblk = (t % SEQ) / 256;
        float q[64];
#pragma unroll
        for (int d = 0; d < 64; ++d) q[d] = bf2f(qkv[(size_t)t * AB_LD + CQA + h * 64 + d]);
        float v0 = -3e38f, v1 = -3e38f, v2 = -3e38f; int i0 = 255, i1 = 255, i2 = 255;
        for (int n = 0; n < qblk; ++n) {
            const float* km = kmean + (size_t)((b * 8 + h) * 32 + n) * 64; float g = 0.f;
#pragma unroll
            for (int d = 0; d < 64; ++d) g += q[d] * km[d];
            if (g > v0) { v2 = v1; i2 = i1; v1 = v0; i1 = i0; v0 = g; i0 = n; }
            else if (g > v1) { v2 = v1; i2 = i1; v1 = g; i1 = n; }
            else if (g > v2) { v2 = g; i2 = n; }
        }
        sel[it] = (unsigned)i0 | ((unsigned)i1 << 8) | ((unsigned)i2 << 16) | (255u << 24);
    }
}
__device__ __forceinline__ void ph_moba_attend(const bf16* qkv, const unsigned* sel, bf16* O, unsigned char* smem) {
    const int lane = tidx() & 63, wave = tidx() >> 6;
    float* pl = (float*)smem + wave * 1024;
    const int gw = bidx() * (NT / 64) + wave, ngw = gridDim.x * (NT / 64);
    for (int it = gw; it < T * 8; it += ngw) {
        const int t = it >> 3, h = it & 7, b = t / SEQ, tt = t % SEQ, qblk = tt / 256;
        const unsigned sw = sel[it];
        int blk[4] = {qblk, (int)(sw & 255), (int)((sw >> 8) & 255), (int)((sw >> 16) & 255)};
        const bf16* qp = qkv + (size_t)t * AB_LD + CQA + h * 64;
        float q[64];
#pragma unroll
        for (int d = 0; d < 64; ++d) q[d] = bf2f(qp[d]);
        float sc[16]; float mx = -3e38f;
#pragma unroll
        for (int s = 0; s < 4; ++s) {
#pragma unroll
            for (int i = 0; i < 4; ++i) {
                const int j = lane + 64 * i, pos = blk[s] * 256 + j;
                const bool ok = (blk[s] != 255) && (s > 0 || pos <= tt);
                float a = -3e38f;
                if (ok) { const bf16* kp = qkv + (size_t)(b * SEQ + pos) * AB_LD + CKA + h * 64; a = 0.f;
#pragma unroll
                    for (int d = 0; d < 64; ++d) a += q[d] * bf2f(kp[d]); }
                sc[s * 4 + i] = a; mx = fmaxf(mx, a);
            }
        }
        mx = wave_max(mx); float l = 0.f;
#pragma unroll
        for (int e = 0; e < 16; ++e) { const float p = (sc[e] > -1e38f) ? exp2f(sc[e] - mx) : 0.f; l += p; pl[(e >> 2) * 256 + lane + 64 * (e & 3)] = p; }
        l = wave_sum(l);
        __builtin_amdgcn_s_waitcnt(0);
        float o = 0.f;
#pragma unroll
        for (int s = 0; s < 4; ++s) {
            if (blk[s] == 255) continue;
            const int nk = (s == 0) ? (tt - qblk * 256 + 1) : 256;
            const bf16* vp = qkv + (size_t)(b * SEQ + blk[s] * 256) * AB_LD + CVA + h * 64 + lane;
            for (int j = 0; j < nk; ++j) o += pl[s * 256 + j] * bf2f(vp[(size_t)j * AB_LD]);
        }
        O[(size_t)t * DM + h * 64 + lane] = (bf16)f2bf(o / l);
    }
}
__device__ __forceinline__ void ph_dsa_select(const bf16* qkv, unsigned long long* mask, unsigned char* smem) {
    unsigned* keys = (unsigned*)smem;
    unsigned* cnt = keys + 8192;
    const int tid = tidx(), lane = tid & 63;
    for (int t = bidx(); t < T; t += gridDim.x) {
        const int b = t / SEQ, tt = t % SEQ, n = tt + 1;
        __syncthreads();
        const bf16* row = qkv + (size_t)t * AB_LD;
        float* qf = (float*)(cnt + 4);
        if (tid < 256) qf[tid] = bf2f(row[CQI + tid]);
        if (tid < 4) qf[256 + tid] = bf2f(row[CWI + tid]);
        __syncthreads();
        for (int kv = tid; kv < 8192; kv += NT) {
            unsigned key = 0u;
            if (kv < n) {
                const bf16* kp = qkv + (size_t)(b * SEQ + kv) * AB_LD + CKI;
                float a0 = 0.f, a1 = 0.f, a2 = 0.f, a3 = 0.f;
                for (int d = 0; d < 64; ++d) { const float kd = bf2f(kp[d]); a0 += qf[d] * kd; a1 += qf[64 + d] * kd; a2 += qf[128 + d] * kd; a3 += qf[192 + d] * kd; }
                const float s = ((qf[256] * fmaxf(a0, 0.f) + qf[257] * fmaxf(a1, 0.f)) + qf[258] * fmaxf(a2, 0.f)) + qf[259] * fmaxf(a3, 0.f);
                key = okey(s);
            }
            keys[kv] = key;
        }
        __syncthreads();
        unsigned thr = 0u, need = 0u;
        if (n > 256) {
            unsigned lo = 0u, hi = 0xFFFFFFFFu;
            while (lo < hi) {
                const unsigned mid = lo + ((hi - lo) >> 1) + ((hi - lo) & 1u);
                if (tid == 0) cnt[0] = 0u;
                __syncthreads();
                unsigned c = 0;
                for (int kv = tid; kv < 8192; kv += NT) c += (keys[kv] >= mid) ? 1u : 0u;
                c = (unsigned)wave_sum((float)c);
                if (lane == 0) atomicAdd(&cnt[0], c);
                __syncthreads();
                const unsigned tot = cnt[0];
                __syncthreads();
                if (tot >= 256u) lo = mid; else hi = mid - 1u;
            }
            thr = lo;
            if (tid == 0) cnt[1] = 0u;
            __syncthreads();
            unsigned c = 0;
            for (int kv = tid; kv < 8192; kv += NT) c += (keys[kv] > thr) ? 1u : 0u;
            c = (unsigned)wave_sum((float)c);
            if (lane == 0) atomicAdd(&cnt[1], c);
            __syncthreads();
            need = 256u - cnt[1];
        }
        if (tid < 64) {
            const int ntile = 4 * (tt / 256 + 1);
            unsigned taken = 0u;
            for (int j = 0; j < ntile; ++j) {
                const int kv = j * 64 + lane; const unsigned key = keys[kv];
                bool s;
                if (n <= 256) s = kv < n;
                else {
                    const bool gt = key > thr, eq = (key == thr) && (kv < n);
                    const unsigned long long em = __ballot(eq);
                    const unsigned rank = taken + (unsigned)__popcll(em & ((1ull << lane) - 1ull));
                    s = gt || (eq && rank < need);
                    taken += (unsigned)__popcll(em);
                }
                const unsigned long long m = __ballot(s);
                if (lane == 0) mask[((size_t)(b * 128 + j)) * SEQ + tt] = m;
            }
        }
    }
}
__device__ __forceinline__ void ph_dsa_attend(const bf16* qkv, const unsigned long long* mask, bf16* O, unsigned char* smem) {
    int* list = (int*)smem;
    int* cnt = list + 256;
    float* pr = (float*)(cnt + 4);
    float* linv = pr + 8 * 256;
    const int tid = tidx(), lane = tid & 63, wave = tid >> 6;
    for (int t = bidx(); t < T; t += gridDim.x) {
        const int b = t / SEQ, tt = t % SEQ;
        __syncthreads();
        const int ntile = 4 * (tt / 256 + 1);
        if (wave == 0) {
            int base = 0;
            for (int j = 0; j < ntile; ++j) {
                const unsigned long long m = mask[((size_t)(b * 128 + j)) * SEQ + tt];
                const int p = base + (int)__popcll(m & ((1ull << lane) - 1ull));
                if (((m >> lane) & 1ull) && p < 256) list[p] = j * 64 + lane;
                base += (int)__popcll(m);
            }
            if (lane == 0) cnt[0] = base;
        }
        __syncthreads();
        const int ns = min(cnt[0], 256);
        const bf16* row = qkv + (size_t)t * AB_LD;
        for (int e = tid; e < 8 * 256; e += NT) {
            const int h = e >> 8, j = e & 255; float a = -3e38f;
            if (j < ns) { const bf16* kp = qkv + (size_t)(b * SEQ + list[j]) * AB_LD + CKB + h * 64; a = 0.f;
                for (int d = 0; d < 64; ++d) a += bf2f(row[CQB + h * 64 + d]) * bf2f(kp[d]); }
            pr[e] = a;
        }
        __syncthreads();
        {
            const int h = wave; float v[4]; float mx = -3e38f;
#pragma unroll
            for (int i = 0; i < 4; ++i) { v[i] = pr[h * 256 + lane + 64 * i]; mx = fmaxf(mx, v[i]); }
            mx = wave_max(mx); float l = 0.f;
#pragma unroll
            for (int i = 0; i < 4; ++i) { const float p = (v[i] > -1e38f) ? exp2f(v[i] - mx) : 0.f; l += p; pr[h * 256 + lane + 64 * i] = p; }
            l = wave_sum(l); if (lane == 0) linv[h] = 1.0f / l;
        }
        __syncthreads();
        {   const int h = tid >> 6, d = tid & 63; float o = 0.f;
            for (int j = 0; j < ns; ++j) o += pr[h * 256 + j] * bf2f(qkv[(size_t)(b * SEQ + list[j]) * AB_LD + CVB + h * 64 + d]);
            O[(size_t)t * DM + 512 + h * 64 + d] = (bf16)f2bf(o * linv[h]); }
    }
}
__device__ __forceinline__ void ph_dilated(const bf16* qkv, bf16* OG, float* LSE) {
    const int lane = tidx() & 63, wave = tidx() >> 6;
    const int gw = bidx() * (NT / 64) + wave, ngw = gridDim.x * (NT / 64);
    for (int it = gw; it < T * 16; it += ngw) {
        const int t = it >> 4, h = it & 15, b = t / SEQ, tt = t % SEQ;
        const bf16* qp = qkv + (size_t)t * C_LD + h * 64;
        float q[64];
#pragma unroll
        for (int d = 0; d < 64; ++d) q[d] = bf2f(qp[d]);
        for (int g = 0; g < 3; ++g) {
            const int dil = (g == 0) ? 1 : (g == 1 ? 4 : 16);
            float sc[3]; float mx = -3e38f;
#pragma unroll
            for (int i = 0; i < 3; ++i) {
                const int j = lane + 64 * i, pos = tt - j * dil; float a = -3e38f;
                if (j <= 128 && pos >= 0) { const bf16* kp = qkv + (size_t)(b * SEQ + pos) * C_LD + 1024 + h * 64; a = 0.f;
#pragma unroll
                    for (int d = 0; d < 64; ++d) a += q[d] * bf2f(kp[d]); }
                sc[i] = a; mx = fmaxf(mx, a);
            }
            mx = wave_max(mx); float l = 0.f; float p[3];
#pragma unroll
            for (int i = 0; i < 3; ++i) { p[i] = (sc[i] > -1e38f) ? exp2f(sc[i] - mx) : 0.f; l += p[i]; }
            l = wave_sum(l);
            float o = 0.f;
            for (int j = 0; j <= 128; ++j) {
                const int pos = tt - j * dil; if (pos < 0) break;
                const float pj = (j < 64) ? __shfl(p[0], j) : ((j < 128) ? __shfl(p[1], j - 64) : __shfl(p[2], 0));
                o += pj * bf2f(qkv[(size_t)(b * SEQ + pos) * C_LD + 2048 + h * 64 + lane]);
            }
            OG[((size_t)g * T + t) * DM + h * 64 + lane] = (bf16)f2bf(o / l);
            if (lane == 0) LSE[((size_t)g * T + t) * 16 + h] = mx + log2f(l);
        }
    }
}
__device__ __forceinline__ void ph_dil_merge(const bf16* OG, const float* LSE, bf16* O) {
    for (size_t e = (size_t)bidx() * NT + tidx(); e < (size_t)T * DM; e += (size_t)gridDim.x * NT) {
        const int t = (int)(e >> 10), c = (int)(e & 1023), h = c >> 6;
        const float l0 = LSE[((size_t)0 * T + t) * 16 + h], l1 = LSE[((size_t)1 * T + t) * 16 + h], l2 = LSE[((size_t)2 * T + t) * 16 + h];
        const float m = fmaxf(l0, fmaxf(l1, l2)); const float w0 = exp2f(l0 - m), w1 = exp2f(l1 - m), w2 = exp2f(l2 - m);
        const float o = (w0 * bf2f(OG[e]) + w1 * bf2f(OG[(size_t)T * DM + e]) + w2 * bf2f(OG[(size_t)2 * T * DM + e])) / (w0 + w1 + w2);
        O[e] = (bf16)f2bf(o);
    }
}
__device__ __forceinline__ void ph_peer_route(const bf16* qry, const float* subk, int* eidx, float* gw, unsigned char* smem) {
    float* s = (float*)smem;
    float* sv = s + 2048;
    int* si = (int*)(sv + 256);
    float* qf = (float*)(si + 256);
    const int tid = tidx(), lane = tid & 63, wave = tid >> 6;
    for (int t = bidx(); t < T; t += gridDim.x) {
        __syncthreads();
        for (int e = tid; e < 2048; e += NT) qf[e] = bf2f(qry[(size_t)t * 2048 + e]);
        __syncthreads();
        for (int e = tid; e < 2048; e += NT) {
            const int hc = e >> 7, k = e & 127; const float* kp = subk + ((size_t)hc * 128 + k) * 128; float a = 0.f;
            for (int d = 0; d < 128; ++d) a += qf[hc * 128 + d] * kp[d];
            s[e] = a;
        }
        __syncthreads();
        for (int hc = wave; hc < 16; hc += NT / 64) {
            float v0 = s[hc * 128 + lane], v1 = s[hc * 128 + 64 + lane];
            for (int r = 0; r < 16; ++r) {
                float bv = v0; int bi = lane;
                if (v1 > bv) { bv = v1; bi = lane + 64; }
#pragma unroll
                for (int o = 1; o < 64; o <<= 1) { const float ov = __shfl_xor(bv, o); const int oi = __shfl_xor(bi, o); if (ov > bv || (ov == bv && oi < bi)) { bv = ov; bi = oi; } }
                if (lane == 0) { sv[hc * 16 + r] = bv; si[hc * 16 + r] = bi; }
                if (bi == lane) v0 = -3e38f; if (bi == lane + 64) v1 = -3e38f;
            }
        }
        __syncthreads();
        {   const int h = wave;
            float c[4]; int ci[4];
#pragma unroll
            for (int i = 0; i < 4; ++i) { const int f = lane + 64 * i; c[i] = sv[(h * 2) * 16 + (f >> 4)] + sv[(h * 2 + 1) * 16 + (f & 15)]; ci[i] = f; }
            float cv[16]; int cf[16];
#pragma unroll
            for (int r = 0; r < 16; ++r) {
                float bv = c[0]; int bi = ci[0];
#pragma unroll
                for (int i = 1; i < 4; ++i) if (c[i] > bv) { bv = c[i]; bi = ci[i]; }
#pragma unroll
                for (int o = 1; o < 64; o <<= 1) { const float ov = __shfl_xor(bv, o); const int oi = __shfl_xor(bi, o); if (ov > bv || (ov == bv && oi < bi)) { bv = ov; bi = oi; } }
                cv[r] = bv; cf[r] = bi;
#pragma unroll
                for (int i = 0; i < 4; ++i) if (ci[i] == bi) c[i] = -3e38f;
            }
            float l = 0.f;
#pragma unroll
            for (int r = 0; r < 16; ++r) l += __expf(cv[r] - cv[0]);
            if (lane < 16) {
                float myv = 0.f; int myf = 0;
#pragma unroll
                for (int r = 0; r < 16; ++r) if (r == lane) { myv = cv[r]; myf = cf[r]; }
                eidx[(size_t)t * 128 + h * 16 + lane] = si[(h * 2) * 16 + (myf >> 4)] * 128 + si[(h * 2 + 1) * 16 + (myf & 15)];
                gw[(size_t)t * 128 + h * 16 + lane] = __expf(myv - cv[0]) / l;
            }
        }
    }
}
__device__ __forceinline__ float gelu_tanh(float x) { const float u = 0.7978845608028654f * (x + 0.044715f * x * x * x); return 0.5f * x * (1.f + tanhf(u)); }
__device__ __forceinline__ void ph_peer_gather(const bf16* xn, const int* eidx, const float* gw, const float* U, const float* V, float* h, unsigned char* smem) {
    float* xf = (float*)smem;
    float* w = xf + 1024;
    int* ei = (int*)(w + 128);
    const int tid = tidx(), lane = tid & 63, wave = tid >> 6;
    for (int t = bidx(); t < T; t += gridDim.x) {
        __syncthreads();
        for (int e = tid; e < 1024; e += NT) xf[e] = bf2f(xn[(size_t)t * DM + e]);
        if (tid < 128) ei[tid] = eidx[(size_t)t * 128 + tid];
        __syncthreads();
        for (int e = wave; e < 128; e += NT / 64) {
            const float* up = U + (size_t)ei[e] * DM; float a = 0.f;
            for (int d = lane; d < 1024; d += 64) a += xf[d] * up[d];
            a = wave_sum(a);
            if (lane == 0) w[e] = gw[(size_t)t * 128 + e] * gelu_tanh(a);
        }
        __syncthreads();
        for (int d = tid; d < 1024; d += NT) {
            float o = 0.f;
            for (int e = 0; e < 128; ++e) o += w[e] * V[(size_t)ei[e] * DM + d];
            h[(size_t)t * DM + d] += o;
        }
    }
}

namespace pg8 {
#define PG8_LAS __attribute__((address_space(3)))
typedef unsigned short bf16_t;
typedef short bf16x8 __attribute__((ext_vector_type(8)));
typedef float f32x4 __attribute__((ext_vector_type(4)));
typedef unsigned u32x4 __attribute__((ext_vector_type(4)));
constexpr int BM = 256, BK = 64, HALF = 128, HTB = HALF * BK * 2  , STAGE_BYTES = 8 * HTB, NXCD = 8, WGM = 8;

__host__ __device__ __forceinline__ int lds_byte(int r, int c) { const int st = (r >> 4) * 2 + (c >> 5), rr = r & 15, cc = c & 31, ob = rr * 64 + cc * 2; return st * 1024 + (ob ^ (((ob >> 9) & 1) << 5)); }
__host__ __device__ __forceinline__ void stage_rc(int b, int& R, int& C) { const int st = b / 1024, sb = b % 1024, swz = sb ^ (((sb >> 9) & 1) << 5); R = (st >> 1) * 16 + swz / 64; C = (st & 1) * 32 + (swz % 64) / 2; }
__host__ __device__ __forceinline__ int perm32(int rho) { const int n = rho >> 4, i = rho & 15; return 8 * (i >> 2) + 4 * n + (i & 3); }

struct Unit { int pm, pn; };
struct Gemm { const bf16_t* A; const bf16_t* Bt; int M, N, K; };

struct StaticOrder {
    int nM, nN, nwg, G, c;
    __host__ __device__ void init(int M, int N, int G_, int c_) { nM = M / BM; nN = N / BM; nwg = nM * nN; G = G_; c = c_; }
    __host__ __device__ bool next(int i, Unit& u) const {
        const long L = (long)i * G + c; if (L >= nwg) return false;
        int wgid = (int)L; { const int q = nwg / NXCD, r = nwg % NXCD, xcd = wgid % NXCD, off = wgid / NXCD; wgid = (xcd < r ? xcd * (q + 1) : r * (q + 1) + (xcd - r) * q) + off; }
        const int nig = WGM * nN, gid = wgid / nig, fm = gid * WGM, gsz = (nM - fm) < WGM ? (nM - fm) : WGM;
        u.pm = fm + ((wgid % nig) % gsz); u.pn = (wgid % nig) / gsz; return true;
    }
    __device__ __forceinline__ void a_ready(const Unit&) const {}
    __device__ __forceinline__ void done(const Unit&) const {}
};


__device__ __forceinline__ unsigned pk_bf16(float lo, float hi) { typedef float f2 __attribute__((ext_vector_type(2))); typedef __bf16 b2 __attribute__((ext_vector_type(2))); f2 v = {lo, hi}; b2 b = __builtin_convertvector(v, b2); return __builtin_bit_cast(unsigned, b); }
struct EBf16 {
    static constexpr bool PERM = true, AFTER_DRAIN = false; bf16_t* O; int ldc;
    __device__ __forceinline__ void operator()(const f32x4 (&acc)[2][2][4][2], const Unit& u, int wr, int wc, int fr, int fq) const {
        const int row0 = u.pm * BM + wr * 64 + fr, col0 = u.pn * BM + wc * 32 + 8 * fq;
#pragma unroll
        for (int ai = 0; ai < 2; ++ai)
#pragma unroll
            for (int m = 0; m < 4; ++m) { bf16_t* rowp = O + (size_t)(row0 + ai * HALF + m * 16) * ldc + col0;
#pragma unroll
                for (int bj = 0; bj < 2; ++bj) { const f32x4 v0 = acc[ai][bj][m][0], v1 = acc[ai][bj][m][1];
                    u32x4 w; w.x = pk_bf16(v0[0], v0[1]); w.y = pk_bf16(v0[2], v0[3]); w.z = pk_bf16(v1[0], v1[1]); w.w = pk_bf16(v1[2], v1[3]);
                    *(u32x4*)(rowp + bj * HALF) = w; } }
    }
};
struct EResAdd {
    static constexpr bool PERM = false, AFTER_DRAIN = false; const float* base; float* out;
    __device__ __forceinline__ void operator()(const f32x4 (&acc)[2][2][4][2], const Unit& u, int wr, int wc, int fr, int fq) const {
        const int col0 = u.pn * BM + wc * 32 + 4 * fq;
#pragma unroll
        for (int ai = 0; ai < 2; ++ai)
#pragma unroll
            for (int m = 0; m < 4; ++m) { const size_t off = (size_t)(u.pm * BM + ai * HALF + wr * 64 + m * 16 + fr) * 1024 + col0;
#pragma unroll
                for (int bj = 0; bj < 2; ++bj)
#pragma unroll
                    for (int n = 0; n < 2; ++n) { const f32x4 b = *(const f32x4*)(base + off + bj * HALF + n * 16); *(f32x4*)(out + off + bj * HALF + n * 16) = b + acc[ai][bj][m][n]; } }
    }
};
struct EGate {
    static constexpr bool PERM = false, AFTER_DRAIN = false; float* h; const bf16_t* up;
    __device__ __forceinline__ void operator()(const f32x4 (&acc)[2][2][4][2], const Unit& u, int wr, int wc, int fr, int fq) const {
        const int col0 = u.pn * BM + wc * 32 + 4 * fq;
#pragma unroll
        for (int ai = 0; ai < 2; ++ai)
#pragma unroll
            for (int m = 0; m < 4; ++m) { const size_t off = (size_t)(u.pm * BM + ai * HALF + wr * 64 + m * 16 + fr) * 1024 + col0;
#pragma unroll
                for (int bj = 0; bj < 2; ++bj)
#pragma unroll
                    for (int n = 0; n < 2; ++n) { const size_t o = off + bj * HALF + n * 16; f32x4 hv = *(const f32x4*)(h + o);
                        const unsigned long long uu = *(const unsigned long long*)(up + o); const f32x4 a = acc[ai][bj][m][n];
                        hv[0] += __builtin_bit_cast(float, (unsigned)(uu << 16)) / (1.f + __expf(-a[0]));
                        hv[1] += __builtin_bit_cast(float, (unsigned)(uu & 0xffff0000ull)) / (1.f + __expf(-a[1]));
                        hv[2] += __builtin_bit_cast(float, (unsigned)((uu >> 16) & 0xffff0000ull)) / (1.f + __expf(-a[2]));
                        hv[3] += __builtin_bit_cast(float, (unsigned)((uu >> 32) & 0xffff0000ull)) / (1.f + __expf(-a[3]));
                        *(f32x4*)(h + o) = hv; } }
    }
};
template <class Epi, class Sched, bool ALIGN_EPI = false, bool SP2 = false>
__device__ __forceinline__ void gemm_phase(PG8_LAS unsigned char* lds, const Gemm g, const Sched& S, const Epi& E) {
    const int tid = tidx(), wid = __builtin_amdgcn_readfirstlane(tid >> 6), lane = tid & 63, wr = wid >> 2, wc = wid & 3, fr = lane & 15, fq = lane >> 4;
    const int K = g.K, nt = K / BK;
    unsigned voffA[2], voffB[2];
#pragma unroll
    for (int i = 0; i < 2; ++i) { int R, C; stage_rc(tid * 16 + i * 8192, R, C); const int Rb = Epi::PERM ? ((R & ~31) + perm32(R & 31)) : R;
        voffA[i] = (unsigned)(R * K + C) * 2u; voffB[i] = (unsigned)(Rb * K + C) * 2u; }
    const size_t kstep = (size_t)(BK * 2);
    const size_t hstep = (size_t)HALF * K * 2;
    const size_t tstep = 2 * hstep;
    const unsigned ldsw = (unsigned)wid * 1024u;
    const int aoff = lds_byte(wr * 64 + fr, fq * 8), boff = lds_byte(wc * 32 + fr, fq * 8);
#define PG8_SA(b, h) (((b) * 2 + (h)) * HTB)
#define PG8_SB(b, h) ((4 + (b) * 2 + (h)) * HTB)
#define PG8_STAGE(bufoff, gbase, voff) do { _Pragma("unroll") for (int _i = 0; _i < 2; ++_i) \
        __builtin_amdgcn_global_load_lds((const unsigned*)((const char*)(gbase) + (voff)[_i]), (PG8_LAS unsigned*)(lds + (bufoff) + ldsw + _i * 8192), 16, 0, 0); } while (0)
#define PG8_LDA(dst, b, h) do { _Pragma("unroll") for (int m = 0; m < 4; ++m) _Pragma("unroll") for (int k = 0; k < 2; ++k) dst[m][k] = *(const PG8_LAS bf16x8*)(lds + PG8_SA(b, h) + aoff + m * 2048 + k * 1024); } while (0)
#define PG8_LDB(dst, b, h) do { _Pragma("unroll") for (int n = 0; n < 2; ++n) _Pragma("unroll") for (int k = 0; k < 2; ++k) dst[n][k] = *(const PG8_LAS bf16x8*)(lds + PG8_SB(b, h) + boff + n * 2048 + k * 1024); } while (0)
#define PG8_MMA(ai, bj, At, Bt) do { __builtin_amdgcn_s_setprio(1); _Pragma("unroll") for (int m = 0; m < 4; ++m) _Pragma("unroll") for (int n = 0; n < 2; ++n) _Pragma("unroll") for (int k = 0; k < 2; ++k) \
        acc[ai][bj][m][n] = __builtin_amdgcn_mfma_f32_16x16x32_bf16(Bt[n][k], At[m][k], acc[ai][bj][m][n], 0, 0, 0); __builtin_amdgcn_s_setprio(0); } while (0)
#define PG8_WAIT_V(n) asm volatile("s_waitcnt vmcnt(" #n ")" ::: "memory")
#define PG8_WAIT_L(n) asm volatile("s_waitcnt lgkmcnt(" #n ")" ::: "memory")
#define PG8_BAR __builtin_amdgcn_s_barrier()
#define PG8_SCHED __builtin_amdgcn_sched_barrier(0)
    Unit cur, nxt; int ui = 0;
    if (!S.next(0, cur)) return;
    f32x4 acc[2][2][4][2];
#pragma unroll
    for (int a = 0; a < 2; ++a)
#pragma unroll
        for (int b = 0; b < 2; ++b)
#pragma unroll
            for (int m = 0; m < 4; ++m)
#pragma unroll
                for (int n = 0; n < 2; ++n) acc[a][b][m][n] = (f32x4){0.f, 0.f, 0.f, 0.f};
    bf16x8 At[4][2], B0[2][2], B1[2][2];
    const char* cA = (const char*)g.A + (size_t)cur.pm * tstep; const char* cB = (const char*)g.Bt + (size_t)cur.pn * tstep;
    S.a_ready(cur);
    if constexpr (SP2) {
        PG8_STAGE(PG8_SB(0, 0), cB, voffB); PG8_STAGE(PG8_SB(0, 1), cB + hstep, voffB); PG8_STAGE(PG8_SA(0, 0), cA, voffA); PG8_STAGE(PG8_SA(0, 1), cA + hstep, voffA);
        if (wr == 1) PG8_BAR;
        PG8_WAIT_V(2); PG8_BAR;
        PG8_STAGE(PG8_SB(1, 0), cB + kstep, voffB); PG8_STAGE(PG8_SA(1, 0), cA + kstep, voffA); PG8_STAGE(PG8_SB(1, 1), cB + hstep + kstep, voffB);
        PG8_WAIT_V(6); PG8_BAR;
    } else {
        PG8_STAGE(PG8_SB(0, 0), cB, voffB); PG8_STAGE(PG8_SA(0, 0), cA, voffA); PG8_STAGE(PG8_SB(0, 1), cB + hstep, voffB); PG8_STAGE(PG8_SA(0, 1), cA + hstep, voffA);
        if (wr == 1) PG8_BAR;
        PG8_WAIT_V(4); PG8_BAR;
        PG8_STAGE(PG8_SB(1, 0), cB + kstep, voffB); PG8_STAGE(PG8_SA(1, 0), cA + kstep, voffA); PG8_STAGE(PG8_SB(1, 1), cB + hstep + kstep, voffB);
        PG8_WAIT_V(6); PG8_BAR;
    }
    for (;;) {
        const bool has_next = S.next(ui + 1, nxt);
        const char* nA = has_next ? (const char*)g.A + (size_t)nxt.pm * tstep : cA; const char* nB = has_next ? (const char*)g.Bt + (size_t)nxt.pn * tstep : cB;
        for (int t = 0; t < nt; t += 2) {
            const bool last = (t == nt - 2);
            const char* a1 = cA + (size_t)(t + 1) * kstep;
            const char* a2 = last ? nA : cA + (size_t)(t + 2) * kstep; const char* b2 = last ? nB : cB + (size_t)(t + 2) * kstep;
            const char* a3 = a2 + kstep; const char* b3 = b2 + kstep;
            if (last && has_next) S.a_ready(nxt);
            if constexpr (SP2) {
            PG8_LDB(B0, 0, 0); PG8_LDB(B1, 0, 1); PG8_SCHED; PG8_LDA(At, 0, 0); PG8_STAGE(PG8_SA(1, 1), a1 + hstep, voffA);
            PG8_WAIT_V(8); PG8_WAIT_L(0); PG8_BAR; PG8_MMA(0, 0, At, B0); PG8_MMA(0, 1, At, B1); PG8_BAR; PG8_SCHED;
            PG8_LDA(At, 0, 1); PG8_STAGE(PG8_SB(0, 0), b2, voffB); PG8_STAGE(PG8_SB(0, 1), b2 + hstep, voffB); PG8_STAGE(PG8_SA(0, 0), a2, voffA);
            PG8_WAIT_V(8); PG8_WAIT_L(0); PG8_BAR; PG8_MMA(1, 0, At, B0); PG8_MMA(1, 1, At, B1); PG8_BAR; PG8_SCHED;
            PG8_LDB(B0, 1, 0); PG8_LDB(B1, 1, 1); PG8_SCHED; PG8_LDA(At, 1, 0); PG8_STAGE(PG8_SA(0, 1), a2 + hstep, voffA);
            PG8_WAIT_V(8); PG8_WAIT_L(0); PG8_BAR; PG8_MMA(0, 0, At, B0); PG8_MMA(0, 1, At, B1); PG8_BAR; PG8_SCHED;
            PG8_LDA(At, 1, 1); PG8_STAGE(PG8_SB(1, 0), b3, voffB); PG8_STAGE(PG8_SB(1, 1), b3 + hstep, voffB); PG8_STAGE(PG8_SA(1, 0), a3, voffA);
            PG8_WAIT_V(8); PG8_WAIT_L(0); PG8_BAR; PG8_MMA(1, 0, At, B0); PG8_MMA(1, 1, At, B1); PG8_BAR; PG8_SCHED;
            } else {
            PG8_LDB(B0, 0, 0); PG8_SCHED; PG8_LDA(At, 0, 0); PG8_STAGE(PG8_SA(1, 1), a1 + hstep, voffA);
            PG8_WAIT_L(8); PG8_BAR; PG8_WAIT_L(0); PG8_MMA(0, 0, At, B0); PG8_BAR; PG8_SCHED;
            PG8_LDB(B1, 0, 1); PG8_STAGE(PG8_SB(0, 0), b2, voffB);
            PG8_BAR; PG8_WAIT_L(0); PG8_MMA(0, 1, At, B1); PG8_BAR;
            PG8_LDA(At, 0, 1); PG8_STAGE(PG8_SA(0, 0), a2, voffA);
            PG8_BAR; PG8_WAIT_L(0); PG8_MMA(1, 0, At, B0); PG8_BAR; PG8_SCHED;
            PG8_STAGE(PG8_SB(0, 1), b2 + hstep, voffB);
            PG8_WAIT_V(6); PG8_BAR; PG8_MMA(1, 1, At, B1); PG8_BAR;
            PG8_LDB(B0, 1, 0); PG8_SCHED; PG8_LDA(At, 1, 0); PG8_STAGE(PG8_SA(0, 1), a2 + hstep, voffA);
            PG8_WAIT_L(8); PG8_BAR; PG8_WAIT_L(0); PG8_MMA(0, 0, At, B0); PG8_BAR; PG8_SCHED;
            PG8_LDB(B1, 1, 1); PG8_STAGE(PG8_SB(1, 0), b3, voffB);
            PG8_BAR; PG8_WAIT_L(0); PG8_MMA(0, 1, At, B1); PG8_BAR;
            PG8_LDA(At, 1, 1); PG8_STAGE(PG8_SA(1, 0), a3, voffA);
            PG8_BAR; PG8_WAIT_L(0); PG8_MMA(1, 0, At, B0); PG8_BAR; PG8_SCHED;
            PG8_STAGE(PG8_SB(1, 1), b3 + hstep, voffB);
            PG8_WAIT_V(6); PG8_BAR; PG8_MMA(1, 1, At, B1); PG8_BAR;
            }
        }
        if constexpr (ALIGN_EPI) { if (wr == 0) PG8_BAR; }
        if constexpr (!Epi::AFTER_DRAIN) { E(acc, cur, wr, wc, fr, fq); S.done(cur); }
        if (!has_next) break;
#pragma unroll
        for (int a = 0; a < 2; ++a)
#pragma unroll
            for (int b = 0; b < 2; ++b)
#pragma unroll
                for (int m = 0; m < 4; ++m)
#pragma unroll
                    for (int n = 0; n < 2; ++n) acc[a][b][m][n] = (f32x4){0.f, 0.f, 0.f, 0.f};
        cur = nxt; cA = nA; cB = nB; ++ui;
        if constexpr (ALIGN_EPI) { if (wr == 1) PG8_BAR; }
    }
    PG8_WAIT_V(0);
    if constexpr (!ALIGN_EPI) { if (wr == 0) PG8_BAR; }
    PG8_BAR;
    if constexpr (Epi::AFTER_DRAIN) { E.fused(acc, cur, wr, wc, fr, fq, lds, wid, lane); S.done(cur); }
#undef PG8_SA
#undef PG8_SB
#undef PG8_STAGE
#undef PG8_LDA
#undef PG8_LDB
#undef PG8_MMA
#undef PG8_WAIT_V
#undef PG8_WAIT_L
#undef PG8_BAR
#undef PG8_SCHED
}
}

#define LAS __attribute__((address_space(3)))
typedef unsigned v4u __attribute__((ext_vector_type(4)));
__device__ __forceinline__ unsigned pk2(float lo, float hi) { return f2bf(lo) | (f2bf(hi) << 16); }
__device__ __forceinline__ void transpose_item(const float* W, int K, int N, bf16* WT, float* scr, int item, int nblk, int lane) {
    const int kb = item / nblk, nb = item % nblk, k0 = 64 * kb, n0 = 32 * nb;
    const int nn = n0 + (lane & 31);
#pragma unroll 8
    for (int i = 0; i < 32; ++i) { const int kk = 2 * i + (lane >> 5); scr[kk * 33 + (lane & 31)] = (nn < N) ? W[(size_t)(k0 + kk) * N + nn] : 0.f; }
    __builtin_amdgcn_s_waitcnt(0xc07f); asm volatile("" ::: "memory");
    const int c = lane & 7;
#pragma unroll
    for (int j = 0; j < 4; ++j) { const int n = (lane >> 3) + 8 * j; const float* sp = scr + (8 * c) * 33 + n;
        v4u o; o.x = pk2(sp[0 * 33], sp[1 * 33]); o.y = pk2(sp[2 * 33], sp[3 * 33]); o.z = pk2(sp[4 * 33], sp[5 * 33]); o.w = pk2(sp[6 * 33], sp[7 * 33]);
        *(v4u*)(WT + (size_t)(n0 + n) * K + k0 + 8 * c) = o; }
    __builtin_amdgcn_s_waitcnt(0xc07f); asm volatile("" ::: "memory");
}
__device__ __forceinline__ void cvt_bf16(const float* src, bf16* dst, size_t n) {
    for (size_t e = ((size_t)bidx() * NT + tidx()) * 8; e < n; e += (size_t)gridDim.x * NT * 8) {
        const f32x4 a = *(const f32x4*)(src + e), b = *(const f32x4*)(src + e + 4);
        v4u o; o.x = pk2(a.x, a.y); o.y = pk2(a.z, a.w); o.z = pk2(b.x, b.y); o.w = pk2(b.z, b.w);
        *(v4u*)(dst + e) = o; }
}
__device__ __forceinline__ void transpose_matrix(const float* W, int K, int N, int Npad, bf16* WT, float* scr, int gw, int ngw, int lane) {
    const int nblk = Npad / 32, nit = (K / 64) * nblk;
    for (int it = gw; it < nit; it += ngw) transpose_item(W, K, N, WT, scr, it, nblk, lane);
}
__device__ __forceinline__ void ph_prologue(unsigned char* smem) {
    const int lane = tidx() & 63, wave = tidx() >> 6;
    float* scr = (float*)smem + wave * (64 * 33);
    const int gw = bidx() * (NT / 64) + wave, ngw = gridDim.x * (NT / 64);
    unsigned char* ws = WSP;
    transpose_matrix(IN(6), 1024, AB_N, AB_LD, (bf16*)(ws + WS_WAB_IN), scr, gw, ngw, lane);
    transpose_matrix(IN(7), 1024, 1024, 1024, (bf16*)(ws + WS_WAB_OUT), scr, gw, ngw, lane);
    transpose_matrix(IN(12), 1024, 3072, 3072, (bf16*)(ws + WS_WC_IN), scr, gw, ngw, lane);
    transpose_matrix(IN(13), 1024, 1024, 1024, (bf16*)(ws + WS_WC_OUT), scr, gw, ngw, lane);
#pragma unroll 1
    for (int L = 0; L < 2; ++L) {
        transpose_matrix(IN(16) + (size_t)L * DM * 2048, 1024, 2048, 2048, (bf16*)(ws + WS_WQ + (size_t)L * 4 * MiB), scr, gw, ngw, lane);
        transpose_matrix(IN(20) + (size_t)L * DM * DM, 1024, 1024, 1024, (bf16*)(ws + WS_WG + (size_t)L * 2 * MiB), scr, gw, ngw, lane);
        transpose_matrix(IN(21) + (size_t)L * 256 * DM, 256, 1024, 1024, (bf16*)(ws + WS_WUP + (size_t)L * (MiB / 2)), scr, gw, ngw, lane);
    }
    cvt_bf16(IN(1), (bf16*)(ws + WS_P), (size_t)2 * T * 256);
    cvt_bf16(IN(17), (bf16*)(ws + WS_SUBK), (size_t)2 * 16 * 128 * 128);
}


typedef __bf16 bf2_t __attribute__((ext_vector_type(2)));
typedef unsigned u32x4g __attribute__((ext_vector_type(4)));
__device__ __forceinline__ float dot2u(unsigned a, unsigned b, float c) { return __builtin_amdgcn_fdot2_f32_bf16(__builtin_bit_cast(bf2_t, a), __builtin_bit_cast(bf2_t, b), c, false); }
__device__ __forceinline__ float dot8(u32x4g a, u32x4g b, float c) {
    c = dot2u(a[0], b[0], c); c = dot2u(a[1], b[1], c); c = dot2u(a[2], b[2], c); c = dot2u(a[3], b[3], c);
    return c;
}
__device__ __forceinline__ float bflo(unsigned d) { return __builtin_bit_cast(float, d << 16); }
__device__ __forceinline__ float bfhi(unsigned d) { return __builtin_bit_cast(float, d & 0xffff0000u); }
#define GATHER_U8(EREG, B) do { float s_[8]; \
    _Pragma("unroll") for (int k = 0; k < 8; ++k) { const int idx = __builtin_amdgcn_readlane(EREG, ((B) * 8 + k) & 63); \
        const u32x4g* up = (const u32x4g*)(U + (size_t)idx * DM); const u32x4g u0 = up[lane], u1 = up[64 + lane]; s_[k] = dot8(x1, u1, dot8(x0, u0, 0.f)); } \
    float r_[4]; const bool b5 = lane & 32, b4 = lane & 16, b3 = lane & 8; \
    _Pragma("unroll") for (int i = 0; i < 4; ++i) { const float snd = b5 ? s_[i] : s_[4 + i], kp = b5 ? s_[4 + i] : s_[i]; r_[i] = kp + __shfl_xor(snd, 32); } \
    float q_[2]; \
    _Pragma("unroll") for (int i = 0; i < 2; ++i) { const float snd = b4 ? r_[i] : r_[2 + i], kp = b4 ? r_[2 + i] : r_[i]; q_[i] = kp + __shfl_xor(snd, 16); } \
    float p_; { const float snd = b3 ? q_[0] : q_[1], kp = b3 ? q_[1] : q_[0]; p_ = kp + __shfl_xor(snd, 8); } \
    p_ += __shfl_xor(p_, 4); p_ += __shfl_xor(p_, 2); p_ += __shfl_xor(p_, 1); \
    if ((lane & 7) == 0) al[(B) * 8 + (lane >> 3)] = p_; } while (0)
#define GATHER_V8(EREG, WREG, B) do { \
    _Pragma("unroll") for (int k = 0; k < 8; ++k) { const int idx = __builtin_amdgcn_readlane(EREG, ((B) * 8 + k) & 63); \
        const float w = __builtin_bit_cast(float, __builtin_amdgcn_readlane(__builtin_bit_cast(int, WREG), ((B) * 8 + k) & 63)); \
        const u32x4g* vp = (const u32x4g*)(V + (size_t)idx * DM); const u32x4g v0 = vp[lane], v1 = vp[64 + lane]; \
        acc[0] += w * bflo(v0.x); acc[1] += w * bfhi(v0.x); acc[2] += w * bflo(v0.y); acc[3] += w * bfhi(v0.y); \
        acc[4] += w * bflo(v0.z); acc[5] += w * bfhi(v0.z); acc[6] += w * bflo(v0.w); acc[7] += w * bfhi(v0.w); \
        acc[8] += w * bflo(v1.x); acc[9] += w * bfhi(v1.x); acc[10] += w * bflo(v1.y); acc[11] += w * bfhi(v1.y); \
        acc[12] += w * bflo(v1.z); acc[13] += w * bfhi(v1.z); acc[14] += w * bflo(v1.w); acc[15] += w * bfhi(v1.w); } } while (0)
__device__ __forceinline__ void ph_peer_gather_opt(const int* eidx, const float* gw, const bf16* U, const bf16* V, float* h, const float* gain_next, bf16* XN, unsigned char* smem) {
    const int tid = tidx(), lane = tid & 63, wave = tid >> 6;
    float* al = (float*)smem + wave * 128;
    const int gwv = bidx() * (NT / 64) + wave, ngw = gridDim.x * (NT / 64);
    for (int t = gwv; t < T; t += ngw) {
        const u32x4g x0 = *(const u32x4g*)(XN + (size_t)t * DM + 8 * lane), x1 = *(const u32x4g*)(XN + (size_t)t * DM + 512 + 8 * lane);
        const int e0 = eidx[(size_t)t * 128 + lane], e1 = eidx[(size_t)t * 128 + 64 + lane];
        const float g0 = gw[(size_t)t * 128 + lane], g1 = gw[(size_t)t * 128 + 64 + lane];
#pragma unroll 1
        for (int b = 0; b < 8; ++b) GATHER_U8(e0, b);
#pragma unroll 1
        for (int b = 8; b < 16; ++b) GATHER_U8(e1, b);
        __builtin_amdgcn_s_waitcnt(0xc07f); asm volatile("" ::: "memory");
        const float w0 = g0 * gelu_tanh(al[lane]), w1 = g1 * gelu_tanh(al[64 + lane]);
        float acc[16];
#pragma unroll
        for (int i = 0; i < 16; ++i) acc[i] = 0.f;
#pragma unroll 1
        for (int b = 0; b < 8; ++b) GATHER_V8(e0, w0, b);
#pragma unroll 1
        for (int b = 8; b < 16; ++b) GATHER_V8(e1, w1, b);
        float* hp = h + (size_t)t * DM + 8 * lane;
        f32x4 h0 = *(f32x4*)(hp), h1 = *(f32x4*)(hp + 4), h2 = *(f32x4*)(hp + 512), h3 = *(f32x4*)(hp + 516);
        h0 += (f32x4){acc[0], acc[1], acc[2], acc[3]}; h1 += (f32x4){acc[4], acc[5], acc[6], acc[7]};
        h2 += (f32x4){acc[8], acc[9], acc[10], acc[11]}; h3 += (f32x4){acc[12], acc[13], acc[14], acc[15]};
        *(f32x4*)(hp) = h0; *(f32x4*)(hp + 4) = h1; *(f32x4*)(hp + 512) = h2; *(f32x4*)(hp + 516) = h3;
        float ss = 0.f;
#pragma unroll
        for (int i = 0; i < 4; ++i) ss += h0[i] * h0[i] + h1[i] * h1[i] + h2[i] * h2[i] + h3[i] * h3[i];
        const float rstd = 1.0f / sqrtf(wave_sum(ss) * (1.0f / DM) + NORM_EPS);
        const f32x4 ga = *(const f32x4*)(gain_next + 8 * lane), gb = *(const f32x4*)(gain_next + 8 * lane + 4), gc = *(const f32x4*)(gain_next + 512 + 8 * lane), gd = *(const f32x4*)(gain_next + 516 + 8 * lane);
        u32x4g o0, o1;
        o0.x = pk2(h0[0] * rstd * ga[0], h0[1] * rstd * ga[1]); o0.y = pk2(h0[2] * rstd * ga[2], h0[3] * rstd * ga[3]);
        o0.z = pk2(h1[0] * rstd * gb[0], h1[1] * rstd * gb[1]); o0.w = pk2(h1[2] * rstd * gb[2], h1[3] * rstd * gb[3]);
        o1.x = pk2(h2[0] * rstd * gc[0], h2[1] * rstd * gc[1]); o1.y = pk2(h2[2] * rstd * gc[2], h2[3] * rstd * gc[3]);
        o1.z = pk2(h3[0] * rstd * gd[0], h3[1] * rstd * gd[1]); o1.w = pk2(h3[2] * rstd * gd[2], h3[3] * rstd * gd[3]);
        *(u32x4g*)(XN + (size_t)t * DM + 8 * lane) = o0; *(u32x4g*)(XN + (size_t)t * DM + 512 + 8 * lane) = o1;
    }
}


typedef short bf16x8r __attribute__((ext_vector_type(8)));
typedef float f32x16r __attribute__((ext_vector_type(16)));
__device__ __forceinline__ float unokey(unsigned k) { const unsigned u = (k & 0x80000000u) ? (k & 0x7fffffffu) : ~k; return __builtin_bit_cast(float, u); }
#define CE_D(a, b) do { const unsigned mx_ = max(a, b), mn_ = min(a, b); a = mx_; b = mn_; } while (0)
#define SORT16_DESC(v, base) do { \
    _Pragma("unroll") for (int k_ = 2; k_ <= 16; k_ <<= 1) \
    _Pragma("unroll") for (int j_ = k_ >> 1; j_ > 0; j_ >>= 1) \
    _Pragma("unroll") for (int i_ = 0; i_ < 16; ++i_) { const int l_ = i_ ^ j_; if (l_ > i_) { if ((i_ & k_) == 0) CE_D(v[(base) + i_], v[(base) + l_]); else CE_D(v[(base) + l_], v[(base) + i_]); } } } while (0)
#define BMERGE16_DESC(v, base) do { \
    _Pragma("unroll") for (int j_ = 8; j_ > 0; j_ >>= 1) \
    _Pragma("unroll") for (int i_ = 0; i_ < 16; ++i_) { const int l_ = i_ ^ j_; if (l_ > i_) CE_D(v[(base) + i_], v[(base) + l_]); } } while (0)
#define TOPMERGE16(v, a, b) do { _Pragma("unroll") for (int i_ = 0; i_ < 16; ++i_) v[(a) + i_] = max(v[(a) + i_], v[(b) + 15 - i_]); BMERGE16_DESC(v, a); } while (0)
#define PARTNER_TOP16(v) do { unsigned o_[16]; _Pragma("unroll") for (int i_ = 0; i_ < 16; ++i_) o_[i_] = (unsigned)__shfl_xor((int)v[15 - i_], 32); \
    _Pragma("unroll") for (int i_ = 0; i_ < 16; ++i_) v[i_] = max(v[i_], o_[i_]); BMERGE16_DESC(v, 0); } while (0)
constexpr int SK_ROW = 272;
__device__ __forceinline__ void ph_peer_route_opt(const bf16* qry, const bf16* subk, int* eidx, float* gw, unsigned char* smem) {
    const int tid = tidx(), lane = tid & 63, wave = tid >> 6, r32 = lane & 31, hi = lane >> 5;
    for (int unit = bidx(); unit < 512; unit += gridDim.x) {
        const int h = unit & 7, tb = unit >> 3;
        __syncthreads();
        for (int i = tid; i < 4096; i += NT) { const int row = i >> 4, ch = i & 15;
            *(u32x4g*)(smem + row * SK_ROW + ch * 16) = *(const u32x4g*)(subk + ((size_t)(h * 2) * 128 + row) * 128 + ch * 8); }
        __syncthreads();
        const int trow = tb * 256 + wave * 32 + r32;
        unsigned top[2][16];
#pragma unroll
        for (int c = 0; c < 2; ++c) {
            f32x16r acc[4];
#pragma unroll
            for (int kb = 0; kb < 4; ++kb) acc[kb] = (f32x16r){0.f, 0.f, 0.f, 0.f, 0.f, 0.f, 0.f, 0.f, 0.f, 0.f, 0.f, 0.f, 0.f, 0.f, 0.f, 0.f};
#pragma unroll
            for (int ks = 0; ks < 8; ++ks) {
                const bf16x8r bq = *(const bf16x8r*)(qry + (size_t)trow * 2048 + h * 256 + c * 128 + ks * 16 + 8 * hi);
#pragma unroll
                for (int kb = 0; kb < 4; ++kb) {
                    const bf16x8r ak = *(const bf16x8r*)(smem + (c * 128 + kb * 32 + r32) * SK_ROW + (ks * 16 + 8 * hi) * 2);
                    acc[kb] = __builtin_amdgcn_mfma_f32_32x32x16_bf16(ak, bq, acc[kb], 0, 0, 0);
                }
            }
            unsigned k[64];
#pragma unroll
            for (int kb = 0; kb < 4; ++kb)
#pragma unroll
                for (int r = 0; r < 16; ++r) { const float sc = acc[kb][r]; const int idx = kb * 32 + (r & 3) + 8 * (r >> 2) + 4 * hi;
                    k[kb * 16 + r] = (okey(sc) & 0xffffff80u) | (unsigned)(127 - idx); }
            SORT16_DESC(k, 0); SORT16_DESC(k, 16); SORT16_DESC(k, 32); SORT16_DESC(k, 48);
            TOPMERGE16(k, 0, 16); TOPMERGE16(k, 32, 48); TOPMERGE16(k, 0, 32);
            PARTNER_TOP16(k);
#pragma unroll
            for (int i = 0; i < 16; ++i) top[c][i] = k[i];
        }
        float va[16], vb[16];
#pragma unroll
        for (int i = 0; i < 16; ++i) { va[i] = unokey((top[0][i] & 0xffffff80u) | 0x40u); vb[i] = unokey((top[1][i] & 0xffffff80u) | 0x40u); }
        unsigned ck[32];
        ck[0] = (okey(hi ? (va[2] + vb[1]) : (va[0] + vb[0])) & 0xffffff00u) | (hi ? 222u : 255u);
        ck[1] = (okey(hi ? (va[2] + vb[2]) : (va[0] + vb[1])) & 0xffffff00u) | (hi ? 221u : 254u);
        ck[2] = (okey(hi ? (va[2] + vb[3]) : (va[0] + vb[2])) & 0xffffff00u) | (hi ? 220u : 253u);
        ck[3] = (okey(hi ? (va[2] + vb[4]) : (va[0] + vb[3])) & 0xffffff00u) | (hi ? 219u : 252u);
        ck[4] = (okey(hi ? (va[3] + vb[0]) : (va[0] + vb[4])) & 0xffffff00u) | (hi ? 207u : 251u);
        ck[5] = (okey(hi ? (va[3] + vb[1]) : (va[0] + vb[5])) & 0xffffff00u) | (hi ? 206u : 250u);
        ck[6] = (okey(hi ? (va[3] + vb[2]) : (va[0] + vb[6])) & 0xffffff00u) | (hi ? 205u : 249u);
        ck[7] = (okey(hi ? (va[3] + vb[3]) : (va[0] + vb[7])) & 0xffffff00u) | (hi ? 204u : 248u);
        ck[8] = (okey(hi ? (va[4] + vb[0]) : (va[0] + vb[8])) & 0xffffff00u) | (hi ? 191u : 247u);
        ck[9] = (okey(hi ? (va[4] + vb[1]) : (va[0] + vb[9])) & 0xffffff00u) | (hi ? 190u : 246u);
        ck[10] = (okey(hi ? (va[4] + vb[2]) : (va[0] + vb[10])) & 0xffffff00u) | (hi ? 189u : 245u);
        ck[11] = (okey(hi ? (va[5] + vb[0]) : (va[0] + vb[11])) & 0xffffff00u) | (hi ? 175u : 244u);
        ck[12] = (okey(hi ? (va[5] + vb[1]) : (va[0] + vb[12])) & 0xffffff00u) | (hi ? 174u : 243u);
        ck[13] = (okey(hi ? (va[6] + vb[0]) : (va[0] + vb[13])) & 0xffffff00u) | (hi ? 159u : 242u);
        ck[14] = (okey(hi ? (va[6] + vb[1]) : (va[0] + vb[14])) & 0xffffff00u) | (hi ? 158u : 241u);
        ck[15] = (okey(hi ? (va[7] + vb[0]) : (va[0] + vb[15])) & 0xffffff00u) | (hi ? 143u : 240u);
        ck[16] = (okey(hi ? (va[7] + vb[1]) : (va[1] + vb[0])) & 0xffffff00u) | (hi ? 142u : 239u);
        ck[17] = (okey(hi ? (va[8] + vb[0]) : (va[1] + vb[1])) & 0xffffff00u) | (hi ? 127u : 238u);
        ck[18] = (okey(hi ? (va[9] + vb[0]) : (va[1] + vb[2])) & 0xffffff00u) | (hi ? 111u : 237u);
        ck[19] = (okey(hi ? (va[10] + vb[0]) : (va[1] + vb[3])) & 0xffffff00u) | (hi ? 95u : 236u);
        ck[20] = (okey(hi ? (va[11] + vb[0]) : (va[1] + vb[4])) & 0xffffff00u) | (hi ? 79u : 235u);
        ck[21] = (okey(hi ? (va[12] + vb[0]) : (va[1] + vb[5])) & 0xffffff00u) | (hi ? 63u : 234u);
        ck[22] = (okey(hi ? (va[13] + vb[0]) : (va[1] + vb[6])) & 0xffffff00u) | (hi ? 47u : 233u);
        ck[23] = (okey(hi ? (va[14] + vb[0]) : (va[1] + vb[7])) & 0xffffff00u) | (hi ? 31u : 232u);
        ck[24] = (okey(hi ? (va[15] + vb[0]) : (va[2] + vb[0])) & 0xffffff00u) | (hi ? 15u : 223u);
#pragma unroll
        for (int s = 25; s < 32; ++s) ck[s] = 0u;
        SORT16_DESC(ck, 0); SORT16_DESC(ck, 16); TOPMERGE16(ck, 0, 16);
        PARTNER_TOP16(ck);
        const float m = unokey((ck[0] & 0xffffff00u) | 0x80u);
        float l = 0.f;
#pragma unroll
        for (int r = 0; r < 16; ++r) l += __expf(unokey((ck[r] & 0xffffff00u) | 0x80u) - m);
        const float linv = 1.0f / l;
        unsigned p0[4], p1[4];
#pragma unroll
        for (int w = 0; w < 4; ++w) { p0[w] = 0u; p1[w] = 0u;
#pragma unroll
            for (int b = 0; b < 4; ++b) { p0[w] |= (127u - (top[0][4 * w + b] & 127u)) << (8 * b); p1[w] |= (127u - (top[1][4 * w + b] & 127u)) << (8 * b); } }
        int eo[8]; float go[8]; const unsigned hmask = 0u - (unsigned)hi;
#pragma unroll
        for (int rr = 0; rr < 8; ++rr) {
            const unsigned key = ck[rr] ^ ((ck[rr] ^ ck[8 + rr]) & hmask);
            const unsigned flat = 255u - (key & 255u), i = flat >> 4, j = flat & 15u;
            const unsigned wi = (i >> 2) == 0 ? p0[0] : ((i >> 2) == 1 ? p0[1] : ((i >> 2) == 2 ? p0[2] : p0[3]));
            const unsigned wj = (j >> 2) == 0 ? p1[0] : ((j >> 2) == 1 ? p1[1] : ((j >> 2) == 2 ? p1[2] : p1[3]));
            const unsigned i0 = (wi >> ((i & 3u) * 8u)) & 255u, i1 = (wj >> ((j & 3u) * 8u)) & 255u;
            eo[rr] = (int)(i0 * 128u + i1);
            go[rr] = __expf(unokey((key & 0xffffff00u) | 0x80u) - m) * linv;
        }
        int* ep = eidx + (size_t)trow * 128 + h * 16 + 8 * hi; float* gp = gw + (size_t)trow * 128 + h * 16 + 8 * hi;
        typedef int i32x4 __attribute__((ext_vector_type(4)));
        *(i32x4*)ep = (i32x4){eo[0], eo[1], eo[2], eo[3]}; *(i32x4*)(ep + 4) = (i32x4){eo[4], eo[5], eo[6], eo[7]};
        *(f32x4*)gp = (f32x4){go[0], go[1], go[2], go[3]}; *(f32x4*)(gp + 4) = (f32x4){go[4], go[5], go[6], go[7]};
    }
}

#ifndef ATTN_STORE16
#define ATTN_STORE16(p,v) (*(u32x4*)(p)=(v))
#endif
namespace attn_g {
typedef unsigned short bf16;
using bf16x8=__attribute__((ext_vector_type(8)))short;
using s16x4=__attribute__((ext_vector_type(4)))short;
using f32x16=__attribute__((ext_vector_type(16)))float;
using u32x4=__attribute__((ext_vector_type(4)))unsigned;
constexpr int D=64;
constexpr int NW=8,QBLK=32,QB=QBLK*NW,KVBLK=64;
__device__ __forceinline__ int crow(int r,int hi){return (r&3)+8*(r>>2)+4*hi;}
#define SBAR() __builtin_amdgcn_sched_barrier(0)
__device__ __forceinline__ void cmask(f32x16&p0,f32x16&p1,int jb,int qrel,int hi){
  const float NEG=-__builtin_inff(); int kb=64*jb+4*hi;
  #pragma unroll
  for(int r=0;r<16;++r){int kv=kb+(r&3)+8*(r>>2); if(kv>qrel)p0[r]=NEG; if(kv+32>qrel)p1[r]=NEG;}
}

constexpr int NSLOT=3, SLOTB=8192;
constexpr int LDS_K=0, LDS_V=NSLOT*SLOTB, LDS_WS=2*NSLOT*SLOTB, LDS_OST=LDS_WS+NW*64*4, LDS_MSK=LDS_OST+NW*4096, LDS_BYTES=LDS_MSK+NW*2*256;
constexpr float C2=0.125f*1.4426950408889634f;
__device__ __forceinline__ void glds16(const void*gsrc,unsigned lds_dst){unsigned keep;
  asm volatile("s_mov_b32 %0, m0\n\ts_mov_b32 m0, %2\n\ts_nop 0\n\tglobal_load_lds_dwordx4 %1, off\n\ts_mov_b32 m0, %0":"=&s"(keep):"v"(gsrc),"s"(lds_dst):"memory");}
__device__ __forceinline__ void glds16s(const void*sbase,unsigned voff,unsigned lds_dst){unsigned keep;
  asm volatile("s_nop 4\n\ts_mov_b32 %0, m0\n\ts_mov_b32 m0, %3\n\ts_nop 0\n\tglobal_load_lds_dwordx4 %1, %2\n\ts_mov_b32 m0, %0":"=&s"(keep):"v"(voff),"s"(sbase),"s"(lds_dst):"memory");}
__device__ __forceinline__ void glds4s(const void*sbase,unsigned voff,unsigned lds_dst){unsigned keep;
  asm volatile("s_nop 4\n\ts_mov_b32 %0, m0\n\ts_mov_b32 m0, %3\n\ts_nop 0\n\tglobal_load_lds_dword %1, %2\n\ts_mov_b32 m0, %0":"=&s"(keep):"v"(voff),"s"(sbase),"s"(lds_dst):"memory");}
__device__ __forceinline__ unsigned bandw(int e){
  const unsigned a=(e<0)?0u:((e>=31)?0xffffffffu:((2u<<e)-1u)); const int f=e-128; const unsigned b=(f<=0)?0u:((f>=32)?0xffffffffu:((1u<<f)-1u)); return a&~b; }
__device__ __forceinline__ float max3f(float a,float b,float c){float r;asm("v_max3_f32 %0, %1, %2, %3":"=v"(r):"v"(a),"v"(b),"v"(c));return r;}
__device__ __forceinline__ float max2f(float a,float b){float r;asm("v_max_f32_e32 %0, %1, %2":"=v"(r):"v"(a),"v"(b));return r;}
__device__ __forceinline__ float fadd_s(float a,float b){float r;asm("v_add_f32_e32 %0, %1, %2":"=v"(r):"v"(a),"v"(b));return r;}
__device__ __forceinline__ float fsub_s(float a,float b){float r;asm("v_sub_f32_e32 %0, %1, %2":"=v"(r):"v"(a),"v"(b));return r;}
typedef float f32x2_t __attribute__((ext_vector_type(2))); typedef __bf16 bf16x2_t __attribute__((ext_vector_type(2)));
__device__ __forceinline__ unsigned cvtpk_s(float lo,float hi){f32x2_t v={lo,hi};bf16x2_t b=__builtin_convertvector(v,bf16x2_t);return __builtin_bit_cast(unsigned,b);}
#define WAIT_BAR(N) asm volatile("s_waitcnt vmcnt(" #N ") lgkmcnt(0)\n\ts_barrier":::"memory")

template<bool NEGM> __device__ __forceinline__ void qkt(f32x16&p0,f32x16&p1,const char*Kslot,const bf16x8*qr,const f32x16&negm,int r32,int hi){ const f32x16 zc_={};
  const char*kb=Kslot+hi*1024+r32*16;
  #pragma unroll
  for(int d0=0;d0<4;++d0){
    const bf16x8 b0=*reinterpret_cast<const bf16x8*>(kb+d0*2048);
    const bf16x8 b1=*reinterpret_cast<const bf16x8*>(kb+d0*2048+512);
    if(d0==0){p0=__builtin_amdgcn_mfma_f32_32x32x16_bf16(b0,qr[0],NEGM?negm:zc_,0,0,0);p1=__builtin_amdgcn_mfma_f32_32x32x16_bf16(b1,qr[0],NEGM?negm:zc_,0,0,0);}
    else{p0=__builtin_amdgcn_mfma_f32_32x32x16_bf16(b0,qr[d0],p0,0,0,0);p1=__builtin_amdgcn_mfma_f32_32x32x16_bf16(b1,qr[d0],p1,0,0,0);}}
}
typedef __attribute__((address_space(3))) const char* lds_cptr;
typedef short v4i16_t __attribute__((ext_vector_type(4)));
__device__ __forceinline__ void kload8(bf16x8*kf,lds_cptr kp){
  kf[0]=*(const __attribute__((address_space(3))) bf16x8*)(kp);      kf[1]=*(const __attribute__((address_space(3))) bf16x8*)(kp+512);
  kf[2]=*(const __attribute__((address_space(3))) bf16x8*)(kp+2048); kf[3]=*(const __attribute__((address_space(3))) bf16x8*)(kp+2560);
  kf[4]=*(const __attribute__((address_space(3))) bf16x8*)(kp+4096); kf[5]=*(const __attribute__((address_space(3))) bf16x8*)(kp+4608);
  kf[6]=*(const __attribute__((address_space(3))) bf16x8*)(kp+6144); kf[7]=*(const __attribute__((address_space(3))) bf16x8*)(kp+6656);
}
__device__ __forceinline__ void kload2(bf16x8*kf,lds_cptr kp,int j){ kf[2*j]=*(const __attribute__((address_space(3))) bf16x8*)(kp+j*2048); kf[2*j+1]=*(const __attribute__((address_space(3))) bf16x8*)(kp+j*2048+512); }
__device__ __forceinline__ s16x4 vtr(lds_cptr p){ return __builtin_bit_cast(s16x4,__builtin_amdgcn_ds_read_tr16_b64_v4i16((__attribute__((address_space(3))) v4i16_t*)p)); }
__device__ __forceinline__ float rowmax(const f32x16&p0,const f32x16&p1){
  float a=max3f(p0[0],p0[1],p1[0]),b=max3f(p0[2],p0[3],p1[1]);a=max3f(a,p1[2],p1[3]);
  #pragma unroll
  for(int r=4;r<16;r+=4){a=max3f(a,p0[r],p0[r+1]);b=max3f(b,p0[r+2],p0[r+3]);a=max3f(a,p1[r],p1[r+1]);b=max3f(b,p1[r+2],p1[r+3]);}
  const float m=max2f(a,b);
  auto rr=__builtin_amdgcn_permlane32_swap(__float_as_uint(m),__float_as_uint(m),false,false);
  return max2f(__uint_as_float(rr[0]),__uint_as_float(rr[1]));
}
__device__ __forceinline__ void pv(f32x16*o,int vb,bf16x8 pa0,bf16x8 pa1,bf16x8 pa2,bf16x8 pa3){
  #pragma unroll
  for(int d0=0;d0<2;++d0){s16x4 lo[4],hi[4];
    #pragma unroll
    for(int ks=0;ks<4;++ks){
      asm volatile("ds_read_b64_tr_b16 %0,%1 offset:%c2":"=&v"(lo[ks]):"v"(vb),"i"(d0*4096+ks*1024):"memory");
      asm volatile("ds_read_b64_tr_b16 %0,%1 offset:%c2":"=&v"(hi[ks]):"v"(vb),"i"(d0*4096+ks*1024+512):"memory");}
    asm volatile("s_waitcnt lgkmcnt(0)":::"memory");SBAR();
    #define PK(k) (bf16x8){lo[k][0],lo[k][1],lo[k][2],lo[k][3],hi[k][0],hi[k][1],hi[k][2],hi[k][3]}
    o[d0]=__builtin_amdgcn_mfma_f32_32x32x16_bf16(pa0,PK(0),o[d0],0,0,0);
    o[d0]=__builtin_amdgcn_mfma_f32_32x32x16_bf16(pa1,PK(1),o[d0],0,0,0);
    o[d0]=__builtin_amdgcn_mfma_f32_32x32x16_bf16(pa2,PK(2),o[d0],0,0,0);
    o[d0]=__builtin_amdgcn_mfma_f32_32x32x16_bf16(pa3,PK(3),o[d0],0,0,0);
    #undef PK
  }
}

#ifndef ATTN_STORE16
#define ATTN_STORE16(p,v) (*(u32x4*)(p)=(v))
#endif
template<int MODE,int THRL> __device__ __forceinline__ void attn_unit(const bf16*Qu,long qs,const bf16*__restrict__ Kh,const bf16*__restrict__ Vh,long kvs,bf16*Ou,long os,float*lse,long lses,const int NT,
    const unsigned*selp,const char*Msrc,const int e0,char*shm){
  constexpr bool USE_NEGM=(MODE==0);
  const int tid=tidx(),lane=tid&63,r32=lane&31,hi=lane>>5; const int wid=__builtin_amdgcn_readfirstlane(tid>>6);
  const bf16*Qw=Qu+(long)(wid*QBLK)*qs;
  const unsigned lds0=(unsigned)(uintptr_t)shm;
  float*wsf=(float*)(shm+LDS_WS)+wid*64;
  const unsigned kvoff=(unsigned)(((int)lane*(int)kvs+wid*8)*2);
  const unsigned vvoff=(unsigned)(((16*(wid&3)+(lane>>2))*(int)kvs+(wid>>2)*32+(lane&3)*8)*2);
  const unsigned kdst=lds0+LDS_K+wid*1024, vdst=lds0+LDS_V+wid*1024;
  #define KT(t) ((MODE==0)?(((t)<4)?(NT-4+(t)):((t)-4)):(t))
  #define DMA_K(t,slot) glds16s((const char*)Kh+(long)KT(t)*(KVBLK*2)*kvs,kvoff,(unsigned)__builtin_amdgcn_readfirstlane(kdst+(slot)))
  #define DMA_V(t,slot) glds16s((const char*)Vh+(long)KT(t)*(KVBLK*2)*kvs,vvoff,(unsigned)__builtin_amdgcn_readfirstlane(vdst+(slot)))
  const unsigned mvoff=(unsigned)((wid*QBLK)*8+lane*4); const unsigned mdst=lds0+LDS_MSK+wid*512;
  #define DMA_M(t) do{ if(MODE==1) glds4s(Msrc+(long)(t)*(8192*8),mvoff,(unsigned)__builtin_amdgcn_readfirstlane(mdst+((t)&1)*256)); }while(0)
  const int vb0=(int)(lds0+LDS_V)+((lane>>4)&1)*32+(lane&3)*8+(4*hi+((lane&15)>>2))*64;
  const char*Kbase=shm+LDS_K; bf16x8 kf[8];
  const lds_cptr shm3=(lds_cptr)shm; const lds_cptr kp0=shm3+LDS_K+hi*1024+r32*16; const lds_cptr vp0=shm3+LDS_V+((lane>>4)&1)*32+(lane&3)*8+(4*hi+((lane&15)>>2))*64;
  DMA_M(0);DMA_M(1);
  DMA_K(0,0);DMA_V(0,0);DMA_K(1,SLOTB);
  bf16x8 qr[4];
  #pragma unroll
  for(int d0=0;d0<4;++d0)qr[d0]=*reinterpret_cast<const bf16x8*>(&Qw[(long)r32*qs+d0*16+hi*8]);
  unsigned selw=0u; if(MODE==0) selw=selp[(long)(wid*QBLK+r32)*8];
  float mhat=0.f,l_reg=0.f;f32x16 o[2];f32x16 negm; { float zz_=0.f; asm volatile("":"+v"(zz_));
    _Pragma("unroll") for(int r=0;r<16;++r){o[0][r]=zz_;o[1][r]=zz_;negm[r]=zz_;} } if(USE_NEGM) asm volatile("":"+v"(negm));
  const int qrel=wid*QBLK+r32;
  #define CMASK(P0,P1,t) do{ const float NEG_=-__builtin_inff(); \
    if(MODE==0){ if((t)<4){cmask(P0,P1,(t),qrel,hi);} else { const unsigned n_=(unsigned)(((t)-4)>>2); const bool ok_=(n_==(selw&255u))|(n_==((selw>>8)&255u))|(n_==((selw>>16)&255u)); \
        _Pragma("unroll") for(int r=0;r<16;++r){P0[r]=ok_?P0[r]:NEG_;P1[r]=ok_?P1[r]:NEG_;} } } \
    else if(MODE==1){ const unsigned long long mw_=*(const __attribute__((address_space(3))) unsigned long long*)(shm3+LDS_MSK+wid*512+((t)&1)*256+r32*8); \
        const unsigned lo_=((unsigned)mw_)>>(4*hi), hh_=((unsigned)(mw_>>32))>>(4*hi); \
        _Pragma("unroll") for(int r=0;r<16;++r){ const unsigned bit_=1u<<((r&3)+8*(r>>2)); P0[r]=(lo_&bit_)?(P0[r]-mhat):NEG_; P1[r]=(hh_&bit_)?(P1[r]-mhat):NEG_; } } \
    else { const int e_=e0-64*(t)+qrel-4*hi; const unsigned lo_=bandw(e_), hh_=bandw(e_-32);     \
        _Pragma("unroll") for(int r=0;r<16;++r){ const unsigned bit_=1u<<((r&3)+8*(r>>2)); P0[r]=(lo_&bit_)?(P0[r]-mhat):NEG_; P1[r]=(hh_&bit_)?(P1[r]-mhat):NEG_; } } }while(0)
  bool resc=false;
  #define START(P0,P1) do{ const float rm=rowmax(P0,P1); resc=false; \
    { const float dl=(rm<-1e30f)?0.f:rm; mhat=fadd_s(mhat,dl); \
      _Pragma("unroll") for(int r=0;r<16;++r){P0[r]=fsub_s(P0[r],dl);P1[r]=fsub_s(P1[r],dl);} \
      if(USE_NEGM){ _Pragma("unroll") for(int r=0;r<16;++r)negm[r]=-mhat; asm volatile("":"+v"(negm)); } } \
    _Pragma("unroll") for(int r=0;r<16;++r)P0[r]=__builtin_amdgcn_exp2f(P0[r]); }while(0)
  #define RESC() do{ if(resc){ asm volatile("s_waitcnt lgkmcnt(0)":::"memory"); \
      _Pragma("unroll") for(int d_=0;d_<2;++d_) _Pragma("unroll") for(int r=0;r<16;++r)o[d_][r]*=wsf[crow(r,hi)]; } }while(0)
  f32x16 pA0,pA1,pB0,pB1; const f32x16 zc16={};
  int sl_prev=0,sl_cur=0,sl_next=SLOTB;
  #define ROT() do{sl_prev=sl_cur;sl_cur=sl_next;sl_next=(sl_next==(NSLOT-1)*SLOTB)?0:sl_next+SLOTB;}while(0)
  DMA_K(2,2*SLOTB);
  WAIT_BAR(3);
  qkt<USE_NEGM>(pA0,pA1,Kbase,qr,negm,r32,hi);asm volatile("s_nop 15\n\ts_nop 7":"+v"(pA0),"+v"(pA1));CMASK(pA0,pA1,0);
  START(pA0,pA1);
  _Pragma("unroll") for(int r=0;r<16;++r)pA1[r]=__builtin_amdgcn_exp2f(pA1[r]);
  WAIT_BAR(0);
  DMA_K(3,0);DMA_V(1,SLOTB);
  ROT();
  kload8(kf,kp0+sl_cur);
  WAIT_BAR(2);
  s16x4 vlo[8],vhi[8]; u32x4 pw0,pw1,pw2,pw3;
  #define PKW(P,B) cvtpk_s(P[B],P[B+1])
  #define PAF(k) __builtin_bit_cast(bf16x8,pw##k)
  #define VFR(i) (bf16x8){vlo[i][0],vlo[i][1],vlo[i][2],vlo[i][3],vhi[i][0],vhi[i][1],vhi[i][2],vhi[i][3]}
  #define PIN(x) asm volatile("":"+v"(x))
  #define MX3(a,b,c) __builtin_fmaxf(__builtin_fmaxf((a),(b)),(c))
  #define GAPA(MF,A0,A1,A2,A3,W0,W1,PW) do{ MF; sacc+=A0; sacc+=A1; sacc+=A2; sacc+=A3; PIN(sacc); W0; W1; PIN(PW); SBAR(); }while(0)
  #define EX(v) __builtin_amdgcn_exp2f(v)
  #define GAPB(MF,X,B) do{ MF; X[B]=EX(X[B]); X[B+1]=EX(X[B+1]); X[B+2]=EX(X[B+2]); X[B+3]=EX(X[B+3]); PIN(X); SBAR(); }while(0)
  #define VRD(i) do{ vlo[i]=vtr(vp_+(((i)>>2)*4096+((i)&3)*1024)); vhi[i]=vtr(vp_+(((i)>>2)*4096+((i)&3)*1024+512)); }while(0)
  #define KRD(G,j) do{ if(G){ kload2(kf,kp0+sl_next,j); SBAR(); } }while(0)
  #define STEP(C0,C1,P0,P1,t,GK,GV,GL) do{ SBAR(); if((t)+1<NT){DMA_M((t)+1);} \
    const lds_cptr vp_=vp0+sl_prev; \
    VRD(0); SBAR(); float sacc=(P0[0]+P0[1]); \
    GAPA(C0=__builtin_amdgcn_mfma_f32_32x32x16_bf16(kf[0],qr[0],USE_NEGM?negm:zc16,0,0,0), P0[2],P0[3],P0[4],P0[5],     pw0[0]=PKW(P0,0), pw0[1]=PKW(P0,2), pw0); \
    VRD(4); SBAR(); GAPA(C1=__builtin_amdgcn_mfma_f32_32x32x16_bf16(kf[1],qr[0],USE_NEGM?negm:zc16,0,0,0), P0[6],P0[7],P0[8],P0[9],     pw0[2]=PKW(P0,4), pw0[3]=PKW(P0,6), pw0); \
    VRD(1); SBAR(); GAPA(C0=__builtin_amdgcn_mfma_f32_32x32x16_bf16(kf[2],qr[1],C0,0,0,0),   P0[10],P0[11],P0[12],P0[13], pw1[0]=PKW(P0,8), pw1[1]=PKW(P0,10), pw1); \
    VRD(5); SBAR(); GAPA(C1=__builtin_amdgcn_mfma_f32_32x32x16_bf16(kf[3],qr[1],C1,0,0,0),   P0[14],P0[15],P1[0],P1[1],   pw1[2]=PKW(P0,12),pw1[3]=PKW(P0,14), pw1); \
    VRD(2); SBAR(); GAPA(C0=__builtin_amdgcn_mfma_f32_32x32x16_bf16(kf[4],qr[2],C0,0,0,0),   P1[2],P1[3],P1[4],P1[5],     pw2[0]=PKW(P1,0), pw2[1]=PKW(P1,2), pw2); \
    VRD(6); SBAR(); GAPA(C1=__builtin_amdgcn_mfma_f32_32x32x16_bf16(kf[5],qr[2],C1,0,0,0),   P1[6],P1[7],P1[8],P1[9],     pw2[2]=PKW(P1,4), pw2[3]=PKW(P1,6), pw2); \
    VRD(3); SBAR(); GAPA(C0=__builtin_amdgcn_mfma_f32_32x32x16_bf16(kf[6],qr[3],C0,0,0,0),   P1[10],P1[11],P1[12],P1[13], pw3[0]=PKW(P1,8), pw3[1]=PKW(P1,10), pw3); \
    VRD(7); SBAR(); GAPA(C1=__builtin_amdgcn_mfma_f32_32x32x16_bf16(kf[7],qr[3],C1,0,0,0),   P1[14],P1[15],0.f,0.f,       pw3[2]=PKW(P1,12),pw3[3]=PKW(P1,14), pw3); \
    l_reg+=sacc; \
    if(GK){DMA_K((t)+3,sl_cur);} if(GV){DMA_V((t)+1,sl_next);} \
    CMASK(C0,C1,t); \
    { float a=MX3(C0[0],C0[1],C1[0]),b=MX3(C0[2],C0[3],C1[1]); a=MX3(a,C1[2],C1[3]); \
      _Pragma("unroll") for(int r=4;r<16;r+=4){a=MX3(a,C0[r],C0[r+1]);b=MX3(b,C0[r+2],C0[r+3]);a=MX3(a,C1[r],C1[r+1]);b=MX3(b,C1[r+2],C1[r+3]);} \
      float rm=__builtin_fmaxf(a,b); { auto rr=__builtin_amdgcn_permlane32_swap(__float_as_uint(rm),__float_as_uint(rm),false,false); rm=__builtin_fmaxf(__uint_as_float(rr[0]),__uint_as_float(rr[1])); } \
      resc=false; \
      if(__builtin_expect(__any(rm>(float)THRL),0)){ const float dl=__builtin_fmaxf(rm,0.f); mhat+=dl; \
        _Pragma("unroll") for(int r=0;r<16;++r){C0[r]-=dl;C1[r]-=dl;} \
        if(USE_NEGM){ _Pragma("unroll") for(int r=0;r<16;++r)negm[r]=-mhat; asm volatile("":"+v"(negm)); } \
        const float f=__builtin_amdgcn_exp2f(-dl); l_reg*=f; if(hi==0)wsf[r32]=f; resc=true; } } \
    SBAR(); \
    GAPB(o[0]=__builtin_amdgcn_mfma_f32_32x32x16_bf16(PAF(0),VFR(0),o[0],0,0,0), C0,0); \
    GAPB(o[1]=__builtin_amdgcn_mfma_f32_32x32x16_bf16(PAF(0),VFR(4),o[1],0,0,0), C0,4); \
    KRD(GL,0); GAPB(o[0]=__builtin_amdgcn_mfma_f32_32x32x16_bf16(PAF(1),VFR(1),o[0],0,0,0), C0,8); \
    KRD(GL,1); GAPB(o[1]=__builtin_amdgcn_mfma_f32_32x32x16_bf16(PAF(1),VFR(5),o[1],0,0,0), C0,12); \
    KRD(GL,2); GAPB(o[0]=__builtin_amdgcn_mfma_f32_32x32x16_bf16(PAF(2),VFR(2),o[0],0,0,0), C1,0); \
    KRD(GL,3); GAPB(o[1]=__builtin_amdgcn_mfma_f32_32x32x16_bf16(PAF(2),VFR(6),o[1],0,0,0), C1,4); \
    GAPB(o[0]=__builtin_amdgcn_mfma_f32_32x32x16_bf16(PAF(3),VFR(3),o[0],0,0,0), C1,8); \
    GAPB(o[1]=__builtin_amdgcn_mfma_f32_32x32x16_bf16(PAF(3),VFR(7),o[1],0,0,0), C1,12); \
    }while(0)
  int t=1;
  for(;t+5<NT;t+=2){
    STEP(pB0,pB1,pA0,pA1,t,true,true,true);     WAIT_BAR(2); RESC(); ROT();
    STEP(pA0,pA1,pB0,pB1,t+1,true,true,true);   WAIT_BAR(2); RESC(); ROT();
  }
  #define ENDW(tt) do{ if((tt)+3<NT){WAIT_BAR(2);} else if((tt)+2<NT){WAIT_BAR(1);} else {WAIT_BAR(0);} }while(0)
  for(;t+1<NT;t+=2){
    STEP(pB0,pB1,pA0,pA1,t,(t+3<NT),(t+1<NT),(t+1<NT));       ENDW(t);   RESC(); ROT();
    STEP(pA0,pA1,pB0,pB1,t+1,(t+4<NT),(t+2<NT),(t+2<NT));     ENDW(t+1); RESC(); ROT();
  }
  STEP(pB0,pB1,pA0,pA1,NT-1,false,false,false); RESC();
  { float sacc=pB0[0]+pB0[1]; _Pragma("unroll") for(int r=2;r<16;++r)sacc+=pB0[r]; _Pragma("unroll") for(int r=0;r<16;++r)sacc+=pB1[r]; l_reg+=sacc;
    pw0=(u32x4){PKW(pB0,0),PKW(pB0,2),PKW(pB0,4),PKW(pB0,6)};pw1=(u32x4){PKW(pB0,8),PKW(pB0,10),PKW(pB0,12),PKW(pB0,14)};pw2=(u32x4){PKW(pB1,0),PKW(pB1,2),PKW(pB1,4),PKW(pB1,6)};pw3=(u32x4){PKW(pB1,8),PKW(pB1,10),PKW(pB1,12),PKW(pB1,14)};
    SBAR(); pv(o,vb0+sl_cur,PAF(0),PAF(1),PAF(2),PAF(3)); }
  #undef PKW
  #undef PAF
  #undef VFR
  #undef PIN
  #undef MX3
  #undef GAPA
  #undef GAPB
  #undef EX
  #undef VRD
  #undef KRD
  #undef STEP
  #undef ENDW
  {auto rr=__builtin_amdgcn_permlane32_swap(__float_as_uint(l_reg),__float_as_uint(l_reg),false,false);l_reg=__uint_as_float(rr[0])+__uint_as_float(rr[1]);}
  if(hi==0)wsf[32+r32]=l_reg;asm volatile("s_waitcnt lgkmcnt(0)":::"memory");
  float rli[16];
  #pragma unroll
  for(int r=0;r<16;++r)rli[r]=__builtin_amdgcn_rcpf(wsf[32+crow(r,hi)]);
  long os2=os,lses2=lses; asm volatile("":"+s"(os2),"+s"(lses2));
  if(lse!=nullptr && hi==0) lse[(long)(wid*QBLK+r32)*lses2]=mhat+__log2f(l_reg);
  bf16*Ow=Ou+(long)(wid*QBLK)*os2;
  { bf16*stg=(bf16*)(shm+LDS_OST)+wid*2048;
    #pragma unroll
    for(int r=0;r<16;++r){const int orow=crow(r,hi);
      #pragma unroll
      for(int d0=0;d0<2;++d0)stg[orow*64+d0*32+r32]=(bf16)f2bf(o[d0][r]*rli[r]);}
    asm volatile("s_waitcnt lgkmcnt(0)":::"memory");
    #pragma unroll
    for(int i=0;i<4;++i){const int row=i*8+(lane>>3),ch=lane&7; const u32x4 v=*(const u32x4*)(stg+row*64+ch*8); ATTN_STORE16(Ow+(long)row*os2+ch*8,v);} }
  asm volatile("s_waitcnt lgkmcnt(0)\n\ts_barrier":::"memory");
  #undef DMA_K
  #undef DMA_V
  #undef DMA_M
  #undef KT
  #undef CMASK
  #undef START
  #undef RESC
  #undef ROT
}
constexpr int ATTN_LDS_BYTES=LDS_BYTES;
#undef SBAR
#undef WAIT_BAR
}

__device__ __forceinline__ int vcu_of(int G, int bx) { return (G % 8 == 0) ? (bx % 8) * (G / 8) + bx / 8 : bx; }
__device__ __forceinline__ void ph_attn_moba(const bf16* QKV, const unsigned* SEL, bf16* O, unsigned char* smem) {
    const int G = (int)gridDim.x, vcu = vcu_of(G, bidx());
#pragma unroll 1
    for (int idx = 2 * vcu; idx < 512; idx += ((idx & 1) ? 2 * G - 1 : 1)) {
        const int bh = idx >> 5, j = idx & 31, qb = (j & 1) ? 31 - (j >> 1) : (j >> 1), b = bh >> 3, h = bh & 7;
        const long row0 = (long)b * SEQ + 256 * qb, kv0 = (long)b * SEQ * AB_LD;
        attn_g::attn_unit<0, 8>(QKV + row0 * AB_LD + CQA + h * 64, AB_LD, QKV + kv0 + CKA + h * 64, QKV + kv0 + CVA + h * 64, AB_LD, O + row0 * DM + h * 64, DM, nullptr, 0, 4 * qb + 4,
                                SEL + row0 * 8 + h, nullptr, 0, (char*)smem);
    }
}


__device__ __forceinline__ void ph_attn_dsa(const bf16* QKV, const unsigned long long* MASK, bf16* O, unsigned char* smem) {
    const int G = (int)gridDim.x, vcu = vcu_of(G, bidx());
#pragma unroll 1
    for (int idx = 2 * vcu; idx < 512; idx += ((idx & 1) ? 2 * G - 1 : 1)) {
        const int bh = idx >> 5, j = idx & 31, qb = (j & 1) ? 31 - (j >> 1) : (j >> 1), b = bh >> 3, h = bh & 7;
        const long row0 = (long)b * SEQ + 256 * qb, kv0 = (long)b * SEQ * AB_LD;
        attn_g::attn_unit<1, 8>(QKV + row0 * AB_LD + CQB + h * 64, AB_LD, QKV + kv0 + CKB + h * 64, QKV + kv0 + CVB + h * 64, AB_LD, O + row0 * DM + 512 + h * 64, DM, nullptr, 0, 4 * qb + 4,
                                nullptr, (const char*)(MASK + (size_t)b * 128 * SEQ + 256 * qb), 0, (char*)smem);
    }
}
__device__ __forceinline__ void ph_attn_dilated(const bf16* QKV1, bf16* OG, float* LSE, unsigned char* smem) {
    const int G = (int)gridDim.x, vcu = vcu_of(G, bidx());
#pragma unroll 1
    for (int u = vcu; u < 3072; u += G) {
        const int g = u >> 10, bh = (u >> 5) & 31, j = u & 31, b = bh >> 4, h = bh & 15;
        const int lg = 2 * g, dil = 1 << lg, per = 32 >> lg;
        const int res = j / per, mb = j % per, m0 = 256 * mb, mk0 = (mb == 0) ? 0 : m0 - 128, nt = (m0 + 256 - mk0) / 64;
        const long qrow = (long)b * SEQ + res + (long)dil * m0, krow = (long)b * SEQ + res + (long)dil * mk0;
        attn_g::attn_unit<2, 8>(QKV1 + qrow * C_LD + h * 64, (long)dil * C_LD, QKV1 + krow * C_LD + 1024 + h * 64, QKV1 + krow * C_LD + 2048 + h * 64, (long)dil * C_LD,
                                OG + ((size_t)g * T + qrow) * DM + h * 64, (long)dil * DM, LSE + ((size_t)g * T + qrow) * 16 + h, (long)dil * 16, nt, nullptr, nullptr, m0 - mk0, (char*)smem);
    }
}


__device__ __forceinline__ size_t score_base(int b, int qb) { return (size_t)65536 * (size_t)(528 * b + (qb * (qb + 1)) / 2); }
__device__ __forceinline__ void ph_dsa_score(const bf16* QKV, float* S, unsigned char* smem) {
    using attn_g::bf16x8; using attn_g::f32x16;
    typedef __attribute__((address_space(3))) const char* lcp;
    const int tid = tidx(), lane = tid & 63, r32 = lane & 31, hi = lane >> 5; const int wid = __builtin_amdgcn_readfirstlane(tid >> 6);
    const unsigned lds0 = (unsigned)(uintptr_t)smem;
    const unsigned kvoff = (unsigned)((lane * AB_LD + wid * 8) * 2);
#pragma unroll 1
    for (int item = bidx(); item < 544; item += (int)gridDim.x) {
        const int b = item / 272; int rr = item % 272, qb = 0;
#pragma unroll 1
        for (;;) { const int nc = (qb + 2) >> 1; if (rr < nc) break; rr -= nc; ++qb; }
        const int t0 = 8 * rr, t1 = min(t0 + 8, 4 * qb + 4);
        const bf16* qrow = QKV + ((size_t)b * SEQ + 256 * qb + wid * 32 + r32) * AB_LD;
        bf16x8 qr[4][4]; float w[4];
#pragma unroll
        for (int h = 0; h < 4; ++h) { w[h] = bf2f(qrow[CWI + h]);
#pragma unroll
            for (int d0 = 0; d0 < 4; ++d0) qr[h][d0] = *(const bf16x8*)(qrow + CQI + h * 64 + d0 * 16 + hi * 8); }
        const char* kbase = (const char*)(QKV + (size_t)b * SEQ * AB_LD + CKI);
        float* srow = S + score_base(b, qb) + (size_t)(wid * 32 + r32) * (256 * (qb + 1)) + 4 * hi;
#define SC_DMA(t) attn_g::glds16s(kbase + (size_t)(t) * (64 * AB_LD * 2), kvoff, (unsigned)__builtin_amdgcn_readfirstlane(lds0 + (((t) - t0) & 1) * 8192 + wid * 1024))
        SC_DMA(t0);
        asm volatile("s_waitcnt vmcnt(0) lgkmcnt(0)\n\ts_barrier" ::: "memory");
#pragma unroll 1
        for (int t = t0; t < t1; ++t) {
            if (t + 1 < t1) SC_DMA(t + 1);
            const lcp kb = (lcp)smem + ((t - t0) & 1) * 8192 + hi * 1024 + r32 * 16;
            bf16x8 kf[4][2];
#pragma unroll
            for (int d0 = 0; d0 < 4; ++d0) { kf[d0][0] = *(const __attribute__((address_space(3))) bf16x8*)(kb + d0 * 2048); kf[d0][1] = *(const __attribute__((address_space(3))) bf16x8*)(kb + d0 * 2048 + 512); }
            f32x16 sc0, sc1;
#pragma unroll
            for (int r = 0; r < 16; ++r) { sc0[r] = 0.f; sc1[r] = 0.f; }
#pragma unroll
            for (int h = 0; h < 4; ++h) {
                f32x16 p0 = {}, p1 = {};
#pragma unroll
                for (int d0 = 0; d0 < 4; ++d0) { p0 = __builtin_amdgcn_mfma_f32_32x32x16_bf16(kf[d0][0], qr[h][d0], p0, 0, 0, 0); p1 = __builtin_amdgcn_mfma_f32_32x32x16_bf16(kf[d0][1], qr[h][d0], p1, 0, 0, 0); }
#pragma unroll
                for (int r = 0; r < 16; ++r) { sc0[r] = fmaf(w[h], fmaxf(p0[r], 0.f), sc0[r]); sc1[r] = fmaf(w[h], fmaxf(p1[r], 0.f), sc1[r]); }
                __builtin_amdgcn_sched_barrier(0);
            }
#pragma unroll
            for (int g = 0; g < 4; ++g) {
                *(f32x4*)(srow + 64 * t + 8 * g) = (f32x4){sc0[4 * g], sc0[4 * g + 1], sc0[4 * g + 2], sc0[4 * g + 3]};
                *(f32x4*)(srow + 64 * t + 8 * g + 32) = (f32x4){sc1[4 * g], sc1[4 * g + 1], sc1[4 * g + 2], sc1[4 * g + 3]};
            }
            asm volatile("s_waitcnt vmcnt(8) lgkmcnt(0)\n\ts_barrier" ::: "memory");
        }
#undef SC_DMA
    }
}
__device__ __forceinline__ void ph_dsa_select_opt(const float* S, unsigned long long* mask) {
    const int tid = tidx(), lane = tid & 63, wave = tid >> 6;
    const int gwv = bidx() * (NT / 64) + wave, ngw = (int)gridDim.x * (NT / 64);
#pragma unroll 1
    for (int t = gwv; t < T; t += ngw) {
        const int b = t / SEQ, tt = t % SEQ, n = tt + 1, qb = tt >> 8;
        const float* row = S + score_base(b, qb) + (size_t)(tt & 255) * (256 * (qb + 1));
        unsigned v[128];
#pragma unroll
        for (int g = 0; g < 8; ++g) {
            if (g * 1024 < n) {
#pragma unroll
                for (int j = 16 * g; j < 16 * g + 16; ++j) { const int kv = 64 * j + lane; v[j] = (kv < n) ? okey(row[(kv < n) ? kv : 0]) : 0u; }
            } else {
#pragma unroll
                for (int j = 16 * g; j < 16 * g + 16; ++j) v[j] = 0u;
            }
        }
        unsigned thr = 0u, need = 0u;
        if (n > 256) {
            unsigned lo = 0u, hi = 0xffffffffu;
#pragma unroll 1
            while (lo < hi) {
                const unsigned mid = lo + ((hi - lo) >> 1) + ((hi - lo) & 1u);
                int c = 0;
#pragma unroll
                for (int g = 0; g < 8; ++g) if (g * 1024 < n) {
#pragma unroll
                    for (int j = 16 * g; j < 16 * g + 16; ++j) c += (v[j] >= mid) ? 1 : 0; }
#pragma unroll
                for (int o = 1; o < 64; o <<= 1) c += __shfl_xor(c, o);
                c = __builtin_amdgcn_readfirstlane(c);
                if (c >= 256) lo = mid; else hi = mid - 1u;
            }
            thr = lo;
            int c = 0;
#pragma unroll
            for (int j = 0; j < 128; ++j) c += (v[j] > thr) ? 1 : 0;
#pragma unroll
            for (int o = 1; o < 64; o <<= 1) c += __shfl_xor(c, o);
            need = 256u - (unsigned)__builtin_amdgcn_readfirstlane(c);
        }
        const int ntile = 4 * (qb + 1);
        unsigned taken = 0u;
        unsigned long long* mrow = mask + (size_t)b * 128 * SEQ + tt;
#pragma unroll
        for (int j = 0; j < 128; ++j) {
            if (j < ntile) {
                const int kv = 64 * j + lane; bool sel;
                if (n <= 256) sel = kv < n;
                else {
                    const bool gt = v[j] > thr, eq = (v[j] == thr) && (kv < n);
                    const unsigned long long em = __ballot(eq);
                    const unsigned rank = taken + (unsigned)__popcll(em & ((1ull << lane) - 1ull));
                    sel = gt || (eq && rank < need);
                    taken += (unsigned)__popcll(em);
                }
                const unsigned long long m = __ballot(sel);
                if (lane == 0) mrow[(size_t)j * SEQ] = m;
            }
        }
    }
}

#define XB_TMO      128
#define XB_XCNT(j)  (256  + 64 * (j))
#define XB_XSUB(j)  (1280 + 64 * (j))
#define XB_XGEN(j)  (2304 + 64 * (j))
#define XB_TOP      3328
#define XB_TOPGEN   3392
#define XCD_BAR_WORDS 3456
#define XB_SPIN_CAP (1u << 18)

__device__ __forceinline__ unsigned xb_ld(unsigned* p)              { return __hip_atomic_load(p, __ATOMIC_RELAXED, __HIP_MEMORY_SCOPE_AGENT); }
__device__ __forceinline__ unsigned xb_add(unsigned* p, unsigned v) { return __hip_atomic_fetch_add(p, v, __ATOMIC_RELAXED, __HIP_MEMORY_SCOPE_AGENT); }
__device__ __forceinline__ unsigned xb_xcc_id() { return (unsigned)__builtin_amdgcn_s_getreg((3 << 11) | 20) & 0xFu; }
#define XB_SPIN(cond, bar) do { unsigned _sp = 0; while (cond) { __builtin_amdgcn_s_sleep(1); \
    if ((++_sp & 255u) == 0u) { if (xb_ld(&(bar)[XB_TMO])) break; if (_sp > XB_SPIN_CAP) { atomicAdd(&(bar)[XB_TMO], 1u); break; } } } } while (0)

struct XcdBarrier {
    unsigned* bar; unsigned x;
    volatile LAS unsigned* st;
};

__device__ __forceinline__ XcdBarrier xcd_barrier_post(unsigned* bar, volatile LAS unsigned* st) {
    XcdBarrier b; b.bar = bar; b.x = xb_xcc_id(); b.st = st;
    if (tidx() == 0) (void)xb_add(&bar[XB_XCNT(b.x)], 1u);
    return b;
}
__device__ __forceinline__ void xcd_barrier_complete(unsigned* bar, unsigned x, unsigned& nloc, unsigned& nx) {
    const unsigned G = gridDim.x * gridDim.y * gridDim.z;
    unsigned sum, cnt, mine, sp = 0u;
    for (;;) {
        sum = 0u; cnt = 0u; mine = 0u;
#pragma unroll
        for (unsigned j = 0; j < 16; ++j) { const unsigned c = xb_ld(&bar[XB_XCNT(j)]); sum += c; cnt += (c > 0u) ? 1u : 0u; mine = (j == x) ? c : mine; }
        if (sum == G) break;
        __builtin_amdgcn_s_sleep(1);
        if ((++sp & 255u) == 0u) { if (xb_ld(&bar[XB_TMO])) break; if (sp > XB_SPIN_CAP) { atomicAdd(&bar[XB_TMO], 1u); break; } }
    }
    nloc = mine > 0u ? mine : 1u; nx = cnt > 0u ? cnt : 1u;
}

__device__ __forceinline__ void xcd_barrier(const XcdBarrier& b) {
    asm volatile("s_waitcnt vmcnt(0)" ::: "memory");
    __syncthreads();
    if (tidx() == 0) {
        unsigned* bar = b.bar;
        __builtin_amdgcn_s_waitcnt(0);
        unsigned nloc = b.st[0], nx = b.st[1];
        if (nloc == 0u) { xcd_barrier_complete(bar, b.x, nloc, nx); b.st[0] = nloc; b.st[1] = nx; }
        const unsigned old = xb_add(&bar[XB_XSUB(b.x)], 1u);
        const unsigned gen = old / nloc;
        if (old + 1u == (gen + 1u) * nloc) {
            __builtin_amdgcn_fence(__ATOMIC_RELEASE, "agent");
            asm volatile("s_waitcnt vmcnt(0)" ::: "memory");
            const unsigned og = xb_add(&bar[XB_TOP], 1u);
            const unsigned tg = og / nx;
            if (og + 1u == (tg + 1u) * nx) xb_add(&bar[XB_TOPGEN], 1u);
            else XB_SPIN(xb_ld(&bar[XB_TOPGEN]) == tg, bar);
            __builtin_amdgcn_fence(__ATOMIC_ACQUIRE, "agent");
            xb_add(&bar[XB_XGEN(b.x)], 1u);
            asm volatile("s_waitcnt vmcnt(0)" ::: "memory");
        } else {
            XB_SPIN(xb_ld(&bar[XB_XGEN(b.x)]) == gen, bar);
            __builtin_amdgcn_fence(__ATOMIC_ACQUIRE, "agent");
            asm volatile("s_waitcnt vmcnt(0)" ::: "memory");
        }
    }
    __syncthreads();
}


namespace cg = cooperative_groups;
constexpr int LDS_BYTES = 147456;
#define GEMM_PHASE(EPI, Aptr, Bptr, Nn, Kk, ...) do { pg8::Gemm g_{(const pg8::bf16_t*)(Aptr), (const pg8::bf16_t*)(Bptr), T, (Nn), (Kk)}; pg8::StaticOrder S_; S_.init(T, (Nn), (int)gridDim.x, (int)bidx()); \
    pg8::EPI E_{__VA_ARGS__}; pg8::gemm_phase<pg8::EPI, pg8::StaticOrder, true, true>((PG8_LAS unsigned char*)smem, g_, S_, E_); } while (0)
__global__ void __launch_bounds__(NT, 2) k_mega(Params P) {
    extern __shared__ __attribute__((aligned(16))) unsigned char smem[];
    cg::grid_group grid = cg::this_grid();
#define BST ((volatile LAS unsigned*)((LAS unsigned char*)smem + 131072 + 64))
    if (tidx() < 2) BST[tidx()] = 0u;
    __syncthreads();
    (void)xcd_barrier_post((unsigned*)(WSP + WS_CTL) + 4096, BST);
#define BAR() do { XcdBarrier b_; b_.bar = (unsigned*)(WSP + WS_CTL) + 4096; b_.x = xb_xcc_id(); b_.st = BST; xcd_barrier(b_); } while (0)
    ph_prologue(smem);
    ph_rmsnorm(IN(0), IN(3), (bf16*)(WSP + WS_XN)); grid.sync();
    { unsigned char* ws = WSP; GEMM_PHASE(EBf16, ws + WS_XN, ws + WS_WAB_IN, AB_LD, DM, (bf16*)(ws + WS_QKV), AB_LD); } BAR();
    ph_prep0((bf16*)(WSP + WS_QKV), (const int*)IN(2), IN(8), IN(9), IN(10), IN(11)); BAR();
    { unsigned char* ws = WSP; ph_kmean((bf16*)(ws + WS_QKV), (float*)(ws + WS_KMEAN)); } BAR();
    { unsigned char* ws = WSP; ph_moba_select((bf16*)(ws + WS_QKV), (float*)(ws + WS_KMEAN), (unsigned*)(ws + WS_SEL)); }
    { unsigned char* ws = WSP; ph_dsa_score((bf16*)(ws + WS_QKV), (float*)(ws + WS_SCORES), smem); } BAR();
    { unsigned char* ws = WSP; ph_attn_moba((bf16*)(ws + WS_QKV), (unsigned*)(ws + WS_SEL), (bf16*)(ws + WS_XN), smem); }
    __syncthreads();
    { unsigned char* ws = WSP; ph_dsa_select_opt((float*)(ws + WS_SCORES), (unsigned long long*)(ws + WS_MASK)); } BAR();
    { unsigned char* ws = WSP; ph_attn_dsa((bf16*)(ws + WS_QKV), (unsigned long long*)(ws + WS_MASK), (bf16*)(ws + WS_XN), smem); } BAR();
    { unsigned char* ws = WSP; GEMM_PHASE(EResAdd, ws + WS_XN, ws + WS_WAB_OUT, DM, DM, IN(0), OUTP); }
    {
        unsigned char* ws = WSP;
#pragma unroll 1
        for (int L = 0; L < 2; ++L) {
            cvt_bf16(IN(18) + (size_t)L * NEXP * DM, (bf16*)(ws + WS_EXP + (size_t)(2 * L) * 32 * MiB), (size_t)NEXP * DM);
            cvt_bf16(IN(19) + (size_t)L * NEXP * DM, (bf16*)(ws + WS_EXP + (size_t)(2 * L + 1) * 32 * MiB), (size_t)NEXP * DM);
        }
    } BAR();
#pragma unroll 1
    for (int L = 0; L < 2; ++L) {
        if (L == 1) {
            ph_rmsnorm(OUTP, IN(3) + DM, (bf16*)(WSP + WS_XN)); BAR();
            { unsigned char* ws = WSP; GEMM_PHASE(EBf16, ws + WS_XN, ws + WS_WC_IN, C_LD, DM, (bf16*)(ws + WS_QKV1), C_LD); } BAR();
            ph_prep1((bf16*)(WSP + WS_QKV1), (const int*)IN(2), IN(14), IN(15)); BAR();
            { unsigned char* ws = WSP; ph_attn_dilated((bf16*)(ws + WS_QKV1), (bf16*)(ws + WS_OG), (float*)(ws + WS_LSE), smem); } BAR();
            { unsigned char* ws = WSP; ph_dil_merge((bf16*)(ws + WS_OG), (float*)(ws + WS_LSE), (bf16*)(ws + WS_XN)); } BAR();
            { unsigned char* ws = WSP; float* hb = OUTP; GEMM_PHASE(EResAdd, ws + WS_XN, ws + WS_WC_OUT, DM, DM, hb, hb); } BAR();
        }
        ph_rmsnorm(OUTP, IN(4) + L * DM, (bf16*)(WSP + WS_XN)); BAR();
        { unsigned char* ws = WSP; GEMM_PHASE(EBf16, ws + WS_XN, ws + WS_WQ + (size_t)L * 4 * MiB, 2048, DM, (bf16*)(ws + WS_QRY), 2048); } BAR();
        { unsigned char* ws = WSP; ph_peer_route_opt((bf16*)(ws + WS_QRY), (bf16*)(ws + WS_SUBK) + (size_t)L * 16 * 128 * 128, (int*)(ws + WS_EIDX), (float*)(ws + WS_GW), smem); } BAR();
        { unsigned char* ws = WSP; ph_peer_gather_opt((int*)(ws + WS_EIDX), (float*)(ws + WS_GW), (bf16*)(ws + WS_EXP + (size_t)(2 * L) * 32 * MiB), (bf16*)(ws + WS_EXP + (size_t)(2 * L + 1) * 32 * MiB), OUTP, IN(5) + L * DM, (bf16*)(ws + WS_XN), smem); }
        __syncthreads();
        { unsigned char* ws = WSP; GEMM_PHASE(EBf16, ws + WS_P + (size_t)L * T * 256 * 2, ws + WS_WUP + (size_t)L * (MiB / 2), DM, 256, (bf16*)(ws + WS_UP), DM); } BAR();
        { unsigned char* ws = WSP; GEMM_PHASE(EGate, ws + WS_XN, ws + WS_WG + (size_t)L * 2 * MiB, DM, DM, OUTP, (bf16*)(ws + WS_UP)); } BAR();
    }
}

extern "C" void kernel_launch(void* const* d_in, const int* in_sizes, int n_in, void* d_out, int out_size, void* d_ws, size_t ws_size, hipStream_t stream) {
    static int grid_blocks = 0;
    if (grid_blocks == 0) {
        if (n_in != 22 || out_size != T * DM || ws_size < WS_END) { fprintf(stderr, "kernel_launch: unexpected shapes: n_in %d out %d ws %zu\n", n_in, out_size, ws_size); grid_blocks = -1; return; }
        if (hipFuncSetAttribute((const void*)k_mega, hipFuncAttributeMaxDynamicSharedMemorySize, LDS_BYTES) != hipSuccess) { fprintf(stderr, "hipFuncSetAttribute failed\n"); grid_blocks = -1; return; }
        int dev = 0, cus = 0, per_cu = 0;
        hipGetDevice(&dev);
        hipDeviceGetAttribute(&cus, hipDeviceAttributeMultiprocessorCount, dev);
        hipOccupancyMaxActiveBlocksPerMultiprocessor(&per_cu, (const void*)k_mega, NT, LDS_BYTES);
        if (per_cu < 1 || cus < 1) { fprintf(stderr, "kernel_launch: occupancy query says %d blocks/CU on %d CUs\n", per_cu, cus); grid_blocks = -1; return; }
        grid_blocks = cus;
    }
    if (grid_blocks < 0) return;
    Params P{};
    for (int i = 0; i < 22; ++i) P.in[i] = (const float*)d_in[i];
    P.out = (float*)d_out; P.ws = (unsigned char*)d_ws;
    if (hipMemsetAsync((char*)d_ws + WS_CTL, 0, 1 * MiB, stream) != hipSuccess) { fprintf(stderr, "kernel_launch: hipMemsetAsync failed\n"); return; }
    void* args[] = {&P};
    hipError_t e = hipLaunchCooperativeKernel((const void*)k_mega, dim3(grid_blocks), dim3(NT), args, LDS_BYTES, stream);
    if (e != hipSuccess) fprintf(stderr, "cooperative launch failed: %s (grid %d)\n", hipGetErrorString(e), grid_blocks);
}
```

```cpp
#include <hip/hip_runtime.h>
#include <hip/hip_cooperative_groups.h>
#include <cstdio>
#include <cstdint>

constexpr int BATCH = 2, SEQ = 8192, T = BATCH * SEQ, DM = 1024;
constexpr int AB_N = 3396, AB_LD = 3584;
constexpr int CQA = 0, CKA = 512, CVA = 1024, CQB = 1536, CKB = 2048, CVB = 2560, CQI = 3072, CKI = 3328, CWI = 3392;
constexpr int C_LD = 3072;
constexpr int NEXP = 16384;
constexpr float NORM_EPS = 1e-6f;
constexpr float C2 = 0.125f * 1.4426950408889634f;
constexpr int NT = 512;
constexpr int PROBE_A = -1, PROBE_B = 0, PROBE_K = 4;

constexpr size_t MiB = 1u << 20;
constexpr size_t WS_CTL = 0;
constexpr size_t WS_WAB_IN = 1 * MiB, WS_WAB_OUT = 8 * MiB, WS_WC_IN = 10 * MiB, WS_WC_OUT = 16 * MiB;
constexpr size_t WS_WQ = 18 * MiB, WS_WG = 26 * MiB, WS_WUP = 30 * MiB, WS_SUBK = 31 * MiB;
constexpr size_t WS_KMEAN = 32 * MiB;
constexpr size_t WS_SEL = 33 * MiB;
constexpr size_t WS_LSE = 34 * MiB;
constexpr size_t WS_EIDX = 37 * MiB;
constexpr size_t WS_GW = 45 * MiB;
constexpr size_t WS_P = 53 * MiB;
constexpr size_t WS_XN = 69 * MiB;
constexpr size_t WS_QKV = 101 * MiB;
constexpr size_t WS_MASK = 213 * MiB;
constexpr size_t WS_SCORES = 229 * MiB;
constexpr size_t WS_EXP = 229 * MiB;
constexpr size_t WS_QRY = 101 * MiB;
constexpr size_t WS_PA = 101 * MiB;
constexpr size_t WS_UP = 165 * MiB;
constexpr size_t WS_QKV1 = 357 * MiB;
constexpr size_t WS_OG = 101 * MiB;
constexpr size_t WS_XN2 = 453 * MiB;
constexpr size_t WS_SS16 = 505 * MiB;
constexpr size_t WS_SS8 = 506 * MiB;
constexpr size_t WS_END = 512 * MiB;

typedef unsigned short bf16;
typedef float f32x4 __attribute__((ext_vector_type(4)));

__device__ __forceinline__ unsigned f2bf(float f) { unsigned u = __builtin_bit_cast(unsigned, f); return (u + 0x7fffu + ((u >> 16) & 1u)) >> 16; }
__device__ __forceinline__ float bf2f(bf16 h) { return __builtin_bit_cast(float, (unsigned)h << 16); }
template <int M> __device__ __forceinline__ int shx_bits(int v) {
    if constexpr (M < 32) return __builtin_amdgcn_ds_swizzle(v, (M << 10) | 0x1f);
    else { const auto rr = __builtin_amdgcn_permlane32_swap((unsigned)v, (unsigned)v, false, false); return (int)((rr[0] == (unsigned)v) ? rr[1] : rr[0]); }
}
template <int M> __device__ __forceinline__ float shx(float v) { return __builtin_bit_cast(float, shx_bits<M>(__builtin_bit_cast(int, v))); }
template <int M> __device__ __forceinline__ int shx(int v) { return shx_bits<M>(v); }
template <int M> __device__ __forceinline__ unsigned shx(unsigned v) { return (unsigned)shx_bits<M>((int)v); }
__device__ __forceinline__ int bperm(int srclane, int v) { return __builtin_amdgcn_ds_bpermute(srclane << 2, v); }
__device__ __forceinline__ float bperm(int srclane, float v) { return __builtin_bit_cast(float, __builtin_amdgcn_ds_bpermute(srclane << 2, __builtin_bit_cast(int, v))); }
__device__ __forceinline__ float wave_sum(float v) {
    v += shx<1>(v); v += shx<2>(v); v += shx<4>(v); v += shx<8>(v); v += shx<16>(v); v += shx<32>(v);
    return v;
}
__device__ __forceinline__ float wave_max(float v) {
    v = fmaxf(v, shx<1>(v)); v = fmaxf(v, shx<2>(v)); v = fmaxf(v, shx<4>(v)); v = fmaxf(v, shx<8>(v)); v = fmaxf(v, shx<16>(v)); v = fmaxf(v, shx<32>(v));
    return v;
}
__device__ __forceinline__ unsigned okey(float f) { unsigned u = __builtin_bit_cast(unsigned, f); return (u & 0x80000000u) ? ~u : (u | 0x80000000u); }

#define TID_TAB ((volatile __attribute__((address_space(3))) unsigned*)(131072 + 512))
__device__ __forceinline__ unsigned hw_slot() { return (unsigned)__builtin_amdgcn_s_getreg(((6 - 1) << 11) | 4); }
__device__ __forceinline__ int tidx() { const unsigned w = TID_TAB[hw_slot()]; int l; asm volatile("v_mbcnt_lo_u32_b32 %0, -1, 0\n\tv_mbcnt_hi_u32_b32 %0, -1, %0" : "=v"(l)); int t = (int)(w << 6) | l; asm volatile("" : "+v"(t)); return t; }
__device__ __forceinline__ int bidx() { int b = __builtin_amdgcn_workgroup_id_x(); asm volatile("" : "+s"(b)); return b; }
struct Params {
    const float* in[22];
    float* out;
    unsigned char* ws;
    int layer;
    int pad;
};

typedef const __attribute__((address_space(4))) unsigned long long* karg_t;
__device__ __forceinline__ unsigned long long karg(int idx) { karg_t ka = (karg_t)__builtin_amdgcn_kernarg_segment_ptr(); asm volatile("" : "+s"(ka)); return ka[idx]; }
#define GASP __attribute__((address_space(1)))
#define IN(i) ((const float*)(const GASP float*)karg(i))
#define OUTP ((float*)(GASP float*)karg(22))
#define WSP ((unsigned char*)(GASP unsigned char*)karg(23))

__device__ __forceinline__ void ph_rmsnorm(const float* src, const float* gain, bf16* dst) {
    const int lane = tidx() & 63, wave = tidx() >> 6;
    const int gw = bidx() * (NT / 64) + wave, ngw = gridDim.x * (NT / 64);
    for (int r = gw; r < T; r += ngw) {
        const f32x4* xr = (const f32x4*)(src + (size_t)r * DM) + lane;
        f32x4 v[4]; float s = 0.f;
#pragma unroll
        for (int j = 0; j < 4; ++j) { v[j] = xr[64 * j]; s += v[j].x * v[j].x + v[j].y * v[j].y + v[j].z * v[j].z + v[j].w * v[j].w; }
        const float rstd = 1.0f / sqrtf(wave_sum(s) * (1.0f / DM) + NORM_EPS);
#pragma unroll
        for (int j = 0; j < 4; ++j) {
            const f32x4 g = ((const f32x4*)gain)[lane + 64 * j];
            unsigned long long o = (unsigned long long)(f2bf(v[j].x * rstd * g.x) | (f2bf(v[j].y * rstd * g.y) << 16)) |
                                   ((unsigned long long)(f2bf(v[j].z * rstd * g.z) | (f2bf(v[j].w * rstd * g.w) << 16)) << 32);
            ((unsigned long long*)(dst + (size_t)r * DM))[lane + 64 * j] = o;
        }
    }
}

template <class AT> __device__ __forceinline__ float ldA(const AT* p);
template <> __device__ __forceinline__ float ldA<bf16>(const bf16* p) { return bf2f(*p); }
template <> __device__ __forceinline__ float ldA<float>(const float* p) { return *p; }

template <class AT, class Epi> __forceinline__
__device__ __forceinline__ void ph_gemm_naive(const AT* A, int lda, const float* B, int N, int K, const Epi& E, unsigned char* smem) {
    float* As = (float*)smem;
    float* Bs = As + 16 * 132;
    const int tid = tidx(), ty = tid >> 5, tx = tid & 31;
    const int ntn = (N + 127) / 128, ntm = T / 128, ntile = ntn * ntm;
    for (int tile = bidx(); tile < ntile; tile += gridDim.x) {
        const int tm = tile / ntn, tn = tile % ntn, m0 = tm * 128, n0 = tn * 128;
        float acc[8][4];
#pragma unroll
        for (int i = 0; i < 8; ++i)
#pragma unroll
            for (int j = 0; j < 4; ++j) acc[i][j] = 0.f;
        for (int k0 = 0; k0 < K; k0 += 16) {
            __syncthreads();
#pragma unroll
            for (int i = 0; i < 4; ++i) { const int e = tid + i * NT, r = e >> 4, kk = e & 15; As[kk * 132 + r] = ldA<AT>(A + (size_t)(m0 + r) * lda + k0 + kk); }
#pragma unroll
            for (int i = 0; i < 4; ++i) { const int e = tid + i * NT, kk = e >> 7, c = e & 127; Bs[kk * 128 + c] = (n0 + c < N) ? B[(size_t)(k0 + kk) * N + n0 + c] : 0.f; }
            __syncthreads();
#pragma unroll 2
            for (int kk = 0; kk < 16; ++kk) {
                float a[8], b[4];
#pragma unroll
                for (int i = 0; i < 8; ++i) a[i] = As[kk * 132 + ty * 8 + i];
#pragma unroll
                for (int j = 0; j < 4; ++j) b[j] = Bs[kk * 128 + tx * 4 + j];
#pragma unroll
                for (int i = 0; i < 8; ++i)
#pragma unroll
                    for (int j = 0; j < 4; ++j) acc[i][j] += a[i] * b[j];
            }
        }
#pragma unroll
        for (int i = 0; i < 8; ++i) {
            const int col = n0 + tx * 4;
            if (col < N) E.store4(m0 + ty * 8 + i, col, (f32x4){acc[i][0], acc[i][1], acc[i][2], acc[i][3]});
        }
    }
}
struct EpBf16 { bf16* O; int ldc;
    __device__ __forceinline__ void store4(int r, int c, f32x4 v) const {
        unsigned long long o = (unsigned long long)(f2bf(v.x) | (f2bf(v.y) << 16)) | ((unsigned long long)(f2bf(v.z) | (f2bf(v.w) << 16)) << 32);
        *(unsigned long long*)(O + (size_t)r * ldc + c) = o; } };
struct EpResAdd { const float* base; float* out;
    __device__ __forceinline__ void store4(int r, int c, f32x4 v) const {
        const f32x4 b = *(const f32x4*)(base + (size_t)r * DM + c); *(f32x4*)(out + (size_t)r * DM + c) = b + v; } };
struct EpGate { float* h; const bf16* up;
    __device__ __forceinline__ void store4(int r, int c, f32x4 v) const {
        f32x4 hv = *(const f32x4*)(h + (size_t)r * DM + c); const bf16* u = up + (size_t)r * DM + c;
        hv.x += bf2f(u[0]) / (1.f + __expf(-v.x)); hv.y += bf2f(u[1]) / (1.f + __expf(-v.y));
        hv.z += bf2f(u[2]) / (1.f + __expf(-v.z)); hv.w += bf2f(u[3]) / (1.f + __expf(-v.w));
        *(f32x4*)(h + (size_t)r * DM + c) = hv; } };

__device__ __forceinline__ void rope_cs(int pos, int i, float& c, float& s) {
    const float inv = exp2f(-(float)i * 0.125f * 18.931568569324174f);
    const float ang = (float)pos * inv;
    const float k = rintf(ang * 0.15915494309189535f);
    float r = fmaf(-k, 6.28125f, ang); r = fmaf(-k, 1.9353071795864769e-3f, r);
    c = cosf(r); s = sinf(r);
}
__device__ __forceinline__ void prep_head(bf16* p, const float* gain, int pos, float scale, bool donorm, int lane) {
    float v = bf2f(p[lane]);
    if (donorm) { const float ss = wave_sum(v * v); v = v * (1.0f / sqrtf(ss * (1.0f / 64.f) + NORM_EPS)) * gain[lane]; }
    const float partner = __shfl_xor(v, 8);
    float c = 1.f, s = 0.f;
    if (lane < 16) rope_cs(pos, lane & 7, c, s);
    float o = v;
    if (lane < 8) o = v * c - partner * s; else if (lane < 16) o = v * c + partner * s;
    p[lane] = (bf16)f2bf(o * scale);
}
__device__ __forceinline__ void ph_prep0(bf16* qkv, const int* positions, const float* aq, const float* ak, const float* bq, const float* bk) {
    const int lane = tidx() & 63, wave = tidx() >> 6;
    const int gw = bidx() * (NT / 64) + wave, ngw = gridDim.x * (NT / 64);
    for (int r = gw; r < T; r += ngw) {
        const int pos = positions[r]; bf16* row = qkv + (size_t)r * AB_LD;
        for (int h = 0; h < 8; ++h) {
            prep_head(row + CQA + h * 64, aq, pos, C2, true, lane);
            prep_head(row + CKA + h * 64, ak, pos, 1.f, true, lane);
            prep_head(row + CQB + h * 64, bq, pos, C2, true, lane);
            prep_head(row + CKB + h * 64, bk, pos, 1.f, true, lane);
        }
        for (int h = 0; h < 4; ++h) prep_head(row + CQI + h * 64, nullptr, pos, 1.f, false, lane);
        prep_head(row + CKI, nullptr, pos, 1.f, false, lane);
    }
}
__device__ __forceinline__ void ph_prep1(bf16* qkv, const int* positions, const float* cq, const float* ck) {
    const int lane = tidx() & 63, wave = tidx() >> 6;
    const int gw = bidx() * (NT / 64) + wave, ngw = gridDim.x * (NT / 64);
    for (int r = gw; r < T; r += ngw) {
        const int pos = positions[r]; bf16* row = qkv + (size_t)r * C_LD;
        for (int h = 0; h < 16; ++h) {
            prep_head(row + h * 64, cq, pos, C2, true, lane);
            prep_head(row + 1024 + h * 64, ck, pos, 1.f, true, lane);
        }
    }
}
__device__ __forceinline__ void ph_kmean(const bf16* qkv, float* kmean) {
    const int lane = tidx() & 63, wave = tidx() >> 6;
    const int gw = bidx() * (NT / 64) + wave, ngw = gridDim.x * (NT / 64);
    for (int it = gw; it < BATCH * 8 * 32; it += ngw) {
        const int b = it / 256, h = (it / 32) % 8, n = it % 32;
        float s = 0.f;
        for (int r = 0; r < 256; ++r) s += bf2f(qkv[(size_t)(b * SEQ + n * 256 + r) * AB_LD + CKA + h * 64 + lane]);
        kmean[(size_t)it * 64 + lane] = s * (1.0f / 256.f);
    }
}
__device__ __forceinline__ void ph_moba_select(const bf16* qkv, const float* kmean, unsigned* sel) {
    for (int it = bidx() * NT + tidx(); it < T * 8; it += gridDim.x * NT) {
        const int t = it >> 3, h = it & 7, b = t / SEQ, qblk = (t % SEQ) / 256;
        float q[64];
#pragma unroll
        for (int d = 0; d < 64; ++d) q[d] = bf2f(qkv[(size_t)t * AB_LD + CQA + h * 64 + d]);
        float v0 = -3e38f, v1 = -3e38f, v2 = -3e38f; int i0 = 255, i1 = 255, i2 = 255;
        for (int n = 0; n < qblk; ++n) {
            const float* km = kmean + (size_t)((b * 8 + h) * 32 + n) * 64; float g = 0.f;
#pragma unroll
            for (int d = 0; d < 64; ++d) g += q[d] * km[d];
            if (g > v0) { v2 = v1; i2 = i1; v1 = v0; i1 = i0; v0 = g; i0 = n; }
            else if (g > v1) { v2 = v1; i2 = i1; v1 = g; i1 = n; }
            else if (g > v2) { v2 = g; i2 = n; }
        }
        sel[it] = (unsigned)i0 | ((unsigned)i1 << 8) | ((unsigned)i2 << 16) | (255u << 24);
    }
}
__device__ __forceinline__ void ph_moba_attend(const bf16* qkv, const unsigned* sel, bf16* O, unsigned char* smem) {
    const int lane = tidx() & 63, wave = tidx() >> 6;
    float* pl = (float*)smem + wave * 1024;
    const int gw = bidx() * (NT / 64) + wave, ngw = gridDim.x * (NT / 64);
    for (int it = gw; it < T * 8; it += ngw) {
        const int t = it >> 3, h = it & 7, b = t / SEQ, tt = t % SEQ, qblk = tt / 256;
        const unsigned sw = sel[it];
        int blk[4] = {qblk, (int)(sw & 255), (int)((sw >> 8) & 255), (int)((sw >> 16) & 255)};
        const bf16* qp = qkv + (size_t)t * AB_LD + CQA + h * 64;
        float q[64];
#pragma unroll
        for (int d = 0; d < 64; ++d) q[d] = bf2f(qp[d]);
        float sc[16]; float mx = -3e38f;
#pragma unroll
        for (int s = 0; s < 4; ++s) {
#pragma unroll
            for (int i = 0; i < 4; ++i) {
                const int j = lane + 64 * i, pos = blk[s] * 256 + j;
                const bool ok = (blk[s] != 255) && (s > 0 || pos <= tt);
                float a = -3e38f;
                if (ok) { const bf16* kp = qkv + (size_t)(b * SEQ + pos) * AB_LD + CKA + h * 64; a = 0.f;
#pragma unroll
                    for (int d = 0; d < 64; ++d) a += q[d] * bf2f(kp[d]); }
                sc[s * 4 + i] = a; mx = fmaxf(mx, a);
            }
        }
        mx = wave_max(mx); float l = 0.f;
#pragma unroll
        for (int e = 0; e < 16; ++e) { const float p = (sc[e] > -1e38f) ? exp2f(sc[e] - mx) : 0.f; l += p; pl[(e >> 2) * 256 + lane + 64 * (e & 3)] = p; }
        l = wave_sum(l);
        __builtin_amdgcn_s_waitcnt(0);
        float o = 0.f;
#pragma unroll
        for (int s = 0; s < 4; ++s) {
            if (blk[s] == 255) continue;
            const int nk = (s == 0) ? (tt - qblk * 256 + 1) : 256;
            const bf16* vp = qkv + (size_t)(b * SEQ + blk[s] * 256) * AB_LD + CVA + h * 64 + lane;
            for (int j = 0; j < nk; ++j) o += pl[s * 256 + j] * bf2f(vp[(size_t)j * AB_LD]);
        }
        O[(size_t)t * DM + h * 64 + lane] = (bf16)f2bf(o / l);
    }
}
__device__ __forceinline__ void ph_dsa_select(const bf16* qkv, unsigned long long* mask, unsigned char* smem) {
    unsigned* keys = (unsigned*)smem;
    unsigned* cnt = keys + 8192;
    const int tid = tidx(), lane = tid & 63;
    for (int t = bidx(); t < T; t += gridDim.x) {
        const int b = t / SEQ, tt = t % SEQ, n = tt + 1;
        __syncthreads();
        const bf16* row = qkv + (size_t)t * AB_LD;
        float* qf = (float*)(cnt + 4);
        if (tid < 256) qf[tid] = bf2f(row[CQI + tid]);
        if (tid < 4) qf[256 + tid] = bf2f(row[CWI + tid]);
        __syncthreads();
        for (int kv = tid; kv < 8192; kv += NT) {
            unsigned key = 0u;
            if (kv < n) {
                const bf16* kp = qkv + (size_t)(b * SEQ + kv) * AB_LD + CKI;
                float a0 = 0.f, a1 = 0.f, a2 = 0.f, a3 = 0.f;
                for (int d = 0; d < 64; ++d) { const float kd = bf2f(kp[d]); a0 += qf[d] * kd; a1 += qf[64 + d] * kd; a2 += qf[128 + d] * kd; a3 += qf[192 + d] * kd; }
                const float s = ((qf[256] * fmaxf(a0, 0.f) + qf[257] * fmaxf(a1, 0.f)) + qf[258] * fmaxf(a2, 0.f)) + qf[259] * fmaxf(a3, 0.f);
                key = okey(s);
            }
            keys[kv] = key;
        }
        __syncthreads();
        unsigned thr = 0u, need = 0u;
        if (n > 256) {
            unsigned lo = 0u, hi = 0xFFFFFFFFu;
            while (lo < hi) {
                const unsigned mid = lo + ((hi - lo) >> 1) + ((hi - lo) & 1u);
                if (tid == 0) cnt[0] = 0u;
                __syncthreads();
                unsigned c = 0;
                for (int kv = tid; kv < 8192; kv += NT) c += (keys[kv] >= mid) ? 1u : 0u;
                c = (unsigned)wave_sum((float)c);
                if (lane == 0) atomicAdd(&cnt[0], c);
                __syncthreads();
                const unsigned tot = cnt[0];
                __syncthreads();
                if (tot >= 256u) lo = mid; else hi = mid - 1u;
            }
            thr = lo;
            if (tid == 0) cnt[1] = 0u;
            __syncthreads();
            unsigned c = 0;
            for (int kv = tid; kv < 8192; kv += NT) c += (keys[kv] > thr) ? 1u : 0u;
            c = (unsigned)wave_sum((float)c);
            if (lane == 0) atomicAdd(&cnt[1], c);
            __syncthreads();
            need = 256u - cnt[1];
        }
        if (tid < 64) {
            const int ntile = 4 * (tt / 256 + 1);
            unsigned taken = 0u;
            for (int j = 0; j < ntile; ++j) {
                const int kv = j * 64 + lane; const unsigned key = keys[kv];
                bool s;
                if (n <= 256) s = kv < n;
                else {
                    const bool gt = key > thr, eq = (key == thr) && (kv < n);
                    const unsigned long long em = __ballot(eq);
                    const unsigned rank = taken + (unsigned)__popcll(em & ((1ull << lane) - 1ull));
                    s = gt || (eq && rank < need);
                    taken += (unsigned)__popcll(em);
                }
                const unsigned long long m = __ballot(s);
                if (lane == 0) mask[((size_t)(b * 128 + j)) * SEQ + tt] = m;
            }
        }
    }
}
__device__ __forceinline__ void ph_dsa_attend(const bf16* qkv, const unsigned long long* mask, bf16* O, unsigned char* smem) {
    int* list = (int*)smem;
    int* cnt = list + 256;
    float* pr = (float*)(cnt + 4);
    float* linv = pr + 8 * 256;
    const int tid = tidx(), lane = tid & 63, wave = tid >> 6;
    for (int t = bidx(); t < T; t += gridDim.x) {
        const int b = t / SEQ, tt = t % SEQ;
        __syncthreads();
        const int ntile = 4 * (tt / 256 + 1);
        if (wave == 0) {
            int base = 0;
            for (int j = 0; j < ntile; ++j) {
                const unsigned long long m = mask[((size_t)(b * 128 + j)) * SEQ + tt];
                const int p = base + (int)__popcll(m & ((1ull << lane) - 1ull));
                if (((m >> lane) & 1ull) && p < 256) list[p] = j * 64 + lane;
                base += (int)__popcll(m);
            }
            if (lane == 0) cnt[0] = base;
        }
        __syncthreads();
        const int ns = min(cnt[0], 256);
        const bf16* row = qkv + (size_t)t * AB_LD;
        for (int e = tid; e < 8 * 256; e += NT) {
            const int h = e >> 8, j = e & 255; float a = -3e38f;
            if (j < ns) { const bf16* kp = qkv + (size_t)(b * SEQ + list[j]) * AB_LD + CKB + h * 64; a = 0.f;
                for (int d = 0; d < 64; ++d) a += bf2f(row[CQB + h * 64 + d]) * bf2f(kp[d]); }
            pr[e] = a;
        }
        __syncthreads();
        {
            const int h = wave; float v[4]; float mx = -3e38f;
#pragma unroll
            for (int i = 0; i < 4; ++i) { v[i] = pr[h * 256 + lane + 64 * i]; mx = fmaxf(mx, v[i]); }
            mx = wave_max(mx); float l = 0.f;
#pragma unroll
            for (int i = 0; i < 4; ++i) { const float p = (v[i] > -1e38f) ? exp2f(v[i] - mx) : 0.f; l += p; pr[h * 256 + lane + 64 * i] = p; }
            l = wave_sum(l); if (lane == 0) linv[h] = 1.0f / l;
        }
        __syncthreads();
        {   const int h = tid >> 6, d = tid & 63; float o = 0.f;
            for (int j = 0; j < ns; ++j) o += pr[h * 256 + j] * bf2f(qkv[(size_t)(b * SEQ + list[j]) * AB_LD + CVB + h * 64 + d]);
            O[(size_t)t * DM + 512 + h * 64 + d] = (bf16)f2bf(o * linv[h]); }
    }
}
__device__ __forceinline__ void ph_dilated(const bf16* qkv, bf16* OG, float* LSE) {
    const int lane = tidx() & 63, wave = tidx() >> 6;
    const int gw = bidx() * (NT / 64) + wave, ngw = gridDim.x * (NT / 64);
    for (int it = gw; it < T * 16; it += ngw) {
        const int t = it >> 4, h = it & 15, b = t / SEQ, tt = t % SEQ;
        const bf16* qp = qkv + (size_t)t * C_LD + h * 64;
        float q[64];
#pragma unroll
        for (int d = 0; d < 64; ++d) q[d] = bf2f(qp[d]);
        for (int g = 0; g < 3; ++g) {
            const int dil = (g == 0) ? 1 : (g == 1 ? 4 : 16);
            float sc[3]; float mx = -3e38f;
#pragma unroll
            for (int i = 0; i < 3; ++i) {
                const int j = lane + 64 * i, pos = tt - j * dil; float a = -3e38f;
                if (j <= 128 && pos >= 0) { const bf16* kp = qkv + (size_t)(b * SEQ + pos) * C_LD + 1024 + h * 64; a = 0.f;
#pragma unroll
                    for (int d = 0; d < 64; ++d) a += q[d] * bf2f(kp[d]); }
                sc[i] = a; mx = fmaxf(mx, a);
            }
            mx = wave_max(mx); float l = 0.f; float p[3];
#pragma unroll
            for (int i = 0; i < 3; ++i) { p[i] = (sc[i] > -1e38f) ? exp2f(sc[i] - mx) : 0.f; l += p[i]; }
            l = wave_sum(l);
            float o = 0.f;
            for (int j = 0; j <= 128; ++j) {
                const int pos = tt - j * dil; if (pos < 0) break;
                const float pj = (j < 64) ? __shfl(p[0], j) : ((j < 128) ? __shfl(p[1], j - 64) : __shfl(p[2], 0));
                o += pj * bf2f(qkv[(size_t)(b * SEQ + pos) * C_LD + 2048 + h * 64 + lane]);
            }
            OG[((size_t)g * T + t) * DM + h * 64 + lane] = (bf16)f2bf(o / l);
            if (lane == 0) LSE[((size_t)g * T + t) * 16 + h] = mx + log2f(l);
        }
    }
}
__device__ __forceinline__ void ph_dil_merge(const bf16* OG, const float* LSE, bf16* O) {
    for (size_t e = (size_t)bidx() * NT + tidx(); e < (size_t)T * DM; e += (size_t)gridDim.x * NT) {
        const int t = (int)(e >> 10), c = (int)(e & 1023), h = c >> 6;
        const float l0 = LSE[((size_t)0 * T + t) * 16 + h], l1 = LSE[((size_t)1 * T + t) * 16 + h], l2 = LSE[((size_t)2 * T + t) * 16 + h];
        const float m = fmaxf(l0, fmaxf(l1, l2)); const float w0 = exp2f(l0 - m), w1 = exp2f(l1 - m), w2 = exp2f(l2 - m);
        const float o = (w0 * bf2f(OG[e]) + w1 * bf2f(OG[(size_t)T * DM + e]) + w2 * bf2f(OG[(size_t)2 * T * DM + e])) / (w0 + w1 + w2);
        O[e] = (bf16)f2bf(o);
    }
}
__device__ __forceinline__ void ph_peer_route(const bf16* qry, const float* subk, int* eidx, float* gw, unsigned char* smem) {
    float* s = (float*)smem;
    float* sv = s + 2048;
    int* si = (int*)(sv + 256);
    float* qf = (float*)(si + 256);
    const int tid = tidx(), lane = tid & 63, wave = tid >> 6;
    for (int t = bidx(); t < T; t += gridDim.x) {
        __syncthreads();
        for (int e = tid; e < 2048; e += NT) qf[e] = bf2f(qry[(size_t)t * 2048 + e]);
        __syncthreads();
        for (int e = tid; e < 2048; e += NT) {
            const int hc = e >> 7, k = e & 127; const float* kp = subk + ((size_t)hc * 128 + k) * 128; float a = 0.f;
            for (int d = 0; d < 128; ++d) a += qf[hc * 128 + d] * kp[d];
            s[e] = a;
        }
        __syncthreads();
        for (int hc = wave; hc < 16; hc += NT / 64) {
            float v0 = s[hc * 128 + lane], v1 = s[hc * 128 + 64 + lane];
            for (int r = 0; r < 16; ++r) {
                float bv = v0; int bi = lane;
                if (v1 > bv) { bv = v1; bi = lane + 64; }
#pragma unroll
                for (int o = 1; o < 64; o <<= 1) { const float ov = __shfl_xor(bv, o); const int oi = __shfl_xor(bi, o); if (ov > bv || (ov == bv && oi < bi)) { bv = ov; bi = oi; } }
                if (lane == 0) { sv[hc * 16 + r] = bv; si[hc * 16 + r] = bi; }
                if (bi == lane) v0 = -3e38f; if (bi == lane + 64) v1 = -3e38f;
            }
        }
        __syncthreads();
        {   const int h = wave;
            float c[4]; int ci[4];
#pragma unroll
            for (int i = 0; i < 4; ++i) { const int f = lane + 64 * i; c[i] = sv[(h * 2) * 16 + (f >> 4)] + sv[(h * 2 + 1) * 16 + (f & 15)]; ci[i] = f; }
            float cv[16]; int cf[16];
#pragma unroll
            for (int r = 0; r < 16; ++r) {
                float bv = c[0]; int bi = ci[0];
#pragma unroll
                for (int i = 1; i < 4; ++i) if (c[i] > bv) { bv = c[i]; bi = ci[i]; }
#pragma unroll
                for (int o = 1; o < 64; o <<= 1) { const float ov = __shfl_xor(bv, o); const int oi = __shfl_xor(bi, o); if (ov > bv || (ov == bv && oi < bi)) { bv = ov; bi = oi; } }
                cv[r] = bv; cf[r] = bi;
#pragma unroll
                for (int i = 0; i < 4; ++i) if (ci[i] == bi) c[i] = -3e38f;
            }
            float l = 0.f;
#pragma unroll
            for (int r = 0; r < 16; ++r) l += __expf(cv[r] - cv[0]);
            if (lane < 16) {
                float myv = 0.f; int myf = 0;
#pragma unroll
                for (int r = 0; r < 16; ++r) if (r == lane) { myv = cv[r]; myf = cf[r]; }
                eidx[(size_t)t * 128 + h * 16 + lane] = si[(h * 2) * 16 + (myf >> 4)] * 128 + si[(h * 2 + 1) * 16 + (myf & 15)];
                gw[(size_t)t * 128 + h * 16 + lane] = __expf(myv - cv[0]) / l;
            }
        }
    }
}
__device__ __forceinline__ float gelu_tanh(float x) { const float u = 0.7978845608028654f * (x + 0.044715f * x * x * x); return 0.5f * x * (1.f + tanhf(u)); }
__device__ __forceinline__ void ph_peer_gather(const bf16* xn, const int* eidx, const float* gw, const float* U, const float* V, float* h, unsigned char* smem) {
    float* xf = (float*)smem;
    float* w = xf + 1024;
    int* ei = (int*)(w + 128);
    const int tid = tidx(), lane = tid & 63, wave = tid >> 6;
    for (int t = bidx(); t < T; t += gridDim.x) {
        __syncthreads();
        for (int e = tid; e < 1024; e += NT) xf[e] = bf2f(xn[(size_t)t * DM + e]);
        if (tid < 128) ei[tid] = eidx[(size_t)t * 128 + tid];
        __syncthreads();
        for (int e = wave; e < 128; e += NT / 64) {
            const float* up = U + (size_t)ei[e] * DM; float a = 0.f;
            for (int d = lane; d < 1024; d += 64) a += xf[d] * up[d];
            a = wave_sum(a);
            if (lane == 0) w[e] = gw[(size_t)t * 128 + e] * gelu_tanh(a);
        }
        __syncthreads();
        for (int d = tid; d < 1024; d += NT) {
            float o = 0.f;
            for (int e = 0; e < 128; ++e) o += w[e] * V[(size_t)ei[e] * DM + d];
            h[(size_t)t * DM + d] += o;
        }
    }
}

namespace pg8 {
#define PG8_LAS __attribute__((address_space(3)))
typedef unsigned short bf16_t;
typedef short bf16x8 __attribute__((ext_vector_type(8)));
typedef float f32x4 __attribute__((ext_vector_type(4)));
typedef unsigned u32x4 __attribute__((ext_vector_type(4)));
constexpr int BM = 256, BK = 64, HALF = 128, HTB = HALF * BK * 2  , STAGE_BYTES = 8 * HTB, NXCD = 8, WGM = 8;

__host__ __device__ __forceinline__ int lds_byte(int r, int c) { const int st = (r >> 4) * 2 + (c >> 5), rr = r & 15, cc = c & 31, ob = rr * 64 + cc * 2; return st * 1024 + (ob ^ (((ob >> 9) & 1) << 5)); }
__host__ __device__ __forceinline__ void stage_rc(int b, int& R, int& C) { const int st = b / 1024, sb = b % 1024, swz = sb ^ (((sb >> 9) & 1) << 5); R = (st >> 1) * 16 + swz / 64; C = (st & 1) * 32 + (swz % 64) / 2; }
__host__ __device__ __forceinline__ int perm32(int rho) { const int n = rho >> 4, i = rho & 15; return 8 * (i >> 2) + 4 * n + (i & 3); }

struct Unit { int pm, pn; };
struct Gemm { const bf16_t* A; const bf16_t* Bt; int M, N, K; };

struct StaticOrder {
    int nM, nN, nwg, G, c;
    __host__ __device__ void init(int M, int N, int G_, int c_) { nM = M / BM; nN = N / BM; nwg = nM * nN; G = G_; c = c_; }
    __host__ __device__ bool next(int i, Unit& u) const {
        const long L = (long)i * G + c; if (L >= nwg) return false;
        int wgid = (int)L; { const int q = nwg / NXCD, r = nwg % NXCD, xcd = wgid % NXCD, off = wgid / NXCD; wgid = (xcd < r ? xcd * (q + 1) : r * (q + 1) + (xcd - r) * q) + off; }
        const int nig = WGM * nN, gid = wgid / nig, fm = gid * WGM, gsz = (nM - fm) < WGM ? (nM - fm) : WGM;
        u.pm = fm + ((wgid % nig) % gsz); u.pn = (wgid % nig) / gsz; return true;
    }
    __device__ __forceinline__ void a_ready(const Unit&) const {}
    __device__ __forceinline__ void done(const Unit&) const {}
};


__device__ __forceinline__ unsigned pk_bf16(float lo, float hi) { typedef float f2 __attribute__((ext_vector_type(2))); typedef __bf16 b2 __attribute__((ext_vector_type(2))); f2 v = {lo, hi}; b2 b = __builtin_convertvector(v, b2); return __builtin_bit_cast(unsigned, b); }
struct EBf16 {
    static constexpr bool PERM = true, AFTER_DRAIN = false; bf16_t* O; int ldc;
    __device__ __forceinline__ void operator()(const f32x4 (&acc)[2][2][4][2], const Unit& u, int wr, int wc, int fr, int fq) const {
        const int row0 = u.pm * BM + wr * 64 + fr, col0 = u.pn * BM + wc * 32 + 8 * fq;
#pragma unroll
        for (int ai = 0; ai < 2; ++ai)
#pragma unroll
            for (int m = 0; m < 4; ++m) { bf16_t* rowp = O + (size_t)(row0 + ai * HALF + m * 16) * ldc + col0;
#pragma unroll
                for (int bj = 0; bj < 2; ++bj) { const f32x4 v0 = acc[ai][bj][m][0], v1 = acc[ai][bj][m][1];
                    u32x4 w; w.x = pk_bf16(v0[0], v0[1]); w.y = pk_bf16(v0[2], v0[3]); w.z = pk_bf16(v1[0], v1[1]); w.w = pk_bf16(v1[2], v1[3]);
                    *(u32x4*)(rowp + bj * HALF) = w; } }
    }
};
struct EResAdd {
    static constexpr bool PERM = false, AFTER_DRAIN = false; const float* base; float* out;
    __device__ __forceinline__ void operator()(const f32x4 (&acc)[2][2][4][2], const Unit& u, int wr, int wc, int fr, int fq) const {
        const int col0 = u.pn * BM + wc * 32 + 4 * fq;
#pragma unroll
        for (int ai = 0; ai < 2; ++ai)
#pragma unroll
            for (int m = 0; m < 4; ++m) { const size_t off = (size_t)(u.pm * BM + ai * HALF + wr * 64 + m * 16 + fr) * 1024 + col0;
#pragma unroll
                for (int bj = 0; bj < 2; ++bj)
#pragma unroll
                    for (int n = 0; n < 2; ++n) { const f32x4 b = *(const f32x4*)(base + off + bj * HALF + n * 16); *(f32x4*)(out + off + bj * HALF + n * 16) = b + acc[ai][bj][m][n]; } }
    }
};
struct EGate {
    static constexpr bool PERM = false, AFTER_DRAIN = false; float* h; const bf16_t* up;
    __device__ __forceinline__ void operator()(const f32x4 (&acc)[2][2][4][2], const Unit& u, int wr, int wc, int fr, int fq) const {
        const int col0 = u.pn * BM + wc * 32 + 4 * fq;
#pragma unroll
        for (int ai = 0; ai < 2; ++ai)
#pragma unroll
            for (int m = 0; m < 4; ++m) { const size_t off = (size_t)(u.pm * BM + ai * HALF + wr * 64 + m * 16 + fr) * 1024 + col0;
#pragma unroll
                for (int bj = 0; bj < 2; ++bj)
#pragma unroll
                    for (int n = 0; n < 2; ++n) { const size_t o = off + bj * HALF + n * 16; f32x4 hv = *(const f32x4*)(h + o);
                        const unsigned long long uu = *(const unsigned long long*)(up + o); const f32x4 a = acc[ai][bj][m][n];
                        hv[0] += __builtin_bit_cast(float, (unsigned)(uu << 16)) / (1.f + __expf(-a[0]));
                        hv[1] += __builtin_bit_cast(float, (unsigned)(uu & 0xffff0000ull)) / (1.f + __expf(-a[1]));
                        hv[2] += __builtin_bit_cast(float, (unsigned)((uu >> 16) & 0xffff0000ull)) / (1.f + __expf(-a[2]));
                        hv[3] += __builtin_bit_cast(float, (unsigned)((uu >> 32) & 0xffff0000ull)) / (1.f + __expf(-a[3]));
                        *(f32x4*)(h + o) = hv; } }
    }
};

__device__ __forceinline__ float rstd16(const float* ss, int row) { const f32x4 a = *(const f32x4*)(ss + (size_t)row * 16), b = *(const f32x4*)(ss + (size_t)row * 16 + 4), c = *(const f32x4*)(ss + (size_t)row * 16 + 8), d = *(const f32x4*)(ss + (size_t)row * 16 + 12);
    const float t = ((a[0] + a[1]) + (a[2] + a[3])) + ((b[0] + b[1]) + (b[2] + b[3])) + ((c[0] + c[1]) + (c[2] + c[3])) + ((d[0] + d[1]) + (d[2] + d[3])); return 1.0f / sqrtf(t * (1.0f / 1024.f) + 1e-6f); }
__device__ __forceinline__ float rstd8(const float* ss, int row) { const f32x4 a = *(const f32x4*)(ss + (size_t)row * 8), b = *(const f32x4*)(ss + (size_t)row * 8 + 4);
    const float t = ((a[0] + a[1]) + (a[2] + a[3])) + ((b[0] + b[1]) + (b[2] + b[3])); return 1.0f / sqrtf(t * (1.0f / 1024.f) + 1e-6f); }
struct EBf16S {
    static constexpr bool PERM = true, AFTER_DRAIN = false; bf16_t* O; int ldc; const float* ss;
    __device__ __forceinline__ void operator()(const f32x4 (&acc)[2][2][4][2], const Unit& u, int wr, int wc, int fr, int fq) const {
        const int row0 = u.pm * BM + wr * 64 + fr, col0 = u.pn * BM + wc * 32 + 8 * fq;
#pragma unroll
        for (int ai = 0; ai < 2; ++ai)
#pragma unroll
            for (int m = 0; m < 4; ++m) { const int row = row0 + ai * HALF + m * 16; const float rs = rstd16(ss, row); bf16_t* rowp = O + (size_t)row * ldc + col0;
#pragma unroll
                for (int bj = 0; bj < 2; ++bj) { const f32x4 v0 = acc[ai][bj][m][0] * rs, v1 = acc[ai][bj][m][1] * rs;
                    u32x4 w; w.x = pk_bf16(v0[0], v0[1]); w.y = pk_bf16(v0[2], v0[3]); w.z = pk_bf16(v1[0], v1[1]); w.w = pk_bf16(v1[2], v1[3]);
                    *(u32x4*)(rowp + bj * HALF) = w; } }
    }
};
struct EResAddN {
    static constexpr bool PERM = false, AFTER_DRAIN = false; const float* base; float* out; bf16_t* xb; float* ss;
    __device__ __forceinline__ void operator()(const f32x4 (&acc)[2][2][4][2], const Unit& u, int wr, int wc, int fr, int fq) const {
        const int col0 = u.pn * BM + wc * 32 + 4 * fq;
#pragma unroll
        for (int ai = 0; ai < 2; ++ai)
#pragma unroll
            for (int m = 0; m < 4; ++m) { const int row = u.pm * BM + ai * HALF + wr * 64 + m * 16 + fr; const size_t off = (size_t)row * 1024 + col0; float sq = 0.f;
#pragma unroll
                for (int bj = 0; bj < 2; ++bj)
#pragma unroll
                    for (int n = 0; n < 2; ++n) { const size_t o = off + bj * HALF + n * 16; const f32x4 v = *(const f32x4*)(base + o) + acc[ai][bj][m][n]; *(f32x4*)(out + o) = v;
                        sq += (v[0] * v[0] + v[1] * v[1]) + (v[2] * v[2] + v[3] * v[3]);
                        *(unsigned long long*)(xb + o) = (unsigned long long)pk_bf16(v[0], v[1]) | ((unsigned long long)pk_bf16(v[2], v[3]) << 32); }
                sq += ::shx<16>(sq); sq += ::shx<32>(sq);
                if (fq == 0) ss[(size_t)row * 16 + u.pn * 4 + wc] = sq; }
    }
};
template <bool LAST> struct EGateN {
    static constexpr bool PERM = false, AFTER_DRAIN = false; float* h; const bf16_t* up; const float* ss8; bf16_t* xb; float* ss;
    __device__ __forceinline__ void operator()(const f32x4 (&acc)[2][2][4][2], const Unit& u, int wr, int wc, int fr, int fq) const {
        const int col0 = u.pn * BM + wc * 32 + 4 * fq;
#pragma unroll
        for (int ai = 0; ai < 2; ++ai)
#pragma unroll
            for (int m = 0; m < 4; ++m) { const int row = u.pm * BM + ai * HALF + wr * 64 + m * 16 + fr; const size_t off = (size_t)row * 1024 + col0; const float rs = rstd8(ss8, row); float sq = 0.f;
#pragma unroll
                for (int bj = 0; bj < 2; ++bj)
#pragma unroll
                    for (int n = 0; n < 2; ++n) { const size_t o = off + bj * HALF + n * 16; f32x4 hv = *(const f32x4*)(h + o);
                        const unsigned long long uu = *(const unsigned long long*)(up + o); const f32x4 a = acc[ai][bj][m][n] * rs;
                        hv[0] += __builtin_bit_cast(float, (unsigned)(uu << 16)) / (1.f + __expf(-a[0]));
                        hv[1] += __builtin_bit_cast(float, (unsigned)(uu & 0xffff0000ull)) / (1.f + __expf(-a[1]));
                        hv[2] += __builtin_bit_cast(float, (unsigned)((uu >> 16) & 0xffff0000ull)) / (1.f + __expf(-a[2]));
                        hv[3] += __builtin_bit_cast(float, (unsigned)((uu >> 32) & 0xffff0000ull)) / (1.f + __expf(-a[3]));
                        *(f32x4*)(h + o) = hv;
                        if (!LAST) { sq += (hv[0] * hv[0] + hv[1] * hv[1]) + (hv[2] * hv[2] + hv[3] * hv[3]);
                            *(unsigned long long*)(xb + o) = (unsigned long long)pk_bf16(hv[0], hv[1]) | ((unsigned long long)pk_bf16(hv[2], hv[3]) << 32); } }
                if (!LAST) { sq += ::shx<16>(sq); sq += ::shx<32>(sq); if (fq == 0) ss[(size_t)row * 16 + u.pn * 4 + wc] = sq; } }
    }
};
template <class Epi, class Sched, bool ALIGN_EPI = false, bool SP2 = false>
__device__ __forceinline__ void gemm_phase(PG8_LAS unsigned char* lds, const Gemm g, const Sched& S, const Epi& E) {
    const int tid = tidx(), wid = __builtin_amdgcn_readfirstlane(tid >> 6), lane = tid & 63, wr = wid >> 2, wc = wid & 3, fr = lane & 15, fq = lane >> 4;
    const int K = g.K, nt = K / BK;
    unsigned voffA[2], voffB[2];
#pragma unroll
    for (int i = 0; i < 2; ++i) { int R, C; stage_rc(tid * 16 + i * 8192, R, C); const int Rb = Epi::PERM ? ((R & ~31) + perm32(R & 31)) : R;
        voffA[i] = (unsigned)(R * K + C) * 2u; voffB[i] = (unsigned)(Rb * K + C) * 2u; }
    const size_t kstep = (size_t)(BK * 2);
    const size_t hstep = (size_t)HALF * K * 2;
    const size_t tstep = 2 * hstep;
    const unsigned ldsw = (unsigned)wid * 1024u;
    const int aoff = lds_byte(wr * 64 + fr, fq * 8), boff = lds_byte(wc * 32 + fr, fq * 8);
#define PG8_SA(b, h) (((b) * 2 + (h)) * HTB)
#define PG8_SB(b, h) ((4 + (b) * 2 + (h)) * HTB)
#define PG8_STAGE(bufoff, gbase, voff) do { _Pragma("unroll") for (int _i = 0; _i < 2; ++_i) \
        __builtin_amdgcn_global_load_lds((const unsigned*)((const char*)(gbase) + (voff)[_i]), (PG8_LAS unsigned*)(lds + (bufoff) + ldsw + _i * 8192), 16, 0, 0); } while (0)
#define PG8_LDA(dst, b, h) do { _Pragma("unroll") for (int m = 0; m < 4; ++m) _Pragma("unroll") for (int k = 0; k < 2; ++k) dst[m][k] = *(const PG8_LAS bf16x8*)(lds + PG8_SA(b, h) + aoff + m * 2048 + k * 1024); } while (0)
#define PG8_LDB(dst, b, h) do { _Pragma("unroll") for (int n = 0; n < 2; ++n) _Pragma("unroll") for (int k = 0; k < 2; ++k) dst[n][k] = *(const PG8_LAS bf16x8*)(lds + PG8_SB(b, h) + boff + n * 2048 + k * 1024); } while (0)
#define PG8_MMA(ai, bj, At, Bt) do { __builtin_amdgcn_s_setprio(1); _Pragma("unroll") for (int m = 0; m < 4; ++m) _Pragma("unroll") for (int n = 0; n < 2; ++n) _Pragma("unroll") for (int k = 0; k < 2; ++k) \
        acc[ai][bj][m][n] = __builtin_amdgcn_mfma_f32_16x16x32_bf16(Bt[n][k], At[m][k], acc[ai][bj][m][n], 0, 0, 0); __builtin_amdgcn_s_setprio(0); } while (0)
#define PG8_WAIT_V(n) asm volatile("s_waitcnt vmcnt(" #n ")" ::: "memory")
#define PG8_WAIT_L(n) asm volatile("s_waitcnt lgkmcnt(" #n ")" ::: "memory")
#define PG8_BAR __builtin_amdgcn_s_barrier()
#define PG8_SCHED __builtin_amdgcn_sched_barrier(0)
    Unit cur, nxt; int ui = 0;
    if (!S.next(0, cur)) return;
    f32x4 acc[2][2][4][2];
#pragma unroll
    for (int a = 0; a < 2; ++a)
#pragma unroll
        for (int b = 0; b < 2; ++b)
#pragma unroll
            for (int m = 0; m < 4; ++m)
#pragma unroll
                for (int n = 0; n < 2; ++n) acc[a][b][m][n] = (f32x4){0.f, 0.f, 0.f, 0.f};
    bf16x8 At[4][2], B0[2][2], B1[2][2];
    const char* cA = (const char*)g.A + (size_t)cur.pm * tstep; const char* cB = (const char*)g.Bt + (size_t)cur.pn * tstep;
    S.a_ready(cur);
    if constexpr (SP2) {
        PG8_STAGE(PG8_SB(0, 0), cB, voffB); PG8_STAGE(PG8_SB(0, 1), cB + hstep, voffB); PG8_STAGE(PG8_SA(0, 0), cA, voffA); PG8_STAGE(PG8_SA(0, 1), cA + hstep, voffA);
        if (wr == 1) PG8_BAR;
        PG8_WAIT_V(2); PG8_BAR;
        PG8_STAGE(PG8_SB(1, 0), cB + kstep, voffB); PG8_STAGE(PG8_SA(1, 0), cA + kstep, voffA); PG8_STAGE(PG8_SB(1, 1), cB + hstep + kstep, voffB);
        PG8_WAIT_V(6); PG8_BAR;
    } else {
        PG8_STAGE(PG8_SB(0, 0), cB, voffB); PG8_STAGE(PG8_SA(0, 0), cA, voffA); PG8_STAGE(PG8_SB(0, 1), cB + hstep, voffB); PG8_STAGE(PG8_SA(0, 1), cA + hstep, voffA);
        if (wr == 1) PG8_BAR;
        PG8_WAIT_V(4); PG8_BAR;
        PG8_STAGE(PG8_SB(1, 0), cB + kstep, voffB); PG8_STAGE(PG8_SA(1, 0), cA + kstep, voffA); PG8_STAGE(PG8_SB(1, 1), cB + hstep + kstep, voffB);
        PG8_WAIT_V(6); PG8_BAR;
    }
    for (;;) {
        const bool has_next = S.next(ui + 1, nxt);
        const char* nA = has_next ? (const char*)g.A + (size_t)nxt.pm * tstep : cA; const char* nB = has_next ? (const char*)g.Bt + (size_t)nxt.pn * tstep : cB;
        for (int t = 0; t < nt; t += 2) {
            const bool last = (t == nt - 2);
            const char* a1 = cA + (size_t)(t + 1) * kstep;
            const char* a2 = last ? nA : cA + (size_t)(t + 2) * kstep; const char* b2 = last ? nB : cB + (size_t)(t + 2) * kstep;
            const char* a3 = a2 + kstep; const char* b3 = b2 + kstep;
            if (last && has_next) S.a_ready(nxt);
            if constexpr (SP2) {
            PG8_LDB(B0, 0, 0); PG8_LDB(B1, 0, 1); PG8_SCHED; PG8_LDA(At, 0, 0); PG8_STAGE(PG8_SA(1, 1), a1 + hstep, voffA);
            PG8_WAIT_V(8); PG8_WAIT_L(0); PG8_BAR; PG8_MMA(0, 0, At, B0); PG8_MMA(0, 1, At, B1); PG8_BAR; PG8_SCHED;
            PG8_LDA(At, 0, 1); PG8_STAGE(PG8_SB(0, 0), b2, voffB); PG8_STAGE(PG8_SB(0, 1), b2 + hstep, voffB); PG8_STAGE(PG8_SA(0, 0), a2, voffA);
            PG8_WAIT_V(8); PG8_WAIT_L(0); PG8_BAR; PG8_MMA(1, 0, At, B0); PG8_MMA(1, 1, At, B1); PG8_BAR; PG8_SCHED;
            PG8_LDB(B0, 1, 0); PG8_LDB(B1, 1, 1); PG8_SCHED; PG8_LDA(At, 1, 0); PG8_STAGE(PG8_SA(0, 1), a2 + hstep, voffA);
            PG8_WAIT_V(8); PG8_WAIT_L(0); PG8_BAR; PG8_MMA(0, 0, At, B0); PG8_MMA(0, 1, At, B1); PG8_BAR; PG8_SCHED;
            PG8_LDA(At, 1, 1); PG8_STAGE(PG8_SB(1, 0), b3, voffB); PG8_STAGE(PG8_SB(1, 1), b3 + hstep, voffB); PG8_STAGE(PG8_SA(1, 0), a3, voffA);
            PG8_WAIT_V(8); PG8_WAIT_L(0); PG8_BAR; PG8_MMA(1, 0, At, B0); PG8_MMA(1, 1, At, B1); PG8_BAR; PG8_SCHED;
            } else {
            PG8_LDB(B0, 0, 0); PG8_SCHED; PG8_LDA(At, 0, 0); PG8_STAGE(PG8_SA(1, 1), a1 + hstep, voffA);
            PG8_WAIT_L(8); PG8_BAR; PG8_WAIT_L(0); PG8_MMA(0, 0, At, B0); PG8_BAR; PG8_SCHED;
            PG8_LDB(B1, 0, 1); PG8_STAGE(PG8_SB(0, 0), b2, voffB);
            PG8_BAR; PG8_WAIT_L(0); PG8_MMA(0, 1, At, B1); PG8_BAR;
            PG8_LDA(At, 0, 1); PG8_STAGE(PG8_SA(0, 0), a2, voffA);
            PG8_BAR; PG8_WAIT_L(0); PG8_MMA(1, 0, At, B0); PG8_BAR; PG8_SCHED;
            PG8_STAGE(PG8_SB(0, 1), b2 + hstep, voffB);
            PG8_WAIT_V(6); PG8_BAR; PG8_MMA(1, 1, At, B1); PG8_BAR;
            PG8_LDB(B0, 1, 0); PG8_SCHED; PG8_LDA(At, 1, 0); PG8_STAGE(PG8_SA(0, 1), a2 + hstep, voffA);
            PG8_WAIT_L(8); PG8_BAR; PG8_WAIT_L(0); PG8_MMA(0, 0, At, B0); PG8_BAR; PG8_SCHED;
            PG8_LDB(B1, 1, 1); PG8_STAGE(PG8_SB(1, 0), b3, voffB);
            PG8_BAR; PG8_WAIT_L(0); PG8_MMA(0, 1, At, B1); PG8_BAR;
            PG8_LDA(At, 1, 1); PG8_STAGE(PG8_SA(1, 0), a3, voffA);
            PG8_BAR; PG8_WAIT_L(0); PG8_MMA(1, 0, At, B0); PG8_BAR; PG8_SCHED;
            PG8_STAGE(PG8_SB(1, 1), b3 + hstep, voffB);
            PG8_WAIT_V(6); PG8_BAR; PG8_MMA(1, 1, At, B1); PG8_BAR;
            }
        }
        if constexpr (ALIGN_EPI) { if (wr == 0) PG8_BAR; }
        if constexpr (!Epi::AFTER_DRAIN) { E(acc, cur, wr, wc, fr, fq); S.done(cur); }
        if (!has_next) break;
#pragma unroll
        for (int a = 0; a < 2; ++a)
#pragma unroll
            for (int b = 0; b < 2; ++b)
#pragma unroll
                for (int m = 0; m < 4; ++m)
#pragma unroll
                    for (int n = 0; n < 2; ++n) acc[a][b][m][n] = (f32x4){0.f, 0.f, 0.f, 0.f};
        cur = nxt; cA = nA; cB = nB; ++ui;
        if constexpr (ALIGN_EPI) { if (wr == 1) PG8_BAR; }
    }
    PG8_WAIT_V(0);
    if constexpr (!ALIGN_EPI) { if (wr == 0) PG8_BAR; }
    PG8_BAR;
    if constexpr (Epi::AFTER_DRAIN) { E.fused(acc, cur, wr, wc, fr, fq, lds, wid, lane); S.done(cur); }
#undef PG8_SA
#undef PG8_SB
#undef PG8_STAGE
#undef PG8_LDA
#undef PG8_LDB
#undef PG8_MMA
#undef PG8_WAIT_V
#undef PG8_WAIT_L
#undef PG8_BAR
#undef PG8_SCHED
}
}

#define LAS __attribute__((address_space(3)))
typedef unsigned v4u __attribute__((ext_vector_type(4)));
__device__ __forceinline__ unsigned pk2(float lo, float hi) { return f2bf(lo) | (f2bf(hi) << 16); }
__device__ __forceinline__ void transpose_item(const float* W, int K, int N, bf16* WT, float* scr, int item, int nblk, int lane, const float* gain) {
    const int kb = item / nblk, nb = item % nblk, k0 = 64 * kb, n0 = 32 * nb;
    const int nc = n0 + 4 * (lane & 7);
    f32x4 tv[8];
#pragma unroll
    for (int i = 0; i < 8; ++i) { const int kk = 8 * i + (lane >> 3); tv[i] = *(const f32x4*)(W + (size_t)(k0 + kk) * N + ((nc < N) ? nc : 0)) * (gain ? gain[k0 + kk] : 1.0f); }
#pragma unroll
    for (int i = 0; i < 8; ++i) { const int kk = 8 * i + (lane >> 3); *(f32x4*)(scr + kk * 36 + 4 * (lane & 7)) = (nc < N) ? tv[i] : (f32x4){0.f, 0.f, 0.f, 0.f}; }
    __builtin_amdgcn_s_waitcnt(0xc07f); asm volatile("" ::: "memory");
    const int c = lane & 7;
#pragma unroll
    for (int j = 0; j < 4; ++j) { const int n = (lane >> 3) + 8 * j; const float* sp = scr + (8 * c) * 36 + n;
        v4u o; o.x = pk2(sp[0 * 36], sp[1 * 36]); o.y = pk2(sp[2 * 36], sp[3 * 36]); o.z = pk2(sp[4 * 36], sp[5 * 36]); o.w = pk2(sp[6 * 36], sp[7 * 36]);
        *(v4u*)(WT + (size_t)(n0 + n) * K + k0 + 8 * c) = o; }
    __builtin_amdgcn_s_waitcnt(0xc07f); asm volatile("" ::: "memory");
}
__device__ __forceinline__ void cvt_bf16(const float* src, bf16* dst, size_t n) {
    for (size_t e = ((size_t)bidx() * NT + tidx()) * 8; e < n; e += (size_t)gridDim.x * NT * 8) {
        const f32x4 a = *(const f32x4*)(src + e), b = *(const f32x4*)(src + e + 4);
        v4u o; o.x = pk2(a.x, a.y); o.y = pk2(a.z, a.w); o.z = pk2(b.x, b.y); o.w = pk2(b.z, b.w);
        *(v4u*)(dst + e) = o; }
}
__device__ __forceinline__ void transpose_matrix(const float* W, int K, int N, int Npad, bf16* WT, float* scr, int gw, int ngw, int lane, const float* gain = nullptr) {
    const int nblk = Npad / 32, nit = (K / 64) * nblk;
    for (int it = gw; it < nit; it += ngw) transpose_item(W, K, N, WT, scr, it, nblk, lane, gain);
}
__device__ __forceinline__ void ph_prologue(unsigned char* smem) {
    const int lane = tidx() & 63, wave = tidx() >> 6;
    float* scr = (float*)smem + wave * (64 * 36);
    const int gw = bidx() * (NT / 64) + wave, ngw = gridDim.x * (NT / 64);
    unsigned char* ws = WSP;
    transpose_matrix(IN(6), 1024, AB_N, AB_LD, (bf16*)(ws + WS_WAB_IN), scr, gw, ngw, lane);
    transpose_matrix(IN(7), 1024, 1024, 1024, (bf16*)(ws + WS_WAB_OUT), scr, gw, ngw, lane);
    transpose_matrix(IN(12), 1024, 3072, 3072, (bf16*)(ws + WS_WC_IN), scr, gw, ngw, lane, IN(3) + DM);
    transpose_matrix(IN(13), 1024, 1024, 1024, (bf16*)(ws + WS_WC_OUT), scr, gw, ngw, lane);
#pragma unroll 1
    for (int L = 0; L < 2; ++L) {
        transpose_matrix(IN(16) + (size_t)L * DM * 2048, 1024, 2048, 2048, (bf16*)(ws + WS_WQ + (size_t)L * 4 * MiB), scr, gw, ngw, lane, IN(4) + L * DM);
        transpose_matrix(IN(20) + (size_t)L * DM * DM, 1024, 1024, 1024, (bf16*)(ws + WS_WG + (size_t)L * 2 * MiB), scr, gw, ngw, lane, IN(5) + L * DM);
        transpose_matrix(IN(21) + (size_t)L * 256 * DM, 256, 1024, 1024, (bf16*)(ws + WS_WUP + (size_t)L * (MiB / 2)), scr, gw, ngw, lane);
    }
    cvt_bf16(IN(1), (bf16*)(ws + WS_P), (size_t)2 * T * 256);
    cvt_bf16(IN(17), (bf16*)(ws + WS_SUBK), (size_t)2 * 16 * 128 * 128);
}


typedef __bf16 bf2_t __attribute__((ext_vector_type(2)));
typedef unsigned u32x4g __attribute__((ext_vector_type(4)));
__device__ __forceinline__ float dot2u(unsigned a, unsigned b, float c) { return __builtin_amdgcn_fdot2_f32_bf16(__builtin_bit_cast(bf2_t, a), __builtin_bit_cast(bf2_t, b), c, false); }
__device__ __forceinline__ float dot8(u32x4g a, u32x4g b, float c) {
    c = dot2u(a[0], b[0], c); c = dot2u(a[1], b[1], c); c = dot2u(a[2], b[2], c); c = dot2u(a[3], b[3], c);
    return c;
}
__device__ __forceinline__ float bflo(unsigned d) { return __builtin_bit_cast(float, d << 16); }
__device__ __forceinline__ float bfhi(unsigned d) { return __builtin_bit_cast(float, d & 0xffff0000u); }
#define GATHER_U8(EREG, B) do { float s_[8]; \
    _Pragma("unroll") for (int k = 0; k < 8; ++k) { const int idx = __builtin_amdgcn_readlane(EREG, ((B) * 8 + k) & 63); \
        const u32x4g* up = (const u32x4g*)(U + (size_t)idx * DM); const u32x4g u0 = up[lane], u1 = up[64 + lane]; s_[k] = dot8(x1, u1, dot8(x0, u0, 0.f)); } \
    float r_[4]; const bool b5 = lane & 32, b4 = lane & 16, b3 = lane & 8; \
    _Pragma("unroll") for (int i = 0; i < 4; ++i) { const float snd = b5 ? s_[i] : s_[4 + i], kp = b5 ? s_[4 + i] : s_[i]; r_[i] = kp + __shfl_xor(snd, 32); } \
    float q_[2]; \
    _Pragma("unroll") for (int i = 0; i < 2; ++i) { const float snd = b4 ? r_[i] : r_[2 + i], kp = b4 ? r_[2 + i] : r_[i]; q_[i] = kp + __shfl_xor(snd, 16); } \
    float p_; { const float snd = b3 ? q_[0] : q_[1], kp = b3 ? q_[1] : q_[0]; p_ = kp + __shfl_xor(snd, 8); } \
    p_ += __shfl_xor(p_, 4); p_ += __shfl_xor(p_, 2); p_ += __shfl_xor(p_, 1); \
    if ((lane & 7) == 0) al[(B) * 8 + (lane >> 3)] = p_; } while (0)
#define GATHER_V8(EREG, WREG, B) do { \
    _Pragma("unroll") for (int k = 0; k < 8; ++k) { const int idx = __builtin_amdgcn_readlane(EREG, ((B) * 8 + k) & 63); \
        const float w = __builtin_bit_cast(float, __builtin_amdgcn_readlane(__builtin_bit_cast(int, WREG), ((B) * 8 + k) & 63)); \
        const u32x4g* vp = (const u32x4g*)(V + (size_t)idx * DM); const u32x4g v0 = vp[lane], v1 = vp[64 + lane]; \
        acc[0] += w * bflo(v0.x); acc[1] += w * bfhi(v0.x); acc[2] += w * bflo(v0.y); acc[3] += w * bfhi(v0.y); \
        acc[4] += w * bflo(v0.z); acc[5] += w * bfhi(v0.z); acc[6] += w * bflo(v0.w); acc[7] += w * bfhi(v0.w); \
        acc[8] += w * bflo(v1.x); acc[9] += w * bfhi(v1.x); acc[10] += w * bflo(v1.y); acc[11] += w * bfhi(v1.y); \
        acc[12] += w * bflo(v1.z); acc[13] += w * bfhi(v1.z); acc[14] += w * bflo(v1.w); acc[15] += w * bfhi(v1.w); } } while (0)
__device__ __forceinline__ void ph_peer_gather_opt(const int* eidx, const float* gw, const bf16* U, const bf16* V, float* h, const float* gain_next, bf16* XN, unsigned char* smem) {
    const int tid = tidx(), lane = tid & 63, wave = tid >> 6;
    float* al = (float*)smem + wave * 128;
    const int gwv = bidx() * (NT / 64) + wave, ngw = gridDim.x * (NT / 64);
    for (int t = gwv; t < T; t += ngw) {
        const u32x4g x0 = *(const u32x4g*)(XN + (size_t)t * DM + 8 * lane), x1 = *(const u32x4g*)(XN + (size_t)t * DM + 512 + 8 * lane);
        const int e0 = eidx[(size_t)t * 128 + lane], e1 = eidx[(size_t)t * 128 + 64 + lane];
        const float g0 = gw[(size_t)t * 128 + lane], g1 = gw[(size_t)t * 128 + 64 + lane];
#pragma unroll 1
        for (int b = 0; b < 8; ++b) GATHER_U8(e0, b);
#pragma unroll 1
        for (int b = 8; b < 16; ++b) GATHER_U8(e1, b);
        __builtin_amdgcn_s_waitcnt(0xc07f); asm volatile("" ::: "memory");
        const float w0 = g0 * gelu_tanh(al[lane]), w1 = g1 * gelu_tanh(al[64 + lane]);
        float acc[16];
#pragma unroll
        for (int i = 0; i < 16; ++i) acc[i] = 0.f;
#pragma unroll 1
        for (int b = 0; b < 8; ++b) GATHER_V8(e0, w0, b);
#pragma unroll 1
        for (int b = 8; b < 16; ++b) GATHER_V8(e1, w1, b);
        float* hp = h + (size_t)t * DM + 8 * lane;
        f32x4 h0 = *(f32x4*)(hp), h1 = *(f32x4*)(hp + 4), h2 = *(f32x4*)(hp + 512), h3 = *(f32x4*)(hp + 516);
        h0 += (f32x4){acc[0], acc[1], acc[2], acc[3]}; h1 += (f32x4){acc[4], acc[5], acc[6], acc[7]};
        h2 += (f32x4){acc[8], acc[9], acc[10], acc[11]}; h3 += (f32x4){acc[12], acc[13], acc[14], acc[15]};
        *(f32x4*)(hp) = h0; *(f32x4*)(hp + 4) = h1; *(f32x4*)(hp + 512) = h2; *(f32x4*)(hp + 516) = h3;
        float ss = 0.f;
#pragma unroll
        for (int i = 0; i < 4; ++i) ss += h0[i] * h0[i] + h1[i] * h1[i] + h2[i] * h2[i] + h3[i] * h3[i];
        const float rstd = 1.0f / sqrtf(wave_sum(ss) * (1.0f / DM) + NORM_EPS);
        const f32x4 ga = *(const f32x4*)(gain_next + 8 * lane), gb = *(const f32x4*)(gain_next + 8 * lane + 4), gc = *(const f32x4*)(gain_next + 512 + 8 * lane), gd = *(const f32x4*)(gain_next + 516 + 8 * lane);
        u32x4g o0, o1;
        o0.x = pk2(h0[0] * rstd * ga[0], h0[1] * rstd * ga[1]); o0.y = pk2(h0[2] * rstd * ga[2], h0[3] * rstd * ga[3]);
        o0.z = pk2(h1[0] * rstd * gb[0], h1[1] * rstd * gb[1]); o0.w = pk2(h1[2] * rstd * gb[2], h1[3] * rstd * gb[3]);
        o1.x = pk2(h2[0] * rstd * gc[0], h2[1] * rstd * gc[1]); o1.y = pk2(h2[2] * rstd * gc[2], h2[3] * rstd * gc[3]);
        o1.z = pk2(h3[0] * rstd * gd[0], h3[1] * rstd * gd[1]); o1.w = pk2(h3[2] * rstd * gd[2], h3[3] * rstd * gd[3]);
        *(u32x4g*)(XN + (size_t)t * DM + 8 * lane) = o0; *(u32x4g*)(XN + (size_t)t * DM + 512 + 8 * lane) = o1;
    }
}


typedef short bf16x8r __attribute__((ext_vector_type(8)));
typedef float f32x16r __attribute__((ext_vector_type(16)));
__device__ __forceinline__ float unokey(unsigned k) { const unsigned u = (k & 0x80000000u) ? (k & 0x7fffffffu) : ~k; return __builtin_bit_cast(float, u); }
#define CE_D(a, b) do { const unsigned mx_ = max(a, b), mn_ = min(a, b); a = mx_; b = mn_; } while (0)
#define SORT16_DESC(v, base) do { \
    _Pragma("unroll") for (int k_ = 2; k_ <= 16; k_ <<= 1) \
    _Pragma("unroll") for (int j_ = k_ >> 1; j_ > 0; j_ >>= 1) \
    _Pragma("unroll") for (int i_ = 0; i_ < 16; ++i_) { const int l_ = i_ ^ j_; if (l_ > i_) { if ((i_ & k_) == 0) CE_D(v[(base) + i_], v[(base) + l_]); else CE_D(v[(base) + l_], v[(base) + i_]); } } } while (0)
#define BMERGE16_DESC(v, base) do { \
    _Pragma("unroll") for (int j_ = 8; j_ > 0; j_ >>= 1) \
    _Pragma("unroll") for (int i_ = 0; i_ < 16; ++i_) { const int l_ = i_ ^ j_; if (l_ > i_) CE_D(v[(base) + i_], v[(base) + l_]); } } while (0)
#define TOPMERGE16(v, a, b) do { _Pragma("unroll") for (int i_ = 0; i_ < 16; ++i_) v[(a) + i_] = max(v[(a) + i_], v[(b) + 15 - i_]); BMERGE16_DESC(v, a); } while (0)
#define PARTNER_TOP16(v) do { unsigned o_[16]; _Pragma("unroll") for (int i_ = 0; i_ < 16; ++i_) o_[i_] = shx<32>(v[15 - i_]); \
    _Pragma("unroll") for (int i_ = 0; i_ < 16; ++i_) v[i_] = max(v[i_], o_[i_]); BMERGE16_DESC(v, 0); } while (0)
constexpr int SK_ROW = 272;
__device__ __forceinline__ void ph_peer_route_opt(const bf16* qry, const bf16* subk, int* eidx, float* gw, unsigned char* smem) {
    const int tid = tidx(), lane = tid & 63, wave = tid >> 6, r32 = lane & 31, hi = lane >> 5;
    for (int unit = bidx(); unit < 512; unit += gridDim.x) {
        const int h = unit & 7, tb = unit >> 3;
        __syncthreads();
        for (int i = tid; i < 4096; i += NT) { const int row = i >> 4, ch = i & 15;
            *(u32x4g*)(smem + row * SK_ROW + ch * 16) = *(const u32x4g*)(subk + ((size_t)(h * 2) * 128 + row) * 128 + ch * 8); }
        __syncthreads();
        const int trow = tb * 256 + wave * 32 + r32;
        unsigned top[2][16];
#pragma unroll
        for (int c = 0; c < 2; ++c) {
            f32x16r acc[4];
#pragma unroll
            for (int kb = 0; kb < 4; ++kb) acc[kb] = (f32x16r){0.f, 0.f, 0.f, 0.f, 0.f, 0.f, 0.f, 0.f, 0.f, 0.f, 0.f, 0.f, 0.f, 0.f, 0.f, 0.f};
#pragma unroll
            for (int ks = 0; ks < 8; ++ks) {
                const bf16x8r bq = *(const bf16x8r*)(qry + (size_t)trow * 2048 + h * 256 + c * 128 + ks * 16 + 8 * hi);
#pragma unroll
                for (int kb = 0; kb < 4; ++kb) {
                    const bf16x8r ak = *(const bf16x8r*)(smem + (c * 128 + kb * 32 + r32) * SK_ROW + (ks * 16 + 8 * hi) * 2);
                    acc[kb] = __builtin_amdgcn_mfma_f32_32x32x16_bf16(ak, bq, acc[kb], 0, 0, 0);
                }
            }
            unsigned k[64];
#pragma unroll
            for (int kb = 0; kb < 4; ++kb)
#pragma unroll
                for (int r = 0; r < 16; ++r) { const float sc = acc[kb][r]; const int idx = kb * 32 + (r & 3) + 8 * (r >> 2) + 4 * hi;
                    k[kb * 16 + r] = (okey(sc) & 0xffffff80u) | (unsigned)(127 - idx); }
            SORT16_DESC(k, 0); SORT16_DESC(k, 16); SORT16_DESC(k, 32); SORT16_DESC(k, 48);
            TOPMERGE16(k, 0, 16); TOPMERGE16(k, 32, 48); TOPMERGE16(k, 0, 32);
            PARTNER_TOP16(k);
#pragma unroll
            for (int i = 0; i < 16; ++i) top[c][i] = k[i];
        }
        float va[16], vb[16];
#pragma unroll
        for (int i = 0; i < 16; ++i) { va[i] = unokey((top[0][i] & 0xffffff80u) | 0x40u); vb[i] = unokey((top[1][i] & 0xffffff80u) | 0x40u); }
        unsigned ck[32];
        ck[0] = (okey(hi ? (va[2] + vb[1]) : (va[0] + vb[0])) & 0xffffff00u) | (hi ? 222u : 255u);
        ck[1] = (okey(hi ? (va[2] + vb[2]) : (va[0] + vb[1])) & 0xffffff00u) | (hi ? 221u : 254u);
        ck[2] = (okey(hi ? (va[2] + vb[3]) : (va[0] + vb[2])) & 0xffffff00u) | (hi ? 220u : 253u);
        ck[3] = (okey(hi ? (va[2] + vb[4]) : (va[0] + vb[3])) & 0xffffff00u) | (hi ? 219u : 252u);
        ck[4] = (okey(hi ? (va[3] + vb[0]) : (va[0] + vb[4])) & 0xffffff00u) | (hi ? 207u : 251u);
        ck[5] = (okey(hi ? (va[3] + vb[1]) : (va[0] + vb[5])) & 0xffffff00u) | (hi ? 206u : 250u);
        ck[6] = (okey(hi ? (va[3] + vb[2]) : (va[0] + vb[6])) & 0xffffff00u) | (hi ? 205u : 249u);
        ck[7] = (okey(hi ? (va[3] + vb[3]) : (va[0] + vb[7])) & 0xffffff00u) | (hi ? 204u : 248u);
        ck[8] = (okey(hi ? (va[4] + vb[0]) : (va[0] + vb[8])) & 0xffffff00u) | (hi ? 191u : 247u);
        ck[9] = (okey(hi ? (va[4] + vb[1]) : (va[0] + vb[9])) & 0xffffff00u) | (hi ? 190u : 246u);
        ck[10] = (okey(hi ? (va[4] + vb[2]) : (va[0] + vb[10])) & 0xffffff00u) | (hi ? 189u : 245u);
        ck[11] = (okey(hi ? (va[5] + vb[0]) : (va[0] + vb[11])) & 0xffffff00u) | (hi ? 175u : 244u);
        ck[12] = (okey(hi ? (va[5] + vb[1]) : (va[0] + vb[12])) & 0xffffff00u) | (hi ? 174u : 243u);
        ck[13] = (okey(hi ? (va[6] + vb[0]) : (va[0] + vb[13])) & 0xffffff00u) | (hi ? 159u : 242u);
        ck[14] = (okey(hi ? (va[6] + vb[1]) : (va[0] + vb[14])) & 0xffffff00u) | (hi ? 158u : 241u);
        ck[15] = (okey(hi ? (va[7] + vb[0]) : (va[0] + vb[15])) & 0xffffff00u) | (hi ? 143u : 240u);
        ck[16] = (okey(hi ? (va[7] + vb[1]) : (va[1] + vb[0])) & 0xffffff00u) | (hi ? 142u : 239u);
        ck[17] = (okey(hi ? (va[8] + vb[0]) : (va[1] + vb[1])) & 0xffffff00u) | (hi ? 127u : 238u);
        ck[18] = (okey(hi ? (va[9] + vb[0]) : (va[1] + vb[2])) & 0xffffff00u) | (hi ? 111u : 237u);
        ck[19] = (okey(hi ? (va[10] + vb[0]) : (va[1] + vb[3])) & 0xffffff00u) | (hi ? 95u : 236u);
        ck[20] = (okey(hi ? (va[11] + vb[0]) : (va[1] + vb[4])) & 0xffffff00u) | (hi ? 79u : 235u);
        ck[21] = (okey(hi ? (va[12] + vb[0]) : (va[1] + vb[5])) & 0xffffff00u) | (hi ? 63u : 234u);
        ck[22] = (okey(hi ? (va[13] + vb[0]) : (va[1] + vb[6])) & 0xffffff00u) | (hi ? 47u : 233u);
        ck[23] = (okey(hi ? (va[14] + vb[0]) : (va[1] + vb[7])) & 0xffffff00u) | (hi ? 31u : 232u);
        ck[24] = (okey(hi ? (va[15] + vb[0]) : (va[2] + vb[0])) & 0xffffff00u) | (hi ? 15u : 223u);
#pragma unroll
        for (int s = 25; s < 32; ++s) ck[s] = 0u;
        SORT16_DESC(ck, 0); SORT16_DESC(ck, 16); TOPMERGE16(ck, 0, 16);
        PARTNER_TOP16(ck);
        const float m = unokey((ck[0] & 0xffffff00u) | 0x80u);
        float l = 0.f;
#pragma unroll
        for (int r = 0; r < 16; ++r) l += __expf(unokey((ck[r] & 0xffffff00u) | 0x80u) - m);
        const float linv = 1.0f / l;
        unsigned p0[4], p1[4];
#pragma unroll
        for (int w = 0; w < 4; ++w) { p0[w] = 0u; p1[w] = 0u;
#pragma unroll
            for (int b = 0; b < 4; ++b) { p0[w] |= (127u - (top[0][4 * w + b] & 127u)) << (8 * b); p1[w] |= (127u - (top[1][4 * w + b] & 127u)) << (8 * b); } }
        int eo[8]; float go[8]; const unsigned hmask = 0u - (unsigned)hi;
#pragma unroll
        for (int rr = 0; rr < 8; ++rr) {
            const unsigned key = ck[rr] ^ ((ck[rr] ^ ck[8 + rr]) & hmask);
            const unsigned flat = 255u - (key & 255u), i = flat >> 4, j = flat & 15u;
            const unsigned wi = (i >> 2) == 0 ? p0[0] : ((i >> 2) == 1 ? p0[1] : ((i >> 2) == 2 ? p0[2] : p0[3]));
            const unsigned wj = (j >> 2) == 0 ? p1[0] : ((j >> 2) == 1 ? p1[1] : ((j >> 2) == 2 ? p1[2] : p1[3]));
            const unsigned i0 = (wi >> ((i & 3u) * 8u)) & 255u, i1 = (wj >> ((j & 3u) * 8u)) & 255u;
            eo[rr] = (int)(i0 * 128u + i1);
            go[rr] = __expf(unokey((key & 0xffffff00u) | 0x80u) - m) * linv;
        }
        int* ep = eidx + (size_t)trow * 128 + h * 16 + 8 * hi; float* gp = gw + (size_t)trow * 128 + h * 16 + 8 * hi;
        typedef int i32x4 __attribute__((ext_vector_type(4)));
        *(i32x4*)ep = (i32x4){eo[0], eo[1], eo[2], eo[3]}; *(i32x4*)(ep + 4) = (i32x4){eo[4], eo[5], eo[6], eo[7]};
        *(f32x4*)gp = (f32x4){go[0], go[1], go[2], go[3]}; *(f32x4*)(gp + 4) = (f32x4){go[4], go[5], go[6], go[7]};
    }
}

#ifndef ATTN_STORE16
#define ATTN_STORE16(p,v) (*(u32x4*)(p)=(v))
#endif
namespace attn_g {
typedef unsigned short bf16;
using bf16x8=__attribute__((ext_vector_type(8)))short;
using s16x4=__attribute__((ext_vector_type(4)))short;
using f32x16=__attribute__((ext_vector_type(16)))float;
using u32x4=__attribute__((ext_vector_type(4)))unsigned;
constexpr int D=64;
constexpr int NW=8,QBLK=32,QB=QBLK*NW,KVBLK=64;
__device__ __forceinline__ int crow(int r,int hi){return (r&3)+8*(r>>2)+4*hi;}
#define SBAR() __builtin_amdgcn_sched_barrier(0)
__device__ __forceinline__ void cmask(f32x16&p0,f32x16&p1,int jb,int qrel,int hi){
  const float NEG=-__builtin_inff(); int kb=64*jb+4*hi;
  #pragma unroll
  for(int r=0;r<16;++r){int kv=kb+(r&3)+8*(r>>2); if(kv>qrel)p0[r]=NEG; if(kv+32>qrel)p1[r]=NEG;}
}

constexpr int NSLOT=3, SLOTB=8192;
constexpr int LDS_K=0, LDS_V=NSLOT*SLOTB, LDS_WS=2*NSLOT*SLOTB, LDS_OST=LDS_WS+NW*64*4, LDS_MSK=LDS_OST+NW*4096, LDS_BYTES=LDS_MSK+NW*2*256;
constexpr float C2=0.125f*1.4426950408889634f;
__device__ __forceinline__ void glds16(const void*gsrc,unsigned lds_dst){unsigned keep;
  asm volatile("s_mov_b32 %0, m0\n\ts_mov_b32 m0, %2\n\ts_nop 0\n\tglobal_load_lds_dwordx4 %1, off\n\ts_mov_b32 m0, %0":"=&s"(keep):"v"(gsrc),"s"(lds_dst):"memory");}
__device__ __forceinline__ void glds16s(const void*sbase,unsigned voff,unsigned lds_dst){unsigned keep;
  asm volatile("s_nop 4\n\ts_mov_b32 %0, m0\n\ts_mov_b32 m0, %3\n\ts_nop 0\n\tglobal_load_lds_dwordx4 %1, %2\n\ts_mov_b32 m0, %0":"=&s"(keep):"v"(voff),"s"(sbase),"s"(lds_dst):"memory");}
__device__ __forceinline__ void glds4s(const void*sbase,unsigned voff,unsigned lds_dst){unsigned keep;
  asm volatile("s_nop 4\n\ts_mov_b32 %0, m0\n\ts_mov_b32 m0, %3\n\ts_nop 0\n\tglobal_load_lds_dword %1, %2\n\ts_mov_b32 m0, %0":"=&s"(keep):"v"(voff),"s"(sbase),"s"(lds_dst):"memory");}
__device__ __forceinline__ unsigned bandw(int e){
  const unsigned a=(e<0)?0u:((e>=31)?0xffffffffu:((2u<<e)-1u)); const int f=e-128; const unsigned b=(f<=0)?0u:((f>=32)?0xffffffffu:((1u<<f)-1u)); return a&~b; }
__device__ __forceinline__ float max3f(float a,float b,float c){float r;asm("v_max3_f32 %0, %1, %2, %3":"=v"(r):"v"(a),"v"(b),"v"(c));return r;}
__device__ __forceinline__ float max2f(float a,float b){float r;asm("v_max_f32_e32 %0, %1, %2":"=v"(r):"v"(a),"v"(b));return r;}
__device__ __forceinline__ float fadd_s(float a,float b){float r;asm("v_add_f32_e32 %0, %1, %2":"=v"(r):"v"(a),"v"(b));return r;}
__device__ __forceinline__ float fsub_s(float a,float b){float r;asm("v_sub_f32_e32 %0, %1, %2":"=v"(r):"v"(a),"v"(b));return r;}
typedef float f32x2_t __attribute__((ext_vector_type(2))); typedef __bf16 bf16x2_t __attribute__((ext_vector_type(2)));
__device__ __forceinline__ unsigned cvtpk_s(float lo,float hi){f32x2_t v={lo,hi};bf16x2_t b=__builtin_convertvector(v,bf16x2_t);return __builtin_bit_cast(unsigned,b);}
#define WAIT_BAR(N) asm volatile("s_waitcnt vmcnt(" #N ") lgkmcnt(0)\n\ts_barrier":::"memory")

template<bool NEGM> __device__ __forceinline__ void qkt(f32x16&p0,f32x16&p1,const char*Kslot,const bf16x8*qr,const f32x16&negm,int r32,int hi){ const f32x16 zc_={};
  const char*kb=Kslot+hi*1024+r32*16;
  #pragma unroll
  for(int d0=0;d0<4;++d0){
    const bf16x8 b0=*reinterpret_cast<const bf16x8*>(kb+d0*2048);
    const bf16x8 b1=*reinterpret_cast<const bf16x8*>(kb+d0*2048+512);
    if(d0==0){p0=__builtin_amdgcn_mfma_f32_32x32x16_bf16(b0,qr[0],NEGM?negm:zc_,0,0,0);p1=__builtin_amdgcn_mfma_f32_32x32x16_bf16(b1,qr[0],NEGM?negm:zc_,0,0,0);}
    else{p0=__builtin_amdgcn_mfma_f32_32x32x16_bf16(b0,qr[d0],p0,0,0,0);p1=__builtin_amdgcn_mfma_f32_32x32x16_bf16(b1,qr[d0],p1,0,0,0);}}
}
typedef __attribute__((address_space(3))) const char* lds_cptr;
typedef short v4i16_t __attribute__((ext_vector_type(4)));
__device__ __forceinline__ void kload8(bf16x8*kf,lds_cptr kp){
  kf[0]=*(const __attribute__((address_space(3))) bf16x8*)(kp);      kf[1]=*(const __attribute__((address_space(3))) bf16x8*)(kp+512);
  kf[2]=*(const __attribute__((address_space(3))) bf16x8*)(kp+2048); kf[3]=*(const __attribute__((address_space(3))) bf16x8*)(kp+2560);
  kf[4]=*(const __attribute__((address_space(3))) bf16x8*)(kp+4096); kf[5]=*(const __attribute__((address_space(3))) bf16x8*)(kp+4608);
  kf[6]=*(const __attribute__((address_space(3))) bf16x8*)(kp+6144); kf[7]=*(const __attribute__((address_space(3))) bf16x8*)(kp+6656);
}
__device__ __forceinline__ void kload2(bf16x8*kf,lds_cptr kp,int j){ kf[2*j]=*(const __attribute__((address_space(3))) bf16x8*)(kp+j*2048); kf[2*j+1]=*(const __attribute__((address_space(3))) bf16x8*)(kp+j*2048+512); }
__device__ __forceinline__ s16x4 vtr(lds_cptr p){ return __builtin_bit_cast(s16x4,__builtin_amdgcn_ds_read_tr16_b64_v4i16((__attribute__((address_space(3))) v4i16_t*)p)); }
__device__ __forceinline__ float rowmax(const f32x16&p0,const f32x16&p1){
  float a=max3f(p0[0],p0[1],p1[0]),b=max3f(p0[2],p0[3],p1[1]);a=max3f(a,p1[2],p1[3]);
  #pragma unroll
  for(int r=4;r<16;r+=4){a=max3f(a,p0[r],p0[r+1]);b=max3f(b,p0[r+2],p0[r+3]);a=max3f(a,p1[r],p1[r+1]);b=max3f(b,p1[r+2],p1[r+3]);}
  const float m=max2f(a,b);
  auto rr=__builtin_amdgcn_permlane32_swap(__float_as_uint(m),__float_as_uint(m),false,false);
  return max2f(__uint_as_float(rr[0]),__uint_as_float(rr[1]));
}
__device__ __forceinline__ void pv(f32x16*o,int vb,bf16x8 pa0,bf16x8 pa1,bf16x8 pa2,bf16x8 pa3){
  #pragma unroll
  for(int d0=0;d0<2;++d0){s16x4 lo[4],hi[4];
    #pragma unroll
    for(int ks=0;ks<4;++ks){
      asm volatile("ds_read_b64_tr_b16 %0,%1 offset:%c2":"=&v"(lo[ks]):"v"(vb),"i"(d0*4096+ks*1024):"memory");
      asm volatile("ds_read_b64_tr_b16 %0,%1 offset:%c2":"=&v"(hi[ks]):"v"(vb),"i"(d0*4096+ks*1024+512):"memory");}
    asm volatile("s_waitcnt lgkmcnt(0)":::"memory");SBAR();
    #define PK(k) (bf16x8){lo[k][0],lo[k][1],lo[k][2],lo[k][3],hi[k][0],hi[k][1],hi[k][2],hi[k][3]}
    o[d0]=__builtin_amdgcn_mfma_f32_32x32x16_bf16(pa0,PK(0),o[d0],0,0,0);
    o[d0]=__builtin_amdgcn_mfma_f32_32x32x16_bf16(pa1,PK(1),o[d0],0,0,0);
    o[d0]=__builtin_amdgcn_mfma_f32_32x32x16_bf16(pa2,PK(2),o[d0],0,0,0);
    o[d0]=__builtin_amdgcn_mfma_f32_32x32x16_bf16(pa3,PK(3),o[d0],0,0,0);
    #undef PK
  }
}

#ifndef ATTN_STORE16
#define ATTN_STORE16(p,v) (*(u32x4*)(p)=(v))
#endif
template<int MODE,int THRL> __device__ __forceinline__ void attn_unit(const bf16*Qu,long qs,const bf16*__restrict__ Kh,const bf16*__restrict__ Vh,long kvs,bf16*Ou,long os,float*lse,long lses,const int NT,
    const unsigned*selp,const char*Msrc,const int e0,char*shm){
  constexpr bool USE_NEGM=(MODE==0);
  const int tid=tidx(),lane=tid&63,r32=lane&31,hi=lane>>5; const int wid=__builtin_amdgcn_readfirstlane(tid>>6);
  const bf16*Qw=Qu+(long)(wid*QBLK)*qs;
  const unsigned lds0=(unsigned)(uintptr_t)shm;
  float*wsf=(float*)(shm+LDS_WS)+wid*64;
  const unsigned kvoff=(unsigned)(((int)lane*(int)kvs+wid*8)*2);
  const unsigned vvoff=(unsigned)(((16*(wid&3)+(lane>>2))*(int)kvs+(wid>>2)*32+(lane&3)*8)*2);
  const unsigned kdst=lds0+LDS_K+wid*1024, vdst=lds0+LDS_V+wid*1024;
  #define KT(t) ((MODE==0)?(((t)<4)?(NT-4+(t)):((t)-4)):(t))
  #define DMA_K(t,slot) glds16s((const char*)Kh+(long)KT(t)*(KVBLK*2)*kvs,kvoff,(unsigned)__builtin_amdgcn_readfirstlane(kdst+(slot)))
  #define DMA_V(t,slot) glds16s((const char*)Vh+(long)KT(t)*(KVBLK*2)*kvs,vvoff,(unsigned)__builtin_amdgcn_readfirstlane(vdst+(slot)))
  const unsigned mvoff=(unsigned)((wid*QBLK)*8+lane*4); const unsigned mdst=lds0+LDS_MSK+wid*512;
  #define DMA_M(t) do{ if(MODE==1) glds4s(Msrc+(long)(t)*(8192*8),mvoff,(unsigned)__builtin_amdgcn_readfirstlane(mdst+((t)&1)*256)); }while(0)
  const int vb0=(int)(lds0+LDS_V)+((lane>>4)&1)*32+(lane&3)*8+(4*hi+((lane&15)>>2))*64;
  const char*Kbase=shm+LDS_K; bf16x8 kf[8];
  const lds_cptr shm3=(lds_cptr)shm; const lds_cptr kp0=shm3+LDS_K+hi*1024+r32*16; const lds_cptr vp0=shm3+LDS_V+((lane>>4)&1)*32+(lane&3)*8+(4*hi+((lane&15)>>2))*64;
  DMA_M(0);DMA_M(1);
  DMA_K(0,0);DMA_V(0,0);DMA_K(1,SLOTB);
  bf16x8 qr[4];
  #pragma unroll
  for(int d0=0;d0<4;++d0)qr[d0]=*reinterpret_cast<const bf16x8*>(&Qw[(long)r32*qs+d0*16+hi*8]);
  unsigned selw=0u; if(MODE==0) selw=selp[(long)(wid*QBLK+r32)*8];
  float mhat=0.f,l_reg=0.f;f32x16 o[2];f32x16 negm; { float zz_=0.f; asm volatile("":"+v"(zz_));
    _Pragma("unroll") for(int r=0;r<16;++r){o[0][r]=zz_;o[1][r]=zz_;negm[r]=zz_;} } if(USE_NEGM) asm volatile("":"+v"(negm));
  const int qrel=wid*QBLK+r32;
  #define CMASK(P0,P1,t) do{ const float NEG_=-__builtin_inff(); \
    if(MODE==0){ if((t)<4){cmask(P0,P1,(t),qrel,hi);} else { const unsigned n_=(unsigned)(((t)-4)>>2); const bool ok_=(n_==(selw&255u))|(n_==((selw>>8)&255u))|(n_==((selw>>16)&255u)); \
        _Pragma("unroll") for(int r=0;r<16;++r){P0[r]=ok_?P0[r]:NEG_;P1[r]=ok_?P1[r]:NEG_;} } } \
    else if(MODE==1){ const unsigned long long mw_=*(const __attribute__((address_space(3))) unsigned long long*)(shm3+LDS_MSK+wid*512+((t)&1)*256+r32*8); \
        const unsigned lo_=((unsigned)mw_)>>(4*hi), hh_=((unsigned)(mw_>>32))>>(4*hi); \
        _Pragma("unroll") for(int r=0;r<16;++r){ const unsigned bit_=1u<<((r&3)+8*(r>>2)); P0[r]=(lo_&bit_)?(P0[r]-mhat):NEG_; P1[r]=(hh_&bit_)?(P1[r]-mhat):NEG_; } } \
    else { const int e_=e0-64*(t)+qrel-4*hi; const unsigned lo_=bandw(e_), hh_=bandw(e_-32);     \
        _Pragma("unroll") for(int r=0;r<16;++r){ const unsigned bit_=1u<<((r&3)+8*(r>>2)); P0[r]=(lo_&bit_)?(P0[r]-mhat):NEG_; P1[r]=(hh_&bit_)?(P1[r]-mhat):NEG_; } } }while(0)
  bool resc=false;
  #define START(P0,P1) do{ const float rm=rowmax(P0,P1); resc=false; \
    { const float dl=(rm<-1e30f)?0.f:rm; mhat=fadd_s(mhat,dl); \
      _Pragma("unroll") for(int r=0;r<16;++r){P0[r]=fsub_s(P0[r],dl);P1[r]=fsub_s(P1[r],dl);} \
      if(USE_NEGM){ _Pragma("unroll") for(int r=0;r<16;++r)negm[r]=-mhat; asm volatile("":"+v"(negm)); } } \
    _Pragma("unroll") for(int r=0;r<16;++r)P0[r]=__builtin_amdgcn_exp2f(P0[r]); }while(0)
  #define RESC() do{ if(resc){ asm volatile("s_waitcnt lgkmcnt(0)":::"memory"); \
      _Pragma("unroll") for(int d_=0;d_<2;++d_) _Pragma("unroll") for(int r=0;r<16;++r)o[d_][r]*=wsf[crow(r,hi)]; } }while(0)
  f32x16 pA0,pA1,pB0,pB1; const f32x16 zc16={};
  int sl_prev=0,sl_cur=0,sl_next=SLOTB;
  #define ROT() do{sl_prev=sl_cur;sl_cur=sl_next;sl_next=(sl_next==(NSLOT-1)*SLOTB)?0:sl_next+SLOTB;}while(0)
  DMA_K(2,2*SLOTB);
  WAIT_BAR(3);
  qkt<USE_NEGM>(pA0,pA1,Kbase,qr,negm,r32,hi);asm volatile("s_nop 15\n\ts_nop 7":"+v"(pA0),"+v"(pA1));CMASK(pA0,pA1,0);
  START(pA0,pA1);
  _Pragma("unroll") for(int r=0;r<16;++r)pA1[r]=__builtin_amdgcn_exp2f(pA1[r]);
  WAIT_BAR(0);
  DMA_K(3,0);DMA_V(1,SLOTB);
  ROT();
  kload8(kf,kp0+sl_cur);
  WAIT_BAR(2);
  s16x4 vlo[8],vhi[8]; u32x4 pw0,pw1,pw2,pw3;
  #define PKW(P,B) cvtpk_s(P[B],P[B+1])
  #define PAF(k) __builtin_bit_cast(bf16x8,pw##k)
  #define VFR(i) (bf16x8){vlo[i][0],vlo[i][1],vlo[i][2],vlo[i][3],vhi[i][0],vhi[i][1],vhi[i][2],vhi[i][3]}
  #define PIN(x) asm volatile("":"+v"(x))
  #define MX3(a,b,c) __builtin_fmaxf(__builtin_fmaxf((a),(b)),(c))
  #define GAPA(MF,A0,A1,A2,A3,W0,W1,PW) do{ MF; sacc+=A0; sacc+=A1; sacc+=A2; sacc+=A3; PIN(sacc); W0; W1; PIN(PW); SBAR(); }while(0)
  #define EX(v) __builtin_amdgcn_exp2f(v)
  #define GAPB(MF,X,B) do{ MF; X[B]=EX(X[B]); X[B+1]=EX(X[B+1]); X[B+2]=EX(X[B+2]); X[B+3]=EX(X[B+3]); PIN(X); SBAR(); }while(0)
  #define VRD(i) do{ vlo[i]=vtr(vp_+(((i)>>2)*4096+((i)&3)*1024)); vhi[i]=vtr(vp_+(((i)>>2)*4096+((i)&3)*1024+512)); }while(0)
  #define KRD(G,j) do{ if(G){ kload2(kf,kp0+sl_next,j); SBAR(); } }while(0)
    \
  #define LIVE2(tt) ((64*(tt)<=e0+32*wid+31)&&(64*(tt)+63>=e0+32*wid-128))
  #define STEP(C0,C1,P0,P1,t,GK,GV,GL) do{ SBAR(); if((t)+1<NT){DMA_M((t)+1);} \
    if((MODE==2)&&!LIVE2(t)&&!LIVE2((t)-1)){ \
      if(GK){DMA_K((t)+3,sl_cur);} if(GV){DMA_V((t)+1,sl_next);} \
      KRD(GL,0); KRD(GL,1); KRD(GL,2); KRD(GL,3); \
      _Pragma("unroll") for(int r=0;r<16;++r){C0[r]=0.f;C1[r]=0.f;} resc=false; \
    } else { \
    const lds_cptr vp_=vp0+sl_prev; \
    VRD(0); SBAR(); float sacc=(P0[0]+P0[1]); \
    GAPA(C0=__builtin_amdgcn_mfma_f32_32x32x16_bf16(kf[0],qr[0],USE_NEGM?negm:zc16,0,0,0), P0[2],P0[3],P0[4],P0[5],     pw0[0]=PKW(P0,0), pw0[1]=PKW(P0,2), pw0); \
    VRD(4); SBAR(); GAPA(C1=__builtin_amdgcn_mfma_f32_32x32x16_bf16(kf[1],qr[0],USE_NEGM?negm:zc16,0,0,0), P0[6],P0[7],P0[8],P0[9],     pw0[2]=PKW(P0,4), pw0[3]=PKW(P0,6), pw0); \
    VRD(1); SBAR(); GAPA(C0=__builtin_amdgcn_mfma_f32_32x32x16_bf16(kf[2],qr[1],C0,0,0,0),   P0[10],P0[11],P0[12],P0[13], pw1[0]=PKW(P0,8), pw1[1]=PKW(P0,10), pw1); \
    VRD(5); SBAR(); GAPA(C1=__builtin_amdgcn_mfma_f32_32x32x16_bf16(kf[3],qr[1],C1,0,0,0),   P0[14],P0[15],P1[0],P1[1],   pw1[2]=PKW(P0,12),pw1[3]=PKW(P0,14), pw1); \
    VRD(2); SBAR(); GAPA(C0=__builtin_amdgcn_mfma_f32_32x32x16_bf16(kf[4],qr[2],C0,0,0,0),   P1[2],P1[3],P1[4],P1[5],     pw2[0]=PKW(P1,0), pw2[1]=PKW(P1,2), pw2); \
    VRD(6); SBAR(); GAPA(C1=__builtin_amdgcn_mfma_f32_32x32x16_bf16(kf[5],qr[2],C1,0,0,0),   P1[6],P1[7],P1[8],P1[9],     pw2[2]=PKW(P1,4), pw2[3]=PKW(P1,6), pw2); \
    VRD(3); SBAR(); GAPA(C0=__builtin_amdgcn_mfma_f32_32x32x16_bf16(kf[6],qr[3],C0,0,0,0),   P1[10],P1[11],P1[12],P1[13], pw3[0]=PKW(P1,8), pw3[1]=PKW(P1,10), pw3); \
    VRD(7); SBAR(); GAPA(C1=__builtin_amdgcn_mfma_f32_32x32x16_bf16(kf[7],qr[3],C1,0,0,0),   P1[14],P1[15],0.f,0.f,       pw3[2]=PKW(P1,12),pw3[3]=PKW(P1,14), pw3); \
    l_reg+=sacc; \
    if(GK){DMA_K((t)+3,sl_cur);} if(GV){DMA_V((t)+1,sl_next);} \
    CMASK(C0,C1,t); \
    { float a=MX3(C0[0],C0[1],C1[0]),b=MX3(C0[2],C0[3],C1[1]); a=MX3(a,C1[2],C1[3]); \
      _Pragma("unroll") for(int r=4;r<16;r+=4){a=MX3(a,C0[r],C0[r+1]);b=MX3(b,C0[r+2],C0[r+3]);a=MX3(a,C1[r],C1[r+1]);b=MX3(b,C1[r+2],C1[r+3]);} \
      float rm=__builtin_fmaxf(a,b); { auto rr=__builtin_amdgcn_permlane32_swap(__float_as_uint(rm),__float_as_uint(rm),false,false); rm=__builtin_fmaxf(__uint_as_float(rr[0]),__uint_as_float(rr[1])); } \
      resc=false; \
      if(__builtin_expect(__any(rm>(float)THRL),0)){ const float dl=__builtin_fmaxf(rm,0.f); mhat+=dl; \
        _Pragma("unroll") for(int r=0;r<16;++r){C0[r]-=dl;C1[r]-=dl;} \
        if(USE_NEGM){ _Pragma("unroll") for(int r=0;r<16;++r)negm[r]=-mhat; asm volatile("":"+v"(negm)); } \
        const float f=__builtin_amdgcn_exp2f(-dl); l_reg*=f; if(hi==0)wsf[r32]=f; resc=true; } } \
    SBAR(); \
    GAPB(o[0]=__builtin_amdgcn_mfma_f32_32x32x16_bf16(PAF(0),VFR(0),o[0],0,0,0), C0,0); \
    GAPB(o[1]=__builtin_amdgcn_mfma_f32_32x32x16_bf16(PAF(0),VFR(4),o[1],0,0,0), C0,4); \
    KRD(GL,0); GAPB(o[0]=__builtin_amdgcn_mfma_f32_32x32x16_bf16(PAF(1),VFR(1),o[0],0,0,0), C0,8); \
    KRD(GL,1); GAPB(o[1]=__builtin_amdgcn_mfma_f32_32x32x16_bf16(PAF(1),VFR(5),o[1],0,0,0), C0,12); \
    KRD(GL,2); GAPB(o[0]=__builtin_amdgcn_mfma_f32_32x32x16_bf16(PAF(2),VFR(2),o[0],0,0,0), C1,0); \
    KRD(GL,3); GAPB(o[1]=__builtin_amdgcn_mfma_f32_32x32x16_bf16(PAF(2),VFR(6),o[1],0,0,0), C1,4); \
    GAPB(o[0]=__builtin_amdgcn_mfma_f32_32x32x16_bf16(PAF(3),VFR(3),o[0],0,0,0), C1,8); \
    GAPB(o[1]=__builtin_amdgcn_mfma_f32_32x32x16_bf16(PAF(3),VFR(7),o[1],0,0,0), C1,12); \
    } }while(0)
  int t=1;
  for(;t+5<NT;t+=2){
    STEP(pB0,pB1,pA0,pA1,t,true,true,true);     WAIT_BAR(2); RESC(); ROT();
    STEP(pA0,pA1,pB0,pB1,t+1,true,true,true);   WAIT_BAR(2); RESC(); ROT();
  }
  #define ENDW(tt) do{ if((tt)+3<NT){WAIT_BAR(2);} else if((tt)+2<NT){WAIT_BAR(1);} else {WAIT_BAR(0);} }while(0)
  for(;t+1<NT;t+=2){
    STEP(pB0,pB1,pA0,pA1,t,(t+3<NT),(t+1<NT),(t+1<NT));       ENDW(t);   RESC(); ROT();
    STEP(pA0,pA1,pB0,pB1,t+1,(t+4<NT),(t+2<NT),(t+2<NT));     ENDW(t+1); RESC(); ROT();
  }
  STEP(pB0,pB1,pA0,pA1,NT-1,false,false,false); RESC();
  { float sacc=pB0[0]+pB0[1]; _Pragma("unroll") for(int r=2;r<16;++r)sacc+=pB0[r]; _Pragma("unroll") for(int r=0;r<16;++r)sacc+=pB1[r]; l_reg+=sacc;
    pw0=(u32x4){PKW(pB0,0),PKW(pB0,2),PKW(pB0,4),PKW(pB0,6)};pw1=(u32x4){PKW(pB0,8),PKW(pB0,10),PKW(pB0,12),PKW(pB0,14)};pw2=(u32x4){PKW(pB1,0),PKW(pB1,2),PKW(pB1,4),PKW(pB1,6)};pw3=(u32x4){PKW(pB1,8),PKW(pB1,10),PKW(pB1,12),PKW(pB1,14)};
    SBAR(); pv(o,vb0+sl_cur,PAF(0),PAF(1),PAF(2),PAF(3)); }
  #undef PKW
  #undef PAF
  #undef VFR
  #undef PIN
  #undef MX3
  #undef GAPA
  #undef GAPB
  #undef EX
  #undef VRD
  #undef KRD
  #undef STEP
  #undef LIVE2
  #undef ENDW
  {auto rr=__builtin_amdgcn_permlane32_swap(__float_as_uint(l_reg),__float_as_uint(l_reg),false,false);l_reg=__uint_as_float(rr[0])+__uint_as_float(rr[1]);}
  if(hi==0)wsf[32+r32]=l_reg;asm volatile("s_waitcnt lgkmcnt(0)":::"memory");
  float rli[16];
  #pragma unroll
  for(int r=0;r<16;++r)rli[r]=__builtin_amdgcn_rcpf(wsf[32+crow(r,hi)]);
  long os2=os,lses2=lses; asm volatile("":"+s"(os2),"+s"(lses2));
  if(lse!=nullptr && hi==0) lse[(long)(wid*QBLK+r32)*lses2]=mhat+__log2f(l_reg);
  bf16*Ow=Ou+(long)(wid*QBLK)*os2;
  { bf16*stg=(bf16*)(shm+LDS_OST)+wid*2048;
    #pragma unroll
    for(int r=0;r<16;++r){const int orow=crow(r,hi);
      #pragma unroll
      for(int d0=0;d0<2;++d0)stg[orow*64+d0*32+r32]=(bf16)f2bf(o[d0][r]*rli[r]);}
    asm volatile("s_waitcnt lgkmcnt(0)":::"memory");
    #pragma unroll
    for(int i=0;i<4;++i){const int row=i*8+(lane>>3),ch=lane&7; const u32x4 v=*(const u32x4*)(stg+row*64+ch*8); ATTN_STORE16(Ow+(long)row*os2+ch*8,v);} }
  asm volatile("s_waitcnt lgkmcnt(0)\n\ts_barrier":::"memory");
  #undef DMA_K
  #undef DMA_V
  #undef DMA_M
  #undef KT
  #undef CMASK
  #undef START
  #undef RESC
  #undef ROT
}
constexpr int ATTN_LDS_BYTES=LDS_BYTES;
#undef SBAR
#undef WAIT_BAR
}

__device__ __forceinline__ int vcu_of(int G, int bx) { return (G % 8 == 0) ? (bx % 8) * (G / 8) + bx / 8 : bx; }
__device__ __forceinline__ void ph_attn_moba(const bf16* QKV, const unsigned* SEL, bf16* O, unsigned char* smem) {
    const int G = (int)gridDim.x, vcu = vcu_of(G, bidx());
#pragma unroll 1
    for (int idx = 2 * vcu; idx < 512; idx += ((idx & 1) ? 2 * G - 1 : 1)) {
        const int bh = idx >> 5, j = idx & 31, qb = (j & 1) ? 31 - (j >> 1) : (j >> 1), b = bh >> 3, h = bh & 7;
        const long row0 = (long)b * SEQ + 256 * qb, kv0 = (long)b * SEQ * AB_LD;
        attn_g::attn_unit<0, 8>(QKV + row0 * AB_LD + CQA + h * 64, AB_LD, QKV + kv0 + CKA + h * 64, QKV + kv0 + CVA + h * 64, AB_LD, O + row0 * DM + h * 64, DM, nullptr, 0, 4 * qb + 4,
                                SEL + row0 * 8 + h, nullptr, 0, (char*)smem);
    }
}


__device__ __forceinline__ void ph_attn_dsa(const bf16* QKV, const unsigned long long* MASK, bf16* O, unsigned char* smem) {
    const int G = (int)gridDim.x, vcu = vcu_of(G, bidx());
#pragma unroll 1
    for (int idx = 2 * vcu; idx < 512; idx += ((idx & 1) ? 2 * G - 1 : 1)) {
        const int bh = idx >> 5, j = idx & 31, qb = (j & 1) ? 31 - (j >> 1) : (j >> 1), b = bh >> 3, h = bh & 7;
        const long row0 = (long)b * SEQ + 256 * qb, kv0 = (long)b * SEQ * AB_LD;
        attn_g::attn_unit<1, 8>(QKV + row0 * AB_LD + CQB + h * 64, AB_LD, QKV + kv0 + CKB + h * 64, QKV + kv0 + CVB + h * 64, AB_LD, O + row0 * DM + 512 + h * 64, DM, nullptr, 0, 4 * qb + 4,
                                nullptr, (const char*)(MASK + (size_t)b * 128 * SEQ + 256 * qb), 0, (char*)smem);
    }
}
__device__ __forceinline__ void ph_attn_dilated(const bf16* QKV1, bf16* OG, float* LSE, unsigned char* smem) {
    const int G = (int)gridDim.x, vcu = vcu_of(G, bidx());
#pragma unroll 1
    for (int u = vcu; u < 3072; u += G) {
        const int g = u >> 10, bh = (u >> 5) & 31, j = u & 31, b = bh >> 4, h = bh & 15;
        const int lg = 2 * g, dil = 1 << lg, per = 32 >> lg;
        const int res = j / per, mb = j % per, m0 = 256 * mb, mk0 = (mb == 0) ? 0 : m0 - 128, nt = (m0 + 256 - mk0) / 64;
        const long qrow = (long)b * SEQ + res + (long)dil * m0, krow = (long)b * SEQ + res + (long)dil * mk0;
        attn_g::attn_unit<2, 8>(QKV1 + qrow * C_LD + h * 64, (long)dil * C_LD, QKV1 + krow * C_LD + 1024 + h * 64, QKV1 + krow * C_LD + 2048 + h * 64, (long)dil * C_LD,
                                OG + ((size_t)g * T + qrow) * DM + h * 64, (long)dil * DM, LSE + ((size_t)g * T + qrow) * 16 + h, (long)dil * 16, nt, nullptr, nullptr, m0 - mk0, (char*)smem);
    }
}


__device__ __forceinline__ float okf(float f) { return __builtin_bit_cast(float, okey(f)); }
__device__ __forceinline__ int score_pitch(int qb) { return 256 * (qb + 1) + 64; }
__device__ __forceinline__ size_t score_base(int b, int qb) { return (size_t)b * 35127296 + (size_t)65536 * (size_t)((qb * (qb + 1)) / 2) + (size_t)16384 * qb; }
__device__ __forceinline__ void ph_dsa_score(const bf16* QKV, float* S, unsigned char* smem) {
    using attn_g::bf16x8; using attn_g::f32x16;
    typedef __attribute__((address_space(3))) const char* lcp;
    const int tid = tidx(), lane = tid & 63, r32 = lane & 31, hi = lane >> 5; const int wid = __builtin_amdgcn_readfirstlane(tid >> 6);
    const unsigned lds0 = (unsigned)(uintptr_t)smem;
    const unsigned kvoff = (unsigned)((lane * AB_LD + wid * 8) * 2);
#pragma unroll 1
    for (int item = bidx(); item < 544; item += (int)gridDim.x) {
        const int b = item / 272; int rr = item % 272, qb = 0;
#pragma unroll 1
        for (;;) { const int nc = (qb + 2) >> 1; if (rr < nc) break; rr -= nc; ++qb; }
        const int t0 = 8 * rr, t1 = min(t0 + 8, 4 * qb + 4);
        const bf16* qrow = QKV + ((size_t)b * SEQ + 256 * qb + wid * 32 + r32) * AB_LD;
        bf16x8 qr[4][4]; float w[4];
#pragma unroll
        for (int h = 0; h < 4; ++h) { w[h] = bf2f(qrow[CWI + h]);
#pragma unroll
            for (int d0 = 0; d0 < 4; ++d0) qr[h][d0] = *(const bf16x8*)(qrow + CQI + h * 64 + d0 * 16 + hi * 8); }
        const char* kbase = (const char*)(QKV + (size_t)b * SEQ * AB_LD + CKI);
        const int rowlen = score_pitch(qb); float* sblk = S + score_base(b, qb) + (size_t)(wid * 32) * rowlen;
#define SC_DMA(t) attn_g::glds16s(kbase + (size_t)(t) * (64 * AB_LD * 2), kvoff, (unsigned)__builtin_amdgcn_readfirstlane(lds0 + (((t) - t0) & 1) * 8192 + wid * 1024))
        SC_DMA(t0);
        asm volatile("s_waitcnt vmcnt(0) lgkmcnt(0)\n\ts_barrier" ::: "memory");
#pragma unroll 1
        for (int t = t0; t < t1; ++t) {
            if (t + 1 < t1) SC_DMA(t + 1);
            const lcp kb = (lcp)smem + ((t - t0) & 1) * 8192 + hi * 1024 + r32 * 16;
            bf16x8 kf[4][2];
#pragma unroll
            for (int d0 = 0; d0 < 4; ++d0) { kf[d0][0] = *(const __attribute__((address_space(3))) bf16x8*)(kb + d0 * 2048); kf[d0][1] = *(const __attribute__((address_space(3))) bf16x8*)(kb + d0 * 2048 + 512); }
            f32x16 sc0, sc1;
#pragma unroll
            for (int r = 0; r < 16; ++r) { sc0[r] = 0.f; sc1[r] = 0.f; }
#pragma unroll
            for (int h = 0; h < 4; ++h) {
                f32x16 p0 = {}, p1 = {};
#pragma unroll
                for (int d0 = 0; d0 < 4; ++d0) { p0 = __builtin_amdgcn_mfma_f32_32x32x16_bf16(kf[d0][0], qr[h][d0], p0, 0, 0, 0); p1 = __builtin_amdgcn_mfma_f32_32x32x16_bf16(kf[d0][1], qr[h][d0], p1, 0, 0, 0); }
#pragma unroll
                for (int r = 0; r < 16; ++r) { sc0[r] = fmaf(w[h], fmaxf(p0[r], 0.f), sc0[r]); sc1[r] = fmaf(w[h], fmaxf(p1[r], 0.f), sc1[r]); }
                __builtin_amdgcn_sched_barrier(0);
            }
            {   typedef __attribute__((address_space(3))) f32x4* lf4;
                const lf4 wr = (lf4)((__attribute__((address_space(3))) char*)smem + 16384 + wid * 8704 + r32 * 272 + hi * 16);
#pragma unroll
                for (int g = 0; g < 4; ++g) {
                    wr[2 * g] = (f32x4){okf(sc0[4 * g]), okf(sc0[4 * g + 1]), okf(sc0[4 * g + 2]), okf(sc0[4 * g + 3])}; wr[2 * g + 8] = (f32x4){okf(sc1[4 * g]), okf(sc1[4 * g + 1]), okf(sc1[4 * g + 2]), okf(sc1[4 * g + 3])}; }
                const int ln2 = tidx() & 63;
                const lf4 rd = (lf4)((__attribute__((address_space(3))) char*)smem + 16384 + wid * 8704 + (ln2 >> 4) * 272 + (ln2 & 15) * 16);
                float* gp = sblk + (size_t)(ln2 >> 4) * rowlen + 64 * t + 4 * (ln2 & 15);
#pragma unroll
                for (int i = 0; i < 8; ++i) { const f32x4 vv = rd[i * 68]; __builtin_nontemporal_store(vv, (f32x4*)(gp + (size_t)(4 * i) * rowlen)); }
            }
            asm volatile("s_waitcnt vmcnt(8) lgkmcnt(0)\n\ts_barrier" ::: "memory");
        }
#undef SC_DMA
    }
}
#define RS_PASS(SHIFT, PMASK, PVAL) do { \
    _Pragma("unroll") for (int i_ = 0; i_ < 16; ++i_) *(LAS u32x4g*)(hist + 4 * (lane + 64 * i_)) = (u32x4g){0u, 0u, 0u, 0u}; \
    _Pragma("unroll") for (int g_ = 0; g_ < 8; ++g_) if (g_ * 1024 < n) { \
        _Pragma("unroll") for (int j_ = 16 * g_; j_ < 16 * g_ + 16; ++j_) { const unsigned k_ = v[j_]; const bool mt_ = (k_ & (PMASK)) == (PVAL); \
            if ((PMASK) == 0u || __ballot(mt_) != 0ull) { \
                if (mt_) __hip_atomic_fetch_add(hist + (((k_ >> (SHIFT)) & 255u) * 16u + (unsigned)(lane & 15)), 1u, __ATOMIC_RELAXED, __HIP_MEMORY_SCOPE_WORKGROUP); } } } \
    unsigned c_[4]; \
    _Pragma("unroll") for (int b_ = 0; b_ < 4; ++b_) { u32x4g q_ = *(const LAS u32x4g*)(hist + 64 * lane + 16 * b_); \
        _Pragma("unroll") for (int i_ = 1; i_ < 4; ++i_) { const u32x4g r_ = *(const LAS u32x4g*)(hist + 64 * lane + 16 * b_ + 4 * i_); q_ += r_; } \
        c_[b_] = (q_[0] + q_[1]) + (q_[2] + q_[3]); } \
    const unsigned tot_ = (c_[0] + c_[1]) + (c_[2] + c_[3]); \
    unsigned inc_ = tot_;                         \
    _Pragma("unroll") for (int o_ = 1; o_ < 64; o_ <<= 1) { const unsigned t_ = (unsigned)bperm((lane + o_) & 63, (int)inc_); if (lane + o_ < 64) inc_ += t_; } \
    const unsigned suf_ = inc_ - tot_;            \
    const unsigned long long hit_ = __ballot(suf_ < need && need <= inc_); \
    const int L_ = (int)__builtin_ctzll(hit_); \
    unsigned run_ = suf_, bsel_ = 0u, cg_ = 0u, ce_ = 0u; bool done_ = false; \
    _Pragma("unroll") for (int i_ = 3; i_ >= 0; --i_) { if (!done_ && run_ + c_[i_] >= need) { bsel_ = (unsigned)(4 * lane + i_); cg_ = run_; ce_ = c_[i_]; done_ = true; } run_ += c_[i_]; } \
    bsel = (unsigned)__builtin_amdgcn_readlane((int)bsel_, L_); need -= (unsigned)__builtin_amdgcn_readlane((int)cg_, L_); ceq = (unsigned)__builtin_amdgcn_readlane((int)ce_, L_); } while (0)
__device__ __forceinline__ void ph_dsa_select_opt(const float* S, unsigned long long* mask, unsigned char* smem) {
    const int tid = tidx(), lane = tid & 63, wave = tid >> 6;
    LAS unsigned* hist = (LAS unsigned*)((LAS unsigned char*)smem + wave * 16384);
    const int gwv = bidx() * (NT / 64) + wave, ngw = (int)gridDim.x * (NT / 64);
#pragma unroll 1
    for (int t = gwv; t < T; t += ngw) {
        const int b = t / SEQ, tt = t % SEQ, n = tt + 1, qb = tt >> 8;
        const float* row = S + score_base(b, qb) + (size_t)(tt & 255) * score_pitch(qb) + 4 * lane;
        unsigned v[128];
#pragma unroll
        for (int g = 0; g < 8; ++g) {
            if (g * 1024 < n) {
#pragma unroll
                for (int j = 4 * g; j < 4 * g + 4; ++j) { const u32x4g q = __builtin_nontemporal_load((const u32x4g*)(row + 256 * j)); v[4 * j] = q[0]; v[4 * j + 1] = q[1]; v[4 * j + 2] = q[2]; v[4 * j + 3] = q[3]; }
            } else {
#pragma unroll
                for (int j = 16 * g; j < 16 * g + 16; ++j) v[j] = 0u;
            }
        }
        asm volatile("" ::: "memory");
#pragma unroll
        for (int g = 0; g < 8; ++g) {
            if (g * 1024 < n && (g + 1) * 1024 > n) {
#pragma unroll
                for (int j = 16 * g; j < 16 * g + 16; ++j) { const int kv = 256 * (j >> 2) + 4 * lane + (j & 3); v[j] = (kv < n) ? v[j] : 0u; }
            }
        }
        unsigned thr = 0u, need = 256u, ceq = 0u;
        if (n > 256) {
            unsigned bsel;
            RS_PASS(24, 0u, 0u);                 thr = bsel << 24;
            RS_PASS(16, 0xff000000u, thr);       thr |= bsel << 16;
            RS_PASS(8, 0xffff0000u, thr);        thr |= bsel << 8;
            RS_PASS(0, 0xffffff00u, thr);        thr |= bsel;
        }
        const int ntile = 4 * (qb + 1);
        const bool ties = (n > 256) && (ceq != need);
        unsigned taken = 0u;
        unsigned long long* mrow = mask + (size_t)b * 128 * SEQ + tt;
#pragma unroll
        for (int j = 0; j < 32; ++j) {
            if (4 * j < ntile) {
                unsigned nib = 0u;
                if (n <= 256) {
#pragma unroll
                    for (int i = 0; i < 4; ++i) nib |= ((256 * j + 4 * lane + i) < n) ? (1u << i) : 0u;
                } else if (!ties) {
#pragma unroll
                    for (int i = 0; i < 4; ++i) nib |= (v[4 * j + i] >= thr) ? (1u << i) : 0u;
                } else {
                    bool eq[4]; unsigned long long em[4]; unsigned long long any = 0ull;
#pragma unroll
                    for (int i = 0; i < 4; ++i) { nib |= (v[4 * j + i] > thr) ? (1u << i) : 0u; eq[i] = (v[4 * j + i] == thr) && ((256 * j + 4 * lane + i) < n); em[i] = __ballot(eq[i]); any |= em[i]; }
                    if (any != 0ull) {
                        const unsigned long long ltm = (1ull << lane) - 1ull;
                        unsigned below = taken, tot = 0u;
#pragma unroll
                        for (int i = 0; i < 4; ++i) { below += (unsigned)__popcll(em[i] & ltm); tot += (unsigned)__popcll(em[i]); }
#pragma unroll
                        for (int i = 0; i < 4; ++i) { if (eq[i]) { if (below < need) nib |= (1u << i); ++below; } }
                        taken += tot;
                    }
                }
                const unsigned sh = 4u * (unsigned)(lane & 15);
                unsigned lo = (sh < 32u) ? (nib << sh) : 0u, hiw = (sh >= 32u) ? (nib << (sh - 32u)) : 0u;
                lo |= (unsigned)__builtin_amdgcn_update_dpp(0, (int)lo, 0x121, 0xf, 0xf, true); hiw |= (unsigned)__builtin_amdgcn_update_dpp(0, (int)hiw, 0x121, 0xf, 0xf, true);
                lo |= (unsigned)__builtin_amdgcn_update_dpp(0, (int)lo, 0x122, 0xf, 0xf, true); hiw |= (unsigned)__builtin_amdgcn_update_dpp(0, (int)hiw, 0x122, 0xf, 0xf, true);
                lo |= (unsigned)__builtin_amdgcn_update_dpp(0, (int)lo, 0x124, 0xf, 0xf, true); hiw |= (unsigned)__builtin_amdgcn_update_dpp(0, (int)hiw, 0x124, 0xf, 0xf, true);
                lo |= (unsigned)__builtin_amdgcn_update_dpp(0, (int)lo, 0x128, 0xf, 0xf, true); hiw |= (unsigned)__builtin_amdgcn_update_dpp(0, (int)hiw, 0x128, 0xf, 0xf, true);
                const int tile = 4 * j + (lane >> 4);
                if ((lane & 15) == 0 && tile < ntile) mrow[(size_t)tile * SEQ] = ((unsigned long long)hiw << 32) | lo;
            }
        }
    }
}
#undef RS_PASS
#define XB_TMO      128
#define XB_XCNT(j)  (256  + 64 * (j))
#define XB_XSUB(j)  (1280 + 64 * (j))
#define XB_XGEN(j)  (2304 + 64 * (j))
#define XB_TOP      3328
#define XB_TOPGEN   3392
#define XCD_BAR_WORDS 3456
#define XB_SPIN_CAP (1u << 18)

__device__ __forceinline__ unsigned xb_ld(unsigned* p)              { return __hip_atomic_load(p, __ATOMIC_RELAXED, __HIP_MEMORY_SCOPE_AGENT); }
__device__ __forceinline__ unsigned xb_add(unsigned* p, unsigned v) { return __hip_atomic_fetch_add(p, v, __ATOMIC_RELAXED, __HIP_MEMORY_SCOPE_AGENT); }
__device__ __forceinline__ unsigned xb_xcc_id() { return (unsigned)__builtin_amdgcn_s_getreg((3 << 11) | 20) & 0xFu; }
#define XB_SPIN(cond, bar) do { unsigned _sp = 0; while (cond) { __builtin_amdgcn_s_sleep(1); \
    if ((++_sp & 255u) == 0u) { if (xb_ld(&(bar)[XB_TMO])) break; if (_sp > XB_SPIN_CAP) { atomicAdd(&(bar)[XB_TMO], 1u); break; } } } } while (0)

struct XcdBarrier {
    unsigned* bar; unsigned x;
    volatile LAS unsigned* st;
};

__device__ __forceinline__ XcdBarrier xcd_barrier_post(unsigned* bar, volatile LAS unsigned* st) {
    XcdBarrier b; b.bar = bar; b.x = xb_xcc_id(); b.st = st;
    if (tidx() == 0) (void)xb_add(&bar[XB_XCNT(b.x)], 1u);
    return b;
}
__device__ __forceinline__ void xcd_barrier_complete(unsigned* bar, unsigned x, unsigned& nloc, unsigned& nx) {
    const unsigned G = gridDim.x * gridDim.y * gridDim.z;
    unsigned sum, cnt, mine, sp = 0u;
    for (;;) {
        sum = 0u; cnt = 0u; mine = 0u;
#pragma unroll
        for (unsigned j = 0; j < 16; ++j) { const unsigned c = xb_ld(&bar[XB_XCNT(j)]); sum += c; cnt += (c > 0u) ? 1u : 0u; mine = (j == x) ? c : mine; }
        if (sum == G) break;
        __builtin_amdgcn_s_sleep(1);
        if ((++sp & 255u) == 0u) { if (xb_ld(&bar[XB_TMO])) break; if (sp > XB_SPIN_CAP) { atomicAdd(&bar[XB_TMO], 1u); break; } }
    }
    nloc = mine > 0u ? mine : 1u; nx = cnt > 0u ? cnt : 1u;
}

__device__ __forceinline__ void xcd_barrier(const XcdBarrier& b) {
    asm volatile("s_waitcnt vmcnt(0)" ::: "memory");
    __syncthreads();
    if (tidx() == 0) {
        unsigned* bar = b.bar;
        __builtin_amdgcn_s_waitcnt(0);
        unsigned nloc = b.st[0], nx = b.st[1];
        if (nloc == 0u) { xcd_barrier_complete(bar, b.x, nloc, nx); b.st[0] = nloc; b.st[1] = nx; }
        const unsigned old = xb_add(&bar[XB_XSUB(b.x)], 1u);
        const unsigned gen = old / nloc;
        if (old + 1u == (gen + 1u) * nloc) {
            __builtin_amdgcn_fence(__ATOMIC_RELEASE, "agent");
            asm volatile("s_waitcnt vmcnt(0)" ::: "memory");
            const unsigned og = xb_add(&bar[XB_TOP], 1u);
            const unsigned tg = og / nx;
            if (og + 1u == (tg + 1u) * nx) xb_add(&bar[XB_TOPGEN], 1u);
            else XB_SPIN(xb_ld(&bar[XB_TOPGEN]) == tg, bar);
            __builtin_amdgcn_fence(__ATOMIC_ACQUIRE, "agent");
            xb_add(&bar[XB_XGEN(b.x)], 1u);
            asm volatile("s_waitcnt vmcnt(0)" ::: "memory");
        } else {
            XB_SPIN(xb_ld(&bar[XB_XGEN(b.x)]) == gen, bar);
            __builtin_amdgcn_fence(__ATOMIC_ACQUIRE, "agent");
            asm volatile("s_waitcnt vmcnt(0)" ::: "memory");
        }
    }
    __syncthreads();
}


constexpr float U_SCALE = 64.f, V_SCALE = 8.f;
typedef float f32x2g __attribute__((ext_vector_type(2)));
template <bool SLICED> __device__ __forceinline__ void cvt_fp8(const float* src, unsigned char* dst, size_t n, float scale) {
    for (size_t e = ((size_t)bidx() * NT + tidx()) * 16; e < n; e += (size_t)gridDim.x * NT * 16) {
        u32x4g o;
#pragma unroll
        for (int d = 0; d < 4; ++d) { const f32x4 a = *(const f32x4*)(src + e + 4 * d);
            int p = __builtin_amdgcn_cvt_pk_fp8_f32(a.x * scale, a.y * scale, 0, false); p = __builtin_amdgcn_cvt_pk_fp8_f32(a.z * scale, a.w * scale, p, true); o[d] = (unsigned)p; }
        if (SLICED) { const size_t ex = e >> 10, dd = e & 1023; *(u32x4g*)(dst + (dd >> 7) * ((size_t)NEXP * 128) + ex * 128 + (dd & 127)) = o; }
        else *(u32x4g*)(dst + e) = o; }
}
__device__ __forceinline__ float dot16_fp8(const float (&x)[16], u32x4g u) {
    f32x2g s2 = {0.f, 0.f};
#pragma unroll
    for (int d = 0; d < 4; ++d) { const int ud = (int)u[d]; const f32x2g lo = __builtin_amdgcn_cvt_pk_f32_fp8(ud, false), hi = __builtin_amdgcn_cvt_pk_f32_fp8(ud, true);
        const f32x2g xa = {x[4 * d], x[4 * d + 1]}, xb = {x[4 * d + 2], x[4 * d + 3]};
        s2 = lo * xa + s2; s2 = hi * xb + s2; }
    return s2[0] + s2[1];
}
#define LD8(dst, TAB, B) do { const int er_ = ((B) < 8) ? e0 : e1; \
    _Pragma("unroll") for (int k = 0; k < 8; ++k) { const int idx = __builtin_amdgcn_readlane(er_, ((B) * 8 + k) & 63); dst[k] = *(const u32x4g*)((TAB) + (size_t)idx * DM + 16 * lane); } } while (0)
#define CMU8(src, B) do { float s_[8]; \
    _Pragma("unroll") for (int k = 0; k < 8; ++k) s_[k] = dot16_fp8(x, src[k]); \
    float r_[4]; const bool b5 = lane & 32, b4 = lane & 16, b3 = lane & 8; \
    _Pragma("unroll") for (int i = 0; i < 4; ++i) { const float snd = b5 ? s_[i] : s_[4 + i], kp = b5 ? s_[4 + i] : s_[i]; r_[i] = kp + __shfl_xor(snd, 32); } \
    float q_[2]; \
    _Pragma("unroll") for (int i = 0; i < 2; ++i) { const float snd = b4 ? r_[i] : r_[2 + i], kp = b4 ? r_[2 + i] : r_[i]; q_[i] = kp + __shfl_xor(snd, 16); } \
    float p_; { const float snd = b3 ? q_[0] : q_[1], kp = b3 ? q_[1] : q_[0]; p_ = kp + __shfl_xor(snd, 8); } \
    p_ += __shfl_xor(p_, 4); p_ += __shfl_xor(p_, 2); p_ += __shfl_xor(p_, 1); \
    if ((lane & 7) == 0) al[(B) * 8 + (lane >> 3)] = p_; } while (0)
#define CMV8(src, B) do { const float wr_ = ((B) < 8) ? w0 : w1; \
    _Pragma("unroll") for (int k = 0; k < 8; ++k) { \
        const float w = __builtin_bit_cast(float, __builtin_amdgcn_readlane(__builtin_bit_cast(int, wr_), ((B) * 8 + k) & 63)); const u32x4g v0 = src[k]; \
        _Pragma("unroll") for (int d = 0; d < 4; ++d) { const int vd = (int)v0[d]; const f32x2g lo = __builtin_amdgcn_cvt_pk_f32_fp8(vd, false), hi = __builtin_amdgcn_cvt_pk_f32_fp8(vd, true); \
            acc[4 * d] = fmaf(w, lo[0], acc[4 * d]); acc[4 * d + 1] = fmaf(w, lo[1], acc[4 * d + 1]); acc[4 * d + 2] = fmaf(w, hi[0], acc[4 * d + 2]); acc[4 * d + 3] = fmaf(w, hi[1], acc[4 * d + 3]); } } } while (0)
__device__ __forceinline__ void ph_peer_gather_fp8(const int* eidx, const float* gw, const unsigned char* U, const unsigned char* V, float* h, const float* gain_next, bf16* XN, unsigned char* smem) {
    const int tid = tidx(), lane = tid & 63, wave = tid >> 6;
    float* al = (float*)smem + wave * 128;
    const int gwv = bidx() * (NT / 64) + wave, ngw = gridDim.x * (NT / 64);
#pragma unroll 1
    for (int t = gwv; t < T; t += ngw) {
        float x[16];
        { const u32x4g xa = *(const u32x4g*)(XN + (size_t)t * DM + 16 * lane), xb = *(const u32x4g*)(XN + (size_t)t * DM + 16 * lane + 8);
#pragma unroll
          for (int d = 0; d < 4; ++d) { const unsigned wa = xa[d], wb = xb[d]; x[2 * d] = bflo(wa); x[2 * d + 1] = bfhi(wa); x[8 + 2 * d] = bflo(wb); x[8 + 2 * d + 1] = bfhi(wb); } }
        const int e0 = eidx[(size_t)t * 128 + lane], e1 = eidx[(size_t)t * 128 + 64 + lane];
        const float g0 = gw[(size_t)t * 128 + lane], g1 = gw[(size_t)t * 128 + 64 + lane];
        u32x4g ra[8], rb[8];
        LD8(ra, U, 0);
#pragma unroll 1
        for (int b = 0; b < 16; b += 2) {
            LD8(rb, U, b + 1); CMU8(ra, b);
            if (b + 2 < 16) LD8(ra, U, b + 2); else LD8(ra, V, 0);
            CMU8(rb, b + 1);
        }
        __builtin_amdgcn_s_waitcnt(0xc07f); asm volatile("" ::: "memory");
        const float w0 = g0 * gelu_tanh(al[lane] * (1.0f / U_SCALE)) * (1.0f / V_SCALE), w1 = g1 * gelu_tanh(al[64 + lane] * (1.0f / U_SCALE)) * (1.0f / V_SCALE);
        float acc[16];
#pragma unroll
        for (int i = 0; i < 16; ++i) acc[i] = 0.f;
#pragma unroll 1
        for (int b = 0; b < 16; b += 2) {
            LD8(rb, V, b + 1); CMV8(ra, b);
            if (b + 2 < 16) LD8(ra, V, b + 2);
            CMV8(rb, b + 1);
        }
        float* hp = h + (size_t)t * DM + 16 * lane;
        f32x4 hv[4]; float ss = 0.f;
#pragma unroll
        for (int i = 0; i < 4; ++i) { hv[i] = *(f32x4*)(hp + 4 * i); hv[i] += (f32x4){acc[4 * i], acc[4 * i + 1], acc[4 * i + 2], acc[4 * i + 3]}; *(f32x4*)(hp + 4 * i) = hv[i];
            ss += hv[i][0] * hv[i][0] + hv[i][1] * hv[i][1] + hv[i][2] * hv[i][2] + hv[i][3] * hv[i][3]; }
        const float rstd = 1.0f / sqrtf(wave_sum(ss) * (1.0f / DM) + NORM_EPS);
        u32x4g o0, o1;
#pragma unroll
        for (int i = 0; i < 2; ++i) { const f32x4 ga = *(const f32x4*)(gain_next + 16 * lane + 4 * i), gb = *(const f32x4*)(gain_next + 16 * lane + 8 + 4 * i);
            o0[2 * i] = pk2(hv[i][0] * rstd * ga[0], hv[i][1] * rstd * ga[1]); o0[2 * i + 1] = pk2(hv[i][2] * rstd * ga[2], hv[i][3] * rstd * ga[3]);
            o1[2 * i] = pk2(hv[2 + i][0] * rstd * gb[0], hv[2 + i][1] * rstd * gb[1]); o1[2 * i + 1] = pk2(hv[2 + i][2] * rstd * gb[2], hv[2 + i][3] * rstd * gb[3]); }
        *(u32x4g*)(XN + (size_t)t * DM + 16 * lane) = o0; *(u32x4g*)(XN + (size_t)t * DM + 16 * lane + 8) = o1;
    }
}

#define GA_LDE(E0, E1, XA, XB, tt) do { const size_t t_ = (size_t)(((tt) < T) ? (tt) : tlast); E0 = eidx[t_ * 128 + lane]; E1 = eidx[t_ * 128 + 64 + lane]; \
    XA = *(const u32x4g*)(XN + t_ * DM + 128 * j + 16 * c); XB = *(const u32x4g*)(XN + t_ * DM + 128 * j + 16 * c + 8); } while (0)
#define G_LDP(PC, E0, E1, TAB) do { _Pragma("unroll") for (int i = 0; i < 16; ++i) { const int idx = bperm((8 * i + sgrp) & 63, (i < 8) ? E0 : E1); PC[i] = *(const u32x4g*)((TAB) + (size_t)idx * 128); } } while (0)
__device__ __forceinline__ void ph_gather_a(const bf16* XN, const int* eidx, const unsigned char* Us, float* PA, int j, int r, int nper, const float* gain) {
    const int tid = tidx(), lane = tid & 63, wave = tid >> 6, sgrp = lane >> 3, c = lane & 7;
    const unsigned char* Uj = Us + (size_t)j * NEXP * 128 + 16 * c;
    const int t0 = r * (NT / 64) + wave, st = nper * (NT / 64); if (st <= 0 || t0 >= T) return;
    const int tlast = t0 + ((T - 1 - t0) / st) * st;
    int e0, e1; u32x4g xa, xb, nxa, nxb; u32x4g pc[16];
    float gs[16];
#pragma unroll
    for (int i = 0; i < 16; ++i) gs[i] = gain[128 * j + 16 * c + i];
    GA_LDE(e0, e1, xa, xb, t0); G_LDP(pc, e0, e1, Uj); GA_LDE(e0, e1, nxa, nxb, t0 + st);
#pragma unroll 1
    for (int t = t0; t < T; t += st) {
        float x[16];
#pragma unroll
        for (int d = 0; d < 4; ++d) { const unsigned wa = xa[d], wb = xb[d]; x[2 * d] = bflo(wa) * gs[2 * d]; x[2 * d + 1] = bfhi(wa) * gs[2 * d + 1]; x[8 + 2 * d] = bflo(wb) * gs[8 + 2 * d]; x[8 + 2 * d + 1] = bfhi(wb) * gs[8 + 2 * d + 1]; }
        float sm[16];
#pragma unroll
        for (int i = 0; i < 16; ++i) sm[i] = dot16_fp8(x, pc[i]);
        asm volatile("" ::: "memory");
        G_LDP(pc, e0, e1, Uj);
        xa = nxa; xb = nxb;
        GA_LDE(e0, e1, nxa, nxb, t + 2 * st);
        float p0 = 0.f, p1 = 0.f;
#pragma unroll
        for (int i = 0; i < 16; ++i) { float v = sm[i]; v += shx<1>(v); v += shx<2>(v); v += shx<4>(v);
            if (i < 8) p0 = ((i & 7) == c) ? v : p0; else p1 = ((i & 7) == c) ? v : p1; }
        float* pa = PA + ((size_t)t * 8 + j) * 128 + 8 * c + sgrp; pa[0] = p0; pa[64] = p1;
    }
}
__device__ __forceinline__ void ph_gather_v(const int* eidx, const float* gw, const float* PA, const unsigned char* V, float* h, const float* gain_next, bf16* XN) {
    const int tid = tidx(), lane = tid & 63, wave = tid >> 6;
    const int gwv = bidx() * (NT / 64) + wave, ngw = gridDim.x * (NT / 64);
    int ne0 = 0, ne1 = 0; if (gwv < T) { ne0 = eidx[(size_t)gwv * 128 + lane]; ne1 = eidx[(size_t)gwv * 128 + 64 + lane]; }
#pragma unroll 1
    for (int t = gwv; t < T; t += ngw) {
        const int e0 = ne0, e1 = ne1;
        u32x4g ra[8], rb[8];
        LD8(ra, V, 0);
        { const size_t tn = (size_t)((t + ngw < T) ? t + ngw : t); ne0 = eidx[tn * 128 + lane]; ne1 = eidx[tn * 128 + 64 + lane]; }
        float a0 = 0.f, a1 = 0.f;
#pragma unroll
        for (int q = 0; q < 8; ++q) { a0 += PA[((size_t)t * 8 + q) * 128 + lane]; a1 += PA[((size_t)t * 8 + q) * 128 + 64 + lane]; }
        const float w0 = gw[(size_t)t * 128 + lane] * gelu_tanh(a0 * (1.0f / U_SCALE)) * (1.0f / V_SCALE), w1 = gw[(size_t)t * 128 + 64 + lane] * gelu_tanh(a1 * (1.0f / U_SCALE)) * (1.0f / V_SCALE);
        float acc[16];
#pragma unroll
        for (int i = 0; i < 16; ++i) acc[i] = 0.f;
#pragma unroll 1
        for (int b = 0; b < 16; b += 2) {
            LD8(rb, V, b + 1); CMV8(ra, b);
            if (b + 2 < 16) LD8(ra, V, b + 2);
            CMV8(rb, b + 1);
        }
        float* hp = h + (size_t)t * DM + 16 * lane;
        f32x4 hv[4]; float ss = 0.f;
#pragma unroll
        for (int i = 0; i < 4; ++i) { hv[i] = *(f32x4*)(hp + 4 * i); hv[i] += (f32x4){acc[4 * i], acc[4 * i + 1], acc[4 * i + 2], acc[4 * i + 3]}; *(f32x4*)(hp + 4 * i) = hv[i];
            ss += hv[i][0] * hv[i][0] + hv[i][1] * hv[i][1] + hv[i][2] * hv[i][2] + hv[i][3] * hv[i][3]; }
        const float rstd = 1.0f / sqrtf(wave_sum(ss) * (1.0f / DM) + NORM_EPS);
        u32x4g o0, o1;
#pragma unroll
        for (int i = 0; i < 2; ++i) { const f32x4 ga = *(const f32x4*)(gain_next + 16 * lane + 4 * i), gb = *(const f32x4*)(gain_next + 16 * lane + 8 + 4 * i);
            o0[2 * i] = pk2(hv[i][0] * rstd * ga[0], hv[i][1] * rstd * ga[1]); o0[2 * i + 1] = pk2(hv[i][2] * rstd * ga[2], hv[i][3] * rstd * ga[3]);
            o1[2 * i] = pk2(hv[2 + i][0] * rstd * gb[0], hv[2 + i][1] * rstd * gb[1]); o1[2 * i + 1] = pk2(hv[2 + i][2] * rstd * gb[2], hv[2 + i][3] * rstd * gb[3]); }
        *(u32x4g*)(XN + (size_t)t * DM + 16 * lane) = o0; *(u32x4g*)(XN + (size_t)t * DM + 16 * lane + 8) = o1;
    }
}


__device__ __forceinline__ void ph_gather_u8(const bf16* XN, const int* eidx, const unsigned char* Us, float* PA, int j, int r, int nper, const float* gain, unsigned char* smem) {
    const int tid = tidx(), lane = tid & 63, wave = tid >> 6, u = lane >> 3, c = lane & 7;
    LAS int* il = (LAS int*)((LAS unsigned char*)smem + wave * 4096);
    const unsigned char* Uj = Us + (size_t)j * NEXP * 128 + 16 * c;
    float gs[16];
#pragma unroll
    for (int i = 0; i < 16; ++i) gs[i] = gain[128 * j + 16 * c + i];
    const int g0 = r * (NT / 64) + wave, gstep = nper * (NT / 64); if (gstep <= 0) return;
#pragma unroll 1
    for (int g = g0; g < T / 8; g += gstep) {
        const size_t t = (size_t)g * 8 + u;
#pragma unroll
        for (int i = 0; i < 4; ++i) *(LAS u32x4g*)(il + u * 128 + 16 * c + 4 * i) = *(const u32x4g*)(eidx + t * 128 + 16 * c + 4 * i);
        float x[16];
        { const u32x4g xa = *(const u32x4g*)(XN + t * DM + 128 * j + 16 * c), xb = *(const u32x4g*)(XN + t * DM + 128 * j + 16 * c + 8);
#pragma unroll
          for (int d = 0; d < 4; ++d) { const unsigned wa = xa[d], wb = xb[d]; x[2 * d] = bflo(wa) * gs[2 * d]; x[2 * d + 1] = bfhi(wa) * gs[2 * d + 1]; x[8 + 2 * d] = bflo(wb) * gs[8 + 2 * d]; x[8 + 2 * d + 1] = bfhi(wb) * gs[8 + 2 * d + 1]; } }
        float res[16];
        u32x4g pa_[8], pb_[8];
#define U8_LD(dst, B) do { _Pragma("unroll") for (int k = 0; k < 8; ++k) { const int idx = il[u * 128 + (B) * 8 + k]; dst[k] = *(const u32x4g*)(Uj + (size_t)idx * 128); } } while (0)
#define U8_CM(src, B) do { float keep_ = 0.f; _Pragma("unroll") for (int k = 0; k < 8; ++k) { float sm = dot16_fp8(x, src[k]); sm += shx<1>(sm); sm += shx<2>(sm); sm += shx<4>(sm); keep_ = (k == c) ? sm : keep_; } res[B] = keep_; } while (0)
        U8_LD(pa_, 0);
#pragma unroll
        for (int b = 0; b < 16; b += 2) {
            U8_LD(pb_, b + 1); U8_CM(pa_, b);
            if (b + 2 < 16) U8_LD(pa_, b + 2);
            U8_CM(pb_, b + 1);
        }
#undef U8_LD
#undef U8_CM
        float* pa = PA + (t * 8 + j) * 128 + c;
#pragma unroll
        for (int b = 0; b < 16; ++b) pa[8 * b] = res[b];
    }
}
__device__ __forceinline__ void ph_gather_w(const float* gw, const float* PA, float* W, const float* ss16) {
    for (size_t e4 = (size_t)bidx() * NT + tidx(); e4 < (size_t)T * 32; e4 += (size_t)gridDim.x * NT) {
        const size_t t = e4 >> 5, e = (e4 & 31) * 4;
        f32x4 a = (f32x4){0.f, 0.f, 0.f, 0.f};
#pragma unroll
        for (int q = 0; q < 8; ++q) a += *(const f32x4*)(PA + (t * 8 + q) * 128 + e);
        const f32x4 g = *(const f32x4*)(gw + t * 128 + e); const float rs = pg8::rstd16(ss16, (int)t) * (1.0f / U_SCALE);
        f32x4 w;
#pragma unroll
        for (int k = 0; k < 4; ++k) w[k] = g[k] * gelu_tanh(a[k] * rs) * (1.0f / V_SCALE);
        *(f32x4*)(W + t * 128 + e) = w;
    }
}
__device__ __forceinline__ void ph_gather_v8(const int* eidx, const float* gw, const float* PA, const unsigned char* Vs, float* h, int j, int r, int nper, unsigned char* smem, bf16* XB, float* ss8) {
    const int tid = tidx(), lane = tid & 63, wave = tid >> 6, u = lane >> 3, c = lane & 7;
    LAS float* wl = (LAS float*)((LAS unsigned char*)smem + wave * 8192);
    LAS int* il = (LAS int*)((LAS unsigned char*)smem + wave * 8192 + 4096);
    const unsigned char* Vj = Vs + (size_t)j * NEXP * 128 + 16 * c;
    const int g0 = r * (NT / 64) + wave, gs = nper * (NT / 64); if (gs <= 0) return;
#pragma unroll 1
    for (int g = g0; g < T / 8; g += gs) {
        const size_t t = (size_t)g * 8 + u;
        {
#pragma unroll
            for (int i = 0; i < 4; ++i) { const f32x4 wv = *(const f32x4*)(PA + t * 128 + 16 * c + 4 * i); const u32x4g ee = *(const u32x4g*)(eidx + t * 128 + 16 * c + 4 * i);
                *(LAS f32x4*)(wl + u * 128 + 16 * c + 4 * i) = wv; *(LAS u32x4g*)(il + u * 128 + 16 * c + 4 * i) = ee; } }
        f32x2g acc2[8];
#pragma unroll
        for (int i = 0; i < 8; ++i) acc2[i] = (f32x2g){0.f, 0.f};
        u32x4g pa_[16], pb_[16];
#define V8_LD(dst, B) do { _Pragma("unroll") for (int k = 0; k < 16; ++k) { const int idx = il[u * 128 + (B) * 16 + k]; dst[k] = *(const u32x4g*)(Vj + (size_t)idx * 128); } } while (0)
#define V8_CM(src, B) do { _Pragma("unroll") for (int k = 0; k < 16; ++k) { const float w = wl[u * 128 + (B) * 16 + k]; const f32x2g w2 = {w, w}; const u32x4g v0 = src[k]; \
        _Pragma("unroll") for (int d = 0; d < 4; ++d) { const int vd = (int)v0[d]; const f32x2g lo = __builtin_amdgcn_cvt_pk_f32_fp8(vd, false), hi = __builtin_amdgcn_cvt_pk_f32_fp8(vd, true); \
            acc2[2 * d] = lo * w2 + acc2[2 * d]; acc2[2 * d + 1] = hi * w2 + acc2[2 * d + 1]; } } } while (0)
        V8_LD(pa_, 0);
#pragma unroll 1
        for (int b = 0; b < 8; b += 2) {
            V8_LD(pb_, b + 1); V8_CM(pa_, b);
            if (b + 2 < 8) V8_LD(pa_, b + 2);
            V8_CM(pb_, b + 1);
        }
#undef V8_LD
#undef V8_CM
        float* hp = h + t * DM + 128 * j + 16 * c; float sq = 0.f; u32x4g xo0, xo1;
#pragma unroll
        for (int i = 0; i < 4; ++i) { f32x4 hv = *(f32x4*)(hp + 4 * i); hv += (f32x4){acc2[2 * i][0], acc2[2 * i][1], acc2[2 * i + 1][0], acc2[2 * i + 1][1]}; *(f32x4*)(hp + 4 * i) = hv;
            sq += (hv[0] * hv[0] + hv[1] * hv[1]) + (hv[2] * hv[2] + hv[3] * hv[3]);
            if (i < 2) { xo0[2 * i] = pk2(hv[0], hv[1]); xo0[2 * i + 1] = pk2(hv[2], hv[3]); } else { xo1[2 * (i - 2)] = pk2(hv[0], hv[1]); xo1[2 * (i - 2) + 1] = pk2(hv[2], hv[3]); } }
        *(u32x4g*)(XB + t * DM + 128 * j + 16 * c) = xo0; *(u32x4g*)(XB + t * DM + 128 * j + 16 * c + 8) = xo1;
        sq += shx<1>(sq); sq += shx<2>(sq); sq += shx<4>(sq);
        if (c == 0) ss8[t * 8 + j] = sq;
    }
}

__device__ __forceinline__ void prep_piece(bf16* p, bool active, bool donorm, const float (&gain)[8], const float (&cs)[8], const float (&sn)[8], float scale, int lane) {
    u32x4g raw = (u32x4g){0u, 0u, 0u, 0u};
    if (active) raw = *(const u32x4g*)p;
    float f[8];
#pragma unroll
    for (int d = 0; d < 4; ++d) { const unsigned w = raw[d]; f[2 * d] = bflo(w); f[2 * d + 1] = bfhi(w); }
    if (donorm) {
        float ss = 0.f;
#pragma unroll
        for (int i = 0; i < 8; ++i) ss += f[i] * f[i];
        ss += shx<1>(ss); ss += shx<2>(ss); ss += shx<4>(ss);
        const float rstd = 1.0f / sqrtf(ss * (1.0f / 64.f) + NORM_EPS);
#pragma unroll
        for (int i = 0; i < 8; ++i) f[i] = f[i] * rstd * gain[i];
    }
    const int sub = lane & 7;
#pragma unroll
    for (int i = 0; i < 8; ++i) { const float pr = shx<1>(f[i]);
        const float r0 = f[i] * cs[i] - pr * sn[i], r1 = f[i] * cs[i] + pr * sn[i];
        f[i] = (sub == 0) ? r0 : ((sub == 1) ? r1 : f[i]); }
    u32x4g o;
#pragma unroll
    for (int d = 0; d < 4; ++d) o[d] = pk2(f[2 * d] * scale, f[2 * d + 1] * scale);
    if (active) *(u32x4g*)p = o;
}
#define ROPE_ROW(pos) float cs[8], sn[8]; { float c_ = 1.f, s_ = 0.f; if (lane < 8) rope_cs(pos, lane, c_, s_); \
    _Pragma("unroll") for (int i = 0; i < 8; ++i) { cs[i] = __builtin_bit_cast(float, __builtin_amdgcn_readlane(__builtin_bit_cast(int, c_), i)); sn[i] = __builtin_bit_cast(float, __builtin_amdgcn_readlane(__builtin_bit_cast(int, s_), i)); } }
#define LOAD_GAIN(dst, src) float dst[8]; { _Pragma("unroll") for (int i = 0; i < 8; ++i) dst[i] = (src)[8 * (lane & 7) + i]; }
__device__ __forceinline__ void ph_prep0_opt(bf16* qkv, const int* positions, const float* aq, const float* ak, const float* bq, const float* bk) {
    const int lane = tidx() & 63, wave = tidx() >> 6;
    const int gw = bidx() * (NT / 64) + wave, ngw = gridDim.x * (NT / 64);
    LOAD_GAIN(gaq, aq); LOAD_GAIN(gak, ak); LOAD_GAIN(gbq, bq); LOAD_GAIN(gbk, bk);
#pragma unroll 1
    for (int r = gw; r < T; r += ngw) {
        const int pos = positions[r]; bf16* row = qkv + (size_t)r * AB_LD + 8 * lane;
        ROPE_ROW(pos);
        prep_piece(row + CQA, true, true, gaq, cs, sn, C2, lane);
        prep_piece(row + CKA, true, true, gak, cs, sn, 1.f, lane);
        prep_piece(row + CQB, true, true, gbq, cs, sn, C2, lane);
        prep_piece(row + CKB, true, true, gbk, cs, sn, 1.f, lane);
        prep_piece(row + CQI, lane < 40, false, gaq, cs, sn, 1.f, lane);
    }
}
__device__ __forceinline__ void ph_prep1_opt(bf16* qkv, const int* positions, const float* cq, const float* ck) {
    const int lane = tidx() & 63, wave = tidx() >> 6;
    const int gw = bidx() * (NT / 64) + wave, ngw = gridDim.x * (NT / 64);
    LOAD_GAIN(gq, cq); LOAD_GAIN(gk, ck);
#pragma unroll 1
    for (int r = gw; r < T; r += ngw) {
        const int pos = positions[r]; bf16* row = qkv + (size_t)r * C_LD + 8 * lane;
        ROPE_ROW(pos);
        prep_piece(row, true, true, gq, cs, sn, C2, lane);
        prep_piece(row + 512, true, true, gq, cs, sn, C2, lane);
        prep_piece(row + 1024, true, true, gk, cs, sn, 1.f, lane);
        prep_piece(row + 1536, true, true, gk, cs, sn, 1.f, lane);
    }
}
__device__ __forceinline__ void ph_kmean_opt(const bf16* qkv, float* kmean) {
    const int lane = tidx() & 63, wave = tidx() >> 6;
    const int gw = bidx() * (NT / 64) + wave, ngw = gridDim.x * (NT / 64);
#pragma unroll 1
    for (int it = gw; it < BATCH * 8 * 32; it += ngw) {
        const int b = it / 256, h = (it / 32) % 8, n = it % 32;
        const bf16* base = qkv + (size_t)(b * SEQ + n * 256) * AB_LD + CKA + h * 64 + lane;
        float s = 0.f;
#pragma unroll 1
        for (int r = 0; r < 256; r += 16) { float v[16];
#pragma unroll
            for (int i = 0; i < 16; ++i) v[i] = bf2f(base[(size_t)(r + i) * AB_LD]);
#pragma unroll
            for (int i = 0; i < 16; ++i) s += v[i]; }
        kmean[(size_t)it * 64 + lane] = s * (1.0f / 256.f);
    }
}
__device__ __forceinline__ void ph_dil_merge_opt(const bf16* OG, const float* LSE, bf16* O) {
    const int lane = tidx() & 63, wave = tidx() >> 6;
    const int gw = bidx() * (NT / 64) + wave, ngw = gridDim.x * (NT / 64);
#pragma unroll 1
    for (int t = gw; t < T; t += ngw) {
        const int h = lane >> 2;
        const float l0 = LSE[((size_t)0 * T + t) * 16 + h], l1 = LSE[((size_t)1 * T + t) * 16 + h], l2 = LSE[((size_t)2 * T + t) * 16 + h];
        const float m = fmaxf(l0, fmaxf(l1, l2)); float w0 = exp2f(l0 - m), w1 = exp2f(l1 - m), w2 = exp2f(l2 - m);
        const float inv = 1.0f / (w0 + w1 + w2); w0 *= inv; w1 *= inv; w2 *= inv;
        const size_t off = (size_t)t * DM + 16 * lane;
#pragma unroll
        for (int half = 0; half < 2; ++half) {
            const u32x4g a = *(const u32x4g*)(OG + off + 8 * half), b = *(const u32x4g*)(OG + (size_t)T * DM + off + 8 * half), c = *(const u32x4g*)(OG + (size_t)2 * T * DM + off + 8 * half);
            u32x4g o;
#pragma unroll
            for (int d = 0; d < 4; ++d) { const unsigned ad = a[d], bd = b[d], cd = c[d];
                o[d] = pk2(w0 * bflo(ad) + w1 * bflo(bd) + w2 * bflo(cd), w0 * bfhi(ad) + w1 * bfhi(bd) + w2 * bfhi(cd)); }
            *(u32x4g*)(O + off + 8 * half) = o;
        }
    }
}


__device__ __forceinline__ void ph_moba_select_opt(const bf16* qkv, const float* kmean, unsigned* sel) {
    using attn_g::bf16x8; using attn_g::f32x16;
    const int tid = tidx(), lane = tid & 63, r32 = lane & 31, hi = lane >> 5, wave = tid >> 6;
#pragma unroll 1
    for (int unit = bidx(); unit < 512; unit += (int)gridDim.x) {
        const int bh = unit >> 5, qb = unit & 31, b = bh >> 3, h = bh & 7;
        const size_t trow = (size_t)b * SEQ + 256 * qb + 32 * wave + r32;
        const float* km = kmean + ((size_t)bh * 32 + r32) * 64;
        f32x16 g = {};
#pragma unroll
        for (int d0 = 0; d0 < 4; ++d0) {
            const f32x4 k0 = *(const f32x4*)(km + d0 * 16 + 8 * hi), k1 = *(const f32x4*)(km + d0 * 16 + 8 * hi + 4);
            u32x4g ap; ap[0] = pk2(k0[0], k0[1]); ap[1] = pk2(k0[2], k0[3]); ap[2] = pk2(k1[0], k1[1]); ap[3] = pk2(k1[2], k1[3]);
            const bf16x8 bq = *(const bf16x8*)(qkv + trow * AB_LD + CQA + h * 64 + d0 * 16 + 8 * hi);
            g = __builtin_amdgcn_mfma_f32_32x32x16_bf16(__builtin_bit_cast(bf16x8, ap), bq, g, 0, 0, 0);
        }
        float v0 = -3e38f, v1 = -3e38f, v2 = -3e38f; int i0 = 255, i1 = 255, i2 = 255;
#pragma unroll
        for (int r = 0; r < 16; ++r) { const int n = (r & 3) + 8 * (r >> 2) + 4 * hi; const float gv = g[r];
            if (n < qb) { if (gv > v0) { v2 = v1; i2 = i1; v1 = v0; i1 = i0; v0 = gv; i0 = n; } else if (gv > v1) { v2 = v1; i2 = i1; v1 = gv; i1 = n; } else if (gv > v2) { v2 = gv; i2 = n; } } }
        const float pv[3] = {shx<32>(v0), shx<32>(v1), shx<32>(v2)}; const int pi[3] = {shx<32>(i0), shx<32>(i1), shx<32>(i2)};
#pragma unroll
        for (int c = 0; c < 3; ++c) { const float gv = pv[c]; const int n = pi[c];
            if (n != 255) { if (gv > v0 || (gv == v0 && n < i0)) { v2 = v1; i2 = i1; v1 = v0; i1 = i0; v0 = gv; i0 = n; } else if (gv > v1 || (gv == v1 && n < i1)) { v2 = v1; i2 = i1; v1 = gv; i1 = n; } else if (gv > v2 || (gv == v2 && n < i2)) { v2 = gv; i2 = n; } } }
        if (hi == 0) sel[trow * 8 + h] = (unsigned)i0 | ((unsigned)i1 << 8) | ((unsigned)i2 << 16) | (255u << 24);
    }
}

namespace cg = cooperative_groups;
constexpr int LDS_BYTES = 147456;
#define GEMM_PHASE(EPI, Aptr, Bptr, Nn, Kk, ...) do { pg8::Gemm g_{(const pg8::bf16_t*)(Aptr), (const pg8::bf16_t*)(Bptr), T, (Nn), (Kk)}; pg8::StaticOrder S_; S_.init(T, (Nn), (int)gridDim.x, (int)bidx()); \
    pg8::EPI E_{__VA_ARGS__}; pg8::gemm_phase<pg8::EPI, pg8::StaticOrder, true, true>((PG8_LAS unsigned char*)smem, g_, S_, E_); } while (0)
__global__ void __launch_bounds__(NT, 2) k_mega(Params P) {
    extern __shared__ __attribute__((aligned(16))) unsigned char smem[];
    cg::grid_group grid = cg::this_grid();
    { const unsigned t0_ = (unsigned)__builtin_amdgcn_workitem_id_x(); if ((t0_ & 63u) == 0u) TID_TAB[hw_slot()] = t0_ >> 6; }
    __syncthreads();
#define BST ((volatile LAS unsigned*)((LAS unsigned char*)smem + 131072 + 64))
#define SLICE_J (__builtin_amdgcn_readfirstlane((int)BST[2]))
#define SLICE_R (__builtin_amdgcn_readfirstlane((int)BST[3]))
#define SLICE_N (__builtin_amdgcn_readfirstlane((int)BST[5]))
    if (tidx() < 2) BST[tidx()] = 0u;
    __syncthreads();
    (void)xcd_barrier_post((unsigned*)(WSP + WS_CTL) + 4096, BST);
#define BAR0() do { XcdBarrier b_; b_.bar = (unsigned*)(WSP + WS_CTL) + 4096; b_.x = xb_xcc_id(); b_.st = BST; xcd_barrier(b_); } while (0)
    #define BAR() do { BAR0(); STAMP(); } while (0)
#define TSW ((volatile LAS unsigned long long*)((LAS unsigned char*)smem + 131072 + 128))
    int nts = 0;
#define STAMP() do { if (PROBE_A >= 0) { if (bidx() == 0 && tidx() == 0) TSW[nts] = __builtin_amdgcn_s_memrealtime(); ++nts; } } while (0)
    STAMP();
    ph_prologue(smem);
    if (tidx() == 0) {
        const unsigned x = xb_xcc_id() & 7u; BST[2] = x; BST[3] = xb_add((unsigned*)(WSP + WS_CTL) + 8192 + 64 * x, 1u); }
    ph_rmsnorm(IN(0), IN(3), (bf16*)(WSP + WS_XN)); grid.sync(); STAMP();
    if (tidx() == 0) {
        bool reg = (gridDim.x % 8u) == 0u;
        for (unsigned q = 0; q < 8u; ++q) reg = reg && (xb_ld((unsigned*)(WSP + WS_CTL) + 8192 + 64 * q) == gridDim.x / 8u);
        if (!reg) { BST[2] = (unsigned)bidx() % 8u; BST[3] = (unsigned)bidx() / 8u; }
        BST[5] = (gridDim.x % 8u == 0u) ? gridDim.x / 8u : 0u; }
    __syncthreads();
    { unsigned char* ws = WSP; GEMM_PHASE(EBf16, ws + WS_XN, ws + WS_WAB_IN, AB_LD, DM, (bf16*)(ws + WS_QKV), AB_LD); } BAR();
    ph_prep0_opt((bf16*)(WSP + WS_QKV), (const int*)IN(2), IN(8), IN(9), IN(10), IN(11)); BAR();
    { unsigned char* ws = WSP; ph_kmean_opt((bf16*)(ws + WS_QKV), (float*)(ws + WS_KMEAN)); } BAR();
    { unsigned char* ws = WSP; ph_moba_select_opt((bf16*)(ws + WS_QKV), (float*)(ws + WS_KMEAN), (unsigned*)(ws + WS_SEL)); }
    { unsigned char* ws = WSP; ph_dsa_score((bf16*)(ws + WS_QKV), (float*)(ws + WS_SCORES), smem); } BAR();
    { unsigned char* ws = WSP; ph_attn_moba((bf16*)(ws + WS_QKV), (unsigned*)(ws + WS_SEL), (bf16*)(ws + WS_XN), smem); }
    __syncthreads();
    { unsigned char* ws = WSP; ph_dsa_select_opt((float*)(ws + WS_SCORES), (unsigned long long*)(ws + WS_MASK), smem); } BAR();
    { unsigned char* ws = WSP; ph_attn_dsa((bf16*)(ws + WS_QKV), (unsigned long long*)(ws + WS_MASK), (bf16*)(ws + WS_XN), smem); } BAR();
    { unsigned char* ws = WSP; GEMM_PHASE(EResAddN, ws + WS_XN, ws + WS_WAB_OUT, DM, DM, IN(0), OUTP, (pg8::bf16_t*)(ws + WS_XN2), (float*)(ws + WS_SS16)); }
    {
        unsigned char* ws = WSP;
#pragma unroll 1
        for (int L = 0; L < 2; ++L) {
            cvt_fp8<true>(IN(18) + (size_t)L * NEXP * DM, ws + WS_EXP + (size_t)(2 * L) * 16 * MiB, (size_t)NEXP * DM, U_SCALE);
            cvt_fp8<true>(IN(19) + (size_t)L * NEXP * DM, ws + WS_EXP + (size_t)(2 * L + 1) * 16 * MiB, (size_t)NEXP * DM, V_SCALE);
        }
    } BAR();
#pragma unroll 1
    for (int L = 0; L < 2; ++L) {
        if (L == 1) {
            { unsigned char* ws = WSP; GEMM_PHASE(EBf16S, ws + WS_XN2, ws + WS_WC_IN, C_LD, DM, (pg8::bf16_t*)(ws + WS_QKV1), C_LD, (const float*)(ws + WS_SS16)); } BAR();
            ph_prep1_opt((bf16*)(WSP + WS_QKV1), (const int*)IN(2), IN(14), IN(15)); BAR();
            { unsigned char* ws = WSP; ph_attn_dilated((bf16*)(ws + WS_QKV1), (bf16*)(ws + WS_OG), (float*)(ws + WS_LSE), smem); } BAR();
            { unsigned char* ws = WSP; ph_dil_merge_opt((bf16*)(ws + WS_OG), (float*)(ws + WS_LSE), (bf16*)(ws + WS_XN)); } BAR();
            { unsigned char* ws = WSP; float* hb = OUTP; GEMM_PHASE(EResAddN, ws + WS_XN, ws + WS_WC_OUT, DM, DM, hb, hb, (pg8::bf16_t*)(ws + WS_XN2), (float*)(ws + WS_SS16)); } BAR();
        }
        { unsigned char* ws = WSP; GEMM_PHASE(EBf16S, ws + WS_XN2, ws + WS_WQ + (size_t)L * 4 * MiB, 2048, DM, (pg8::bf16_t*)(ws + WS_QRY), 2048, (const float*)(ws + WS_SS16)); } BAR();
        { unsigned char* ws = WSP; ph_peer_route_opt((bf16*)(ws + WS_QRY), (bf16*)(ws + WS_SUBK) + (size_t)L * 16 * 128 * 128, (int*)(ws + WS_EIDX), (float*)(ws + WS_GW), smem); } BAR();
        { unsigned char* ws = WSP; ph_gather_u8((bf16*)(ws + WS_XN2), (int*)(ws + WS_EIDX), ws + WS_EXP + (size_t)(2 * L) * 16 * MiB, (float*)(ws + WS_PA), SLICE_J, SLICE_R, SLICE_N, IN(4) + L * DM, smem); } BAR();
        { unsigned char* ws = WSP; ph_gather_w((float*)(ws + WS_GW), (float*)(ws + WS_PA), (float*)(ws + WS_GW), (const float*)(ws + WS_SS16)); }
        { unsigned char* ws = WSP; GEMM_PHASE(EBf16, ws + WS_P + (size_t)L * T * 256 * 2, ws + WS_WUP + (size_t)L * (MiB / 2), DM, 256, (bf16*)(ws + WS_UP), DM); } BAR();
        { unsigned char* ws = WSP; ph_gather_v8((int*)(ws + WS_EIDX), (float*)(ws + WS_GW), (float*)(ws + WS_GW), ws + WS_EXP + (size_t)(2 * L + 1) * 16 * MiB, OUTP, SLICE_J, SLICE_R, SLICE_N, smem, (bf16*)(ws + WS_XN), (float*)(ws + WS_SS8)); } BAR();
        if (L == 0) { unsigned char* ws = WSP; GEMM_PHASE(EGateN<false>, ws + WS_XN, ws + WS_WG, DM, DM, OUTP, (pg8::bf16_t*)(ws + WS_UP), (const float*)(ws + WS_SS8), (pg8::bf16_t*)(ws + WS_XN2), (float*)(ws + WS_SS16)); BAR(); }
        else { unsigned char* ws = WSP; GEMM_PHASE(EGateN<true>, ws + WS_XN, ws + WS_WG + 2 * MiB, DM, DM, OUTP, (pg8::bf16_t*)(ws + WS_UP), (const float*)(ws + WS_SS8), (pg8::bf16_t*)(ws + WS_XN2), (float*)(ws + WS_SS16)); STAMP(); }
    }
    if (PROBE_A >= 0 && bidx() == 0 && tidx() == 0) {
        const unsigned long long target = (unsigned long long)PROBE_K * (TSW[PROBE_B] - TSW[PROBE_A]), t0 = __builtin_amdgcn_s_memrealtime();
        while (__builtin_amdgcn_s_memrealtime() - t0 < target) __builtin_amdgcn_s_sleep(32);
    }
}

extern "C" void kernel_launch(void* const* d_in, const int* in_sizes, int n_in, void* d_out, int out_size, void* d_ws, size_t ws_size, hipStream_t stream) {
    static int grid_blocks = 0;
    if (grid_blocks == 0) {
        if (n_in != 22 || out_size != T * DM || ws_size < WS_END) { fprintf(stderr, "kernel_launch: unexpected shapes: n_in %d out %d ws %zu\n", n_in, out_size, ws_size); grid_blocks = -1; return; }
        if (hipFuncSetAttribute((const void*)k_mega, hipFuncAttributeMaxDynamicSharedMemorySize, LDS_BYTES) != hipSuccess) { fprintf(stderr, "hipFuncSetAttribute failed\n"); grid_blocks = -1; return; }
        int dev = 0, cus = 0, per_cu = 0;
        hipGetDevice(&dev);
        hipDeviceGetAttribute(&cus, hipDeviceAttributeMultiprocessorCount, dev);
        hipOccupancyMaxActiveBlocksPerMultiprocessor(&per_cu, (const void*)k_mega, NT, LDS_BYTES);
        if (per_cu < 1 || cus < 1) { fprintf(stderr, "kernel_launch: occupancy query says %d blocks/CU on %d CUs\n", per_cu, cus); grid_blocks = -1; return; }
        grid_blocks = cus;
    }
    if (grid_blocks < 0) return;
    Params P{};
    for (int i = 0; i < 22; ++i) P.in[i] = (const float*)d_in[i];
    P.out = (float*)d_out; P.ws = (unsigned char*)d_ws;
    if (hipMemsetAsync((char*)d_ws + WS_CTL, 0, 1 * MiB, stream) != hipSuccess) { fprintf(stderr, "kernel_launch: hipMemsetAsync failed\n"); return; }
    void* args[] = {&P};
    hipError_t e = hipLaunchCooperativeKernel((const void*)k_mega, dim3(grid_blocks), dim3(NT), args, LDS_BYTES, stream);
    if (e != hipSuccess) fprintf(stderr, "cooperative launch failed: %s (grid %d)\n", hipGetErrorString(e), grid_blocks);
}
```

```cpp
#include <hip/hip_runtime.h>
#include <hip/hip_cooperative_groups.h>
#include <cstdio>
#include <cstdint>

constexpr int BATCH = 2, SEQ = 8192, T = BATCH * SEQ, DM = 1024;
constexpr int AB_N = 3396, AB_LD = 3584;
constexpr int CQA = 0, CKA = 512, CVA = 1024, CQB = 1536, CKB = 2048, CVB = 2560, CQI = 3072, CKI = 3328, CWI = 3392;
constexpr int C_LD = 3072;
constexpr int NEXP = 16384;
constexpr float NORM_EPS = 1e-6f;
constexpr float C2 = 0.125f * 1.4426950408889634f;
constexpr int NT = 512;
constexpr int PROBE_A = -1, PROBE_B = 0, PROBE_K = 4;

constexpr size_t MiB = 1u << 20;
constexpr size_t WS_CTL = 0;
constexpr size_t WS_WAB_IN = 1 * MiB, WS_WAB_OUT = 8 * MiB, WS_WC_IN = 10 * MiB, WS_WC_OUT = 16 * MiB;
constexpr size_t WS_WQ = 18 * MiB, WS_WG = 26 * MiB, WS_WUP = 30 * MiB, WS_SUBK = 31 * MiB;
constexpr size_t WS_KMEAN = 32 * MiB;
constexpr size_t WS_SEL = 33 * MiB;
constexpr size_t WS_LSE = 34 * MiB;
constexpr size_t WS_EIDX = 37 * MiB;
constexpr size_t WS_GW = 45 * MiB;
constexpr size_t WS_P = 53 * MiB;
constexpr size_t WS_XN = 69 * MiB;
constexpr size_t WS_QKV = 101 * MiB;
constexpr size_t WS_MASK = 213 * MiB;
constexpr size_t WS_SCORES = 229 * MiB;
constexpr size_t WS_EXP = 229 * MiB;
constexpr size_t WS_QRY = 101 * MiB;
constexpr size_t WS_PA = 101 * MiB;
constexpr size_t WS_UP = 165 * MiB;
constexpr size_t WS_QKV1 = 357 * MiB;
constexpr size_t WS_OG = 101 * MiB;
constexpr size_t WS_XN2 = 453 * MiB;
constexpr size_t WS_SS16 = 505 * MiB;
constexpr size_t WS_SS8 = 506 * MiB;
constexpr size_t WS_END = 512 * MiB;

typedef unsigned short bf16;
typedef float f32x4 __attribute__((ext_vector_type(4)));

__device__ __forceinline__ unsigned f2bf(float f) { unsigned u = __builtin_bit_cast(unsigned, f); return (u + 0x7fffu + ((u >> 16) & 1u)) >> 16; }
__device__ __forceinline__ float bf2f(bf16 h) { return __builtin_bit_cast(float, (unsigned)h << 16); }
template <int M> __device__ __forceinline__ int shx_bits(int v) {
    if constexpr (M < 32) return __builtin_amdgcn_ds_swizzle(v, (M << 10) | 0x1f);
    else { const auto rr = __builtin_amdgcn_permlane32_swap((unsigned)v, (unsigned)v, false, false); return (int)((rr[0] == (unsigned)v) ? rr[1] : rr[0]); }
}
template <int M> __device__ __forceinline__ float shx(float v) { return __builtin_bit_cast(float, shx_bits<M>(__builtin_bit_cast(int, v))); }
template <int M> __device__ __forceinline__ int shx(int v) { return shx_bits<M>(v); }
template <int M> __device__ __forceinline__ unsigned shx(unsigned v) { return (unsigned)shx_bits<M>((int)v); }
__device__ __forceinline__ int bperm(int srclane, int v) { return __builtin_amdgcn_ds_bpermute(srclane << 2, v); }
__device__ __forceinline__ float bperm(int srclane, float v) { return __builtin_bit_cast(float, __builtin_amdgcn_ds_bpermute(srclane << 2, __builtin_bit_cast(int, v))); }
__device__ __forceinline__ float wave_sum(float v) {
    v += shx<1>(v); v += shx<2>(v); v += shx<4>(v); v += shx<8>(v); v += shx<16>(v); v += shx<32>(v);
    return v;
}
__device__ __forceinline__ float wave_max(float v) {
    v = fmaxf(v, shx<1>(v)); v = fmaxf(v, shx<2>(v)); v = fmaxf(v, shx<4>(v)); v = fmaxf(v, shx<8>(v)); v = fmaxf(v, shx<16>(v)); v = fmaxf(v, shx<32>(v));
    return v;
}
__device__ __forceinline__ unsigned okey(float f) { unsigned u = __builtin_bit_cast(unsigned, f); return (u & 0x80000000u) ? ~u : (u | 0x80000000u); }

#define TID_TAB ((volatile __attribute__((address_space(3))) unsigned*)(131072 + 512))
__device__ __forceinline__ unsigned hw_slot() { return (unsigned)__builtin_amdgcn_s_getreg(((6 - 1) << 11) | 4); }
__device__ __forceinline__ int tidx() { const unsigned w = TID_TAB[hw_slot()]; int l; asm volatile("v_mbcnt_lo_u32_b32 %0, -1, 0\n\tv_mbcnt_hi_u32_b32 %0, -1, %0" : "=v"(l)); int t = (int)(w << 6) | l; asm volatile("" : "+v"(t)); return t; }
__device__ __forceinline__ int bidx() { int b = __builtin_amdgcn_workgroup_id_x(); asm volatile("" : "+s"(b)); return b; }
struct Params {
    const float* in[22];
    float* out;
    unsigned char* ws;
    int layer;
    int pad;
};

typedef const __attribute__((address_space(4))) unsigned long long* karg_t;
__device__ __forceinline__ unsigned long long karg(int idx) { karg_t ka = (karg_t)__builtin_amdgcn_kernarg_segment_ptr(); asm volatile("" : "+s"(ka)); return ka[idx]; }
#define GASP __attribute__((address_space(1)))
#define IN(i) ((const float*)(const GASP float*)karg(i))
#define OUTP ((float*)(GASP float*)karg(22))
#define WSP ((unsigned char*)(GASP unsigned char*)karg(23))

__device__ __forceinline__ void ph_rmsnorm(const float* src, const float* gain, bf16* dst) {
    const int lane = tidx() & 63, wave = tidx() >> 6;
    const int gw = bidx() * (NT / 64) + wave, ngw = gridDim.x * (NT / 64);
    for (int r = gw; r < T; r += ngw) {
        const f32x4* xr = (const f32x4*)(src + (size_t)r * DM) + lane;
        f32x4 v[4]; float s = 0.f;
#pragma unroll
        for (int j = 0; j < 4; ++j) { v[j] = xr[64 * j]; s += v[j].x * v[j].x + v[j].y * v[j].y + v[j].z * v[j].z + v[j].w * v[j].w; }
        const float rstd = 1.0f / sqrtf(wave_sum(s) * (1.0f / DM) + NORM_EPS);
#pragma unroll
        for (int j = 0; j < 4; ++j) {
            const f32x4 g = ((const f32x4*)gain)[lane + 64 * j];
            unsigned long long o = (unsigned long long)(f2bf(v[j].x * rstd * g.x) | (f2bf(v[j].y * rstd * g.y) << 16)) |
                                   ((unsigned long long)(f2bf(v[j].z * rstd * g.z) | (f2bf(v[j].w * rstd * g.w) << 16)) << 32);
            ((unsigned long long*)(dst + (size_t)r * DM))[lane + 64 * j] = o;
        }
    }
}

template <class AT> __device__ __forceinline__ float ldA(const AT* p);
template <> __device__ __forceinline__ float ldA<bf16>(const bf16* p) { return bf2f(*p); }
template <> __device__ __forceinline__ float ldA<float>(const float* p) { return *p; }

template <class AT, class Epi> __forceinline__
__device__ __forceinline__ void ph_gemm_naive(const AT* A, int lda, const float* B, int N, int K, const Epi& E, unsigned char* smem) {
    float* As = (float*)smem;
    float* Bs = As + 16 * 132;
    const int tid = tidx(), ty = tid >> 5, tx = tid & 31;
    const int ntn = (N + 127) / 128, ntm = T / 128, ntile = ntn * ntm;
    for (int tile = bidx(); tile < ntile; tile += gridDim.x) {
        const int tm = tile / ntn, tn = tile % ntn, m0 = tm * 128, n0 = tn * 128;
        float acc[8][4];
#pragma unroll
        for (int i = 0; i < 8; ++i)
#pragma unroll
            for (int j = 0; j < 4; ++j) acc[i][j] = 0.f;
        for (int k0 = 0; k0 < K; k0 += 16) {
            __syncthreads();
#pragma unroll
            for (int i = 0; i < 4; ++i) { const int e = tid + i * NT, r = e >> 4, kk = e & 15; As[kk * 132 + r] = ldA<AT>(A + (size_t)(m0 + r) * lda + k0 + kk); }
#pragma unroll
            for (int i = 0; i < 4; ++i) { const int e = tid + i * NT, kk = e >> 7, c = e & 127; Bs[kk * 128 + c] = (n0 + c < N) ? B[(size_t)(k0 + kk) * N + n0 + c] : 0.f; }
            __syncthreads();
#pragma unroll 2
            for (int kk = 0; kk < 16; ++kk) {
                float a[8], b[4];
#pragma unroll
                for (int i = 0; i < 8; ++i) a[i] = As[kk * 132 + ty * 8 + i];
#pragma unroll
                for (int j = 0; j < 4; ++j) b[j] = Bs[kk * 128 + tx * 4 + j];
#pragma unroll
                for (int i = 0; i < 8; ++i)
#pragma unroll
                    for (int j = 0; j < 4; ++j) acc[i][j] += a[i] * b[j];
            }
        }
#pragma unroll
        for (int i = 0; i < 8; ++i) {
            const int col = n0 + tx * 4;
            if (col < N) E.store4(m0 + ty * 8 + i, col, (f32x4){acc[i][0], acc[i][1], acc[i][2], acc[i][3]});
        }
    }
}
struct EpBf16 { bf16* O; int ldc;
    __device__ __forceinline__ void store4(int r, int c, f32x4 v) const {
        unsigned long long o = (unsigned long long)(f2bf(v.x) | (f2bf(v.y) << 16)) | ((unsigned long long)(f2bf(v.z) | (f2bf(v.w) << 16)) << 32);
        *(unsigned long long*)(O + (size_t)r * ldc + c) = o; } };
struct EpResAdd { const float* base; float* out;
    __device__ __forceinline__ void store4(int r, int c, f32x4 v) const {
        const f32x4 b = *(const f32x4*)(base + (size_t)r * DM + c); *(f32x4*)(out + (size_t)r * DM + c) = b + v; } };
struct EpGate { float* h; const bf16* up;
    __device__ __forceinline__ void store4(int r, int c, f32x4 v) const {
        f32x4 hv = *(const f32x4*)(h + (size_t)r * DM + c); const bf16* u = up + (size_t)r * DM + c;
        hv.x += bf2f(u[0]) / (1.f + __expf(-v.x)); hv.y += bf2f(u[1]) / (1.f + __expf(-v.y));
        hv.z += bf2f(u[2]) / (1.f + __expf(-v.z)); hv.w += bf2f(u[3]) / (1.f + __expf(-v.w));
        *(f32x4*)(h + (size_t)r * DM + c) = hv; } };

__device__ __forceinline__ void rope_cs(int pos, int i, float& c, float& s) {
    const float inv = exp2f(-(float)i * 0.125f * 18.931568569324174f);
    const float ang = (float)pos * inv;
    const float k = rintf(ang * 0.15915494309189535f);
    float r = fmaf(-k, 6.28125f, ang); r = fmaf(-k, 1.9353071795864769e-3f, r);
    c = cosf(r); s = sinf(r);
}
__device__ __forceinline__ void prep_head(bf16* p, const float* gain, int pos, float scale, bool donorm, int lane) {
    float v = bf2f(p[lane]);
    if (donorm) { const float ss = wave_sum(v * v); v = v * (1.0f / sqrtf(ss * (1.0f / 64.f) + NORM_EPS)) * gain[lane]; }
    const float partner = __shfl_xor(v, 8);
    float c = 1.f, s = 0.f;
    if (lane < 16) rope_cs(pos, lane & 7, c, s);
    float o = v;
    if (lane < 8) o = v * c - partner * s; else if (lane < 16) o = v * c + partner * s;
    p[lane] = (bf16)f2bf(o * scale);
}
__device__ __forceinline__ void ph_prep0(bf16* qkv, const int* positions, const float* aq, const float* ak, const float* bq, const float* bk) {
    const int lane = tidx() & 63, wave = tidx() >> 6;
    const int gw = bidx() * (NT / 64) + wave, ngw = gridDim.x * (NT / 64);
    for (int r = gw; r < T; r += ngw) {
        const int pos = positions[r]; bf16* row = qkv + (size_t)r * AB_LD;
        for (int h = 0; h < 8; ++h) {
            prep_head(row + CQA + h * 64, aq, pos, C2, true, lane);
            prep_head(row + CKA + h * 64, ak, pos, 1.f, true, lane);
            prep_head(row + CQB + h * 64, bq, pos, C2, true, lane);
            prep_head(row + CKB + h * 64, bk, pos, 1.f, true, lane);
        }
        for (int h = 0; h < 4; ++h) prep_head(row + CQI + h * 64, nullptr, pos, 1.f, false, lane);
        prep_head(row + CKI, nullptr, pos, 1.f, false, lane);
    }
}
__device__ __forceinline__ void ph_prep1(bf16* qkv, const int* positions, const float* cq, const float* ck) {
    const int lane = tidx() & 63, wave = tidx() >> 6;
    const int gw = bidx() * (NT / 64) + wave, ngw = gridDim.x * (NT / 64);
    for (int r = gw; r < T; r += ngw) {
        const int pos = positions[r]; bf16* row = qkv + (size_t)r * C_LD;
        for (int h = 0; h < 16; ++h) {
            prep_head(row + h * 64, cq, pos, C2, true, lane);
            prep_head(row + 1024 + h * 64, ck, pos, 1.f, true, lane);
        }
    }
}
__device__ __forceinline__ void ph_kmean(const bf16* qkv, float* kmean) {
    const int lane = tidx() & 63, wave = tidx() >> 6;
    const int gw = bidx() * (NT / 64) + wave, ngw = gridDim.x * (NT / 64);
    for (int it = gw; it < BATCH * 8 * 32; it += ngw) {
        const int b = it / 256, h = (it / 32) % 8, n = it % 32;
        float s = 0.f;
        for (int r = 0; r < 256; ++r) s += bf2f(qkv[(size_t)(b * SEQ + n * 256 + r) * AB_LD + CKA + h * 64 + lane]);
        kmean[(size_t)it * 64 + lane] = s * (1.0f / 256.f);
    }
}
__device__ __forceinline__ void ph_moba_select(const bf16* qkv, const float* kmean, unsigned* sel) {
    for (int it = bidx() * NT + tidx(); it < T * 8; it += gridDim.x * NT) {
        const int t = it >> 3, h = it & 7, b = t / SEQ, qblk = (t % SEQ) / 256;
        float q[64];
#pragma unroll
        for (int d = 0; d < 64; ++d) q[d] = bf2f(qkv[(size_t)t * AB_LD + CQA + h * 64 + d]);
        float v0 = -3e38f, v1 = -3e38f, v2 = -3e38f; int i0 = 255, i1 = 255, i2 = 255;
        for (int n = 0; n < qblk; ++n) {
            const float* km = kmean + (size_t)((b * 8 + h) * 32 + n) * 64; float g = 0.f;
#pragma unroll
            for (int d = 0; d < 64; ++d) g += q[d] * km[d];
            if (g > v0) { v2 = v1; i2 = i1; v1 = v0; i1 = i0; v0 = g; i0 = n; }
            else if (g > v1) { v2 = v1; i2 = i1; v1 = g; i1 = n; }
            else if (g > v2) { v2 = g; i2 = n; }
        }
        sel[it] = (unsigned)i0 | ((unsigned)i1 << 8) | ((unsigned)i2 << 16) | (255u << 24);
    }
}
__device__ __forceinline__ void ph_moba_attend(const bf16* qkv, const unsigned* sel, bf16* O, unsigned char* smem) {
    const int lane = tidx() & 63, wave = tidx() >> 6;
    float* pl = (float*)smem + wave * 1024;
    const int gw = bidx() * (NT / 64) + wave, ngw = gridDim.x * (NT / 64);
    for (int it = gw; it < T * 8; it += ngw) {
        const int t = it >> 3, h = it & 7, b = t / SEQ, tt = t % SEQ, qblk = tt / 256;
        const unsigned sw = sel[it];
        int blk[4] = {qblk, (int)(sw & 255), (int)((sw >> 8) & 255), (int)((sw >> 16) & 255)};
        const bf16* qp = qkv + (size_t)t * AB_LD + CQA + h * 64;
        float q[64];
#pragma unroll
        for (int d = 0; d < 64; ++d) q[d] = bf2f(qp[d]);
        float sc[16]; float mx = -3e38f;
#pragma unroll
        for (int s = 0; s < 4; ++s) {
#pragma unroll
            for (int i = 0; i < 4; ++i) {
                const int j = lane + 64 * i, pos = blk[s] * 256 + j;
                const bool ok = (blk[s] != 255) && (s > 0 || pos <= tt);
                float a = -3e38f;
                if (ok) { const bf16* kp = qkv + (size_t)(b * SEQ + pos) * AB_LD + CKA + h * 64; a = 0.f;
#pragma unroll
                    for (int d = 0; d < 64; ++d) a += q[d] * bf2f(kp[d]); }
                sc[s * 4 + i] = a; mx = fmaxf(mx, a);
            }
        }
        mx = wave_max(mx); float l = 0.f;
#pragma unroll
        for (int e = 0; e < 16; ++e) { const float p = (sc[e] > -1e38f) ? exp2f(sc[e] - mx) : 0.f; l += p; pl[(e >> 2) * 256 + lane + 64 * (e & 3)] = p; }
        l = wave_sum(l);
        __builtin_amdgcn_s_waitcnt(0);
        float o = 0.f;
#pragma unroll
        for (int s = 0; s < 4; ++s) {
            if (blk[s] == 255) continue;
            const int nk = (s == 0) ? (tt - qblk * 256 + 1) : 256;
            const bf16* vp = qkv + (size_t)(b * SEQ + blk[s] * 256) * AB_LD + CVA + h * 64 + lane;
            for (int j = 0; j < nk; ++j) o += pl[s * 256 + j] * bf2f(vp[(size_t)j * AB_LD]);
        }
        O[(size_t)t * DM + h * 64 + lane] = (bf16)f2bf(o / l);
    }
}
__device__ __forceinline__ void ph_dsa_select(const bf16* qkv, unsigned long long* mask, unsigned char* smem) {
    unsigned* keys = (unsigned*)smem;
    unsigned* cnt = keys + 8192;
    const int tid = tidx(), lane = tid & 63;
    for (int t = bidx(); t < T; t += gridDim.x) {
        const int b = t / SEQ, tt = t % SEQ, n = tt + 1;
        __syncthreads();
        const bf16* row = qkv + (size_t)t * AB_LD;
        float* qf = (float*)(cnt + 4);
        if (tid < 256) qf[tid] = bf2f(row[CQI + tid]);
        if (tid < 4) qf[256 + tid] = bf2f(row[CWI + tid]);
        __syncthreads();
        for (int kv = tid; kv < 8192; kv += NT) {
            unsigned key = 0u;
            if (kv < n) {
                const bf16* kp = qkv + (size_t)(b * SEQ + kv) * AB_LD + CKI;
                float a0 = 0.f, a1 = 0.f, a2 = 0.f, a3 = 0.f;
                for (int d = 0; d < 64; ++d) { const float kd = bf2f(kp[d]); a0 += qf[d] * kd; a1 += qf[64 + d] * kd; a2 += qf[128 + d] * kd; a3 += qf[192 + d] * kd; }
                const float s = ((qf[256] * fmaxf(a0, 0.f) + qf[257] * fmaxf(a1, 0.f)) + qf[258] * fmaxf(a2, 0.f)) + qf[259] * fmaxf(a3, 0.f);
                key = okey(s);
            }
            keys[kv] = key;
        }
        __syncthreads();
        unsigned thr = 0u, need = 0u;
        if (n > 256) {
            unsigned lo = 0u, hi = 0xFFFFFFFFu;
            while (lo < hi) {
                const unsigned mid = lo + ((hi - lo) >> 1) + ((hi - lo) & 1u);
                if (tid == 0) cnt[0] = 0u;
                __syncthreads();
                unsigned c = 0;
                for (int kv = tid; kv < 8192; kv += NT) c += (keys[kv] >= mid) ? 1u : 0u;
                c = (unsigned)wave_sum((float)c);
                if (lane == 0) atomicAdd(&cnt[0], c);
                __syncthreads();
                const unsigned tot = cnt[0];
                __syncthreads();
                if (tot >= 256u) lo = mid; else hi = mid - 1u;
            }
            thr = lo;
            if (tid == 0) cnt[1] = 0u;
            __syncthreads();
            unsigned c = 0;
            for (int kv = tid; kv < 8192; kv += NT) c += (keys[kv] > thr) ? 1u : 0u;
            c = (unsigned)wave_sum((float)c);
            if (lane == 0) atomicAdd(&cnt[1], c);
            __syncthreads();
            need = 256u - cnt[1];
        }
        if (tid < 64) {
            const int ntile = 4 * (tt / 256 + 1);
            unsigned taken = 0u;
            for (int j = 0; j < ntile; ++j) {
                const int kv = j * 64 + lane; const unsigned key = keys[kv];
                bool s;
                if (n <= 256) s = kv < n;
                else {
                    const bool gt = key > thr, eq = (key == thr) && (kv < n);
                    const unsigned long long em = __ballot(eq);
                    const unsigned rank = taken + (unsigned)__popcll(em & ((1ull << lane) - 1ull));
                    s = gt || (eq && rank < need);
                    taken += (unsigned)__popcll(em);
                }
                const unsigned long long m = __ballot(s);
                if (lane == 0) mask[((size_t)(b * 128 + j)) * SEQ + tt] = m;
            }
        }
    }
}
__device__ __forceinline__ void ph_dsa_attend(const bf16* qkv, const unsigned long long* mask, bf16* O, unsigned char* smem) {
    int* list = (int*)smem;
    int* cnt = list + 256;
    float* pr = (float*)(cnt + 4);
    float* linv = pr + 8 * 256;
    const int tid = tidx(), lane = tid & 63, wave = tid >> 6;
    for (int t = bidx(); t < T; t += gridDim.x) {
        const int b = t / SEQ, tt = t % SEQ;
        __syncthreads();
        const int ntile = 4 * (tt / 256 + 1);
        if (wave == 0) {
            int base = 0;
            for (int j = 0; j < ntile; ++j) {
                const unsigned long long m = mask[((size_t)(b * 128 + j)) * SEQ + tt];
                const int p = base + (int)__popcll(m & ((1ull << lane) - 1ull));
                if (((m >> lane) & 1ull) && p < 256) list[p] = j * 64 + lane;
                base += (int)__popcll(m);
            }
            if (lane == 0) cnt[0] = base;
        }
        __syncthreads();
        const int ns = min(cnt[0], 256);
        const bf16* row = qkv + (size_t)t * AB_LD;
        for (int e = tid; e < 8 * 256; e += NT) {
            const int h = e >> 8, j = e & 255; float a = -3e38f;
            if (j < ns) { const bf16* kp = qkv + (size_t)(b * SEQ + list[j]) * AB_LD + CKB + h * 64; a = 0.f;
                for (int d = 0; d < 64; ++d) a += bf2f(row[CQB + h * 64 + d]) * bf2f(kp[d]); }
            pr[e] = a;
        }
        __syncthreads();
        {
            const int h = wave; float v[4]; float mx = -3e38f;
#pragma unroll
            for (int i = 0; i < 4; ++i) { v[i] = pr[h * 256 + lane + 64 * i]; mx = fmaxf(mx, v[i]); }
            mx = wave_max(mx); float l = 0.f;
#pragma unroll
            for (int i = 0; i < 4; ++i) { const float p = (v[i] > -1e38f) ? exp2f(v[i] - mx) : 0.f; l += p; pr[h * 256 + lane + 64 * i] = p; }
            l = wave_sum(l); if (lane == 0) linv[h] = 1.0f / l;
        }
        __syncthreads();
        {   const int h = tid >> 6, d = tid & 63; float o = 0.f;
            for (int j = 0; j < ns; ++j) o += pr[h * 256 + j] * bf2f(qkv[(size_t)(b * SEQ + list[j]) * AB_LD + CVB + h * 64 + d]);
            O[(size_t)t * DM + 512 + h * 64 + d] = (bf16)f2bf(o * linv[h]); }
    }
}
__device__ __forceinline__ void ph_dilated(const bf16* qkv, bf16* OG, float* LSE) {
    const int lane = tidx() & 63, wave = tidx() >> 6;
    const int gw = bidx() * (NT / 64) + wave, ngw = gridDim.x * (NT / 64);
    for (int it = gw; it < T * 16; it += ngw) {
        const int t = it >> 4, h = it & 15, b = t / SEQ, tt = t % SEQ;
        const bf16* qp = qkv + (size_t)t * C_LD + h * 64;
        float q[64];
#pragma unroll
        for (int d = 0; d < 64; ++d) q[d] = bf2f(qp[d]);
        for (int g = 0; g < 3; ++g) {
            const int dil = (g == 0) ? 1 : (g == 1 ? 4 : 16);
            float sc[3]; float mx = -3e38f;
#pragma unroll
            for (int i = 0; i < 3; ++i) {
                const int j = lane + 64 * i, pos = tt - j * dil; float a = -3e38f;
                if (j <= 128 && pos >= 0) { const bf16* kp = qkv + (size_t)(b * SEQ + pos) * C_LD + 1024 + h * 64; a = 0.f;
#pragma unroll
                    for (int d = 0; d < 64; ++d) a += q[d] * bf2f(kp[d]); }
                sc[i] = a; mx = fmaxf(mx, a);
            }
            mx = wave_max(mx); float l = 0.f; float p[3];
#pragma unroll
            for (int i = 0; i < 3; ++i) { p[i] = (sc[i] > -1e38f) ? exp2f(sc[i] - mx) : 0.f; l += p[i]; }
            l = wave_sum(l);
            float o = 0.f;
            for (int j = 0; j <= 128; ++j) {
                const int pos = tt - j * dil; if (pos < 0) break;
                const float pj = (j < 64) ? __shfl(p[0], j) : ((j < 128) ? __shfl(p[1], j - 64) : __shfl(p[2], 0));
                o += pj * bf2f(qkv[(size_t)(b * SEQ + pos) * C_LD + 2048 + h * 64 + lane]);
            }
            OG[((size_t)g * T + t) * DM + h * 64 + lane] = (bf16)f2bf(o / l);
            if (lane == 0) LSE[((size_t)g * T + t) * 16 + h] = mx + log2f(l);
        }
    }
}
__device__ __forceinline__ void ph_dil_merge(const bf16* OG, const float* LSE, bf16* O) {
    for (size_t e = (size_t)bidx() * NT + tidx(); e < (size_t)T * DM; e += (size_t)gridDim.x * NT) {
        const int t = (int)(e >> 10), c = (int)(e & 1023), h = c >> 6;
        const float l0 = LSE[((size_t)0 * T + t) * 16 + h], l1 = LSE[((size_t)1 * T + t) * 16 + h], l2 = LSE[((size_t)2 * T + t) * 16 + h];
        const float m = fmaxf(l0, fmaxf(l1, l2)); const float w0 = exp2f(l0 - m), w1 = exp2f(l1 - m), w2 = exp2f(l2 - m);
        const float o = (w0 * bf2f(OG[e]) + w1 * bf2f(OG[(size_t)T * DM + e]) + w2 * bf2f(OG[(size_t)2 * T * DM + e])) / (w0 + w1 + w2);
        O[e] = (bf16)f2bf(o);
    }
}
__device__ __forceinline__ void ph_peer_route(const bf16* qry, const float* subk, int* eidx, float* gw, unsigned char* smem) {
    float* s = (float*)smem;
    float* sv = s + 2048;
    int* si = (int*)(sv + 256);
    float* qf = (float*)(si + 256);
    const int tid = tidx(), lane = tid & 63, wave = tid >> 6;
    for (int t = bidx(); t < T; t += gridDim.x) {
        __syncthreads();
        for (int e = tid; e < 2048; e += NT) qf[e] = bf2f(qry[(size_t)t * 2048 + e]);
        __syncthreads();
        for (int e = tid; e < 2048; e += NT) {
            const int hc = e >> 7, k = e & 127; const float* kp = subk + ((size_t)hc * 128 + k) * 128; float a = 0.f;
            for (int d = 0; d < 128; ++d) a += qf[hc * 128 + d] * kp[d];
            s[e] = a;
        }
        __syncthreads();
        for (int hc = wave; hc < 16; hc += NT / 64) {
            float v0 = s[hc * 128 + lane], v1 = s[hc * 128 + 64 + lane];
            for (int r = 0; r < 16; ++r) {
                float bv = v0; int bi = lane;
                if (v1 > bv) { bv = v1; bi = lane + 64; }
#pragma unroll
                for (int o = 1; o < 64; o <<= 1) { const float ov = __shfl_xor(bv, o); const int oi = __shfl_xor(bi, o); if (ov > bv || (ov == bv && oi < bi)) { bv = ov; bi = oi; } }
                if (lane == 0) { sv[hc * 16 + r] = bv; si[hc * 16 + r] = bi; }
                if (bi == lane) v0 = -3e38f; if (bi == lane + 64) v1 = -3e38f;
            }
        }
        __syncthreads();
        {   const int h = wave;
            float c[4]; int ci[4];
#pragma unroll
            for (int i = 0; i < 4; ++i) { const int f = lane + 64 * i; c[i] = sv[(h * 2) * 16 + (f >> 4)] + sv[(h * 2 + 1) * 16 + (f & 15)]; ci[i] = f; }
            float cv[16]; int cf[16];
#pragma unroll
            for (int r = 0; r < 16; ++r) {
                float bv = c[0]; int bi = ci[0];
#pragma unroll
                for (int i = 1; i < 4; ++i) if (c[i] > bv) { bv = c[i]; bi = ci[i]; }
#pragma unroll
                for (int o = 1; o < 64; o <<= 1) { const float ov = __shfl_xor(bv, o); const int oi = __shfl_xor(bi, o); if (ov > bv || (ov == bv && oi < bi)) { bv = ov; bi = oi; } }
                cv[r] = bv; cf[r] = bi;
#pragma unroll
                for (int i = 0; i < 4; ++i) if (ci[i] == bi) c[i] = -3e38f;
            }
            float l = 0.f;
#pragma unroll
            for (int r = 0; r < 16; ++r) l += __expf(cv[r] - cv[0]);
            if (lane < 16) {
                float myv = 0.f; int myf = 0;
#pragma unroll
                for (int r = 0; r < 16; ++r) if (r == lane) { myv = cv[r]; myf = cf[r]; }
                eidx[(size_t)t * 128 + h * 16 + lane] = si[(h * 2) * 16 + (myf >> 4)] * 128 + si[(h * 2 + 1) * 16 + (myf & 15)];
                gw[(size_t)t * 128 + h * 16 + lane] = __expf(myv - cv[0]) / l;
            }
        }
    }
}
__device__ __forceinline__ float gelu_tanh(float x) { const float u = 0.7978845608028654f * (x + 0.044715f * x * x * x); return 0.5f * x * (1.f + tanhf(u)); }
__device__ __forceinline__ void ph_peer_gather(const bf16* xn, const int* eidx, const float* gw, const float* U, const float* V, float* h, unsigned char* smem) {
    float* xf = (float*)smem;
    float* w = xf + 1024;
    int* ei = (int*)(w + 128);
    const int tid = tidx(), lane = tid & 63, wave = tid >> 6;
    for (int t = bidx(); t < T; t += gridDim.x) {
        __syncthreads();
        for (int e = tid; e < 1024; e += NT) xf[e] = bf2f(xn[(size_t)t * DM + e]);
        if (tid < 128) ei[tid] = eidx[(size_t)t * 128 + tid];
        __syncthreads();
        for (int e = wave; e < 128; e += NT / 64) {
            const float* up = U + (size_t)ei[e] * DM; float a = 0.f;
            for (int d = lane; d < 1024; d += 64) a += xf[d] * up[d];
            a = wave_sum(a);
            if (lane == 0) w[e] = gw[(size_t)t * 128 + e] * gelu_tanh(a);
        }
        __syncthreads();
        for (int d = tid; d < 1024; d += NT) {
            float o = 0.f;
            for (int e = 0; e < 128; ++e) o += w[e] * V[(size_t)ei[e] * DM + d];
            h[(size_t)t * DM + d] += o;
        }
    }
}

namespace pg8 {
#define PG8_LAS __attribute__((address_space(3)))
typedef unsigned short bf16_t;
typedef short bf16x8 __attribute__((ext_vector_type(8)));
typedef float f32x4 __attribute__((ext_vector_type(4)));
typedef unsigned u32x4 __attribute__((ext_vector_type(4)));
constexpr int BM = 256, BK = 64, HALF = 128, HTB = HALF * BK * 2  , STAGE_BYTES = 8 * HTB, NXCD = 8, WGM = 8;

__host__ __device__ __forceinline__ int lds_byte(int r, int c) { const int st = (r >> 4) * 2 + (c >> 5), rr = r & 15, cc = c & 31, ob = rr * 64 + cc * 2; return st * 1024 + (ob ^ (((ob >> 9) & 1) << 5)); }
__host__ __device__ __forceinline__ void stage_rc(int b, int& R, int& C) { const int st = b / 1024, sb = b % 1024, swz = sb ^ (((sb >> 9) & 1) << 5); R = (st >> 1) * 16 + swz / 64; C = (st & 1) * 32 + (swz % 64) / 2; }
__host__ __device__ __forceinline__ int perm32(int rho) { const int n = rho >> 4, i = rho & 15; return 8 * (i >> 2) + 4 * n + (i & 3); }

struct Unit { int pm, pn; };
struct Gemm { const bf16_t* A; const bf16_t* Bt; int M, N, K; };

struct StaticOrder {
    int nM, nN, nwg, G, c;
    __host__ __device__ void init(int M, int N, int G_, int c_) { nM = M / BM; nN = N / BM; nwg = nM * nN; G = G_; c = c_; }
    __host__ __device__ bool next(int i, Unit& u) const {
        const long L = (long)i * G + c; if (L >= nwg) return false;
        int wgid = (int)L; { const int q = nwg / NXCD, r = nwg % NXCD, xcd = wgid % NXCD, off = wgid / NXCD; wgid = (xcd < r ? xcd * (q + 1) : r * (q + 1) + (xcd - r) * q) + off; }
        const int nig = WGM * nN, gid = wgid / nig, fm = gid * WGM, gsz = (nM - fm) < WGM ? (nM - fm) : WGM;
        u.pm = fm + ((wgid % nig) % gsz); u.pn = (wgid % nig) / gsz; return true;
    }
    __device__ __forceinline__ void a_ready(const Unit&) const {}
    __device__ __forceinline__ void done(const Unit&) const {}
};


__device__ __forceinline__ unsigned pk_bf16(float lo, float hi) { typedef float f2 __attribute__((ext_vector_type(2))); typedef __bf16 b2 __attribute__((ext_vector_type(2))); f2 v = {lo, hi}; b2 b = __builtin_convertvector(v, b2); return __builtin_bit_cast(unsigned, b); }
struct EBf16 {
    static constexpr bool PERM = true, AFTER_DRAIN = false; bf16_t* O; int ldc;
    __device__ __forceinline__ void operator()(const f32x4 (&acc)[2][2][4][2], const Unit& u, int wr, int wc, int fr, int fq) const {
        const int row0 = u.pm * BM + wr * 64 + fr, col0 = u.pn * BM + wc * 32 + 8 * fq;
#pragma unroll
        for (int ai = 0; ai < 2; ++ai)
#pragma unroll
            for (int m = 0; m < 4; ++m) { bf16_t* rowp = O + (size_t)(row0 + ai * HALF + m * 16) * ldc + col0;
#pragma unroll
                for (int bj = 0; bj < 2; ++bj) { const f32x4 v0 = acc[ai][bj][m][0], v1 = acc[ai][bj][m][1];
                    u32x4 w; w.x = pk_bf16(v0[0], v0[1]); w.y = pk_bf16(v0[2], v0[3]); w.z = pk_bf16(v1[0], v1[1]); w.w = pk_bf16(v1[2], v1[3]);
                    *(u32x4*)(rowp + bj * HALF) = w; } }
    }
};
struct EResAdd {
    static constexpr bool PERM = false, AFTER_DRAIN = false; const float* base; float* out;
    __device__ __forceinline__ void operator()(const f32x4 (&acc)[2][2][4][2], const Unit& u, int wr, int wc, int fr, int fq) const {
        const int col0 = u.pn * BM + wc * 32 + 4 * fq;
#pragma unroll
        for (int ai = 0; ai < 2; ++ai)
#pragma unroll
            for (int m = 0; m < 4; ++m) { const size_t off = (size_t)(u.pm * BM + ai * HALF + wr * 64 + m * 16 + fr) * 1024 + col0;
#pragma unroll
                for (int bj = 0; bj < 2; ++bj)
#pragma unroll
                    for (int n = 0; n < 2; ++n) { const f32x4 b = *(const f32x4*)(base + off + bj * HALF + n * 16); *(f32x4*)(out + off + bj * HALF + n * 16) = b + acc[ai][bj][m][n]; } }
    }
};
struct EGate {
    static constexpr bool PERM = false, AFTER_DRAIN = false; float* h; const bf16_t* up;
    __device__ __forceinline__ void operator()(const f32x4 (&acc)[2][2][4][2], const Unit& u, int wr, int wc, int fr, int fq) const {
        const int col0 = u.pn * BM + wc * 32 + 4 * fq;
#pragma unroll
        for (int ai = 0; ai < 2; ++ai)
#pragma unroll
            for (int m = 0; m < 4; ++m) { const size_t off = (size_t)(u.pm * BM + ai * HALF + wr * 64 + m * 16 + fr) * 1024 + col0;
#pragma unroll
                for (int bj = 0; bj < 2; ++bj)
#pragma unroll
                    for (int n = 0; n < 2; ++n) { const size_t o = off + bj * HALF + n * 16; f32x4 hv = *(const f32x4*)(h + o);
                        const unsigned long long uu = *(const unsigned long long*)(up + o); const f32x4 a = acc[ai][bj][m][n];
                        hv[0] += __builtin_bit_cast(float, (unsigned)(uu << 16)) / (1.f + __expf(-a[0]));
                        hv[1] += __builtin_bit_cast(float, (unsigned)(uu & 0xffff0000ull)) / (1.f + __expf(-a[1]));
                        hv[2] += __builtin_bit_cast(float, (unsigned)((uu >> 16) & 0xffff0000ull)) / (1.f + __expf(-a[2]));
                        hv[3] += __builtin_bit_cast(float, (unsigned)((uu >> 32) & 0xffff0000ull)) / (1.f + __expf(-a[3]));
                        *(f32x4*)(h + o) = hv; } }
    }
};

__device__ __forceinline__ float rstd16(const float* ss, int row) { const f32x4 a = *(const f32x4*)(ss + (size_t)row * 16), b = *(const f32x4*)(ss + (size_t)row * 16 + 4), c = *(const f32x4*)(ss + (size_t)row * 16 + 8), d = *(const f32x4*)(ss + (size_t)row * 16 + 12);
    const float t = ((a[0] + a[1]) + (a[2] + a[3])) + ((b[0] + b[1]) + (b[2] + b[3])) + ((c[0] + c[1]) + (c[2] + c[3])) + ((d[0] + d[1]) + (d[2] + d[3])); return 1.0f / sqrtf(t * (1.0f / 1024.f) + 1e-6f); }
__device__ __forceinline__ float rstd8(const float* ss, int row) { const f32x4 a = *(const f32x4*)(ss + (size_t)row * 8), b = *(const f32x4*)(ss + (size_t)row * 8 + 4);
    const float t = ((a[0] + a[1]) + (a[2] + a[3])) + ((b[0] + b[1]) + (b[2] + b[3])); return 1.0f / sqrtf(t * (1.0f / 1024.f) + 1e-6f); }
struct EBf16S {
    static constexpr bool PERM = true, AFTER_DRAIN = false; bf16_t* O; int ldc; const float* ss;
    __device__ __forceinline__ void operator()(const f32x4 (&acc)[2][2][4][2], const Unit& u, int wr, int wc, int fr, int fq) const {
        const int row0 = u.pm * BM + wr * 64 + fr, col0 = u.pn * BM + wc * 32 + 8 * fq;
#pragma unroll
        for (int ai = 0; ai < 2; ++ai)
#pragma unroll
            for (int m = 0; m < 4; ++m) { const int row = row0 + ai * HALF + m * 16; const float rs = rstd16(ss, row); bf16_t* rowp = O + (size_t)row * ldc + col0;
#pragma unroll
                for (int bj = 0; bj < 2; ++bj) { const f32x4 v0 = acc[ai][bj][m][0] * rs, v1 = acc[ai][bj][m][1] * rs;
                    u32x4 w; w.x = pk_bf16(v0[0], v0[1]); w.y = pk_bf16(v0[2], v0[3]); w.z = pk_bf16(v1[0], v1[1]); w.w = pk_bf16(v1[2], v1[3]);
                    *(u32x4*)(rowp + bj * HALF) = w; } }
    }
};
struct EResAddN {
    static constexpr bool PERM = false, AFTER_DRAIN = false; const float* base; float* out; bf16_t* xb; float* ss;
    __device__ __forceinline__ void operator()(const f32x4 (&acc)[2][2][4][2], const Unit& u, int wr, int wc, int fr, int fq) const {
        const int col0 = u.pn * BM + wc * 32 + 4 * fq;
#pragma unroll
        for (int ai = 0; ai < 2; ++ai)
#pragma unroll
            for (int m = 0; m < 4; ++m) { const int row = u.pm * BM + ai * HALF + wr * 64 + m * 16 + fr; const size_t off = (size_t)row * 1024 + col0; float sq = 0.f;
#pragma unroll
                for (int bj = 0; bj < 2; ++bj)
#pragma unroll
                    for (int n = 0; n < 2; ++n) { const size_t o = off + bj * HALF + n * 16; const f32x4 v = *(const f32x4*)(base + o) + acc[ai][bj][m][n]; *(f32x4*)(out + o) = v;
                        sq += (v[0] * v[0] + v[1] * v[1]) + (v[2] * v[2] + v[3] * v[3]);
                        *(unsigned long long*)(xb + o) = (unsigned long long)pk_bf16(v[0], v[1]) | ((unsigned long long)pk_bf16(v[2], v[3]) << 32); }
                sq += ::shx<16>(sq); sq += ::shx<32>(sq);
                if (fq == 0) ss[(size_t)row * 16 + u.pn * 4 + wc] = sq; }
    }
};
template <bool LAST> struct EGateN {
    static constexpr bool PERM = false, AFTER_DRAIN = false; float* h; const bf16_t* up; const float* ss8; bf16_t* xb; float* ss;
    __device__ __forceinline__ void operator()(const f32x4 (&acc)[2][2][4][2], const Unit& u, int wr, int wc, int fr, int fq) const {
        const int col0 = u.pn * BM + wc * 32 + 4 * fq;
#pragma unroll
        for (int ai = 0; ai < 2; ++ai)
#pragma unroll
            for (int m = 0; m < 4; ++m) { const int row = u.pm * BM + ai * HALF + wr * 64 + m * 16 + fr; const size_t off = (size_t)row * 1024 + col0; const float rs = rstd8(ss8, row); float sq = 0.f;
#pragma unroll
                for (int bj = 0; bj < 2; ++bj)
#pragma unroll
                    for (int n = 0; n < 2; ++n) { const size_t o = off + bj * HALF + n * 16; f32x4 hv = *(const f32x4*)(h + o);
                        const unsigned long long uu = *(const unsigned long long*)(up + o); const f32x4 a = acc[ai][bj][m][n] * rs;
                        hv[0] += __builtin_bit_cast(float, (unsigned)(uu << 16)) / (1.f + __expf(-a[0]));
                        hv[1] += __builtin_bit_cast(float, (unsigned)(uu & 0xffff0000ull)) / (1.f + __expf(-a[1]));
                        hv[2] += __builtin_bit_cast(float, (unsigned)((uu >> 16) & 0xffff0000ull)) / (1.f + __expf(-a[2]));
                        hv[3] += __builtin_bit_cast(float, (unsigned)((uu >> 32) & 0xffff0000ull)) / (1.f + __expf(-a[3]));
                        *(f32x4*)(h + o) = hv;
                        if (!LAST) { sq += (hv[0] * hv[0] + hv[1] * hv[1]) + (hv[2] * hv[2] + hv[3] * hv[3]);
                            *(unsigned long long*)(xb + o) = (unsigned long long)pk_bf16(hv[0], hv[1]) | ((unsigned long long)pk_bf16(hv[2], hv[3]) << 32); } }
                if (!LAST) { sq += ::shx<16>(sq); sq += ::shx<32>(sq); if (fq == 0) ss[(size_t)row * 16 + u.pn * 4 + wc] = sq; } }
    }
};
template <class Epi, class Sched, bool ALIGN_EPI = false, bool SP2 = false>
__device__ __forceinline__ void gemm_phase(PG8_LAS unsigned char* lds, const Gemm g, const Sched& S, const Epi& E) {
    const int tid = tidx(), wid = __builtin_amdgcn_readfirstlane(tid >> 6), lane = tid & 63, wr = wid >> 2, wc = wid & 3, fr = lane & 15, fq = lane >> 4;
    const int K = g.K, nt = K / BK;
    unsigned voffA[2], voffB[2];
#pragma unroll
    for (int i = 0; i < 2; ++i) { int R, C; stage_rc(tid * 16 + i * 8192, R, C); const int Rb = Epi::PERM ? ((R & ~31) + perm32(R & 31)) : R;
        voffA[i] = (unsigned)(R * K + C) * 2u; voffB[i] = (unsigned)(Rb * K + C) * 2u; }
    const size_t kstep = (size_t)(BK * 2);
    const size_t hstep = (size_t)HALF * K * 2;
    const size_t tstep = 2 * hstep;
    const unsigned ldsw = (unsigned)wid * 1024u;
    const int aoff = lds_byte(wr * 64 + fr, fq * 8), boff = lds_byte(wc * 32 + fr, fq * 8);
#define PG8_SA(b, h) (((b) * 2 + (h)) * HTB)
#define PG8_SB(b, h) ((4 + (b) * 2 + (h)) * HTB)
#define PG8_STAGE(bufoff, gbase, voff) do { _Pragma("unroll") for (int _i = 0; _i < 2; ++_i) \
        __builtin_amdgcn_global_load_lds((const unsigned*)((const char*)(gbase) + (voff)[_i]), (PG8_LAS unsigned*)(lds + (bufoff) + ldsw + _i * 8192), 16, 0, 0); } while (0)
#define PG8_LDA(dst, b, h) do { _Pragma("unroll") for (int m = 0; m < 4; ++m) _Pragma("unroll") for (int k = 0; k < 2; ++k) dst[m][k] = *(const PG8_LAS bf16x8*)(lds + PG8_SA(b, h) + aoff + m * 2048 + k * 1024); } while (0)
#define PG8_LDB(dst, b, h) do { _Pragma("unroll") for (int n = 0; n < 2; ++n) _Pragma("unroll") for (int k = 0; k < 2; ++k) dst[n][k] = *(const PG8_LAS bf16x8*)(lds + PG8_SB(b, h) + boff + n * 2048 + k * 1024); } while (0)
#define PG8_MMA(ai, bj, At, Bt) do { __builtin_amdgcn_s_setprio(1); _Pragma("unroll") for (int m = 0; m < 4; ++m) _Pragma("unroll") for (int n = 0; n < 2; ++n) _Pragma("unroll") for (int k = 0; k < 2; ++k) \
        acc[ai][bj][m][n] = __builtin_amdgcn_mfma_f32_16x16x32_bf16(Bt[n][k], At[m][k], acc[ai][bj][m][n], 0, 0, 0); __builtin_amdgcn_s_setprio(0); } while (0)
#define PG8_WAIT_V(n) asm volatile("s_waitcnt vmcnt(" #n ")" ::: "memory")
#define PG8_WAIT_L(n) asm volatile("s_waitcnt lgkmcnt(" #n ")" ::: "memory")
#define PG8_BAR __builtin_amdgcn_s_barrier()
#define PG8_SCHED __builtin_amdgcn_sched_barrier(0)
    Unit cur, nxt; int ui = 0;
    if (!S.next(0, cur)) return;
    f32x4 acc[2][2][4][2];
#pragma unroll
    for (int a = 0; a < 2; ++a)
#pragma unroll
        for (int b = 0; b < 2; ++b)
#pragma unroll
            for (int m = 0; m < 4; ++m)
#pragma unroll
                for (int n = 0; n < 2; ++n) acc[a][b][m][n] = (f32x4){0.f, 0.f, 0.f, 0.f};
    bf16x8 At[4][2], B0[2][2], B1[2][2];
    const char* cA = (const char*)g.A + (size_t)cur.pm * tstep; const char* cB = (const char*)g.Bt + (size_t)cur.pn * tstep;
    S.a_ready(cur);
    if constexpr (SP2) {
        PG8_STAGE(PG8_SB(0, 0), cB, voffB); PG8_STAGE(PG8_SB(0, 1), cB + hstep, voffB); PG8_STAGE(PG8_SA(0, 0), cA, voffA); PG8_STAGE(PG8_SA(0, 1), cA + hstep, voffA);
        if (wr == 1) PG8_BAR;
        PG8_WAIT_V(2); PG8_BAR;
        PG8_STAGE(PG8_SB(1, 0), cB + kstep, voffB); PG8_STAGE(PG8_SA(1, 0), cA + kstep, voffA); PG8_STAGE(PG8_SB(1, 1), cB + hstep + kstep, voffB);
        PG8_WAIT_V(6); PG8_BAR;
    } else {
        PG8_STAGE(PG8_SB(0, 0), cB, voffB); PG8_STAGE(PG8_SA(0, 0), cA, voffA); PG8_STAGE(PG8_SB(0, 1), cB + hstep, voffB); PG8_STAGE(PG8_SA(0, 1), cA + hstep, voffA);
        if (wr == 1) PG8_BAR;
        PG8_WAIT_V(4); PG8_BAR;
        PG8_STAGE(PG8_SB(1, 0), cB + kstep, voffB); PG8_STAGE(PG8_SA(1, 0), cA + kstep, voffA); PG8_STAGE(PG8_SB(1, 1), cB + hstep + kstep, voffB);
        PG8_WAIT_V(6); PG8_BAR;
    }
    for (;;) {
        const bool has_next = S.next(ui + 1, nxt);
        const char* nA = has_next ? (const char*)g.A + (size_t)nxt.pm * tstep : cA; const char* nB = has_next ? (const char*)g.Bt + (size_t)nxt.pn * tstep : cB;
        for (int t = 0; t < nt; t += 2) {
            const bool last = (t == nt - 2);
            const char* a1 = cA + (size_t)(t + 1) * kstep;
            const char* a2 = last ? nA : cA + (size_t)(t + 2) * kstep; const char* b2 = last ? nB : cB + (size_t)(t + 2) * kstep;
            const char* a3 = a2 + kstep; const char* b3 = b2 + kstep;
            if (last && has_next) S.a_ready(nxt);
            if constexpr (SP2) {
            PG8_LDB(B0, 0, 0); PG8_LDB(B1, 0, 1); PG8_SCHED; PG8_LDA(At, 0, 0); PG8_STAGE(PG8_SA(1, 1), a1 + hstep, voffA);
            PG8_WAIT_V(8); PG8_WAIT_L(0); PG8_BAR; PG8_MMA(0, 0, At, B0); PG8_MMA(0, 1, At, B1); PG8_BAR; PG8_SCHED;
            PG8_LDA(At, 0, 1); PG8_STAGE(PG8_SB(0, 0), b2, voffB); PG8_STAGE(PG8_SB(0, 1), b2 + hstep, voffB); PG8_STAGE(PG8_SA(0, 0), a2, voffA);
            PG8_WAIT_V(8); PG8_WAIT_L(0); PG8_BAR; PG8_MMA(1, 0, At, B0); PG8_MMA(1, 1, At, B1); PG8_BAR; PG8_SCHED;
            PG8_LDB(B0, 1, 0); PG8_LDB(B1, 1, 1); PG8_SCHED; PG8_LDA(At, 1, 0); PG8_STAGE(PG8_SA(0, 1), a2 + hstep, voffA);
            PG8_WAIT_V(8); PG8_WAIT_L(0); PG8_BAR; PG8_MMA(0, 0, At, B0); PG8_MMA(0, 1, At, B1); PG8_BAR; PG8_SCHED;
            PG8_LDA(At, 1, 1); PG8_STAGE(PG8_SB(1, 0), b3, voffB); PG8_STAGE(PG8_SB(1, 1), b3 + hstep, voffB); PG8_STAGE(PG8_SA(1, 0), a3, voffA);
            PG8_WAIT_V(8); PG8_WAIT_L(0); PG8_BAR; PG8_MMA(1, 0, At, B0); PG8_MMA(1, 1, At, B1); PG8_BAR; PG8_SCHED;
            } else {
            PG8_LDB(B0, 0, 0); PG8_SCHED; PG8_LDA(At, 0, 0); PG8_STAGE(PG8_SA(1, 1), a1 + hstep, voffA);
            PG8_WAIT_L(8); PG8_BAR; PG8_WAIT_L(0); PG8_MMA(0, 0, At, B0); PG8_BAR; PG8_SCHED;
            PG8_LDB(B1, 0, 1); PG8_STAGE(PG8_SB(0, 0), b2, voffB);
            PG8_BAR; PG8_WAIT_L(0); PG8_MMA(0, 1, At, B1); PG8_BAR;
            PG8_LDA(At, 0, 1); PG8_STAGE(PG8_SA(0, 0), a2, voffA);
            PG8_BAR; PG8_WAIT_L(0); PG8_MMA(1, 0, At, B0); PG8_BAR; PG8_SCHED;
            PG8_STAGE(PG8_SB(0, 1), b2 + hstep, voffB);
            PG8_WAIT_V(6); PG8_BAR; PG8_MMA(1, 1, At, B1); PG8_BAR;
            PG8_LDB(B0, 1, 0); PG8_SCHED; PG8_LDA(At, 1, 0); PG8_STAGE(PG8_SA(0, 1), a2 + hstep, voffA);
            PG8_WAIT_L(8); PG8_BAR; PG8_WAIT_L(0); PG8_MMA(0, 0, At, B0); PG8_BAR; PG8_SCHED;
            PG8_LDB(B1, 1, 1); PG8_STAGE(PG8_SB(1, 0), b3, voffB);
            PG8_BAR; PG8_WAIT_L(0); PG8_MMA(0, 1, At, B1); PG8_BAR;
            PG8_LDA(At, 1, 1); PG8_STAGE(PG8_SA(1, 0), a3, voffA);
            PG8_BAR; PG8_WAIT_L(0); PG8_MMA(1, 0, At, B0); PG8_BAR; PG8_SCHED;
            PG8_STAGE(PG8_SB(1, 1), b3 + hstep, voffB);
            PG8_WAIT_V(6); PG8_BAR; PG8_MMA(1, 1, At, B1); PG8_BAR;
            }
        }
        if constexpr (ALIGN_EPI) { if (wr == 0) PG8_BAR; }
        if constexpr (!Epi::AFTER_DRAIN) { E(acc, cur, wr, wc, fr, fq); S.done(cur); }
        if (!has_next) break;
#pragma unroll
        for (int a = 0; a < 2; ++a)
#pragma unroll
            for (int b = 0; b < 2; ++b)
#pragma unroll
                for (int m = 0; m < 4; ++m)
#pragma unroll
                    for (int n = 0; n < 2; ++n) acc[a][b][m][n] = (f32x4){0.f, 0.f, 0.f, 0.f};
        cur = nxt; cA = nA; cB = nB; ++ui;
        if constexpr (ALIGN_EPI) { if (wr == 1) PG8_BAR; }
    }
    PG8_WAIT_V(0);
    if constexpr (!ALIGN_EPI) { if (wr == 0) PG8_BAR; }
    PG8_BAR;
    if constexpr (Epi::AFTER_DRAIN) { E.fused(acc, cur, wr, wc, fr, fq, lds, wid, lane); S.done(cur); }
#undef PG8_SA
#undef PG8_SB
#undef PG8_STAGE
#undef PG8_LDA
#undef PG8_LDB
#undef PG8_MMA
#undef PG8_WAIT_V
#undef PG8_WAIT_L
#undef PG8_BAR
#undef PG8_SCHED
}
}

#define LAS __attribute__((address_space(3)))
typedef unsigned v4u __attribute__((ext_vector_type(4)));
__device__ __forceinline__ unsigned pk2(float lo, float hi) { return f2bf(lo) | (f2bf(hi) << 16); }
__device__ __forceinline__ void transpose_item(const float* W, int K, int N, bf16* WT, float* scr, int item, int nblk, int lane, const float* gain) {
    const int kb = item / nblk, nb = item % nblk, k0 = 64 * kb, n0 = 32 * nb;
    const int nc = n0 + 4 * (lane & 7);
    f32x4 tv[8];
#pragma unroll
    for (int i = 0; i < 8; ++i) { const int kk = 8 * i + (lane >> 3); tv[i] = *(const f32x4*)(W + (size_t)(k0 + kk) * N + ((nc < N) ? nc : 0)) * (gain ? gain[k0 + kk] : 1.0f); }
#pragma unroll
    for (int i = 0; i < 8; ++i) { const int kk = 8 * i + (lane >> 3); *(f32x4*)(scr + kk * 36 + 4 * (lane & 7)) = (nc < N) ? tv[i] : (f32x4){0.f, 0.f, 0.f, 0.f}; }
    __builtin_amdgcn_s_waitcnt(0xc07f); asm volatile("" ::: "memory");
    const int c = lane & 7;
#pragma unroll
    for (int j = 0; j < 4; ++j) { const int n = (lane >> 3) + 8 * j; const float* sp = scr + (8 * c) * 36 + n;
        v4u o; o.x = pk2(sp[0 * 36], sp[1 * 36]); o.y = pk2(sp[2 * 36], sp[3 * 36]); o.z = pk2(sp[4 * 36], sp[5 * 36]); o.w = pk2(sp[6 * 36], sp[7 * 36]);
        *(v4u*)(WT + (size_t)(n0 + n) * K + k0 + 8 * c) = o; }
    __builtin_amdgcn_s_waitcnt(0xc07f); asm volatile("" ::: "memory");
}
__device__ __forceinline__ void cvt_bf16(const float* src, bf16* dst, size_t n) {
    for (size_t e = ((size_t)bidx() * NT + tidx()) * 8; e < n; e += (size_t)gridDim.x * NT * 8) {
        const f32x4 a = *(const f32x4*)(src + e), b = *(const f32x4*)(src + e + 4);
        v4u o; o.x = pk2(a.x, a.y); o.y = pk2(a.z, a.w); o.z = pk2(b.x, b.y); o.w = pk2(b.z, b.w);
        *(v4u*)(dst + e) = o; }
}
__device__ __forceinline__ void transpose_matrix(const float* W, int K, int N, int Npad, bf16* WT, float* scr, int gw, int ngw, int lane, const float* gain = nullptr) {
    const int nblk = Npad / 32, nit = (K / 64) * nblk;
    for (int it = gw; it < nit; it += ngw) transpose_item(W, K, N, WT, scr, it, nblk, lane, gain);
}
__device__ __forceinline__ void ph_prologue(unsigned char* smem) {
    const int lane = tidx() & 63, wave = tidx() >> 6;
    float* scr = (float*)smem + wave * (64 * 36);
    const int gw = bidx() * (NT / 64) + wave, ngw = gridDim.x * (NT / 64);
    unsigned char* ws = WSP;
    transpose_matrix(IN(6), 1024, AB_N, AB_LD, (bf16*)(ws + WS_WAB_IN), scr, gw, ngw, lane);
    transpose_matrix(IN(7), 1024, 1024, 1024, (bf16*)(ws + WS_WAB_OUT), scr, gw, ngw, lane);
    transpose_matrix(IN(12), 1024, 3072, 3072, (bf16*)(ws + WS_WC_IN), scr, gw, ngw, lane, IN(3) + DM);
    transpose_matrix(IN(13), 1024, 1024, 1024, (bf16*)(ws + WS_WC_OUT), scr, gw, ngw, lane);
#pragma unroll 1
    for (int L = 0; L < 2; ++L) {
        transpose_matrix(IN(16) + (size_t)L * DM * 2048, 1024, 2048, 2048, (bf16*)(ws + WS_WQ + (size_t)L * 4 * MiB), scr, gw, ngw, lane, IN(4) + L * DM);
        transpose_matrix(IN(20) + (size_t)L * DM * DM, 1024, 1024, 1024, (bf16*)(ws + WS_WG + (size_t)L * 2 * MiB), scr, gw, ngw, lane, IN(5) + L * DM);
        transpose_matrix(IN(21) + (size_t)L * 256 * DM, 256, 1024, 1024, (bf16*)(ws + WS_WUP + (size_t)L * (MiB / 2)), scr, gw, ngw, lane);
    }
    cvt_bf16(IN(1), (bf16*)(ws + WS_P), (size_t)2 * T * 256);
    cvt_bf16(IN(17), (bf16*)(ws + WS_SUBK), (size_t)2 * 16 * 128 * 128);
}


typedef __bf16 bf2_t __attribute__((ext_vector_type(2)));
typedef unsigned u32x4g __attribute__((ext_vector_type(4)));
__device__ __forceinline__ float dot2u(unsigned a, unsigned b, float c) { return __builtin_amdgcn_fdot2_f32_bf16(__builtin_bit_cast(bf2_t, a), __builtin_bit_cast(bf2_t, b), c, false); }
__device__ __forceinline__ float dot8(u32x4g a, u32x4g b, float c) {
    c = dot2u(a[0], b[0], c); c = dot2u(a[1], b[1], c); c = dot2u(a[2], b[2], c); c = dot2u(a[3], b[3], c);
    return c;
}
__device__ __forceinline__ float bflo(unsigned d) { return __builtin_bit_cast(float, d << 16); }
__device__ __forceinline__ float bfhi(unsigned d) { return __builtin_bit_cast(float, d & 0xffff0000u); }
#define GATHER_U8(EREG, B) do { float s_[8]; \
    _Pragma("unroll") for (int k = 0; k < 8; ++k) { const int idx = __builtin_amdgcn_readlane(EREG, ((B) * 8 + k) & 63); \
        const u32x4g* up = (const u32x4g*)(U + (size_t)idx * DM); const u32x4g u0 = up[lane], u1 = up[64 + lane]; s_[k] = dot8(x1, u1, dot8(x0, u0, 0.f)); } \
    float r_[4]; const bool b5 = lane & 32, b4 = lane & 16, b3 = lane & 8; \
    _Pragma("unroll") for (int i = 0; i < 4; ++i) { const float snd = b5 ? s_[i] : s_[4 + i], kp = b5 ? s_[4 + i] : s_[i]; r_[i] = kp + __shfl_xor(snd, 32); } \
    float q_[2]; \
    _Pragma("unroll") for (int i = 0; i < 2; ++i) { const float snd = b4 ? r_[i] : r_[2 + i], kp = b4 ? r_[2 + i] : r_[i]; q_[i] = kp + __shfl_xor(snd, 16); } \
    float p_; { const float snd = b3 ? q_[0] : q_[1], kp = b3 ? q_[1] : q_[0]; p_ = kp + __shfl_xor(snd, 8); } \
    p_ += __shfl_xor(p_, 4); p_ += __shfl_xor(p_, 2); p_ += __shfl_xor(p_, 1); \
    if ((lane & 7) == 0) al[(B) * 8 + (lane >> 3)] = p_; } while (0)
#define GATHER_V8(EREG, WREG, B) do { \
    _Pragma("unroll") for (int k = 0; k < 8; ++k) { const int idx = __builtin_amdgcn_readlane(EREG, ((B) * 8 + k) & 63); \
        const float w = __builtin_bit_cast(float, __builtin_amdgcn_readlane(__builtin_bit_cast(int, WREG), ((B) * 8 + k) & 63)); \
        const u32x4g* vp = (const u32x4g*)(V + (size_t)idx * DM); const u32x4g v0 = vp[lane], v1 = vp[64 + lane]; \
        acc[0] += w * bflo(v0.x); acc[1] += w * bfhi(v0.x); acc[2] += w * bflo(v0.y); acc[3] += w * bfhi(v0.y); \
        acc[4] += w * bflo(v0.z); acc[5] += w * bfhi(v0.z); acc[6] += w * bflo(v0.w); acc[7] += w * bfhi(v0.w); \
        acc[8] += w * bflo(v1.x); acc[9] += w * bfhi(v1.x); acc[10] += w * bflo(v1.y); acc[11] += w * bfhi(v1.y); \
        acc[12] += w * bflo(v1.z); acc[13] += w * bfhi(v1.z); acc[14] += w * bflo(v1.w); acc[15] += w * bfhi(v1.w); } } while (0)
__device__ __forceinline__ void ph_peer_gather_opt(const int* eidx, const float* gw, const bf16* U, const bf16* V, float* h, const float* gain_next, bf16* XN, unsigned char* smem) {
    const int tid = tidx(), lane = tid & 63, wave = tid >> 6;
    float* al = (float*)smem + wave * 128;
    const int gwv = bidx() * (NT / 64) + wave, ngw = gridDim.x * (NT / 64);
    for (int t = gwv; t < T; t += ngw) {
        const u32x4g x0 = *(const u32x4g*)(XN + (size_t)t * DM + 8 * lane), x1 = *(const u32x4g*)(XN + (size_t)t * DM + 512 + 8 * lane);
        const int e0 = eidx[(size_t)t * 128 + lane], e1 = eidx[(size_t)t * 128 + 64 + lane];
        const float g0 = gw[(size_t)t * 128 + lane], g1 = gw[(size_t)t * 128 + 64 + lane];
#pragma unroll 1
        for (int b = 0; b < 8; ++b) GATHER_U8(e0, b);
#pragma unroll 1
        for (int b = 8; b < 16; ++b) GATHER_U8(e1, b);
        __builtin_amdgcn_s_waitcnt(0xc07f); asm volatile("" ::: "memory");
        const float w0 = g0 * gelu_tanh(al[lane]), w1 = g1 * gelu_tanh(al[64 + lane]);
        float acc[16];
#pragma unroll
        for (int i = 0; i < 16; ++i) acc[i] = 0.f;
#pragma unroll 1
        for (int b = 0; b < 8; ++b) GATHER_V8(e0, w0, b);
#pragma unroll 1
        for (int b = 8; b < 16; ++b) GATHER_V8(e1, w1, b);
        float* hp = h + (size_t)t * DM + 8 * lane;
        f32x4 h0 = *(f32x4*)(hp), h1 = *(f32x4*)(hp + 4), h2 = *(f32x4*)(hp + 512), h3 = *(f32x4*)(hp + 516);
        h0 += (f32x4){acc[0], acc[1], acc[2], acc[3]}; h1 += (f32x4){acc[4], acc[5], acc[6], acc[7]};
        h2 += (f32x4){acc[8], acc[9], acc[10], acc[11]}; h3 += (f32x4){acc[12], acc[13], acc[14], acc[15]};
        *(f32x4*)(hp) = h0; *(f32x4*)(hp + 4) = h1; *(f32x4*)(hp + 512) = h2; *(f32x4*)(hp + 516) = h3;
        float ss = 0.f;
#pragma unroll
        for (int i = 0; i < 4; ++i) ss += h0[i] * h0[i] + h1[i] * h1[i] + h2[i] * h2[i] + h3[i] * h3[i];
        const float rstd = 1.0f / sqrtf(wave_sum(ss) * (1.0f / DM) + NORM_EPS);
        const f32x4 ga = *(const f32x4*)(gain_next + 8 * lane), gb = *(const f32x4*)(gain_next + 8 * lane + 4), gc = *(const f32x4*)(gain_next + 512 + 8 * lane), gd = *(const f32x4*)(gain_next + 516 + 8 * lane);
        u32x4g o0, o1;
        o0.x = pk2(h0[0] * rstd * ga[0], h0[1] * rstd * ga[1]); o0.y = pk2(h0[2] * rstd * ga[2], h0[3] * rstd * ga[3]);
        o0.z = pk2(h1[0] * rstd * gb[0], h1[1] * rstd * gb[1]); o0.w = pk2(h1[2] * rstd * gb[2], h1[3] * rstd * gb[3]);
        o1.x = pk2(h2[0] * rstd * gc[0], h2[1] * rstd * gc[1]); o1.y = pk2(h2[2] * rstd * gc[2], h2[3] * rstd * gc[3]);
        o1.z = pk2(h3[0] * rstd * gd[0], h3[1] * rstd * gd[1]); o1.w = pk2(h3[2] * rstd * gd[2], h3[3] * rstd * gd[3]);
        *(u32x4g*)(XN + (size_t)t * DM + 8 * lane) = o0; *(u32x4g*)(XN + (size_t)t * DM + 512 + 8 * lane) = o1;
    }
}


typedef short bf16x8r __attribute__((ext_vector_type(8)));
typedef float f32x16r __attribute__((ext_vector_type(16)));
__device__ __forceinline__ float unokey(unsigned k) { const unsigned u = (k & 0x80000000u) ? (k & 0x7fffffffu) : ~k; return __builtin_bit_cast(float, u); }
#define CE_D(a, b) do { const unsigned mx_ = max(a, b), mn_ = min(a, b); a = mx_; b = mn_; } while (0)
#define SORT16_DESC(v, base) do { \
    _Pragma("unroll") for (int k_ = 2; k_ <= 16; k_ <<= 1) \
    _Pragma("unroll") for (int j_ = k_ >> 1; j_ > 0; j_ >>= 1) \
    _Pragma("unroll") for (int i_ = 0; i_ < 16; ++i_) { const int l_ = i_ ^ j_; if (l_ > i_) { if ((i_ & k_) == 0) CE_D(v[(base) + i_], v[(base) + l_]); else CE_D(v[(base) + l_], v[(base) + i_]); } } } while (0)
#define BMERGE16_DESC(v, base) do { \
    _Pragma("unroll") for (int j_ = 8; j_ > 0; j_ >>= 1) \
    _Pragma("unroll") for (int i_ = 0; i_ < 16; ++i_) { const int l_ = i_ ^ j_; if (l_ > i_) CE_D(v[(base) + i_], v[(base) + l_]); } } while (0)
#define TOPMERGE16(v, a, b) do { _Pragma("unroll") for (int i_ = 0; i_ < 16; ++i_) v[(a) + i_] = max(v[(a) + i_], v[(b) + 15 - i_]); BMERGE16_DESC(v, a); } while (0)
#define PARTNER_TOP16(v) do { unsigned o_[16]; _Pragma("unroll") for (int i_ = 0; i_ < 16; ++i_) o_[i_] = shx<32>(v[15 - i_]); \
    _Pragma("unroll") for (int i_ = 0; i_ < 16; ++i_) v[i_] = max(v[i_], o_[i_]); BMERGE16_DESC(v, 0); } while (0)
constexpr int SK_ROW = 272;
__device__ __forceinline__ void ph_peer_route_opt(const bf16* qry, const bf16* subk, int* eidx, float* gw, unsigned char* smem) {
    const int tid = tidx(), lane = tid & 63, wave = tid >> 6, r32 = lane & 31, hi = lane >> 5;
    for (int unit = bidx(); unit < 512; unit += gridDim.x) {
        const int h = unit & 7, tb = unit >> 3;
        __syncthreads();
        for (int i = tid; i < 4096; i += NT) { const int row = i >> 4, ch = i & 15;
            *(u32x4g*)(smem + row * SK_ROW + ch * 16) = *(const u32x4g*)(subk + ((size_t)(h * 2) * 128 + row) * 128 + ch * 8); }
        __syncthreads();
        const int trow = tb * 256 + wave * 32 + r32;
        unsigned top[2][16];
#pragma unroll
        for (int c = 0; c < 2; ++c) {
            f32x16r acc[4];
#pragma unroll
            for (int kb = 0; kb < 4; ++kb) acc[kb] = (f32x16r){0.f, 0.f, 0.f, 0.f, 0.f, 0.f, 0.f, 0.f, 0.f, 0.f, 0.f, 0.f, 0.f, 0.f, 0.f, 0.f};
#pragma unroll
            for (int ks = 0; ks < 8; ++ks) {
                const bf16x8r bq = *(const bf16x8r*)(qry + (size_t)trow * 2048 + h * 256 + c * 128 + ks * 16 + 8 * hi);
#pragma unroll
                for (int kb = 0; kb < 4; ++kb) {
                    const bf16x8r ak = *(const bf16x8r*)(smem + (c * 128 + kb * 32 + r32) * SK_ROW + (ks * 16 + 8 * hi) * 2);
                    acc[kb] = __builtin_amdgcn_mfma_f32_32x32x16_bf16(ak, bq, acc[kb], 0, 0, 0);
                }
            }
            unsigned k[64];
#pragma unroll
            for (int kb = 0; kb < 4; ++kb)
#pragma unroll
                for (int r = 0; r < 16; ++r) { const float sc = acc[kb][r]; const int idx = kb * 32 + (r & 3) + 8 * (r >> 2) + 4 * hi;
                    k[kb * 16 + r] = (okey(sc) & 0xffffff80u) | (unsigned)(127 - idx); }
            SORT16_DESC(k, 0); SORT16_DESC(k, 16); SORT16_DESC(k, 32); SORT16_DESC(k, 48);
            TOPMERGE16(k, 0, 16); TOPMERGE16(k, 32, 48); TOPMERGE16(k, 0, 32);
            PARTNER_TOP16(k);
#pragma unroll
            for (int i = 0; i < 16; ++i) top[c][i] = k[i];
        }
        float va[16], vb[16];
#pragma unroll
        for (int i = 0; i < 16; ++i) { va[i] = unokey((top[0][i] & 0xffffff80u) | 0x40u); vb[i] = unokey((top[1][i] & 0xffffff80u) | 0x40u); }
        unsigned ck[32];
        ck[0] = (okey(hi ? (va[2] + vb[1]) : (va[0] + vb[0])) & 0xffffff00u) | (hi ? 222u : 255u);
        ck[1] = (okey(hi ? (va[2] + vb[2]) : (va[0] + vb[1])) & 0xffffff00u) | (hi ? 221u : 254u);
        ck[2] = (okey(hi ? (va[2] + vb[3]) : (va[0] + vb[2])) & 0xffffff00u) | (hi ? 220u : 253u);
        ck[3] = (okey(hi ? (va[2] + vb[4]) : (va[0] + vb[3])) & 0xffffff00u) | (hi ? 219u : 252u);
        ck[4] = (okey(hi ? (va[3] + vb[0]) : (va[0] + vb[4])) & 0xffffff00u) | (hi ? 207u : 251u);
        ck[5] = (okey(hi ? (va[3] + vb[1]) : (va[0] + vb[5])) & 0xffffff00u) | (hi ? 206u : 250u);
        ck[6] = (okey(hi ? (va[3] + vb[2]) : (va[0] + vb[6])) & 0xffffff00u) | (hi ? 205u : 249u);
        ck[7] = (okey(hi ? (va[3] + vb[3]) : (va[0] + vb[7])) & 0xffffff00u) | (hi ? 204u : 248u);
        ck[8] = (okey(hi ? (va[4] + vb[0]) : (va[0] + vb[8])) & 0xffffff00u) | (hi ? 191u : 247u);
        ck[9] = (okey(hi ? (va[4] + vb[1]) : (va[0] + vb[9])) & 0xffffff00u) | (hi ? 190u : 246u);
        ck[10] = (okey(hi ? (va[4] + vb[2]) : (va[0] + vb[10])) & 0xffffff00u) | (hi ? 189u : 245u);
        ck[11] = (okey(hi ? (va[5] + vb[0]) : (va[0] + vb[11])) & 0xffffff00u) | (hi ? 175u : 244u);
        ck[12] = (okey(hi ? (va[5] + vb[1]) : (va[0] + vb[12])) & 0xffffff00u) | (hi ? 174u : 243u);
        ck[13] = (okey(hi ? (va[6] + vb[0]) : (va[0] + vb[13])) & 0xffffff00u) | (hi ? 159u : 242u);
        ck[14] = (okey(hi ? (va[6] + vb[1]) : (va[0] + vb[14])) & 0xffffff00u) | (hi ? 158u : 241u);
        ck[15] = (okey(hi ? (va[7] + vb[0]) : (va[0] + vb[15])) & 0xffffff00u) | (hi ? 143u : 240u);
        ck[16] = (okey(hi ? (va[7] + vb[1]) : (va[1] + vb[0])) & 0xffffff00u) | (hi ? 142u : 239u);
        ck[17] = (okey(hi ? (va[8] + vb[0]) : (va[1] + vb[1])) & 0xffffff00u) | (hi ? 127u : 238u);
        ck[18] = (okey(hi ? (va[9] + vb[0]) : (va[1] + vb[2])) & 0xffffff00u) | (hi ? 111u : 237u);
        ck[19] = (okey(hi ? (va[10] + vb[0]) : (va[1] + vb[3])) & 0xffffff00u) | (hi ? 95u : 236u);
        ck[20] = (okey(hi ? (va[11] + vb[0]) : (va[1] + vb[4])) & 0xffffff00u) | (hi ? 79u : 235u);
        ck[21] = (okey(hi ? (va[12] + vb[0]) : (va[1] + vb[5])) & 0xffffff00u) | (hi ? 63u : 234u);
        ck[22] = (okey(hi ? (va[13] + vb[0]) : (va[1] + vb[6])) & 0xffffff00u) | (hi ? 47u : 233u);
        ck[23] = (okey(hi ? (va[14] + vb[0]) : (va[1] + vb[7])) & 0xffffff00u) | (hi ? 31u : 232u);
        ck[24] = (okey(hi ? (va[15] + vb[0]) : (va[2] + vb[0])) & 0xffffff00u) | (hi ? 15u : 223u);
#pragma unroll
        for (int s = 25; s < 32; ++s) ck[s] = 0u;
        SORT16_DESC(ck, 0); SORT16_DESC(ck, 16); TOPMERGE16(ck, 0, 16);
        PARTNER_TOP16(ck);
        const float m = unokey((ck[0] & 0xffffff00u) | 0x80u);
        float l = 0.f;
#pragma unroll
        for (int r = 0; r < 16; ++r) l += __expf(unokey((ck[r] & 0xffffff00u) | 0x80u) - m);
        const float linv = 1.0f / l;
        unsigned p0[4], p1[4];
#pragma unroll
        for (int w = 0; w < 4; ++w) { p0[w] = 0u; p1[w] = 0u;
#pragma unroll
            for (int b = 0; b < 4; ++b) { p0[w] |= (127u - (top[0][4 * w + b] & 127u)) << (8 * b); p1[w] |= (127u - (top[1][4 * w + b] & 127u)) << (8 * b); } }
        int eo[8]; float go[8]; const unsigned hmask = 0u - (unsigned)hi;
#pragma unroll
        for (int rr = 0; rr < 8; ++rr) {
            const unsigned key = ck[rr] ^ ((ck[rr] ^ ck[8 + rr]) & hmask);
            const unsigned flat = 255u - (key & 255u), i = flat >> 4, j = flat & 15u;
            const unsigned wi = (i >> 2) == 0 ? p0[0] : ((i >> 2) == 1 ? p0[1] : ((i >> 2) == 2 ? p0[2] : p0[3]));
            const unsigned wj = (j >> 2) == 0 ? p1[0] : ((j >> 2) == 1 ? p1[1] : ((j >> 2) == 2 ? p1[2] : p1[3]));
            const unsigned i0 = (wi >> ((i & 3u) * 8u)) & 255u, i1 = (wj >> ((j & 3u) * 8u)) & 255u;
            eo[rr] = (int)(i0 * 128u + i1);
            go[rr] = __expf(unokey((key & 0xffffff00u) | 0x80u) - m) * linv;
        }
        int* ep = eidx + (size_t)trow * 128 + h * 16 + 8 * hi; float* gp = gw + (size_t)trow * 128 + h * 16 + 8 * hi;
        typedef int i32x4 __attribute__((ext_vector_type(4)));
        *(i32x4*)ep = (i32x4){eo[0], eo[1], eo[2], eo[3]}; *(i32x4*)(ep + 4) = (i32x4){eo[4], eo[5], eo[6], eo[7]};
        *(f32x4*)gp = (f32x4){go[0], go[1], go[2], go[3]}; *(f32x4*)(gp + 4) = (f32x4){go[4], go[5], go[6], go[7]};
    }
}

#ifndef ATTN_STORE16
#define ATTN_STORE16(p,v) (*(u32x4*)(p)=(v))
#endif
namespace attn_g {
typedef unsigned short bf16;
using bf16x8=__attribute__((ext_vector_type(8)))short;
using s16x4=__attribute__((ext_vector_type(4)))short;
using f32x16=__attribute__((ext_vector_type(16)))float;
using u32x4=__attribute__((ext_vector_type(4)))unsigned;
constexpr int D=64;
constexpr int NW=8,QBLK=32,QB=QBLK*NW,KVBLK=64;
__device__ __forceinline__ int crow(int r,int hi){return (r&3)+8*(r>>2)+4*hi;}
#define SBAR() __builtin_amdgcn_sched_barrier(0)
__device__ __forceinline__ void cmask(f32x16&p0,f32x16&p1,int jb,int qrel,int hi){
  const float NEG=-__builtin_inff(); int kb=64*jb+4*hi;
  #pragma unroll
  for(int r=0;r<16;++r){int kv=kb+(r&3)+8*(r>>2); if(kv>qrel)p0[r]=NEG; if(kv+32>qrel)p1[r]=NEG;}
}

constexpr int NSLOT=3, SLOTB=8192;
constexpr int LDS_K=0, LDS_V=NSLOT*SLOTB, LDS_WS=2*NSLOT*SLOTB, LDS_OST=LDS_WS+NW*64*4, LDS_MSK=LDS_OST+NW*4096, LDS_BYTES=LDS_MSK+NW*2*256;
constexpr float C2=0.125f*1.4426950408889634f;
__device__ __forceinline__ void glds16(const void*gsrc,unsigned lds_dst){unsigned keep;
  asm volatile("s_mov_b32 %0, m0\n\ts_mov_b32 m0, %2\n\ts_nop 0\n\tglobal_load_lds_dwordx4 %1, off\n\ts_mov_b32 m0, %0":"=&s"(keep):"v"(gsrc),"s"(lds_dst):"memory");}
__device__ __forceinline__ void glds16s(const void*sbase,unsigned voff,unsigned lds_dst){unsigned keep;
  asm volatile("s_nop 4\n\ts_mov_b32 %0, m0\n\ts_mov_b32 m0, %3\n\ts_nop 0\n\tglobal_load_lds_dwordx4 %1, %2\n\ts_mov_b32 m0, %0":"=&s"(keep):"v"(voff),"s"(sbase),"s"(lds_dst):"memory");}
__device__ __forceinline__ void glds4s(const void*sbase,unsigned voff,unsigned lds_dst){unsigned keep;
  asm volatile("s_nop 4\n\ts_mov_b32 %0, m0\n\ts_mov_b32 m0, %3\n\ts_nop 0\n\tglobal_load_lds_dword %1, %2\n\ts_mov_b32 m0, %0":"=&s"(keep):"v"(voff),"s"(sbase),"s"(lds_dst):"memory");}
__device__ __forceinline__ unsigned bandw(int e){
  const unsigned a=(e<0)?0u:((e>=31)?0xffffffffu:((2u<<e)-1u)); const int f=e-128; const unsigned b=(f<=0)?0u:((f>=32)?0xffffffffu:((1u<<f)-1u)); return a&~b; }
__device__ __forceinline__ float max3f(float a,float b,float c){float r;asm("v_max3_f32 %0, %1, %2, %3":"=v"(r):"v"(a),"v"(b),"v"(c));return r;}
__device__ __forceinline__ float max2f(float a,float b){float r;asm("v_max_f32_e32 %0, %1, %2":"=v"(r):"v"(a),"v"(b));return r;}
__device__ __forceinline__ float fadd_s(float a,float b){float r;asm("v_add_f32_e32 %0, %1, %2":"=v"(r):"v"(a),"v"(b));return r;}
__device__ __forceinline__ float fsub_s(float a,float b){float r;asm("v_sub_f32_e32 %0, %1, %2":"=v"(r):"v"(a),"v"(b));return r;}
typedef float f32x2_t __attribute__((ext_vector_type(2))); typedef __bf16 bf16x2_t __attribute__((ext_vector_type(2)));
__device__ __forceinline__ unsigned cvtpk_s(float lo,float hi){f32x2_t v={lo,hi};bf16x2_t b=__builtin_convertvector(v,bf16x2_t);return __builtin_bit_cast(unsigned,b);}
#define WAIT_BAR(N) asm volatile("s_waitcnt vmcnt(" #N ") lgkmcnt(0)\n\ts_barrier":::"memory")

template<bool NEGM> __device__ __forceinline__ void qkt(f32x16&p0,f32x16&p1,const char*Kslot,const bf16x8*qr,const f32x16&negm,int r32,int hi){ const f32x16 zc_={};
  const char*kb=Kslot+hi*1024+r32*16;
  #pragma unroll
  for(int d0=0;d0<4;++d0){
    const bf16x8 b0=*reinterpret_cast<const bf16x8*>(kb+d0*2048);
    const bf16x8 b1=*reinterpret_cast<const bf16x8*>(kb+d0*2048+512);
    if(d0==0){p0=__builtin_amdgcn_mfma_f32_32x32x16_bf16(b0,qr[0],NEGM?negm:zc_,0,0,0);p1=__builtin_amdgcn_mfma_f32_32x32x16_bf16(b1,qr[0],NEGM?negm:zc_,0,0,0);}
    else{p0=__builtin_amdgcn_mfma_f32_32x32x16_bf16(b0,qr[d0],p0,0,0,0);p1=__builtin_amdgcn_mfma_f32_32x32x16_bf16(b1,qr[d0],p1,0,0,0);}}
}
typedef __attribute__((address_space(3))) const char* lds_cptr;
typedef short v4i16_t __attribute__((ext_vector_type(4)));
__device__ __forceinline__ void kload8(bf16x8*kf,lds_cptr kp){
  kf[0]=*(const __attribute__((address_space(3))) bf16x8*)(kp);      kf[1]=*(const __attribute__((address_space(3))) bf16x8*)(kp+512);
  kf[2]=*(const __attribute__((address_space(3))) bf16x8*)(kp+2048); kf[3]=*(const __attribute__((address_space(3))) bf16x8*)(kp+2560);
  kf[4]=*(const __attribute__((address_space(3))) bf16x8*)(kp+4096); kf[5]=*(const __attribute__((address_space(3))) bf16x8*)(kp+4608);
  kf[6]=*(const __attribute__((address_space(3))) bf16x8*)(kp+6144); kf[7]=*(const __attribute__((address_space(3))) bf16x8*)(kp+6656);
}
__device__ __forceinline__ void kload2(bf16x8*kf,lds_cptr kp,int j){ kf[2*j]=*(const __attribute__((address_space(3))) bf16x8*)(kp+j*2048); kf[2*j+1]=*(const __attribute__((address_space(3))) bf16x8*)(kp+j*2048+512); }
__device__ __forceinline__ s16x4 vtr(lds_cptr p){ return __builtin_bit_cast(s16x4,__builtin_amdgcn_ds_read_tr16_b64_v4i16((__attribute__((address_space(3))) v4i16_t*)p)); }
__device__ __forceinline__ float rowmax(const f32x16&p0,const f32x16&p1){
  float a=max3f(p0[0],p0[1],p1[0]),b=max3f(p0[2],p0[3],p1[1]);a=max3f(a,p1[2],p1[3]);
  #pragma unroll
  for(int r=4;r<16;r+=4){a=max3f(a,p0[r],p0[r+1]);b=max3f(b,p0[r+2],p0[r+3]);a=max3f(a,p1[r],p1[r+1]);b=max3f(b,p1[r+2],p1[r+3]);}
  const float m=max2f(a,b);
  auto rr=__builtin_amdgcn_permlane32_swap(__float_as_uint(m),__float_as_uint(m),false,false);
  return max2f(__uint_as_float(rr[0]),__uint_as_float(rr[1]));
}
__device__ __forceinline__ void pv(f32x16*o,int vb,bf16x8 pa0,bf16x8 pa1,bf16x8 pa2,bf16x8 pa3){
  #pragma unroll
  for(int d0=0;d0<2;++d0){s16x4 lo[4],hi[4];
    #pragma unroll
    for(int ks=0;ks<4;++ks){
      asm volatile("ds_read_b64_tr_b16 %0,%1 offset:%c2":"=&v"(lo[ks]):"v"(vb),"i"(d0*4096+ks*1024):"memory");
      asm volatile("ds_read_b64_tr_b16 %0,%1 offset:%c2":"=&v"(hi[ks]):"v"(vb),"i"(d0*4096+ks*1024+512):"memory");}
    asm volatile("s_waitcnt lgkmcnt(0)":::"memory");SBAR();
    #define PK(k) (bf16x8){lo[k][0],lo[k][1],lo[k][2],lo[k][3],hi[k][0],hi[k][1],hi[k][2],hi[k][3]}
    o[d0]=__builtin_amdgcn_mfma_f32_32x32x16_bf16(pa0,PK(0),o[d0],0,0,0);
    o[d0]=__builtin_amdgcn_mfma_f32_32x32x16_bf16(pa1,PK(1),o[d0],0,0,0);
    o[d0]=__builtin_amdgcn_mfma_f32_32x32x16_bf16(pa2,PK(2),o[d0],0,0,0);
    o[d0]=__builtin_amdgcn_mfma_f32_32x32x16_bf16(pa3,PK(3),o[d0],0,0,0);
    #undef PK
  }
}

#ifndef ATTN_STORE16
#define ATTN_STORE16(p,v) (*(u32x4*)(p)=(v))
#endif
template<int MODE,int THRL> __device__ __forceinline__ void attn_unit(const bf16*Qu,long qs,const bf16*__restrict__ Kh,const bf16*__restrict__ Vh,long kvs,bf16*Ou,long os,float*lse,long lses,const int NT,
    const unsigned*selp,const char*Msrc,const int e0,char*shm){
  constexpr bool USE_NEGM=(MODE==0);
  const int tid=tidx(),lane=tid&63,r32=lane&31,hi=lane>>5; const int wid=__builtin_amdgcn_readfirstlane(tid>>6);
  const bf16*Qw=Qu+(long)(wid*QBLK)*qs;
  const unsigned lds0=(unsigned)(uintptr_t)shm;
  float*wsf=(float*)(shm+LDS_WS)+wid*64;
  const unsigned kvoff=(unsigned)(((int)lane*(int)kvs+wid*8)*2);
  const unsigned vvoff=(unsigned)(((16*(wid&3)+(lane>>2))*(int)kvs+(wid>>2)*32+(lane&3)*8)*2);
  const unsigned kdst=lds0+LDS_K+wid*1024, vdst=lds0+LDS_V+wid*1024;
  #define KT(t) ((MODE==0)?(((t)<4)?(NT-4+(t)):((t)-4)):(t))
  #define DMA_K(t,slot) glds16s((const char*)Kh+(long)KT(t)*(KVBLK*2)*kvs,kvoff,(unsigned)__builtin_amdgcn_readfirstlane(kdst+(slot)))
  #define DMA_V(t,slot) glds16s((const char*)Vh+(long)KT(t)*(KVBLK*2)*kvs,vvoff,(unsigned)__builtin_amdgcn_readfirstlane(vdst+(slot)))
  const unsigned mvoff=(unsigned)((wid*QBLK)*8+lane*4); const unsigned mdst=lds0+LDS_MSK+wid*512;
  #define DMA_M(t) do{ if(MODE==1) glds4s(Msrc+(long)(t)*(8192*8),mvoff,(unsigned)__builtin_amdgcn_readfirstlane(mdst+((t)&1)*256)); }while(0)
  const int vb0=(int)(lds0+LDS_V)+((lane>>4)&1)*32+(lane&3)*8+(4*hi+((lane&15)>>2))*64;
  const char*Kbase=shm+LDS_K; bf16x8 kf[8];
  const lds_cptr shm3=(lds_cptr)shm; const lds_cptr kp0=shm3+LDS_K+hi*1024+r32*16; const lds_cptr vp0=shm3+LDS_V+((lane>>4)&1)*32+(lane&3)*8+(4*hi+((lane&15)>>2))*64;
  DMA_M(0);DMA_M(1);
  DMA_K(0,0);DMA_V(0,0);DMA_K(1,SLOTB);
  bf16x8 qr[4];
  #pragma unroll
  for(int d0=0;d0<4;++d0)qr[d0]=*reinterpret_cast<const bf16x8*>(&Qw[(long)r32*qs+d0*16+hi*8]);
  unsigned selw=0u; if(MODE==0) selw=selp[(long)(wid*QBLK+r32)*8];
  float mhat=0.f,l_reg=0.f;f32x16 o[2];f32x16 negm; { float zz_=0.f; asm volatile("":"+v"(zz_));
    _Pragma("unroll") for(int r=0;r<16;++r){o[0][r]=zz_;o[1][r]=zz_;negm[r]=zz_;} } if(USE_NEGM) asm volatile("":"+v"(negm));
  const int qrel=wid*QBLK+r32;
  #define CMASK(P0,P1,t) do{ const float NEG_=-__builtin_inff(); \
    if(MODE==0){ if((t)<4){cmask(P0,P1,(t),qrel,hi);} else { const unsigned n_=(unsigned)(((t)-4)>>2); const bool ok_=(n_==(selw&255u))|(n_==((selw>>8)&255u))|(n_==((selw>>16)&255u)); \
        _Pragma("unroll") for(int r=0;r<16;++r){P0[r]=ok_?P0[r]:NEG_;P1[r]=ok_?P1[r]:NEG_;} } } \
    else if(MODE==1){ const unsigned long long mw_=*(const __attribute__((address_space(3))) unsigned long long*)(shm3+LDS_MSK+wid*512+((t)&1)*256+r32*8); \
        const unsigned lo_=((unsigned)mw_)>>(4*hi), hh_=((unsigned)(mw_>>32))>>(4*hi); \
        _Pragma("unroll") for(int r=0;r<16;++r){ const unsigned bit_=1u<<((r&3)+8*(r>>2)); P0[r]=(lo_&bit_)?(P0[r]-mhat):NEG_; P1[r]=(hh_&bit_)?(P1[r]-mhat):NEG_; } } \
    else { const int e_=e0-64*(t)+qrel-4*hi; const unsigned lo_=bandw(e_), hh_=bandw(e_-32);     \
        _Pragma("unroll") for(int r=0;r<16;++r){ const unsigned bit_=1u<<((r&3)+8*(r>>2)); P0[r]=(lo_&bit_)?(P0[r]-mhat):NEG_; P1[r]=(hh_&bit_)?(P1[r]-mhat):NEG_; } } }while(0)
  bool resc=false;
  #define START(P0,P1) do{ const float rm=rowmax(P0,P1); resc=false; \
    { const float dl=(rm<-1e30f)?0.f:rm; mhat=fadd_s(mhat,dl); \
      _Pragma("unroll") for(int r=0;r<16;++r){P0[r]=fsub_s(P0[r],dl);P1[r]=fsub_s(P1[r],dl);} \
      if(USE_NEGM){ _Pragma("unroll") for(int r=0;r<16;++r)negm[r]=-mhat; asm volatile("":"+v"(negm)); } } \
    _Pragma("unroll") for(int r=0;r<16;++r)P0[r]=__builtin_amdgcn_exp2f(P0[r]); }while(0)
  #define RESC() do{ if(resc){ asm volatile("s_waitcnt lgkmcnt(0)":::"memory"); \
      _Pragma("unroll") for(int d_=0;d_<2;++d_) _Pragma("unroll") for(int r=0;r<16;++r)o[d_][r]*=wsf[crow(r,hi)]; } }while(0)
  f32x16 pA0,pA1,pB0,pB1; const f32x16 zc16={};
  int sl_prev=0,sl_cur=0,sl_next=SLOTB;
  #define ROT() do{sl_prev=sl_cur;sl_cur=sl_next;sl_next=(sl_next==(NSLOT-1)*SLOTB)?0:sl_next+SLOTB;}while(0)
  DMA_K(2,2*SLOTB);
  WAIT_BAR(3);
  qkt<USE_NEGM>(pA0,pA1,Kbase,qr,negm,r32,hi);asm volatile("s_nop 15\n\ts_nop 7":"+v"(pA0),"+v"(pA1));CMASK(pA0,pA1,0);
  START(pA0,pA1);
  _Pragma("unroll") for(int r=0;r<16;++r)pA1[r]=__builtin_amdgcn_exp2f(pA1[r]);
  WAIT_BAR(0);
  DMA_K(3,0);DMA_V(1,SLOTB);
  ROT();
  kload8(kf,kp0+sl_cur);
  WAIT_BAR(2);
  s16x4 vlo[8],vhi[8]; u32x4 pw0,pw1,pw2,pw3;
  #define PKW(P,B) cvtpk_s(P[B],P[B+1])
  #define PAF(k) __builtin_bit_cast(bf16x8,pw##k)
  #define VFR(i) (bf16x8){vlo[i][0],vlo[i][1],vlo[i][2],vlo[i][3],vhi[i][0],vhi[i][1],vhi[i][2],vhi[i][3]}
  #define PIN(x) asm volatile("":"+v"(x))
  #define MX3(a,b,c) __builtin_fmaxf(__builtin_fmaxf((a),(b)),(c))
  #define GAPA(MF,A0,A1,A2,A3,W0,W1,PW) do{ MF; sacc+=A0; sacc+=A1; sacc+=A2; sacc+=A3; PIN(sacc); W0; W1; PIN(PW); SBAR(); }while(0)
  #define EX(v) __builtin_amdgcn_exp2f(v)
  #define GAPB(MF,X,B) do{ MF; X[B]=EX(X[B]); X[B+1]=EX(X[B+1]); X[B+2]=EX(X[B+2]); X[B+3]=EX(X[B+3]); PIN(X); SBAR(); }while(0)
  #define VRD(i) do{ vlo[i]=vtr(vp_+(((i)>>2)*4096+((i)&3)*1024)); vhi[i]=vtr(vp_+(((i)>>2)*4096+((i)&3)*1024+512)); }while(0)
  #define KRD(G,j) do{ if(G){ kload2(kf,kp0+sl_next,j); SBAR(); } }while(0)
    \
  #define LIVE2(tt) ((64*(tt)<=e0+32*wid+31)&&(64*(tt)+63>=e0+32*wid-128))
  #define STEP(C0,C1,P0,P1,t,GK,GV,GL) do{ SBAR(); if((t)+1<NT){DMA_M((t)+1);} \
    if((MODE==2)&&!LIVE2(t)&&!LIVE2((t)-1)){ \
      if(GK){DMA_K((t)+3,sl_cur);} if(GV){DMA_V((t)+1,sl_next);} \
      KRD(GL,0); KRD(GL,1); KRD(GL,2); KRD(GL,3); \
      _Pragma("unroll") for(int r=0;r<16;++r){C0[r]=0.f;C1[r]=0.f;} resc=false; \
    } else { \
    const lds_cptr vp_=vp0+sl_prev; \
    VRD(0); SBAR(); float sacc=(P0[0]+P0[1]); \
    GAPA(C0=__builtin_amdgcn_mfma_f32_32x32x16_bf16(kf[0],qr[0],USE_NEGM?negm:zc16,0,0,0), P0[2],P0[3],P0[4],P0[5],     pw0[0]=PKW(P0,0), pw0[1]=PKW(P0,2), pw0); \
    VRD(4); SBAR(); GAPA(C1=__builtin_amdgcn_mfma_f32_32x32x16_bf16(kf[1],qr[0],USE_NEGM?negm:zc16,0,0,0), P0[6],P0[7],P0[8],P0[9],     pw0[2]=PKW(P0,4), pw0[3]=PKW(P0,6), pw0); \
    VRD(1); SBAR(); GAPA(C0=__builtin_amdgcn_mfma_f32_32x32x16_bf16(kf[2],qr[1],C0,0,0,0),   P0[10],P0[11],P0[12],P0[13], pw1[0]=PKW(P0,8), pw1[1]=PKW(P0,10), pw1); \
    VRD(5); SBAR(); GAPA(C1=__builtin_amdgcn_mfma_f32_32x32x16_bf16(kf[3],qr[1],C1,0,0,0),   P0[14],P0[15],P1[0],P1[1],   pw1[2]=PKW(P0,12),pw1[3]=PKW(P0,14), pw1); \
    VRD(2); SBAR(); GAPA(C0=__builtin_amdgcn_mfma_f32_32x32x16_bf16(kf[4],qr[2],C0,0,0,0),   P1[2],P1[3],P1[4],P1[5],     pw2[0]=PKW(P1,0), pw2[1]=PKW(P1,2), pw2); \
    VRD(6); SBAR(); GAPA(C1=__builtin_amdgcn_mfma_f32_32x32x16_bf16(kf[5],qr[2],C1,0,0,0),   P1[6],P1[7],P1[8],P1[9],     pw2[2]=PKW(P1,4), pw2[3]=PKW(P1,6), pw2); \
    VRD(3); SBAR(); GAPA(C0=__builtin_amdgcn_mfma_f32_32x32x16_bf16(kf[6],qr[3],C0,0,0,0),   P1[10],P1[11],P1[12],P1[13], pw3[0]=PKW(P1,8), pw3[1]=PKW(P1,10), pw3); \
    VRD(7); SBAR(); GAPA(C1=__builtin_amdgcn_mfma_f32_32x32x16_bf16(kf[7],qr[3],C1,0,0,0),   P1[14],P1[15],0.f,0.f,       pw3[2]=PKW(P1,12),pw3[3]=PKW(P1,14), pw3); \
    l_reg+=sacc; \
    if(GK){DMA_K((t)+3,sl_cur);} if(GV){DMA_V((t)+1,sl_next);} \
    CMASK(C0,C1,t); \
    { float a=MX3(C0[0],C0[1],C1[0]),b=MX3(C0[2],C0[3],C1[1]); a=MX3(a,C1[2],C1[3]); \
      _Pragma("unroll") for(int r=4;r<16;r+=4){a=MX3(a,C0[r],C0[r+1]);b=MX3(b,C0[r+2],C0[r+3]);a=MX3(a,C1[r],C1[r+1]);b=MX3(b,C1[r+2],C1[r+3]);} \
      float rm=__builtin_fmaxf(a,b); { auto rr=__builtin_amdgcn_permlane32_swap(__float_as_uint(rm),__float_as_uint(rm),false,false); rm=__builtin_fmaxf(__uint_as_float(rr[0]),__uint_as_float(rr[1])); } \
      resc=false; \
      if(__builtin_expect(__any(rm>(float)THRL),0)){ const float dl=__builtin_fmaxf(rm,0.f); mhat+=dl; \
        _Pragma("unroll") for(int r=0;r<16;++r){C0[r]-=dl;C1[r]-=dl;} \
        if(USE_NEGM){ _Pragma("unroll") for(int r=0;r<16;++r)negm[r]=-mhat; asm volatile("":"+v"(negm)); } \
        const float f=__builtin_amdgcn_exp2f(-dl); l_reg*=f; if(hi==0)wsf[r32]=f; resc=true; } } \
    SBAR(); \
    GAPB(o[0]=__builtin_amdgcn_mfma_f32_32x32x16_bf16(PAF(0),VFR(0),o[0],0,0,0), C0,0); \
    GAPB(o[1]=__builtin_amdgcn_mfma_f32_32x32x16_bf16(PAF(0),VFR(4),o[1],0,0,0), C0,4); \
    KRD(GL,0); GAPB(o[0]=__builtin_amdgcn_mfma_f32_32x32x16_bf16(PAF(1),VFR(1),o[0],0,0,0), C0,8); \
    KRD(GL,1); GAPB(o[1]=__builtin_amdgcn_mfma_f32_32x32x16_bf16(PAF(1),VFR(5),o[1],0,0,0), C0,12); \
    KRD(GL,2); GAPB(o[0]=__builtin_amdgcn_mfma_f32_32x32x16_bf16(PAF(2),VFR(2),o[0],0,0,0), C1,0); \
    KRD(GL,3); GAPB(o[1]=__builtin_amdgcn_mfma_f32_32x32x16_bf16(PAF(2),VFR(6),o[1],0,0,0), C1,4); \
    GAPB(o[0]=__builtin_amdgcn_mfma_f32_32x32x16_bf16(PAF(3),VFR(3),o[0],0,0,0), C1,8); \
    GAPB(o[1]=__builtin_amdgcn_mfma_f32_32x32x16_bf16(PAF(3),VFR(7),o[1],0,0,0), C1,12); \
    } }while(0)
  int t=1;
  for(;t+5<NT;t+=2){
    STEP(pB0,pB1,pA0,pA1,t,true,true,true);     WAIT_BAR(2); RESC(); ROT();
    STEP(pA0,pA1,pB0,pB1,t+1,true,true,true);   WAIT_BAR(2); RESC(); ROT();
  }
  #define ENDW(tt) do{ if((tt)+3<NT){WAIT_BAR(2);} else if((tt)+2<NT){WAIT_BAR(1);} else {WAIT_BAR(0);} }while(0)
  for(;t+1<NT;t+=2){
    STEP(pB0,pB1,pA0,pA1,t,(t+3<NT),(t+1<NT),(t+1<NT));       ENDW(t);   RESC(); ROT();
    STEP(pA0,pA1,pB0,pB1,t+1,(t+4<NT),(t+2<NT),(t+2<NT));     ENDW(t+1); RESC(); ROT();
  }
  STEP(pB0,pB1,pA0,pA1,NT-1,false,false,false); RESC();
  { float sacc=pB0[0]+pB0[1]; _Pragma("unroll") for(int r=2;r<16;++r)sacc+=pB0[r]; _Pragma("unroll") for(int r=0;r<16;++r)sacc+=pB1[r]; l_reg+=sacc;
    pw0=(u32x4){PKW(pB0,0),PKW(pB0,2),PKW(pB0,4),PKW(pB0,6)};pw1=(u32x4){PKW(pB0,8),PKW(pB0,10),PKW(pB0,12),PKW(pB0,14)};pw2=(u32x4){PKW(pB1,0),PKW(pB1,2),PKW(pB1,4),PKW(pB1,6)};pw3=(u32x4){PKW(pB1,8),PKW(pB1,10),PKW(pB1,12),PKW(pB1,14)};
    SBAR(); pv(o,vb0+sl_cur,PAF(0),PAF(1),PAF(2),PAF(3)); }
  #undef PKW
  #undef PAF
  #undef VFR
  #undef PIN
  #undef MX3
  #undef GAPA
  #undef GAPB
  #undef EX
  #undef VRD
  #undef KRD
  #undef STEP
  #undef LIVE2
  #undef ENDW
  {auto rr=__builtin_amdgcn_permlane32_swap(__float_as_uint(l_reg),__float_as_uint(l_reg),false,false);l_reg=__uint_as_float(rr[0])+__uint_as_float(rr[1]);}
  if(hi==0)wsf[32+r32]=l_reg;asm volatile("s_waitcnt lgkmcnt(0)":::"memory");
  float rli[16];
  #pragma unroll
  for(int r=0;r<16;++r)rli[r]=__builtin_amdgcn_rcpf(wsf[32+crow(r,hi)]);
  long os2=os,lses2=lses; asm volatile("":"+s"(os2),"+s"(lses2));
  if(lse!=nullptr && hi==0) lse[(long)(wid*QBLK+r32)*lses2]=mhat+__log2f(l_reg);
  bf16*Ow=Ou+(long)(wid*QBLK)*os2;
  { bf16*stg=(bf16*)(shm+LDS_OST)+wid*2048;
    #pragma unroll
    for(int r=0;r<16;++r){const int orow=crow(r,hi);
      #pragma unroll
      for(int d0=0;d0<2;++d0)stg[orow*64+d0*32+r32]=(bf16)f2bf(o[d0][r]*rli[r]);}
    asm volatile("s_waitcnt lgkmcnt(0)":::"memory");
    #pragma unroll
    for(int i=0;i<4;++i){const int row=i*8+(lane>>3),ch=lane&7; const u32x4 v=*(const u32x4*)(stg+row*64+ch*8); ATTN_STORE16(Ow+(long)row*os2+ch*8,v);} }
  asm volatile("s_waitcnt lgkmcnt(0)\n\ts_barrier":::"memory");
  #undef DMA_K
  #undef DMA_V
  #undef DMA_M
  #undef KT
  #undef CMASK
  #undef START
  #undef RESC
  #undef ROT
}
constexpr int ATTN_LDS_BYTES=LDS_BYTES;
#undef SBAR
#undef WAIT_BAR
}

__device__ __forceinline__ int vcu_of(int G, int bx) { return (G % 8 == 0) ? (bx % 8) * (G / 8) + bx / 8 : bx; }
__device__ __forceinline__ void ph_attn_moba(const bf16* QKV, const unsigned* SEL, bf16* O, unsigned char* smem) {
    const int G = (int)gridDim.x, vcu = vcu_of(G, bidx());
#pragma unroll 1
    for (int idx = 2 * vcu; idx < 512; idx += ((idx & 1) ? 2 * G - 1 : 1)) {
        const int bh = idx >> 5, j = idx & 31, qb = (j & 1) ? 31 - (j >> 1) : (j >> 1), b = bh >> 3, h = bh & 7;
        const long row0 = (long)b * SEQ + 256 * qb, kv0 = (long)b * SEQ * AB_LD;
        attn_g::attn_unit<0, 8>(QKV + row0 * AB_LD + CQA + h * 64, AB_LD, QKV + kv0 + CKA + h * 64, QKV + kv0 + CVA + h * 64, AB_LD, O + row0 * DM + h * 64, DM, nullptr, 0, 4 * qb + 4,
                                SEL + row0 * 8 + h, nullptr, 0, (char*)smem);
    }
}


__device__ __forceinline__ void ph_attn_dsa(const bf16* QKV, const unsigned long long* MASK, bf16* O, unsigned char* smem) {
    const int G = (int)gridDim.x, vcu = vcu_of(G, bidx());
#pragma unroll 1
    for (int idx = 2 * vcu; idx < 512; idx += ((idx & 1) ? 2 * G - 1 : 1)) {
        const int bh = idx >> 5, j = idx & 31, qb = (j & 1) ? 31 - (j >> 1) : (j >> 1), b = bh >> 3, h = bh & 7;
        const long row0 = (long)b * SEQ + 256 * qb, kv0 = (long)b * SEQ * AB_LD;
        attn_g::attn_unit<1, 8>(QKV + row0 * AB_LD + CQB + h * 64, AB_LD, QKV + kv0 + CKB + h * 64, QKV + kv0 + CVB + h * 64, AB_LD, O + row0 * DM + 512 + h * 64, DM, nullptr, 0, 4 * qb + 4,
                                nullptr, (const char*)(MASK + (size_t)b * 128 * SEQ + 256 * qb), 0, (char*)smem);
    }
}
__device__ __forceinline__ void ph_attn_dilated(const bf16* QKV1, bf16* OG, float* LSE, unsigned char* smem) {
    const int G = (int)gridDim.x, vcu = vcu_of(G, bidx());
#pragma unroll 1
    for (int u = vcu; u < 3072; u += G) {
        const int g = u >> 10, bh = (u >> 5) & 31, j = u & 31, b = bh >> 4, h = bh & 15;
        const int lg = 2 * g, dil = 1 << lg, per = 32 >> lg;
        const int res = j / per, mb = j % per, m0 = 256 * mb, mk0 = (mb == 0) ? 0 : m0 - 128, nt = (m0 + 256 - mk0) / 64;
        const long qrow = (long)b * SEQ + res + (long)dil * m0, krow = (long)b * SEQ + res + (long)dil * mk0;
        attn_g::attn_unit<2, 8>(QKV1 + qrow * C_LD + h * 64, (long)dil * C_LD, QKV1 + krow * C_LD + 1024 + h * 64, QKV1 + krow * C_LD + 2048 + h * 64, (long)dil * C_LD,
                                OG + ((size_t)g * T + qrow) * DM + h * 64, (long)dil * DM, LSE + ((size_t)g * T + qrow) * 16 + h, (long)dil * 16, nt, nullptr, nullptr, m0 - mk0, (char*)smem);
    }
}


__device__ __forceinline__ float okf(float f) { return __builtin_bit_cast(float, okey(f)); }
__device__ __forceinline__ int score_pitch(int qb) { return 256 * (qb + 1) + 64; }
__device__ __forceinline__ size_t score_base(int b, int qb) { return (size_t)b * 35127296 + (size_t)65536 * (size_t)((qb * (qb + 1)) / 2) + (size_t)16384 * qb; }
__device__ __forceinline__ void ph_dsa_score(const bf16* QKV, float* S, unsigned char* smem) {
    using attn_g::bf16x8; using attn_g::f32x16;
    typedef __attribute__((address_space(3))) const char* lcp;
    const int tid = tidx(), lane = tid & 63, r32 = lane & 31, hi = lane >> 5; const int wid = __builtin_amdgcn_readfirstlane(tid >> 6);
    const unsigned lds0 = (unsigned)(uintptr_t)smem;
    const unsigned kvoff = (unsigned)((lane * AB_LD + wid * 8) * 2);
#pragma unroll 1
    for (int item = bidx(); item < 544; item += (int)gridDim.x) {
        const int b = item / 272; int rr = item % 272, qb = 0;
#pragma unroll 1
        for (;;) { const int nc = (qb + 2) >> 1; if (rr < nc) break; rr -= nc; ++qb; }
        const int t0 = 8 * rr, t1 = min(t0 + 8, 4 * qb + 4);
        const bf16* qrow = QKV + ((size_t)b * SEQ + 256 * qb + wid * 32 + r32) * AB_LD;
        bf16x8 qr[4][4]; float w[4];
#pragma unroll
        for (int h = 0; h < 4; ++h) { w[h] = bf2f(qrow[CWI + h]);
#pragma unroll
            for (int d0 = 0; d0 < 4; ++d0) qr[h][d0] = *(const bf16x8*)(qrow + CQI + h * 64 + d0 * 16 + hi * 8); }
        const char* kbase = (const char*)(QKV + (size_t)b * SEQ * AB_LD + CKI);
        const int rowlen = score_pitch(qb); float* sblk = S + score_base(b, qb) + (size_t)(wid * 32) * rowlen;
#define SC_DMA(t) attn_g::glds16s(kbase + (size_t)(t) * (64 * AB_LD * 2), kvoff, (unsigned)__builtin_amdgcn_readfirstlane(lds0 + (((t) - t0) & 1) * 8192 + wid * 1024))
        SC_DMA(t0);
        asm volatile("s_waitcnt vmcnt(0) lgkmcnt(0)\n\ts_barrier" ::: "memory");
#pragma unroll 1
        for (int t = t0; t < t1; ++t) {
            if (t + 1 < t1) SC_DMA(t + 1);
            const lcp kb = (lcp)smem + ((t - t0) & 1) * 8192 + hi * 1024 + r32 * 16;
            bf16x8 kf[4][2];
#pragma unroll
            for (int d0 = 0; d0 < 4; ++d0) { kf[d0][0] = *(const __attribute__((address_space(3))) bf16x8*)(kb + d0 * 2048); kf[d0][1] = *(const __attribute__((address_space(3))) bf16x8*)(kb + d0 * 2048 + 512); }
            f32x16 sc0, sc1;
#pragma unroll
            for (int r = 0; r < 16; ++r) { sc0[r] = 0.f; sc1[r] = 0.f; }
#pragma unroll
            for (int h = 0; h < 4; ++h) {
                f32x16 p0 = {}, p1 = {};
#pragma unroll
                for (int d0 = 0; d0 < 4; ++d0) { p0 = __builtin_amdgcn_mfma_f32_32x32x16_bf16(kf[d0][0], qr[h][d0], p0, 0, 0, 0); p1 = __builtin_amdgcn_mfma_f32_32x32x16_bf16(kf[d0][1], qr[h][d0], p1, 0, 0, 0); }
#pragma unroll
                for (int r = 0; r < 16; ++r) { sc0[r] = fmaf(w[h], fmaxf(p0[r], 0.f), sc0[r]); sc1[r] = fmaf(w[h], fmaxf(p1[r], 0.f), sc1[r]); }
                __builtin_amdgcn_sched_barrier(0);
            }
            {   typedef __attribute__((address_space(3))) f32x4* lf4;
                const lf4 wr = (lf4)((__attribute__((address_space(3))) char*)smem + 16384 + wid * 8704 + r32 * 272 + hi * 16);
#pragma unroll
                for (int g = 0; g < 4; ++g) {
                    wr[2 * g] = (f32x4){okf(sc0[4 * g]), okf(sc0[4 * g + 1]), okf(sc0[4 * g + 2]), okf(sc0[4 * g + 3])}; wr[2 * g + 8] = (f32x4){okf(sc1[4 * g]), okf(sc1[4 * g + 1]), okf(sc1[4 * g + 2]), okf(sc1[4 * g + 3])}; }
                const int ln2 = tidx() & 63;
                const lf4 rd = (lf4)((__attribute__((address_space(3))) char*)smem + 16384 + wid * 8704 + (ln2 >> 4) * 272 + (ln2 & 15) * 16);
                float* gp = sblk + (size_t)(ln2 >> 4) * rowlen + 64 * t + 4 * (ln2 & 15);
#pragma unroll
                for (int i = 0; i < 8; ++i) { const f32x4 vv = rd[i * 68]; *(f32x4*)(gp + (size_t)(4 * i) * rowlen) = vv; }
            }
            asm volatile("s_waitcnt vmcnt(8) lgkmcnt(0)\n\ts_barrier" ::: "memory");
        }
#undef SC_DMA
    }
}
#define RS_PASS(SHIFT, PMASK, PVAL) do { \
    _Pragma("unroll") for (int i_ = 0; i_ < 16; ++i_) *(LAS u32x4g*)(hist + 4 * (lane + 64 * i_)) = (u32x4g){0u, 0u, 0u, 0u}; \
    _Pragma("unroll") for (int g_ = 0; g_ < 8; ++g_) if (g_ * 1024 < n) { \
        _Pragma("unroll") for (int j_ = 16 * g_; j_ < 16 * g_ + 16; ++j_) { const unsigned k_ = v[j_]; const bool mt_ = (k_ & (PMASK)) == (PVAL); \
            if ((PMASK) == 0u || __ballot(mt_) != 0ull) { \
                if (mt_) __hip_atomic_fetch_add(hist + (((k_ >> (SHIFT)) & 255u) * 16u + (unsigned)(lane & 15)), 1u, __ATOMIC_RELAXED, __HIP_MEMORY_SCOPE_WORKGROUP); } } } \
    unsigned c_[4]; \
    _Pragma("unroll") for (int b_ = 0; b_ < 4; ++b_) { u32x4g q_ = *(const LAS u32x4g*)(hist + 64 * lane + 16 * b_); \
        _Pragma("unroll") for (int i_ = 1; i_ < 4; ++i_) { const u32x4g r_ = *(const LAS u32x4g*)(hist + 64 * lane + 16 * b_ + 4 * i_); q_ += r_; } \
        c_[b_] = (q_[0] + q_[1]) + (q_[2] + q_[3]); } \
    const unsigned tot_ = (c_[0] + c_[1]) + (c_[2] + c_[3]); \
    unsigned inc_ = tot_;                         \
    _Pragma("unroll") for (int o_ = 1; o_ < 64; o_ <<= 1) { const unsigned t_ = (unsigned)bperm((lane + o_) & 63, (int)inc_); if (lane + o_ < 64) inc_ += t_; } \
    const unsigned suf_ = inc_ - tot_;            \
    const unsigned long long hit_ = __ballot(suf_ < need && need <= inc_); \
    const int L_ = (int)__builtin_ctzll(hit_); \
    unsigned run_ = suf_, bsel_ = 0u, cg_ = 0u, ce_ = 0u; bool done_ = false; \
    _Pragma("unroll") for (int i_ = 3; i_ >= 0; --i_) { if (!done_ && run_ + c_[i_] >= need) { bsel_ = (unsigned)(4 * lane + i_); cg_ = run_; ce_ = c_[i_]; done_ = true; } run_ += c_[i_]; } \
    bsel = (unsigned)__builtin_amdgcn_readlane((int)bsel_, L_); need -= (unsigned)__builtin_amdgcn_readlane((int)cg_, L_); ceq = (unsigned)__builtin_amdgcn_readlane((int)ce_, L_); } while (0)
__device__ __forceinline__ void ph_dsa_select_opt(const float* S, unsigned long long* mask, unsigned char* smem) {
    const int tid = tidx(), lane = tid & 63, wave = tid >> 6;
    LAS unsigned* hist = (LAS unsigned*)((LAS unsigned char*)smem + wave * 16384);
    const int gwv = bidx() * (NT / 64) + wave, ngw = (int)gridDim.x * (NT / 64);
#pragma unroll 1
    for (int t = T - 1 - gwv; t >= 0; t -= ngw) {
        const int b = t / SEQ, tt = t % SEQ, n = tt + 1, qb = tt >> 8;
        const float* row = S + score_base(b, qb) + (size_t)(tt & 255) * score_pitch(qb) + 4 * lane;
        unsigned v[128];
#pragma unroll
        for (int g = 0; g < 8; ++g) {
            if (g * 1024 < n) {
#pragma unroll
                for (int j = 4 * g; j < 4 * g + 4; ++j) { const u32x4g q = *(const u32x4g*)(row + 256 * j); v[4 * j] = q[0]; v[4 * j + 1] = q[1]; v[4 * j + 2] = q[2]; v[4 * j + 3] = q[3]; }
            } else {
#pragma unroll
                for (int j = 16 * g; j < 16 * g + 16; ++j) v[j] = 0u;
            }
        }
        asm volatile("" ::: "memory");
#pragma unroll
        for (int g = 0; g < 8; ++g) {
            if (g * 1024 < n && (g + 1) * 1024 > n) {
#pragma unroll
                for (int j = 16 * g; j < 16 * g + 16; ++j) { const int kv = 256 * (j >> 2) + 4 * lane + (j & 3); v[j] = (kv < n) ? v[j] : 0u; }
            }
        }
        unsigned thr = 0u, need = 256u, ceq = 0u;
        if (n > 256) {
            unsigned bsel;
            RS_PASS(24, 0u, 0u);                 thr = bsel << 24;
            RS_PASS(16, 0xff000000u, thr);       thr |= bsel << 16;
            RS_PASS(8, 0xffff0000u, thr);        thr |= bsel << 8;
            RS_PASS(0, 0xffffff00u, thr);        thr |= bsel;
        }
        const int ntile = 4 * (qb + 1);
        const bool ties = (n > 256) && (ceq != need);
        unsigned taken = 0u;
        unsigned long long* mrow = mask + (size_t)b * 128 * SEQ + tt;
#pragma unroll
        for (int j = 0; j < 32; ++j) {
            if (4 * j < ntile) {
                unsigned nib = 0u;
                if (n <= 256) {
#pragma unroll
                    for (int i = 0; i < 4; ++i) nib |= ((256 * j + 4 * lane + i) < n) ? (1u << i) : 0u;
                } else if (!ties) {
#pragma unroll
                    for (int i = 0; i < 4; ++i) nib |= (v[4 * j + i] >= thr) ? (1u << i) : 0u;
                } else {
                    bool eq[4]; unsigned long long em[4]; unsigned long long any = 0ull;
#pragma unroll
                    for (int i = 0; i < 4; ++i) { nib |= (v[4 * j + i] > thr) ? (1u << i) : 0u; eq[i] = (v[4 * j + i] == thr) && ((256 * j + 4 * lane + i) < n); em[i] = __ballot(eq[i]); any |= em[i]; }
                    if (any != 0ull) {
                        const unsigned long long ltm = (1ull << lane) - 1ull;
                        unsigned below = taken, tot = 0u;
#pragma unroll
                        for (int i = 0; i < 4; ++i) { below += (unsigned)__popcll(em[i] & ltm); tot += (unsigned)__popcll(em[i]); }
#pragma unroll
                        for (int i = 0; i < 4; ++i) { if (eq[i]) { if (below < need) nib |= (1u << i); ++below; } }
                        taken += tot;
                    }
                }
                const unsigned sh = 4u * (unsigned)(lane & 15);
                unsigned lo = (sh < 32u) ? (nib << sh) : 0u, hiw = (sh >= 32u) ? (nib << (sh - 32u)) : 0u;
                lo |= (unsigned)__builtin_amdgcn_update_dpp(0, (int)lo, 0x121, 0xf, 0xf, true); hiw |= (unsigned)__builtin_amdgcn_update_dpp(0, (int)hiw, 0x121, 0xf, 0xf, true);
                lo |= (unsigned)__builtin_amdgcn_update_dpp(0, (int)lo, 0x122, 0xf, 0xf, true); hiw |= (unsigned)__builtin_amdgcn_update_dpp(0, (int)hiw, 0x122, 0xf, 0xf, true);
                lo |= (unsigned)__builtin_amdgcn_update_dpp(0, (int)lo, 0x124, 0xf, 0xf, true); hiw |= (unsigned)__builtin_amdgcn_update_dpp(0, (int)hiw, 0x124, 0xf, 0xf, true);
                lo |= (unsigned)__builtin_amdgcn_update_dpp(0, (int)lo, 0x128, 0xf, 0xf, true); hiw |= (unsigned)__builtin_amdgcn_update_dpp(0, (int)hiw, 0x128, 0xf, 0xf, true);
                const int tile = 4 * j + (lane >> 4);
                if ((lane & 15) == 0 && tile < ntile) mrow[(size_t)tile * SEQ] = ((unsigned long long)hiw << 32) | lo;
            }
        }
    }
}
#undef RS_PASS
#define XB_TMO      128
#define XB_XCNT(j)  (256  + 64 * (j))
#define XB_XSUB(j)  (1280 + 64 * (j))
#define XB_XGEN(j)  (2304 + 64 * (j))
#define XB_TOP      3328
#define XB_TOPGEN   3392
#define XCD_BAR_WORDS 3456
#define XB_SPIN_CAP (1u << 18)

__device__ __forceinline__ unsigned xb_ld(unsigned* p)              { return __hip_atomic_load(p, __ATOMIC_RELAXED, __HIP_MEMORY_SCOPE_AGENT); }
__device__ __forceinline__ unsigned xb_add(unsigned* p, unsigned v) { return __hip_atomic_fetch_add(p, v, __ATOMIC_RELAXED, __HIP_MEMORY_SCOPE_AGENT); }
__device__ __forceinline__ unsigned xb_xcc_id() { return (unsigned)__builtin_amdgcn_s_getreg((3 << 11) | 20) & 0xFu; }
#define XB_SPIN(cond, bar) do { unsigned _sp = 0; while (cond) { __builtin_amdgcn_s_sleep(1); \
    if ((++_sp & 255u) == 0u) { if (xb_ld(&(bar)[XB_TMO])) break; if (_sp > XB_SPIN_CAP) { atomicAdd(&(bar)[XB_TMO], 1u); break; } } } } while (0)

struct XcdBarrier {
    unsigned* bar; unsigned x;
    volatile LAS unsigned* st;
};

__device__ __forceinline__ XcdBarrier xcd_barrier_post(unsigned* bar, volatile LAS unsigned* st) {
    XcdBarrier b; b.bar = bar; b.x = xb_xcc_id(); b.st = st;
    if (tidx() == 0) (void)xb_add(&bar[XB_XCNT(b.x)], 1u);
    return b;
}
__device__ __forceinline__ void xcd_barrier_complete(unsigned* bar, unsigned x, unsigned& nloc, unsigned& nx) {
    const unsigned G = gridDim.x * gridDim.y * gridDim.z;
    unsigned sum, cnt, mine, sp = 0u;
    for (;;) {
        sum = 0u; cnt = 0u; mine = 0u;
#pragma unroll
        for (unsigned j = 0; j < 16; ++j) { const unsigned c = xb_ld(&bar[XB_XCNT(j)]); sum += c; cnt += (c > 0u) ? 1u : 0u; mine = (j == x) ? c : mine; }
        if (sum == G) break;
        __builtin_amdgcn_s_sleep(1);
        if ((++sp & 255u) == 0u) { if (xb_ld(&bar[XB_TMO])) break; if (sp > XB_SPIN_CAP) { atomicAdd(&bar[XB_TMO], 1u); break; } }
    }
    nloc = mine > 0u ? mine : 1u; nx = cnt > 0u ? cnt : 1u;
}

__device__ __forceinline__ void xcd_barrier(const XcdBarrier& b) {
    asm volatile("s_waitcnt vmcnt(0)" ::: "memory");
    __syncthreads();
    if (tidx() == 0) {
        unsigned* bar = b.bar;
        __builtin_amdgcn_s_waitcnt(0);
        unsigned nloc = b.st[0], nx = b.st[1];
        if (nloc == 0u) { xcd_barrier_complete(bar, b.x, nloc, nx); b.st[0] = nloc; b.st[1] = nx; }
        const unsigned old = xb_add(&bar[XB_XSUB(b.x)], 1u);
        const unsigned gen = old / nloc;
        if (old + 1u == (gen + 1u) * nloc) {
            __builtin_amdgcn_fence(__ATOMIC_RELEASE, "agent");
            asm volatile("s_waitcnt vmcnt(0)" ::: "memory");
            const unsigned og = xb_add(&bar[XB_TOP], 1u);
            const unsigned tg = og / nx;
            if (og + 1u == (tg + 1u) * nx) xb_add(&bar[XB_TOPGEN], 1u);
            else XB_SPIN(xb_ld(&bar[XB_TOPGEN]) == tg, bar);
            __builtin_amdgcn_fence(__ATOMIC_ACQUIRE, "agent");
            xb_add(&bar[XB_XGEN(b.x)], 1u);
            asm volatile("s_waitcnt vmcnt(0)" ::: "memory");
        } else {
            XB_SPIN(xb_ld(&bar[XB_XGEN(b.x)]) == gen, bar);
            __builtin_amdgcn_fence(__ATOMIC_ACQUIRE, "agent");
            asm volatile("s_waitcnt vmcnt(0)" ::: "memory");
        }
    }
    __syncthreads();
}


constexpr float U_SCALE = 64.f, V_SCALE = 8.f;
typedef float f32x2g __attribute__((ext_vector_type(2)));
template <bool SLICED> __device__ __forceinline__ void cvt_fp8(const float* src, unsigned char* dst, size_t n, float scale) {
    for (size_t e = ((size_t)bidx() * NT + tidx()) * 16; e < n; e += (size_t)gridDim.x * NT * 16) {
        u32x4g o;
#pragma unroll
        for (int d = 0; d < 4; ++d) { const f32x4 a = *(const f32x4*)(src + e + 4 * d);
            int p = __builtin_amdgcn_cvt_pk_fp8_f32(a.x * scale, a.y * scale, 0, false); p = __builtin_amdgcn_cvt_pk_fp8_f32(a.z * scale, a.w * scale, p, true); o[d] = (unsigned)p; }
        if (SLICED) { const size_t ex = e >> 10, dd = e & 1023; *(u32x4g*)(dst + (dd >> 7) * ((size_t)NEXP * 128) + ex * 128 + (dd & 127)) = o; }
        else *(u32x4g*)(dst + e) = o; }
}
__device__ __forceinline__ float dot16_fp8(const float (&x)[16], u32x4g u) {
    f32x2g s2 = {0.f, 0.f};
#pragma unroll
    for (int d = 0; d < 4; ++d) { const int ud = (int)u[d]; const f32x2g lo = __builtin_amdgcn_cvt_pk_f32_fp8(ud, false), hi = __builtin_amdgcn_cvt_pk_f32_fp8(ud, true);
        const f32x2g xa = {x[4 * d], x[4 * d + 1]}, xb = {x[4 * d + 2], x[4 * d + 3]};
        s2 = lo * xa + s2; s2 = hi * xb + s2; }
    return s2[0] + s2[1];
}
#define LD8(dst, TAB, B) do { const int er_ = ((B) < 8) ? e0 : e1; \
    _Pragma("unroll") for (int k = 0; k < 8; ++k) { const int idx = __builtin_amdgcn_readlane(er_, ((B) * 8 + k) & 63); dst[k] = *(const u32x4g*)((TAB) + (size_t)idx * DM + 16 * lane); } } while (0)
#define CMU8(src, B) do { float s_[8]; \
    _Pragma("unroll") for (int k = 0; k < 8; ++k) s_[k] = dot16_fp8(x, src[k]); \
    float r_[4]; const bool b5 = lane & 32, b4 = lane & 16, b3 = lane & 8; \
    _Pragma("unroll") for (int i = 0; i < 4; ++i) { const float snd = b5 ? s_[i] : s_[4 + i], kp = b5 ? s_[4 + i] : s_[i]; r_[i] = kp + __shfl_xor(snd, 32); } \
    float q_[2]; \
    _Pragma("unroll") for (int i = 0; i < 2; ++i) { const float snd = b4 ? r_[i] : r_[2 + i], kp = b4 ? r_[2 + i] : r_[i]; q_[i] = kp + __shfl_xor(snd, 16); } \
    float p_; { const float snd = b3 ? q_[0] : q_[1], kp = b3 ? q_[1] : q_[0]; p_ = kp + __shfl_xor(snd, 8); } \
    p_ += __shfl_xor(p_, 4); p_ += __shfl_xor(p_, 2); p_ += __shfl_xor(p_, 1); \
    if ((lane & 7) == 0) al[(B) * 8 + (lane >> 3)] = p_; } while (0)
#define CMV8(src, B) do { const float wr_ = ((B) < 8) ? w0 : w1; \
    _Pragma("unroll") for (int k = 0; k < 8; ++k) { \
        const float w = __builtin_bit_cast(float, __builtin_amdgcn_readlane(__builtin_bit_cast(int, wr_), ((B) * 8 + k) & 63)); const u32x4g v0 = src[k]; \
        _Pragma("unroll") for (int d = 0; d < 4; ++d) { const int vd = (int)v0[d]; const f32x2g lo = __builtin_amdgcn_cvt_pk_f32_fp8(vd, false), hi = __builtin_amdgcn_cvt_pk_f32_fp8(vd, true); \
            acc[4 * d] = fmaf(w, lo[0], acc[4 * d]); acc[4 * d + 1] = fmaf(w, lo[1], acc[4 * d + 1]); acc[4 * d + 2] = fmaf(w, hi[0], acc[4 * d + 2]); acc[4 * d + 3] = fmaf(w, hi[1], acc[4 * d + 3]); } } } while (0)
__device__ __forceinline__ void ph_peer_gather_fp8(const int* eidx, const float* gw, const unsigned char* U, const unsigned char* V, float* h, const float* gain_next, bf16* XN, unsigned char* smem) {
    const int tid = tidx(), lane = tid & 63, wave = tid >> 6;
    float* al = (float*)smem + wave * 128;
    const int gwv = bidx() * (NT / 64) + wave, ngw = gridDim.x * (NT / 64);
#pragma unroll 1
    for (int t = gwv; t < T; t += ngw) {
        float x[16];
        { const u32x4g xa = *(const u32x4g*)(XN + (size_t)t * DM + 16 * lane), xb = *(const u32x4g*)(XN + (size_t)t * DM + 16 * lane + 8);
#pragma unroll
          for (int d = 0; d < 4; ++d) { const unsigned wa = xa[d], wb = xb[d]; x[2 * d] = bflo(wa); x[2 * d + 1] = bfhi(wa); x[8 + 2 * d] = bflo(wb); x[8 + 2 * d + 1] = bfhi(wb); } }
        const int e0 = eidx[(size_t)t * 128 + lane], e1 = eidx[(size_t)t * 128 + 64 + lane];
        const float g0 = gw[(size_t)t * 128 + lane], g1 = gw[(size_t)t * 128 + 64 + lane];
        u32x4g ra[8], rb[8];
        LD8(ra, U, 0);
#pragma unroll 1
        for (int b = 0; b < 16; b += 2) {
            LD8(rb, U, b + 1); CMU8(ra, b);
            if (b + 2 < 16) LD8(ra, U, b + 2); else LD8(ra, V, 0);
            CMU8(rb, b + 1);
        }
        __builtin_amdgcn_s_waitcnt(0xc07f); asm volatile("" ::: "memory");
        const float w0 = g0 * gelu_tanh(al[lane] * (1.0f / U_SCALE)) * (1.0f / V_SCALE), w1 = g1 * gelu_tanh(al[64 + lane] * (1.0f / U_SCALE)) * (1.0f / V_SCALE);
        float acc[16];
#pragma unroll
        for (int i = 0; i < 16; ++i) acc[i] = 0.f;
#pragma unroll 1
        for (int b = 0; b < 16; b += 2) {
            LD8(rb, V, b + 1); CMV8(ra, b);
            if (b + 2 < 16) LD8(ra, V, b + 2);
            CMV8(rb, b + 1);
        }
        float* hp = h + (size_t)t * DM + 16 * lane;
        f32x4 hv[4]; float ss = 0.f;
#pragma unroll
        for (int i = 0; i < 4; ++i) { hv[i] = *(f32x4*)(hp + 4 * i); hv[i] += (f32x4){acc[4 * i], acc[4 * i + 1], acc[4 * i + 2], acc[4 * i + 3]}; *(f32x4*)(hp + 4 * i) = hv[i];
            ss += hv[i][0] * hv[i][0] + hv[i][1] * hv[i][1] + hv[i][2] * hv[i][2] + hv[i][3] * hv[i][3]; }
        const float rstd = 1.0f / sqrtf(wave_sum(ss) * (1.0f / DM) + NORM_EPS);
        u32x4g o0, o1;
#pragma unroll
        for (int i = 0; i < 2; ++i) { const f32x4 ga = *(const f32x4*)(gain_next + 16 * lane + 4 * i), gb = *(const f32x4*)(gain_next + 16 * lane + 8 + 4 * i);
            o0[2 * i] = pk2(hv[i][0] * rstd * ga[0], hv[i][1] * rstd * ga[1]); o0[2 * i + 1] = pk2(hv[i][2] * rstd * ga[2], hv[i][3] * rstd * ga[3]);
            o1[2 * i] = pk2(hv[2 + i][0] * rstd * gb[0], hv[2 + i][1] * rstd * gb[1]); o1[2 * i + 1] = pk2(hv[2 + i][2] * rstd * gb[2], hv[2 + i][3] * rstd * gb[3]); }
        *(u32x4g*)(XN + (size_t)t * DM + 16 * lane) = o0; *(u32x4g*)(XN + (size_t)t * DM + 16 * lane + 8) = o1;
    }
}

#define GA_LDE(E0, E1, XA, XB, tt) do { const size_t t_ = (size_t)(((tt) < T) ? (tt) : tlast); E0 = eidx[t_ * 128 + lane]; E1 = eidx[t_ * 128 + 64 + lane]; \
    XA = *(const u32x4g*)(XN + t_ * DM + 128 * j + 16 * c); XB = *(const u32x4g*)(XN + t_ * DM + 128 * j + 16 * c + 8); } while (0)
#define G_LDP(PC, E0, E1, TAB) do { _Pragma("unroll") for (int i = 0; i < 16; ++i) { const int idx = bperm((8 * i + sgrp) & 63, (i < 8) ? E0 : E1); PC[i] = *(const u32x4g*)((TAB) + (size_t)idx * 128); } } while (0)
__device__ __forceinline__ void ph_gather_a(const bf16* XN, const int* eidx, const unsigned char* Us, float* PA, int j, int r, int nper, const float* gain) {
    const int tid = tidx(), lane = tid & 63, wave = tid >> 6, sgrp = lane >> 3, c = lane & 7;
    const unsigned char* Uj = Us + (size_t)j * NEXP * 128 + 16 * c;
    const int t0 = r * (NT / 64) + wave, st = nper * (NT / 64); if (st <= 0 || t0 >= T) return;
    const int tlast = t0 + ((T - 1 - t0) / st) * st;
    int e0, e1; u32x4g xa, xb, nxa, nxb; u32x4g pc[16];
    float gs[16];
#pragma unroll
    for (int i = 0; i < 16; ++i) gs[i] = gain[128 * j + 16 * c + i];
    GA_LDE(e0, e1, xa, xb, t0); G_LDP(pc, e0, e1, Uj); GA_LDE(e0, e1, nxa, nxb, t0 + st);
#pragma unroll 1
    for (int t = t0; t < T; t += st) {
        float x[16];
#pragma unroll
        for (int d = 0; d < 4; ++d) { const unsigned wa = xa[d], wb = xb[d]; x[2 * d] = bflo(wa) * gs[2 * d]; x[2 * d + 1] = bfhi(wa) * gs[2 * d + 1]; x[8 + 2 * d] = bflo(wb) * gs[8 + 2 * d]; x[8 + 2 * d + 1] = bfhi(wb) * gs[8 + 2 * d + 1]; }
        float sm[16];
#pragma unroll
        for (int i = 0; i < 16; ++i) sm[i] = dot16_fp8(x, pc[i]);
        asm volatile("" ::: "memory");
        G_LDP(pc, e0, e1, Uj);
        xa = nxa; xb = nxb;
        GA_LDE(e0, e1, nxa, nxb, t + 2 * st);
        float p0 = 0.f, p1 = 0.f;
#pragma unroll
        for (int i = 0; i < 16; ++i) { float v = sm[i]; v += shx<1>(v); v += shx<2>(v); v += shx<4>(v);
            if (i < 8) p0 = ((i & 7) == c) ? v : p0; else p1 = ((i & 7) == c) ? v : p1; }
        float* pa = PA + ((size_t)t * 8 + j) * 128 + 8 * c + sgrp; pa[0] = p0; pa[64] = p1;
    }
}
__device__ __forceinline__ void ph_gather_v(const int* eidx, const float* gw, const float* PA, const unsigned char* V, float* h, const float* gain_next, bf16* XN) {
    const int tid = tidx(), lane = tid & 63, wave = tid >> 6;
    const int gwv = bidx() * (NT / 64) + wave, ngw = gridDim.x * (NT / 64);
    int ne0 = 0, ne1 = 0; if (gwv < T) { ne0 = eidx[(size_t)gwv * 128 + lane]; ne1 = eidx[(size_t)gwv * 128 + 64 + lane]; }
#pragma unroll 1
    for (int t = gwv; t < T; t += ngw) {
        const int e0 = ne0, e1 = ne1;
        u32x4g ra[8], rb[8];
        LD8(ra, V, 0);
        { const size_t tn = (size_t)((t + ngw < T) ? t + ngw : t); ne0 = eidx[tn * 128 + lane]; ne1 = eidx[tn * 128 + 64 + lane]; }
        float a0 = 0.f, a1 = 0.f;
#pragma unroll
        for (int q = 0; q < 8; ++q) { a0 += PA[((size_t)t * 8 + q) * 128 + lane]; a1 += PA[((size_t)t * 8 + q) * 128 + 64 + lane]; }
        const float w0 = gw[(size_t)t * 128 + lane] * gelu_tanh(a0 * (1.0f / U_SCALE)) * (1.0f / V_SCALE), w1 = gw[(size_t)t * 128 + 64 + lane] * gelu_tanh(a1 * (1.0f / U_SCALE)) * (1.0f / V_SCALE);
        float acc[16];
#pragma unroll
        for (int i = 0; i < 16; ++i) acc[i] = 0.f;
#pragma unroll 1
        for (int b = 0; b < 16; b += 2) {
            LD8(rb, V, b + 1); CMV8(ra, b);
            if (b + 2 < 16) LD8(ra, V, b + 2);
            CMV8(rb, b + 1);
        }
        float* hp = h + (size_t)t * DM + 16 * lane;
        f32x4 hv[4]; float ss = 0.f;
#pragma unroll
        for (int i = 0; i < 4; ++i) { hv[i] = *(f32x4*)(hp + 4 * i); hv[i] += (f32x4){acc[4 * i], acc[4 * i + 1], acc[4 * i + 2], acc[4 * i + 3]}; *(f32x4*)(hp + 4 * i) = hv[i];
            ss += hv[i][0] * hv[i][0] + hv[i][1] * hv[i][1] + hv[i][2] * hv[i][2] + hv[i][3] * hv[i][3]; }
        const float rstd = 1.0f / sqrtf(wave_sum(ss) * (1.0f / DM) + NORM_EPS);
        u32x4g o0, o1;
#pragma unroll
        for (int i = 0; i < 2; ++i) { const f32x4 ga = *(const f32x4*)(gain_next + 16 * lane + 4 * i), gb = *(const f32x4*)(gain_next + 16 * lane + 8 + 4 * i);
            o0[2 * i] = pk2(hv[i][0] * rstd * ga[0], hv[i][1] * rstd * ga[1]); o0[2 * i + 1] = pk2(hv[i][2] * rstd * ga[2], hv[i][3] * rstd * ga[3]);
            o1[2 * i] = pk2(hv[2 + i][0] * rstd * gb[0], hv[2 + i][1] * rstd * gb[1]); o1[2 * i + 1] = pk2(hv[2 + i][2] * rstd * gb[2], hv[2 + i][3] * rstd * gb[3]); }
        *(u32x4g*)(XN + (size_t)t * DM + 16 * lane) = o0; *(u32x4g*)(XN + (size_t)t * DM + 16 * lane + 8) = o1;
    }
}


__device__ __forceinline__ void ph_gather_u8(const bf16* XN, const int* eidx, const unsigned char* Us, float* PA, int j, int r, int nper, const float* gain, unsigned char* smem) {
    const int tid = tidx(), lane = tid & 63, wave = tid >> 6, u = lane >> 3, c = lane & 7;
    LAS int* il = (LAS int*)((LAS unsigned char*)smem + wave * 4096);
    const unsigned char* Uj = Us + (size_t)j * NEXP * 128 + 16 * c;
    float gs[16];
#pragma unroll
    for (int i = 0; i < 16; ++i) gs[i] = gain[128 * j + 16 * c + i];
    const int g0 = r * (NT / 64) + wave, gstep = nper * (NT / 64); if (gstep <= 0) return;
#pragma unroll 1
    for (int g = g0; g < T / 8; g += gstep) {
        const size_t t = (size_t)g * 8 + u;
#pragma unroll
        for (int i = 0; i < 4; ++i) *(LAS u32x4g*)(il + u * 128 + 16 * c + 4 * i) = *(const u32x4g*)(eidx + t * 128 + 16 * c + 4 * i);
        float x[16];
        { const u32x4g xa = *(const u32x4g*)(XN + t * DM + 128 * j + 16 * c), xb = *(const u32x4g*)(XN + t * DM + 128 * j + 16 * c + 8);
#pragma unroll
          for (int d = 0; d < 4; ++d) { const unsigned wa = xa[d], wb = xb[d]; x[2 * d] = bflo(wa) * gs[2 * d]; x[2 * d + 1] = bfhi(wa) * gs[2 * d + 1]; x[8 + 2 * d] = bflo(wb) * gs[8 + 2 * d]; x[8 + 2 * d + 1] = bfhi(wb) * gs[8 + 2 * d + 1]; } }
        float res[16];
        u32x4g pa_[8], pb_[8];
#define U8_LD(dst, B) do { _Pragma("unroll") for (int k = 0; k < 8; ++k) { const int idx = il[u * 128 + (B) * 8 + k]; dst[k] = *(const u32x4g*)(Uj + (size_t)idx * 128); } } while (0)
#define U8_CM(src, B) do { float keep_ = 0.f; _Pragma("unroll") for (int k = 0; k < 8; ++k) { float sm = dot16_fp8(x, src[k]); sm += shx<1>(sm); sm += shx<2>(sm); sm += shx<4>(sm); keep_ = (k == c) ? sm : keep_; } res[B] = keep_; } while (0)
        U8_LD(pa_, 0);
#pragma unroll
        for (int b = 0; b < 16; b += 2) {
            U8_LD(pb_, b + 1); U8_CM(pa_, b);
            if (b + 2 < 16) U8_LD(pa_, b + 2);
            U8_CM(pb_, b + 1);
        }
#undef U8_LD
#undef U8_CM
        float* pa = PA + (t * 8 + j) * 128 + c;
#pragma unroll
        for (int b = 0; b < 16; ++b) pa[8 * b] = res[b];
    }
}
__device__ __forceinline__ void ph_gather_w(const float* gw, const float* PA, float* W, const float* ss16) {
    for (size_t e4 = (size_t)bidx() * NT + tidx(); e4 < (size_t)T * 32; e4 += (size_t)gridDim.x * NT) {
        const size_t t = e4 >> 5, e = (e4 & 31) * 4;
        f32x4 a = (f32x4){0.f, 0.f, 0.f, 0.f};
#pragma unroll
        for (int q = 0; q < 8; ++q) a += *(const f32x4*)(PA + (t * 8 + q) * 128 + e);
        const f32x4 g = *(const f32x4*)(gw + t * 128 + e); const float rs = pg8::rstd16(ss16, (int)t) * (1.0f / U_SCALE);
        f32x4 w;
#pragma unroll
        for (int k = 0; k < 4; ++k) w[k] = g[k] * gelu_tanh(a[k] * rs) * (1.0f / V_SCALE);
        *(f32x4*)(W + t * 128 + e) = w;
    }
}
__device__ __forceinline__ void ph_gather_v8(const int* eidx, const float* gw, const float* PA, const unsigned char* Vs, float* h, int j, int r, int nper, unsigned char* smem, bf16* XB, float* ss8) {
    const int tid = tidx(), lane = tid & 63, wave = tid >> 6, u = lane >> 3, c = lane & 7;
    LAS float* wl = (LAS float*)((LAS unsigned char*)smem + wave * 8192);
    LAS int* il = (LAS int*)((LAS unsigned char*)smem + wave * 8192 + 4096);
    const unsigned char* Vj = Vs + (size_t)j * NEXP * 128 + 16 * c;
    const int g0 = r * (NT / 64) + wave, gs = nper * (NT / 64); if (gs <= 0) return;
#pragma unroll 1
    for (int g = g0; g < T / 8; g += gs) {
        const size_t t = (size_t)g * 8 + u;
        {
#pragma unroll
            for (int i = 0; i < 4; ++i) { const f32x4 wv = *(const f32x4*)(PA + t * 128 + 16 * c + 4 * i); const u32x4g ee = *(const u32x4g*)(eidx + t * 128 + 16 * c + 4 * i);
                *(LAS f32x4*)(wl + u * 128 + 16 * c + 4 * i) = wv; *(LAS u32x4g*)(il + u * 128 + 16 * c + 4 * i) = ee; } }
        f32x2g acc2[8];
#pragma unroll
        for (int i = 0; i < 8; ++i) acc2[i] = (f32x2g){0.f, 0.f};
        u32x4g pa_[16], pb_[16];
#define V8_LD(dst, B) do { _Pragma("unroll") for (int k = 0; k < 16; ++k) { const int idx = il[u * 128 + (B) * 16 + k]; dst[k] = *(const u32x4g*)(Vj + (size_t)idx * 128); } } while (0)
#define V8_CM(src, B) do { _Pragma("unroll") for (int k = 0; k < 16; ++k) { const float w = wl[u * 128 + (B) * 16 + k]; const f32x2g w2 = {w, w}; const u32x4g v0 = src[k]; \
        _Pragma("unroll") for (int d = 0; d < 4; ++d) { const int vd = (int)v0[d]; const f32x2g lo = __builtin_amdgcn_cvt_pk_f32_fp8(vd, false), hi = __builtin_amdgcn_cvt_pk_f32_fp8(vd, true); \
            acc2[2 * d] = lo * w2 + acc2[2 * d]; acc2[2 * d + 1] = hi * w2 + acc2[2 * d + 1]; } } } while (0)
        V8_LD(pa_, 0);
#pragma unroll 1
        for (int b = 0; b < 8; b += 2) {
            V8_LD(pb_, b + 1); V8_CM(pa_, b);
            if (b + 2 < 8) V8_LD(pa_, b + 2);
            V8_CM(pb_, b + 1);
        }
#undef V8_LD
#undef V8_CM
        float* hp = h + t * DM + 128 * j + 16 * c; float sq = 0.f; u32x4g xo0, xo1;
#pragma unroll
        for (int i = 0; i < 4; ++i) { f32x4 hv = *(f32x4*)(hp + 4 * i); hv += (f32x4){acc2[2 * i][0], acc2[2 * i][1], acc2[2 * i + 1][0], acc2[2 * i + 1][1]}; *(f32x4*)(hp + 4 * i) = hv;
            sq += (hv[0] * hv[0] + hv[1] * hv[1]) + (hv[2] * hv[2] + hv[3] * hv[3]);
            if (i < 2) { xo0[2 * i] = pk2(hv[0], hv[1]); xo0[2 * i + 1] = pk2(hv[2], hv[3]); } else { xo1[2 * (i - 2)] = pk2(hv[0], hv[1]); xo1[2 * (i - 2) + 1] = pk2(hv[2], hv[3]); } }
        *(u32x4g*)(XB + t * DM + 128 * j + 16 * c) = xo0; *(u32x4g*)(XB + t * DM + 128 * j + 16 * c + 8) = xo1;
        sq += shx<1>(sq); sq += shx<2>(sq); sq += shx<4>(sq);
        if (c == 0) ss8[t * 8 + j] = sq;
    }
}

__device__ __forceinline__ void prep_piece(bf16* p, bool active, bool donorm, const float (&gain)[8], const float (&cs)[8], const float (&sn)[8], float scale, int lane) {
    u32x4g raw = (u32x4g){0u, 0u, 0u, 0u};
    if (active) raw = *(const u32x4g*)p;
    float f[8];
#pragma unroll
    for (int d = 0; d < 4; ++d) { const unsigned w = raw[d]; f[2 * d] = bflo(w); f[2 * d + 1] = bfhi(w); }
    if (donorm) {
        float ss = 0.f;
#pragma unroll
        for (int i = 0; i < 8; ++i) ss += f[i] * f[i];
        ss += shx<1>(ss); ss += shx<2>(ss); ss += shx<4>(ss);
        const float rstd = 1.0f / sqrtf(ss * (1.0f / 64.f) + NORM_EPS);
#pragma unroll
        for (int i = 0; i < 8; ++i) f[i] = f[i] * rstd * gain[i];
    }
    const int sub = lane & 7;
#pragma unroll
    for (int i = 0; i < 8; ++i) { const float pr = shx<1>(f[i]);
        const float r0 = f[i] * cs[i] - pr * sn[i], r1 = f[i] * cs[i] + pr * sn[i];
        f[i] = (sub == 0) ? r0 : ((sub == 1) ? r1 : f[i]); }
    u32x4g o;
#pragma unroll
    for (int d = 0; d < 4; ++d) o[d] = pk2(f[2 * d] * scale, f[2 * d + 1] * scale);
    if (active) *(u32x4g*)p = o;
}
#define ROPE_ROW(pos) float cs[8], sn[8]; { float c_ = 1.f, s_ = 0.f; if (lane < 8) rope_cs(pos, lane, c_, s_); \
    _Pragma("unroll") for (int i = 0; i < 8; ++i) { cs[i] = __builtin_bit_cast(float, __builtin_amdgcn_readlane(__builtin_bit_cast(int, c_), i)); sn[i] = __builtin_bit_cast(float, __builtin_amdgcn_readlane(__builtin_bit_cast(int, s_), i)); } }
#define LOAD_GAIN(dst, src) float dst[8]; { _Pragma("unroll") for (int i = 0; i < 8; ++i) dst[i] = (src)[8 * (lane & 7) + i]; }
__device__ __forceinline__ void ph_prep0_opt(bf16* qkv, const int* positions, const float* aq, const float* ak, const float* bq, const float* bk) {
    const int lane = tidx() & 63, wave = tidx() >> 6;
    const int gw = bidx() * (NT / 64) + wave, ngw = gridDim.x * (NT / 64);
    LOAD_GAIN(gaq, aq); LOAD_GAIN(gak, ak); LOAD_GAIN(gbq, bq); LOAD_GAIN(gbk, bk);
#pragma unroll 1
    for (int r = gw; r < T; r += ngw) {
        const int pos = positions[r]; bf16* row = qkv + (size_t)r * AB_LD + 8 * lane;
        ROPE_ROW(pos);
        prep_piece(row + CQA, true, true, gaq, cs, sn, C2, lane);
        prep_piece(row + CKA, true, true, gak, cs, sn, 1.f, lane);
        prep_piece(row + CQB, true, true, gbq, cs, sn, C2, lane);
        prep_piece(row + CKB, true, true, gbk, cs, sn, 1.f, lane);
        prep_piece(row + CQI, lane < 40, false, gaq, cs, sn, 1.f, lane);
    }
}
__device__ __forceinline__ void ph_prep1_opt(bf16* qkv, const int* positions, const float* cq, const float* ck) {
    const int lane = tidx() & 63, wave = tidx() >> 6;
    const int gw = bidx() * (NT / 64) + wave, ngw = gridDim.x * (NT / 64);
    LOAD_GAIN(gq, cq); LOAD_GAIN(gk, ck);
#pragma unroll 1
    for (int r = gw; r < T; r += ngw) {
        const int pos = positions[r]; bf16* row = qkv + (size_t)r * C_LD + 8 * lane;
        ROPE_ROW(pos);
        prep_piece(row, true, true, gq, cs, sn, C2, lane);
        prep_piece(row + 512, true, true, gq, cs, sn, C2, lane);
        prep_piece(row + 1024, true, true, gk, cs, sn, 1.f, lane);
        prep_piece(row + 1536, true, true, gk, cs, sn, 1.f, lane);
    }
}
__device__ __forceinline__ void ph_kmean_opt(const bf16* qkv, float* kmean) {
    const int lane = tidx() & 63, wave = tidx() >> 6;
    const int gw = bidx() * (NT / 64) + wave, ngw = gridDim.x * (NT / 64);
#pragma unroll 1
    for (int it = gw; it < BATCH * 8 * 32; it += ngw) {
        const int b = it / 256, h = (it / 32) % 8, n = it % 32;
        const bf16* base = qkv + (size_t)(b * SEQ + n * 256) * AB_LD + CKA + h * 64 + lane;
        float s = 0.f;
#pragma unroll 1
        for (int r = 0; r < 256; r += 16) { float v[16];
#pragma unroll
            for (int i = 0; i < 16; ++i) v[i] = bf2f(base[(size_t)(r + i) * AB_LD]);
#pragma unroll
            for (int i = 0; i < 16; ++i) s += v[i]; }
        kmean[(size_t)it * 64 + lane] = s * (1.0f / 256.f);
    }
}
__device__ __forceinline__ void ph_dil_merge_opt(const bf16* OG, const float* LSE, bf16* O) {
    const int lane = tidx() & 63, wave = tidx() >> 6;
    const int gw = bidx() * (NT / 64) + wave, ngw = gridDim.x * (NT / 64);
#pragma unroll 1
    for (int t = gw; t < T; t += ngw) {
        const int h = lane >> 2;
        const float l0 = LSE[((size_t)0 * T + t) * 16 + h], l1 = LSE[((size_t)1 * T + t) * 16 + h], l2 = LSE[((size_t)2 * T + t) * 16 + h];
        const float m = fmaxf(l0, fmaxf(l1, l2)); float w0 = exp2f(l0 - m), w1 = exp2f(l1 - m), w2 = exp2f(l2 - m);
        const float inv = 1.0f / (w0 + w1 + w2); w0 *= inv; w1 *= inv; w2 *= inv;
        const size_t off = (size_t)t * DM + 16 * lane;
#pragma unroll
        for (int half = 0; half < 2; ++half) {
            const u32x4g a = *(const u32x4g*)(OG + off + 8 * half), b = *(const u32x4g*)(OG + (size_t)T * DM + off + 8 * half), c = *(const u32x4g*)(OG + (size_t)2 * T * DM + off + 8 * half);
            u32x4g o;
#pragma unroll
            for (int d = 0; d < 4; ++d) { const unsigned ad = a[d], bd = b[d], cd = c[d];
                o[d] = pk2(w0 * bflo(ad) + w1 * bflo(bd) + w2 * bflo(cd), w0 * bfhi(ad) + w1 * bfhi(bd) + w2 * bfhi(cd)); }
            *(u32x4g*)(O + off + 8 * half) = o;
        }
    }
}


__device__ __forceinline__ void ph_moba_select_opt(const bf16* qkv, const float* kmean, unsigned* sel) {
    using attn_g::bf16x8; using attn_g::f32x16;
    const int tid = tidx(), lane = tid & 63, r32 = lane & 31, hi = lane >> 5, wave = tid >> 6;
#pragma unroll 1
    for (int unit = bidx(); unit < 512; unit += (int)gridDim.x) {
        const int bh = unit >> 5, qb = unit & 31, b = bh >> 3, h = bh & 7;
        const size_t trow = (size_t)b * SEQ + 256 * qb + 32 * wave + r32;
        const float* km = kmean + ((size_t)bh * 32 + r32) * 64;
        f32x16 g = {};
#pragma unroll
        for (int d0 = 0; d0 < 4; ++d0) {
            const f32x4 k0 = *(const f32x4*)(km + d0 * 16 + 8 * hi), k1 = *(const f32x4*)(km + d0 * 16 + 8 * hi + 4);
            u32x4g ap; ap[0] = pk2(k0[0], k0[1]); ap[1] = pk2(k0[2], k0[3]); ap[2] = pk2(k1[0], k1[1]); ap[3] = pk2(k1[2], k1[3]);
            const bf16x8 bq = *(const bf16x8*)(qkv + trow * AB_LD + CQA + h * 64 + d0 * 16 + 8 * hi);
            g = __builtin_amdgcn_mfma_f32_32x32x16_bf16(__builtin_bit_cast(bf16x8, ap), bq, g, 0, 0, 0);
        }
        float v0 = -3e38f, v1 = -3e38f, v2 = -3e38f; int i0 = 255, i1 = 255, i2 = 255;
#pragma unroll
        for (int r = 0; r < 16; ++r) { const int n = (r & 3) + 8 * (r >> 2) + 4 * hi; const float gv = g[r];
            if (n < qb) { if (gv > v0) { v2 = v1; i2 = i1; v1 = v0; i1 = i0; v0 = gv; i0 = n; } else if (gv > v1) { v2 = v1; i2 = i1; v1 = gv; i1 = n; } else if (gv > v2) { v2 = gv; i2 = n; } } }
        const float pv[3] = {shx<32>(v0), shx<32>(v1), shx<32>(v2)}; const int pi[3] = {shx<32>(i0), shx<32>(i1), shx<32>(i2)};
#pragma unroll
        for (int c = 0; c < 3; ++c) { const float gv = pv[c]; const int n = pi[c];
            if (n != 255) { if (gv > v0 || (gv == v0 && n < i0)) { v2 = v1; i2 = i1; v1 = v0; i1 = i0; v0 = gv; i0 = n; } else if (gv > v1 || (gv == v1 && n < i1)) { v2 = v1; i2 = i1; v1 = gv; i1 = n; } else if (gv > v2 || (gv == v2 && n < i2)) { v2 = gv; i2 = n; } } }
        if (hi == 0) sel[trow * 8 + h] = (unsigned)i0 | ((unsigned)i1 << 8) | ((unsigned)i2 << 16) | (255u << 24);
    }
}

namespace cg = cooperative_groups;
constexpr int LDS_BYTES = 147456;
#define GEMM_PHASE(EPI, Aptr, Bptr, Nn, Kk, ...) do { pg8::Gemm g_{(const pg8::bf16_t*)(Aptr), (const pg8::bf16_t*)(Bptr), T, (Nn), (Kk)}; pg8::StaticOrder S_; S_.init(T, (Nn), (int)gridDim.x, (int)bidx()); \
    pg8::EPI E_{__VA_ARGS__}; pg8::gemm_phase<pg8::EPI, pg8::StaticOrder, true, true>((PG8_LAS unsigned char*)smem, g_, S_, E_); } while (0)
__global__ void __launch_bounds__(NT, 2) k_mega(Params P) {
    extern __shared__ __attribute__((aligned(16))) unsigned char smem[];
    cg::grid_group grid = cg::this_grid();
    { const unsigned t0_ = (unsigned)__builtin_amdgcn_workitem_id_x(); if ((t0_ & 63u) == 0u) TID_TAB[hw_slot()] = t0_ >> 6; }
    __syncthreads();
#define BST ((volatile LAS unsigned*)((LAS unsigned char*)smem + 131072 + 64))
#define SLICE_J (__builtin_amdgcn_readfirstlane((int)BST[2]))
#define SLICE_R (__builtin_amdgcn_readfirstlane((int)BST[3]))
#define SLICE_N (__builtin_amdgcn_readfirstlane((int)BST[5]))
    if (tidx() < 2) BST[tidx()] = 0u;
    __syncthreads();
    (void)xcd_barrier_post((unsigned*)(WSP + WS_CTL) + 4096, BST);
#define BAR0() do { XcdBarrier b_; b_.bar = (unsigned*)(WSP + WS_CTL) + 4096; b_.x = xb_xcc_id(); b_.st = BST; xcd_barrier(b_); } while (0)
    #define BAR() do { BAR0(); STAMP(); } while (0)
#define TSW ((volatile LAS unsigned long long*)((LAS unsigned char*)smem + 131072 + 128))
    int nts = 0;
#define STAMP() do { if (PROBE_A >= 0) { if (bidx() == 0 && tidx() == 0) TSW[nts] = __builtin_amdgcn_s_memrealtime(); ++nts; } } while (0)
    STAMP();
    ph_prologue(smem);
    if (tidx() == 0) {
        const unsigned x = xb_xcc_id() & 7u; BST[2] = x; BST[3] = xb_add((unsigned*)(WSP + WS_CTL) + 8192 + 64 * x, 1u); }
    ph_rmsnorm(IN(0), IN(3), (bf16*)(WSP + WS_XN)); grid.sync(); STAMP();
    if (tidx() == 0) {
        bool reg = (gridDim.x % 8u) == 0u;
        for (unsigned q = 0; q < 8u; ++q) reg = reg && (xb_ld((unsigned*)(WSP + WS_CTL) + 8192 + 64 * q) == gridDim.x / 8u);
        if (!reg) { BST[2] = (unsigned)bidx() % 8u; BST[3] = (unsigned)bidx() / 8u; }
        BST[5] = (gridDim.x % 8u == 0u) ? gridDim.x / 8u : 0u; }
    __syncthreads();
    { unsigned char* ws = WSP; GEMM_PHASE(EBf16, ws + WS_XN, ws + WS_WAB_IN, AB_LD, DM, (bf16*)(ws + WS_QKV), AB_LD); } BAR();
    ph_prep0_opt((bf16*)(WSP + WS_QKV), (const int*)IN(2), IN(8), IN(9), IN(10), IN(11)); BAR();
    { unsigned char* ws = WSP; ph_kmean_opt((bf16*)(ws + WS_QKV), (float*)(ws + WS_KMEAN)); } BAR();
    { unsigned char* ws = WSP; ph_moba_select_opt((bf16*)(ws + WS_QKV), (float*)(ws + WS_KMEAN), (unsigned*)(ws + WS_SEL)); }
    { unsigned char* ws = WSP; ph_dsa_score((bf16*)(ws + WS_QKV), (float*)(ws + WS_SCORES), smem); } BAR();
    { unsigned char* ws = WSP; ph_dsa_select_opt((float*)(ws + WS_SCORES), (unsigned long long*)(ws + WS_MASK), smem); }
    __syncthreads();
    { unsigned char* ws = WSP; ph_attn_moba((bf16*)(ws + WS_QKV), (unsigned*)(ws + WS_SEL), (bf16*)(ws + WS_XN), smem); } BAR();
    { unsigned char* ws = WSP; ph_attn_dsa((bf16*)(ws + WS_QKV), (unsigned long long*)(ws + WS_MASK), (bf16*)(ws + WS_XN), smem); } BAR();
    { unsigned char* ws = WSP; GEMM_PHASE(EResAddN, ws + WS_XN, ws + WS_WAB_OUT, DM, DM, IN(0), OUTP, (pg8::bf16_t*)(ws + WS_XN2), (float*)(ws + WS_SS16)); }
    {
        unsigned char* ws = WSP;
#pragma unroll 1
        for (int L = 0; L < 2; ++L) {
            cvt_fp8<true>(IN(18) + (size_t)L * NEXP * DM, ws + WS_EXP + (size_t)(2 * L) * 16 * MiB, (size_t)NEXP * DM, U_SCALE);
            cvt_fp8<true>(IN(19) + (size_t)L * NEXP * DM, ws + WS_EXP + (size_t)(2 * L + 1) * 16 * MiB, (size_t)NEXP * DM, V_SCALE);
        }
    } BAR();
#pragma unroll 1
    for (int L = 0; L < 2; ++L) {
        if (L == 1) {
            { unsigned char* ws = WSP; GEMM_PHASE(EBf16S, ws + WS_XN2, ws + WS_WC_IN, C_LD, DM, (pg8::bf16_t*)(ws + WS_QKV1), C_LD, (const float*)(ws + WS_SS16)); } BAR();
            ph_prep1_opt((bf16*)(WSP + WS_QKV1), (const int*)IN(2), IN(14), IN(15)); BAR();
            { unsigned char* ws = WSP; ph_attn_dilated((bf16*)(ws + WS_QKV1), (bf16*)(ws + WS_OG), (float*)(ws + WS_LSE), smem); } BAR();
            { unsigned char* ws = WSP; ph_dil_merge_opt((bf16*)(ws + WS_OG), (float*)(ws + WS_LSE), (bf16*)(ws + WS_XN)); } BAR();
            { unsigned char* ws = WSP; float* hb = OUTP; GEMM_PHASE(EResAddN, ws + WS_XN, ws + WS_WC_OUT, DM, DM, hb, hb, (pg8::bf16_t*)(ws + WS_XN2), (float*)(ws + WS_SS16)); } BAR();
        }
        { unsigned char* ws = WSP; GEMM_PHASE(EBf16S, ws + WS_XN2, ws + WS_WQ + (size_t)L * 4 * MiB, 2048, DM, (pg8::bf16_t*)(ws + WS_QRY), 2048, (const float*)(ws + WS_SS16)); } BAR();
        { unsigned char* ws = WSP; ph_peer_route_opt((bf16*)(ws + WS_QRY), (bf16*)(ws + WS_SUBK) + (size_t)L * 16 * 128 * 128, (int*)(ws + WS_EIDX), (float*)(ws + WS_GW), smem); } BAR();
        { unsigned char* ws = WSP; ph_gather_u8((bf16*)(ws + WS_XN2), (int*)(ws + WS_EIDX), ws + WS_EXP + (size_t)(2 * L) * 16 * MiB, (float*)(ws + WS_PA), SLICE_J, SLICE_R, SLICE_N, IN(4) + L * DM, smem); } BAR();
        { unsigned char* ws = WSP; ph_gather_w((float*)(ws + WS_GW), (float*)(ws + WS_PA), (float*)(ws + WS_GW), (const float*)(ws + WS_SS16)); }
        { unsigned char* ws = WSP; GEMM_PHASE(EBf16, ws + WS_P + (size_t)L * T * 256 * 2, ws + WS_WUP + (size_t)L * (MiB / 2), DM, 256, (bf16*)(ws + WS_UP), DM); } BAR();
        { unsigned char* ws = WSP; ph_gather_v8((int*)(ws + WS_EIDX), (float*)(ws + WS_GW), (float*)(ws + WS_GW), ws + WS_EXP + (size_t)(2 * L + 1) * 16 * MiB, OUTP, SLICE_J, SLICE_R, SLICE_N, smem, (bf16*)(ws + WS_XN), (float*)(ws + WS_SS8)); } BAR();
        if (L == 0) { unsigned char* ws = WSP; GEMM_PHASE(EGateN<false>, ws + WS_XN, ws + WS_WG, DM, DM, OUTP, (pg8::bf16_t*)(ws + WS_UP), (const float*)(ws + WS_SS8), (pg8::bf16_t*)(ws + WS_XN2), (float*)(ws + WS_SS16)); BAR(); }
        else { unsigned char* ws = WSP; GEMM_PHASE(EGateN<true>, ws + WS_XN, ws + WS_WG + 2 * MiB, DM, DM, OUTP, (pg8::bf16_t*)(ws + WS_UP), (const float*)(ws + WS_SS8), (pg8::bf16_t*)(ws + WS_XN2), (float*)(ws + WS_SS16)); STAMP(); }
    }
    if (PROBE_A >= 0 && bidx() == 0 && tidx() == 0) {
        const unsigned long long target = (unsigned long long)PROBE_K * (TSW[PROBE_B] - TSW[PROBE_A]), t0 = __builtin_amdgcn_s_memrealtime();
        while (__builtin_amdgcn_s_memrealtime() - t0 < target) __builtin_amdgcn_s_sleep(32);
    }
}

extern "C" void kernel_launch(void* const* d_in, const int* in_sizes, int n_in, void* d_out, int out_size, void* d_ws, size_t ws_size, hipStream_t stream) {
    static int grid_blocks = 0;
    if (grid_blocks == 0) {
        if (n_in != 22 || out_size != T * DM || ws_size < WS_END) { fprintf(stderr, "kernel_launch: unexpected shapes: n_in %d out %d ws %zu\n", n_in, out_size, ws_size); grid_blocks = -1; return; }
        if (hipFuncSetAttribute((const void*)k_mega, hipFuncAttributeMaxDynamicSharedMemorySize, LDS_BYTES) != hipSuccess) { fprintf(stderr, "hipFuncSetAttribute failed\n"); grid_blocks = -1; return; }
        int dev = 0, cus = 0, per_cu = 0;
        hipGetDevice(&dev);
        hipDeviceGetAttribute(&cus, hipDeviceAttributeMultiprocessorCount, dev);
        hipOccupancyMaxActiveBlocksPerMultiprocessor(&per_cu, (const void*)k_mega, NT, LDS_BYTES);
        if (per_cu < 1 || cus < 1) { fprintf(stderr, "kernel_launch: occupancy query says %d blocks/CU on %d CUs\n", per_cu, cus); grid_blocks = -1; return; }
        grid_blocks = cus;
    }
    if (grid_blocks < 0) return;
    Params P{};
    for (int i = 0; i < 22; ++i) P.in[i] = (const float*)d_in[i];
    P.out = (float*)d_out; P.ws = (unsigned char*)d_ws;
    if (hipMemsetAsync((char*)d_ws + WS_CTL, 0, 1 * MiB, stream) != hipSuccess) { fprintf(stderr, "kernel_launch: hipMemsetAsync failed\n"); return; }
    void* args[] = {&P};
    hipError_t e = hipLaunchCooperativeKernel((const void*)k_mega, dim3(grid_blocks), dim3(NT), args, LDS_BYTES, stream);
    if (e != hipSuccess) fprintf(stderr, "cooperative launch failed: %s (grid %d)\n", hipGetErrorString(e), grid_blocks);
}
```

```cpp
#include <hip/hip_runtime.h>
#include <hip/hip_cooperative_groups.h>
#include <cstdio>
#include <cstdint>

constexpr int BATCH = 2, SEQ = 8192, T = BATCH * SEQ, DM = 1024;
constexpr int AB_N = 3396, AB_LD = 3584;
constexpr int CQA = 0, CKA = 512, CVA = 1024, CQB = 1536, CKB = 2048, CVB = 2560, CQI = 3072, CKI = 3328, CWI = 3392;
constexpr int C_LD = 3072;
constexpr int NEXP = 16384;
constexpr float NORM_EPS = 1e-6f;
constexpr float C2 = 0.125f * 1.4426950408889634f;
constexpr int NT = 512;
constexpr int PROBE_A = -1, PROBE_B = 0, PROBE_K = 4;

constexpr size_t MiB = 1u << 20;
constexpr size_t WS_CTL = 0;
constexpr size_t WS_WAB_IN = 1 * MiB, WS_WAB_OUT = 8 * MiB, WS_WC_IN = 10 * MiB, WS_WC_OUT = 16 * MiB;
constexpr size_t WS_WQ = 18 * MiB, WS_WG = 26 * MiB, WS_WUP = 30 * MiB, WS_SUBK = 31 * MiB;
constexpr size_t WS_KMEAN = 32 * MiB;
constexpr size_t WS_SEL = 33 * MiB;
constexpr size_t WS_LSE = 34 * MiB;
constexpr size_t WS_EIDX = 37 * MiB;
constexpr size_t WS_GW = 45 * MiB;
constexpr size_t WS_P = 53 * MiB;
constexpr size_t WS_XN = 69 * MiB;
constexpr size_t WS_QKV = 101 * MiB;
constexpr size_t WS_MASK = 213 * MiB;
constexpr size_t WS_SCORES = 229 * MiB;
constexpr size_t WS_EXP = 229 * MiB;
constexpr size_t WS_QRY = 101 * MiB;
constexpr size_t WS_PA = 101 * MiB;
constexpr size_t WS_UP = 165 * MiB;
constexpr size_t WS_QKV1 = 357 * MiB;
constexpr size_t WS_OG = 101 * MiB;
constexpr size_t WS_XN2 = 453 * MiB;
constexpr size_t WS_SS16 = 505 * MiB;
constexpr size_t WS_SS8 = 506 * MiB;
constexpr size_t WS_CST = 507 * MiB;
constexpr size_t WS_GTAB = 508 * MiB;
constexpr size_t WS_END = 512 * MiB;

typedef unsigned short bf16;
typedef float f32x4 __attribute__((ext_vector_type(4)));

__device__ __forceinline__ unsigned f2bf(float f) { unsigned u = __builtin_bit_cast(unsigned, f); return (u + 0x7fffu + ((u >> 16) & 1u)) >> 16; }
__device__ __forceinline__ float bf2f(bf16 h) { return __builtin_bit_cast(float, (unsigned)h << 16); }
template <int M> __device__ __forceinline__ int shx_bits(int v) {
    if constexpr (M < 32) return __builtin_amdgcn_ds_swizzle(v, (M << 10) | 0x1f);
    else { const auto rr = __builtin_amdgcn_permlane32_swap((unsigned)v, (unsigned)v, false, false); return (int)((rr[0] == (unsigned)v) ? rr[1] : rr[0]); }
}
template <int M> __device__ __forceinline__ float shx(float v) { return __builtin_bit_cast(float, shx_bits<M>(__builtin_bit_cast(int, v))); }
template <int M> __device__ __forceinline__ int shx(int v) { return shx_bits<M>(v); }
template <int M> __device__ __forceinline__ unsigned shx(unsigned v) { return (unsigned)shx_bits<M>((int)v); }
__device__ __forceinline__ int bperm(int srclane, int v) { return __builtin_amdgcn_ds_bpermute(srclane << 2, v); }
__device__ __forceinline__ float bperm(int srclane, float v) { return __builtin_bit_cast(float, __builtin_amdgcn_ds_bpermute(srclane << 2, __builtin_bit_cast(int, v))); }
__device__ __forceinline__ float wave_sum(float v) {
    v += shx<1>(v); v += shx<2>(v); v += shx<4>(v); v += shx<8>(v); v += shx<16>(v); v += shx<32>(v);
    return v;
}
__device__ __forceinline__ float wave_max(float v) {
    v = fmaxf(v, shx<1>(v)); v = fmaxf(v, shx<2>(v)); v = fmaxf(v, shx<4>(v)); v = fmaxf(v, shx<8>(v)); v = fmaxf(v, shx<16>(v)); v = fmaxf(v, shx<32>(v));
    return v;
}
__device__ __forceinline__ unsigned okey(float f) { unsigned u = __builtin_bit_cast(unsigned, f); return (u & 0x80000000u) ? ~u : (u | 0x80000000u); }

#define TID_TAB ((volatile __attribute__((address_space(3))) unsigned*)(131072 + 512))
__device__ __forceinline__ unsigned hw_slot() { return (unsigned)__builtin_amdgcn_s_getreg(((6 - 1) << 11) | 4); }
__device__ __forceinline__ int tidx() { const unsigned w = TID_TAB[hw_slot()]; int l; asm volatile("v_mbcnt_lo_u32_b32 %0, -1, 0\n\tv_mbcnt_hi_u32_b32 %0, -1, %0" : "=v"(l)); int t = (int)(w << 6) | l; asm volatile("" : "+v"(t)); return t; }
__device__ __forceinline__ int bidx() { int b = __builtin_amdgcn_workgroup_id_x(); asm volatile("" : "+s"(b)); return b; }
struct Params {
    const float* in[22];
    float* out;
    unsigned char* ws;
    int layer;
    int pad;
};

typedef const __attribute__((address_space(4))) unsigned long long* karg_t;
__device__ __forceinline__ unsigned long long karg(int idx) { karg_t ka = (karg_t)__builtin_amdgcn_kernarg_segment_ptr(); asm volatile("" : "+s"(ka)); return ka[idx]; }
#define GASP __attribute__((address_space(1)))
#define IN(i) ((const float*)(const GASP float*)karg(i))
#define OUTP ((float*)(GASP float*)karg(22))
#define WSP ((unsigned char*)(GASP unsigned char*)karg(23))

__device__ __forceinline__ void ph_rmsnorm(const float* src, const float* gain, bf16* dst) {
    const int lane = tidx() & 63, wave = tidx() >> 6;
    const int gw = bidx() * (NT / 64) + wave, ngw = gridDim.x * (NT / 64);
    for (int r = gw; r < T; r += ngw) {
        const f32x4* xr = (const f32x4*)(src + (size_t)r * DM) + lane;
        f32x4 v[4]; float s = 0.f;
#pragma unroll
        for (int j = 0; j < 4; ++j) { v[j] = xr[64 * j]; s += v[j].x * v[j].x + v[j].y * v[j].y + v[j].z * v[j].z + v[j].w * v[j].w; }
        const float rstd = 1.0f / sqrtf(wave_sum(s) * (1.0f / DM) + NORM_EPS);
#pragma unroll
        for (int j = 0; j < 4; ++j) {
            const f32x4 g = ((const f32x4*)gain)[lane + 64 * j];
            unsigned long long o = (unsigned long long)(f2bf(v[j].x * rstd * g.x) | (f2bf(v[j].y * rstd * g.y) << 16)) |
                                   ((unsigned long long)(f2bf(v[j].z * rstd * g.z) | (f2bf(v[j].w * rstd * g.w) << 16)) << 32);
            ((unsigned long long*)(dst + (size_t)r * DM))[lane + 64 * j] = o;
        }
    }
}

template <class AT> __device__ __forceinline__ float ldA(const AT* p);
template <> __device__ __forceinline__ float ldA<bf16>(const bf16* p) { return bf2f(*p); }
template <> __device__ __forceinline__ float ldA<float>(const float* p) { return *p; }

template <class AT, class Epi> __forceinline__
__device__ __forceinline__ void ph_gemm_naive(const AT* A, int lda, const float* B, int N, int K, const Epi& E, unsigned char* smem) {
    float* As = (float*)smem;
    float* Bs = As + 16 * 132;
    const int tid = tidx(), ty = tid >> 5, tx = tid & 31;
    const int ntn = (N + 127) / 128, ntm = T / 128, ntile = ntn * ntm;
    for (int tile = bidx(); tile < ntile; tile += gridDim.x) {
        const int tm = tile / ntn, tn = tile % ntn, m0 = tm * 128, n0 = tn * 128;
        float acc[8][4];
#pragma unroll
        for (int i = 0; i < 8; ++i)
#pragma unroll
            for (int j = 0; j < 4; ++j) acc[i][j] = 0.f;
        for (int k0 = 0; k0 < K; k0 += 16) {
            __syncthreads();
#pragma unroll
            for (int i = 0; i < 4; ++i) { const int e = tid + i * NT, r = e >> 4, kk = e & 15; As[kk * 132 + r] = ldA<AT>(A + (size_t)(m0 + r) * lda + k0 + kk); }
#pragma unroll
            for (int i = 0; i < 4; ++i) { const int e = tid + i * NT, kk = e >> 7, c = e & 127; Bs[kk * 128 + c] = (n0 + c < N) ? B[(size_t)(k0 + kk) * N + n0 + c] : 0.f; }
            __syncthreads();
#pragma unroll 2
            for (int kk = 0; kk < 16; ++kk) {
                float a[8], b[4];
#pragma unroll
                for (int i = 0; i < 8; ++i) a[i] = As[kk * 132 + ty * 8 + i];
#pragma unroll
                for (int j = 0; j < 4; ++j) b[j] = Bs[kk * 128 + tx * 4 + j];
#pragma unroll
                for (int i = 0; i < 8; ++i)
#pragma unroll
                    for (int j = 0; j < 4; ++j) acc[i][j] += a[i] * b[j];
            }
        }
#pragma unroll
        for (int i = 0; i < 8; ++i) {
            const int col = n0 + tx * 4;
            if (col < N) E.store4(m0 + ty * 8 + i, col, (f32x4){acc[i][0], acc[i][1], acc[i][2], acc[i][3]});
        }
    }
}
struct EpBf16 { bf16* O; int ldc;
    __device__ __forceinline__ void store4(int r, int c, f32x4 v) const {
        unsigned long long o = (unsigned long long)(f2bf(v.x) | (f2bf(v.y) << 16)) | ((unsigned long long)(f2bf(v.z) | (f2bf(v.w) << 16)) << 32);
        *(unsigned long long*)(O + (size_t)r * ldc + c) = o; } };
struct EpResAdd { const float* base; float* out;
    __device__ __forceinline__ void store4(int r, int c, f32x4 v) const {
        const f32x4 b = *(const f32x4*)(base + (size_t)r * DM + c); *(f32x4*)(out + (size_t)r * DM + c) = b + v; } };
struct EpGate { float* h; const bf16* up;
    __device__ __forceinline__ void store4(int r, int c, f32x4 v) const {
        f32x4 hv = *(const f32x4*)(h + (size_t)r * DM + c); const bf16* u = up + (size_t)r * DM + c;
        hv.x += bf2f(u[0]) / (1.f + __expf(-v.x)); hv.y += bf2f(u[1]) / (1.f + __expf(-v.y));
        hv.z += bf2f(u[2]) / (1.f + __expf(-v.z)); hv.w += bf2f(u[3]) / (1.f + __expf(-v.w));
        *(f32x4*)(h + (size_t)r * DM + c) = hv; } };

__device__ __forceinline__ void rope_cs(int pos, int i, float& c, float& s) {
    const float inv = exp2f(-(float)i * 0.125f * 18.931568569324174f);
    const float ang = (float)pos * inv;
    const float k = rintf(ang * 0.15915494309189535f);
    float r = fmaf(-k, 6.28125f, ang); r = fmaf(-k, 1.9353071795864769e-3f, r);
    c = cosf(r); s = sinf(r);
}
__device__ __forceinline__ void prep_head(bf16* p, const float* gain, int pos, float scale, bool donorm, int lane) {
    float v = bf2f(p[lane]);
    if (donorm) { const float ss = wave_sum(v * v); v = v * (1.0f / sqrtf(ss * (1.0f / 64.f) + NORM_EPS)) * gain[lane]; }
    const float partner = __shfl_xor(v, 8);
    float c = 1.f, s = 0.f;
    if (lane < 16) rope_cs(pos, lane & 7, c, s);
    float o = v;
    if (lane < 8) o = v * c - partner * s; else if (lane < 16) o = v * c + partner * s;
    p[lane] = (bf16)f2bf(o * scale);
}
__device__ __forceinline__ void ph_prep0(bf16* qkv, const int* positions, const float* aq, const float* ak, const float* bq, const float* bk) {
    const int lane = tidx() & 63, wave = tidx() >> 6;
    const int gw = bidx() * (NT / 64) + wave, ngw = gridDim.x * (NT / 64);
    for (int r = gw; r < T; r += ngw) {
        const int pos = positions[r]; bf16* row = qkv + (size_t)r * AB_LD;
        for (int h = 0; h < 8; ++h) {
            prep_head(row + CQA + h * 64, aq, pos, C2, true, lane);
            prep_head(row + CKA + h * 64, ak, pos, 1.f, true, lane);
            prep_head(row + CQB + h * 64, bq, pos, C2, true, lane);
            prep_head(row + CKB + h * 64, bk, pos, 1.f, true, lane);
        }
        for (int h = 0; h < 4; ++h) prep_head(row + CQI + h * 64, nullptr, pos, 1.f, false, lane);
        prep_head(row + CKI, nullptr, pos, 1.f, false, lane);
    }
}
__device__ __forceinline__ void ph_prep1(bf16* qkv, const int* positions, const float* cq, const float* ck) {
    const int lane = tidx() & 63, wave = tidx() >> 6;
    const int gw = bidx() * (NT / 64) + wave, ngw = gridDim.x * (NT / 64);
    for (int r = gw; r < T; r += ngw) {
        const int pos = positions[r]; bf16* row = qkv + (size_t)r * C_LD;
        for (int h = 0; h < 16; ++h) {
            prep_head(row + h * 64, cq, pos, C2, true, lane);
            prep_head(row + 1024 + h * 64, ck, pos, 1.f, true, lane);
        }
    }
}
__device__ __forceinline__ void ph_kmean(const bf16* qkv, float* kmean) {
    const int lane = tidx() & 63, wave = tidx() >> 6;
    const int gw = bidx() * (NT / 64) + wave, ngw = gridDim.x * (NT / 64);
    for (int it = gw; it < BATCH * 8 * 32; it += ngw) {
        const int b = it / 256, h = (it / 32) % 8, n = it % 32;
        float s = 0.f;
        for (int r = 0; r < 256; ++r) s += bf2f(qkv[(size_t)(b * SEQ + n * 256 + r) * AB_LD + CKA + h * 64 + lane]);
        kmean[(size_t)it * 64 + lane] = s * (1.0f / 256.f);
    }
}
__device__ __forceinline__ void ph_moba_select(const bf16* qkv, const float* kmean, unsigned* sel) {
    for (int it = bidx() * NT + tidx(); it < T * 8; it += gridDim.x * NT) {
        const int t = it >> 3, h = it & 7, b = t / SEQ, qblk = (t % SEQ) / 256;
        float q[64];
#pragma unroll
        for (int d = 0; d < 64; ++d) q[d] = bf2f(qkv[(size_t)t * AB_LD + CQA + h * 64 + d]);
        float v0 = -3e38f, v1 = -3e38f, v2 = -3e38f; int i0 = 255, i1 = 255, i2 = 255;
        for (int n = 0; n < qblk; ++n) {
            const float* km = kmean + (size_t)((b * 8 + h) * 32 + n) * 64; float g = 0.f;
#pragma unroll
            for (int d = 0; d < 64; ++d) g += q[d] * km[d];
            if (g > v0) { v2 = v1; i2 = i1; v1 = v0; i1 = i0; v0 = g; i0 = n; }
            else if (g > v1) { v2 = v1; i2 = i1; v1 = g; i1 = n; }
            else if (g > v2) { v2 = g; i2 = n; }
        }
        sel[it] = (unsigned)i0 | ((unsigned)i1 << 8) | ((unsigned)i2 << 16) | (255u << 24);
    }
}
__device__ __forceinline__ void ph_moba_attend(const bf16* qkv, const unsigned* sel, bf16* O, unsigned char* smem) {
    const int lane = tidx() & 63, wave = tidx() >> 6;
    float* pl = (float*)smem + wave * 1024;
    const int gw = bidx() * (NT / 64) + wave, ngw = gridDim.x * (NT / 64);
    for (int it = gw; it < T * 8; it += ngw) {
        const int t = it >> 3, h = it & 7, b = t / SEQ, tt = t % SEQ, qblk = tt / 256;
        const unsigned sw = sel[it];
        int blk[4] = {qblk, (int)(sw & 255), (int)((sw >> 8) & 255), (int)((sw >> 16) & 255)};
        const bf16* qp = qkv + (size_t)t * AB_LD + CQA + h * 64;
        float q[64];
#pragma unroll
        for (int d = 0; d < 64; ++d) q[d] = bf2f(qp[d]);
        float sc[16]; float mx = -3e38f;
#pragma unroll
        for (int s = 0; s < 4; ++s) {
#pragma unroll
            for (int i = 0; i < 4; ++i) {
                const int j = lane + 64 * i, pos = blk[s] * 256 + j;
                const bool ok = (blk[s] != 255) && (s > 0 || pos <= tt);
                float a = -3e38f;
                if (ok) { const bf16* kp = qkv + (size_t)(b * SEQ + pos) * AB_LD + CKA + h * 64; a = 0.f;
#pragma unroll
                    for (int d = 0; d < 64; ++d) a += q[d] * bf2f(kp[d]); }
                sc[s * 4 + i] = a; mx = fmaxf(mx, a);
            }
        }
        mx = wave_max(mx); float l = 0.f;
#pragma unroll
        for (int e = 0; e < 16; ++e) { const float p = (sc[e] > -1e38f) ? exp2f(sc[e] - mx) : 0.f; l += p; pl[(e >> 2) * 256 + lane + 64 * (e & 3)] = p; }
        l = wave_sum(l);
        __builtin_amdgcn_s_waitcnt(0);
        float o = 0.f;
#pragma unroll
        for (int s = 0; s < 4; ++s) {
            if (blk[s] == 255) continue;
            const int nk = (s == 0) ? (tt - qblk * 256 + 1) : 256;
            const bf16* vp = qkv + (size_t)(b * SEQ + blk[s] * 256) * AB_LD + CVA + h * 64 + lane;
            for (int j = 0; j < nk; ++j) o += pl[s * 256 + j] * bf2f(vp[(size_t)j * AB_LD]);
        }
        O[(size_t)t * DM + h * 64 + lane] = (bf16)f2bf(o / l);
    }
}
__device__ __forceinline__ void ph_dsa_select(const bf16* qkv, unsigned long long* mask, unsigned char* smem) {
    unsigned* keys = (unsigned*)smem;
    unsigned* cnt = keys + 8192;
    const int tid = tidx(), lane = tid & 63;
    for (int t = bidx(); t < T; t += gridDim.x) {
        const int b = t / SEQ, tt = t % SEQ, n = tt + 1;
        __syncthreads();
        const bf16* row = qkv + (size_t)t * AB_LD;
        float* qf = (float*)(cnt + 4);
        if (tid < 256) qf[tid] = bf2f(row[CQI + tid]);
        if (tid < 4) qf[256 + tid] = bf2f(row[CWI + tid]);
        __syncthreads();
        for (int kv = tid; kv < 8192; kv += NT) {
            unsigned key = 0u;
            if (kv < n) {
                const bf16* kp = qkv + (size_t)(b * SEQ + kv) * AB_LD + CKI;
                float a0 = 0.f, a1 = 0.f, a2 = 0.f, a3 = 0.f;
                for (int d = 0; d < 64; ++d) { const float kd = bf2f(kp[d]); a0 += qf[d] * kd; a1 += qf[64 + d] * kd; a2 += qf[128 + d] * kd; a3 += qf[192 + d] * kd; }
                const float s = ((qf[256] * fmaxf(a0, 0.f) + qf[257] * fmaxf(a1, 0.f)) + qf[258] * fmaxf(a2, 0.f)) + qf[259] * fmaxf(a3, 0.f);
                key = okey(s);
            }
            keys[kv] = key;
        }
        __syncthreads();
        unsigned thr = 0u, need = 0u;
        if (n > 256) {
            unsigned lo = 0u, hi = 0xFFFFFFFFu;
            while (lo < hi) {
                const unsigned mid = lo + ((hi - lo) >> 1) + ((hi - lo) & 1u);
                if (tid == 0) cnt[0] = 0u;
                __syncthreads();
                unsigned c = 0;
                for (int kv = tid; kv < 8192; kv += NT) c += (keys[kv] >= mid) ? 1u : 0u;
                c = (unsigned)wave_sum((float)c);
                if (lane == 0) atomicAdd(&cnt[0], c);
                __syncthreads();
                const unsigned tot = cnt[0];
                __syncthreads();
                if (tot >= 256u) lo = mid; else hi = mid - 1u;
            }
            thr = lo;
            if (tid == 0) cnt[1] = 0u;
            __syncthreads();
            unsigned c = 0;
            for (int kv = tid; kv < 8192; kv += NT) c += (keys[kv] > thr) ? 1u : 0u;
            c = (unsigned)wave_sum((float)c);
            if (lane == 0) atomicAdd(&cnt[1], c);
            __syncthreads();
            need = 256u - cnt[1];
        }
        if (tid < 64) {
            const int ntile = 4 * (tt / 256 + 1);
            unsigned taken = 0u;
            for (int j = 0; j < ntile; ++j) {
                const int kv = j * 64 + lane; const unsigned key = keys[kv];
                bool s;
                if (n <= 256) s = kv < n;
                else {
                    const bool gt = key > thr, eq = (key == thr) && (kv < n);
                    const unsigned long long em = __ballot(eq);
                    const unsigned rank = taken + (unsigned)__popcll(em & ((1ull << lane) - 1ull));
                    s = gt || (eq && rank < need);
                    taken += (unsigned)__popcll(em);
                }
                const unsigned long long m = __ballot(s);
                if (lane == 0) mask[((size_t)(b * 128 + j)) * SEQ + tt] = m;
            }
        }
    }
}
__device__ __forceinline__ void ph_dsa_attend(const bf16* qkv, const unsigned long long* mask, bf16* O, unsigned char* smem) {
    int* list = (int*)smem;
    int* cnt = list + 256;
    float* pr = (float*)(cnt + 4);
    float* linv = pr + 8 * 256;
    const int tid = tidx(), lane = tid & 63, wave = tid >> 6;
    for (int t = bidx(); t < T; t += gridDim.x) {
        const int b = t / SEQ, tt = t % SEQ;
        __syncthreads();
        const int ntile = 4 * (tt / 256 + 1);
        if (wave == 0) {
            int base = 0;
            for (int j = 0; j < ntile; ++j) {
                const unsigned long long m = mask[((size_t)(b * 128 + j)) * SEQ + tt];
                const int p = base + (int)__popcll(m & ((1ull << lane) - 1ull));
                if (((m >> lane) & 1ull) && p < 256) list[p] = j * 64 + lane;
                base += (int)__popcll(m);
            }
            if (lane == 0) cnt[0] = base;
        }
        __syncthreads();
        const int ns = min(cnt[0], 256);
        const bf16* row = qkv + (size_t)t * AB_LD;
        for (int e = tid; e < 8 * 256; e += NT) {
            const int h = e >> 8, j = e & 255; float a = -3e38f;
            if (j < ns) { const bf16* kp = qkv + (size_t)(b * SEQ + list[j]) * AB_LD + CKB + h * 64; a = 0.f;
                for (int d = 0; d < 64; ++d) a += bf2f(row[CQB + h * 64 + d]) * bf2f(kp[d]); }
            pr[e] = a;
        }
        __syncthreads();
        {
            const int h = wave; float v[4]; float mx = -3e38f;
#pragma unroll
            for (int i = 0; i < 4; ++i) { v[i] = pr[h * 256 + lane + 64 * i]; mx = fmaxf(mx, v[i]); }
            mx = wave_max(mx); float l = 0.f;
#pragma unroll
            for (int i = 0; i < 4; ++i) { const float p = (v[i] > -1e38f) ? exp2f(v[i] - mx) : 0.f; l += p; pr[h * 256 + lane + 64 * i] = p; }
            l = wave_sum(l); if (lane == 0) linv[h] = 1.0f / l;
        }
        __syncthreads();
        {   const int h = tid >> 6, d = tid & 63; float o = 0.f;
            for (int j = 0; j < ns; ++j) o += pr[h * 256 + j] * bf2f(qkv[(size_t)(b * SEQ + list[j]) * AB_LD + CVB + h * 64 + d]);
            O[(size_t)t * DM + 512 + h * 64 + d] = (bf16)f2bf(o * linv[h]); }
    }
}
__device__ __forceinline__ void ph_dilated(const bf16* qkv, bf16* OG, float* LSE) {
    const int lane = tidx() & 63, wave = tidx() >> 6;
    const int gw = bidx() * (NT / 64) + wave, ngw = gridDim.x * (NT / 64);
    for (int it = gw; it < T * 16; it += ngw) {
        const int t = it >> 4, h = it & 15, b = t / SEQ, tt = t % SEQ;
        const bf16* qp = qkv + (size_t)t * C_LD + h * 64;
        float q[64];
#pragma unroll
        for (int d = 0; d < 64; ++d) q[d] = bf2f(qp[d]);
        for (int g = 0; g < 3; ++g) {
            const int dil = (g == 0) ? 1 : (g == 1 ? 4 : 16);
            float sc[3]; float mx = -3e38f;
#pragma unroll
            for (int i = 0; i < 3; ++i) {
                const int j = lane + 64 * i, pos = tt - j * dil; float a = -3e38f;
                if (j <= 128 && pos >= 0) { const bf16* kp = qkv + (size_t)(b * SEQ + pos) * C_LD + 1024 + h * 64; a = 0.f;
#pragma unroll
                    for (int d = 0; d < 64; ++d) a += q[d] * bf2f(kp[d]); }
                sc[i] = a; mx = fmaxf(mx, a);
            }
            mx = wave_max(mx); float l = 0.f; float p[3];
#pragma unroll
            for (int i = 0; i < 3; ++i) { p[i] = (sc[i] > -1e38f) ? exp2f(sc[i] - mx) : 0.f; l += p[i]; }
            l = wave_sum(l);
            float o = 0.f;
            for (int j = 0; j <= 128; ++j) {
                const int pos = tt - j * dil; if (pos < 0) break;
                const float pj = (j < 64) ? __shfl(p[0], j) : ((j < 128) ? __shfl(p[1], j - 64) : __shfl(p[2], 0));
                o += pj * bf2f(qkv[(size_t)(b * SEQ + pos) * C_LD + 2048 + h * 64 + lane]);
            }
            OG[((size_t)g * T + t) * DM + h * 64 + lane] = (bf16)f2bf(o / l);
            if (lane == 0) LSE[((size_t)g * T + t) * 16 + h] = mx + log2f(l);
        }
    }
}
__device__ __forceinline__ void ph_dil_merge(const bf16* OG, const float* LSE, bf16* O) {
    for (size_t e = (size_t)bidx() * NT + tidx(); e < (size_t)T * DM; e += (size_t)gridDim.x * NT) {
        const int t = (int)(e >> 10), c = (int)(e & 1023), h = c >> 6;
        const float l0 = LSE[((size_t)0 * T + t) * 16 + h], l1 = LSE[((size_t)1 * T + t) * 16 + h], l2 = LSE[((size_t)2 * T + t) * 16 + h];
        const float m = fmaxf(l0, fmaxf(l1, l2)); const float w0 = exp2f(l0 - m), w1 = exp2f(l1 - m), w2 = exp2f(l2 - m);
        const float o = (w0 * bf2f(OG[e]) + w1 * bf2f(OG[(size_t)T * DM + e]) + w2 * bf2f(OG[(size_t)2 * T * DM + e])) / (w0 + w1 + w2);
        O[e] = (bf16)f2bf(o);
    }
}
__device__ __forceinline__ void ph_peer_route(const bf16* qry, const float* subk, int* eidx, float* gw, unsigned char* smem) {
    float* s = (float*)smem;
    float* sv = s + 2048;
    int* si = (int*)(sv + 256);
    float* qf = (float*)(si + 256);
    const int tid = tidx(), lane = tid & 63, wave = tid >> 6;
    for (int t = bidx(); t < T; t += gridDim.x) {
        __syncthreads();
        for (int e = tid; e < 2048; e += NT) qf[e] = bf2f(qry[(size_t)t * 2048 + e]);
        __syncthreads();
        for (int e = tid; e < 2048; e += NT) {
            const int hc = e >> 7, k = e & 127; const float* kp = subk + ((size_t)hc * 128 + k) * 128; float a = 0.f;
            for (int d = 0; d < 128; ++d) a += qf[hc * 128 + d] * kp[d];
            s[e] = a;
        }
        __syncthreads();
        for (int hc = wave; hc < 16; hc += NT / 64) {
            float v0 = s[hc * 128 + lane], v1 = s[hc * 128 + 64 + lane];
            for (int r = 0; r < 16; ++r) {
                float bv = v0; int bi = lane;
                if (v1 > bv) { bv = v1; bi = lane + 64; }
#pragma unroll
                for (int o = 1; o < 64; o <<= 1) { const float ov = __shfl_xor(bv, o); const int oi = __shfl_xor(bi, o); if (ov > bv || (ov == bv && oi < bi)) { bv = ov; bi = oi; } }
                if (lane == 0) { sv[hc * 16 + r] = bv; si[hc * 16 + r] = bi; }
                if (bi == lane) v0 = -3e38f; if (bi == lane + 64) v1 = -3e38f;
            }
        }
        __syncthreads();
        {   const int h = wave;
            float c[4]; int ci[4];
#pragma unroll
            for (int i = 0; i < 4; ++i) { const int f = lane + 64 * i; c[i] = sv[(h * 2) * 16 + (f >> 4)] + sv[(h * 2 + 1) * 16 + (f & 15)]; ci[i] = f; }
            float cv[16]; int cf[16];
#pragma unroll
            for (int r = 0; r < 16; ++r) {
                float bv = c[0]; int bi = ci[0];
#pragma unroll
                for (int i = 1; i < 4; ++i) if (c[i] > bv) { bv = c[i]; bi = ci[i]; }
#pragma unroll
                for (int o = 1; o < 64; o <<= 1) { const float ov = __shfl_xor(bv, o); const int oi = __shfl_xor(bi, o); if (ov > bv || (ov == bv && oi < bi)) { bv = ov; bi = oi; } }
                cv[r] = bv; cf[r] = bi;
#pragma unroll
                for (int i = 0; i < 4; ++i) if (ci[i] == bi) c[i] = -3e38f;
            }
            float l = 0.f;
#pragma unroll
            for (int r = 0; r < 16; ++r) l += __expf(cv[r] - cv[0]);
            if (lane < 16) {
                float myv = 0.f; int myf = 0;
#pragma unroll
                for (int r = 0; r < 16; ++r) if (r == lane) { myv = cv[r]; myf = cf[r]; }
                eidx[(size_t)t * 128 + h * 16 + lane] = si[(h * 2) * 16 + (myf >> 4)] * 128 + si[(h * 2 + 1) * 16 + (myf & 15)];
                gw[(size_t)t * 128 + h * 16 + lane] = __expf(myv - cv[0]) / l;
            }
        }
    }
}
__device__ __forceinline__ float gelu_tanh(float x) { const float u = 0.7978845608028654f * (x + 0.044715f * x * x * x); return 0.5f * x * (1.f + tanhf(u)); }
__device__ __forceinline__ void ph_peer_gather(const bf16* xn, const int* eidx, const float* gw, const float* U, const float* V, float* h, unsigned char* smem) {
    float* xf = (float*)smem;
    float* w = xf + 1024;
    int* ei = (int*)(w + 128);
    const int tid = tidx(), lane = tid & 63, wave = tid >> 6;
    for (int t = bidx(); t < T; t += gridDim.x) {
        __syncthreads();
        for (int e = tid; e < 1024; e += NT) xf[e] = bf2f(xn[(size_t)t * DM + e]);
        if (tid < 128) ei[tid] = eidx[(size_t)t * 128 + tid];
        __syncthreads();
        for (int e = wave; e < 128; e += NT / 64) {
            const float* up = U + (size_t)ei[e] * DM; float a = 0.f;
            for (int d = lane; d < 1024; d += 64) a += xf[d] * up[d];
            a = wave_sum(a);
            if (lane == 0) w[e] = gw[(size_t)t * 128 + e] * gelu_tanh(a);
        }
        __syncthreads();
        for (int d = tid; d < 1024; d += NT) {
            float o = 0.f;
            for (int e = 0; e < 128; ++e) o += w[e] * V[(size_t)ei[e] * DM + d];
            h[(size_t)t * DM + d] += o;
        }
    }
}

namespace pg8 {
#define PG8_LAS __attribute__((address_space(3)))
typedef unsigned short bf16_t;
typedef short bf16x8 __attribute__((ext_vector_type(8)));
typedef float f32x4 __attribute__((ext_vector_type(4)));
typedef unsigned u32x4 __attribute__((ext_vector_type(4)));
constexpr int BM = 256, BK = 64, HALF = 128, HTB = HALF * BK * 2  , STAGE_BYTES = 8 * HTB, NXCD = 8, WGM = 8;

__host__ __device__ __forceinline__ int lds_byte(int r, int c) { const int st = (r >> 4) * 2 + (c >> 5), rr = r & 15, cc = c & 31, ob = rr * 64 + cc * 2; return st * 1024 + (ob ^ (((ob >> 9) & 1) << 5)); }
__host__ __device__ __forceinline__ void stage_rc(int b, int& R, int& C) { const int st = b / 1024, sb = b % 1024, swz = sb ^ (((sb >> 9) & 1) << 5); R = (st >> 1) * 16 + swz / 64; C = (st & 1) * 32 + (swz % 64) / 2; }
__host__ __device__ __forceinline__ int perm32(int rho) { const int n = rho >> 4, i = rho & 15; return 8 * (i >> 2) + 4 * n + (i & 3); }

struct Unit { int pm, pn; };
struct Gemm { const bf16_t* A; const bf16_t* Bt; int M, N, K; };

struct StaticOrder {
    int nM, nN, nwg, G, c;
    __host__ __device__ void init(int M, int N, int G_, int c_) { nM = M / BM; nN = N / BM; nwg = nM * nN; G = G_; c = c_; }
    __host__ __device__ bool next(int i, Unit& u) const {
        const long L = (long)i * G + c; if (L >= nwg) return false;
        int wgid = (int)L; { const int q = nwg / NXCD, r = nwg % NXCD, xcd = wgid % NXCD, off = wgid / NXCD; wgid = (xcd < r ? xcd * (q + 1) : r * (q + 1) + (xcd - r) * q) + off; }
        const int nig = WGM * nN, gid = wgid / nig, fm = gid * WGM, gsz = (nM - fm) < WGM ? (nM - fm) : WGM;
        u.pm = fm + ((wgid % nig) % gsz); u.pn = (wgid % nig) / gsz; return true;
    }
    __device__ __forceinline__ void a_ready(const Unit&) const {}
    __device__ __forceinline__ void done(const Unit&) const {}
};


__device__ __forceinline__ unsigned pk_bf16(float lo, float hi) { typedef float f2 __attribute__((ext_vector_type(2))); typedef __bf16 b2 __attribute__((ext_vector_type(2))); f2 v = {lo, hi}; b2 b = __builtin_convertvector(v, b2); return __builtin_bit_cast(unsigned, b); }
struct EBf16 {
    static constexpr bool PERM = true, AFTER_DRAIN = false; bf16_t* O; int ldc;
    __device__ __forceinline__ void operator()(const f32x4 (&acc)[2][2][4][2], const Unit& u, int wr, int wc, int, int) const {
        const int lane_ = ::tidx() & 63, fr = lane_ & 15, fq = lane_ >> 4;
        const int row0 = u.pm * BM + wr * 64 + fr, col0 = u.pn * BM + wc * 32 + 8 * fq;
#pragma unroll
        for (int ai = 0; ai < 2; ++ai)
#pragma unroll
            for (int m = 0; m < 4; ++m) { bf16_t* rowp = O + (size_t)(row0 + ai * HALF + m * 16) * ldc + col0;
#pragma unroll
                for (int bj = 0; bj < 2; ++bj) { const f32x4 v0 = acc[ai][bj][m][0], v1 = acc[ai][bj][m][1];
                    u32x4 w; w.x = pk_bf16(v0[0], v0[1]); w.y = pk_bf16(v0[2], v0[3]); w.z = pk_bf16(v1[0], v1[1]); w.w = pk_bf16(v1[2], v1[3]);
                    *(u32x4*)(rowp + bj * HALF) = w; } }
    }
};
struct EResAdd {
    static constexpr bool PERM = false, AFTER_DRAIN = false; const float* base; float* out;
    __device__ __forceinline__ void operator()(const f32x4 (&acc)[2][2][4][2], const Unit& u, int wr, int wc, int fr, int fq) const {
        const int col0 = u.pn * BM + wc * 32 + 4 * fq;
#pragma unroll
        for (int ai = 0; ai < 2; ++ai)
#pragma unroll
            for (int m = 0; m < 4; ++m) { const size_t off = (size_t)(u.pm * BM + ai * HALF + wr * 64 + m * 16 + fr) * 1024 + col0;
#pragma unroll
                for (int bj = 0; bj < 2; ++bj)
#pragma unroll
                    for (int n = 0; n < 2; ++n) { const f32x4 b = *(const f32x4*)(base + off + bj * HALF + n * 16); *(f32x4*)(out + off + bj * HALF + n * 16) = b + acc[ai][bj][m][n]; } }
    }
};
struct EGate {
    static constexpr bool PERM = false, AFTER_DRAIN = false; float* h; const bf16_t* up;
    __device__ __forceinline__ void operator()(const f32x4 (&acc)[2][2][4][2], const Unit& u, int wr, int wc, int fr, int fq) const {
        const int col0 = u.pn * BM + wc * 32 + 4 * fq;
#pragma unroll
        for (int ai = 0; ai < 2; ++ai)
#pragma unroll
            for (int m = 0; m < 4; ++m) { const size_t off = (size_t)(u.pm * BM + ai * HALF + wr * 64 + m * 16 + fr) * 1024 + col0;
#pragma unroll
                for (int bj = 0; bj < 2; ++bj)
#pragma unroll
                    for (int n = 0; n < 2; ++n) { const size_t o = off + bj * HALF + n * 16; f32x4 hv = *(const f32x4*)(h + o);
                        const unsigned long long uu = *(const unsigned long long*)(up + o); const f32x4 a = acc[ai][bj][m][n];
                        hv[0] += __builtin_bit_cast(float, (unsigned)(uu << 16)) / (1.f + __expf(-a[0]));
                        hv[1] += __builtin_bit_cast(float, (unsigned)(uu & 0xffff0000ull)) / (1.f + __expf(-a[1]));
                        hv[2] += __builtin_bit_cast(float, (unsigned)((uu >> 16) & 0xffff0000ull)) / (1.f + __expf(-a[2]));
                        hv[3] += __builtin_bit_cast(float, (unsigned)((uu >> 32) & 0xffff0000ull)) / (1.f + __expf(-a[3]));
                        *(f32x4*)(h + o) = hv; } }
    }
};

__device__ __forceinline__ float rstd16(const float* ss, int row) { const f32x4 a = *(const f32x4*)(ss + (size_t)row * 16), b = *(const f32x4*)(ss + (size_t)row * 16 + 4), c = *(const f32x4*)(ss + (size_t)row * 16 + 8), d = *(const f32x4*)(ss + (size_t)row * 16 + 12);
    const float t = ((a[0] + a[1]) + (a[2] + a[3])) + ((b[0] + b[1]) + (b[2] + b[3])) + ((c[0] + c[1]) + (c[2] + c[3])) + ((d[0] + d[1]) + (d[2] + d[3])); return 1.0f / sqrtf(t * (1.0f / 1024.f) + 1e-6f); }
__device__ __forceinline__ float rstd8(const float* ss, int row) { const f32x4 a = *(const f32x4*)(ss + (size_t)row * 8), b = *(const f32x4*)(ss + (size_t)row * 8 + 4);
    const float t = ((a[0] + a[1]) + (a[2] + a[3])) + ((b[0] + b[1]) + (b[2] + b[3])); return 1.0f / sqrtf(t * (1.0f / 1024.f) + 1e-6f); }
struct EBf16S {
    static constexpr bool PERM = true, AFTER_DRAIN = false; bf16_t* O; int ldc; const float* ss;
    __device__ __forceinline__ void operator()(const f32x4 (&acc)[2][2][4][2], const Unit& u, int wr, int wc, int fr, int fq) const {
        const int row0 = u.pm * BM + wr * 64 + fr, col0 = u.pn * BM + wc * 32 + 8 * fq;
#pragma unroll
        for (int ai = 0; ai < 2; ++ai)
#pragma unroll
            for (int m = 0; m < 4; ++m) { const int row = row0 + ai * HALF + m * 16; const float rs = rstd16(ss, row); bf16_t* rowp = O + (size_t)row * ldc + col0;
#pragma unroll
                for (int bj = 0; bj < 2; ++bj) { const f32x4 v0 = acc[ai][bj][m][0] * rs, v1 = acc[ai][bj][m][1] * rs;
                    u32x4 w; w.x = pk_bf16(v0[0], v0[1]); w.y = pk_bf16(v0[2], v0[3]); w.z = pk_bf16(v1[0], v1[1]); w.w = pk_bf16(v1[2], v1[3]);
                    *(u32x4*)(rowp + bj * HALF) = w; } }
    }
};
__device__ __forceinline__ int head_perm(int l) { return (l & ~255) | (((l >> 6) & 3) << 5) | (((l >> 4) & 3) << 3) | (l & 7) | (((l >> 3) & 1) << 7); }
template <int LAYER> struct EPrep {
    static constexpr bool PERM = true, AFTER_DRAIN = false; bf16_t* O; int ldc; const float* cst; const float* gtab; const float* ss;
    __device__ __forceinline__ void operator()(const f32x4 (&acc)[2][2][4][2], const Unit& u, int wr, int wc, int fr, int fq) const {
        const int hh = u.pn * 4 + wc;
        bool donorm, dorope; float scale; int gi;
        if (LAYER == 0) { const int grp = hh >> 3; donorm = (grp < 5) && (grp != 2); dorope = donorm || (hh >= 48 && hh <= 52); scale = (grp == 0 || grp == 3) ? 0.125f * 1.4426950408889634f : 1.f;
            gi = donorm ? ((grp < 2) ? grp : ((grp - 1) & 3)) : 6; }
        else { donorm = hh < 32; dorope = donorm; scale = (hh < 16) ? 0.125f * 1.4426950408889634f : 1.f; gi = donorm ? 4 + ((hh >> 4) & 1) : 6; }
        const float* gp = gtab + 64 * gi + 16 * fq;
        const f32x4 gn0 = *(const f32x4*)(gp) * scale, gn1 = *(const f32x4*)(gp + 4) * scale, gn2 = *(const f32x4*)(gp + 8) * scale, gn3 = *(const f32x4*)(gp + 12) * scale;
        const bool rot = dorope && (fq == 0);
        const int row0 = u.pm * BM + wr * 64 + fr;
#pragma unroll
        for (int ai = 0; ai < 2; ++ai)
#pragma unroll
            for (int m = 0; m < 4; ++m) { const int row = row0 + ai * HALF + m * 16;
                f32x4 v0 = acc[ai][0][m][0], v1 = acc[ai][0][m][1], v2 = acc[ai][1][m][0], v3 = acc[ai][1][m][1];
                if (LAYER == 1) { const float rs = rstd16(ss, row); v0 = v0 * rs; v1 = v1 * rs; v2 = v2 * rs; v3 = v3 * rs; }
                float sq = ((v0[0] * v0[0] + v0[1] * v0[1]) + (v0[2] * v0[2] + v0[3] * v0[3])) + ((v1[0] * v1[0] + v1[1] * v1[1]) + (v1[2] * v1[2] + v1[3] * v1[3]))
                         + ((v2[0] * v2[0] + v2[1] * v2[1]) + (v2[2] * v2[2] + v2[3] * v2[3])) + ((v3[0] * v3[0] + v3[1] * v3[1]) + (v3[2] * v3[2] + v3[3] * v3[3]));
                sq += ::shx<16>(sq); sq += ::shx<32>(sq);
                const float rstd = donorm ? 1.0f / sqrtf(sq * (1.0f / 64.f) + NORM_EPS) : 1.0f;
                v0 = v0 * rstd * gn0; v1 = v1 * rstd * gn1; v2 = v2 * rstd * gn2; v3 = v3 * rstd * gn3;
                const float* cp = cst + (size_t)row * 16;
                const f32x4 one = {1.f, 1.f, 1.f, 1.f}, zero = {0.f, 0.f, 0.f, 0.f};
                const f32x4 c0 = rot ? *(const f32x4*)(cp) : one, c1 = rot ? *(const f32x4*)(cp + 4) : one, s0 = rot ? *(const f32x4*)(cp + 8) : zero, s1 = rot ? *(const f32x4*)(cp + 12) : zero;
                const f32x4 r0 = v0 * c0 - v2 * s0, r1 = v1 * c1 - v3 * s1, r2 = v2 * c0 + v0 * s0, r3 = v3 * c1 + v1 * s1;
                u32x4 w0, w1;
                w0.x = pk_bf16(r0[0], r0[1]); w0.y = pk_bf16(r0[2], r0[3]); w0.z = pk_bf16(r1[0], r1[1]); w0.w = pk_bf16(r1[2], r1[3]);
                w1.x = pk_bf16(r2[0], r2[1]); w1.y = pk_bf16(r2[2], r2[3]); w1.z = pk_bf16(r3[0], r3[1]); w1.w = pk_bf16(r3[2], r3[3]);
                bf16_t* rowp = O + (size_t)row * ldc + 64 * hh + 16 * fq;
                *(u32x4*)rowp = w0; *(u32x4*)(rowp + 8) = w1; }
    }
};
struct EResAddN {
    static constexpr bool PERM = false, AFTER_DRAIN = false; const float* base; float* out; bf16_t* xb; float* ss;
    __device__ __forceinline__ void operator()(const f32x4 (&acc)[2][2][4][2], const Unit& u, int wr, int wc, int fr, int fq) const {
        const int col0 = u.pn * BM + wc * 32 + 4 * fq;
#pragma unroll
        for (int ai = 0; ai < 2; ++ai)
#pragma unroll
            for (int m = 0; m < 4; ++m) { const int row = u.pm * BM + ai * HALF + wr * 64 + m * 16 + fr; const size_t off = (size_t)row * 1024 + col0; float sq = 0.f;
#pragma unroll
                for (int bj = 0; bj < 2; ++bj)
#pragma unroll
                    for (int n = 0; n < 2; ++n) { const size_t o = off + bj * HALF + n * 16; const f32x4 v = *(const f32x4*)(base + o) + acc[ai][bj][m][n]; *(f32x4*)(out + o) = v;
                        sq += (v[0] * v[0] + v[1] * v[1]) + (v[2] * v[2] + v[3] * v[3]);
                        *(unsigned long long*)(xb + o) = (unsigned long long)pk_bf16(v[0], v[1]) | ((unsigned long long)pk_bf16(v[2], v[3]) << 32); }
                sq += ::shx<16>(sq); sq += ::shx<32>(sq);
                if (fq == 0) ss[(size_t)row * 16 + u.pn * 4 + wc] = sq; }
    }
};
template <bool LAST> struct EGateN {
    static constexpr bool PERM = false, AFTER_DRAIN = false; float* h; const bf16_t* up; const float* ss8; bf16_t* xb; float* ss;
    __device__ __forceinline__ void operator()(const f32x4 (&acc)[2][2][4][2], const Unit& u, int wr, int wc, int fr, int fq) const {
        const int col0 = u.pn * BM + wc * 32 + 4 * fq;
#pragma unroll
        for (int ai = 0; ai < 2; ++ai)
#pragma unroll
            for (int m = 0; m < 4; ++m) { const int row = u.pm * BM + ai * HALF + wr * 64 + m * 16 + fr; const size_t off = (size_t)row * 1024 + col0; const float rs = rstd8(ss8, row); float sq = 0.f;
#pragma unroll
                for (int bj = 0; bj < 2; ++bj)
#pragma unroll
                    for (int n = 0; n < 2; ++n) { const size_t o = off + bj * HALF + n * 16; f32x4 hv = *(const f32x4*)(h + o);
                        const unsigned long long uu = *(const unsigned long long*)(up + o); const f32x4 a = acc[ai][bj][m][n] * rs;
                        hv[0] += __builtin_bit_cast(float, (unsigned)(uu << 16)) / (1.f + __expf(-a[0]));
                        hv[1] += __builtin_bit_cast(float, (unsigned)(uu & 0xffff0000ull)) / (1.f + __expf(-a[1]));
                        hv[2] += __builtin_bit_cast(float, (unsigned)((uu >> 16) & 0xffff0000ull)) / (1.f + __expf(-a[2]));
                        hv[3] += __builtin_bit_cast(float, (unsigned)((uu >> 32) & 0xffff0000ull)) / (1.f + __expf(-a[3]));
                        *(f32x4*)(h + o) = hv;
                        if (!LAST) { sq += (hv[0] * hv[0] + hv[1] * hv[1]) + (hv[2] * hv[2] + hv[3] * hv[3]);
                            *(unsigned long long*)(xb + o) = (unsigned long long)pk_bf16(hv[0], hv[1]) | ((unsigned long long)pk_bf16(hv[2], hv[3]) << 32); } }
                if (!LAST) { sq += ::shx<16>(sq); sq += ::shx<32>(sq); if (fq == 0) ss[(size_t)row * 16 + u.pn * 4 + wc] = sq; } }
    }
};
template <class Epi, class Sched, bool ALIGN_EPI = false, bool SP2 = false>
__device__ __forceinline__ void gemm_phase(PG8_LAS unsigned char* lds, const Gemm g, const Sched& S, const Epi& E) {
    const int tid = tidx(), wid = __builtin_amdgcn_readfirstlane(tid >> 6), lane = tid & 63, wr = wid >> 2, wc = wid & 3, fr = lane & 15, fq = lane >> 4;
    const int K = g.K, nt = K / BK;
    unsigned voffA[2], voffB[2];
#pragma unroll
    for (int i = 0; i < 2; ++i) { int R, C; stage_rc(tid * 16 + i * 8192, R, C); const int Rb = Epi::PERM ? ((R & ~31) + perm32(R & 31)) : R;
        voffA[i] = (unsigned)(R * K + C) * 2u; voffB[i] = (unsigned)(Rb * K + C) * 2u; }
    const size_t kstep = (size_t)(BK * 2);
    const size_t hstep = (size_t)HALF * K * 2;
    const size_t tstep = 2 * hstep;
    const unsigned ldsw = (unsigned)wid * 1024u;
    const int aoff = lds_byte(wr * 64 + fr, fq * 8), boff = lds_byte(wc * 32 + fr, fq * 8);
#define PG8_SA(b, h) (((b) * 2 + (h)) * HTB)
#define PG8_SB(b, h) ((4 + (b) * 2 + (h)) * HTB)
#define PG8_STAGE(bufoff, gbase, voff) do { _Pragma("unroll") for (int _i = 0; _i < 2; ++_i) \
        __builtin_amdgcn_global_load_lds((const unsigned*)((const char*)(gbase) + (voff)[_i]), (PG8_LAS unsigned*)(lds + (bufoff) + ldsw + _i * 8192), 16, 0, 0); } while (0)
#define PG8_LDA(dst, b, h) do { _Pragma("unroll") for (int m = 0; m < 4; ++m) _Pragma("unroll") for (int k = 0; k < 2; ++k) dst[m][k] = *(const PG8_LAS bf16x8*)(lds + PG8_SA(b, h) + aoff + m * 2048 + k * 1024); } while (0)
#define PG8_LDB(dst, b, h) do { _Pragma("unroll") for (int n = 0; n < 2; ++n) _Pragma("unroll") for (int k = 0; k < 2; ++k) dst[n][k] = *(const PG8_LAS bf16x8*)(lds + PG8_SB(b, h) + boff + n * 2048 + k * 1024); } while (0)
#define PG8_MMA(ai, bj, At, Bt) do { __builtin_amdgcn_s_setprio(1); _Pragma("unroll") for (int m = 0; m < 4; ++m) _Pragma("unroll") for (int n = 0; n < 2; ++n) _Pragma("unroll") for (int k = 0; k < 2; ++k) \
        acc[ai][bj][m][n] = __builtin_amdgcn_mfma_f32_16x16x32_bf16(Bt[n][k], At[m][k], acc[ai][bj][m][n], 0, 0, 0); __builtin_amdgcn_s_setprio(0); } while (0)
#define PG8_WAIT_V(n) asm volatile("s_waitcnt vmcnt(" #n ")" ::: "memory")
#define PG8_WAIT_L(n) asm volatile("s_waitcnt lgkmcnt(" #n ")" ::: "memory")
#define PG8_BAR __builtin_amdgcn_s_barrier()
#define PG8_SCHED __builtin_amdgcn_sched_barrier(0)
    Unit cur, nxt; int ui = 0;
    if (!S.next(0, cur)) return;
    f32x4 acc[2][2][4][2];
#pragma unroll
    for (int a = 0; a < 2; ++a)
#pragma unroll
        for (int b = 0; b < 2; ++b)
#pragma unroll
            for (int m = 0; m < 4; ++m)
#pragma unroll
                for (int n = 0; n < 2; ++n) acc[a][b][m][n] = (f32x4){0.f, 0.f, 0.f, 0.f};
    bf16x8 At[4][2], B0[2][2], B1[2][2];
    const char* cA = (const char*)g.A + (size_t)cur.pm * tstep; const char* cB = (const char*)g.Bt + (size_t)cur.pn * tstep;
    S.a_ready(cur);
    if constexpr (SP2) {
        PG8_STAGE(PG8_SB(0, 0), cB, voffB); PG8_STAGE(PG8_SB(0, 1), cB + hstep, voffB); PG8_STAGE(PG8_SA(0, 0), cA, voffA); PG8_STAGE(PG8_SA(0, 1), cA + hstep, voffA);
        if (wr == 1) PG8_BAR;
        PG8_WAIT_V(2); PG8_BAR;
        PG8_STAGE(PG8_SB(1, 0), cB + kstep, voffB); PG8_STAGE(PG8_SA(1, 0), cA + kstep, voffA); PG8_STAGE(PG8_SB(1, 1), cB + hstep + kstep, voffB);
        PG8_WAIT_V(6); PG8_BAR;
    } else {
        PG8_STAGE(PG8_SB(0, 0), cB, voffB); PG8_STAGE(PG8_SA(0, 0), cA, voffA); PG8_STAGE(PG8_SB(0, 1), cB + hstep, voffB); PG8_STAGE(PG8_SA(0, 1), cA + hstep, voffA);
        if (wr == 1) PG8_BAR;
        PG8_WAIT_V(4); PG8_BAR;
        PG8_STAGE(PG8_SB(1, 0), cB + kstep, voffB); PG8_STAGE(PG8_SA(1, 0), cA + kstep, voffA); PG8_STAGE(PG8_SB(1, 1), cB + hstep + kstep, voffB);
        PG8_WAIT_V(6); PG8_BAR;
    }
    for (;;) {
        const bool has_next = S.next(ui + 1, nxt);
        const char* nA = has_next ? (const char*)g.A + (size_t)nxt.pm * tstep : cA; const char* nB = has_next ? (const char*)g.Bt + (size_t)nxt.pn * tstep : cB;
        for (int t = 0; t < nt; t += 2) {
            const bool last = (t == nt - 2);
            const char* a1 = cA + (size_t)(t + 1) * kstep;
            const char* a2 = last ? nA : cA + (size_t)(t + 2) * kstep; const char* b2 = last ? nB : cB + (size_t)(t + 2) * kstep;
            const char* a3 = a2 + kstep; const char* b3 = b2 + kstep;
            if (last && has_next) S.a_ready(nxt);
            if constexpr (SP2) {
            PG8_LDB(B0, 0, 0); PG8_LDB(B1, 0, 1); PG8_SCHED; PG8_LDA(At, 0, 0); PG8_STAGE(PG8_SA(1, 1), a1 + hstep, voffA);
            PG8_WAIT_V(8); PG8_WAIT_L(0); PG8_BAR; PG8_MMA(0, 0, At, B0); PG8_MMA(0, 1, At, B1); PG8_BAR; PG8_SCHED;
            PG8_LDA(At, 0, 1); PG8_STAGE(PG8_SB(0, 0), b2, voffB); PG8_STAGE(PG8_SB(0, 1), b2 + hstep, voffB); PG8_STAGE(PG8_SA(0, 0), a2, voffA);
            PG8_WAIT_V(8); PG8_WAIT_L(0); PG8_BAR; PG8_MMA(1, 0, At, B0); PG8_MMA(1, 1, At, B1); PG8_BAR; PG8_SCHED;
            PG8_LDB(B0, 1, 0); PG8_LDB(B1, 1, 1); PG8_SCHED; PG8_LDA(At, 1, 0); PG8_STAGE(PG8_SA(0, 1), a2 + hstep, voffA);
            PG8_WAIT_V(8); PG8_WAIT_L(0); PG8_BAR; PG8_MMA(0, 0, At, B0); PG8_MMA(0, 1, At, B1); PG8_BAR; PG8_SCHED;
            PG8_LDA(At, 1, 1); PG8_STAGE(PG8_SB(1, 0), b3, voffB); PG8_STAGE(PG8_SB(1, 1), b3 + hstep, voffB); PG8_STAGE(PG8_SA(1, 0), a3, voffA);
            PG8_WAIT_V(8); PG8_WAIT_L(0); PG8_BAR; PG8_MMA(1, 0, At, B0); PG8_MMA(1, 1, At, B1); PG8_BAR; PG8_SCHED;
            } else {
            PG8_LDB(B0, 0, 0); PG8_SCHED; PG8_LDA(At, 0, 0); PG8_STAGE(PG8_SA(1, 1), a1 + hstep, voffA);
            PG8_WAIT_L(8); PG8_BAR; PG8_WAIT_L(0); PG8_MMA(0, 0, At, B0); PG8_BAR; PG8_SCHED;
            PG8_LDB(B1, 0, 1); PG8_STAGE(PG8_SB(0, 0), b2, voffB);
            PG8_BAR; PG8_WAIT_L(0); PG8_MMA(0, 1, At, B1); PG8_BAR;
            PG8_LDA(At, 0, 1); PG8_STAGE(PG8_SA(0, 0), a2, voffA);
            PG8_BAR; PG8_WAIT_L(0); PG8_MMA(1, 0, At, B0); PG8_BAR; PG8_SCHED;
            PG8_STAGE(PG8_SB(0, 1), b2 + hstep, voffB);
            PG8_WAIT_V(6); PG8_BAR; PG8_MMA(1, 1, At, B1); PG8_BAR;
            PG8_LDB(B0, 1, 0); PG8_SCHED; PG8_LDA(At, 1, 0); PG8_STAGE(PG8_SA(0, 1), a2 + hstep, voffA);
            PG8_WAIT_L(8); PG8_BAR; PG8_WAIT_L(0); PG8_MMA(0, 0, At, B0); PG8_BAR; PG8_SCHED;
            PG8_LDB(B1, 1, 1); PG8_STAGE(PG8_SB(1, 0), b3, voffB);
            PG8_BAR; PG8_WAIT_L(0); PG8_MMA(0, 1, At, B1); PG8_BAR;
            PG8_LDA(At, 1, 1); PG8_STAGE(PG8_SA(1, 0), a3, voffA);
            PG8_BAR; PG8_WAIT_L(0); PG8_MMA(1, 0, At, B0); PG8_BAR; PG8_SCHED;
            PG8_STAGE(PG8_SB(1, 1), b3 + hstep, voffB);
            PG8_WAIT_V(6); PG8_BAR; PG8_MMA(1, 1, At, B1); PG8_BAR;
            }
        }
        if constexpr (ALIGN_EPI) { if (wr == 0) PG8_BAR; }
        if constexpr (!Epi::AFTER_DRAIN) { E(acc, cur, wr, wc, fr, fq); S.done(cur); }
        if (!has_next) break;
#pragma unroll
        for (int a = 0; a < 2; ++a)
#pragma unroll
            for (int b = 0; b < 2; ++b)
#pragma unroll
                for (int m = 0; m < 4; ++m)
#pragma unroll
                    for (int n = 0; n < 2; ++n) acc[a][b][m][n] = (f32x4){0.f, 0.f, 0.f, 0.f};
        cur = nxt; cA = nA; cB = nB; ++ui;
        if constexpr (ALIGN_EPI) { if (wr == 1) PG8_BAR; }
    }
    PG8_WAIT_V(0);
    if constexpr (!ALIGN_EPI) { if (wr == 0) PG8_BAR; }
    PG8_BAR;
    if constexpr (Epi::AFTER_DRAIN) { E.fused(acc, cur, wr, wc, fr, fq, lds, wid, lane); S.done(cur); }
#undef PG8_SA
#undef PG8_SB
#undef PG8_STAGE
#undef PG8_LDA
#undef PG8_LDB
#undef PG8_MMA
#undef PG8_WAIT_V
#undef PG8_WAIT_L
#undef PG8_BAR
#undef PG8_SCHED
}
}

#define LAS __attribute__((address_space(3)))
typedef unsigned v4u __attribute__((ext_vector_type(4)));
__device__ __forceinline__ unsigned pk2(float lo, float hi) { return f2bf(lo) | (f2bf(hi) << 16); }
__device__ __forceinline__ void transpose_item(const float* W, int K, int N, bf16* WT, float* scr, int item, int nblk, int lane, const float* gain, bool hperm) {
    const int kb = item / nblk, nb = item % nblk, k0 = 64 * kb, n0 = 32 * nb;
    const int nc = n0 + 4 * (lane & 7);
    f32x4 tv[8];
#pragma unroll
    for (int i = 0; i < 8; ++i) { const int kk = 8 * i + (lane >> 3); tv[i] = *(const f32x4*)(W + (size_t)(k0 + kk) * N + ((nc < N) ? nc : 0)) * (gain ? gain[k0 + kk] : 1.0f); }
#pragma unroll
    for (int i = 0; i < 8; ++i) { const int kk = 8 * i + (lane >> 3); *(f32x4*)(scr + kk * 36 + 4 * (lane & 7)) = (nc < N) ? tv[i] : (f32x4){0.f, 0.f, 0.f, 0.f}; }
    __builtin_amdgcn_s_waitcnt(0xc07f); asm volatile("" ::: "memory");
    const int c = lane & 7;
#pragma unroll
    for (int j = 0; j < 4; ++j) { const int n = (lane >> 3) + 8 * j; const float* sp = scr + (8 * c) * 36 + n;
        v4u o; o.x = pk2(sp[0 * 36], sp[1 * 36]); o.y = pk2(sp[2 * 36], sp[3 * 36]); o.z = pk2(sp[4 * 36], sp[5 * 36]); o.w = pk2(sp[6 * 36], sp[7 * 36]);
        *(v4u*)(WT + (size_t)(hperm ? pg8::head_perm(n0 + n) : (n0 + n)) * K + k0 + 8 * c) = o; }
    __builtin_amdgcn_s_waitcnt(0xc07f); asm volatile("" ::: "memory");
}
__device__ __forceinline__ void cvt_bf16(const float* src, bf16* dst, size_t n) {
    for (size_t e = ((size_t)bidx() * NT + tidx()) * 8; e < n; e += (size_t)gridDim.x * NT * 8) {
        const f32x4 a = *(const f32x4*)(src + e), b = *(const f32x4*)(src + e + 4);
        v4u o; o.x = pk2(a.x, a.y); o.y = pk2(a.z, a.w); o.z = pk2(b.x, b.y); o.w = pk2(b.z, b.w);
        *(v4u*)(dst + e) = o; }
}
__device__ __forceinline__ void transpose_matrix(const float* W, int K, int N, int Npad, bf16* WT, float* scr, int gw, int ngw, int lane, const float* gain = nullptr, bool hperm = false) {
    const int nblk = Npad / 32, nit = (K / 64) * nblk;
    for (int it = gw; it < nit; it += ngw) transpose_item(W, K, N, WT, scr, it, nblk, lane, gain, hperm);
}
__device__ __forceinline__ void ph_prologue(unsigned char* smem) {
    const int lane = tidx() & 63, wave = tidx() >> 6;
    float* scr = (float*)smem + wave * (64 * 36);
    const int gw = bidx() * (NT / 64) + wave, ngw = gridDim.x * (NT / 64);
    unsigned char* ws = WSP;
    transpose_matrix(IN(6), 1024, AB_N, AB_LD, (bf16*)(ws + WS_WAB_IN), scr, gw, ngw, lane, nullptr, true);
    transpose_matrix(IN(7), 1024, 1024, 1024, (bf16*)(ws + WS_WAB_OUT), scr, gw, ngw, lane);
    transpose_matrix(IN(12), 1024, 3072, 3072, (bf16*)(ws + WS_WC_IN), scr, gw, ngw, lane, IN(3) + DM, true);
    transpose_matrix(IN(13), 1024, 1024, 1024, (bf16*)(ws + WS_WC_OUT), scr, gw, ngw, lane);
#pragma unroll 1
    for (int L = 0; L < 2; ++L) {
        transpose_matrix(IN(16) + (size_t)L * DM * 2048, 1024, 2048, 2048, (bf16*)(ws + WS_WQ + (size_t)L * 4 * MiB), scr, gw, ngw, lane, IN(4) + L * DM);
        transpose_matrix(IN(20) + (size_t)L * DM * DM, 1024, 1024, 1024, (bf16*)(ws + WS_WG + (size_t)L * 2 * MiB), scr, gw, ngw, lane, IN(5) + L * DM);
        transpose_matrix(IN(21) + (size_t)L * 256 * DM, 256, 1024, 1024, (bf16*)(ws + WS_WUP + (size_t)L * (MiB / 2)), scr, gw, ngw, lane);
    }
    cvt_bf16(IN(1), (bf16*)(ws + WS_P), (size_t)2 * T * 256);
    if (bidx() == 0 && tidx() < 64) { float* gt = (float*)(ws + WS_GTAB); const int l_ = tidx();
        gt[l_] = IN(8)[l_]; gt[64 + l_] = IN(9)[l_]; gt[128 + l_] = IN(10)[l_]; gt[192 + l_] = IN(11)[l_]; gt[256 + l_] = IN(14)[l_]; gt[320 + l_] = IN(15)[l_]; gt[384 + l_] = 1.0f; }
    { float* cst = (float*)(ws + WS_CST); const int* positions = (const int*)IN(2);
      for (int e = bidx() * NT + tidx(); e < T * 8; e += (int)gridDim.x * NT) { const int r = e >> 3, i = e & 7; float c, sn; rope_cs(positions[r], i, c, sn); cst[(size_t)r * 16 + i] = c; cst[(size_t)r * 16 + 8 + i] = sn; } }
    cvt_bf16(IN(17), (bf16*)(ws + WS_SUBK), (size_t)2 * 16 * 128 * 128);
}


typedef __bf16 bf2_t __attribute__((ext_vector_type(2)));
typedef unsigned u32x4g __attribute__((ext_vector_type(4)));
__device__ __forceinline__ float dot2u(unsigned a, unsigned b, float c) { return __builtin_amdgcn_fdot2_f32_bf16(__builtin_bit_cast(bf2_t, a), __builtin_bit_cast(bf2_t, b), c, false); }
__device__ __forceinline__ float dot8(u32x4g a, u32x4g b, float c) {
    c = dot2u(a[0], b[0], c); c = dot2u(a[1], b[1], c); c = dot2u(a[2], b[2], c); c = dot2u(a[3], b[3], c);
    return c;
}
__device__ __forceinline__ float bflo(unsigned d) { return __builtin_bit_cast(float, d << 16); }
__device__ __forceinline__ float bfhi(unsigned d) { return __builtin_bit_cast(float, d & 0xffff0000u); }
#define GATHER_U8(EREG, B) do { float s_[8]; \
    _Pragma("unroll") for (int k = 0; k < 8; ++k) { const int idx = __builtin_amdgcn_readlane(EREG, ((B) * 8 + k) & 63); \
        const u32x4g* up = (const u32x4g*)(U + (size_t)idx * DM); const u32x4g u0 = up[lane], u1 = up[64 + lane]; s_[k] = dot8(x1, u1, dot8(x0, u0, 0.f)); } \
    float r_[4]; const bool b5 = lane & 32, b4 = lane & 16, b3 = lane & 8; \
    _Pragma("unroll") for (int i = 0; i < 4; ++i) { const float snd = b5 ? s_[i] : s_[4 + i], kp = b5 ? s_[4 + i] : s_[i]; r_[i] = kp + __shfl_xor(snd, 32); } \
    float q_[2]; \
    _Pragma("unroll") for (int i = 0; i < 2; ++i) { const float snd = b4 ? r_[i] : r_[2 + i], kp = b4 ? r_[2 + i] : r_[i]; q_[i] = kp + __shfl_xor(snd, 16); } \
    float p_; { const float snd = b3 ? q_[0] : q_[1], kp = b3 ? q_[1] : q_[0]; p_ = kp + __shfl_xor(snd, 8); } \
    p_ += __shfl_xor(p_, 4); p_ += __shfl_xor(p_, 2); p_ += __shfl_xor(p_, 1); \
    if ((lane & 7) == 0) al[(B) * 8 + (lane >> 3)] = p_; } while (0)
#define GATHER_V8(EREG, WREG, B) do { \
    _Pragma("unroll") for (int k = 0; k < 8; ++k) { const int idx = __builtin_amdgcn_readlane(EREG, ((B) * 8 + k) & 63); \
        const float w = __builtin_bit_cast(float, __builtin_amdgcn_readlane(__builtin_bit_cast(int, WREG), ((B) * 8 + k) & 63)); \
        const u32x4g* vp = (const u32x4g*)(V + (size_t)idx * DM); const u32x4g v0 = vp[lane], v1 = vp[64 + lane]; \
        acc[0] += w * bflo(v0.x); acc[1] += w * bfhi(v0.x); acc[2] += w * bflo(v0.y); acc[3] += w * bfhi(v0.y); \
        acc[4] += w * bflo(v0.z); acc[5] += w * bfhi(v0.z); acc[6] += w * bflo(v0.w); acc[7] += w * bfhi(v0.w); \
        acc[8] += w * bflo(v1.x); acc[9] += w * bfhi(v1.x); acc[10] += w * bflo(v1.y); acc[11] += w * bfhi(v1.y); \
        acc[12] += w * bflo(v1.z); acc[13] += w * bfhi(v1.z); acc[14] += w * bflo(v1.w); acc[15] += w * bfhi(v1.w); } } while (0)
__device__ __forceinline__ void ph_peer_gather_opt(const int* eidx, const float* gw, const bf16* U, const bf16* V, float* h, const float* gain_next, bf16* XN, unsigned char* smem) {
    const int tid = tidx(), lane = tid & 63, wave = tid >> 6;
    float* al = (float*)smem + wave * 128;
    const int gwv = bidx() * (NT / 64) + wave, ngw = gridDim.x * (NT / 64);
    for (int t = gwv; t < T; t += ngw) {
        const u32x4g x0 = *(const u32x4g*)(XN + (size_t)t * DM + 8 * lane), x1 = *(const u32x4g*)(XN + (size_t)t * DM + 512 + 8 * lane);
        const int e0 = eidx[(size_t)t * 128 + lane], e1 = eidx[(size_t)t * 128 + 64 + lane];
        const float g0 = gw[(size_t)t * 128 + lane], g1 = gw[(size_t)t * 128 + 64 + lane];
#pragma unroll 1
        for (int b = 0; b < 8; ++b) GATHER_U8(e0, b);
#pragma unroll 1
        for (int b = 8; b < 16; ++b) GATHER_U8(e1, b);
        __builtin_amdgcn_s_waitcnt(0xc07f); asm volatile("" ::: "memory");
        const float w0 = g0 * gelu_tanh(al[lane]), w1 = g1 * gelu_tanh(al[64 + lane]);
        float acc[16];
#pragma unroll
        for (int i = 0; i < 16; ++i) acc[i] = 0.f;
#pragma unroll 1
        for (int b = 0; b < 8; ++b) GATHER_V8(e0, w0, b);
#pragma unroll 1
        for (int b = 8; b < 16; ++b) GATHER_V8(e1, w1, b);
        float* hp = h + (size_t)t * DM + 8 * lane;
        f32x4 h0 = *(f32x4*)(hp), h1 = *(f32x4*)(hp + 4), h2 = *(f32x4*)(hp + 512), h3 = *(f32x4*)(hp + 516);
        h0 += (f32x4){acc[0], acc[1], acc[2], acc[3]}; h1 += (f32x4){acc[4], acc[5], acc[6], acc[7]};
        h2 += (f32x4){acc[8], acc[9], acc[10], acc[11]}; h3 += (f32x4){acc[12], acc[13], acc[14], acc[15]};
        *(f32x4*)(hp) = h0; *(f32x4*)(hp + 4) = h1; *(f32x4*)(hp + 512) = h2; *(f32x4*)(hp + 516) = h3;
        float ss = 0.f;
#pragma unroll
        for (int i = 0; i < 4; ++i) ss += h0[i] * h0[i] + h1[i] * h1[i] + h2[i] * h2[i] + h3[i] * h3[i];
        const float rstd = 1.0f / sqrtf(wave_sum(ss) * (1.0f / DM) + NORM_EPS);
        const f32x4 ga = *(const f32x4*)(gain_next + 8 * lane), gb = *(const f32x4*)(gain_next + 8 * lane + 4), gc = *(const f32x4*)(gain_next + 512 + 8 * lane), gd = *(const f32x4*)(gain_next + 516 + 8 * lane);
        u32x4g o0, o1;
        o0.x = pk2(h0[0] * rstd * ga[0], h0[1] * rstd * ga[1]); o0.y = pk2(h0[2] * rstd * ga[2], h0[3] * rstd * ga[3]);
        o0.z = pk2(h1[0] * rstd * gb[0], h1[1] * rstd * gb[1]); o0.w = pk2(h1[2] * rstd * gb[2], h1[3] * rstd * gb[3]);
        o1.x = pk2(h2[0] * rstd * gc[0], h2[1] * rstd * gc[1]); o1.y = pk2(h2[2] * rstd * gc[2], h2[3] * rstd * gc[3]);
        o1.z = pk2(h3[0] * rstd * gd[0], h3[1] * rstd * gd[1]); o1.w = pk2(h3[2] * rstd * gd[2], h3[3] * rstd * gd[3]);
        *(u32x4g*)(XN + (size_t)t * DM + 8 * lane) = o0; *(u32x4g*)(XN + (size_t)t * DM + 512 + 8 * lane) = o1;
    }
}


typedef short bf16x8r __attribute__((ext_vector_type(8)));
typedef float f32x16r __attribute__((ext_vector_type(16)));
__device__ __forceinline__ float unokey(unsigned k) { const unsigned u = (k & 0x80000000u) ? (k & 0x7fffffffu) : ~k; return __builtin_bit_cast(float, u); }
#define CE_D(a, b) do { const unsigned mx_ = max(a, b), mn_ = min(a, b); a = mx_; b = mn_; } while (0)
#define SORT16_DESC(v, base) do { \
    _Pragma("unroll") for (int k_ = 2; k_ <= 16; k_ <<= 1) \
    _Pragma("unroll") for (int j_ = k_ >> 1; j_ > 0; j_ >>= 1) \
    _Pragma("unroll") for (int i_ = 0; i_ < 16; ++i_) { const int l_ = i_ ^ j_; if (l_ > i_) { if ((i_ & k_) == 0) CE_D(v[(base) + i_], v[(base) + l_]); else CE_D(v[(base) + l_], v[(base) + i_]); } } } while (0)
#define BMERGE16_DESC(v, base) do { \
    _Pragma("unroll") for (int j_ = 8; j_ > 0; j_ >>= 1) \
    _Pragma("unroll") for (int i_ = 0; i_ < 16; ++i_) { const int l_ = i_ ^ j_; if (l_ > i_) CE_D(v[(base) + i_], v[(base) + l_]); } } while (0)
#define TOPMERGE16(v, a, b) do { _Pragma("unroll") for (int i_ = 0; i_ < 16; ++i_) v[(a) + i_] = max(v[(a) + i_], v[(b) + 15 - i_]); BMERGE16_DESC(v, a); } while (0)
#define PARTNER_TOP16(v) do { unsigned o_[16]; _Pragma("unroll") for (int i_ = 0; i_ < 16; ++i_) o_[i_] = shx<32>(v[15 - i_]); \
    _Pragma("unroll") for (int i_ = 0; i_ < 16; ++i_) v[i_] = max(v[i_], o_[i_]); BMERGE16_DESC(v, 0); } while (0)
constexpr int SK_ROW = 272;
__device__ __forceinline__ void ph_peer_route_opt(const bf16* qry, const bf16* subk, int* eidx, float* gw, unsigned char* smem) {
    const int tid = tidx(), lane = tid & 63, wave = tid >> 6, r32 = lane & 31, hi = lane >> 5;
    for (int unit = bidx(); unit < 512; unit += gridDim.x) {
        const int h = unit & 7, tb = unit >> 3;
        __syncthreads();
        for (int i = tid; i < 4096; i += NT) { const int row = i >> 4, ch = i & 15;
            *(u32x4g*)(smem + row * SK_ROW + ch * 16) = *(const u32x4g*)(subk + ((size_t)(h * 2) * 128 + row) * 128 + ch * 8); }
        __syncthreads();
        const int trow = tb * 256 + wave * 32 + r32;
        unsigned top[2][16];
#pragma unroll
        for (int c = 0; c < 2; ++c) {
            f32x16r acc[4];
#pragma unroll
            for (int kb = 0; kb < 4; ++kb) acc[kb] = (f32x16r){0.f, 0.f, 0.f, 0.f, 0.f, 0.f, 0.f, 0.f, 0.f, 0.f, 0.f, 0.f, 0.f, 0.f, 0.f, 0.f};
#pragma unroll
            for (int ks = 0; ks < 8; ++ks) {
                const bf16x8r bq = *(const bf16x8r*)(qry + (size_t)trow * 2048 + h * 256 + c * 128 + ks * 16 + 8 * hi);
#pragma unroll
                for (int kb = 0; kb < 4; ++kb) {
                    const bf16x8r ak = *(const bf16x8r*)(smem + (c * 128 + kb * 32 + r32) * SK_ROW + (ks * 16 + 8 * hi) * 2);
                    acc[kb] = __builtin_amdgcn_mfma_f32_32x32x16_bf16(ak, bq, acc[kb], 0, 0, 0);
                }
            }
            unsigned k[64];
#pragma unroll
            for (int kb = 0; kb < 4; ++kb)
#pragma unroll
                for (int r = 0; r < 16; ++r) { const float sc = acc[kb][r]; const int idx = kb * 32 + (r & 3) + 8 * (r >> 2) + 4 * hi;
                    k[kb * 16 + r] = (okey(sc) & 0xffffff80u) | (unsigned)(127 - idx); }
            SORT16_DESC(k, 0); SORT16_DESC(k, 16); SORT16_DESC(k, 32); SORT16_DESC(k, 48);
            TOPMERGE16(k, 0, 16); TOPMERGE16(k, 32, 48); TOPMERGE16(k, 0, 32);
            PARTNER_TOP16(k);
#pragma unroll
            for (int i = 0; i < 16; ++i) top[c][i] = k[i];
        }
        float va[16], vb[16];
#pragma unroll
        for (int i = 0; i < 16; ++i) { va[i] = unokey((top[0][i] & 0xffffff80u) | 0x40u); vb[i] = unokey((top[1][i] & 0xffffff80u) | 0x40u); }
        unsigned ck[32];
        ck[0] = (okey(hi ? (va[2] + vb[1]) : (va[0] + vb[0])) & 0xffffff00u) | (hi ? 222u : 255u);
        ck[1] = (okey(hi ? (va[2] + vb[2]) : (va[0] + vb[1])) & 0xffffff00u) | (hi ? 221u : 254u);
        ck[2] = (okey(hi ? (va[2] + vb[3]) : (va[0] + vb[2])) & 0xffffff00u) | (hi ? 220u : 253u);
        ck[3] = (okey(hi ? (va[2] + vb[4]) : (va[0] + vb[3])) & 0xffffff00u) | (hi ? 219u : 252u);
        ck[4] = (okey(hi ? (va[3] + vb[0]) : (va[0] + vb[4])) & 0xffffff00u) | (hi ? 207u : 251u);
        ck[5] = (okey(hi ? (va[3] + vb[1]) : (va[0] + vb[5])) & 0xffffff00u) | (hi ? 206u : 250u);
        ck[6] = (okey(hi ? (va[3] + vb[2]) : (va[0] + vb[6])) & 0xffffff00u) | (hi ? 205u : 249u);
        ck[7] = (okey(hi ? (va[3] + vb[3]) : (va[0] + vb[7])) & 0xffffff00u) | (hi ? 204u : 248u);
        ck[8] = (okey(hi ? (va[4] + vb[0]) : (va[0] + vb[8])) & 0xffffff00u) | (hi ? 191u : 247u);
        ck[9] = (okey(hi ? (va[4] + vb[1]) : (va[0] + vb[9])) & 0xffffff00u) | (hi ? 190u : 246u);
        ck[10] = (okey(hi ? (va[4] + vb[2]) : (va[0] + vb[10])) & 0xffffff00u) | (hi ? 189u : 245u);
        ck[11] = (okey(hi ? (va[5] + vb[0]) : (va[0] + vb[11])) & 0xffffff00u) | (hi ? 175u : 244u);
        ck[12] = (okey(hi ? (va[5] + vb[1]) : (va[0] + vb[12])) & 0xffffff00u) | (hi ? 174u : 243u);
        ck[13] = (okey(hi ? (va[6] + vb[0]) : (va[0] + vb[13])) & 0xffffff00u) | (hi ? 159u : 242u);
        ck[14] = (okey(hi ? (va[6] + vb[1]) : (va[0] + vb[14])) & 0xffffff00u) | (hi ? 158u : 241u);
        ck[15] = (okey(hi ? (va[7] + vb[0]) : (va[0] + vb[15])) & 0xffffff00u) | (hi ? 143u : 240u);
        ck[16] = (okey(hi ? (va[7] + vb[1]) : (va[1] + vb[0])) & 0xffffff00u) | (hi ? 142u : 239u);
        ck[17] = (okey(hi ? (va[8] + vb[0]) : (va[1] + vb[1])) & 0xffffff00u) | (hi ? 127u : 238u);
        ck[18] = (okey(hi ? (va[9] + vb[0]) : (va[1] + vb[2])) & 0xffffff00u) | (hi ? 111u : 237u);
        ck[19] = (okey(hi ? (va[10] + vb[0]) : (va[1] + vb[3])) & 0xffffff00u) | (hi ? 95u : 236u);
        ck[20] = (okey(hi ? (va[11] + vb[0]) : (va[1] + vb[4])) & 0xffffff00u) | (hi ? 79u : 235u);
        ck[21] = (okey(hi ? (va[12] + vb[0]) : (va[1] + vb[5])) & 0xffffff00u) | (hi ? 63u : 234u);
        ck[22] = (okey(hi ? (va[13] + vb[0]) : (va[1] + vb[6])) & 0xffffff00u) | (hi ? 47u : 233u);
        ck[23] = (okey(hi ? (va[14] + vb[0]) : (va[1] + vb[7])) & 0xffffff00u) | (hi ? 31u : 232u);
        ck[24] = (okey(hi ? (va[15] + vb[0]) : (va[2] + vb[0])) & 0xffffff00u) | (hi ? 15u : 223u);
#pragma unroll
        for (int s = 25; s < 32; ++s) ck[s] = 0u;
        SORT16_DESC(ck, 0); SORT16_DESC(ck, 16); TOPMERGE16(ck, 0, 16);
        PARTNER_TOP16(ck);
        const float m = unokey((ck[0] & 0xffffff00u) | 0x80u);
        float l = 0.f;
#pragma unroll
        for (int r = 0; r < 16; ++r) l += __expf(unokey((ck[r] & 0xffffff00u) | 0x80u) - m);
        const float linv = 1.0f / l;
        unsigned p0[4], p1[4];
#pragma unroll
        for (int w = 0; w < 4; ++w) { p0[w] = 0u; p1[w] = 0u;
#pragma unroll
            for (int b = 0; b < 4; ++b) { p0[w] |= (127u - (top[0][4 * w + b] & 127u)) << (8 * b); p1[w] |= (127u - (top[1][4 * w + b] & 127u)) << (8 * b); } }
        int eo[8]; float go[8]; const unsigned hmask = 0u - (unsigned)hi;
#pragma unroll
        for (int rr = 0; rr < 8; ++rr) {
            const unsigned key = ck[rr] ^ ((ck[rr] ^ ck[8 + rr]) & hmask);
            const unsigned flat = 255u - (key & 255u), i = flat >> 4, j = flat & 15u;
            const unsigned wi = (i >> 2) == 0 ? p0[0] : ((i >> 2) == 1 ? p0[1] : ((i >> 2) == 2 ? p0[2] : p0[3]));
            const unsigned wj = (j >> 2) == 0 ? p1[0] : ((j >> 2) == 1 ? p1[1] : ((j >> 2) == 2 ? p1[2] : p1[3]));
            const unsigned i0 = (wi >> ((i & 3u) * 8u)) & 255u, i1 = (wj >> ((j & 3u) * 8u)) & 255u;
            eo[rr] = (int)(i0 * 128u + i1);
            go[rr] = __expf(unokey((key & 0xffffff00u) | 0x80u) - m) * linv;
        }
        int* ep = eidx + (size_t)trow * 128 + h * 16 + 8 * hi; float* gp = gw + (size_t)trow * 128 + h * 16 + 8 * hi;
        typedef int i32x4 __attribute__((ext_vector_type(4)));
        *(i32x4*)ep = (i32x4){eo[0], eo[1], eo[2], eo[3]}; *(i32x4*)(ep + 4) = (i32x4){eo[4], eo[5], eo[6], eo[7]};
        *(f32x4*)gp = (f32x4){go[0], go[1], go[2], go[3]}; *(f32x4*)(gp + 4) = (f32x4){go[4], go[5], go[6], go[7]};
    }
}

#ifndef ATTN_STORE16
#define ATTN_STORE16(p,v) (*(u32x4*)(p)=(v))
#endif
namespace attn_g {
typedef unsigned short bf16;
using bf16x8=__attribute__((ext_vector_type(8)))short;
using s16x4=__attribute__((ext_vector_type(4)))short;
using f32x16=__attribute__((ext_vector_type(16)))float;
using u32x4=__attribute__((ext_vector_type(4)))unsigned;
constexpr int D=64;
constexpr int NW=8,QBLK=32,QB=QBLK*NW,KVBLK=64;
__device__ __forceinline__ int crow(int r,int hi){return (r&3)+8*(r>>2)+4*hi;}
#define SBAR() __builtin_amdgcn_sched_barrier(0)
__device__ __forceinline__ void cmask(f32x16&p0,f32x16&p1,int jb,int qrel,int hi){
  const float NEG=-__builtin_inff(); int kb=64*jb+4*hi;
  #pragma unroll
  for(int r=0;r<16;++r){int kv=kb+(r&3)+8*(r>>2); if(kv>qrel)p0[r]=NEG; if(kv+32>qrel)p1[r]=NEG;}
}

constexpr int NSLOT=3, SLOTB=8192;
constexpr int LDS_K=0, LDS_V=NSLOT*SLOTB, LDS_WS=2*NSLOT*SLOTB, LDS_OST=LDS_WS+NW*64*4, LDS_MSK=LDS_OST+NW*4096, LDS_BYTES=LDS_MSK+NW*2*256;
constexpr float C2=0.125f*1.4426950408889634f;
__device__ __forceinline__ void glds16(const void*gsrc,unsigned lds_dst){unsigned keep;
  asm volatile("s_mov_b32 %0, m0\n\ts_mov_b32 m0, %2\n\ts_nop 0\n\tglobal_load_lds_dwordx4 %1, off\n\ts_mov_b32 m0, %0":"=&s"(keep):"v"(gsrc),"s"(lds_dst):"memory");}
__device__ __forceinline__ void glds16s(const void*sbase,unsigned voff,unsigned lds_dst){unsigned keep;
  asm volatile("s_nop 4\n\ts_mov_b32 %0, m0\n\ts_mov_b32 m0, %3\n\ts_nop 0\n\tglobal_load_lds_dwordx4 %1, %2\n\ts_mov_b32 m0, %0":"=&s"(keep):"v"(voff),"s"(sbase),"s"(lds_dst):"memory");}
__device__ __forceinline__ void glds4s(const void*sbase,unsigned voff,unsigned lds_dst){unsigned keep;
  asm volatile("s_nop 4\n\ts_mov_b32 %0, m0\n\ts_mov_b32 m0, %3\n\ts_nop 0\n\tglobal_load_lds_dword %1, %2\n\ts_mov_b32 m0, %0":"=&s"(keep):"v"(voff),"s"(sbase),"s"(lds_dst):"memory");}
__device__ __forceinline__ unsigned bandw(int e){
  const unsigned a=(e<0)?0u:((e>=31)?0xffffffffu:((2u<<e)-1u)); const int f=e-128; const unsigned b=(f<=0)?0u:((f>=32)?0xffffffffu:((1u<<f)-1u)); return a&~b; }
__device__ __forceinline__ float max3f(float a,float b,float c){float r;asm("v_max3_f32 %0, %1, %2, %3":"=v"(r):"v"(a),"v"(b),"v"(c));return r;}
__device__ __forceinline__ float max2f(float a,float b){float r;asm("v_max_f32_e32 %0, %1, %2":"=v"(r):"v"(a),"v"(b));return r;}
__device__ __forceinline__ float fadd_s(float a,float b){float r;asm("v_add_f32_e32 %0, %1, %2":"=v"(r):"v"(a),"v"(b));return r;}
__device__ __forceinline__ float fsub_s(float a,float b){float r;asm("v_sub_f32_e32 %0, %1, %2":"=v"(r):"v"(a),"v"(b));return r;}
typedef float f32x2_t __attribute__((ext_vector_type(2))); typedef __bf16 bf16x2_t __attribute__((ext_vector_type(2)));
__device__ __forceinline__ unsigned cvtpk_s(float lo,float hi){f32x2_t v={lo,hi};bf16x2_t b=__builtin_convertvector(v,bf16x2_t);return __builtin_bit_cast(unsigned,b);}
#define WAIT_BAR(N) asm volatile("s_waitcnt vmcnt(" #N ") lgkmcnt(0)\n\ts_barrier":::"memory")

template<bool NEGM> __device__ __forceinline__ void qkt(f32x16&p0,f32x16&p1,const char*Kslot,const bf16x8*qr,const f32x16&negm,int r32,int hi){ const f32x16 zc_={};
  const char*kb=Kslot+hi*1024+r32*16;
  #pragma unroll
  for(int d0=0;d0<4;++d0){
    const bf16x8 b0=*reinterpret_cast<const bf16x8*>(kb+d0*2048);
    const bf16x8 b1=*reinterpret_cast<const bf16x8*>(kb+d0*2048+512);
    if(d0==0){p0=__builtin_amdgcn_mfma_f32_32x32x16_bf16(b0,qr[0],NEGM?negm:zc_,0,0,0);p1=__builtin_amdgcn_mfma_f32_32x32x16_bf16(b1,qr[0],NEGM?negm:zc_,0,0,0);}
    else{p0=__builtin_amdgcn_mfma_f32_32x32x16_bf16(b0,qr[d0],p0,0,0,0);p1=__builtin_amdgcn_mfma_f32_32x32x16_bf16(b1,qr[d0],p1,0,0,0);}}
}
typedef __attribute__((address_space(3))) const char* lds_cptr;
typedef short v4i16_t __attribute__((ext_vector_type(4)));
__device__ __forceinline__ void kload8(bf16x8*kf,lds_cptr kp){
  kf[0]=*(const __attribute__((address_space(3))) bf16x8*)(kp);      kf[1]=*(const __attribute__((address_space(3))) bf16x8*)(kp+512);
  kf[2]=*(const __attribute__((address_space(3))) bf16x8*)(kp+2048); kf[3]=*(const __attribute__((address_space(3))) bf16x8*)(kp+2560);
  kf[4]=*(const __attribute__((address_space(3))) bf16x8*)(kp+4096); kf[5]=*(const __attribute__((address_space(3))) bf16x8*)(kp+4608);
  kf[6]=*(const __attribute__((address_space(3))) bf16x8*)(kp+6144); kf[7]=*(const __attribute__((address_space(3))) bf16x8*)(kp+6656);
}
__device__ __forceinline__ void kload2(bf16x8*kf,lds_cptr kp,int j){ kf[2*j]=*(const __attribute__((address_space(3))) bf16x8*)(kp+j*2048); kf[2*j+1]=*(const __attribute__((address_space(3))) bf16x8*)(kp+j*2048+512); }
__device__ __forceinline__ s16x4 vtr(lds_cptr p){ return __builtin_bit_cast(s16x4,__builtin_amdgcn_ds_read_tr16_b64_v4i16((__attribute__((address_space(3))) v4i16_t*)p)); }
__device__ __forceinline__ float rowmax(const f32x16&p0,const f32x16&p1){
  float a=max3f(p0[0],p0[1],p1[0]),b=max3f(p0[2],p0[3],p1[1]);a=max3f(a,p1[2],p1[3]);
  #pragma unroll
  for(int r=4;r<16;r+=4){a=max3f(a,p0[r],p0[r+1]);b=max3f(b,p0[r+2],p0[r+3]);a=max3f(a,p1[r],p1[r+1]);b=max3f(b,p1[r+2],p1[r+3]);}
  const float m=max2f(a,b);
  auto rr=__builtin_amdgcn_permlane32_swap(__float_as_uint(m),__float_as_uint(m),false,false);
  return max2f(__uint_as_float(rr[0]),__uint_as_float(rr[1]));
}
__device__ __forceinline__ void pv(f32x16*o,int vb,bf16x8 pa0,bf16x8 pa1,bf16x8 pa2,bf16x8 pa3){
  #pragma unroll
  for(int d0=0;d0<2;++d0){s16x4 lo[4],hi[4];
    #pragma unroll
    for(int ks=0;ks<4;++ks){
      asm volatile("ds_read_b64_tr_b16 %0,%1 offset:%c2":"=&v"(lo[ks]):"v"(vb),"i"(d0*4096+ks*1024):"memory");
      asm volatile("ds_read_b64_tr_b16 %0,%1 offset:%c2":"=&v"(hi[ks]):"v"(vb),"i"(d0*4096+ks*1024+512):"memory");}
    asm volatile("s_waitcnt lgkmcnt(0)":::"memory");SBAR();
    #define PK(k) (bf16x8){lo[k][0],lo[k][1],lo[k][2],lo[k][3],hi[k][0],hi[k][1],hi[k][2],hi[k][3]}
    o[d0]=__builtin_amdgcn_mfma_f32_32x32x16_bf16(pa0,PK(0),o[d0],0,0,0);
    o[d0]=__builtin_amdgcn_mfma_f32_32x32x16_bf16(pa1,PK(1),o[d0],0,0,0);
    o[d0]=__builtin_amdgcn_mfma_f32_32x32x16_bf16(pa2,PK(2),o[d0],0,0,0);
    o[d0]=__builtin_amdgcn_mfma_f32_32x32x16_bf16(pa3,PK(3),o[d0],0,0,0);
    #undef PK
  }
}

#ifndef ATTN_STORE16
#define ATTN_STORE16(p,v) (*(u32x4*)(p)=(v))
#endif
template<int MODE,int THRL> __device__ __forceinline__ void attn_unit(const bf16*Qu,long qs,const bf16*__restrict__ Kh,const bf16*__restrict__ Vh,long kvs,bf16*Ou,long os,float*lse,long lses,const int NT,
    const unsigned*selp,const char*Msrc,const int e0,char*shm){
  constexpr bool USE_NEGM=(MODE==0);
  const int tid=tidx(),lane=tid&63,r32=lane&31,hi=lane>>5; const int wid=__builtin_amdgcn_readfirstlane(tid>>6);
  const bf16*Qw=Qu+(long)(wid*QBLK)*qs;
  const unsigned lds0=(unsigned)(uintptr_t)shm;
  float*wsf=(float*)(shm+LDS_WS)+wid*64;
  const unsigned kvoff=(unsigned)(((int)lane*(int)kvs+wid*8)*2);
  const unsigned vvoff=(unsigned)(((16*(wid&3)+(lane>>2))*(int)kvs+(wid>>2)*32+(lane&3)*8)*2);
  const unsigned kdst=lds0+LDS_K+wid*1024, vdst=lds0+LDS_V+wid*1024;
  #define KT(t) ((MODE==0)?(((t)<4)?(NT-4+(t)):((t)-4)):(t))
  #define DMA_K(t,slot) glds16s((const char*)Kh+(long)KT(t)*(KVBLK*2)*kvs,kvoff,(unsigned)__builtin_amdgcn_readfirstlane(kdst+(slot)))
  #define DMA_V(t,slot) glds16s((const char*)Vh+(long)KT(t)*(KVBLK*2)*kvs,vvoff,(unsigned)__builtin_amdgcn_readfirstlane(vdst+(slot)))
  const unsigned mvoff=(unsigned)((wid*QBLK)*8+lane*4); const unsigned mdst=lds0+LDS_MSK+wid*512;
  #define DMA_M(t) do{ if(MODE==1) glds4s(Msrc+(long)(t)*(8192*8),mvoff,(unsigned)__builtin_amdgcn_readfirstlane(mdst+((t)&1)*256)); }while(0)
  const int vb0=(int)(lds0+LDS_V)+((lane>>4)&1)*32+(lane&3)*8+(4*hi+((lane&15)>>2))*64;
  const char*Kbase=shm+LDS_K; bf16x8 kf[8];
  const lds_cptr shm3=(lds_cptr)shm; const lds_cptr kp0=shm3+LDS_K+hi*1024+r32*16; const lds_cptr vp0=shm3+LDS_V+((lane>>4)&1)*32+(lane&3)*8+(4*hi+((lane&15)>>2))*64;
  DMA_M(0);DMA_M(1);
  DMA_K(0,0);DMA_V(0,0);DMA_K(1,SLOTB);
  bf16x8 qr[4];
  #pragma unroll
  for(int d0=0;d0<4;++d0)qr[d0]=*reinterpret_cast<const bf16x8*>(&Qw[(long)r32*qs+d0*16+hi*8]);
  unsigned selw=0u; if(MODE==0) selw=selp[(long)(wid*QBLK+r32)*8];
  float mhat=0.f,l_reg=0.f;f32x16 o[2];f32x16 negm; { float zz_=0.f; asm volatile("":"+v"(zz_));
    _Pragma("unroll") for(int r=0;r<16;++r){o[0][r]=zz_;o[1][r]=zz_;negm[r]=zz_;} } if(USE_NEGM) asm volatile("":"+v"(negm));
  const int qrel=wid*QBLK+r32;
  #define CMASK(P0,P1,t) do{ const float NEG_=-__builtin_inff(); \
    if(MODE==0){ if((t)<4){cmask(P0,P1,(t),qrel,hi);} else { const unsigned n_=(unsigned)(((t)-4)>>2); const bool ok_=(n_==(selw&255u))|(n_==((selw>>8)&255u))|(n_==((selw>>16)&255u)); \
        _Pragma("unroll") for(int r=0;r<16;++r){P0[r]=ok_?P0[r]:NEG_;P1[r]=ok_?P1[r]:NEG_;} } } \
    else if(MODE==1){ const unsigned long long mw_=*(const __attribute__((address_space(3))) unsigned long long*)(shm3+LDS_MSK+wid*512+((t)&1)*256+r32*8); \
        const unsigned lo_=((unsigned)mw_)>>(4*hi), hh_=((unsigned)(mw_>>32))>>(4*hi); \
        _Pragma("unroll") for(int r=0;r<16;++r){ const unsigned bit_=1u<<((r&3)+8*(r>>2)); P0[r]=(lo_&bit_)?(P0[r]-mhat):NEG_; P1[r]=(hh_&bit_)?(P1[r]-mhat):NEG_; } } \
    else { const int e_=e0-64*(t)+qrel-4*hi; const unsigned lo_=bandw(e_), hh_=bandw(e_-32);     \
        _Pragma("unroll") for(int r=0;r<16;++r){ const unsigned bit_=1u<<((r&3)+8*(r>>2)); P0[r]=(lo_&bit_)?(P0[r]-mhat):NEG_; P1[r]=(hh_&bit_)?(P1[r]-mhat):NEG_; } } }while(0)
  bool resc=false;
  #define START(P0,P1) do{ const float rm=rowmax(P0,P1); resc=false; \
    { const float dl=(rm<-1e30f)?0.f:rm; mhat=fadd_s(mhat,dl); \
      _Pragma("unroll") for(int r=0;r<16;++r){P0[r]=fsub_s(P0[r],dl);P1[r]=fsub_s(P1[r],dl);} \
      if(USE_NEGM){ _Pragma("unroll") for(int r=0;r<16;++r)negm[r]=-mhat; asm volatile("":"+v"(negm)); } } \
    _Pragma("unroll") for(int r=0;r<16;++r)P0[r]=__builtin_amdgcn_exp2f(P0[r]); }while(0)
  #define RESC() do{ if(resc){ asm volatile("s_waitcnt lgkmcnt(0)":::"memory"); \
      _Pragma("unroll") for(int d_=0;d_<2;++d_) _Pragma("unroll") for(int r=0;r<16;++r)o[d_][r]*=wsf[crow(r,hi)]; } }while(0)
  f32x16 pA0,pA1,pB0,pB1; const f32x16 zc16={};
  int sl_prev=0,sl_cur=0,sl_next=SLOTB;
  #define ROT() do{sl_prev=sl_cur;sl_cur=sl_next;sl_next=(sl_next==(NSLOT-1)*SLOTB)?0:sl_next+SLOTB;}while(0)
  DMA_K(2,2*SLOTB);
  WAIT_BAR(3);
  qkt<USE_NEGM>(pA0,pA1,Kbase,qr,negm,r32,hi);asm volatile("s_nop 15\n\ts_nop 7":"+v"(pA0),"+v"(pA1));CMASK(pA0,pA1,0);
  START(pA0,pA1);
  _Pragma("unroll") for(int r=0;r<16;++r)pA1[r]=__builtin_amdgcn_exp2f(pA1[r]);
  WAIT_BAR(0);
  DMA_K(3,0);DMA_V(1,SLOTB);
  ROT();
  kload8(kf,kp0+sl_cur);
  WAIT_BAR(2);
  s16x4 vlo[8],vhi[8]; u32x4 pw0,pw1,pw2,pw3;
  #define PKW(P,B) cvtpk_s(P[B],P[B+1])
  #define PAF(k) __builtin_bit_cast(bf16x8,pw##k)
  #define VFR(i) (bf16x8){vlo[i][0],vlo[i][1],vlo[i][2],vlo[i][3],vhi[i][0],vhi[i][1],vhi[i][2],vhi[i][3]}
  #define PIN(x) asm volatile("":"+v"(x))
  #define MX3(a,b,c) __builtin_fmaxf(__builtin_fmaxf((a),(b)),(c))
  #define GAPA(MF,A0,A1,A2,A3,W0,W1,PW) do{ MF; sacc+=A0; sacc+=A1; sacc+=A2; sacc+=A3; PIN(sacc); W0; W1; PIN(PW); SBAR(); }while(0)
  #define EX(v) __builtin_amdgcn_exp2f(v)
  #define GAPB(MF,X,B) do{ MF; X[B]=EX(X[B]); X[B+1]=EX(X[B+1]); X[B+2]=EX(X[B+2]); X[B+3]=EX(X[B+3]); PIN(X); SBAR(); }while(0)
  #define VRD(i) do{ vlo[i]=vtr(vp_+(((i)>>2)*4096+((i)&3)*1024)); vhi[i]=vtr(vp_+(((i)>>2)*4096+((i)&3)*1024+512)); }while(0)
  #define KRD(G,j) do{ if(G){ kload2(kf,kp0+sl_next,j); SBAR(); } }while(0)
    \
  #define LIVE2(tt) ((64*(tt)<=e0+32*wid+31)&&(64*(tt)+63>=e0+32*wid-128))
  #define STEP(C0,C1,P0,P1,t,GK,GV,GL) do{ SBAR(); if((t)+1<NT){DMA_M((t)+1);} \
    if((MODE==2)&&!LIVE2(t)&&!LIVE2((t)-1)){ \
      if(GK){DMA_K((t)+3,sl_cur);} if(GV){DMA_V((t)+1,sl_next);} \
      KRD(GL,0); KRD(GL,1); KRD(GL,2); KRD(GL,3); \
      _Pragma("unroll") for(int r=0;r<16;++r){C0[r]=0.f;C1[r]=0.f;} resc=false; \
    } else { \
    const lds_cptr vp_=vp0+sl_prev; \
    VRD(0); SBAR(); float sacc=(P0[0]+P0[1]); \
    GAPA(C0=__builtin_amdgcn_mfma_f32_32x32x16_bf16(kf[0],qr[0],USE_NEGM?negm:zc16,0,0,0), P0[2],P0[3],P0[4],P0[5],     pw0[0]=PKW(P0,0), pw0[1]=PKW(P0,2), pw0); \
    VRD(4); SBAR(); GAPA(C1=__builtin_amdgcn_mfma_f32_32x32x16_bf16(kf[1],qr[0],USE_NEGM?negm:zc16,0,0,0), P0[6],P0[7],P0[8],P0[9],     pw0[2]=PKW(P0,4), pw0[3]=PKW(P0,6), pw0); \
    VRD(1); SBAR(); GAPA(C0=__builtin_amdgcn_mfma_f32_32x32x16_bf16(kf[2],qr[1],C0,0,0,0),   P0[10],P0[11],P0[12],P0[13], pw1[0]=PKW(P0,8), pw1[1]=PKW(P0,10), pw1); \
    VRD(5); SBAR(); GAPA(C1=__builtin_amdgcn_mfma_f32_32x32x16_bf16(kf[3],qr[1],C1,0,0,0),   P0[14],P0[15],P1[0],P1[1],   pw1[2]=PKW(P0,12),pw1[3]=PKW(P0,14), pw1); \
    VRD(2); SBAR(); GAPA(C0=__builtin_amdgcn_mfma_f32_32x32x16_bf16(kf[4],qr[2],C0,0,0,0),   P1[2],P1[3],P1[4],P1[5],     pw2[0]=PKW(P1,0), pw2[1]=PKW(P1,2), pw2); \
    VRD(6); SBAR(); GAPA(C1=__builtin_amdgcn_mfma_f32_32x32x16_bf16(kf[5],qr[2],C1,0,0,0),   P1[6],P1[7],P1[8],P1[9],     pw2[2]=PKW(P1,4), pw2[3]=PKW(P1,6), pw2); \
    VRD(3); SBAR(); GAPA(C0=__builtin_amdgcn_mfma_f32_32x32x16_bf16(kf[6],qr[3],C0,0,0,0),   P1[10],P1[11],P1[12],P1[13], pw3[0]=PKW(P1,8), pw3[1]=PKW(P1,10), pw3); \
    VRD(7); SBAR(); GAPA(C1=__builtin_amdgcn_mfma_f32_32x32x16_bf16(kf[7],qr[3],C1,0,0,0),   P1[14],P1[15],0.f,0.f,       pw3[2]=PKW(P1,12),pw3[3]=PKW(P1,14), pw3); \
    l_reg+=sacc; \
    if(GK){DMA_K((t)+3,sl_cur);} if(GV){DMA_V((t)+1,sl_next);} \
    CMASK(C0,C1,t); \
    { float a=MX3(C0[0],C0[1],C1[0]),b=MX3(C0[2],C0[3],C1[1]); a=MX3(a,C1[2],C1[3]); \
      _Pragma("unroll") for(int r=4;r<16;r+=4){a=MX3(a,C0[r],C0[r+1]);b=MX3(b,C0[r+2],C0[r+3]);a=MX3(a,C1[r],C1[r+1]);b=MX3(b,C1[r+2],C1[r+3]);} \
      float rm=__builtin_fmaxf(a,b); { auto rr=__builtin_amdgcn_permlane32_swap(__float_as_uint(rm),__float_as_uint(rm),false,false); rm=__builtin_fmaxf(__uint_as_float(rr[0]),__uint_as_float(rr[1])); } \
      resc=false; \
      if(__builtin_expect(__any(rm>(float)THRL),0)){ const float dl=__builtin_fmaxf(rm,0.f); mhat+=dl; \
        _Pragma("unroll") for(int r=0;r<16;++r){C0[r]-=dl;C1[r]-=dl;} \
        if(USE_NEGM){ _Pragma("unroll") for(int r=0;r<16;++r)negm[r]=-mhat; asm volatile("":"+v"(negm)); } \
        const float f=__builtin_amdgcn_exp2f(-dl); l_reg*=f; if(hi==0)wsf[r32]=f; resc=true; } } \
    SBAR(); \
    GAPB(o[0]=__builtin_amdgcn_mfma_f32_32x32x16_bf16(PAF(0),VFR(0),o[0],0,0,0), C0,0); \
    GAPB(o[1]=__builtin_amdgcn_mfma_f32_32x32x16_bf16(PAF(0),VFR(4),o[1],0,0,0), C0,4); \
    KRD(GL,0); GAPB(o[0]=__builtin_amdgcn_mfma_f32_32x32x16_bf16(PAF(1),VFR(1),o[0],0,0,0), C0,8); \
    KRD(GL,1); GAPB(o[1]=__builtin_amdgcn_mfma_f32_32x32x16_bf16(PAF(1),VFR(5),o[1],0,0,0), C0,12); \
    KRD(GL,2); GAPB(o[0]=__builtin_amdgcn_mfma_f32_32x32x16_bf16(PAF(2),VFR(2),o[0],0,0,0), C1,0); \
    KRD(GL,3); GAPB(o[1]=__builtin_amdgcn_mfma_f32_32x32x16_bf16(PAF(2),VFR(6),o[1],0,0,0), C1,4); \
    GAPB(o[0]=__builtin_amdgcn_mfma_f32_32x32x16_bf16(PAF(3),VFR(3),o[0],0,0,0), C1,8); \
    GAPB(o[1]=__builtin_amdgcn_mfma_f32_32x32x16_bf16(PAF(3),VFR(7),o[1],0,0,0), C1,12); \
    } }while(0)
  int t=1;
  for(;t+5<NT;t+=2){
    STEP(pB0,pB1,pA0,pA1,t,true,true,true);     WAIT_BAR(2); RESC(); ROT();
    STEP(pA0,pA1,pB0,pB1,t+1,true,true,true);   WAIT_BAR(2); RESC(); ROT();
  }
  #define ENDW(tt) do{ if((tt)+3<NT){WAIT_BAR(2);} else if((tt)+2<NT){WAIT_BAR(1);} else {WAIT_BAR(0);} }while(0)
  for(;t+1<NT;t+=2){
    STEP(pB0,pB1,pA0,pA1,t,(t+3<NT),(t+1<NT),(t+1<NT));       ENDW(t);   RESC(); ROT();
    STEP(pA0,pA1,pB0,pB1,t+1,(t+4<NT),(t+2<NT),(t+2<NT));     ENDW(t+1); RESC(); ROT();
  }
  STEP(pB0,pB1,pA0,pA1,NT-1,false,false,false); RESC();
  { float sacc=pB0[0]+pB0[1]; _Pragma("unroll") for(int r=2;r<16;++r)sacc+=pB0[r]; _Pragma("unroll") for(int r=0;r<16;++r)sacc+=pB1[r]; l_reg+=sacc;
    pw0=(u32x4){PKW(pB0,0),PKW(pB0,2),PKW(pB0,4),PKW(pB0,6)};pw1=(u32x4){PKW(pB0,8),PKW(pB0,10),PKW(pB0,12),PKW(pB0,14)};pw2=(u32x4){PKW(pB1,0),PKW(pB1,2),PKW(pB1,4),PKW(pB1,6)};pw3=(u32x4){PKW(pB1,8),PKW(pB1,10),PKW(pB1,12),PKW(pB1,14)};
    SBAR(); pv(o,vb0+sl_cur,PAF(0),PAF(1),PAF(2),PAF(3)); }
  #undef PKW
  #undef PAF
  #undef VFR
  #undef PIN
  #undef MX3
  #undef GAPA
  #undef GAPB
  #undef EX
  #undef VRD
  #undef KRD
  #undef STEP
  #undef LIVE2
  #undef ENDW
  {auto rr=__builtin_amdgcn_permlane32_swap(__float_as_uint(l_reg),__float_as_uint(l_reg),false,false);l_reg=__uint_as_float(rr[0])+__uint_as_float(rr[1]);}
  if(hi==0)wsf[32+r32]=l_reg;asm volatile("s_waitcnt lgkmcnt(0)":::"memory");
  float rli[16];
  #pragma unroll
  for(int r=0;r<16;++r)rli[r]=__builtin_amdgcn_rcpf(wsf[32+crow(r,hi)]);
  long os2=os,lses2=lses; asm volatile("":"+s"(os2),"+s"(lses2));
  if(lse!=nullptr && hi==0) lse[(long)(wid*QBLK+r32)*lses2]=mhat+__log2f(l_reg);
  bf16*Ow=Ou+(long)(wid*QBLK)*os2;
  { bf16*stg=(bf16*)(shm+LDS_OST)+wid*2048;
    #pragma unroll
    for(int r=0;r<16;++r){const int orow=crow(r,hi);
      #pragma unroll
      for(int d0=0;d0<2;++d0)stg[orow*64+d0*32+r32]=(bf16)f2bf(o[d0][r]*rli[r]);}
    asm volatile("s_waitcnt lgkmcnt(0)":::"memory");
    #pragma unroll
    for(int i=0;i<4;++i){const int row=i*8+(lane>>3),ch=lane&7; const u32x4 v=*(const u32x4*)(stg+row*64+ch*8); ATTN_STORE16(Ow+(long)row*os2+ch*8,v);} }
  asm volatile("s_waitcnt lgkmcnt(0)\n\ts_barrier":::"memory");
  #undef DMA_K
  #undef DMA_V
  #undef DMA_M
  #undef KT
  #undef CMASK
  #undef START
  #undef RESC
  #undef ROT
}
constexpr int ATTN_LDS_BYTES=LDS_BYTES;
#undef SBAR
#undef WAIT_BAR
}

__device__ __forceinline__ int vcu_of(int G, int bx) { return (G % 8 == 0) ? (bx % 8) * (G / 8) + bx / 8 : bx; }
__device__ __forceinline__ void ph_attn_moba(const bf16* QKV, const unsigned* SEL, bf16* O, unsigned char* smem) {
    const int G = (int)gridDim.x, vcu = vcu_of(G, bidx());
#pragma unroll 1
    for (int idx = 2 * vcu; idx < 512; idx += ((idx & 1) ? 2 * G - 1 : 1)) {
        const int bh = idx >> 5, j = idx & 31, qb = (j & 1) ? 31 - (j >> 1) : (j >> 1), b = bh >> 3, h = bh & 7;
        const long row0 = (long)b * SEQ + 256 * qb, kv0 = (long)b * SEQ * AB_LD;
        attn_g::attn_unit<0, 8>(QKV + row0 * AB_LD + CQA + h * 64, AB_LD, QKV + kv0 + CKA + h * 64, QKV + kv0 + CVA + h * 64, AB_LD, O + row0 * DM + h * 64, DM, nullptr, 0, 4 * qb + 4,
                                SEL + row0 * 8 + h, nullptr, 0, (char*)smem);
    }
}


__device__ __forceinline__ void ph_attn_dsa(const bf16* QKV, const unsigned long long* MASK, bf16* O, unsigned char* smem) {
    const int G = (int)gridDim.x, vcu = vcu_of(G, bidx());
#pragma unroll 1
    for (int idx = 2 * vcu; idx < 512; idx += ((idx & 1) ? 2 * G - 1 : 1)) {
        const int bh = idx >> 5, j = idx & 31, qb = (j & 1) ? 31 - (j >> 1) : (j >> 1), b = bh >> 3, h = bh & 7;
        const long row0 = (long)b * SEQ + 256 * qb, kv0 = (long)b * SEQ * AB_LD;
        attn_g::attn_unit<1, 8>(QKV + row0 * AB_LD + CQB + h * 64, AB_LD, QKV + kv0 + CKB + h * 64, QKV + kv0 + CVB + h * 64, AB_LD, O + row0 * DM + 512 + h * 64, DM, nullptr, 0, 4 * qb + 4,
                                nullptr, (const char*)(MASK + (size_t)b * 128 * SEQ + 256 * qb), 0, (char*)smem);
    }
}
__device__ __forceinline__ void ph_attn_dilated(const bf16* QKV1, bf16* OG, float* LSE, unsigned char* smem) {
    const int G = (int)gridDim.x, vcu = vcu_of(G, bidx());
#pragma unroll 1
    for (int u = vcu; u < 3072; u += G) {
        const int g = u >> 10, bh = (u >> 5) & 31, j = u & 31, b = bh >> 4, h = bh & 15;
        const int lg = 2 * g, dil = 1 << lg, per = 32 >> lg;
        const int res = j / per, mb = j % per, m0 = 256 * mb, mk0 = (mb == 0) ? 0 : m0 - 128, nt = (m0 + 256 - mk0) / 64;
        const long qrow = (long)b * SEQ + res + (long)dil * m0, krow = (long)b * SEQ + res + (long)dil * mk0;
        attn_g::attn_unit<2, 8>(QKV1 + qrow * C_LD + h * 64, (long)dil * C_LD, QKV1 + krow * C_LD + 1024 + h * 64, QKV1 + krow * C_LD + 2048 + h * 64, (long)dil * C_LD,
                                OG + ((size_t)g * T + qrow) * DM + h * 64, (long)dil * DM, LSE + ((size_t)g * T + qrow) * 16 + h, (long)dil * 16, nt, nullptr, nullptr, m0 - mk0, (char*)smem);
    }
}


__device__ __forceinline__ float okf(float f) { return __builtin_bit_cast(float, okey(f)); }
__device__ __forceinline__ int score_pitch(int qb) { return 256 * (qb + 1) + 64; }
__device__ __forceinline__ size_t score_base(int b, int qb) { return (size_t)b * 35127296 + (size_t)65536 * (size_t)((qb * (qb + 1)) / 2) + (size_t)16384 * qb; }
__device__ __forceinline__ void ph_dsa_score(const bf16* QKV, float* S, unsigned char* smem) {
    using attn_g::bf16x8; using attn_g::f32x16;
    typedef __attribute__((address_space(3))) const char* lcp;
    const int tid = tidx(), lane = tid & 63, r32 = lane & 31, hi = lane >> 5; const int wid = __builtin_amdgcn_readfirstlane(tid >> 6);
    const unsigned lds0 = (unsigned)(uintptr_t)smem;
    const unsigned kvoff = (unsigned)((lane * AB_LD + wid * 8) * 2);
#pragma unroll 1
    for (int item = bidx(); item < 544; item += (int)gridDim.x) {
        const int b = item / 272; int rr = item % 272, qb = 0;
#pragma unroll 1
        for (;;) { const int nc = (qb + 2) >> 1; if (rr < nc) break; rr -= nc; ++qb; }
        const int t0 = 8 * rr, t1 = min(t0 + 8, 4 * qb + 4);
        const bf16* qrow = QKV + ((size_t)b * SEQ + 256 * qb + wid * 32 + r32) * AB_LD;
        bf16x8 qr[4][4]; float w[4];
#pragma unroll
        for (int h = 0; h < 4; ++h) { w[h] = bf2f(qrow[CWI + h]);
#pragma unroll
            for (int d0 = 0; d0 < 4; ++d0) qr[h][d0] = *(const bf16x8*)(qrow + CQI + h * 64 + d0 * 16 + hi * 8); }
        const char* kbase = (const char*)(QKV + (size_t)b * SEQ * AB_LD + CKI);
        const int rowlen = score_pitch(qb); float* sblk = S + score_base(b, qb) + (size_t)(wid * 32) * rowlen;
#define SC_DMA(t) attn_g::glds16s(kbase + (size_t)(t) * (64 * AB_LD * 2), kvoff, (unsigned)__builtin_amdgcn_readfirstlane(lds0 + (((t) - t0) & 1) * 8192 + wid * 1024))
        SC_DMA(t0);
        asm volatile("s_waitcnt vmcnt(0) lgkmcnt(0)\n\ts_barrier" ::: "memory");
#pragma unroll 1
        for (int t = t0; t < t1; ++t) {
            if (t + 1 < t1) SC_DMA(t + 1);
            const lcp kb = (lcp)smem + ((t - t0) & 1) * 8192 + hi * 1024 + r32 * 16;
            bf16x8 kf[4][2];
#pragma unroll
            for (int d0 = 0; d0 < 4; ++d0) { kf[d0][0] = *(const __attribute__((address_space(3))) bf16x8*)(kb + d0 * 2048); kf[d0][1] = *(const __attribute__((address_space(3))) bf16x8*)(kb + d0 * 2048 + 512); }
            f32x16 sc0, sc1;
#pragma unroll
            for (int r = 0; r < 16; ++r) { sc0[r] = 0.f; sc1[r] = 0.f; }
#pragma unroll
            for (int h = 0; h < 4; ++h) {
                f32x16 p0 = {}, p1 = {};
#pragma unroll
                for (int d0 = 0; d0 < 4; ++d0) { p0 = __builtin_amdgcn_mfma_f32_32x32x16_bf16(kf[d0][0], qr[h][d0], p0, 0, 0, 0); p1 = __builtin_amdgcn_mfma_f32_32x32x16_bf16(kf[d0][1], qr[h][d0], p1, 0, 0, 0); }
#pragma unroll
                for (int r = 0; r < 16; ++r) { sc0[r] = fmaf(w[h], fmaxf(p0[r], 0.f), sc0[r]); sc1[r] = fmaf(w[h], fmaxf(p1[r], 0.f), sc1[r]); }
                __builtin_amdgcn_sched_barrier(0);
            }
            {   typedef __attribute__((address_space(3))) f32x4* lf4;
                const lf4 wr = (lf4)((__attribute__((address_space(3))) char*)smem + 16384 + wid * 8704 + r32 * 272 + hi * 16);
#pragma unroll
                for (int g = 0; g < 4; ++g) {
                    wr[2 * g] = (f32x4){okf(sc0[4 * g]), okf(sc0[4 * g + 1]), okf(sc0[4 * g + 2]), okf(sc0[4 * g + 3])}; wr[2 * g + 8] = (f32x4){okf(sc1[4 * g]), okf(sc1[4 * g + 1]), okf(sc1[4 * g + 2]), okf(sc1[4 * g + 3])}; }
                const int ln2 = tidx() & 63;
                const lf4 rd = (lf4)((__attribute__((address_space(3))) char*)smem + 16384 + wid * 8704 + (ln2 >> 4) * 272 + (ln2 & 15) * 16);
                float* gp = sblk + (size_t)(ln2 >> 4) * rowlen + 64 * t + 4 * (ln2 & 15);
#pragma unroll
                for (int i = 0; i < 8; ++i) { const f32x4 vv = rd[i * 68]; *(f32x4*)(gp + (size_t)(4 * i) * rowlen) = vv; }
            }
            asm volatile("s_waitcnt vmcnt(8) lgkmcnt(0)\n\ts_barrier" ::: "memory");
        }
#undef SC_DMA
    }
}
#define RS_PASS(SHIFT, PMASK, PVAL) do { \
    _Pragma("unroll") for (int i_ = 0; i_ < 16; ++i_) *(LAS u32x4g*)(hist + 4 * (lane + 64 * i_)) = (u32x4g){0u, 0u, 0u, 0u}; \
    _Pragma("unroll") for (int g_ = 0; g_ < 8; ++g_) if (g_ * 1024 < n) { \
        _Pragma("unroll") for (int j_ = 16 * g_; j_ < 16 * g_ + 16; ++j_) { const unsigned k_ = v[j_]; const bool mt_ = (k_ & (PMASK)) == (PVAL); \
            if ((PMASK) == 0u || __ballot(mt_) != 0ull) { \
                if (mt_) __hip_atomic_fetch_add(hist + (((k_ >> (SHIFT)) & 255u) * 16u + (unsigned)(lane & 15)), 1u, __ATOMIC_RELAXED, __HIP_MEMORY_SCOPE_WORKGROUP); } } } \
    unsigned c_[4]; \
    _Pragma("unroll") for (int b_ = 0; b_ < 4; ++b_) { u32x4g q_ = *(const LAS u32x4g*)(hist + 64 * lane + 16 * b_); \
        _Pragma("unroll") for (int i_ = 1; i_ < 4; ++i_) { const u32x4g r_ = *(const LAS u32x4g*)(hist + 64 * lane + 16 * b_ + 4 * i_); q_ += r_; } \
        c_[b_] = (q_[0] + q_[1]) + (q_[2] + q_[3]); } \
    const unsigned tot_ = (c_[0] + c_[1]) + (c_[2] + c_[3]); \
    unsigned inc_ = tot_;                         \
    _Pragma("unroll") for (int o_ = 1; o_ < 64; o_ <<= 1) { const unsigned t_ = (unsigned)bperm((lane + o_) & 63, (int)inc_); if (lane + o_ < 64) inc_ += t_; } \
    const unsigned suf_ = inc_ - tot_;            \
    const unsigned long long hit_ = __ballot(suf_ < need && need <= inc_); \
    const int L_ = (int)__builtin_ctzll(hit_); \
    unsigned run_ = suf_, bsel_ = 0u, cg_ = 0u, ce_ = 0u; bool done_ = false; \
    _Pragma("unroll") for (int i_ = 3; i_ >= 0; --i_) { if (!done_ && run_ + c_[i_] >= need) { bsel_ = (unsigned)(4 * lane + i_); cg_ = run_; ce_ = c_[i_]; done_ = true; } run_ += c_[i_]; } \
    bsel = (unsigned)__builtin_amdgcn_readlane((int)bsel_, L_); need -= (unsigned)__builtin_amdgcn_readlane((int)cg_, L_); ceq = (unsigned)__builtin_amdgcn_readlane((int)ce_, L_); } while (0)
__device__ __forceinline__ void ph_dsa_select_opt(const float* S, unsigned long long* mask, unsigned char* smem) {
    const int tid = tidx(), lane = tid & 63, wave = tid >> 6;
    LAS unsigned* hist = (LAS unsigned*)((LAS unsigned char*)smem + wave * 16384);
    const int gwv = bidx() * (NT / 64) + wave, ngw = (int)gridDim.x * (NT / 64);
#pragma unroll 1
    for (int t = T - 1 - gwv; t >= 0; t -= ngw) {
        const int b = t / SEQ, tt = t % SEQ, n = tt + 1, qb = tt >> 8;
        const float* row = S + score_base(b, qb) + (size_t)(tt & 255) * score_pitch(qb) + 4 * lane;
        unsigned v[128];
#pragma unroll
        for (int g = 0; g < 8; ++g) {
            if (g * 1024 < n) {
#pragma unroll
                for (int j = 4 * g; j < 4 * g + 4; ++j) { const u32x4g q = *(const u32x4g*)(row + 256 * j); v[4 * j] = q[0]; v[4 * j + 1] = q[1]; v[4 * j + 2] = q[2]; v[4 * j + 3] = q[3]; }
            } else {
#pragma unroll
                for (int j = 16 * g; j < 16 * g + 16; ++j) v[j] = 0u;
            }
        }
        asm volatile("" ::: "memory");
#pragma unroll
        for (int g = 0; g < 8; ++g) {
            if (g * 1024 < n && (g + 1) * 1024 > n) {
#pragma unroll
                for (int j = 16 * g; j < 16 * g + 16; ++j) { const int kv = 256 * (j >> 2) + 4 * lane + (j & 3); v[j] = (kv < n) ? v[j] : 0u; }
            }
        }
        unsigned thr = 0u, need = 256u, ceq = 0u;
        if (n > 256) {
            unsigned bsel;
            RS_PASS(24, 0u, 0u);                 thr = bsel << 24;
            RS_PASS(16, 0xff000000u, thr);       thr |= bsel << 16;
            RS_PASS(8, 0xffff0000u, thr);        thr |= bsel << 8;
            RS_PASS(0, 0xffffff00u, thr);        thr |= bsel;
        }
        const int ntile = 4 * (qb + 1);
        const bool ties = (n > 256) && (ceq != need);
        unsigned taken = 0u;
        unsigned long long* mrow = mask + (size_t)b * 128 * SEQ + tt;
#pragma unroll
        for (int j = 0; j < 32; ++j) {
            if (4 * j < ntile) {
                unsigned nib = 0u;
                if (n <= 256) {
#pragma unroll
                    for (int i = 0; i < 4; ++i) nib |= ((256 * j + 4 * lane + i) < n) ? (1u << i) : 0u;
                } else if (!ties) {
#pragma unroll
                    for (int i = 0; i < 4; ++i) nib |= (v[4 * j + i] >= thr) ? (1u << i) : 0u;
                } else {
                    bool eq[4]; unsigned long long em[4]; unsigned long long any = 0ull;
#pragma unroll
                    for (int i = 0; i < 4; ++i) { nib |= (v[4 * j + i] > thr) ? (1u << i) : 0u; eq[i] = (v[4 * j + i] == thr) && ((256 * j + 4 * lane + i) < n); em[i] = __ballot(eq[i]); any |= em[i]; }
                    if (any != 0ull) {
                        const unsigned long long ltm = (1ull << lane) - 1ull;
                        unsigned below = taken, tot = 0u;
#pragma unroll
                        for (int i = 0; i < 4; ++i) { below += (unsigned)__popcll(em[i] & ltm); tot += (unsigned)__popcll(em[i]); }
#pragma unroll
                        for (int i = 0; i < 4; ++i) { if (eq[i]) { if (below < need) nib |= (1u << i); ++below; } }
                        taken += tot;
                    }
                }
                const unsigned sh = 4u * (unsigned)(lane & 15);
                unsigned lo = (sh < 32u) ? (nib << sh) : 0u, hiw = (sh >= 32u) ? (nib << (sh - 32u)) : 0u;
                lo |= (unsigned)__builtin_amdgcn_update_dpp(0, (int)lo, 0x121, 0xf, 0xf, true); hiw |= (unsigned)__builtin_amdgcn_update_dpp(0, (int)hiw, 0x121, 0xf, 0xf, true);
                lo |= (unsigned)__builtin_amdgcn_update_dpp(0, (int)lo, 0x122, 0xf, 0xf, true); hiw |= (unsigned)__builtin_amdgcn_update_dpp(0, (int)hiw, 0x122, 0xf, 0xf, true);
                lo |= (unsigned)__builtin_amdgcn_update_dpp(0, (int)lo, 0x124, 0xf, 0xf, true); hiw |= (unsigned)__builtin_amdgcn_update_dpp(0, (int)hiw, 0x124, 0xf, 0xf, true);
                lo |= (unsigned)__builtin_amdgcn_update_dpp(0, (int)lo, 0x128, 0xf, 0xf, true); hiw |= (unsigned)__builtin_amdgcn_update_dpp(0, (int)hiw, 0x128, 0xf, 0xf, true);
                const int tile = 4 * j + (lane >> 4);
                if ((lane & 15) == 0 && tile < ntile) mrow[(size_t)tile * SEQ] = ((unsigned long long)hiw << 32) | lo;
            }
        }
    }
}
#undef RS_PASS
#define XB_TMO      128
#define XB_XCNT(j)  (256  + 64 * (j))
#define XB_XSUB(j)  (1280 + 64 * (j))
#define XB_XGEN(j)  (2304 + 64 * (j))
#define XB_TOP      3328
#define XB_TOPGEN   3392
#define XCD_BAR_WORDS 3456
#define XB_SPIN_CAP (1u << 18)

__device__ __forceinline__ unsigned xb_ld(unsigned* p)              { return __hip_atomic_load(p, __ATOMIC_RELAXED, __HIP_MEMORY_SCOPE_AGENT); }
__device__ __forceinline__ unsigned xb_add(unsigned* p, unsigned v) { return __hip_atomic_fetch_add(p, v, __ATOMIC_RELAXED, __HIP_MEMORY_SCOPE_AGENT); }
__device__ __forceinline__ unsigned xb_xcc_id() { return (unsigned)__builtin_amdgcn_s_getreg((3 << 11) | 20) & 0xFu; }
#define XB_SPIN(cond, bar) do { unsigned _sp = 0; while (cond) { __builtin_amdgcn_s_sleep(1); \
    if ((++_sp & 255u) == 0u) { if (xb_ld(&(bar)[XB_TMO])) break; if (_sp > XB_SPIN_CAP) { atomicAdd(&(bar)[XB_TMO], 1u); break; } } } } while (0)

struct XcdBarrier {
    unsigned* bar; unsigned x;
    volatile LAS unsigned* st;
};

__device__ __forceinline__ XcdBarrier xcd_barrier_post(unsigned* bar, volatile LAS unsigned* st) {
    XcdBarrier b; b.bar = bar; b.x = xb_xcc_id(); b.st = st;
    if (tidx() == 0) (void)xb_add(&bar[XB_XCNT(b.x)], 1u);
    return b;
}
__device__ __forceinline__ void xcd_barrier_complete(unsigned* bar, unsigned x, unsigned& nloc, unsigned& nx) {
    const unsigned G = gridDim.x * gridDim.y * gridDim.z;
    unsigned sum, cnt, mine, sp = 0u;
    for (;;) {
        sum = 0u; cnt = 0u; mine = 0u;
#pragma unroll
        for (unsigned j = 0; j < 16; ++j) { const unsigned c = xb_ld(&bar[XB_XCNT(j)]); sum += c; cnt += (c > 0u) ? 1u : 0u; mine = (j == x) ? c : mine; }
        if (sum == G) break;
        __builtin_amdgcn_s_sleep(1);
        if ((++sp & 255u) == 0u) { if (xb_ld(&bar[XB_TMO])) break; if (sp > XB_SPIN_CAP) { atomicAdd(&bar[XB_TMO], 1u); break; } }
    }
    nloc = mine > 0u ? mine : 1u; nx = cnt > 0u ? cnt : 1u;
}

__device__ __forceinline__ void xcd_barrier(const XcdBarrier& b) {
    asm volatile("s_waitcnt vmcnt(0)" ::: "memory");
    __syncthreads();
    if (tidx() == 0) {
        unsigned* bar = b.bar;
        __builtin_amdgcn_s_waitcnt(0);
        unsigned nloc = b.st[0], nx = b.st[1];
        if (nloc == 0u) { xcd_barrier_complete(bar, b.x, nloc, nx); b.st[0] = nloc; b.st[1] = nx; }
        const unsigned old = xb_add(&bar[XB_XSUB(b.x)], 1u);
        const unsigned gen = old / nloc;
        if (old + 1u == (gen + 1u) * nloc) {
            __builtin_amdgcn_fence(__ATOMIC_RELEASE, "agent");
            asm volatile("s_waitcnt vmcnt(0)" ::: "memory");
            const unsigned og = xb_add(&bar[XB_TOP], 1u);
            const unsigned tg = og / nx;
            if (og + 1u == (tg + 1u) * nx) xb_add(&bar[XB_TOPGEN], 1u);
            else XB_SPIN(xb_ld(&bar[XB_TOPGEN]) == tg, bar);
            __builtin_amdgcn_fence(__ATOMIC_ACQUIRE, "agent");
            xb_add(&bar[XB_XGEN(b.x)], 1u);
            asm volatile("s_waitcnt vmcnt(0)" ::: "memory");
        } else {
            XB_SPIN(xb_ld(&bar[XB_XGEN(b.x)]) == gen, bar);
            __builtin_amdgcn_fence(__ATOMIC_ACQUIRE, "agent");
            asm volatile("s_waitcnt vmcnt(0)" ::: "memory");
        }
    }
    __syncthreads();
}


constexpr float U_SCALE = 64.f, V_SCALE = 8.f;
typedef float f32x2g __attribute__((ext_vector_type(2)));
template <bool SLICED> __device__ __forceinline__ void cvt_fp8(const float* src, unsigned char* dst, size_t n, float scale) {
    for (size_t e = ((size_t)bidx() * NT + tidx()) * 16; e < n; e += (size_t)gridDim.x * NT * 16) {
        u32x4g o;
#pragma unroll
        for (int d = 0; d < 4; ++d) { const f32x4 a = *(const f32x4*)(src + e + 4 * d);
            int p = __builtin_amdgcn_cvt_pk_fp8_f32(a.x * scale, a.y * scale, 0, false); p = __builtin_amdgcn_cvt_pk_fp8_f32(a.z * scale, a.w * scale, p, true); o[d] = (unsigned)p; }
        if (SLICED) { const size_t ex = e >> 10, dd = e & 1023; *(u32x4g*)(dst + (dd >> 7) * ((size_t)NEXP * 128) + ex * 128 + (dd & 127)) = o; }
        else *(u32x4g*)(dst + e) = o; }
}
__device__ __forceinline__ float dot16_fp8(const float (&x)[16], u32x4g u) {
    f32x2g s2 = {0.f, 0.f};
#pragma unroll
    for (int d = 0; d < 4; ++d) { const int ud = (int)u[d]; const f32x2g lo = __builtin_amdgcn_cvt_pk_f32_fp8(ud, false), hi = __builtin_amdgcn_cvt_pk_f32_fp8(ud, true);
        const f32x2g xa = {x[4 * d], x[4 * d + 1]}, xb = {x[4 * d + 2], x[4 * d + 3]};
        s2 = lo * xa + s2; s2 = hi * xb + s2; }
    return s2[0] + s2[1];
}
#define LD8(dst, TAB, B) do { const int er_ = ((B) < 8) ? e0 : e1; \
    _Pragma("unroll") for (int k = 0; k < 8; ++k) { const int idx = __builtin_amdgcn_readlane(er_, ((B) * 8 + k) & 63); dst[k] = *(const u32x4g*)((TAB) + (size_t)idx * DM + 16 * lane); } } while (0)
#define CMU8(src, B) do { float s_[8]; \
    _Pragma("unroll") for (int k = 0; k < 8; ++k) s_[k] = dot16_fp8(x, src[k]); \
    float r_[4]; const bool b5 = lane & 32, b4 = lane & 16, b3 = lane & 8; \
    _Pragma("unroll") for (int i = 0; i < 4; ++i) { const float snd = b5 ? s_[i] : s_[4 + i], kp = b5 ? s_[4 + i] : s_[i]; r_[i] = kp + __shfl_xor(snd, 32); } \
    float q_[2]; \
    _Pragma("unroll") for (int i = 0; i < 2; ++i) { const float snd = b4 ? r_[i] : r_[2 + i], kp = b4 ? r_[2 + i] : r_[i]; q_[i] = kp + __shfl_xor(snd, 16); } \
    float p_; { const float snd = b3 ? q_[0] : q_[1], kp = b3 ? q_[1] : q_[0]; p_ = kp + __shfl_xor(snd, 8); } \
    p_ += __shfl_xor(p_, 4); p_ += __shfl_xor(p_, 2); p_ += __shfl_xor(p_, 1); \
    if ((lane & 7) == 0) al[(B) * 8 + (lane >> 3)] = p_; } while (0)
#define CMV8(src, B) do { const float wr_ = ((B) < 8) ? w0 : w1; \
    _Pragma("unroll") for (int k = 0; k < 8; ++k) { \
        const float w = __builtin_bit_cast(float, __builtin_amdgcn_readlane(__builtin_bit_cast(int, wr_), ((B) * 8 + k) & 63)); const u32x4g v0 = src[k]; \
        _Pragma("unroll") for (int d = 0; d < 4; ++d) { const int vd = (int)v0[d]; const f32x2g lo = __builtin_amdgcn_cvt_pk_f32_fp8(vd, false), hi = __builtin_amdgcn_cvt_pk_f32_fp8(vd, true); \
            acc[4 * d] = fmaf(w, lo[0], acc[4 * d]); acc[4 * d + 1] = fmaf(w, lo[1], acc[4 * d + 1]); acc[4 * d + 2] = fmaf(w, hi[0], acc[4 * d + 2]); acc[4 * d + 3] = fmaf(w, hi[1], acc[4 * d + 3]); } } } while (0)
__device__ __forceinline__ void ph_peer_gather_fp8(const int* eidx, const float* gw, const unsigned char* U, const unsigned char* V, float* h, const float* gain_next, bf16* XN, unsigned char* smem) {
    const int tid = tidx(), lane = tid & 63, wave = tid >> 6;
    float* al = (float*)smem + wave * 128;
    const int gwv = bidx() * (NT / 64) + wave, ngw = gridDim.x * (NT / 64);
#pragma unroll 1
    for (int t = gwv; t < T; t += ngw) {
        float x[16];
        { const u32x4g xa = *(const u32x4g*)(XN + (size_t)t * DM + 16 * lane), xb = *(const u32x4g*)(XN + (size_t)t * DM + 16 * lane + 8);
#pragma unroll
          for (int d = 0; d < 4; ++d) { const unsigned wa = xa[d], wb = xb[d]; x[2 * d] = bflo(wa); x[2 * d + 1] = bfhi(wa); x[8 + 2 * d] = bflo(wb); x[8 + 2 * d + 1] = bfhi(wb); } }
        const int e0 = eidx[(size_t)t * 128 + lane], e1 = eidx[(size_t)t * 128 + 64 + lane];
        const float g0 = gw[(size_t)t * 128 + lane], g1 = gw[(size_t)t * 128 + 64 + lane];
        u32x4g ra[8], rb[8];
        LD8(ra, U, 0);
#pragma unroll 1
        for (int b = 0; b < 16; b += 2) {
            LD8(rb, U, b + 1); CMU8(ra, b);
            if (b + 2 < 16) LD8(ra, U, b + 2); else LD8(ra, V, 0);
            CMU8(rb, b + 1);
        }
        __builtin_amdgcn_s_waitcnt(0xc07f); asm volatile("" ::: "memory");
        const float w0 = g0 * gelu_tanh(al[lane] * (1.0f / U_SCALE)) * (1.0f / V_SCALE), w1 = g1 * gelu_tanh(al[64 + lane] * (1.0f / U_SCALE)) * (1.0f / V_SCALE);
        float acc[16];
#pragma unroll
        for (int i = 0; i < 16; ++i) acc[i] = 0.f;
#pragma unroll 1
        for (int b = 0; b < 16; b += 2) {
            LD8(rb, V, b + 1); CMV8(ra, b);
            if (b + 2 < 16) LD8(ra, V, b + 2);
            CMV8(rb, b + 1);
        }
        float* hp = h + (size_t)t * DM + 16 * lane;
        f32x4 hv[4]; float ss = 0.f;
#pragma unroll
        for (int i = 0; i < 4; ++i) { hv[i] = *(f32x4*)(hp + 4 * i); hv[i] += (f32x4){acc[4 * i], acc[4 * i + 1], acc[4 * i + 2], acc[4 * i + 3]}; *(f32x4*)(hp + 4 * i) = hv[i];
            ss += hv[i][0] * hv[i][0] + hv[i][1] * hv[i][1] + hv[i][2] * hv[i][2] + hv[i][3] * hv[i][3]; }
        const float rstd = 1.0f / sqrtf(wave_sum(ss) * (1.0f / DM) + NORM_EPS);
        u32x4g o0, o1;
#pragma unroll
        for (int i = 0; i < 2; ++i) { const f32x4 ga = *(const f32x4*)(gain_next + 16 * lane + 4 * i), gb = *(const f32x4*)(gain_next + 16 * lane + 8 + 4 * i);
            o0[2 * i] = pk2(hv[i][0] * rstd * ga[0], hv[i][1] * rstd * ga[1]); o0[2 * i + 1] = pk2(hv[i][2] * rstd * ga[2], hv[i][3] * rstd * ga[3]);
            o1[2 * i] = pk2(hv[2 + i][0] * rstd * gb[0], hv[2 + i][1] * rstd * gb[1]); o1[2 * i + 1] = pk2(hv[2 + i][2] * rstd * gb[2], hv[2 + i][3] * rstd * gb[3]); }
        *(u32x4g*)(XN + (size_t)t * DM + 16 * lane) = o0; *(u32x4g*)(XN + (size_t)t * DM + 16 * lane + 8) = o1;
    }
}

#define GA_LDE(E0, E1, XA, XB, tt) do { const size_t t_ = (size_t)(((tt) < T) ? (tt) : tlast); E0 = eidx[t_ * 128 + lane]; E1 = eidx[t_ * 128 + 64 + lane]; \
    XA = *(const u32x4g*)(XN + t_ * DM + 128 * j + 16 * c); XB = *(const u32x4g*)(XN + t_ * DM + 128 * j + 16 * c + 8); } while (0)
#define G_LDP(PC, E0, E1, TAB) do { _Pragma("unroll") for (int i = 0; i < 16; ++i) { const int idx = bperm((8 * i + sgrp) & 63, (i < 8) ? E0 : E1); PC[i] = *(const u32x4g*)((TAB) + (size_t)idx * 128); } } while (0)
__device__ __forceinline__ void ph_gather_a(const bf16* XN, const int* eidx, const unsigned char* Us, float* PA, int j, int r, int nper, const float* gain) {
    const int tid = tidx(), lane = tid & 63, wave = tid >> 6, sgrp = lane >> 3, c = lane & 7;
    const unsigned char* Uj = Us + (size_t)j * NEXP * 128 + 16 * c;
    const int t0 = r * (NT / 64) + wave, st = nper * (NT / 64); if (st <= 0 || t0 >= T) return;
    const int tlast = t0 + ((T - 1 - t0) / st) * st;
    int e0, e1; u32x4g xa, xb, nxa, nxb; u32x4g pc[16];
    float gs[16];
#pragma unroll
    for (int i = 0; i < 16; ++i) gs[i] = gain[128 * j + 16 * c + i];
    GA_LDE(e0, e1, xa, xb, t0); G_LDP(pc, e0, e1, Uj); GA_LDE(e0, e1, nxa, nxb, t0 + st);
#pragma unroll 1
    for (int t = t0; t < T; t += st) {
        float x[16];
#pragma unroll
        for (int d = 0; d < 4; ++d) { const unsigned wa = xa[d], wb = xb[d]; x[2 * d] = bflo(wa) * gs[2 * d]; x[2 * d + 1] = bfhi(wa) * gs[2 * d + 1]; x[8 + 2 * d] = bflo(wb) * gs[8 + 2 * d]; x[8 + 2 * d + 1] = bfhi(wb) * gs[8 + 2 * d + 1]; }
        float sm[16];
#pragma unroll
        for (int i = 0; i < 16; ++i) sm[i] = dot16_fp8(x, pc[i]);
        asm volatile("" ::: "memory");
        G_LDP(pc, e0, e1, Uj);
        xa = nxa; xb = nxb;
        GA_LDE(e0, e1, nxa, nxb, t + 2 * st);
        float p0 = 0.f, p1 = 0.f;
#pragma unroll
        for (int i = 0; i < 16; ++i) { float v = sm[i]; v += shx<1>(v); v += shx<2>(v); v += shx<4>(v);
            if (i < 8) p0 = ((i & 7) == c) ? v : p0; else p1 = ((i & 7) == c) ? v : p1; }
        float* pa = PA + ((size_t)t * 8 + j) * 128 + 8 * c + sgrp; pa[0] = p0; pa[64] = p1;
    }
}
__device__ __forceinline__ void ph_gather_v(const int* eidx, const float* gw, const float* PA, const unsigned char* V, float* h, const float* gain_next, bf16* XN) {
    const int tid = tidx(), lane = tid & 63, wave = tid >> 6;
    const int gwv = bidx() * (NT / 64) + wave, ngw = gridDim.x * (NT / 64);
    int ne0 = 0, ne1 = 0; if (gwv < T) { ne0 = eidx[(size_t)gwv * 128 + lane]; ne1 = eidx[(size_t)gwv * 128 + 64 + lane]; }
#pragma unroll 1
    for (int t = gwv; t < T; t += ngw) {
        const int e0 = ne0, e1 = ne1;
        u32x4g ra[8], rb[8];
        LD8(ra, V, 0);
        { const size_t tn = (size_t)((t + ngw < T) ? t + ngw : t); ne0 = eidx[tn * 128 + lane]; ne1 = eidx[tn * 128 + 64 + lane]; }
        float a0 = 0.f, a1 = 0.f;
#pragma unroll
        for (int q = 0; q < 8; ++q) { a0 += PA[((size_t)t * 8 + q) * 128 + lane]; a1 += PA[((size_t)t * 8 + q) * 128 + 64 + lane]; }
        const float w0 = gw[(size_t)t * 128 + lane] * gelu_tanh(a0 * (1.0f / U_SCALE)) * (1.0f / V_SCALE), w1 = gw[(size_t)t * 128 + 64 + lane] * gelu_tanh(a1 * (1.0f / U_SCALE)) * (1.0f / V_SCALE);
        float acc[16];
#pragma unroll
        for (int i = 0; i < 16; ++i) acc[i] = 0.f;
#pragma unroll 1
        for (int b = 0; b < 16; b += 2) {
            LD8(rb, V, b + 1); CMV8(ra, b);
            if (b + 2 < 16) LD8(ra, V, b + 2);
            CMV8(rb, b + 1);
        }
        float* hp = h + (size_t)t * DM + 16 * lane;
        f32x4 hv[4]; float ss = 0.f;
#pragma unroll
        for (int i = 0; i < 4; ++i) { hv[i] = *(f32x4*)(hp + 4 * i); hv[i] += (f32x4){acc[4 * i], acc[4 * i + 1], acc[4 * i + 2], acc[4 * i + 3]}; *(f32x4*)(hp + 4 * i) = hv[i];
            ss += hv[i][0] * hv[i][0] + hv[i][1] * hv[i][1] + hv[i][2] * hv[i][2] + hv[i][3] * hv[i][3]; }
        const float rstd = 1.0f / sqrtf(wave_sum(ss) * (1.0f / DM) + NORM_EPS);
        u32x4g o0, o1;
#pragma unroll
        for (int i = 0; i < 2; ++i) { const f32x4 ga = *(const f32x4*)(gain_next + 16 * lane + 4 * i), gb = *(const f32x4*)(gain_next + 16 * lane + 8 + 4 * i);
            o0[2 * i] = pk2(hv[i][0] * rstd * ga[0], hv[i][1] * rstd * ga[1]); o0[2 * i + 1] = pk2(hv[i][2] * rstd * ga[2], hv[i][3] * rstd * ga[3]);
            o1[2 * i] = pk2(hv[2 + i][0] * rstd * gb[0], hv[2 + i][1] * rstd * gb[1]); o1[2 * i + 1] = pk2(hv[2 + i][2] * rstd * gb[2], hv[2 + i][3] * rstd * gb[3]); }
        *(u32x4g*)(XN + (size_t)t * DM + 16 * lane) = o0; *(u32x4g*)(XN + (size_t)t * DM + 16 * lane + 8) = o1;
    }
}


__device__ __forceinline__ void ph_gather_u8(const bf16* XN, const int* eidx, const unsigned char* Us, float* PA, int j, int r, int nper, const float* gain, unsigned char* smem) {
    const int tid = tidx(), lane = tid & 63, wave = tid >> 6, u = lane >> 3, c = lane & 7;
    LAS int* il = (LAS int*)((LAS unsigned char*)smem + wave * 4096);
    const unsigned char* Uj = Us + (size_t)j * NEXP * 128 + 16 * c;
    float gs[16];
#pragma unroll
    for (int i = 0; i < 16; ++i) gs[i] = gain[128 * j + 16 * c + i];
    const int g0 = r * (NT / 64) + wave, gstep = nper * (NT / 64); if (gstep <= 0) return;
#pragma unroll 1
    for (int g = g0; g < T / 8; g += gstep) {
        const size_t t = (size_t)g * 8 + u;
#pragma unroll
        for (int i = 0; i < 4; ++i) *(LAS u32x4g*)(il + u * 128 + 16 * c + 4 * i) = *(const u32x4g*)(eidx + t * 128 + 16 * c + 4 * i);
        float x[16];
        { const u32x4g xa = *(const u32x4g*)(XN + t * DM + 128 * j + 16 * c), xb = *(const u32x4g*)(XN + t * DM + 128 * j + 16 * c + 8);
#pragma unroll
          for (int d = 0; d < 4; ++d) { const unsigned wa = xa[d], wb = xb[d]; x[2 * d] = bflo(wa) * gs[2 * d]; x[2 * d + 1] = bfhi(wa) * gs[2 * d + 1]; x[8 + 2 * d] = bflo(wb) * gs[8 + 2 * d]; x[8 + 2 * d + 1] = bfhi(wb) * gs[8 + 2 * d + 1]; } }
        float res[16];
        u32x4g pa_[8], pb_[8];
#define U8_LD(dst, B) do { _Pragma("unroll") for (int k = 0; k < 8; ++k) { const int idx = il[u * 128 + (B) * 8 + k]; dst[k] = *(const u32x4g*)(Uj + (size_t)idx * 128); } } while (0)
#define U8_CM(src, B) do { float keep_ = 0.f; _Pragma("unroll") for (int k = 0; k < 8; ++k) { float sm = dot16_fp8(x, src[k]); sm += shx<1>(sm); sm += shx<2>(sm); sm += shx<4>(sm); keep_ = (k == c) ? sm : keep_; } res[B] = keep_; } while (0)
        U8_LD(pa_, 0);
#pragma unroll
        for (int b = 0; b < 16; b += 2) {
            U8_LD(pb_, b + 1); U8_CM(pa_, b);
            if (b + 2 < 16) U8_LD(pa_, b + 2);
            U8_CM(pb_, b + 1);
        }
#undef U8_LD
#undef U8_CM
        float* pa = PA + (t * 8 + j) * 128 + c;
#pragma unroll
        for (int b = 0; b < 16; ++b) pa[8 * b] = res[b];
    }
}
__device__ __forceinline__ void ph_gather_w(const float* gw, const float* PA, float* W, const float* ss16) {
    for (size_t e4 = (size_t)bidx() * NT + tidx(); e4 < (size_t)T * 32; e4 += (size_t)gridDim.x * NT) {
        const size_t t = e4 >> 5, e = (e4 & 31) * 4;
        f32x4 a = (f32x4){0.f, 0.f, 0.f, 0.f};
#pragma unroll
        for (int q = 0; q < 8; ++q) a += *(const f32x4*)(PA + (t * 8 + q) * 128 + e);
        const f32x4 g = *(const f32x4*)(gw + t * 128 + e); const float rs = pg8::rstd16(ss16, (int)t) * (1.0f / U_SCALE);
        f32x4 w;
#pragma unroll
        for (int k = 0; k < 4; ++k) w[k] = g[k] * gelu_tanh(a[k] * rs) * (1.0f / V_SCALE);
        *(f32x4*)(W + t * 128 + e) = w;
    }
}
__device__ __forceinline__ void ph_gather_v8(const int* eidx, const float* gw, const float* PA, const unsigned char* Vs, float* h, int j, int r, int nper, unsigned char* smem, bf16* XB, float* ss8) {
    const int tid = tidx(), lane = tid & 63, wave = tid >> 6, u = lane >> 3, c = lane & 7;
    LAS float* wl = (LAS float*)((LAS unsigned char*)smem + wave * 8192);
    LAS int* il = (LAS int*)((LAS unsigned char*)smem + wave * 8192 + 4096);
    const unsigned char* Vj = Vs + (size_t)j * NEXP * 128 + 16 * c;
    const int g0 = r * (NT / 64) + wave, gs = nper * (NT / 64); if (gs <= 0) return;
#pragma unroll 1
    for (int g = g0; g < T / 8; g += gs) {
        const size_t t = (size_t)g * 8 + u;
        {
#pragma unroll
            for (int i = 0; i < 4; ++i) { const f32x4 wv = *(const f32x4*)(PA + t * 128 + 16 * c + 4 * i); const u32x4g ee = *(const u32x4g*)(eidx + t * 128 + 16 * c + 4 * i);
                *(LAS f32x4*)(wl + u * 128 + 16 * c + 4 * i) = wv; *(LAS u32x4g*)(il + u * 128 + 16 * c + 4 * i) = ee; } }
        f32x2g acc2[8];
#pragma unroll
        for (int i = 0; i < 8; ++i) acc2[i] = (f32x2g){0.f, 0.f};
        u32x4g pa_[16], pb_[16];
#define V8_LD(dst, B) do { _Pragma("unroll") for (int k = 0; k < 16; ++k) { const int idx = il[u * 128 + (B) * 16 + k]; dst[k] = *(const u32x4g*)(Vj + (size_t)idx * 128); } } while (0)
#define V8_CM(src, B) do { _Pragma("unroll") for (int k = 0; k < 16; ++k) { const float w = wl[u * 128 + (B) * 16 + k]; const f32x2g w2 = {w, w}; const u32x4g v0 = src[k]; \
        _Pragma("unroll") for (int d = 0; d < 4; ++d) { const int vd = (int)v0[d]; const f32x2g lo = __builtin_amdgcn_cvt_pk_f32_fp8(vd, false), hi = __builtin_amdgcn_cvt_pk_f32_fp8(vd, true); \
            acc2[2 * d] = lo * w2 + acc2[2 * d]; acc2[2 * d + 1] = hi * w2 + acc2[2 * d + 1]; } } } while (0)
        V8_LD(pa_, 0);
#pragma unroll 1
        for (int b = 0; b < 8; b += 2) {
            V8_LD(pb_, b + 1); V8_CM(pa_, b);
            if (b + 2 < 8) V8_LD(pa_, b + 2);
            V8_CM(pb_, b + 1);
        }
#undef V8_LD
#undef V8_CM
        float* hp = h + t * DM + 128 * j + 16 * c; float sq = 0.f; u32x4g xo0, xo1;
#pragma unroll
        for (int i = 0; i < 4; ++i) { f32x4 hv = *(f32x4*)(hp + 4 * i); hv += (f32x4){acc2[2 * i][0], acc2[2 * i][1], acc2[2 * i + 1][0], acc2[2 * i + 1][1]}; *(f32x4*)(hp + 4 * i) = hv;
            sq += (hv[0] * hv[0] + hv[1] * hv[1]) + (hv[2] * hv[2] + hv[3] * hv[3]);
            if (i < 2) { xo0[2 * i] = pk2(hv[0], hv[1]); xo0[2 * i + 1] = pk2(hv[2], hv[3]); } else { xo1[2 * (i - 2)] = pk2(hv[0], hv[1]); xo1[2 * (i - 2) + 1] = pk2(hv[2], hv[3]); } }
        *(u32x4g*)(XB + t * DM + 128 * j + 16 * c) = xo0; *(u32x4g*)(XB + t * DM + 128 * j + 16 * c + 8) = xo1;
        sq += shx<1>(sq); sq += shx<2>(sq); sq += shx<4>(sq);
        if (c == 0) ss8[t * 8 + j] = sq;
    }
}

__device__ __forceinline__ void prep_piece(bf16* p, bool active, bool donorm, const float (&gain)[8], const float (&cs)[8], const float (&sn)[8], float scale, int lane) {
    u32x4g raw = (u32x4g){0u, 0u, 0u, 0u};
    if (active) raw = *(const u32x4g*)p;
    float f[8];
#pragma unroll
    for (int d = 0; d < 4; ++d) { const unsigned w = raw[d]; f[2 * d] = bflo(w); f[2 * d + 1] = bfhi(w); }
    if (donorm) {
        float ss = 0.f;
#pragma unroll
        for (int i = 0; i < 8; ++i) ss += f[i] * f[i];
        ss += shx<1>(ss); ss += shx<2>(ss); ss += shx<4>(ss);
        const float rstd = 1.0f / sqrtf(ss * (1.0f / 64.f) + NORM_EPS);
#pragma unroll
        for (int i = 0; i < 8; ++i) f[i] = f[i] * rstd * gain[i];
    }
    const int sub = lane & 7;
#pragma unroll
    for (int i = 0; i < 8; ++i) { const float pr = shx<1>(f[i]);
        const float r0 = f[i] * cs[i] - pr * sn[i], r1 = f[i] * cs[i] + pr * sn[i];
        f[i] = (sub == 0) ? r0 : ((sub == 1) ? r1 : f[i]); }
    u32x4g o;
#pragma unroll
    for (int d = 0; d < 4; ++d) o[d] = pk2(f[2 * d] * scale, f[2 * d + 1] * scale);
    if (active) *(u32x4g*)p = o;
}
#define ROPE_ROW(pos) float cs[8], sn[8]; { float c_ = 1.f, s_ = 0.f; if (lane < 8) rope_cs(pos, lane, c_, s_); \
    _Pragma("unroll") for (int i = 0; i < 8; ++i) { cs[i] = __builtin_bit_cast(float, __builtin_amdgcn_readlane(__builtin_bit_cast(int, c_), i)); sn[i] = __builtin_bit_cast(float, __builtin_amdgcn_readlane(__builtin_bit_cast(int, s_), i)); } }
#define LOAD_GAIN(dst, src) float dst[8]; { _Pragma("unroll") for (int i = 0; i < 8; ++i) dst[i] = (src)[8 * (lane & 7) + i]; }
__device__ __forceinline__ void ph_prep0_opt(bf16* qkv, const int* positions, const float* aq, const float* ak, const float* bq, const float* bk) {
    const int lane = tidx() & 63, wave = tidx() >> 6;
    const int gw = bidx() * (NT / 64) + wave, ngw = gridDim.x * (NT / 64);
    LOAD_GAIN(gaq, aq); LOAD_GAIN(gak, ak); LOAD_GAIN(gbq, bq); LOAD_GAIN(gbk, bk);
#pragma unroll 1
    for (int r = gw; r < T; r += ngw) {
        const int pos = positions[r]; bf16* row = qkv + (size_t)r * AB_LD + 8 * lane;
        ROPE_ROW(pos);
        prep_piece(row + CQA, true, true, gaq, cs, sn, C2, lane);
        prep_piece(row + CKA, true, true, gak, cs, sn, 1.f, lane);
        prep_piece(row + CQB, true, true, gbq, cs, sn, C2, lane);
        prep_piece(row + CKB, true, true, gbk, cs, sn, 1.f, lane);
        prep_piece(row + CQI, lane < 40, false, gaq, cs, sn, 1.f, lane);
    }
}
__device__ __forceinline__ void ph_prep1_opt(bf16* qkv, const int* positions, const float* cq, const float* ck) {
    const int lane = tidx() & 63, wave = tidx() >> 6;
    const int gw = bidx() * (NT / 64) + wave, ngw = gridDim.x * (NT / 64);
    LOAD_GAIN(gq, cq); LOAD_GAIN(gk, ck);
#pragma unroll 1
    for (int r = gw; r < T; r += ngw) {
        const int pos = positions[r]; bf16* row = qkv + (size_t)r * C_LD + 8 * lane;
        ROPE_ROW(pos);
        prep_piece(row, true, true, gq, cs, sn, C2, lane);
        prep_piece(row + 512, true, true, gq, cs, sn, C2, lane);
        prep_piece(row + 1024, true, true, gk, cs, sn, 1.f, lane);
        prep_piece(row + 1536, true, true, gk, cs, sn, 1.f, lane);
    }
}
__device__ __forceinline__ void ph_kmean_opt(const bf16* qkv, float* kmean) {
    const int lane = tidx() & 63, wave = tidx() >> 6;
    const int gw = bidx() * (NT / 64) + wave, ngw = gridDim.x * (NT / 64);
#pragma unroll 1
    for (int it = gw; it < BATCH * 8 * 32; it += ngw) {
        const int b = it / 256, h = (it / 32) % 8, n = it % 32;
        const bf16* base = qkv + (size_t)(b * SEQ + n * 256) * AB_LD + CKA + h * 64 + lane;
        float s = 0.f;
#pragma unroll 1
        for (int r = 0; r < 256; r += 16) { float v[16];
#pragma unroll
            for (int i = 0; i < 16; ++i) v[i] = bf2f(base[(size_t)(r + i) * AB_LD]);
#pragma unroll
            for (int i = 0; i < 16; ++i) s += v[i]; }
        kmean[(size_t)it * 64 + lane] = s * (1.0f / 256.f);
    }
}
__device__ __forceinline__ void ph_dil_merge_opt(const bf16* OG, const float* LSE, bf16* O) {
    const int lane = tidx() & 63, wave = tidx() >> 6;
    const int gw = bidx() * (NT / 64) + wave, ngw = gridDim.x * (NT / 64);
#pragma unroll 1
    for (int t = gw; t < T; t += ngw) {
        const int h = lane >> 2;
        const float l0 = LSE[((size_t)0 * T + t) * 16 + h], l1 = LSE[((size_t)1 * T + t) * 16 + h], l2 = LSE[((size_t)2 * T + t) * 16 + h];
        const float m = fmaxf(l0, fmaxf(l1, l2)); float w0 = exp2f(l0 - m), w1 = exp2f(l1 - m), w2 = exp2f(l2 - m);
        const float inv = 1.0f / (w0 + w1 + w2); w0 *= inv; w1 *= inv; w2 *= inv;
        const size_t off = (size_t)t * DM + 16 * lane;
#pragma unroll
        for (int half = 0; half < 2; ++half) {
            const u32x4g a = *(const u32x4g*)(OG + off + 8 * half), b = *(const u32x4g*)(OG + (size_t)T * DM + off + 8 * half), c = *(const u32x4g*)(OG + (size_t)2 * T * DM + off + 8 * half);
            u32x4g o;
#pragma unroll
            for (int d = 0; d < 4; ++d) { const unsigned ad = a[d], bd = b[d], cd = c[d];
                o[d] = pk2(w0 * bflo(ad) + w1 * bflo(bd) + w2 * bflo(cd), w0 * bfhi(ad) + w1 * bfhi(bd) + w2 * bfhi(cd)); }
            *(u32x4g*)(O + off + 8 * half) = o;
        }
    }
}


__device__ __forceinline__ void ph_moba_select_opt(const bf16* qkv, const float* kmean, unsigned* sel) {
    using attn_g::bf16x8; using attn_g::f32x16;
    const int tid = tidx(), lane = tid & 63, r32 = lane & 31, hi = lane >> 5, wave = tid >> 6;
#pragma unroll 1
    for (int unit = bidx(); unit < 512; unit += (int)gridDim.x) {
        const int bh = unit >> 5, qb = unit & 31, b = bh >> 3, h = bh & 7;
        const size_t trow = (size_t)b * SEQ + 256 * qb + 32 * wave + r32;
        const float* km = kmean + ((size_t)bh * 32 + r32) * 64;
        f32x16 g = {};
#pragma unroll
        for (int d0 = 0; d0 < 4; ++d0) {
            const f32x4 k0 = *(const f32x4*)(km + d0 * 16 + 8 * hi), k1 = *(const f32x4*)(km + d0 * 16 + 8 * hi + 4);
            u32x4g ap; ap[0] = pk2(k0[0], k0[1]); ap[1] = pk2(k0[2], k0[3]); ap[2] = pk2(k1[0], k1[1]); ap[3] = pk2(k1[2], k1[3]);
            const bf16x8 bq = *(const bf16x8*)(qkv + trow * AB_LD + CQA + h * 64 + d0 * 16 + 8 * hi);
            g = __builtin_amdgcn_mfma_f32_32x32x16_bf16(__builtin_bit_cast(bf16x8, ap), bq, g, 0, 0, 0);
        }
        float v0 = -3e38f, v1 = -3e38f, v2 = -3e38f; int i0 = 255, i1 = 255, i2 = 255;
#pragma unroll
        for (int r = 0; r < 16; ++r) { const int n = (r & 3) + 8 * (r >> 2) + 4 * hi; const float gv = g[r];
            if (n < qb) { if (gv > v0) { v2 = v1; i2 = i1; v1 = v0; i1 = i0; v0 = gv; i0 = n; } else if (gv > v1) { v2 = v1; i2 = i1; v1 = gv; i1 = n; } else if (gv > v2) { v2 = gv; i2 = n; } } }
        const float pv[3] = {shx<32>(v0), shx<32>(v1), shx<32>(v2)}; const int pi[3] = {shx<32>(i0), shx<32>(i1), shx<32>(i2)};
#pragma unroll
        for (int c = 0; c < 3; ++c) { const float gv = pv[c]; const int n = pi[c];
            if (n != 255) { if (gv > v0 || (gv == v0 && n < i0)) { v2 = v1; i2 = i1; v1 = v0; i1 = i0; v0 = gv; i0 = n; } else if (gv > v1 || (gv == v1 && n < i1)) { v2 = v1; i2 = i1; v1 = gv; i1 = n; } else if (gv > v2 || (gv == v2 && n < i2)) { v2 = gv; i2 = n; } } }
        if (hi == 0) sel[trow * 8 + h] = (unsigned)i0 | ((unsigned)i1 << 8) | ((unsigned)i2 << 16) | (255u << 24);
    }
}

namespace cg = cooperative_groups;
constexpr int LDS_BYTES = 147456;
#define GEMM_PHASE(EPI, Aptr, Bptr, Nn, Kk, ...) do { pg8::Gemm g_{(const pg8::bf16_t*)(Aptr), (const pg8::bf16_t*)(Bptr), T, (Nn), (Kk)}; pg8::StaticOrder S_; S_.init(T, (Nn), (int)gridDim.x, (int)bidx()); \
    pg8::EPI E_{__VA_ARGS__}; pg8::gemm_phase<pg8::EPI, pg8::StaticOrder, true, true>((PG8_LAS unsigned char*)smem, g_, S_, E_); } while (0)
__global__ void __launch_bounds__(NT, 2) k_mega(Params P) {
    extern __shared__ __attribute__((aligned(16))) unsigned char smem[];
    cg::grid_group grid = cg::this_grid();
    { const unsigned t0_ = (unsigned)__builtin_amdgcn_workitem_id_x(); if ((t0_ & 63u) == 0u) TID_TAB[hw_slot()] = t0_ >> 6; }
    __syncthreads();
#define BST ((volatile LAS unsigned*)((LAS unsigned char*)smem + 131072 + 64))
#define SLICE_J (__builtin_amdgcn_readfirstlane((int)BST[2]))
#define SLICE_R (__builtin_amdgcn_readfirstlane((int)BST[3]))
#define SLICE_N (__builtin_amdgcn_readfirstlane((int)BST[5]))
    if (tidx() < 2) BST[tidx()] = 0u;
    __syncthreads();
    (void)xcd_barrier_post((unsigned*)(WSP + WS_CTL) + 4096, BST);
#define BAR0() do { XcdBarrier b_; b_.bar = (unsigned*)(WSP + WS_CTL) + 4096; b_.x = xb_xcc_id(); b_.st = BST; xcd_barrier(b_); } while (0)
    #define BAR() do { BAR0(); STAMP(); } while (0)
#define TSW ((volatile LAS unsigned long long*)((LAS unsigned char*)smem + 131072 + 128))
    int nts = 0;
#define STAMP() do { if (PROBE_A >= 0) { if (bidx() == 0 && tidx() == 0) TSW[nts] = __builtin_amdgcn_s_memrealtime(); ++nts; } } while (0)
    STAMP();
    ph_prologue(smem);
    if (tidx() == 0) {
        const unsigned x = xb_xcc_id() & 7u; BST[2] = x; BST[3] = xb_add((unsigned*)(WSP + WS_CTL) + 8192 + 64 * x, 1u); }
    ph_rmsnorm(IN(0), IN(3), (bf16*)(WSP + WS_XN)); grid.sync(); STAMP();
    if (tidx() == 0) {
        bool reg = (gridDim.x % 8u) == 0u;
        for (unsigned q = 0; q < 8u; ++q) reg = reg && (xb_ld((unsigned*)(WSP + WS_CTL) + 8192 + 64 * q) == gridDim.x / 8u);
        if (!reg) { BST[2] = (unsigned)bidx() % 8u; BST[3] = (unsigned)bidx() / 8u; }
        BST[5] = (gridDim.x % 8u == 0u) ? gridDim.x / 8u : 0u; }
    __syncthreads();
    { unsigned char* ws = WSP; GEMM_PHASE(EPrep<0>, ws + WS_XN, ws + WS_WAB_IN, AB_LD, DM, (bf16*)(ws + WS_QKV), AB_LD, (const float*)(ws + WS_CST), (const float*)(ws + WS_GTAB), nullptr); } BAR();
    { unsigned char* ws = WSP; ph_kmean_opt((bf16*)(ws + WS_QKV), (float*)(ws + WS_KMEAN)); } BAR();
    { unsigned char* ws = WSP; ph_moba_select_opt((bf16*)(ws + WS_QKV), (float*)(ws + WS_KMEAN), (unsigned*)(ws + WS_SEL)); }
    { unsigned char* ws = WSP; ph_dsa_score((bf16*)(ws + WS_QKV), (float*)(ws + WS_SCORES), smem); } BAR();
    { unsigned char* ws = WSP; ph_dsa_select_opt((float*)(ws + WS_SCORES), (unsigned long long*)(ws + WS_MASK), smem); }
    __syncthreads();
    { unsigned char* ws = WSP; ph_attn_moba((bf16*)(ws + WS_QKV), (unsigned*)(ws + WS_SEL), (bf16*)(ws + WS_XN), smem); } BAR();
    { unsigned char* ws = WSP; ph_attn_dsa((bf16*)(ws + WS_QKV), (unsigned long long*)(ws + WS_MASK), (bf16*)(ws + WS_XN), smem); } BAR();
    { unsigned char* ws = WSP; GEMM_PHASE(EResAddN, ws + WS_XN, ws + WS_WAB_OUT, DM, DM, IN(0), OUTP, (pg8::bf16_t*)(ws + WS_XN2), (float*)(ws + WS_SS16)); }
    {
        unsigned char* ws = WSP;
#pragma unroll 1
        for (int L = 0; L < 2; ++L) {
            cvt_fp8<true>(IN(18) + (size_t)L * NEXP * DM, ws + WS_EXP + (size_t)(2 * L) * 16 * MiB, (size_t)NEXP * DM, U_SCALE);
            cvt_fp8<true>(IN(19) + (size_t)L * NEXP * DM, ws + WS_EXP + (size_t)(2 * L + 1) * 16 * MiB, (size_t)NEXP * DM, V_SCALE);
        }
    } BAR();
#pragma unroll 1
    for (int L = 0; L < 2; ++L) {
        if (L == 1) {
            { unsigned char* ws = WSP; GEMM_PHASE(EPrep<1>, ws + WS_XN2, ws + WS_WC_IN, C_LD, DM, (pg8::bf16_t*)(ws + WS_QKV1), C_LD, (const float*)(ws + WS_CST), (const float*)(ws + WS_GTAB), (const float*)(ws + WS_SS16)); } BAR();
            { unsigned char* ws = WSP; ph_attn_dilated((bf16*)(ws + WS_QKV1), (bf16*)(ws + WS_OG), (float*)(ws + WS_LSE), smem); } BAR();
            { unsigned char* ws = WSP; ph_dil_merge_opt((bf16*)(ws + WS_OG), (float*)(ws + WS_LSE), (bf16*)(ws + WS_XN)); } BAR();
            { unsigned char* ws = WSP; float* hb = OUTP; GEMM_PHASE(EResAddN, ws + WS_XN, ws + WS_WC_OUT, DM, DM, hb, hb, (pg8::bf16_t*)(ws + WS_XN2), (float*)(ws + WS_SS16)); } BAR();
        }
        { unsigned char* ws = WSP; GEMM_PHASE(EBf16S, ws + WS_XN2, ws + WS_WQ + (size_t)L * 4 * MiB, 2048, DM, (pg8::bf16_t*)(ws + WS_QRY), 2048, (const float*)(ws + WS_SS16)); } BAR();
        { unsigned char* ws = WSP; ph_peer_route_opt((bf16*)(ws + WS_QRY), (bf16*)(ws + WS_SUBK) + (size_t)L * 16 * 128 * 128, (int*)(ws + WS_EIDX), (float*)(ws + WS_GW), smem); } BAR();
        { unsigned char* ws = WSP; ph_gather_u8((bf16*)(ws + WS_XN2), (int*)(ws + WS_EIDX), ws + WS_EXP + (size_t)(2 * L) * 16 * MiB, (float*)(ws + WS_PA), SLICE_J, SLICE_R, SLICE_N, IN(4) + L * DM, smem); } BAR();
        { unsigned char* ws = WSP; ph_gather_w((float*)(ws + WS_GW), (float*)(ws + WS_PA), (float*)(ws + WS_GW), (const float*)(ws + WS_SS16)); }
        { unsigned char* ws = WSP; GEMM_PHASE(EBf16, ws + WS_P + (size_t)L * T * 256 * 2, ws + WS_WUP + (size_t)L * (MiB / 2), DM, 256, (bf16*)(ws + WS_UP), DM); } BAR();
        { unsigned char* ws = WSP; ph_gather_v8((int*)(ws + WS_EIDX), (float*)(ws + WS_GW), (float*)(ws + WS_GW), ws + WS_EXP + (size_t)(2 * L + 1) * 16 * MiB, OUTP, SLICE_J, SLICE_R, SLICE_N, smem, (bf16*)(ws + WS_XN), (float*)(ws + WS_SS8)); } BAR();
        if (L == 0) { unsigned char* ws = WSP; GEMM_PHASE(EGateN<false>, ws + WS_XN, ws + WS_WG, DM, DM, OUTP, (pg8::bf16_t*)(ws + WS_UP), (const float*)(ws + WS_SS8), (pg8::bf16_t*)(ws + WS_XN2), (float*)(ws + WS_SS16)); BAR(); }
        else { unsigned char* ws = WSP; GEMM_PHASE(EGateN<true>, ws + WS_XN, ws + WS_WG + 2 * MiB, DM, DM, OUTP, (pg8::bf16_t*)(ws + WS_UP), (const float*)(ws + WS_SS8), (pg8::bf16_t*)(ws + WS_XN2), (float*)(ws + WS_SS16)); STAMP(); }
    }
    if (PROBE_A >= 0 && bidx() == 0 && tidx() == 0) {
        const unsigned long long target = (unsigned long long)PROBE_K * (TSW[PROBE_B] - TSW[PROBE_A]), t0 = __builtin_amdgcn_s_memrealtime();
        while (__builtin_amdgcn_s_memrealtime() - t0 < target) __builtin_amdgcn_s_sleep(32);
    }
}

extern "C" void kernel_launch(void* const* d_in, const int* in_sizes, int n_in, void* d_out, int out_size, void* d_ws, size_t ws_size, hipStream_t stream) {
    static int grid_blocks = 0;
    if (grid_blocks == 0) {
        if (n_in != 22 || out_size != T * DM || ws_size < WS_END) { fprintf(stderr, "kernel_launch: unexpected shapes: n_in %d out %d ws %zu\n", n_in, out_size, ws_size); grid_blocks = -1; return; }
        if (hipFuncSetAttribute((const void*)k_mega, hipFuncAttributeMaxDynamicSharedMemorySize, LDS_BYTES) != hipSuccess) { fprintf(stderr, "hipFuncSetAttribute failed\n"); grid_blocks = -1; return; }
        int dev = 0, cus = 0, per_cu = 0;
        hipGetDevice(&dev);
        hipDeviceGetAttribute(&cus, hipDeviceAttributeMultiprocessorCount, dev);
        hipOccupancyMaxActiveBlocksPerMultiprocessor(&per_cu, (const void*)k_mega, NT, LDS_BYTES);
        if (per_cu < 1 || cus < 1) { fprintf(stderr, "kernel_launch: occupancy query says %d blocks/CU on %d CUs\n", per_cu, cus); grid_blocks = -1; return; }
        grid_blocks = cus;
    }
    if (grid_blocks < 0) return;
    Params P{};
    for (int i = 0; i < 22; ++i) P.in[i] = (const float*)d_in[i];
    P.out = (float*)d_out; P.ws = (unsigned char*)d_ws;
    if (hipMemsetAsync((char*)d_ws + WS_CTL, 0, 1 * MiB, stream) != hipSuccess) { fprintf(stderr, "kernel_launch: hipMemsetAsync failed\n"); return; }
    void* args[] = {&P};
    hipError_t e = hipLaunchCooperativeKernel((const void*)k_mega, dim3(grid_blocks), dim3(NT), args, LDS_BYTES, stream);
    if (e != hipSuccess) fprintf(stderr, "cooperative launch failed: %s (grid %d)\n", hipGetErrorString(e), grid_blocks);
}
```
